# Optimizing an MI355X kernel written in HIP

```python
import jax, jax.numpy as jnp
from jax import lax
import numpy as np

D_MODEL = 1024
BATCH = 2
SEQ = 8192
DEPTH = 2

GRID_W = 64
CTX_LEN = 256
N_MIXERS = 2
HG_HEADS = 8
HG_HEAD_DIM = D_MODEL // HG_HEADS
HG_CHUNK = 64
SC_WIDTH = 3
N_EXPERTS = 16
EC_CAPACITY_FACTOR = 2
D_EXPERT = 2 * D_MODEL
N_ADA = 6
N_HGRN_LAYERS = (DEPTH + 1) // 2
N_CONV_LAYERS = DEPTH // 2
LAST_CTX_READER = N_MIXERS * ((DEPTH - 1) // N_MIXERS)
EPS = 1e-6
POS_TEMP = 10000.0

kernel_name = "hybrid_hgrn2_shortconv_ecmoe_dit"


def _rmsnorm(x, g):
    xf = x.astype(jnp.float32)
    y = xf * lax.rsqrt(jnp.mean(xf * xf, axis=-1, keepdims=True) + EPS)
    return (y * g.astype(jnp.float32)).astype(x.dtype)


def _modulate(x, g, shift, scale):
    return _rmsnorm(x, g) * (1 + scale) + shift


def _grid_sincos(n_tokens, dtype):
    rows = n_tokens // GRID_W
    row = jnp.repeat(jnp.arange(rows), GRID_W).astype(jnp.float32)
    col = jnp.tile(jnp.arange(GRID_W), rows).astype(jnp.float32)
    n_freq = D_MODEL // 4
    omega = POS_TEMP ** (-jnp.arange(n_freq, dtype=jnp.float32) / n_freq)
    def emb(p):
        a = p[:, None] * omega[None, :]
        return jnp.concatenate([jnp.sin(a), jnp.cos(a)], axis=-1)
    return jnp.concatenate([emb(row), emb(col)], axis=-1).astype(dtype)


def _gla_chunks(q, k, v, logf, s0):
    b_, h_, t_, _ = q.shape
    n = t_ // HG_CHUNK
    def to_chunks(a):
        return jnp.moveaxis(a.reshape(b_, h_, n, HG_CHUNK, a.shape[-1]), 2, 0)
    incl = jnp.tril(jnp.ones((HG_CHUNK, HG_CHUNK), dtype=bool))[:, :, None]
    def step(s, inp):
        qc, kc, vc, lf = inp
        cum = jnp.cumsum(lf.astype(jnp.float32), axis=2)
        diff = cum[:, :, :, None, :] - cum[:, :, None, :, :]
        decay = jnp.exp(jnp.where(incl, diff, -jnp.inf))
        scores = jnp.einsum('bhtk,bhsk,bhtsk->bhts', qc, kc, decay)
        o = (jnp.einsum('bhts,bhsv->bhtv', scores, vc)
             + jnp.einsum('bhtk,bhkv->bhtv', qc * jnp.exp(cum), s))
        last = cum[:, :, -1, :]
        s = (jnp.exp(last)[..., None] * s
             + jnp.einsum('bhsk,bhsv->bhkv', kc * jnp.exp(last[:, :, None, :] - cum), vc))
        return s, o
    s_fin, o = lax.scan(step, s0, (to_chunks(q), to_chunks(k), to_chunks(v), to_chunks(logf)))
    o = jnp.moveaxis(o, 0, 2).reshape(b_, h_, t_, -1)
    return o, s_fin


def _hgrn_heads(h, w_in, lb, s0_fwd, s0_bwd):
    b_, t_, _ = h.shape
    q, i_in, z_fwd, z_bwd, g = jnp.split(h @ w_in, 5, axis=-1)
    def heads(a):
        return a.reshape(b_, t_, HG_HEADS, HG_HEAD_DIM).transpose(0, 2, 1, 3)
    q = heads(q) * HG_HEAD_DIM ** -0.5
    v = heads(i_in)
    lbh = lb.reshape(HG_HEADS, 1, HG_HEAD_DIM)
    def forget(z):
        f = lbh + (1 - lbh) * jax.nn.sigmoid(heads(z).astype(jnp.float32))
        return jnp.log(f), 1.0 - f
    logf_f, k_f = forget(z_fwd)
    logf_b, k_b = forget(z_bwd)
    o_f, s_f = _gla_chunks(q, k_f, v, logf_f, s0_fwd)
    flip = lambda a: jnp.flip(a, axis=2)
    o_b, s_b = _gla_chunks(flip(q), flip(k_b), flip(v), flip(logf_b), s0_bwd)
    return o_f + flip(o_b), g, s_f, s_b


def _hgrn_out(o, g, norm_g, w_out):
    b_, h_, t_, dv = o.shape
    o = _rmsnorm(o, norm_g)
    o = o.transpose(0, 2, 1, 3).reshape(b_, t_, h_ * dv).astype(g.dtype) * jax.nn.silu(g)
    return o @ w_out


def _short_conv(h, w_in, w_conv, w_out):
    b_gate, c_gate, u = jnp.split(h @ w_in, 3, axis=-1)
    u = c_gate * u
    y = lax.conv_general_dilated(
        u, w_conv.astype(u.dtype)[:, None, :], window_strides=(1,),
        padding=((SC_WIDTH // 2, SC_WIDTH // 2),),
        dimension_numbers=('NWC', 'WIO', 'NWC'), feature_group_count=D_MODEL)
    return (b_gate * y) @ w_out


def _ec_moe(h, w_router, w_gate, w_up, w_down):
    b_, t_, _ = h.shape
    cap = EC_CAPACITY_FACTOR * t_ // N_EXPERTS
    affinity = jax.nn.softmax((h @ w_router).astype(jnp.float32), axis=-1)
    gate, idx = lax.top_k(jnp.swapaxes(affinity, 1, 2), cap)
    bidx = jnp.arange(b_)[:, None, None]
    xg = h[bidx, idx]
    a = jnp.einsum('becd,edf->becf', xg, w_gate)
    u = jnp.einsum('becd,edf->becf', xg, w_up)
    y = jnp.einsum('becf,efd->becd', jax.nn.silu(a) * u, w_down)
    y = y * gate[..., None].astype(y.dtype)
    return jnp.zeros_like(h).at[bidx, idx].add(y)


def setup_inputs(seed: int = 0) -> dict:
    key = jax.random.key(seed)
    ks = jax.random.split(key, 22)
    f32 = jnp.float32
    def nrm(k, shape, fan_in):
        return jax.random.normal(k, shape, f32) * fan_in ** -0.5
    def gain(k, shape):
        return 1.0 + 0.02 * jax.random.normal(k, shape, f32)
    return {
        "x": jax.random.normal(ks[0], (BATCH, SEQ, D_MODEL), f32),
        "c": jax.random.normal(ks[1], (BATCH, D_MODEL), f32),
        "ctx": jax.random.normal(ks[2], (BATCH, CTX_LEN, D_MODEL), f32),
        "c_ctx": jax.random.normal(ks[3], (D_MODEL,), f32),
        "ada_w": 0.5 * nrm(ks[4], (DEPTH, D_MODEL, N_ADA * D_MODEL), D_MODEL),
        "ada_b": 0.02 * jax.random.normal(ks[5], (DEPTH, N_ADA * D_MODEL), f32),
        "norm_mix": gain(ks[6], (DEPTH, D_MODEL)),
        "norm_ffn": gain(ks[7], (DEPTH, D_MODEL)),
        "norm_final": gain(ks[8], (D_MODEL,)),
        "hg_w_in": nrm(ks[9], (N_HGRN_LAYERS, D_MODEL, 5 * D_MODEL), D_MODEL),
        "hg_lb_logits": 0.1 * jax.random.normal(ks[10], (DEPTH + 1, D_MODEL), f32),
        "hg_norm": gain(ks[11], (N_HGRN_LAYERS, HG_HEAD_DIM)),
        "hg_w_out": nrm(ks[12], (N_HGRN_LAYERS, D_MODEL, D_MODEL), D_MODEL),
        "sc_w_in": nrm(ks[13], (N_CONV_LAYERS, D_MODEL, 3 * D_MODEL), D_MODEL),
        "sc_conv": nrm(ks[14], (N_CONV_LAYERS, SC_WIDTH, D_MODEL), SC_WIDTH),
        "sc_w_out": nrm(ks[15], (N_CONV_LAYERS, D_MODEL, D_MODEL), D_MODEL),
        "moe_router": nrm(ks[16], (DEPTH, D_MODEL, N_EXPERTS), D_MODEL),
        "moe_w_gate": nrm(ks[17], (DEPTH, N_EXPERTS, D_MODEL, D_EXPERT), D_MODEL),
        "moe_w_up": nrm(ks[18], (DEPTH, N_EXPERTS, D_MODEL, D_EXPERT), D_MODEL),
        "moe_w_down": nrm(ks[19], (DEPTH, N_EXPERTS, D_EXPERT, D_MODEL), D_EXPERT),
    }


def reference(x, c, ctx, c_ctx, ada_w, ada_b, norm_mix, norm_ffn, norm_final,
              hg_w_in, hg_lb_logits, hg_norm, hg_w_out,
              sc_w_in, sc_conv, sc_w_out,
              moe_router, moe_w_gate, moe_w_up, moe_w_down):
    b_, t_, _ = x.shape
    x = x + _grid_sincos(t_, x.dtype)[None]
    xc = ctx
    lower_bounds = jnp.cumsum(jax.nn.softmax(hg_lb_logits.astype(jnp.float32), axis=0), axis=0)
    silu_c = jax.nn.silu(c)
    silu_cc = jax.nn.silu(c_ctx)
    for i in range(DEPTH):
        j = i // N_MIXERS
        ctx_live = i < LAST_CTX_READER
        sh1, sc1, g1, sh2, sc2, g2 = jnp.split((silu_c @ ada_w[i] + ada_b[i])[:, None, :], N_ADA, axis=-1)
        csh1, csc1, cg1, csh2, csc2, cg2 = jnp.split(silu_cc @ ada_w[i] + ada_b[i], N_ADA, axis=-1)
        h = _modulate(x, norm_mix[i], sh1, sc1)
        if i % N_MIXERS == 0:
            hc = _modulate(xc, norm_mix[i], csh1, csc1)
            zeros = jnp.zeros((b_, HG_HEADS, HG_HEAD_DIM, HG_HEAD_DIM), jnp.float32)
            oc, gc, s_f, s_b = _hgrn_heads(hc, hg_w_in[j], lower_bounds[i], zeros, zeros)
            o, g, _, _ = _hgrn_heads(h, hg_w_in[j], lower_bounds[i], s_f, s_b)
            x = x + g1 * _hgrn_out(o, g, hg_norm[j], hg_w_out[j])
            if ctx_live:
                xc = xc + cg1 * _hgrn_out(oc, gc, hg_norm[j], hg_w_out[j])
        else:
            x = x + g1 * _short_conv(h, sc_w_in[j], sc_conv[j], sc_w_out[j])
            if ctx_live:
                hc = _modulate(xc, norm_mix[i], csh1, csc1)
                xc = xc + cg1 * _short_conv(hc, sc_w_in[j], sc_conv[j], sc_w_out[j])
        h = _modulate(x, norm_ffn[i], sh2, sc2)
        x = x + g2 * _ec_moe(h, moe_router[i], moe_w_gate[i], moe_w_up[i], moe_w_down[i])
        if ctx_live:
            hc = _modulate(xc, norm_ffn[i], csh2, csc2)
            xc = xc + cg2 * _ec_moe(hc, moe_router[i], moe_w_gate[i], moe_w_up[i], moe_w_down[i])
    return _rmsnorm(x, norm_final)
```

```cpp
#include <hip/hip_runtime.h>
#include <cstdio>
#include <cstdint>

namespace pg8 {
#define PG8_LAS __attribute__((address_space(3)))
typedef unsigned short bf16_t;
typedef short bf16x8 __attribute__((ext_vector_type(8)));
typedef float f32x4 __attribute__((ext_vector_type(4)));
typedef unsigned u32x4 __attribute__((ext_vector_type(4)));
typedef unsigned u32x2 __attribute__((ext_vector_type(2)));
constexpr int BM = 256, BK = 64, HALF = 128, HTB = HALF * BK * 2, STAGE_BYTES = 8 * HTB, NXCD = 8, WGM = 8;

__host__ __device__ __forceinline__ int lds_byte(int r, int c) { const int st = (r >> 4) * 2 + (c >> 5), rr = r & 15, cc = c & 31, ob = rr * 64 + cc * 2; return st * 1024 + (ob ^ (((ob >> 9) & 1) << 5)); }
__host__ __device__ __forceinline__ void stage_rc(int b, int& R, int& C) { const int st = b / 1024, sb = b % 1024, swz = sb ^ (((sb >> 9) & 1) << 5); R = (st >> 1) * 16 + swz / 64; C = (st & 1) * 32 + (swz % 64) / 2; }
__host__ __device__ __forceinline__ int perm32(int rho) { const int n = rho >> 4, i = rho & 15; return 8 * (i >> 2) + 4 * n + (i & 3); }

struct Unit { int pm, pn, pb; };
struct Gemm { const bf16_t* A; const bf16_t* Bt; int M, N, K; };

struct StaticOrder {
    int nM, nN, nwg, G, c, mpe;
    __device__ void init(int M, int N, int G_, int c_, int mpe_) { nM = M / BM; nN = N / BM; nwg = nM * nN; G = G_; c = c_; mpe = mpe_; }
    __device__ bool next(int i, Unit& u) const {
        const long L = (long)i * G + c; if (L >= nwg) return false;
        int wgid = (int)L; { const int q = nwg / NXCD, r = nwg % NXCD, xcd = wgid % NXCD, off = wgid / NXCD; wgid = (xcd < r ? xcd * (q + 1) : r * (q + 1) + (xcd - r) * q) + off; }
        const int nig = WGM * nN, gid = wgid / nig, fm = gid * WGM, gsz = (nM - fm) < WGM ? (nM - fm) : WGM;
        u.pm = fm + ((wgid % nig) % gsz); u.pn = (wgid % nig) / gsz; u.pb = mpe > 0 ? (u.pm / mpe) * nN + u.pn : u.pn; return true;
    }
};

__device__ __forceinline__ unsigned cvt_pk_bf16(float lo, float hi) { unsigned r; asm volatile("v_cvt_pk_bf16_f32 %0, %1, %2" : "=v"(r) : "v"(lo), "v"(hi)); return r; }

template <class Epi>
__device__ __forceinline__ void gemm_phase(PG8_LAS unsigned char* lds, const Gemm g, const StaticOrder& S, const Epi& E) {
    const int tid = threadIdx.x, wid = __builtin_amdgcn_readfirstlane(tid >> 6), lane = tid & 63, wr = wid >> 2, wc = wid & 3, fr = lane & 15, fq = lane >> 4;
    const int K = g.K, nt = K / BK;
    unsigned voffA[2], voffB[2];
#pragma unroll
    for (int i = 0; i < 2; ++i) { int R, C; stage_rc(tid * 16 + i * 8192, R, C); const int Rb = Epi::PERM ? ((R & ~31) + perm32(R & 31)) : R;
        voffA[i] = (unsigned)(R * K + C) * 2u; voffB[i] = (unsigned)(Rb * K + C) * 2u; }
    const size_t kstep = (size_t)(BK * 2);
    const size_t hstep = (size_t)HALF * K * 2;
    const size_t tstep = 2 * hstep;
    const unsigned ldsw = (unsigned)wid * 1024u;
    const int aoff = lds_byte(wr * 64 + fr, fq * 8), boff = lds_byte(wc * 32 + fr, fq * 8);
#define PG8_SA(b, h) (((b) * 2 + (h)) * HTB)
#define PG8_SB(b, h) ((4 + (b) * 2 + (h)) * HTB)
#define PG8_STAGE(bufoff, gbase, voff) do { _Pragma("unroll") for (int _i = 0; _i < 2; ++_i) \
        __builtin_amdgcn_global_load_lds((const unsigned*)((const char*)(gbase) + (voff)[_i]), (PG8_LAS unsigned*)(lds + (bufoff) + ldsw + _i * 8192), 16, 0, 0); } while (0)
#define PG8_LDA(dst, b, h) do { _Pragma("unroll") for (int m = 0; m < 4; ++m) _Pragma("unroll") for (int k = 0; k < 2; ++k) dst[m][k] = *(const PG8_LAS bf16x8*)(lds + PG8_SA(b, h) + aoff + m * 2048 + k * 1024); } while (0)
#define PG8_LDB(dst, b, h) do { _Pragma("unroll") for (int n = 0; n < 2; ++n) _Pragma("unroll") for (int k = 0; k < 2; ++k) dst[n][k] = *(const PG8_LAS bf16x8*)(lds + PG8_SB(b, h) + boff + n * 2048 + k * 1024); } while (0)
#define PG8_MMA(ai, bj, At, Bt) do { __builtin_amdgcn_s_setprio(1); _Pragma("unroll") for (int m = 0; m < 4; ++m) _Pragma("unroll") for (int n = 0; n < 2; ++n) _Pragma("unroll") for (int k = 0; k < 2; ++k) \
        acc[ai][bj][m][n] = __builtin_amdgcn_mfma_f32_16x16x32_bf16(Bt[n][k], At[m][k], acc[ai][bj][m][n], 0, 0, 0); __builtin_amdgcn_s_setprio(0); } while (0)
#define PG8_WAIT_V(n) asm volatile("s_waitcnt vmcnt(" #n ")" ::: "memory")
#define PG8_WAIT_L(n) asm volatile("s_waitcnt lgkmcnt(" #n ")" ::: "memory")
#define PG8_BAR __builtin_amdgcn_s_barrier()
#define PG8_SCHED __builtin_amdgcn_sched_barrier(0)
    Unit cur, nxt; int ui = 0;
    if (!S.next(0, cur)) return;
    f32x4 acc[2][2][4][2];
#pragma unroll
    for (int a = 0; a < 2; ++a)
#pragma unroll
        for (int b = 0; b < 2; ++b)
#pragma unroll
            for (int m = 0; m < 4; ++m)
#pragma unroll
                for (int n = 0; n < 2; ++n) acc[a][b][m][n] = (f32x4){0.f, 0.f, 0.f, 0.f};
    bf16x8 At[4][2], B0[2][2], B1[2][2];
    const char* cA = (const char*)g.A + (size_t)cur.pm * tstep; const char* cB = (const char*)g.Bt + (size_t)cur.pb * tstep;
    PG8_STAGE(PG8_SB(0, 0), cB, voffB); PG8_STAGE(PG8_SB(0, 1), cB + hstep, voffB); PG8_STAGE(PG8_SA(0, 0), cA, voffA); PG8_STAGE(PG8_SA(0, 1), cA + hstep, voffA);
    if (wr == 1) PG8_BAR;
    PG8_WAIT_V(2); PG8_BAR;
    PG8_STAGE(PG8_SB(1, 0), cB + kstep, voffB); PG8_STAGE(PG8_SA(1, 0), cA + kstep, voffA); PG8_STAGE(PG8_SB(1, 1), cB + hstep + kstep, voffB);
    PG8_WAIT_V(6); PG8_BAR;
    for (;;) {
        const bool has_next = S.next(ui + 1, nxt);
        const char* nA = has_next ? (const char*)g.A + (size_t)nxt.pm * tstep : cA; const char* nB = has_next ? (const char*)g.Bt + (size_t)nxt.pb * tstep : cB;
        for (int t = 0; t < nt; t += 2) {
            const bool last = (t == nt - 2);
            const char* a1 = cA + (size_t)(t + 1) * kstep;
            const char* a2 = last ? nA : cA + (size_t)(t + 2) * kstep; const char* b2 = last ? nB : cB + (size_t)(t + 2) * kstep;
            const char* a3 = a2 + kstep; const char* b3 = b2 + kstep;
            PG8_LDB(B0, 0, 0); PG8_LDB(B1, 0, 1); PG8_SCHED; PG8_LDA(At, 0, 0); PG8_STAGE(PG8_SA(1, 1), a1 + hstep, voffA);
            PG8_WAIT_V(8); PG8_WAIT_L(0); PG8_BAR; PG8_MMA(0, 0, At, B0); PG8_MMA(0, 1, At, B1); PG8_BAR; PG8_SCHED;
            PG8_LDA(At, 0, 1); PG8_STAGE(PG8_SB(0, 0), b2, voffB); PG8_STAGE(PG8_SB(0, 1), b2 + hstep, voffB); PG8_STAGE(PG8_SA(0, 0), a2, voffA);
            PG8_WAIT_V(8); PG8_WAIT_L(0); PG8_BAR; PG8_MMA(1, 0, At, B0); PG8_MMA(1, 1, At, B1); PG8_BAR; PG8_SCHED;
            PG8_LDB(B0, 1, 0); PG8_LDB(B1, 1, 1); PG8_SCHED; PG8_LDA(At, 1, 0); PG8_STAGE(PG8_SA(0, 1), a2 + hstep, voffA);
            PG8_WAIT_V(8); PG8_WAIT_L(0); PG8_BAR; PG8_MMA(0, 0, At, B0); PG8_MMA(0, 1, At, B1); PG8_BAR; PG8_SCHED;
            PG8_LDA(At, 1, 1); PG8_STAGE(PG8_SB(1, 0), b3, voffB); PG8_STAGE(PG8_SB(1, 1), b3 + hstep, voffB); PG8_STAGE(PG8_SA(1, 0), a3, voffA);
            PG8_WAIT_V(8); PG8_WAIT_L(0); PG8_BAR; PG8_MMA(1, 0, At, B0); PG8_MMA(1, 1, At, B1); PG8_BAR; PG8_SCHED;
        }
        if (wr == 0) PG8_BAR;
        E(acc, cur, wr, wc, fr, fq);
        if (!has_next) break;
#pragma unroll
        for (int a = 0; a < 2; ++a)
#pragma unroll
            for (int b = 0; b < 2; ++b)
#pragma unroll
                for (int m = 0; m < 4; ++m)
#pragma unroll
                    for (int n = 0; n < 2; ++n) acc[a][b][m][n] = (f32x4){0.f, 0.f, 0.f, 0.f};
        cur = nxt; cA = nA; cB = nB; ++ui;
        if (wr == 1) PG8_BAR;
    }
    PG8_WAIT_V(0);
    PG8_BAR;
#undef PG8_SA
#undef PG8_SB
#undef PG8_STAGE
#undef PG8_LDA
#undef PG8_LDB
#undef PG8_MMA
#undef PG8_WAIT_V
#undef PG8_WAIT_L
#undef PG8_BAR
#undef PG8_SCHED
}
}

using pg8::bf16_t; using pg8::f32x4; using pg8::u32x4; using pg8::u32x2;
typedef unsigned short u16x8 __attribute__((ext_vector_type(8)));
typedef float f32x2 __attribute__((ext_vector_type(2)));

constexpr int DM = 1024, NB = 2, SEQ = 8192, NTOK = NB * SEQ, CTXL = 256, NCTX = NB * CTXL, NROW = NTOK + NCTX;
constexpr int NE = 16, CAP = 1024, DE = 2048, NSLOT = NE * NB * CAP;
constexpr int NADA = 6 * DM;
constexpr int NTHR = 512;

constexpr size_t MiB = 1u << 20;
constexpr size_t WS_CTL = 0;
constexpr size_t WS_MOD = 1 * MiB;
constexpr size_t WS_LB = WS_MOD + 256 * 1024;
constexpr size_t WS_POSR = WS_LB + 64 * 1024;
constexpr size_t WS_POSC = WS_POSR + 256 * 1024;
constexpr size_t WS_AFF = 2 * MiB;
constexpr size_t WS_TOPI = 3 * MiB;
constexpr size_t WS_TOPG = WS_TOPI + 128 * 1024;
constexpr size_t WS_SLOT = 4 * MiB;
constexpr size_t WS_WHGIN = 6 * MiB;
constexpr size_t WS_WHGOUT = 16 * MiB;
constexpr size_t WS_WSCIN = 18 * MiB;
constexpr size_t WS_WSCOUT = 24 * MiB;
constexpr size_t WS_WMOE1 = 26 * MiB;
constexpr size_t WS_WMOE2 = WS_WMOE1 + 256 * MiB;
constexpr size_t WS_X = WS_WMOE2 + 128 * MiB;
constexpr size_t WS_H = WS_X + 64 * MiB;
constexpr size_t WS_R = WS_H + 34 * MiB;
constexpr size_t WS_Q = WS_R;
constexpr size_t WS_V = WS_Q + 34 * MiB;
constexpr size_t WS_G = WS_V + 34 * MiB;
constexpr size_t WS_LF = WS_G + 34 * MiB;
constexpr size_t WS_LBK = WS_LF + 66 * MiB;
constexpr size_t WS_OF = WS_LBK + 66 * MiB;
constexpr size_t WS_OB = WS_OF + 64 * MiB;
constexpr size_t WS_ON = WS_OB + 64 * MiB;
constexpr size_t WS_HG_END = WS_ON + 32 * MiB;
constexpr size_t WS_XG = WS_R;
constexpr size_t WS_ACT = WS_XG + 64 * MiB;
constexpr size_t WS_Y = WS_ACT + 128 * MiB;
constexpr size_t WS_MOE_END = WS_Y + 128 * MiB;
constexpr size_t WS_BG = WS_R;
constexpr size_t WS_CU = WS_BG + 32 * MiB;
constexpr size_t WS_Z = WS_CU + 32 * MiB;
constexpr size_t WS_END = WS_HG_END > WS_MOE_END ? WS_HG_END : WS_MOE_END;
static_assert(WS_END <= 1024 * MiB, "workspace map exceeds 1 GiB");

constexpr int LDS_BYTES = 135168;

struct Params { const float* in[20]; float* out; unsigned char* ws; int ph_lo, ph_hi; };
enum { I_X = 0, I_C, I_CTX, I_CCTX, I_ADAW, I_ADAB, I_NMIX, I_NFFN, I_NFIN, I_HGWIN, I_HGLB, I_HGNORM, I_HGWOUT, I_SCWIN, I_SCCONV, I_SCWOUT, I_ROUTER, I_WGATE, I_WUP, I_WDOWN };

__device__ __forceinline__ unsigned f2bf(float f) { unsigned u = __builtin_bit_cast(unsigned, f); return (u + 0x7fffu + ((u >> 16) & 1u)) >> 16; }
__device__ __forceinline__ unsigned pk2(float lo, float hi) { return f2bf(lo) | (f2bf(hi) << 16); }
__device__ __forceinline__ float bf2f(unsigned short h) { return __builtin_bit_cast(float, (unsigned)h << 16); }
__device__ __forceinline__ float wave_sum(float v) {
#pragma unroll
    for (int o = 1; o < 64; o <<= 1) v += __shfl_xor(v, o);
    return v;
}
__device__ __forceinline__ float sigmoidf_(float x) { return 1.f / (1.f + expf(-x)); }
__device__ __forceinline__ float siluf_(float x) { return x / (1.f + expf(-x)); }

struct EpiInProj {
    static constexpr bool PERM = false;
    bf16_t *Q, *V, *G; float *LF, *LBK; const float* lb0;
    __device__ __forceinline__ void operator()(const f32x4 (&acc)[2][2][4][2], const pg8::Unit& u, int wr, int wc, int fr, int fq) const {
        const int sec = u.pn >> 2;
        const int row0 = u.pm * 256 + wr * 64 + fr, cb = (u.pn & 3) * 256 + wc * 32 + 4 * fq;
        if (sec == 0 || sec == 1 || sec == 4) {
            bf16_t* O = sec == 0 ? Q : (sec == 1 ? V : G);
#pragma unroll
            for (int ai = 0; ai < 2; ++ai)
#pragma unroll
                for (int m = 0; m < 4; ++m) { bf16_t* rp = O + (size_t)(row0 + ai * 128 + m * 16) * DM + cb;
#pragma unroll
                    for (int bj = 0; bj < 2; ++bj)
#pragma unroll
                        for (int n = 0; n < 2; ++n) { f32x4 v = acc[ai][bj][m][n];
                            if (sec == 0) v = v * 0.08838834764831845f;
                            if (sec == 4) { v[0] = siluf_(v[0]); v[1] = siluf_(v[1]); v[2] = siluf_(v[2]); v[3] = siluf_(v[3]); }
                            u32x2 w; w.x = pk2(v[0], v[1]); w.y = pk2(v[2], v[3]); *(u32x2*)(rp + bj * 128 + n * 16) = w; } }
        } else {
            float* O = sec == 2 ? LF : LBK;
            f32x4 lbv[2][2];
#pragma unroll
            for (int bj = 0; bj < 2; ++bj)
#pragma unroll
                for (int n = 0; n < 2; ++n) lbv[bj][n] = *(const f32x4*)(lb0 + cb + bj * 128 + n * 16);
#pragma unroll
            for (int ai = 0; ai < 2; ++ai)
#pragma unroll
                for (int m = 0; m < 4; ++m) { float* rp = O + (size_t)(row0 + ai * 128 + m * 16) * DM + cb;
#pragma unroll
                    for (int bj = 0; bj < 2; ++bj)
#pragma unroll
                        for (int n = 0; n < 2; ++n) { const f32x4 z = acc[ai][bj][m][n], lb = lbv[bj][n]; f32x4 o;
#pragma unroll
                            for (int i = 0; i < 4; ++i) o[i] = logf(lb[i] + (1.f - lb[i]) * sigmoidf_(z[i]));
                            *(f32x4*)(rp + bj * 128 + n * 16) = o; } }
        }
    }
};
struct EpiResid {
    static constexpr bool PERM = false;
    float* X; const float* gate;
    __device__ __forceinline__ void operator()(const f32x4 (&acc)[2][2][4][2], const pg8::Unit& u, int wr, int wc, int fr, int fq) const {
        const int row0 = u.pm * 256 + wr * 64 + fr, cb = u.pn * 256 + wc * 32 + 4 * fq;
        const float* gp = gate + (size_t)((u.pm * 256) / SEQ) * NADA + cb;
        f32x4 gv[2][2];
#pragma unroll
        for (int bj = 0; bj < 2; ++bj)
#pragma unroll
            for (int n = 0; n < 2; ++n) gv[bj][n] = *(const f32x4*)(gp + bj * 128 + n * 16);
#pragma unroll
        for (int ai = 0; ai < 2; ++ai)
#pragma unroll
            for (int m = 0; m < 4; ++m) { float* rp = X + (size_t)(row0 + ai * 128 + m * 16) * DM + cb;
#pragma unroll
                for (int bj = 0; bj < 2; ++bj)
#pragma unroll
                    for (int n = 0; n < 2; ++n) { f32x4* q = (f32x4*)(rp + bj * 128 + n * 16); *q = *q + gv[bj][n] * acc[ai][bj][m][n]; } }
    }
};
struct EpiGLU {
    static constexpr bool PERM = true;
    bf16_t* ACT;
    __device__ __forceinline__ void operator()(const f32x4 (&acc)[2][2][4][2], const pg8::Unit& u, int wr, int wc, int fr, int fq) const {
        const int row0 = u.pm * 256 + wr * 64 + fr, cb = u.pn * 128 + wc * 32 + 8 * fq;
#pragma unroll
        for (int ai = 0; ai < 2; ++ai)
#pragma unroll
            for (int m = 0; m < 4; ++m) { bf16_t* rp = ACT + (size_t)(row0 + ai * 128 + m * 16) * DE + cb;
                f32x4 o[2];
#pragma unroll
                for (int n = 0; n < 2; ++n) { const f32x4 a = acc[ai][0][m][n], w = acc[ai][1][m][n];
#pragma unroll
                    for (int i = 0; i < 4; ++i) o[n][i] = siluf_(a[i]) * w[i]; }
                u32x4 w; w.x = pk2(o[0][0], o[0][1]); w.y = pk2(o[0][2], o[0][3]); w.z = pk2(o[1][0], o[1][1]); w.w = pk2(o[1][2], o[1][3]);
                *(u32x4*)rp = w; }
    }
};
struct EpiRowScale {
    static constexpr bool PERM = false;
    float* Y; const float* rg;
    __device__ __forceinline__ void operator()(const f32x4 (&acc)[2][2][4][2], const pg8::Unit& u, int wr, int wc, int fr, int fq) const {
        const int row0 = u.pm * 256 + wr * 64 + fr, cb = u.pn * 256 + wc * 32 + 4 * fq;
#pragma unroll
        for (int ai = 0; ai < 2; ++ai)
#pragma unroll
            for (int m = 0; m < 4; ++m) { const int row = row0 + ai * 128 + m * 16; const float gsc = rg[row]; float* rp = Y + (size_t)row * DM + cb;
#pragma unroll
                for (int bj = 0; bj < 2; ++bj)
#pragma unroll
                    for (int n = 0; n < 2; ++n) *(f32x4*)(rp + bj * 128 + n * 16) = acc[ai][bj][m][n] * gsc; }
    }
};
struct EpiConvIn {
    static constexpr bool PERM = true;
    bf16_t *BG, *CU;
    __device__ __forceinline__ void operator()(const f32x4 (&acc)[2][2][4][2], const pg8::Unit& u, int wr, int wc, int fr, int fq) const {
        const int row0 = u.pm * 256 + wr * 64 + fr;
        if (u.pn < 4) {
            const int cb = u.pn * 256 + wc * 32 + 8 * fq;
#pragma unroll
            for (int ai = 0; ai < 2; ++ai)
#pragma unroll
                for (int m = 0; m < 4; ++m) { bf16_t* rp = BG + (size_t)(row0 + ai * 128 + m * 16) * DM + cb;
#pragma unroll
                    for (int bj = 0; bj < 2; ++bj) { const f32x4 v0 = acc[ai][bj][m][0], v1 = acc[ai][bj][m][1];
                        u32x4 w; w.x = pk2(v0[0], v0[1]); w.y = pk2(v0[2], v0[3]); w.z = pk2(v1[0], v1[1]); w.w = pk2(v1[2], v1[3]);
                        *(u32x4*)(rp + bj * 128) = w; } }
        } else {
            const int cb = (u.pn - 4) * 128 + wc * 32 + 8 * fq;
#pragma unroll
            for (int ai = 0; ai < 2; ++ai)
#pragma unroll
                for (int m = 0; m < 4; ++m) { bf16_t* rp = CU + (size_t)(row0 + ai * 128 + m * 16) * DM + cb;
                    const f32x4 v0 = acc[ai][0][m][0] * acc[ai][1][m][0], v1 = acc[ai][0][m][1] * acc[ai][1][m][1];
                    u32x4 w; w.x = pk2(v0[0], v0[1]); w.y = pk2(v0[2], v0[3]); w.z = pk2(v1[0], v1[1]); w.w = pk2(v1[2], v1[3]);
                    *(u32x4*)rp = w; }
        }
    }
};

__device__ __forceinline__ void ph_prep(const Params& p, unsigned char* lds, int bid, int nblk) {
    float* sv = (float*)lds;
    float* red = sv + 3 * 1024;
    const int tid = threadIdx.x;
    const float* c = p.in[I_C]; const float* cctx = p.in[I_CCTX];
    for (int i = tid; i < 3 * 1024; i += NTHR) { const float v = (i < 2048) ? c[i] : cctx[i - 2048]; sv[i] = siluf_(v); }
    __syncthreads();
    const float* ada_w = p.in[I_ADAW]; const float* ada_b = p.in[I_ADAB];
    float* mod = (float*)(p.ws + WS_MOD);
    for (int it = bid; it < 96; it += nblk) {
        const int l = it / 48, j0 = (it % 48) * 128, col = tid & 127, ks = tid >> 7;
        const float* W = ada_w + (size_t)l * DM * NADA + j0 + col;
        float a0 = 0.f, a1 = 0.f, a2 = 0.f;
#pragma unroll 8
        for (int k = ks * 256; k < ks * 256 + 256; ++k) { const float w = W[(size_t)k * NADA]; a0 += sv[k] * w; a1 += sv[1024 + k] * w; a2 += sv[2048 + k] * w; }
        red[(ks * 3 + 0) * 128 + col] = a0; red[(ks * 3 + 1) * 128 + col] = a1; red[(ks * 3 + 2) * 128 + col] = a2;
        __syncthreads();
        if (tid < 384) { const int v = tid >> 7, cc = tid & 127;
            const float s = (red[(0 * 3 + v) * 128 + cc] + red[(1 * 3 + v) * 128 + cc]) + (red[(2 * 3 + v) * 128 + cc] + red[(3 * 3 + v) * 128 + cc]) + ada_b[l * NADA + j0 + cc];
            mod[(size_t)(l * 3 + v) * NADA + j0 + cc] = s; }
        __syncthreads();
    }
    const int gt = bid * NTHR + tid, NT = nblk * NTHR;
    const float* lg = p.in[I_HGLB]; float* lb0 = (float*)(p.ws + WS_LB);
    for (int d = gt; d < DM; d += NT) { const float l0 = lg[d], l1 = lg[DM + d], l2 = lg[2 * DM + d]; const float mx = fmaxf(l0, fmaxf(l1, l2));
        const float e0 = expf(l0 - mx), e1 = expf(l1 - mx), e2 = expf(l2 - mx); lb0[d] = e0 / (e0 + e1 + e2); }
    float* posr = (float*)(p.ws + WS_POSR);
    for (int i = gt; i < (128 + 64) * 512; i += NT) { const int pi = i >> 9, dd = i & 511; const int pos = pi < 128 ? pi : pi - 128; const int fi = dd & 255;
        const float om = exp2f(-(float)fi * (13.287712379549449f / 256.0f)); const float a = (float)pos * om; posr[i] = dd < 256 ? sinf(a) : cosf(a); }
}

__device__ __forceinline__ void transpose_item(const float* W, int N, bf16_t* WT, int K, float* scr, int k0, int n0, size_t drow0, int lane) {
#pragma unroll 8
    for (int i = 0; i < 32; ++i) { const int kk = 2 * i + (lane >> 5); scr[kk * 33 + (lane & 31)] = W[(size_t)(k0 + kk) * N + n0 + (lane & 31)]; }
    __builtin_amdgcn_s_waitcnt(0xc07f); asm volatile("" ::: "memory");
    const int c = lane & 7;
#pragma unroll
    for (int j = 0; j < 4; ++j) { const int n = (lane >> 3) + 8 * j; const float* s = scr + (8 * c) * 33 + n;
        u32x4 o; o.x = pk2(s[0 * 33], s[1 * 33]); o.y = pk2(s[2 * 33], s[3 * 33]); o.z = pk2(s[4 * 33], s[5 * 33]); o.w = pk2(s[6 * 33], s[7 * 33]);
        *(u32x4*)(WT + (drow0 + n) * K + k0 + 8 * c) = o; }
    __builtin_amdgcn_s_waitcnt(0xc07f); asm volatile("" ::: "memory");
}
__device__ __forceinline__ void ph_convert(const Params& p, unsigned char* lds, int bid, int nblk) {
    const int tid = threadIdx.x, lane = tid & 63, wave = tid >> 6;
    float* scr = (float*)lds + wave * (64 * 33);
    const int gw = bid * 8 + wave, NGW = nblk * 8;
    constexpr int I_A = 16 * 160, I_B = 16 * 32, I_C_ = 16 * 96, I_D = 16 * 32, I_E = 32 * 1024, I_F = 32 * 1024, I_G = 32 * 1024;
    constexpr int NITEMS = I_A + I_B + I_C_ + I_D + I_E + I_F + I_G;
    for (int it = gw; it < NITEMS; it += NGW) {
        int r = it;
        if (r < I_A) { const int kb = r / 160, nb = r % 160; transpose_item(p.in[I_HGWIN], 5120, (bf16_t*)(p.ws + WS_WHGIN), 1024, scr, kb * 64, nb * 32, (size_t)nb * 32, lane); continue; } r -= I_A;
        if (r < I_B) { const int kb = r / 32, nb = r % 32; transpose_item(p.in[I_HGWOUT], 1024, (bf16_t*)(p.ws + WS_WHGOUT), 1024, scr, kb * 64, nb * 32, (size_t)nb * 32, lane); continue; } r -= I_B;
        if (r < I_C_) { const int kb = r / 96, nb = r % 96, n0 = nb * 32; size_t dr;
            if (n0 < 1024) dr = n0; else { const int np = n0 - 1024, sec = np >> 10, nn = np & 1023; dr = 1024 + (nn >> 7) * 256 + sec * 128 + (nn & 127); }
            transpose_item(p.in[I_SCWIN], 3072, (bf16_t*)(p.ws + WS_WSCIN), 1024, scr, kb * 64, n0, dr, lane); continue; } r -= I_C_;
        if (r < I_D) { const int kb = r / 32, nb = r % 32; transpose_item(p.in[I_SCWOUT], 1024, (bf16_t*)(p.ws + WS_WSCOUT), 1024, scr, kb * 64, nb * 32, (size_t)nb * 32, lane); continue; } r -= I_D;
        if (r < I_E + I_F) { const int up = r >= I_E; if (up) r -= I_E; const int le = r >> 10, q = r & 1023, kb = q >> 6, nb = q & 63, n0 = nb * 32;
            const size_t dr = (size_t)le * 4096 + (n0 >> 7) * 256 + up * 128 + (n0 & 127);
            transpose_item(p.in[up ? I_WUP : I_WGATE] + (size_t)le * 1024 * 2048, 2048, (bf16_t*)(p.ws + WS_WMOE1), 1024, scr, kb * 64, n0, dr, lane); continue; } r -= I_E + I_F;
        { const int le = r >> 10, q = r & 1023, kb = q >> 5, nb = q & 31, n0 = nb * 32;
            transpose_item(p.in[I_WDOWN] + (size_t)le * 2048 * 1024, 1024, (bf16_t*)(p.ws + WS_WMOE2), 2048, scr, kb * 64, n0, (size_t)le * 1024 + n0, lane); }
    }
}

__device__ __forceinline__ void store_mod_bf16(bf16_t* hrow, const f32x4 (&v)[4], float rstd, const float* g, const float* sh, const float* sc, int lane) {
#pragma unroll
    for (int j = 0; j < 4; ++j) { const int c0 = 256 * j + 4 * lane; const f32x4 gv = *(const f32x4*)(g + c0), shv = *(const f32x4*)(sh + c0), scv = *(const f32x4*)(sc + c0);
        f32x4 h;
#pragma unroll
        for (int i = 0; i < 4; ++i) h[i] = (v[j][i] * rstd * gv[i]) * (1.f + scv[i]) + shv[i];
        u32x2 w; w.x = pk2(h[0], h[1]); w.y = pk2(h[2], h[3]); *(u32x2*)(hrow + c0) = w; }
}
__device__ __forceinline__ void ph_mod0(const Params& p, int bid, int nblk) {
    const int tid = threadIdx.x, lane = tid & 63, wave = tid >> 6, gw = bid * 8 + wave, NGW = nblk * 8;
    const float* x = p.in[I_X]; const float* ctx = p.in[I_CTX]; const float* g = p.in[I_NMIX];
    const float* mod = (const float*)(p.ws + WS_MOD); const float* posr = (const float*)(p.ws + WS_POSR); const float* posc = (const float*)(p.ws + WS_POSC);
    float* X = (float*)(p.ws + WS_X); bf16_t* H = (bf16_t*)(p.ws + WS_H);
    for (int row = gw; row < NROW; row += NGW) {
        f32x4 v[4]; float ss = 0.f; int vec;
        if (row < NTOK) { const int t = row & (SEQ - 1); vec = row >> 13; const float* pr = posr + (size_t)(t >> 6) * 512; const float* pc = posc + (size_t)(t & 63) * 512;
#pragma unroll
            for (int j = 0; j < 4; ++j) { const int c0 = 256 * j + 4 * lane; const f32x4 pv = *(const f32x4*)((j < 2 ? pr : pc) + (c0 & 511));
                v[j] = *(const f32x4*)(x + (size_t)row * DM + c0) + pv; *(f32x4*)(X + (size_t)row * DM + c0) = v[j]; }
        } else { vec = 2;
#pragma unroll
            for (int j = 0; j < 4; ++j) v[j] = *(const f32x4*)(ctx + (size_t)(row - NTOK) * DM + 256 * j + 4 * lane); }
#pragma unroll
        for (int j = 0; j < 4; ++j) ss += (v[j][0] * v[j][0] + v[j][1] * v[j][1]) + (v[j][2] * v[j][2] + v[j][3] * v[j][3]);
        const float rstd = 1.f / sqrtf(wave_sum(ss) * (1.f / DM) + 1e-6f);
        const float* mv = mod + (size_t)(0 * 3 + vec) * NADA;
        store_mod_bf16(H + (size_t)row * DM, v, rstd, g, mv, mv + DM, lane);
    }
}

__device__ __forceinline__ void ph_gla_simple(const Params& p, unsigned char* lds, int bid, int nblk) {
    float* qs = (float*)lds; float* fs = qs + 4096; float* ks = fs + 4096; float* vs = ks + 4096; float* part = vs + 1024;
    const int tid = threadIdx.x, lane = tid & 63, wave = tid >> 6, kk = tid >> 5, vv = tid & 31;
    const bf16_t* Q = (const bf16_t*)(p.ws + WS_Q); const bf16_t* V = (const bf16_t*)(p.ws + WS_V);
    for (int unit = bid; unit < 128; unit += nblk) {
        const int vsl = unit & 3, dir = (unit >> 2) & 1, h = (unit >> 3) & 7, b = unit >> 6;
        const float* LFp = (const float*)(p.ws + (dir ? WS_LBK : WS_LF)); float* O = (float*)(p.ws + (dir ? WS_OB : WS_OF));
        float s[8];
#pragma unroll
        for (int i = 0; i < 8; ++i) s[i] = 0.f;
        for (int bt = 0; bt < 8 + 256; ++bt) {
            const bool isctx = bt < 8; const int nb = isctx ? bt : bt - 8, nbt = isctx ? 8 : 256;
            const int t0 = dir == 0 ? nb * 32 : (nbt - 1 - nb) * 32;
            const size_t rbase = isctx ? (size_t)(NTOK + b * CTXL + t0) : (size_t)(b * SEQ + t0);
            { const int r = tid >> 4, c8 = (tid & 15) * 8; const size_t off = (rbase + r) * DM + h * 128 + c8;
                const u16x8 qv = *(const u16x8*)(Q + off); const f32x4 l0 = *(const f32x4*)(LFp + off), l1 = *(const f32x4*)(LFp + off + 4);
#pragma unroll
                for (int i = 0; i < 8; ++i) { qs[r * 128 + c8 + i] = bf2f(qv[i]); const float f = expf(i < 4 ? l0[i] : l1[i - 4]); fs[r * 128 + c8 + i] = f; ks[r * 128 + c8 + i] = 1.f - f; }
                if (tid < 128) { const int r2 = tid >> 2, c = (tid & 3) * 8; const u16x8 vv8 = *(const u16x8*)(V + (rbase + r2) * DM + h * 128 + vsl * 32 + c);
#pragma unroll
                    for (int i = 0; i < 8; ++i) vs[r2 * 32 + c + i] = bf2f(vv8[i]); } }
            __syncthreads();
            for (int jj = 0; jj < 32; ++jj) { const int j = dir ? 31 - jj : jj; const float vj = vs[j * 32 + vv]; float po = 0.f;
#pragma unroll
                for (int i = 0; i < 8; ++i) { const float f = fs[j * 128 + kk * 8 + i], k_ = ks[j * 128 + kk * 8 + i], q_ = qs[j * 128 + kk * 8 + i]; s[i] = f * s[i] + k_ * vj; po += q_ * s[i]; }
                po += __shfl_xor(po, 32);
                if (!isctx && lane < 32) part[(j * 8 + wave) * 32 + vv] = po; }
            __syncthreads();
            if (!isctx) { const int j = tid >> 4, v2 = (tid & 15) * 2; float o0 = 0.f, o1 = 0.f;
#pragma unroll
                for (int w = 0; w < 8; ++w) { o0 += part[(j * 8 + w) * 32 + v2]; o1 += part[(j * 8 + w) * 32 + v2 + 1]; }
                *(f32x2*)(O + (rbase + j) * DM + h * 128 + vsl * 32 + v2) = (f32x2){o0, o1}; }
        }
        __syncthreads();
    }
}

__device__ __forceinline__ void ph_onorm(const Params& p, int bid, int nblk) {
    const int tid = threadIdx.x, lane = tid & 63, wave = tid >> 6, gw = bid * 8 + wave, NGW = nblk * 8;
    const float* OF = (const float*)(p.ws + WS_OF); const float* OB = (const float*)(p.ws + WS_OB); const bf16_t* G = (const bf16_t*)(p.ws + WS_G); bf16_t* ON = (bf16_t*)(p.ws + WS_ON);
    const float* ng = p.in[I_HGNORM];
    const f32x4 gv = *(const f32x4*)(ng + 4 * (lane & 31));
    for (int row = gw; row < NTOK; row += NGW) {
#pragma unroll
        for (int j = 0; j < 4; ++j) { const size_t off = (size_t)row * DM + 256 * j + 4 * lane; const f32x4 o = *(const f32x4*)(OF + off) + *(const f32x4*)(OB + off);
            float ss = (o[0] * o[0] + o[1] * o[1]) + (o[2] * o[2] + o[3] * o[3]);
#pragma unroll
            for (int d = 1; d < 32; d <<= 1) ss += __shfl_xor(ss, d);
            const float rstd = 1.f / sqrtf(ss * (1.f / 128.f) + 1e-6f);
            const u32x2 gg = *(const u32x2*)(G + off);
            const float g0 = bf2f((unsigned short)(gg.x & 0xffffu)), g1 = bf2f((unsigned short)(gg.x >> 16)), g2 = bf2f((unsigned short)(gg.y & 0xffffu)), g3 = bf2f((unsigned short)(gg.y >> 16));
            u32x2 w; w.x = pk2(o[0] * rstd * gv[0] * g0, o[1] * rstd * gv[1] * g1); w.y = pk2(o[2] * rstd * gv[2] * g2, o[3] * rstd * gv[3] * g3);
            *(u32x2*)(ON + off) = w; }
    }
}

__device__ __forceinline__ void ph_modffn(const Params& p, unsigned char* lds, int bid, int nblk, int l) {
    const int tid = threadIdx.x, lane = tid & 63, wave = tid >> 6, gw = bid * 8 + wave, NGW = nblk * 8;
    float* rw = (float*)lds;
    const float* router = p.in[I_ROUTER] + (size_t)l * DM * NE;
    for (int i = tid; i < DM * NE / 4; i += NTHR) ((f32x4*)rw)[i] = ((const f32x4*)router)[i];
    __syncthreads();
    const float* X = (const float*)(p.ws + WS_X); bf16_t* H = (bf16_t*)(p.ws + WS_H); float* aff = (float*)(p.ws + WS_AFF); int* slot = (int*)(p.ws + WS_SLOT);
    const float* g = p.in[I_NFFN] + (size_t)l * DM; const float* mod = (const float*)(p.ws + WS_MOD);
    for (int row = gw; row < NTOK; row += NGW) {
        const int b = row >> 13, t = row & (SEQ - 1);
        const float* mv = mod + (size_t)(l * 3 + b) * NADA; const float* sh = mv + 3 * DM; const float* sc = mv + 4 * DM;
        f32x4 v[4]; float ss = 0.f;
#pragma unroll
        for (int j = 0; j < 4; ++j) { v[j] = *(const f32x4*)(X + (size_t)row * DM + 256 * j + 4 * lane); ss += (v[j][0] * v[j][0] + v[j][1] * v[j][1]) + (v[j][2] * v[j][2] + v[j][3] * v[j][3]); }
        const float rstd = 1.f / sqrtf(wave_sum(ss) * (1.f / DM) + 1e-6f);
        float lg[16];
#pragma unroll
        for (int e = 0; e < 16; ++e) lg[e] = 0.f;
#pragma unroll
        for (int j = 0; j < 4; ++j) { const int c0 = 256 * j + 4 * lane; const f32x4 gv = *(const f32x4*)(g + c0), shv = *(const f32x4*)(sh + c0), scv = *(const f32x4*)(sc + c0);
            f32x4 h;
#pragma unroll
            for (int i = 0; i < 4; ++i) { h[i] = (v[j][i] * rstd * gv[i]) * (1.f + scv[i]) + shv[i];
                const f32x4 r0 = *(const f32x4*)(rw + (c0 + i) * 16), r1 = *(const f32x4*)(rw + (c0 + i) * 16 + 4), r2 = *(const f32x4*)(rw + (c0 + i) * 16 + 8), r3 = *(const f32x4*)(rw + (c0 + i) * 16 + 12);
#pragma unroll
                for (int e = 0; e < 4; ++e) { lg[e] += h[i] * r0[e]; lg[4 + e] += h[i] * r1[e]; lg[8 + e] += h[i] * r2[e]; lg[12 + e] += h[i] * r3[e]; }
                asm volatile("" ::: "memory"); }
            u32x2 w; w.x = pk2(h[0], h[1]); w.y = pk2(h[2], h[3]); *(u32x2*)(H + (size_t)row * DM + c0) = w; }
        float mx = -3.0e38f;
#pragma unroll
        for (int e = 0; e < 16; ++e) { lg[e] = wave_sum(lg[e]); mx = fmaxf(mx, lg[e]); }
        float den = 0.f;
#pragma unroll
        for (int e = 0; e < 16; ++e) { lg[e] = expf(lg[e] - mx); den += lg[e]; }
        const float inv = 1.f / den;
        float mine = 0.f;
#pragma unroll
        for (int e = 0; e < 16; ++e) mine = (lane == e) ? lg[e] * inv : mine;
        if (lane < 16) { aff[(size_t)(b * NE + lane) * SEQ + t] = mine; slot[(size_t)row * NE + lane] = -1; }
    }
}

__device__ __forceinline__ void ph_topk(const Params& p, unsigned char* lds, int bid, int nblk) {
    unsigned long long* a = (unsigned long long*)lds;
    const int tid = threadIdx.x;
    const float* aff = (const float*)(p.ws + WS_AFF); int* topi = (int*)(p.ws + WS_TOPI); float* topg = (float*)(p.ws + WS_TOPG); int* slot = (int*)(p.ws + WS_SLOT);
    for (int it = bid; it < NB * NE; it += nblk) {
        const int b = it >> 4, e = it & 15; const float* src = aff + (size_t)it * SEQ;
        for (int i = tid; i < SEQ; i += NTHR) a[i] = ((unsigned long long)__float_as_uint(src[i]) << 32) | (unsigned long long)(0xFFFFFFFFu - (unsigned)i);
        __syncthreads();
        for (int k = 2; k <= SEQ; k <<= 1)
            for (int j = k >> 1; j > 0; j >>= 1) {
                for (int t = tid; t < SEQ / 2; t += NTHR) { const int i = ((t & ~(j - 1)) << 1) | (t & (j - 1)), ixj = i | j; const bool desc = (i & k) == 0;
                    const unsigned long long x = a[i], y = a[ixj]; if ((x < y) == desc) { a[i] = y; a[ixj] = x; } }
                __syncthreads();
            }
        for (int s = tid; s < CAP; s += NTHR) { const unsigned long long x = a[s]; const int idx = (int)(0xFFFFFFFFu - (unsigned)(x & 0xFFFFFFFFull)); const float gt = __uint_as_float((unsigned)(x >> 32));
            const int r = (e * NB + b) * CAP + s; topi[r] = b * SEQ + idx; topg[r] = gt; slot[(size_t)(b * SEQ + idx) * NE + e] = s; }
        __syncthreads();
    }
}

__device__ __forceinline__ void ph_gather(const Params& p, int bid, int nblk) {
    const int tid = threadIdx.x, lane = tid & 63, wave = tid >> 6, gw = bid * 8 + wave, NGW = nblk * 8;
    const bf16_t* H = (const bf16_t*)(p.ws + WS_H); bf16_t* XG = (bf16_t*)(p.ws + WS_XG); const int* topi = (const int*)(p.ws + WS_TOPI);
    for (int r = gw; r < NSLOT; r += NGW) { const int src = topi[r];
        const u32x4* s = (const u32x4*)(H + (size_t)src * DM); u32x4* d = (u32x4*)(XG + (size_t)r * DM);
        d[lane] = s[lane]; d[64 + lane] = s[64 + lane]; }
}

__device__ __forceinline__ void ph_combine(const Params& p, int bid, int nblk, int l, bool final_) {
    const int tid = threadIdx.x, lane = tid & 63, wave = tid >> 6, gw = bid * 8 + wave, NGW = nblk * 8;
    float* X = (float*)(p.ws + WS_X); bf16_t* H = (bf16_t*)(p.ws + WS_H); const float* Y = (const float*)(p.ws + WS_Y); const int* slot = (const int*)(p.ws + WS_SLOT);
    const float* mod = (const float*)(p.ws + WS_MOD);
    for (int row = gw; row < NTOK; row += NGW) {
        const int b = row >> 13;
        const float* g2 = mod + (size_t)(l * 3 + b) * NADA + 5 * DM;
        f32x4 a[4];
#pragma unroll
        for (int j = 0; j < 4; ++j) a[j] = (f32x4){0.f, 0.f, 0.f, 0.f};
        const int myslot = lane < 16 ? slot[(size_t)row * NE + lane] : -1;
        for (int e = 0; e < NE; ++e) { const int s = __shfl(myslot, e);
            if (s >= 0) { const float* yr = Y + (size_t)((e * NB + b) * CAP + s) * DM;
#pragma unroll
                for (int j = 0; j < 4; ++j) a[j] = a[j] + *(const f32x4*)(yr + 256 * j + 4 * lane); } }
        f32x4 v[4]; float ss = 0.f;
#pragma unroll
        for (int j = 0; j < 4; ++j) { const int c0 = 256 * j + 4 * lane; v[j] = *(const f32x4*)(X + (size_t)row * DM + c0) + *(const f32x4*)(g2 + c0) * a[j];
            ss += (v[j][0] * v[j][0] + v[j][1] * v[j][1]) + (v[j][2] * v[j][2] + v[j][3] * v[j][3]); }
        const float rstd = 1.f / sqrtf(wave_sum(ss) * (1.f / DM) + 1e-6f);
        if (final_) { const float* gf = p.in[I_NFIN];
#pragma unroll
            for (int j = 0; j < 4; ++j) { const int c0 = 256 * j + 4 * lane; const f32x4 gv = *(const f32x4*)(gf + c0); *(f32x4*)(p.out + (size_t)row * DM + c0) = v[j] * rstd * gv; }
        } else {
#pragma unroll
            for (int j = 0; j < 4; ++j) *(f32x4*)(X + (size_t)row * DM + 256 * j + 4 * lane) = v[j];
            const float* mv = mod + (size_t)((l + 1) * 3 + b) * NADA;
            store_mod_bf16(H + (size_t)row * DM, v, rstd, p.in[I_NMIX] + (size_t)(l + 1) * DM, mv, mv + DM, lane);
        }
    }
}

__device__ __forceinline__ void ph_conv(const Params& p, int bid, int nblk) {
    const int tid = threadIdx.x, lane = tid & 63, wave = tid >> 6, gw = bid * 8 + wave, NGW = nblk * 8;
    const bf16_t* BG = (const bf16_t*)(p.ws + WS_BG); const bf16_t* CU = (const bf16_t*)(p.ws + WS_CU); bf16_t* Z = (bf16_t*)(p.ws + WS_Z);
    const float* wc = p.in[I_SCCONV];
    for (int row = gw; row < NTOK; row += NGW) { const int t = row & (SEQ - 1);
#pragma unroll
        for (int hh = 0; hh < 2; ++hh) { const int c0 = hh * 512 + 8 * lane; const size_t off = (size_t)row * DM + c0;
            const u16x8 z0 = {0, 0, 0, 0, 0, 0, 0, 0};
            const u16x8 um = t > 0 ? *(const u16x8*)(CU + off - DM) : z0, u0 = *(const u16x8*)(CU + off), up = t < SEQ - 1 ? *(const u16x8*)(CU + off + DM) : z0, bg = *(const u16x8*)(BG + off);
            float o[8];
#pragma unroll
            for (int i = 0; i < 8; ++i) o[i] = bf2f(bg[i]) * (wc[c0 + i] * bf2f(um[i]) + wc[DM + c0 + i] * bf2f(u0[i]) + wc[2 * DM + c0 + i] * bf2f(up[i]));
            u32x4 w; w.x = pk2(o[0], o[1]); w.y = pk2(o[2], o[3]); w.z = pk2(o[4], o[5]); w.w = pk2(o[6], o[7]); *(u32x4*)(Z + off) = w; }
    }
}

constexpr int NPHASE = 22;
template <int PHT> __global__ void __launch_bounds__(NTHR, 2) mega(Params p) {
    extern __shared__ __attribute__((aligned(16))) unsigned char lds[];
    const int bid = blockIdx.x, nblk = gridDim.x;
    PG8_LAS unsigned char* l3 = (PG8_LAS unsigned char*)lds;
    unsigned char* ws = p.ws;
    const float* mod = (const float*)(ws + WS_MOD);
    { constexpr int ph = PHT;
        switch (ph) {
        case 0: ph_prep(p, lds, bid, nblk); break;
        case 1: ph_convert(p, lds, bid, nblk); break;
        case 2: ph_mod0(p, bid, nblk); break;
        case 3: { pg8::Gemm g{(const bf16_t*)(ws + WS_H), (const bf16_t*)(ws + WS_WHGIN), NROW, 5120, DM}; pg8::StaticOrder S; S.init(NROW, 5120, nblk, bid, 0);
            EpiInProj E{(bf16_t*)(ws + WS_Q), (bf16_t*)(ws + WS_V), (bf16_t*)(ws + WS_G), (float*)(ws + WS_LF), (float*)(ws + WS_LBK), (const float*)(ws + WS_LB)};
            pg8::gemm_phase<EpiInProj>(l3, g, S, E); } break;
        case 4: ph_gla_simple(p, lds, bid, nblk); break;
        case 5: ph_onorm(p, bid, nblk); break;
        case 6: { pg8::Gemm g{(const bf16_t*)(ws + WS_ON), (const bf16_t*)(ws + WS_WHGOUT), NTOK, DM, DM}; pg8::StaticOrder S; S.init(NTOK, DM, nblk, bid, 0);
            EpiResid E{(float*)(ws + WS_X), mod + 2 * DM}; pg8::gemm_phase<EpiResid>(l3, g, S, E); } break;
        case 7: ph_modffn(p, lds, bid, nblk, 0); break;
        case 8: case 17: ph_topk(p, lds, bid, nblk); break;
        case 9: case 18: ph_gather(p, bid, nblk); break;
        case 10: case 19: { const int l = ph == 10 ? 0 : 1;
            pg8::Gemm g{(const bf16_t*)(ws + WS_XG), (const bf16_t*)(ws + WS_WMOE1) + (size_t)l * NE * 4096 * DM, NSLOT, 4096, DM}; pg8::StaticOrder S; S.init(NSLOT, 4096, nblk, bid, 8);
            EpiGLU E{(bf16_t*)(ws + WS_ACT)}; pg8::gemm_phase<EpiGLU>(l3, g, S, E); } break;
        case 11: case 20: { const int l = ph == 11 ? 0 : 1;
            pg8::Gemm g{(const bf16_t*)(ws + WS_ACT), (const bf16_t*)(ws + WS_WMOE2) + (size_t)l * NE * DM * DE, NSLOT, DM, DE}; pg8::StaticOrder S; S.init(NSLOT, DM, nblk, bid, 8);
            EpiRowScale E{(float*)(ws + WS_Y), (const float*)(ws + WS_TOPG)}; pg8::gemm_phase<EpiRowScale>(l3, g, S, E); } break;
        case 12: ph_combine(p, bid, nblk, 0, false); break;
        case 13: { pg8::Gemm g{(const bf16_t*)(ws + WS_H), (const bf16_t*)(ws + WS_WSCIN), NTOK, 3072, DM}; pg8::StaticOrder S; S.init(NTOK, 3072, nblk, bid, 0);
            EpiConvIn E{(bf16_t*)(ws + WS_BG), (bf16_t*)(ws + WS_CU)}; pg8::gemm_phase<EpiConvIn>(l3, g, S, E); } break;
        case 14: ph_conv(p, bid, nblk); break;
        case 15: { pg8::Gemm g{(const bf16_t*)(ws + WS_Z), (const bf16_t*)(ws + WS_WSCOUT), NTOK, DM, DM}; pg8::StaticOrder S; S.init(NTOK, DM, nblk, bid, 0);
            EpiResid E{(float*)(ws + WS_X), mod + (size_t)3 * NADA + 2 * DM}; pg8::gemm_phase<EpiResid>(l3, g, S, E); } break;
        case 16: ph_modffn(p, lds, bid, nblk, 1); break;
        case 21: ph_combine(p, bid, nblk, 1, true); break;
        default: break;
        }
    }
}

#include <utility>
template <int... I> static void set_attrs(std::integer_sequence<int, I...>) { ((void)hipFuncSetAttribute((const void*)mega<I>, hipFuncAttributeMaxDynamicSharedMemorySize, LDS_BYTES), ...); }
template <int... I> static void launch_all(std::integer_sequence<int, I...>, int grid, const Params& p, hipStream_t stream) { ((mega<I><<<dim3(grid), dim3(NTHR), LDS_BYTES, stream>>>(p)), ...); }
extern "C" void kernel_launch(void* const* d_in, const int* in_sizes, int n_in, void* d_out, int out_size, void* d_ws, size_t ws_size, hipStream_t stream) {
    static int grid = 0;
    if (grid == 0) {
        if (n_in != 20 || ws_size < WS_END) { fprintf(stderr, "kernel_launch: unexpected inputs (n_in %d, ws %zu, need %zu)\n", n_in, ws_size, (size_t)WS_END); grid = -1; return; }
        int dev = 0, cus = 0;
        (void)hipGetDevice(&dev); (void)hipDeviceGetAttribute(&cus, hipDeviceAttributeMultiprocessorCount, dev);
        set_attrs(std::make_integer_sequence<int, NPHASE>{});
        grid = cus > 0 ? cus : 256;
    }
    if (grid < 0) return;
    Params p{};
    for (int i = 0; i < 20; ++i) p.in[i] = (const float*)d_in[i];
    p.out = (float*)d_out; p.ws = (unsigned char*)d_ws;
    launch_all(std::make_integer_sequence<int, NPHASE>{}, grid, p, stream);
}
```

```cpp
#include <hip/hip_runtime.h>
#include <cstdio>
#include <cstdint>

namespace pg8 {
#define PG8_LAS __attribute__((address_space(3)))
typedef unsigned short bf16_t;
typedef short bf16x8 __attribute__((ext_vector_type(8)));
typedef float f32x4 __attribute__((ext_vector_type(4)));
typedef unsigned u32x4 __attribute__((ext_vector_type(4)));
typedef unsigned u32x2 __attribute__((ext_vector_type(2)));
constexpr int BM = 256, BK = 64, HALF = 128, HTB = HALF * BK * 2, STAGE_BYTES = 8 * HTB, NXCD = 8, WGM = 8;

__host__ __device__ __forceinline__ int lds_byte(int r, int c) { const int st = (r >> 4) * 2 + (c >> 5), rr = r & 15, cc = c & 31, ob = rr * 64 + cc * 2; return st * 1024 + (ob ^ (((ob >> 9) & 1) << 5)); }
__host__ __device__ __forceinline__ void stage_rc(int b, int& R, int& C) { const int st = b / 1024, sb = b % 1024, swz = sb ^ (((sb >> 9) & 1) << 5); R = (st >> 1) * 16 + swz / 64; C = (st & 1) * 32 + (swz % 64) / 2; }
__host__ __device__ __forceinline__ int perm32(int rho) { const int n = rho >> 4, i = rho & 15; return 8 * (i >> 2) + 4 * n + (i & 3); }

struct Unit { int pm, pn, pb; };
struct Gemm { const bf16_t* A; const bf16_t* Bt; int M, N, K; };

struct StaticOrder {
    int nM, nN, nwg, G, c, mpe;
    __device__ void init(int M, int N, int G_, int c_, int mpe_) { nM = M / BM; nN = N / BM; nwg = nM * nN; G = G_; c = c_; mpe = mpe_; }
    __device__ bool next(int i, Unit& u) const {
        const long L = (long)i * G + c; if (L >= nwg) return false;
        int wgid = (int)L; { const int q = nwg / NXCD, r = nwg % NXCD, xcd = wgid % NXCD, off = wgid / NXCD; wgid = (xcd < r ? xcd * (q + 1) : r * (q + 1) + (xcd - r) * q) + off; }
        const int nig = WGM * nN, gid = wgid / nig, fm = gid * WGM, gsz = (nM - fm) < WGM ? (nM - fm) : WGM;
        u.pm = fm + ((wgid % nig) % gsz); u.pn = (wgid % nig) / gsz; u.pb = mpe > 0 ? (u.pm / mpe) * nN + u.pn : u.pn; return true;
    }
};

__device__ __forceinline__ unsigned cvt_pk_bf16(float lo, float hi) { unsigned r; asm volatile("v_cvt_pk_bf16_f32 %0, %1, %2" : "=v"(r) : "v"(lo), "v"(hi)); return r; }

template <class Epi>
__device__ __forceinline__ void gemm_phase(PG8_LAS unsigned char* lds, const Gemm g, const StaticOrder& S, const Epi& E) {
    int tid_ = threadIdx.x; asm volatile("" : "+v"(tid_));
    const int tid = tid_, wid = __builtin_amdgcn_readfirstlane(tid >> 6), lane = tid & 63, wr = wid >> 2, wc = wid & 3, fr = lane & 15, fq = lane >> 4;
    const int K = g.K, nt = K / BK;
    unsigned voffA[2], voffB[2];
#pragma unroll
    for (int i = 0; i < 2; ++i) { int R, C; stage_rc(tid * 16 + i * 8192, R, C); const int Rb = Epi::PERM ? ((R & ~31) + perm32(R & 31)) : R;
        voffA[i] = (unsigned)(R * K + C) * 2u; voffB[i] = (unsigned)(Rb * K + C) * 2u; }
    const size_t kstep = (size_t)(BK * 2);
    const size_t hstep = (size_t)HALF * K * 2;
    const size_t tstep = 2 * hstep;
    const unsigned ldsw = (unsigned)wid * 1024u;
    const int aoff = lds_byte(wr * 64 + fr, fq * 8), boff = lds_byte(wc * 32 + fr, fq * 8);
#define PG8_SA(b, h) (((b) * 2 + (h)) * HTB)
#define PG8_SB(b, h) ((4 + (b) * 2 + (h)) * HTB)
#define PG8_STAGE(bufoff, gbase, voff) do { _Pragma("unroll") for (int _i = 0; _i < 2; ++_i) \
        __builtin_amdgcn_global_load_lds((const unsigned*)((const char*)(gbase) + (voff)[_i]), (PG8_LAS unsigned*)(lds + (bufoff) + ldsw + _i * 8192), 16, 0, 0); } while (0)
#define PG8_LDA(dst, b, h) do { _Pragma("unroll") for (int m = 0; m < 4; ++m) _Pragma("unroll") for (int k = 0; k < 2; ++k) dst[m][k] = *(const PG8_LAS bf16x8*)(lds + PG8_SA(b, h) + aoff + m * 2048 + k * 1024); } while (0)
#define PG8_LDB(dst, b, h) do { _Pragma("unroll") for (int n = 0; n < 2; ++n) _Pragma("unroll") for (int k = 0; k < 2; ++k) dst[n][k] = *(const PG8_LAS bf16x8*)(lds + PG8_SB(b, h) + boff + n * 2048 + k * 1024); } while (0)
#define PG8_MMA(ai, bj, At, Bt) do { __builtin_amdgcn_s_setprio(1); _Pragma("unroll") for (int m = 0; m < 4; ++m) _Pragma("unroll") for (int n = 0; n < 2; ++n) _Pragma("unroll") for (int k = 0; k < 2; ++k) \
        acc[ai][bj][m][n] = __builtin_amdgcn_mfma_f32_16x16x32_bf16(Bt[n][k], At[m][k], acc[ai][bj][m][n], 0, 0, 0); __builtin_amdgcn_s_setprio(0); } while (0)
#define PG8_WAIT_V(n) asm volatile("s_waitcnt vmcnt(" #n ")" ::: "memory")
#define PG8_WAIT_L(n) asm volatile("s_waitcnt lgkmcnt(" #n ")" ::: "memory")
#define PG8_BAR __builtin_amdgcn_s_barrier()
#define PG8_SCHED __builtin_amdgcn_sched_barrier(0)
    Unit cur, nxt; int ui = 0;
    if (!S.next(0, cur)) return;
    f32x4 acc[2][2][4][2];
#pragma unroll
    for (int a = 0; a < 2; ++a)
#pragma unroll
        for (int b = 0; b < 2; ++b)
#pragma unroll
            for (int m = 0; m < 4; ++m)
#pragma unroll
                for (int n = 0; n < 2; ++n) acc[a][b][m][n] = (f32x4){0.f, 0.f, 0.f, 0.f};
    bf16x8 At[4][2], B0[2][2], B1[2][2];
    const char* cA = (const char*)g.A + (size_t)cur.pm * tstep; const char* cB = (const char*)g.Bt + (size_t)cur.pb * tstep;
    PG8_STAGE(PG8_SB(0, 0), cB, voffB); PG8_STAGE(PG8_SB(0, 1), cB + hstep, voffB); PG8_STAGE(PG8_SA(0, 0), cA, voffA); PG8_STAGE(PG8_SA(0, 1), cA + hstep, voffA);
    if (wr == 1) PG8_BAR;
    PG8_WAIT_V(2); PG8_BAR;
    PG8_STAGE(PG8_SB(1, 0), cB + kstep, voffB); PG8_STAGE(PG8_SA(1, 0), cA + kstep, voffA); PG8_STAGE(PG8_SB(1, 1), cB + hstep + kstep, voffB);
    PG8_WAIT_V(6); PG8_BAR;
    for (;;) {
        const bool has_next = S.next(ui + 1, nxt);
        const char* nA = has_next ? (const char*)g.A + (size_t)nxt.pm * tstep : cA; const char* nB = has_next ? (const char*)g.Bt + (size_t)nxt.pb * tstep : cB;
        for (int t = 0; t < nt; t += 2) {
            const bool last = (t == nt - 2);
            const char* a1 = cA + (size_t)(t + 1) * kstep;
            const char* a2 = last ? nA : cA + (size_t)(t + 2) * kstep; const char* b2 = last ? nB : cB + (size_t)(t + 2) * kstep;
            const char* a3 = a2 + kstep; const char* b3 = b2 + kstep;
            PG8_LDB(B0, 0, 0); PG8_LDB(B1, 0, 1); PG8_SCHED; PG8_LDA(At, 0, 0); PG8_STAGE(PG8_SA(1, 1), a1 + hstep, voffA);
            PG8_WAIT_V(8); PG8_WAIT_L(0); PG8_BAR; PG8_MMA(0, 0, At, B0); PG8_MMA(0, 1, At, B1); PG8_BAR; PG8_SCHED;
            PG8_LDA(At, 0, 1); PG8_STAGE(PG8_SB(0, 0), b2, voffB); PG8_STAGE(PG8_SB(0, 1), b2 + hstep, voffB); PG8_STAGE(PG8_SA(0, 0), a2, voffA);
            PG8_WAIT_V(8); PG8_WAIT_L(0); PG8_BAR; PG8_MMA(1, 0, At, B0); PG8_MMA(1, 1, At, B1); PG8_BAR; PG8_SCHED;
            PG8_LDB(B0, 1, 0); PG8_LDB(B1, 1, 1); PG8_SCHED; PG8_LDA(At, 1, 0); PG8_STAGE(PG8_SA(0, 1), a2 + hstep, voffA);
            PG8_WAIT_V(8); PG8_WAIT_L(0); PG8_BAR; PG8_MMA(0, 0, At, B0); PG8_MMA(0, 1, At, B1); PG8_BAR; PG8_SCHED;
            PG8_LDA(At, 1, 1); PG8_STAGE(PG8_SB(1, 0), b3, voffB); PG8_STAGE(PG8_SB(1, 1), b3 + hstep, voffB); PG8_STAGE(PG8_SA(1, 0), a3, voffA);
            PG8_WAIT_V(8); PG8_WAIT_L(0); PG8_BAR; PG8_MMA(1, 0, At, B0); PG8_MMA(1, 1, At, B1); PG8_BAR; PG8_SCHED;
        }
        if (wr == 0) PG8_BAR;
        E(acc, cur, wr, wc, fr, fq);
        if (!has_next) break;
#pragma unroll
        for (int a = 0; a < 2; ++a)
#pragma unroll
            for (int b = 0; b < 2; ++b)
#pragma unroll
                for (int m = 0; m < 4; ++m)
#pragma unroll
                    for (int n = 0; n < 2; ++n) acc[a][b][m][n] = (f32x4){0.f, 0.f, 0.f, 0.f};
        cur = nxt; cA = nA; cB = nB; ++ui;
        if (wr == 1) PG8_BAR;
    }
    PG8_WAIT_V(0);
    PG8_BAR;
#undef PG8_SA
#undef PG8_SB
#undef PG8_STAGE
#undef PG8_LDA
#undef PG8_LDB
#undef PG8_MMA
#undef PG8_WAIT_V
#undef PG8_WAIT_L
#undef PG8_BAR
#undef PG8_SCHED
}
}

using pg8::bf16_t; using pg8::f32x4; using pg8::u32x4; using pg8::u32x2;
typedef unsigned short u16x8 __attribute__((ext_vector_type(8)));
typedef float f32x2 __attribute__((ext_vector_type(2)));

constexpr int DM = 1024, NB = 2, SEQ = 8192, NTOK = NB * SEQ, CTXL = 256, NCTX = NB * CTXL, NROW = NTOK + NCTX;
constexpr int NE = 16, CAP = 1024, DE = 2048, NSLOT = NE * NB * CAP;
constexpr int NADA = 6 * DM;
constexpr int NTHR = 512;

constexpr size_t MiB = 1u << 20;
constexpr size_t WS_CTL = 0;
constexpr size_t WS_MOD = 1 * MiB;
constexpr size_t WS_LB = WS_MOD + 256 * 1024;
constexpr size_t WS_POSR = WS_LB + 64 * 1024;
constexpr size_t WS_POSC = WS_POSR + 256 * 1024;
constexpr size_t WS_AFF = 2 * MiB;
constexpr size_t WS_TOPI = 3 * MiB;
constexpr size_t WS_TOPG = WS_TOPI + 128 * 1024;
constexpr size_t WS_SLOT = 4 * MiB;
constexpr size_t WS_WHGIN = 6 * MiB;
constexpr size_t WS_WHGOUT = 16 * MiB;
constexpr size_t WS_WSCIN = 18 * MiB;
constexpr size_t WS_WSCOUT = 24 * MiB;
constexpr size_t WS_WMOE1 = 26 * MiB;
constexpr size_t WS_WMOE2 = WS_WMOE1 + 256 * MiB;
constexpr size_t WS_X = WS_WMOE2 + 128 * MiB;
constexpr size_t WS_H = WS_X + 64 * MiB;
constexpr size_t WS_R = WS_H + 34 * MiB;
constexpr size_t WS_Q = WS_R;
constexpr size_t WS_V = WS_Q + 34 * MiB;
constexpr size_t WS_G = WS_V + 34 * MiB;
constexpr size_t WS_LF = WS_G + 34 * MiB;
constexpr size_t WS_LBK = WS_LF + 66 * MiB;
constexpr size_t WS_OF = WS_LBK + 66 * MiB;
constexpr size_t WS_OB = WS_OF + 64 * MiB;
constexpr size_t WS_ON = WS_OB + 64 * MiB;
constexpr size_t WS_HG_END = WS_ON + 32 * MiB;
constexpr size_t WS_XG = WS_R;
constexpr size_t WS_ACT = WS_XG + 64 * MiB;
constexpr size_t WS_Y = WS_ACT + 128 * MiB;
constexpr size_t WS_MOE_END = WS_Y + 128 * MiB;
constexpr size_t WS_BG = WS_R;
constexpr size_t WS_CU = WS_BG + 32 * MiB;
constexpr size_t WS_Z = WS_CU + 32 * MiB;
constexpr size_t WS_END = WS_HG_END > WS_MOE_END ? WS_HG_END : WS_MOE_END;
static_assert(WS_END <= 1024 * MiB, "workspace map exceeds 1 GiB");

constexpr int LDS_BYTES = 135168;

struct Params { const float* in[20]; float* out; unsigned char* ws; int ph_lo, ph_hi; };
enum { I_X = 0, I_C, I_CTX, I_CCTX, I_ADAW, I_ADAB, I_NMIX, I_NFFN, I_NFIN, I_HGWIN, I_HGLB, I_HGNORM, I_HGWOUT, I_SCWIN, I_SCCONV, I_SCWOUT, I_ROUTER, I_WGATE, I_WUP, I_WDOWN };

__device__ __forceinline__ unsigned f2bf(float f) { unsigned u = __builtin_bit_cast(unsigned, f); return (u + 0x7fffu + ((u >> 16) & 1u)) >> 16; }
__device__ __forceinline__ unsigned pk2(float lo, float hi) { return f2bf(lo) | (f2bf(hi) << 16); }
__device__ __forceinline__ float bf2f(unsigned short h) { return __builtin_bit_cast(float, (unsigned)h << 16); }
__device__ __forceinline__ float wave_sum(float v) {
#pragma unroll
    for (int o = 1; o < 64; o <<= 1) v += __shfl_xor(v, o);
    return v;
}
__device__ __forceinline__ float sigmoidf_(float x) { return 1.f / (1.f + expf(-x)); }
__device__ __forceinline__ float siluf_(float x) { return x / (1.f + expf(-x)); }

struct EpiInProj {
    static constexpr bool PERM = false;
    unsigned char* ws;
    __device__ __forceinline__ void operator()(const f32x4 (&acc)[2][2][4][2], const pg8::Unit& u, int wr, int wc, int fr, int fq) const {
        const int sec = u.pn >> 2;
        const int row0 = u.pm * 256 + wr * 64 + fr, cb = (u.pn & 3) * 256 + wc * 32 + 4 * fq;
        if (sec == 0 || sec == 1 || sec == 4) {
            bf16_t* O = (bf16_t*)(ws + (sec == 0 ? WS_Q : (sec == 1 ? WS_V : WS_G)));
#pragma unroll
            for (int ai = 0; ai < 2; ++ai)
#pragma unroll
                for (int m = 0; m < 4; ++m) { bf16_t* rp = O + (size_t)(row0 + ai * 128 + m * 16) * DM + cb;
#pragma unroll
                    for (int bj = 0; bj < 2; ++bj)
#pragma unroll
                        for (int n = 0; n < 2; ++n) { f32x4 v = acc[ai][bj][m][n];
                            if (sec == 0) v = v * 0.08838834764831845f;
                            if (sec == 4) { v[0] = siluf_(v[0]); v[1] = siluf_(v[1]); v[2] = siluf_(v[2]); v[3] = siluf_(v[3]); }
                            u32x2 w; w.x = pk2(v[0], v[1]); w.y = pk2(v[2], v[3]); *(u32x2*)(rp + bj * 128 + n * 16) = w; } }
        } else {
            float* O = (float*)(ws + (sec == 2 ? WS_LF : WS_LBK)); const float* lb0 = (const float*)(ws + WS_LB);
            f32x4 lbv[2][2];
#pragma unroll
            for (int bj = 0; bj < 2; ++bj)
#pragma unroll
                for (int n = 0; n < 2; ++n) lbv[bj][n] = *(const f32x4*)(lb0 + cb + bj * 128 + n * 16);
#pragma unroll
            for (int ai = 0; ai < 2; ++ai)
#pragma unroll
                for (int m = 0; m < 4; ++m) { float* rp = O + (size_t)(row0 + ai * 128 + m * 16) * DM + cb;
#pragma unroll
                    for (int bj = 0; bj < 2; ++bj)
#pragma unroll
                        for (int n = 0; n < 2; ++n) { const f32x4 z = acc[ai][bj][m][n], lb = lbv[bj][n]; f32x4 o;
#pragma unroll
                            for (int i = 0; i < 4; ++i) o[i] = logf(lb[i] + (1.f - lb[i]) * sigmoidf_(z[i]));
                            *(f32x4*)(rp + bj * 128 + n * 16) = o; } }
        }
    }
};
struct EpiResid {
    static constexpr bool PERM = false;
    float* X; const float* gate;
    __device__ __forceinline__ void operator()(const f32x4 (&acc)[2][2][4][2], const pg8::Unit& u, int wr, int wc, int fr, int fq) const {
        const int row0 = u.pm * 256 + wr * 64 + fr, cb = u.pn * 256 + wc * 32 + 4 * fq;
        const float* gp = gate + (size_t)((u.pm * 256) / SEQ) * NADA + cb;
        f32x4 gv[2][2];
#pragma unroll
        for (int bj = 0; bj < 2; ++bj)
#pragma unroll
            for (int n = 0; n < 2; ++n) gv[bj][n] = *(const f32x4*)(gp + bj * 128 + n * 16);
#pragma unroll
        for (int ai = 0; ai < 2; ++ai)
#pragma unroll
            for (int m = 0; m < 4; ++m) { float* rp = X + (size_t)(row0 + ai * 128 + m * 16) * DM + cb;
#pragma unroll
                for (int bj = 0; bj < 2; ++bj)
#pragma unroll
                    for (int n = 0; n < 2; ++n) { f32x4* q = (f32x4*)(rp + bj * 128 + n * 16); *q = *q + gv[bj][n] * acc[ai][bj][m][n]; } }
    }
};
struct EpiGLU {
    static constexpr bool PERM = true;
    bf16_t* ACT;
    __device__ __forceinline__ void operator()(const f32x4 (&acc)[2][2][4][2], const pg8::Unit& u, int wr, int wc, int fr, int fq) const {
        const int row0 = u.pm * 256 + wr * 64 + fr, cb = u.pn * 128 + wc * 32 + 8 * fq;
#pragma unroll
        for (int ai = 0; ai < 2; ++ai)
#pragma unroll
            for (int m = 0; m < 4; ++m) { bf16_t* rp = ACT + (size_t)(row0 + ai * 128 + m * 16) * DE + cb;
                f32x4 o[2];
#pragma unroll
                for (int n = 0; n < 2; ++n) { const f32x4 a = acc[ai][0][m][n], w = acc[ai][1][m][n];
#pragma unroll
                    for (int i = 0; i < 4; ++i) o[n][i] = siluf_(a[i]) * w[i]; }
                u32x4 w; w.x = pk2(o[0][0], o[0][1]); w.y = pk2(o[0][2], o[0][3]); w.z = pk2(o[1][0], o[1][1]); w.w = pk2(o[1][2], o[1][3]);
                *(u32x4*)rp = w; }
    }
};
struct EpiRowScale {
    static constexpr bool PERM = false;
    float* Y; const float* rg;
    __device__ __forceinline__ void operator()(const f32x4 (&acc)[2][2][4][2], const pg8::Unit& u, int wr, int wc, int fr, int fq) const {
        const int row0 = u.pm * 256 + wr * 64 + fr, cb = u.pn * 256 + wc * 32 + 4 * fq;
#pragma unroll
        for (int ai = 0; ai < 2; ++ai)
#pragma unroll
            for (int m = 0; m < 4; ++m) { const int row = row0 + ai * 128 + m * 16; const float gsc = rg[row]; float* rp = Y + (size_t)row * DM + cb;
#pragma unroll
                for (int bj = 0; bj < 2; ++bj)
#pragma unroll
                    for (int n = 0; n < 2; ++n) *(f32x4*)(rp + bj * 128 + n * 16) = acc[ai][bj][m][n] * gsc; }
    }
};
struct EpiConvIn {
    static constexpr bool PERM = true;
    bf16_t *BG, *CU;
    __device__ __forceinline__ void operator()(const f32x4 (&acc)[2][2][4][2], const pg8::Unit& u, int wr, int wc, int fr, int fq) const {
        const int row0 = u.pm * 256 + wr * 64 + fr;
        if (u.pn < 4) {
            const int cb = u.pn * 256 + wc * 32 + 8 * fq;
#pragma unroll
            for (int ai = 0; ai < 2; ++ai)
#pragma unroll
                for (int m = 0; m < 4; ++m) { bf16_t* rp = BG + (size_t)(row0 + ai * 128 + m * 16) * DM + cb;
#pragma unroll
                    for (int bj = 0; bj < 2; ++bj) { const f32x4 v0 = acc[ai][bj][m][0], v1 = acc[ai][bj][m][1];
                        u32x4 w; w.x = pk2(v0[0], v0[1]); w.y = pk2(v0[2], v0[3]); w.z = pk2(v1[0], v1[1]); w.w = pk2(v1[2], v1[3]);
                        *(u32x4*)(rp + bj * 128) = w; } }
        } else {
            const int cb = (u.pn - 4) * 128 + wc * 32 + 8 * fq;
#pragma unroll
            for (int ai = 0; ai < 2; ++ai)
#pragma unroll
                for (int m = 0; m < 4; ++m) { bf16_t* rp = CU + (size_t)(row0 + ai * 128 + m * 16) * DM + cb;
                    const f32x4 v0 = acc[ai][0][m][0] * acc[ai][1][m][0], v1 = acc[ai][0][m][1] * acc[ai][1][m][1];
                    u32x4 w; w.x = pk2(v0[0], v0[1]); w.y = pk2(v0[2], v0[3]); w.z = pk2(v1[0], v1[1]); w.w = pk2(v1[2], v1[3]);
                    *(u32x4*)rp = w; }
        }
    }
};

__device__ __forceinline__ void ph_prep(const Params& p, unsigned char* lds, int bid, int nblk) {
    float* sv = (float*)lds;
    float* red = sv + 3 * 1024;
    int tid_ = threadIdx.x; asm volatile("" : "+v"(tid_)); const int tid = tid_;
    const float* c = p.in[I_C]; const float* cctx = p.in[I_CCTX];
    for (int i = tid; i < 3 * 1024; i += NTHR) { const float v = (i < 2048) ? c[i] : cctx[i - 2048]; sv[i] = siluf_(v); }
    __syncthreads();
    const float* ada_w = p.in[I_ADAW]; const float* ada_b = p.in[I_ADAB];
    float* mod = (float*)(p.ws + WS_MOD);
    for (int it = bid; it < 96; it += nblk) {
        const int l = it / 48, j0 = (it % 48) * 128, col = tid & 127, ks = tid >> 7;
        const float* W = ada_w + (size_t)l * DM * NADA + j0 + col;
        float a0 = 0.f, a1 = 0.f, a2 = 0.f;
#pragma unroll 8
        for (int k = ks * 256; k < ks * 256 + 256; ++k) { const float w = W[(size_t)k * NADA]; a0 += sv[k] * w; a1 += sv[1024 + k] * w; a2 += sv[2048 + k] * w; }
        red[(ks * 3 + 0) * 128 + col] = a0; red[(ks * 3 + 1) * 128 + col] = a1; red[(ks * 3 + 2) * 128 + col] = a2;
        __syncthreads();
        if (tid < 384) { const int v = tid >> 7, cc = tid & 127;
            const float s = (red[(0 * 3 + v) * 128 + cc] + red[(1 * 3 + v) * 128 + cc]) + (red[(2 * 3 + v) * 128 + cc] + red[(3 * 3 + v) * 128 + cc]) + ada_b[l * NADA + j0 + cc];
            mod[(size_t)(l * 3 + v) * NADA + j0 + cc] = s; }
        __syncthreads();
    }
    const int gt = bid * NTHR + tid, NT = nblk * NTHR;
    const float* lg = p.in[I_HGLB]; float* lb0 = (float*)(p.ws + WS_LB);
    for (int d = gt; d < DM; d += NT) { const float l0 = lg[d], l1 = lg[DM + d], l2 = lg[2 * DM + d]; const float mx = fmaxf(l0, fmaxf(l1, l2));
        const float e0 = expf(l0 - mx), e1 = expf(l1 - mx), e2 = expf(l2 - mx); lb0[d] = e0 / (e0 + e1 + e2); }
    float* posr = (float*)(p.ws + WS_POSR);
    for (int i = gt; i < (128 + 64) * 512; i += NT) { const int pi = i >> 9, dd = i & 511; const int pos = pi < 128 ? pi : pi - 128; const int fi = dd & 255;
        const float om = exp2f(-(float)fi * (13.287712379549449f / 256.0f)); const float a = (float)pos * om; posr[i] = dd < 256 ? sinf(a) : cosf(a); }
}

__device__ __forceinline__ void transpose_item(const float* W, int N, bf16_t* WT, int K, float* scr, int k0, int n0, size_t drow0, int lane) {
#pragma unroll 8
    for (int i = 0; i < 32; ++i) { const int kk = 2 * i + (lane >> 5); scr[kk * 33 + (lane & 31)] = W[(size_t)(k0 + kk) * N + n0 + (lane & 31)]; }
    __builtin_amdgcn_s_waitcnt(0xc07f); asm volatile("" ::: "memory");
    const int c = lane & 7;
#pragma unroll
    for (int j = 0; j < 4; ++j) { const int n = (lane >> 3) + 8 * j; const float* s = scr + (8 * c) * 33 + n;
        u32x4 o; o.x = pk2(s[0 * 33], s[1 * 33]); o.y = pk2(s[2 * 33], s[3 * 33]); o.z = pk2(s[4 * 33], s[5 * 33]); o.w = pk2(s[6 * 33], s[7 * 33]);
        *(u32x4*)(WT + (drow0 + n) * K + k0 + 8 * c) = o; }
    __builtin_amdgcn_s_waitcnt(0xc07f); asm volatile("" ::: "memory");
}
__device__ __forceinline__ void ph_convert(const Params& p, unsigned char* lds, int bid, int nblk) {
    int tid_ = threadIdx.x; asm volatile("" : "+v"(tid_));
    const int tid = tid_, lane = tid & 63, wave = tid >> 6;
    float* scr = (float*)lds + wave * (64 * 33);
    const int gw = bid * 8 + wave, NGW = nblk * 8;
    constexpr int I_A = 16 * 160, I_B = 16 * 32, I_C_ = 16 * 96, I_D = 16 * 32, I_E = 32 * 1024, I_F = 32 * 1024, I_G = 32 * 1024;
    constexpr int NITEMS = I_A + I_B + I_C_ + I_D + I_E + I_F + I_G;
    for (int it = gw; it < NITEMS; it += NGW) {
        int r = it;
        if (r < I_A) { const int kb = r / 160, nb = r % 160; transpose_item(p.in[I_HGWIN], 5120, (bf16_t*)(p.ws + WS_WHGIN), 1024, scr, kb * 64, nb * 32, (size_t)nb * 32, lane); continue; } r -= I_A;
        if (r < I_B) { const int kb = r / 32, nb = r % 32; transpose_item(p.in[I_HGWOUT], 1024, (bf16_t*)(p.ws + WS_WHGOUT), 1024, scr, kb * 64, nb * 32, (size_t)nb * 32, lane); continue; } r -= I_B;
        if (r < I_C_) { const int kb = r / 96, nb = r % 96, n0 = nb * 32; size_t dr;
            if (n0 < 1024) dr = n0; else { const int np = n0 - 1024, sec = np >> 10, nn = np & 1023; dr = 1024 + (nn >> 7) * 256 + sec * 128 + (nn & 127); }
            transpose_item(p.in[I_SCWIN], 3072, (bf16_t*)(p.ws + WS_WSCIN), 1024, scr, kb * 64, n0, dr, lane); continue; } r -= I_C_;
        if (r < I_D) { const int kb = r / 32, nb = r % 32; transpose_item(p.in[I_SCWOUT], 1024, (bf16_t*)(p.ws + WS_WSCOUT), 1024, scr, kb * 64, nb * 32, (size_t)nb * 32, lane); continue; } r -= I_D;
        if (r < I_E + I_F) { const int up = r >= I_E; if (up) r -= I_E; const int le = r >> 10, q = r & 1023, kb = q >> 6, nb = q & 63, n0 = nb * 32;
            const size_t dr = (size_t)le * 4096 + (n0 >> 7) * 256 + up * 128 + (n0 & 127);
            transpose_item(p.in[up ? I_WUP : I_WGATE] + (size_t)le * 1024 * 2048, 2048, (bf16_t*)(p.ws + WS_WMOE1), 1024, scr, kb * 64, n0, dr, lane); continue; } r -= I_E + I_F;
        { const int le = r >> 10, q = r & 1023, kb = q >> 5, nb = q & 31, n0 = nb * 32;
            transpose_item(p.in[I_WDOWN] + (size_t)le * 2048 * 1024, 1024, (bf16_t*)(p.ws + WS_WMOE2), 2048, scr, kb * 64, n0, (size_t)le * 1024 + n0, lane); }
    }
}

__device__ __forceinline__ void store_mod_bf16(bf16_t* hrow, const f32x4 (&v)[4], float rstd, const float* g, const float* sh, const float* sc, int lane) {
#pragma unroll
    for (int j = 0; j < 4; ++j) { const int c0 = 256 * j + 4 * lane; const f32x4 gv = *(const f32x4*)(g + c0), shv = *(const f32x4*)(sh + c0), scv = *(const f32x4*)(sc + c0);
        f32x4 h;
#pragma unroll
        for (int i = 0; i < 4; ++i) h[i] = (v[j][i] * rstd * gv[i]) * (1.f + scv[i]) + shv[i];
        u32x2 w; w.x = pk2(h[0], h[1]); w.y = pk2(h[2], h[3]); *(u32x2*)(hrow + c0) = w; }
}
__device__ __forceinline__ void ph_mod0(const Params& p, int bid, int nblk) {
    int tid_ = threadIdx.x; asm volatile("" : "+v"(tid_));
    const int tid = tid_, lane = tid & 63, wave = tid >> 6, gw = bid * 8 + wave, NGW = nblk * 8;
    const float* x = p.in[I_X]; const float* ctx = p.in[I_CTX]; const float* g = p.in[I_NMIX];
    const float* mod = (const float*)(p.ws + WS_MOD); const float* posr = (const float*)(p.ws + WS_POSR); const float* posc = (const float*)(p.ws + WS_POSC);
    float* X = (float*)(p.ws + WS_X); bf16_t* H = (bf16_t*)(p.ws + WS_H);
    for (int row = gw; row < NROW; row += NGW) {
        f32x4 v[4]; float ss = 0.f; int vec;
        if (row < NTOK) { const int t = row & (SEQ - 1); vec = row >> 13; const float* pr = posr + (size_t)(t >> 6) * 512; const float* pc = posc + (size_t)(t & 63) * 512;
#pragma unroll
            for (int j = 0; j < 4; ++j) { const int c0 = 256 * j + 4 * lane; const f32x4 pv = *(const f32x4*)((j < 2 ? pr : pc) + (c0 & 511));
                v[j] = *(const f32x4*)(x + (size_t)row * DM + c0) + pv; *(f32x4*)(X + (size_t)row * DM + c0) = v[j]; }
        } else { vec = 2;
#pragma unroll
            for (int j = 0; j < 4; ++j) v[j] = *(const f32x4*)(ctx + (size_t)(row - NTOK) * DM + 256 * j + 4 * lane); }
#pragma unroll
        for (int j = 0; j < 4; ++j) ss += (v[j][0] * v[j][0] + v[j][1] * v[j][1]) + (v[j][2] * v[j][2] + v[j][3] * v[j][3]);
        const float rstd = 1.f / sqrtf(wave_sum(ss) * (1.f / DM) + 1e-6f);
        const float* mv = mod + (size_t)(0 * 3 + vec) * NADA;
        store_mod_bf16(H + (size_t)row * DM, v, rstd, g, mv, mv + DM, lane);
    }
}

__device__ __forceinline__ void ph_gla_simple(const Params& p, unsigned char* lds, int bid, int nblk) {
    float* qs = (float*)lds; float* fs = qs + 4096; float* ks = fs + 4096; float* vs = ks + 4096; float* part = vs + 1024;
    int tid_ = threadIdx.x; asm volatile("" : "+v"(tid_));
    const int tid = tid_, lane = tid & 63, wave = tid >> 6, kk = tid >> 5, vv = tid & 31;
    const bf16_t* Q = (const bf16_t*)(p.ws + WS_Q); const bf16_t* V = (const bf16_t*)(p.ws + WS_V);
    for (int unit = bid; unit < 128; unit += nblk) {
        const int vsl = unit & 3, dir = (unit >> 2) & 1, h = (unit >> 3) & 7, b = unit >> 6;
        const float* LFp = (const float*)(p.ws + (dir ? WS_LBK : WS_LF)); float* O = (float*)(p.ws + (dir ? WS_OB : WS_OF));
        float s[8];
#pragma unroll
        for (int i = 0; i < 8; ++i) s[i] = 0.f;
        for (int bt = 0; bt < 8 + 256; ++bt) {
            const bool isctx = bt < 8; const int nb = isctx ? bt : bt - 8, nbt = isctx ? 8 : 256;
            const int t0 = dir == 0 ? nb * 32 : (nbt - 1 - nb) * 32;
            const size_t rbase = isctx ? (size_t)(NTOK + b * CTXL + t0) : (size_t)(b * SEQ + t0);
            { const int r = tid >> 4, c8 = (tid & 15) * 8; const size_t off = (rbase + r) * DM + h * 128 + c8;
                const u16x8 qv = *(const u16x8*)(Q + off); const f32x4 l0 = *(const f32x4*)(LFp + off), l1 = *(const f32x4*)(LFp + off + 4);
#pragma unroll
                for (int i = 0; i < 8; ++i) { qs[r * 128 + c8 + i] = bf2f(qv[i]); const float f = expf(i < 4 ? l0[i] : l1[i - 4]); fs[r * 128 + c8 + i] = f; ks[r * 128 + c8 + i] = 1.f - f; }
                if (tid < 128) { const int r2 = tid >> 2, c = (tid & 3) * 8; const u16x8 vv8 = *(const u16x8*)(V + (rbase + r2) * DM + h * 128 + vsl * 32 + c);
#pragma unroll
                    for (int i = 0; i < 8; ++i) vs[r2 * 32 + c + i] = bf2f(vv8[i]); } }
            __syncthreads();
            for (int jj = 0; jj < 32; ++jj) { const int j = dir ? 31 - jj : jj; const float vj = vs[j * 32 + vv]; float po = 0.f;
#pragma unroll
                for (int i = 0; i < 8; ++i) { const float f = fs[j * 128 + kk * 8 + i], k_ = ks[j * 128 + kk * 8 + i], q_ = qs[j * 128 + kk * 8 + i]; s[i] = f * s[i] + k_ * vj; po += q_ * s[i]; }
                po += __shfl_xor(po, 32);
                if (!isctx && lane < 32) part[(j * 8 + wave) * 32 + vv] = po; }
            __syncthreads();
            if (!isctx) { const int j = tid >> 4, v2 = (tid & 15) * 2; float o0 = 0.f, o1 = 0.f;
#pragma unroll
                for (int w = 0; w < 8; ++w) { o0 += part[(j * 8 + w) * 32 + v2]; o1 += part[(j * 8 + w) * 32 + v2 + 1]; }
                *(f32x2*)(O + (rbase + j) * DM + h * 128 + vsl * 32 + v2) = (f32x2){o0, o1}; }
        }
        __syncthreads();
    }
}

__device__ __forceinline__ void ph_onorm(const Params& p, int bid, int nblk) {
    int tid_ = threadIdx.x; asm volatile("" : "+v"(tid_));
    const int tid = tid_, lane = tid & 63, wave = tid >> 6, gw = bid * 8 + wave, NGW = nblk * 8;
    const float* OF = (const float*)(p.ws + WS_OF); const float* OB = (const float*)(p.ws + WS_OB); const bf16_t* G = (const bf16_t*)(p.ws + WS_G); bf16_t* ON = (bf16_t*)(p.ws + WS_ON);
    const float* ng = p.in[I_HGNORM];
    const f32x4 gv = *(const f32x4*)(ng + 4 * (lane & 31));
    for (int row = gw; row < NTOK; row += NGW) {
#pragma unroll
        for (int j = 0; j < 4; ++j) { const size_t off = (size_t)row * DM + 256 * j + 4 * lane; const f32x4 o = *(const f32x4*)(OF + off) + *(const f32x4*)(OB + off);
            float ss = (o[0] * o[0] + o[1] * o[1]) + (o[2] * o[2] + o[3] * o[3]);
#pragma unroll
            for (int d = 1; d < 32; d <<= 1) ss += __shfl_xor(ss, d);
            const float rstd = 1.f / sqrtf(ss * (1.f / 128.f) + 1e-6f);
            const u32x2 gg = *(const u32x2*)(G + off);
            const float g0 = bf2f((unsigned short)(gg.x & 0xffffu)), g1 = bf2f((unsigned short)(gg.x >> 16)), g2 = bf2f((unsigned short)(gg.y & 0xffffu)), g3 = bf2f((unsigned short)(gg.y >> 16));
            u32x2 w; w.x = pk2(o[0] * rstd * gv[0] * g0, o[1] * rstd * gv[1] * g1); w.y = pk2(o[2] * rstd * gv[2] * g2, o[3] * rstd * gv[3] * g3);
            *(u32x2*)(ON + off) = w; }
    }
}

__device__ __forceinline__ void ph_modffn(const Params& p, unsigned char* lds, int bid, int nblk, int l) {
    int tid_ = threadIdx.x; asm volatile("" : "+v"(tid_));
    const int tid = tid_, lane = tid & 63, wave = tid >> 6, gw = bid * 8 + wave, NGW = nblk * 8;
    float* rw = (float*)lds;
    const float* router = p.in[I_ROUTER] + (size_t)l * DM * NE;
    for (int i = tid; i < DM * NE / 4; i += NTHR) ((f32x4*)rw)[i] = ((const f32x4*)router)[i];
    __syncthreads();
    const float* X = (const float*)(p.ws + WS_X); bf16_t* H = (bf16_t*)(p.ws + WS_H); float* aff = (float*)(p.ws + WS_AFF); int* slot = (int*)(p.ws + WS_SLOT);
    const float* g = p.in[I_NFFN] + (size_t)l * DM; const float* mod = (const float*)(p.ws + WS_MOD);
    for (int row = gw; row < NTOK; row += NGW) {
        const int b = row >> 13, t = row & (SEQ - 1);
        const float* mv = mod + (size_t)(l * 3 + b) * NADA; const float* sh = mv + 3 * DM; const float* sc = mv + 4 * DM;
        f32x4 v[4]; float ss = 0.f;
#pragma unroll
        for (int j = 0; j < 4; ++j) { v[j] = *(const f32x4*)(X + (size_t)row * DM + 256 * j + 4 * lane); ss += (v[j][0] * v[j][0] + v[j][1] * v[j][1]) + (v[j][2] * v[j][2] + v[j][3] * v[j][3]); }
        const float rstd = 1.f / sqrtf(wave_sum(ss) * (1.f / DM) + 1e-6f);
        float lg[16];
#pragma unroll
        for (int e = 0; e < 16; ++e) lg[e] = 0.f;
#pragma unroll
        for (int j = 0; j < 4; ++j) { const int c0 = 256 * j + 4 * lane; const f32x4 gv = *(const f32x4*)(g + c0), shv = *(const f32x4*)(sh + c0), scv = *(const f32x4*)(sc + c0);
            f32x4 h;
#pragma unroll
            for (int i = 0; i < 4; ++i) { h[i] = (v[j][i] * rstd * gv[i]) * (1.f + scv[i]) + shv[i];
                const f32x4 r0 = *(const f32x4*)(rw + (c0 + i) * 16), r1 = *(const f32x4*)(rw + (c0 + i) * 16 + 4), r2 = *(const f32x4*)(rw + (c0 + i) * 16 + 8), r3 = *(const f32x4*)(rw + (c0 + i) * 16 + 12);
#pragma unroll
                for (int e = 0; e < 4; ++e) { lg[e] += h[i] * r0[e]; lg[4 + e] += h[i] * r1[e]; lg[8 + e] += h[i] * r2[e]; lg[12 + e] += h[i] * r3[e]; }
                asm volatile("" ::: "memory"); }
            u32x2 w; w.x = pk2(h[0], h[1]); w.y = pk2(h[2], h[3]); *(u32x2*)(H + (size_t)row * DM + c0) = w; }
        float mx = -3.0e38f;
#pragma unroll
        for (int e = 0; e < 16; ++e) { lg[e] = wave_sum(lg[e]); mx = fmaxf(mx, lg[e]); }
        float den = 0.f;
#pragma unroll
        for (int e = 0; e < 16; ++e) { lg[e] = expf(lg[e] - mx); den += lg[e]; }
        const float inv = 1.f / den;
        float mine = 0.f;
#pragma unroll
        for (int e = 0; e < 16; ++e) mine = (lane == e) ? lg[e] * inv : mine;
        if (lane < 16) { aff[(size_t)(b * NE + lane) * SEQ + t] = mine; slot[(size_t)row * NE + lane] = -1; }
    }
}

__device__ __forceinline__ void ph_topk(const Params& p, unsigned char* lds, int bid, int nblk) {
    unsigned long long* a = (unsigned long long*)lds;
    int tid_ = threadIdx.x; asm volatile("" : "+v"(tid_)); const int tid = tid_;
    const float* aff = (const float*)(p.ws + WS_AFF); int* topi = (int*)(p.ws + WS_TOPI); float* topg = (float*)(p.ws + WS_TOPG); int* slot = (int*)(p.ws + WS_SLOT);
    for (int it = bid; it < NB * NE; it += nblk) {
        const int b = it >> 4, e = it & 15; const float* src = aff + (size_t)it * SEQ;
        for (int i = tid; i < SEQ; i += NTHR) a[i] = ((unsigned long long)__float_as_uint(src[i]) << 32) | (unsigned long long)(0xFFFFFFFFu - (unsigned)i);
        __syncthreads();
        for (int k = 2; k <= SEQ; k <<= 1)
            for (int j = k >> 1; j > 0; j >>= 1) {
                for (int t = tid; t < SEQ / 2; t += NTHR) { const int i = ((t & ~(j - 1)) << 1) | (t & (j - 1)), ixj = i | j; const bool desc = (i & k) == 0;
                    const unsigned long long x = a[i], y = a[ixj]; if ((x < y) == desc) { a[i] = y; a[ixj] = x; } }
                __syncthreads();
            }
        for (int s = tid; s < CAP; s += NTHR) { const unsigned long long x = a[s]; const int idx = (int)(0xFFFFFFFFu - (unsigned)(x & 0xFFFFFFFFull)); const float gt = __uint_as_float((unsigned)(x >> 32));
            const int r = (e * NB + b) * CAP + s; topi[r] = b * SEQ + idx; topg[r] = gt; slot[(size_t)(b * SEQ + idx) * NE + e] = s; }
        __syncthreads();
    }
}

__device__ __forceinline__ void ph_gather(const Params& p, int bid, int nblk) {
    int tid_ = threadIdx.x; asm volatile("" : "+v"(tid_));
    const int tid = tid_, lane = tid & 63, wave = tid >> 6, gw = bid * 8 + wave, NGW = nblk * 8;
    const bf16_t* H = (const bf16_t*)(p.ws + WS_H); bf16_t* XG = (bf16_t*)(p.ws + WS_XG); const int* topi = (const int*)(p.ws + WS_TOPI);
    for (int r = gw; r < NSLOT; r += NGW) { const int src = topi[r];
        const u32x4* s = (const u32x4*)(H + (size_t)src * DM); u32x4* d = (u32x4*)(XG + (size_t)r * DM);
        d[lane] = s[lane]; d[64 + lane] = s[64 + lane]; }
}

__device__ __forceinline__ void ph_combine(const Params& p, int bid, int nblk, int l, bool final_) {
    int tid_ = threadIdx.x; asm volatile("" : "+v"(tid_));
    const int tid = tid_, lane = tid & 63, wave = tid >> 6, gw = bid * 8 + wave, NGW = nblk * 8;
    float* X = (float*)(p.ws + WS_X); bf16_t* H = (bf16_t*)(p.ws + WS_H); const float* Y = (const float*)(p.ws + WS_Y); const int* slot = (const int*)(p.ws + WS_SLOT);
    const float* mod = (const float*)(p.ws + WS_MOD);
    for (int row = gw; row < NTOK; row += NGW) {
        const int b = row >> 13;
        const float* g2 = mod + (size_t)(l * 3 + b) * NADA + 5 * DM;
        f32x4 a[4];
#pragma unroll
        for (int j = 0; j < 4; ++j) a[j] = (f32x4){0.f, 0.f, 0.f, 0.f};
        const int myslot = lane < 16 ? slot[(size_t)row * NE + lane] : -1;
        for (int e = 0; e < NE; ++e) { const int s = __shfl(myslot, e);
            if (s >= 0) { const float* yr = Y + (size_t)((e * NB + b) * CAP + s) * DM;
#pragma unroll
                for (int j = 0; j < 4; ++j) a[j] = a[j] + *(const f32x4*)(yr + 256 * j + 4 * lane); } }
        f32x4 v[4]; float ss = 0.f;
#pragma unroll
        for (int j = 0; j < 4; ++j) { const int c0 = 256 * j + 4 * lane; v[j] = *(const f32x4*)(X + (size_t)row * DM + c0) + *(const f32x4*)(g2 + c0) * a[j];
            ss += (v[j][0] * v[j][0] + v[j][1] * v[j][1]) + (v[j][2] * v[j][2] + v[j][3] * v[j][3]); }
        const float rstd = 1.f / sqrtf(wave_sum(ss) * (1.f / DM) + 1e-6f);
        if (final_) { const float* gf = p.in[I_NFIN];
#pragma unroll
            for (int j = 0; j < 4; ++j) { const int c0 = 256 * j + 4 * lane; const f32x4 gv = *(const f32x4*)(gf + c0); *(f32x4*)(p.out + (size_t)row * DM + c0) = v[j] * rstd * gv; }
        } else {
#pragma unroll
            for (int j = 0; j < 4; ++j) *(f32x4*)(X + (size_t)row * DM + 256 * j + 4 * lane) = v[j];
            const float* mv = mod + (size_t)((l + 1) * 3 + b) * NADA;
            store_mod_bf16(H + (size_t)row * DM, v, rstd, p.in[I_NMIX] + (size_t)(l + 1) * DM, mv, mv + DM, lane);
        }
    }
}

__device__ __forceinline__ void ph_conv(const Params& p, int bid, int nblk) {
    int tid_ = threadIdx.x; asm volatile("" : "+v"(tid_));
    const int tid = tid_, lane = tid & 63, wave = tid >> 6, gw = bid * 8 + wave, NGW = nblk * 8;
    const bf16_t* BG = (const bf16_t*)(p.ws + WS_BG); const bf16_t* CU = (const bf16_t*)(p.ws + WS_CU); bf16_t* Z = (bf16_t*)(p.ws + WS_Z);
    const float* wc = p.in[I_SCCONV];
    for (int row = gw; row < NTOK; row += NGW) { const int t = row & (SEQ - 1);
#pragma unroll
        for (int hh = 0; hh < 2; ++hh) { const int c0 = hh * 512 + 8 * lane; const size_t off = (size_t)row * DM + c0;
            const u16x8 z0 = {0, 0, 0, 0, 0, 0, 0, 0};
            const u16x8 um = t > 0 ? *(const u16x8*)(CU + off - DM) : z0, u0 = *(const u16x8*)(CU + off), up = t < SEQ - 1 ? *(const u16x8*)(CU + off + DM) : z0, bg = *(const u16x8*)(BG + off);
            float o[8];
#pragma unroll
            for (int i = 0; i < 8; ++i) o[i] = bf2f(bg[i]) * (wc[c0 + i] * bf2f(um[i]) + wc[DM + c0 + i] * bf2f(u0[i]) + wc[2 * DM + c0 + i] * bf2f(up[i]));
            u32x4 w; w.x = pk2(o[0], o[1]); w.y = pk2(o[2], o[3]); w.z = pk2(o[4], o[5]); w.w = pk2(o[6], o[7]); *(u32x4*)(Z + off) = w; }
    }
}

#define LAS __attribute__((address_space(3)))
#define XB_TMO      128
#define XB_XCNT(j)  (256  + 64 * (j))
#define XB_XSUB(j)  (1280 + 64 * (j))
#define XB_XGEN(j)  (2304 + 64 * (j))
#define XB_TOP      3328
#define XB_TOPGEN   3392
#define XCD_BAR_WORDS 3456
#define XB_SPIN_CAP (1u << 18)
__device__ __forceinline__ unsigned xb_ld(unsigned* p)              { return __hip_atomic_load(p, __ATOMIC_RELAXED, __HIP_MEMORY_SCOPE_AGENT); }
__device__ __forceinline__ unsigned xb_add(unsigned* p, unsigned v) { return __hip_atomic_fetch_add(p, v, __ATOMIC_RELAXED, __HIP_MEMORY_SCOPE_AGENT); }
__device__ __forceinline__ unsigned xb_xcc_id() { return (unsigned)__builtin_amdgcn_s_getreg((3 << 11) | 20) & 0xFu; }
#define XB_SPIN(cond, bar) do { unsigned _sp = 0; while (cond) { __builtin_amdgcn_s_sleep(1); \
    if ((++_sp & 255u) == 0u) { if (xb_ld(&(bar)[XB_TMO])) break; if (_sp > XB_SPIN_CAP) { atomicAdd(&(bar)[XB_TMO], 1u); break; } } } } while (0)
struct XcdBarrier { unsigned* bar; unsigned x; volatile LAS unsigned* st; };
__device__ __forceinline__ XcdBarrier xcd_barrier_post(unsigned* bar, volatile LAS unsigned* st) {
    XcdBarrier b; b.bar = bar; b.x = xb_xcc_id(); b.st = st;
    if (threadIdx.x == 0) (void)xb_add(&bar[XB_XCNT(b.x)], 1u);
    return b;
}
__device__ __forceinline__ void xcd_barrier_complete(unsigned* bar, unsigned x, unsigned& nloc, unsigned& nx) {
    const unsigned G = gridDim.x * gridDim.y * gridDim.z;
    unsigned sum, cnt, mine, sp = 0u;
    for (;;) {
        sum = 0u; cnt = 0u; mine = 0u;
#pragma unroll
        for (unsigned j = 0; j < 16; ++j) { const unsigned c = xb_ld(&bar[XB_XCNT(j)]); sum += c; cnt += (c > 0u) ? 1u : 0u; mine = (j == x) ? c : mine; }
        if (sum == G) break;
        __builtin_amdgcn_s_sleep(1);
        if ((++sp & 255u) == 0u) { if (xb_ld(&bar[XB_TMO])) break; if (sp > XB_SPIN_CAP) { atomicAdd(&bar[XB_TMO], 1u); break; } }
    }
    nloc = mine > 0u ? mine : 1u; nx = cnt > 0u ? cnt : 1u;
}
__device__ __forceinline__ void xcd_barrier(unsigned* bar_, volatile LAS unsigned* st_) {
    XcdBarrier b; b.bar = bar_; b.x = xb_xcc_id(); b.st = st_;
    asm volatile("s_waitcnt vmcnt(0)" ::: "memory");
    __syncthreads();
    if (threadIdx.x == 0) {
        unsigned* bar = b.bar;
        __builtin_amdgcn_s_waitcnt(0);
        unsigned nloc = b.st[0], nx = b.st[1];
        if (nloc == 0u) { xcd_barrier_complete(bar, b.x, nloc, nx); b.st[0] = nloc; b.st[1] = nx; }
        const unsigned old = xb_add(&bar[XB_XSUB(b.x)], 1u);
        const unsigned gen = old / nloc;
        if (old + 1u == (gen + 1u) * nloc) {
            __builtin_amdgcn_fence(__ATOMIC_RELEASE, "agent");
            asm volatile("s_waitcnt vmcnt(0)" ::: "memory");
            const unsigned og = xb_add(&bar[XB_TOP], 1u);
            const unsigned tg = og / nx;
            if (og + 1u == (tg + 1u) * nx) xb_add(&bar[XB_TOPGEN], 1u);
            else XB_SPIN(xb_ld(&bar[XB_TOPGEN]) == tg, bar);
            __builtin_amdgcn_fence(__ATOMIC_ACQUIRE, "agent");
            xb_add(&bar[XB_XGEN(b.x)], 1u);
            asm volatile("s_waitcnt vmcnt(0)" ::: "memory");
        } else {
            XB_SPIN(xb_ld(&bar[XB_XGEN(b.x)]) == gen, bar);
            __builtin_amdgcn_fence(__ATOMIC_ACQUIRE, "agent");
            asm volatile("s_waitcnt vmcnt(0)" ::: "memory");
        }
    }
    __syncthreads();
}

constexpr int NPHASE = 22;
constexpr int MISC_OFF = 131072 + 320;
constexpr int CW_BAR = 4096;
template <int LO, int HI> __global__ void __launch_bounds__(NTHR, 2) mega(Params p) {
    extern __shared__ __attribute__((aligned(16))) unsigned char lds[];
    const int bid = blockIdx.x, nblk = gridDim.x;
    PG8_LAS unsigned char* l3 = (PG8_LAS unsigned char*)lds;
    unsigned char* ws = p.ws;
    const float* mod = (const float*)(ws + WS_MOD);
    constexpr bool MULTI = (HI - LO) > 1;
    if (MULTI) {
        volatile LAS unsigned* MISC = (volatile LAS unsigned*)(l3 + MISC_OFF);
        if (threadIdx.x < 32) MISC[threadIdx.x] = 0u;
        __syncthreads();
        (void)xcd_barrier_post((unsigned*)(ws + WS_CTL) + CW_BAR, MISC + 8);
    }
#define IN(k) (LO <= (k) && (k) < HI)
#define SEAM(k) do { if (IN(k) && IN((k) + 1)) xcd_barrier((unsigned*)(p.ws + WS_CTL) + CW_BAR, (volatile LAS unsigned*)(l3 + MISC_OFF) + 8); } while (0)
    if (IN(0)) ph_prep(p, lds, bid, nblk);
    SEAM(0);
    if (IN(1)) ph_convert(p, lds, bid, nblk);
    SEAM(1);
    if (IN(2)) ph_mod0(p, bid, nblk);
    SEAM(2);
    if (IN(3)) { pg8::Gemm g{(const bf16_t*)(ws + WS_H), (const bf16_t*)(ws + WS_WHGIN), NROW, 5120, DM}; pg8::StaticOrder S; S.init(NROW, 5120, nblk, bid, 0);
        EpiInProj E{ws};
        pg8::gemm_phase<EpiInProj>(l3, g, S, E); }
    SEAM(3);
    if (IN(4)) ph_gla_simple(p, lds, bid, nblk);
    SEAM(4);
    if (IN(5)) ph_onorm(p, bid, nblk);
    SEAM(5);
    if (IN(6)) { pg8::Gemm g{(const bf16_t*)(ws + WS_ON), (const bf16_t*)(ws + WS_WHGOUT), NTOK, DM, DM}; pg8::StaticOrder S; S.init(NTOK, DM, nblk, bid, 0);
        EpiResid E{(float*)(ws + WS_X), mod + 2 * DM}; pg8::gemm_phase<EpiResid>(l3, g, S, E); }
    SEAM(6);
#define MOE_BLOCK(l, P0) \
    if (IN(P0)) ph_modffn(p, lds, bid, nblk, l); \
    SEAM(P0); \
    if (IN(P0 + 1)) ph_topk(p, lds, bid, nblk); \
    SEAM(P0 + 1); \
    if (IN(P0 + 2)) ph_gather(p, bid, nblk); \
    SEAM(P0 + 2); \
    if (IN(P0 + 3)) { pg8::Gemm g{(const bf16_t*)(ws + WS_XG), (const bf16_t*)(ws + WS_WMOE1) + (size_t)l * NE * 4096 * DM, NSLOT, 4096, DM}; pg8::StaticOrder S; S.init(NSLOT, 4096, nblk, bid, 8); \
        EpiGLU E{(bf16_t*)(ws + WS_ACT)}; pg8::gemm_phase<EpiGLU>(l3, g, S, E); } \
    SEAM(P0 + 3); \
    if (IN(P0 + 4)) { pg8::Gemm g{(const bf16_t*)(ws + WS_ACT), (const bf16_t*)(ws + WS_WMOE2) + (size_t)l * NE * DM * DE, NSLOT, DM, DE}; pg8::StaticOrder S; S.init(NSLOT, DM, nblk, bid, 8); \
        EpiRowScale E{(float*)(ws + WS_Y), (const float*)(ws + WS_TOPG)}; pg8::gemm_phase<EpiRowScale>(l3, g, S, E); } \
    SEAM(P0 + 4);
    MOE_BLOCK(0, 7)
    if (IN(12)) ph_combine(p, bid, nblk, 0, false);
    SEAM(12);
    if (IN(13)) { pg8::Gemm g{(const bf16_t*)(ws + WS_H), (const bf16_t*)(ws + WS_WSCIN), NTOK, 3072, DM}; pg8::StaticOrder S; S.init(NTOK, 3072, nblk, bid, 0);
        EpiConvIn E{(bf16_t*)(ws + WS_BG), (bf16_t*)(ws + WS_CU)}; pg8::gemm_phase<EpiConvIn>(l3, g, S, E); }
    SEAM(13);
    if (IN(14)) ph_conv(p, bid, nblk);
    SEAM(14);
    if (IN(15)) { pg8::Gemm g{(const bf16_t*)(ws + WS_Z), (const bf16_t*)(ws + WS_WSCOUT), NTOK, DM, DM}; pg8::StaticOrder S; S.init(NTOK, DM, nblk, bid, 0);
        EpiResid E{(float*)(ws + WS_X), mod + (size_t)3 * NADA + 2 * DM}; pg8::gemm_phase<EpiResid>(l3, g, S, E); }
    SEAM(15);
    MOE_BLOCK(1, 16)
#undef MOE_BLOCK
    if (IN(21)) ph_combine(p, bid, nblk, 1, true);
#undef IN
#undef SEAM
}

#ifndef MK_SPLIT
#define MK_SPLIT 0
#endif
#if MK_SPLIT
#include <utility>
template <int... I> static void launch_all(std::integer_sequence<int, I...>, int grid, Params& p, hipStream_t stream) {
    ((void)hipFuncSetAttribute((const void*)mega<I, I + 1>, hipFuncAttributeMaxDynamicSharedMemorySize, LDS_BYTES), ...);
    ((mega<I, I + 1><<<dim3(grid), dim3(NTHR), LDS_BYTES, stream>>>(p)), ...); }
#endif
extern "C" void kernel_launch(void* const* d_in, const int* in_sizes, int n_in, void* d_out, int out_size, void* d_ws, size_t ws_size, hipStream_t stream) {
    static int grid = 0;
    if (grid == 0) {
        if (n_in != 20 || ws_size < WS_END) { fprintf(stderr, "kernel_launch: unexpected inputs (n_in %d, ws %zu, need %zu)\n", n_in, ws_size, (size_t)WS_END); grid = -1; return; }
        int dev = 0, cus = 0, per_cu = 0;
        (void)hipGetDevice(&dev); (void)hipDeviceGetAttribute(&cus, hipDeviceAttributeMultiprocessorCount, dev);
        (void)hipFuncSetAttribute((const void*)mega<0, NPHASE>, hipFuncAttributeMaxDynamicSharedMemorySize, LDS_BYTES);
        if (hipOccupancyMaxActiveBlocksPerMultiprocessor(&per_cu, (const void*)mega<0, NPHASE>, NTHR, LDS_BYTES) != hipSuccess || per_cu < 1) { fprintf(stderr, "kernel_launch: occupancy query failed (%d)\n", per_cu); per_cu = 1; }
        (void)hipGetLastError();
        if (per_cu > 1) per_cu = 1;
        grid = (cus > 0 ? cus : 256) * per_cu;
    }
    if (grid < 0) return;
    Params p{};
    for (int i = 0; i < 20; ++i) p.in[i] = (const float*)d_in[i];
    p.out = (float*)d_out; p.ws = (unsigned char*)d_ws;
#if MK_SPLIT
    launch_all(std::make_integer_sequence<int, NPHASE>{}, grid, p, stream);
#else
    (void)hipMemsetAsync((char*)d_ws + WS_CTL, 0, 65536, stream);
    void* args[] = {&p};
    hipError_t e = hipLaunchCooperativeKernel((const void*)mega<0, NPHASE>, dim3(grid), dim3(NTHR), args, LDS_BYTES, stream);
    if (e != hipSuccess) fprintf(stderr, "kernel_launch: cooperative launch failed: %s (grid %d)\n", hipGetErrorString(e), grid);
#endif
}
```

```cpp
#include <hip/hip_runtime.h>
#include <cstdio>
#include <cstdint>

namespace pg8 {
#define PG8_LAS __attribute__((address_space(3)))
typedef unsigned short bf16_t;
typedef short bf16x8 __attribute__((ext_vector_type(8)));
typedef float f32x4 __attribute__((ext_vector_type(4)));
typedef unsigned u32x4 __attribute__((ext_vector_type(4)));
typedef unsigned u32x2 __attribute__((ext_vector_type(2)));
constexpr int BM = 256, BK = 64, HALF = 128, HTB = HALF * BK * 2, STAGE_BYTES = 8 * HTB, NXCD = 8, WGM = 8;

__host__ __device__ __forceinline__ int lds_byte(int r, int c) { const int st = (r >> 4) * 2 + (c >> 5), rr = r & 15, cc = c & 31, ob = rr * 64 + cc * 2; return st * 1024 + (ob ^ (((ob >> 9) & 1) << 5)); }
__host__ __device__ __forceinline__ void stage_rc(int b, int& R, int& C) { const int st = b / 1024, sb = b % 1024, swz = sb ^ (((sb >> 9) & 1) << 5); R = (st >> 1) * 16 + swz / 64; C = (st & 1) * 32 + (swz % 64) / 2; }
__host__ __device__ __forceinline__ int perm32(int rho) { const int n = rho >> 4, i = rho & 15; return 8 * (i >> 2) + 4 * n + (i & 3); }

struct Unit { int pm, pn, pb; };
struct Gemm { const bf16_t* A; const bf16_t* Bt; int M, N, K; };

struct StaticOrder {
    int nM, nN, nwg, G, c, mpe;
    __device__ void init(int M, int N, int G_, int c_, int mpe_) { nM = M / BM; nN = N / BM; nwg = nM * nN; G = G_; c = c_; mpe = mpe_; }
    __device__ bool next(int i, Unit& u) const {
        const long L = (long)i * G + c; if (L >= nwg) return false;
        int wgid = (int)L; { const int q = nwg / NXCD, r = nwg % NXCD, xcd = wgid % NXCD, off = wgid / NXCD; wgid = (xcd < r ? xcd * (q + 1) : r * (q + 1) + (xcd - r) * q) + off; }
        const int nig = WGM * nN, gid = wgid / nig, fm = gid * WGM, gsz = (nM - fm) < WGM ? (nM - fm) : WGM;
        u.pm = fm + ((wgid % nig) % gsz); u.pn = (wgid % nig) / gsz; u.pb = mpe > 0 ? (u.pm / mpe) * nN + u.pn : u.pn; return true;
    }
};

__device__ __forceinline__ unsigned cvt_pk_bf16(float lo, float hi) { unsigned r; asm volatile("v_cvt_pk_bf16_f32 %0, %1, %2" : "=v"(r) : "v"(lo), "v"(hi)); return r; }

template <class Epi>
__device__ __forceinline__ void gemm_phase(PG8_LAS unsigned char* lds, const Gemm g, const StaticOrder& S, const Epi& E) {
    int tid_ = threadIdx.x; asm volatile("" : "+v"(tid_));
    const int tid = tid_, wid = __builtin_amdgcn_readfirstlane(tid >> 6), lane = tid & 63, wr = wid >> 2, wc = wid & 3, fr = lane & 15, fq = lane >> 4;
    const int K = g.K, nt = K / BK;
    unsigned voffA[2], voffB[2];
#pragma unroll
    for (int i = 0; i < 2; ++i) { int R, C; stage_rc(tid * 16 + i * 8192, R, C); const int Rb = Epi::PERM ? ((R & ~31) + perm32(R & 31)) : R;
        voffA[i] = (unsigned)(R * K + C) * 2u; voffB[i] = (unsigned)(Rb * K + C) * 2u; }
    const size_t kstep = (size_t)(BK * 2);
    const size_t hstep = (size_t)HALF * K * 2;
    const size_t tstep = 2 * hstep;
    const unsigned ldsw = (unsigned)wid * 1024u;
    const int aoff = lds_byte(wr * 64 + fr, fq * 8), boff = lds_byte(wc * 32 + fr, fq * 8);
#define PG8_SA(b, h) (((b) * 2 + (h)) * HTB)
#define PG8_SB(b, h) ((4 + (b) * 2 + (h)) * HTB)
#define PG8_STAGE(bufoff, gbase, voff) do { _Pragma("unroll") for (int _i = 0; _i < 2; ++_i) \
        __builtin_amdgcn_global_load_lds((const unsigned*)((const char*)(gbase) + (voff)[_i]), (PG8_LAS unsigned*)(lds + (bufoff) + ldsw + _i * 8192), 16, 0, 0); } while (0)
#define PG8_LDA(dst, b, h) do { _Pragma("unroll") for (int m = 0; m < 4; ++m) _Pragma("unroll") for (int k = 0; k < 2; ++k) dst[m][k] = *(const PG8_LAS bf16x8*)(lds + PG8_SA(b, h) + aoff + m * 2048 + k * 1024); } while (0)
#define PG8_LDB(dst, b, h) do { _Pragma("unroll") for (int n = 0; n < 2; ++n) _Pragma("unroll") for (int k = 0; k < 2; ++k) dst[n][k] = *(const PG8_LAS bf16x8*)(lds + PG8_SB(b, h) + boff + n * 2048 + k * 1024); } while (0)
#define PG8_MMA(ai, bj, At, Bt) do { __builtin_amdgcn_s_setprio(1); _Pragma("unroll") for (int m = 0; m < 4; ++m) _Pragma("unroll") for (int n = 0; n < 2; ++n) _Pragma("unroll") for (int k = 0; k < 2; ++k) \
        acc[ai][bj][m][n] = __builtin_amdgcn_mfma_f32_16x16x32_bf16(Bt[n][k], At[m][k], acc[ai][bj][m][n], 0, 0, 0); __builtin_amdgcn_s_setprio(0); } while (0)
#define PG8_WAIT_V(n) asm volatile("s_waitcnt vmcnt(" #n ")" ::: "memory")
#define PG8_WAIT_L(n) asm volatile("s_waitcnt lgkmcnt(" #n ")" ::: "memory")
#define PG8_BAR __builtin_amdgcn_s_barrier()
#define PG8_SCHED __builtin_amdgcn_sched_barrier(0)
    Unit cur, nxt; int ui = 0;
    if (!S.next(0, cur)) return;
    f32x4 acc[2][2][4][2];
#pragma unroll
    for (int a = 0; a < 2; ++a)
#pragma unroll
        for (int b = 0; b < 2; ++b)
#pragma unroll
            for (int m = 0; m < 4; ++m)
#pragma unroll
                for (int n = 0; n < 2; ++n) acc[a][b][m][n] = (f32x4){0.f, 0.f, 0.f, 0.f};
    bf16x8 At[4][2], B0[2][2], B1[2][2];
    const char* cA = (const char*)g.A + (size_t)cur.pm * tstep; const char* cB = (const char*)g.Bt + (size_t)cur.pb * tstep;
    PG8_STAGE(PG8_SB(0, 0), cB, voffB); PG8_STAGE(PG8_SB(0, 1), cB + hstep, voffB); PG8_STAGE(PG8_SA(0, 0), cA, voffA); PG8_STAGE(PG8_SA(0, 1), cA + hstep, voffA);
    if (wr == 1) PG8_BAR;
    PG8_WAIT_V(2); PG8_BAR;
    PG8_STAGE(PG8_SB(1, 0), cB + kstep, voffB); PG8_STAGE(PG8_SA(1, 0), cA + kstep, voffA); PG8_STAGE(PG8_SB(1, 1), cB + hstep + kstep, voffB);
    PG8_WAIT_V(6); PG8_BAR;
    for (;;) {
        const bool has_next = S.next(ui + 1, nxt);
        const char* nA = has_next ? (const char*)g.A + (size_t)nxt.pm * tstep : cA; const char* nB = has_next ? (const char*)g.Bt + (size_t)nxt.pb * tstep : cB;
        for (int t = 0; t < nt; t += 2) {
            const bool last = (t == nt - 2);
            const char* a1 = cA + (size_t)(t + 1) * kstep;
            const char* a2 = last ? nA : cA + (size_t)(t + 2) * kstep; const char* b2 = last ? nB : cB + (size_t)(t + 2) * kstep;
            const char* a3 = a2 + kstep; const char* b3 = b2 + kstep;
            PG8_LDB(B0, 0, 0); PG8_LDB(B1, 0, 1); PG8_SCHED; PG8_LDA(At, 0, 0); PG8_STAGE(PG8_SA(1, 1), a1 + hstep, voffA);
            PG8_WAIT_V(8); PG8_WAIT_L(0); PG8_BAR; PG8_MMA(0, 0, At, B0); PG8_MMA(0, 1, At, B1); PG8_BAR; PG8_SCHED;
            PG8_LDA(At, 0, 1); PG8_STAGE(PG8_SB(0, 0), b2, voffB); PG8_STAGE(PG8_SB(0, 1), b2 + hstep, voffB); PG8_STAGE(PG8_SA(0, 0), a2, voffA);
            PG8_WAIT_V(8); PG8_WAIT_L(0); PG8_BAR; PG8_MMA(1, 0, At, B0); PG8_MMA(1, 1, At, B1); PG8_BAR; PG8_SCHED;
            PG8_LDB(B0, 1, 0); PG8_LDB(B1, 1, 1); PG8_SCHED; PG8_LDA(At, 1, 0); PG8_STAGE(PG8_SA(0, 1), a2 + hstep, voffA);
            PG8_WAIT_V(8); PG8_WAIT_L(0); PG8_BAR; PG8_MMA(0, 0, At, B0); PG8_MMA(0, 1, At, B1); PG8_BAR; PG8_SCHED;
            PG8_LDA(At, 1, 1); PG8_STAGE(PG8_SB(1, 0), b3, voffB); PG8_STAGE(PG8_SB(1, 1), b3 + hstep, voffB); PG8_STAGE(PG8_SA(1, 0), a3, voffA);
            PG8_WAIT_V(8); PG8_WAIT_L(0); PG8_BAR; PG8_MMA(1, 0, At, B0); PG8_MMA(1, 1, At, B1); PG8_BAR; PG8_SCHED;
        }
        if (wr == 0) PG8_BAR;
        E(acc, cur, wr, wc, fr, fq);
        if (!has_next) break;
#pragma unroll
        for (int a = 0; a < 2; ++a)
#pragma unroll
            for (int b = 0; b < 2; ++b)
#pragma unroll
                for (int m = 0; m < 4; ++m)
#pragma unroll
                    for (int n = 0; n < 2; ++n) acc[a][b][m][n] = (f32x4){0.f, 0.f, 0.f, 0.f};
        cur = nxt; cA = nA; cB = nB; ++ui;
        if (wr == 1) PG8_BAR;
    }
    PG8_WAIT_V(0);
    PG8_BAR;
#undef PG8_SA
#undef PG8_SB
#undef PG8_STAGE
#undef PG8_LDA
#undef PG8_LDB
#undef PG8_MMA
#undef PG8_WAIT_V
#undef PG8_WAIT_L
#undef PG8_BAR
#undef PG8_SCHED
}
}

#define LAS __attribute__((address_space(3)))
using pg8::bf16_t; using pg8::f32x4; using pg8::u32x4; using pg8::u32x2;
typedef unsigned short u16x8 __attribute__((ext_vector_type(8)));
typedef float f32x2 __attribute__((ext_vector_type(2)));

constexpr int DM = 1024, NB = 2, SEQ = 8192, NTOK = NB * SEQ, CTXL = 256, NCTX = NB * CTXL, NROW = NTOK + NCTX;
constexpr int NE = 16, CAP = 1024, DE = 2048, NSLOT = NE * NB * CAP;
constexpr int NADA = 6 * DM;
constexpr int NTHR = 512;

constexpr size_t MiB = 1u << 20;
constexpr size_t WS_CTL = 0;
constexpr size_t WS_MOD = 1 * MiB;
constexpr size_t WS_LB = WS_MOD + 256 * 1024;
constexpr size_t WS_POSR = WS_LB + 64 * 1024;
constexpr size_t WS_POSC = WS_POSR + 256 * 1024;
constexpr size_t WS_AFF = 2 * MiB;
constexpr size_t WS_TOPI = 3 * MiB;
constexpr size_t WS_TOPG = WS_TOPI + 128 * 1024;
constexpr size_t WS_SLOT = 4 * MiB;
constexpr size_t WS_WHGIN = 6 * MiB;
constexpr size_t WS_WHGOUT = 16 * MiB;
constexpr size_t WS_WSCIN = 18 * MiB;
constexpr size_t WS_WSCOUT = 24 * MiB;
constexpr size_t WS_WMOE1 = 26 * MiB;
constexpr size_t WS_WMOE2 = WS_WMOE1 + 256 * MiB;
constexpr size_t WS_X = WS_WMOE2 + 128 * MiB;
constexpr size_t WS_H = WS_X + 64 * MiB;
constexpr size_t WS_R = WS_H + 34 * MiB;
constexpr size_t WS_Q = WS_R;
constexpr size_t WS_V = WS_Q + 34 * MiB;
constexpr size_t WS_G = WS_V + 34 * MiB;
constexpr size_t WS_LF = WS_G + 34 * MiB;
constexpr size_t WS_LBK = WS_LF + 66 * MiB;
constexpr size_t WS_OF = WS_LBK + 66 * MiB;
constexpr size_t WS_OB = WS_OF + 64 * MiB;
constexpr size_t WS_U = WS_OB;
constexpr size_t WS_DD = WS_OB + 40 * MiB;
constexpr size_t WS_ON = WS_OB + 64 * MiB;
constexpr size_t WS_HG_END = WS_ON + 32 * MiB;
constexpr size_t WS_XG = WS_R;
constexpr size_t WS_ACT = WS_XG + 64 * MiB;
constexpr size_t WS_Y = WS_ACT + 128 * MiB;
constexpr size_t WS_MOE_END = WS_Y + 128 * MiB;
constexpr size_t WS_BG = WS_R;
constexpr size_t WS_CU = WS_BG + 32 * MiB;
constexpr size_t WS_Z = WS_CU + 32 * MiB;
constexpr size_t WS_END = WS_HG_END > WS_MOE_END ? WS_HG_END : WS_MOE_END;
static_assert(WS_END <= 1024 * MiB, "workspace map exceeds 1 GiB");

constexpr int LDS_BYTES = 135168;

struct Params { const float* in[20]; float* out; unsigned char* ws; int ph_lo, ph_hi; };
enum { I_X = 0, I_C, I_CTX, I_CCTX, I_ADAW, I_ADAB, I_NMIX, I_NFFN, I_NFIN, I_HGWIN, I_HGLB, I_HGNORM, I_HGWOUT, I_SCWIN, I_SCCONV, I_SCWOUT, I_ROUTER, I_WGATE, I_WUP, I_WDOWN };

__device__ __forceinline__ unsigned f2bf(float f) { unsigned u = __builtin_bit_cast(unsigned, f); return (u + 0x7fffu + ((u >> 16) & 1u)) >> 16; }
__device__ __forceinline__ unsigned pk2(float lo, float hi) { return f2bf(lo) | (f2bf(hi) << 16); }
__device__ __forceinline__ float bf2f(unsigned short h) { return __builtin_bit_cast(float, (unsigned)h << 16); }
__device__ __forceinline__ float wave_sum(float v) {
#pragma unroll
    for (int o = 1; o < 64; o <<= 1) v += __shfl_xor(v, o);
    return v;
}
__device__ __forceinline__ float sigmoidf_(float x) { return 1.f / (1.f + expf(-x)); }
__device__ __forceinline__ float siluf_(float x) { return x / (1.f + expf(-x)); }

struct EpiInProj {
    static constexpr bool PERM = false;
    unsigned char* ws;
    __device__ __forceinline__ void operator()(const f32x4 (&acc)[2][2][4][2], const pg8::Unit& u, int wr, int wc, int fr, int fq) const {
        const int sec = u.pn >> 2;
        const int row0 = u.pm * 256 + wr * 64 + fr, cb = (u.pn & 3) * 256 + wc * 32 + 4 * fq;
        if (sec == 0 || sec == 1 || sec == 4) {
            bf16_t* O = (bf16_t*)(ws + (sec == 0 ? WS_Q : (sec == 1 ? WS_V : WS_G)));
#pragma unroll
            for (int ai = 0; ai < 2; ++ai)
#pragma unroll
                for (int m = 0; m < 4; ++m) { bf16_t* rp = O + (size_t)(row0 + ai * 128 + m * 16) * DM + cb;
#pragma unroll
                    for (int bj = 0; bj < 2; ++bj)
#pragma unroll
                        for (int n = 0; n < 2; ++n) { f32x4 v = acc[ai][bj][m][n];
                            if (sec == 0) v = v * 0.08838834764831845f;
                            if (sec == 4) { v[0] = siluf_(v[0]); v[1] = siluf_(v[1]); v[2] = siluf_(v[2]); v[3] = siluf_(v[3]); }
                            u32x2 w; w.x = pk2(v[0], v[1]); w.y = pk2(v[2], v[3]); *(u32x2*)(rp + bj * 128 + n * 16) = w; } }
        } else {
            float* O = (float*)(ws + (sec == 2 ? WS_LF : WS_LBK)); const float* lb0 = (const float*)(ws + WS_LB);
            f32x4 lbv[2][2];
#pragma unroll
            for (int bj = 0; bj < 2; ++bj)
#pragma unroll
                for (int n = 0; n < 2; ++n) lbv[bj][n] = *(const f32x4*)(lb0 + cb + bj * 128 + n * 16);
#pragma unroll
            for (int ai = 0; ai < 2; ++ai)
#pragma unroll
                for (int m = 0; m < 4; ++m) { float* rp = O + (size_t)(row0 + ai * 128 + m * 16) * DM + cb;
#pragma unroll
                    for (int bj = 0; bj < 2; ++bj)
#pragma unroll
                        for (int n = 0; n < 2; ++n) { const f32x4 z = acc[ai][bj][m][n], lb = lbv[bj][n]; f32x4 o;
#pragma unroll
                            for (int i = 0; i < 4; ++i) o[i] = lb[i] + (1.f - lb[i]) * sigmoidf_(z[i]);
                            *(f32x4*)(rp + bj * 128 + n * 16) = o; } }
        }
    }
};
struct EpiResid {
    static constexpr bool PERM = false;
    float* X; const float* gate;
    __device__ __forceinline__ void operator()(const f32x4 (&acc)[2][2][4][2], const pg8::Unit& u, int wr, int wc, int fr, int fq) const {
        const int row0 = u.pm * 256 + wr * 64 + fr, cb = u.pn * 256 + wc * 32 + 4 * fq;
        const float* gp = gate + (size_t)((u.pm * 256) / SEQ) * NADA + cb;
        f32x4 gv[2][2];
#pragma unroll
        for (int bj = 0; bj < 2; ++bj)
#pragma unroll
            for (int n = 0; n < 2; ++n) gv[bj][n] = *(const f32x4*)(gp + bj * 128 + n * 16);
#pragma unroll
        for (int ai = 0; ai < 2; ++ai)
#pragma unroll
            for (int m = 0; m < 4; ++m) { float* rp = X + (size_t)(row0 + ai * 128 + m * 16) * DM + cb;
#pragma unroll
                for (int bj = 0; bj < 2; ++bj)
#pragma unroll
                    for (int n = 0; n < 2; ++n) { f32x4* q = (f32x4*)(rp + bj * 128 + n * 16); *q = *q + gv[bj][n] * acc[ai][bj][m][n]; } }
    }
};
struct EpiGLU {
    static constexpr bool PERM = true;
    bf16_t* ACT;
    __device__ __forceinline__ void operator()(const f32x4 (&acc)[2][2][4][2], const pg8::Unit& u, int wr, int wc, int fr, int fq) const {
        const int row0 = u.pm * 256 + wr * 64 + fr, cb = u.pn * 128 + wc * 32 + 8 * fq;
#pragma unroll
        for (int ai = 0; ai < 2; ++ai)
#pragma unroll
            for (int m = 0; m < 4; ++m) { bf16_t* rp = ACT + (size_t)(row0 + ai * 128 + m * 16) * DE + cb;
                f32x4 o[2];
#pragma unroll
                for (int n = 0; n < 2; ++n) { const f32x4 a = acc[ai][0][m][n], w = acc[ai][1][m][n];
#pragma unroll
                    for (int i = 0; i < 4; ++i) o[n][i] = siluf_(a[i]) * w[i]; }
                u32x4 w; w.x = pk2(o[0][0], o[0][1]); w.y = pk2(o[0][2], o[0][3]); w.z = pk2(o[1][0], o[1][1]); w.w = pk2(o[1][2], o[1][3]);
                *(u32x4*)rp = w; }
    }
};
struct EpiRowScale {
    static constexpr bool PERM = false;
    float* Y; const float* rg;
    __device__ __forceinline__ void operator()(const f32x4 (&acc)[2][2][4][2], const pg8::Unit& u, int wr, int wc, int fr, int fq) const {
        const int row0 = u.pm * 256 + wr * 64 + fr, cb = u.pn * 256 + wc * 32 + 4 * fq;
#pragma unroll
        for (int ai = 0; ai < 2; ++ai)
#pragma unroll
            for (int m = 0; m < 4; ++m) { const int row = row0 + ai * 128 + m * 16; const float gsc = rg[row]; float* rp = Y + (size_t)row * DM + cb;
#pragma unroll
                for (int bj = 0; bj < 2; ++bj)
#pragma unroll
                    for (int n = 0; n < 2; ++n) *(f32x4*)(rp + bj * 128 + n * 16) = acc[ai][bj][m][n] * gsc; }
    }
};
struct EpiConvIn {
    static constexpr bool PERM = true;
    bf16_t *BG, *CU;
    __device__ __forceinline__ void operator()(const f32x4 (&acc)[2][2][4][2], const pg8::Unit& u, int wr, int wc, int fr, int fq) const {
        const int row0 = u.pm * 256 + wr * 64 + fr;
        if (u.pn < 4) {
            const int cb = u.pn * 256 + wc * 32 + 8 * fq;
#pragma unroll
            for (int ai = 0; ai < 2; ++ai)
#pragma unroll
                for (int m = 0; m < 4; ++m) { bf16_t* rp = BG + (size_t)(row0 + ai * 128 + m * 16) * DM + cb;
#pragma unroll
                    for (int bj = 0; bj < 2; ++bj) { const f32x4 v0 = acc[ai][bj][m][0], v1 = acc[ai][bj][m][1];
                        u32x4 w; w.x = pk2(v0[0], v0[1]); w.y = pk2(v0[2], v0[3]); w.z = pk2(v1[0], v1[1]); w.w = pk2(v1[2], v1[3]);
                        *(u32x4*)(rp + bj * 128) = w; } }
        } else {
            const int cb = (u.pn - 4) * 128 + wc * 32 + 8 * fq;
#pragma unroll
            for (int ai = 0; ai < 2; ++ai)
#pragma unroll
                for (int m = 0; m < 4; ++m) { bf16_t* rp = CU + (size_t)(row0 + ai * 128 + m * 16) * DM + cb;
                    const f32x4 v0 = acc[ai][0][m][0] * acc[ai][1][m][0], v1 = acc[ai][0][m][1] * acc[ai][1][m][1];
                    u32x4 w; w.x = pk2(v0[0], v0[1]); w.y = pk2(v0[2], v0[3]); w.z = pk2(v1[0], v1[1]); w.w = pk2(v1[2], v1[3]);
                    *(u32x4*)rp = w; }
        }
    }
};

__device__ __forceinline__ void ph_prep(const Params& p, unsigned char* lds, int bid, int nblk) {
    float* sv = (float*)lds;
    float* red = sv + 3 * 1024;
    int tid_ = threadIdx.x; asm volatile("" : "+v"(tid_)); const int tid = tid_;
    const float* c = p.in[I_C]; const float* cctx = p.in[I_CCTX];
    for (int i = tid; i < 3 * 1024; i += NTHR) { const float v = (i < 2048) ? c[i] : cctx[i - 2048]; sv[i] = siluf_(v); }
    __syncthreads();
    const float* ada_w = p.in[I_ADAW]; const float* ada_b = p.in[I_ADAB];
    float* mod = (float*)(p.ws + WS_MOD);
    for (int it = bid; it < 96; it += nblk) {
        const int l = it / 48, j0 = (it % 48) * 128, col = tid & 127, ks = tid >> 7;
        const float* W = ada_w + (size_t)l * DM * NADA + j0 + col;
        float a0 = 0.f, a1 = 0.f, a2 = 0.f;
#pragma unroll 8
        for (int k = ks * 256; k < ks * 256 + 256; ++k) { const float w = W[(size_t)k * NADA]; a0 += sv[k] * w; a1 += sv[1024 + k] * w; a2 += sv[2048 + k] * w; }
        red[(ks * 3 + 0) * 128 + col] = a0; red[(ks * 3 + 1) * 128 + col] = a1; red[(ks * 3 + 2) * 128 + col] = a2;
        __syncthreads();
        if (tid < 384) { const int v = tid >> 7, cc = tid & 127;
            const float s = (red[(0 * 3 + v) * 128 + cc] + red[(1 * 3 + v) * 128 + cc]) + (red[(2 * 3 + v) * 128 + cc] + red[(3 * 3 + v) * 128 + cc]) + ada_b[l * NADA + j0 + cc];
            mod[(size_t)(l * 3 + v) * NADA + j0 + cc] = s; }
        __syncthreads();
    }
    const int gt = bid * NTHR + tid, NT = nblk * NTHR;
    const float* lg = p.in[I_HGLB]; float* lb0 = (float*)(p.ws + WS_LB);
    for (int d = gt; d < DM; d += NT) { const float l0 = lg[d], l1 = lg[DM + d], l2 = lg[2 * DM + d]; const float mx = fmaxf(l0, fmaxf(l1, l2));
        const float e0 = expf(l0 - mx), e1 = expf(l1 - mx), e2 = expf(l2 - mx); lb0[d] = e0 / (e0 + e1 + e2); }
    float* posr = (float*)(p.ws + WS_POSR);
    for (int i = gt; i < (128 + 64) * 512; i += NT) { const int pi = i >> 9, dd = i & 511; const int pos = pi < 128 ? pi : pi - 128; const int fi = dd & 255;
        const float om = exp2f(-(float)fi * (13.287712379549449f / 256.0f)); const float a = (float)pos * om; posr[i] = dd < 256 ? sinf(a) : cosf(a); }
}

__device__ __forceinline__ void transpose_item(const float* W, int N, bf16_t* WT, int K, float* scr, int k0, int n0, size_t drow0, int lane) {
#pragma unroll 8
    for (int i = 0; i < 32; ++i) { const int kk = 2 * i + (lane >> 5); scr[kk * 33 + (lane & 31)] = W[(size_t)(k0 + kk) * N + n0 + (lane & 31)]; }
    __builtin_amdgcn_s_waitcnt(0xc07f); asm volatile("" ::: "memory");
    const int c = lane & 7;
#pragma unroll
    for (int j = 0; j < 4; ++j) { const int n = (lane >> 3) + 8 * j; const float* s = scr + (8 * c) * 33 + n;
        u32x4 o; o.x = pk2(s[0 * 33], s[1 * 33]); o.y = pk2(s[2 * 33], s[3 * 33]); o.z = pk2(s[4 * 33], s[5 * 33]); o.w = pk2(s[6 * 33], s[7 * 33]);
        *(u32x4*)(WT + (drow0 + n) * K + k0 + 8 * c) = o; }
    __builtin_amdgcn_s_waitcnt(0xc07f); asm volatile("" ::: "memory");
}
__device__ __forceinline__ void ph_convert(const Params& p, unsigned char* lds, int bid, int nblk) {
    int tid_ = threadIdx.x; asm volatile("" : "+v"(tid_));
    const int tid = tid_, lane = tid & 63, wave = tid >> 6;
    float* scr = (float*)lds + wave * (64 * 33);
    const int gw = bid * 8 + wave, NGW = nblk * 8;
    constexpr int I_A = 16 * 160, I_B = 16 * 32, I_C_ = 16 * 96, I_D = 16 * 32, I_E = 32 * 1024, I_F = 32 * 1024, I_G = 32 * 1024;
    constexpr int NITEMS = I_A + I_B + I_C_ + I_D + I_E + I_F + I_G;
    for (int it = gw; it < NITEMS; it += NGW) {
        int r = it;
        if (r < I_A) { const int kb = r / 160, nb = r % 160; transpose_item(p.in[I_HGWIN], 5120, (bf16_t*)(p.ws + WS_WHGIN), 1024, scr, kb * 64, nb * 32, (size_t)nb * 32, lane); continue; } r -= I_A;
        if (r < I_B) { const int kb = r / 32, nb = r % 32; transpose_item(p.in[I_HGWOUT], 1024, (bf16_t*)(p.ws + WS_WHGOUT), 1024, scr, kb * 64, nb * 32, (size_t)nb * 32, lane); continue; } r -= I_B;
        if (r < I_C_) { const int kb = r / 96, nb = r % 96, n0 = nb * 32; size_t dr;
            if (n0 < 1024) dr = n0; else { const int np = n0 - 1024, sec = np >> 10, nn = np & 1023; dr = 1024 + (nn >> 7) * 256 + sec * 128 + (nn & 127); }
            transpose_item(p.in[I_SCWIN], 3072, (bf16_t*)(p.ws + WS_WSCIN), 1024, scr, kb * 64, n0, dr, lane); continue; } r -= I_C_;
        if (r < I_D) { const int kb = r / 32, nb = r % 32; transpose_item(p.in[I_SCWOUT], 1024, (bf16_t*)(p.ws + WS_WSCOUT), 1024, scr, kb * 64, nb * 32, (size_t)nb * 32, lane); continue; } r -= I_D;
        if (r < I_E + I_F) { const int up = r >= I_E; if (up) r -= I_E; const int le = r >> 10, q = r & 1023, kb = q >> 6, nb = q & 63, n0 = nb * 32;
            const size_t dr = (size_t)le * 4096 + (n0 >> 7) * 256 + up * 128 + (n0 & 127);
            transpose_item(p.in[up ? I_WUP : I_WGATE] + (size_t)le * 1024 * 2048, 2048, (bf16_t*)(p.ws + WS_WMOE1), 1024, scr, kb * 64, n0, dr, lane); continue; } r -= I_E + I_F;
        { const int le = r >> 10, q = r & 1023, kb = q >> 5, nb = q & 31, n0 = nb * 32;
            transpose_item(p.in[I_WDOWN] + (size_t)le * 2048 * 1024, 1024, (bf16_t*)(p.ws + WS_WMOE2), 2048, scr, kb * 64, n0, (size_t)le * 1024 + n0, lane); }
    }
}

__device__ __forceinline__ void store_mod_bf16(bf16_t* hrow, const f32x4 (&v)[4], float rstd, const float* g, const float* sh, const float* sc, int lane) {
#pragma unroll
    for (int j = 0; j < 4; ++j) { const int c0 = 256 * j + 4 * lane; const f32x4 gv = *(const f32x4*)(g + c0), shv = *(const f32x4*)(sh + c0), scv = *(const f32x4*)(sc + c0);
        f32x4 h;
#pragma unroll
        for (int i = 0; i < 4; ++i) h[i] = (v[j][i] * rstd * gv[i]) * (1.f + scv[i]) + shv[i];
        u32x2 w; w.x = pk2(h[0], h[1]); w.y = pk2(h[2], h[3]); *(u32x2*)(hrow + c0) = w; }
}
__device__ __forceinline__ void ph_mod0(const Params& p, int bid, int nblk) {
    int tid_ = threadIdx.x; asm volatile("" : "+v"(tid_));
    const int tid = tid_, lane = tid & 63, wave = tid >> 6, gw = bid * 8 + wave, NGW = nblk * 8;
    const float* x = p.in[I_X]; const float* ctx = p.in[I_CTX]; const float* g = p.in[I_NMIX];
    const float* mod = (const float*)(p.ws + WS_MOD); const float* posr = (const float*)(p.ws + WS_POSR); const float* posc = (const float*)(p.ws + WS_POSC);
    float* X = (float*)(p.ws + WS_X); bf16_t* H = (bf16_t*)(p.ws + WS_H);
    for (int row = gw; row < NROW; row += NGW) {
        f32x4 v[4]; float ss = 0.f; int vec;
        if (row < NTOK) { const int t = row & (SEQ - 1); vec = row >> 13; const float* pr = posr + (size_t)(t >> 6) * 512; const float* pc = posc + (size_t)(t & 63) * 512;
#pragma unroll
            for (int j = 0; j < 4; ++j) { const int c0 = 256 * j + 4 * lane; const f32x4 pv = *(const f32x4*)((j < 2 ? pr : pc) + (c0 & 511));
                v[j] = *(const f32x4*)(x + (size_t)row * DM + c0) + pv; *(f32x4*)(X + (size_t)row * DM + c0) = v[j]; }
        } else { vec = 2;
#pragma unroll
            for (int j = 0; j < 4; ++j) v[j] = *(const f32x4*)(ctx + (size_t)(row - NTOK) * DM + 256 * j + 4 * lane); }
#pragma unroll
        for (int j = 0; j < 4; ++j) ss += (v[j][0] * v[j][0] + v[j][1] * v[j][1]) + (v[j][2] * v[j][2] + v[j][3] * v[j][3]);
        const float rstd = 1.f / sqrtf(wave_sum(ss) * (1.f / DM) + 1e-6f);
        const float* mv = mod + (size_t)(0 * 3 + vec) * NADA;
        store_mod_bf16(H + (size_t)row * DM, v, rstd, g, mv, mv + DM, lane);
    }
}

__device__ __forceinline__ void ph_gla_simple(const Params& p, unsigned char* lds, int bid, int nblk) {
    float* qs = (float*)lds; float* fs = qs + 4096; float* ks = fs + 4096; float* vs = ks + 4096; float* part = vs + 1024;
    int tid_ = threadIdx.x; asm volatile("" : "+v"(tid_));
    const int tid = tid_, lane = tid & 63, wave = tid >> 6, kk = tid >> 5, vv = tid & 31;
    const bf16_t* Q = (const bf16_t*)(p.ws + WS_Q); const bf16_t* V = (const bf16_t*)(p.ws + WS_V);
    for (int unit = bid; unit < 128; unit += nblk) {
        const int vsl = unit & 3, dir = (unit >> 2) & 1, h = (unit >> 3) & 7, b = unit >> 6;
        const float* LFp = (const float*)(p.ws + (dir ? WS_LBK : WS_LF)); float* O = (float*)(p.ws + (dir ? WS_OB : WS_OF));
        float s[8];
#pragma unroll
        for (int i = 0; i < 8; ++i) s[i] = 0.f;
        for (int bt = 0; bt < 8 + 256; ++bt) {
            const bool isctx = bt < 8; const int nb = isctx ? bt : bt - 8, nbt = isctx ? 8 : 256;
            const int t0 = dir == 0 ? nb * 32 : (nbt - 1 - nb) * 32;
            const size_t rbase = isctx ? (size_t)(NTOK + b * CTXL + t0) : (size_t)(b * SEQ + t0);
            { const int r = tid >> 4, c8 = (tid & 15) * 8; const size_t off = (rbase + r) * DM + h * 128 + c8;
                const u16x8 qv = *(const u16x8*)(Q + off); const f32x4 l0 = *(const f32x4*)(LFp + off), l1 = *(const f32x4*)(LFp + off + 4);
#pragma unroll
                for (int i = 0; i < 8; ++i) { qs[r * 128 + c8 + i] = bf2f(qv[i]); const float f = i < 4 ? l0[i] : l1[i - 4]; fs[r * 128 + c8 + i] = f; ks[r * 128 + c8 + i] = 1.f - f; }
                if (tid < 128) { const int r2 = tid >> 2, c = (tid & 3) * 8; const u16x8 vv8 = *(const u16x8*)(V + (rbase + r2) * DM + h * 128 + vsl * 32 + c);
#pragma unroll
                    for (int i = 0; i < 8; ++i) vs[r2 * 32 + c + i] = bf2f(vv8[i]); } }
            __syncthreads();
            for (int jj = 0; jj < 32; ++jj) { const int j = dir ? 31 - jj : jj; const float vj = vs[j * 32 + vv]; float po = 0.f;
#pragma unroll
                for (int i = 0; i < 8; ++i) { const float f = fs[j * 128 + kk * 8 + i], k_ = ks[j * 128 + kk * 8 + i], q_ = qs[j * 128 + kk * 8 + i]; s[i] = f * s[i] + k_ * vj; po += q_ * s[i]; }
                po += __shfl_xor(po, 32);
                if (!isctx && lane < 32) part[(j * 8 + wave) * 32 + vv] = po; }
            __syncthreads();
            if (!isctx) { const int j = tid >> 4, v2 = (tid & 15) * 2; float o0 = 0.f, o1 = 0.f;
#pragma unroll
                for (int w = 0; w < 8; ++w) { o0 += part[(j * 8 + w) * 32 + v2]; o1 += part[(j * 8 + w) * 32 + v2 + 1]; }
                *(f32x2*)(O + (rbase + j) * DM + h * 128 + vsl * 32 + v2) = (f32x2){o0, o1}; }
        }
        __syncthreads();
    }
}

__device__ __forceinline__ void ph_onorm(const Params& p, int bid, int nblk) {
    int tid_ = threadIdx.x; asm volatile("" : "+v"(tid_));
    const int tid = tid_, lane = tid & 63, wave = tid >> 6, gw = bid * 8 + wave, NGW = nblk * 8;
    const float* OF = (const float*)(p.ws + WS_OF); const float* OB = (const float*)(p.ws + WS_OB); const bf16_t* G = (const bf16_t*)(p.ws + WS_G); bf16_t* ON = (bf16_t*)(p.ws + WS_ON);
    const float* ng = p.in[I_HGNORM];
    const f32x4 gv = *(const f32x4*)(ng + 4 * (lane & 31));
    for (int row = gw; row < NTOK; row += NGW) {
#pragma unroll
        for (int j = 0; j < 4; ++j) { const size_t off = (size_t)row * DM + 256 * j + 4 * lane; const f32x4 o = *(const f32x4*)(OF + off) + *(const f32x4*)(OB + off);
            float ss = (o[0] * o[0] + o[1] * o[1]) + (o[2] * o[2] + o[3] * o[3]);
#pragma unroll
            for (int d = 1; d < 32; d <<= 1) ss += __shfl_xor(ss, d);
            const float rstd = 1.f / sqrtf(ss * (1.f / 128.f) + 1e-6f);
            const u32x2 gg = *(const u32x2*)(G + off);
            const float g0 = bf2f((unsigned short)(gg.x & 0xffffu)), g1 = bf2f((unsigned short)(gg.x >> 16)), g2 = bf2f((unsigned short)(gg.y & 0xffffu)), g3 = bf2f((unsigned short)(gg.y >> 16));
            u32x2 w; w.x = pk2(o[0] * rstd * gv[0] * g0, o[1] * rstd * gv[1] * g1); w.y = pk2(o[2] * rstd * gv[2] * g2, o[3] * rstd * gv[3] * g3);
            *(u32x2*)(ON + off) = w; }
    }
}

typedef short s16x4 __attribute__((ext_vector_type(4)));
typedef short v4i16_t __attribute__((ext_vector_type(4)));
using pg8::bf16x8;
constexpr int KT_STR = 160, KS_STR = 144, V_STR = 288;
constexpr int GL_QT = 0, GL_KT = 20480, GL_KS = 40960, GL_PL = 59392, GL_V = 68608, GL_SEG = 87040, GL_DV = 89088, GL_EM = 89600, GL_SSQ = 90112, GL_RSTD = 92160;
__device__ __forceinline__ s16x4 lds_tr(const LAS unsigned char* p) { return __builtin_bit_cast(s16x4, __builtin_amdgcn_ds_read_tr16_b64_v4i16((LAS v4i16_t*)p)); }
__device__ __forceinline__ bf16x8 cat8(s16x4 a, s16x4 b) { return __builtin_shufflevector(a, b, 0, 1, 2, 3, 4, 5, 6, 7); }
__device__ __forceinline__ bf16x8 lds_pair64(const LAS unsigned char* p, int d2) { const u32x2 a = *(const LAS u32x2*)p, b = *(const LAS u32x2*)(p + d2); u32x4 r; r.x = a.x; r.y = a.y; r.z = b.x; r.w = b.y; return __builtin_bit_cast(bf16x8, r); }

struct GlaRegs { float f[16]; unsigned short q[16]; u32x4 v[2]; };
template <bool WITHQ>
__device__ __forceinline__ void gla_load(GlaRegs& R, const float* F, const bf16_t* Q, const bf16_t* V, int rb, int dir, int h, int tid) {
    const int k = tid & 127, seg = tid >> 7;
#pragma unroll
    for (int i = 0; i < 16; ++i) { const int p = 16 * seg + i; const size_t row = (size_t)(dir ? rb + 63 - p : rb + p);
        R.f[i] = F[row * DM + h * 128 + k]; if (WITHQ) R.q[i] = Q[row * DM + h * 128 + k]; }
#pragma unroll
    for (int i = 0; i < 2; ++i) { const int id = tid + 512 * i, p = id >> 4, c8 = (id & 15) * 8; const size_t row = (size_t)(dir ? rb + 63 - p : rb + p);
        R.v[i] = *(const u32x4*)(V + row * DM + h * 128 + c8); }
}
template <bool G2>
__device__ __forceinline__ void gla_phase_a(const GlaRegs& R, LAS unsigned char* lds, int tid) {
    const int k = tid & 127, seg = tid >> 7;
    LAS float* segtot = (LAS float*)(lds + GL_SEG);
#pragma unroll
    for (int i = 0; i < 2; ++i) { const int id = tid + 512 * i, p = id >> 4, c8 = (id & 15) * 8; *(LAS u32x4*)(lds + GL_V + p * V_STR + c8 * 2) = R.v[i]; }
    if (G2) {
        float c[16]; c[0] = R.f[0];
#pragma unroll
        for (int i = 1; i < 16; ++i) c[i] = c[i - 1] * R.f[i];
        segtot[seg * 128 + k] = c[15];
        __syncthreads();
        const float T0 = segtot[k], T1 = segtot[128 + k], T2 = segtot[256 + k], T3 = segtot[384 + k];
        const float Fs = seg == 0 ? 1.f / (T0 * T1) : (seg == 1 ? 1.f / T1 : (seg == 2 ? 1.f : T2));
        const float cK = T2 * T3;
        if (seg == 0) { ((LAS float*)(lds + GL_DV))[k] = T0 * T1 * cK; ((LAS float*)(lds + GL_EM))[k] = T0 * T1; }
        unsigned wq[8], wk[8], ws_[8];
#pragma unroll
        for (int i = 0; i < 16; i += 2) { float qp[2], kp[2], ks[2];
#pragma unroll
            for (int e = 0; e < 2; ++e) { const float eq = c[i + e] * Fs, inv = __builtin_amdgcn_rcpf(eq), kk = 1.f - R.f[i + e];
                qp[e] = bf2f(R.q[i + e]) * eq; kp[e] = kk * inv; ks[e] = kp[e] * cK; }
            wq[i >> 1] = pk2(qp[0], qp[1]); wk[i >> 1] = pk2(kp[0], kp[1]); ws_[i >> 1] = pk2(ks[0], ks[1]); }
        LAS unsigned char* dq = lds + GL_QT + k * KT_STR + seg * 32; LAS unsigned char* dk = lds + GL_KT + k * KT_STR + seg * 32; LAS unsigned char* ds = lds + GL_KS + k * KS_STR + seg * 32;
        *(LAS u32x4*)dq = (u32x4){wq[0], wq[1], wq[2], wq[3]}; *(LAS u32x4*)(dq + 16) = (u32x4){wq[4], wq[5], wq[6], wq[7]};
        *(LAS u32x4*)dk = (u32x4){wk[0], wk[1], wk[2], wk[3]}; *(LAS u32x4*)(dk + 16) = (u32x4){wk[4], wk[5], wk[6], wk[7]};
        *(LAS u32x4*)ds = (u32x4){ws_[0], ws_[1], ws_[2], ws_[3]}; *(LAS u32x4*)(ds + 16) = (u32x4){ws_[4], ws_[5], ws_[6], ws_[7]};
    } else {
        float sx[16]; sx[15] = 1.f;
#pragma unroll
        for (int i = 14; i >= 0; --i) sx[i] = sx[i + 1] * R.f[i + 1];
        segtot[seg * 128 + k] = sx[0] * R.f[0];
        __syncthreads();
        const float T0 = segtot[k], T1 = segtot[128 + k], T2 = segtot[256 + k], T3 = segtot[384 + k];
        const float later = seg == 0 ? T1 * T2 * T3 : (seg == 1 ? T2 * T3 : (seg == 2 ? T3 : 1.f));
        if (seg == 0) ((LAS float*)(lds + GL_DV))[k] = T0 * T1 * T2 * T3;
        unsigned ws_[8];
#pragma unroll
        for (int i = 0; i < 16; i += 2) ws_[i >> 1] = pk2((1.f - R.f[i]) * sx[i] * later, (1.f - R.f[i + 1]) * sx[i + 1] * later);
        LAS unsigned char* ds = lds + GL_KS + k * KS_STR + seg * 32;
        *(LAS u32x4*)ds = (u32x4){ws_[0], ws_[1], ws_[2], ws_[3]}; *(LAS u32x4*)(ds + 16) = (u32x4){ws_[4], ws_[5], ws_[6], ws_[7]};
    }
    __syncthreads();
}
__device__ __forceinline__ void gla_state_update(f32x4 (&S)[8], const bf16x8 (&Vf)[2], const LAS unsigned char* lds, int i16, int g) {
#pragma unroll
    for (int j = 0; j < 8; ++j) { const f32x4 dv = *(const LAS f32x4*)(lds + GL_DV + (16 * j + 4 * g) * 4); S[j] = S[j] * dv;
#pragma unroll
        for (int c2 = 0; c2 < 2; ++c2) { const bf16x8 a = lds_pair64(lds + GL_KS + (16 * j + i16) * KS_STR + (32 * c2 + 4 * g) * 2, 32);
            S[j] = __builtin_amdgcn_mfma_f32_16x16x32_bf16(a, Vf[c2], S[j], 0, 0, 0); } }
}
__device__ __forceinline__ void gla_load_vf(bf16x8 (&Vf)[2], const LAS unsigned char* lds, int w, int i16, int g) {
    const int q4 = i16 >> 2, pp = i16 & 3;
#pragma unroll
    for (int c2 = 0; c2 < 2; ++c2) { const LAS unsigned char* vb = lds + GL_V + (32 * c2 + 4 * g + q4) * V_STR + (16 * w + 4 * pp) * 2; Vf[c2] = cat8(lds_tr(vb), lds_tr(vb + 16 * V_STR)); }
}

__device__ __forceinline__ void ph_gla_states(const Params& p, unsigned char* lds_, int bid, int nblk) {
    int tid_ = threadIdx.x; asm volatile("" : "+v"(tid_));
    const int tid = tid_, lane = tid & 63, w = __builtin_amdgcn_readfirstlane(tid >> 6), i16 = lane & 15, g = lane >> 4;
    LAS unsigned char* lds = (LAS unsigned char*)lds_;
    const bf16_t* V = (const bf16_t*)(p.ws + WS_V);
    float* U = (float*)(p.ws + WS_U); float* DD = (float*)(p.ws + WS_DD);
    for (int ui = bid; ui < 544; ui += nblk) {
        int b, h, dir, nch, rb0, uidx;
        if (ui < 512) { b = ui >> 8; h = (ui >> 5) & 7; dir = (ui >> 4) & 1; const int sc = ui & 15; nch = 8; rb0 = b * SEQ + sc * 512; uidx = ((b * 8 + h) * 2 + dir) * 17 + sc; }
        else { const int r = ui - 512; b = r >> 4; h = (r >> 1) & 7; dir = r & 1; nch = 4; rb0 = NTOK + b * CTXL; uidx = ((b * 8 + h) * 2 + dir) * 17 + 16; }
        const float* F = (const float*)(p.ws + (dir ? WS_LBK : WS_LF));
        f32x4 S[8];
#pragma unroll
        for (int j = 0; j < 8; ++j) S[j] = (f32x4){0.f, 0.f, 0.f, 0.f};
        float dtot = 1.f;
        GlaRegs R;
        gla_load<false>(R, F, nullptr, V, rb0 + 64 * (dir ? nch - 1 : 0), dir, h, tid);
        for (int step = 0; step < nch; ++step) {
            gla_phase_a<false>(R, lds, tid);
            if (step + 1 < nch) { const int n = dir ? nch - 2 - step : step + 1; gla_load<false>(R, F, nullptr, V, rb0 + 64 * n, dir, h, tid); }
            if (tid < 128) dtot *= ((const LAS float*)(lds + GL_DV))[tid];
            bf16x8 Vf[2]; gla_load_vf(Vf, lds, w, i16, g);
            gla_state_update(S, Vf, lds, i16, g);
            __syncthreads();
        }
        float* up = U + (size_t)uidx * 16384 + (size_t)(w * 8) * 256 + lane * 4;
#pragma unroll
        for (int j = 0; j < 8; ++j) *(f32x4*)(up + j * 256) = S[j];
        if (tid < 128) DD[(size_t)uidx * 128 + tid] = dtot;
    }
}

__device__ __forceinline__ void ph_gla_out(const Params& p, unsigned char* lds_, int bid, int nblk) {
    int tid_ = threadIdx.x; asm volatile("" : "+v"(tid_));
    const int tid = tid_, lane = tid & 63, w = __builtin_amdgcn_readfirstlane(tid >> 6), i16 = lane & 15, g = lane >> 4, q4 = i16 >> 2, pp = i16 & 3;
    LAS unsigned char* lds = (LAS unsigned char*)lds_;
    const bf16_t* Q = (const bf16_t*)(p.ws + WS_Q); const bf16_t* V = (const bf16_t*)(p.ws + WS_V); const bf16_t* G = (const bf16_t*)(p.ws + WS_G);
    const float* U = (const float*)(p.ws + WS_U); const float* DD = (const float*)(p.ws + WS_DD);
    float* OF = (float*)(p.ws + WS_OF); bf16_t* ON = (bf16_t*)(p.ws + WS_ON);
    const float ngv = p.in[I_HGNORM][16 * w + i16];
    const int troff = (4 * g + q4) * KT_STR + (4 * pp) * 2;
    for (int unit = bid; unit < 256; unit += nblk) {
        const int b = unit >> 7, h = (unit >> 4) & 7, sc = unit & 15, rbs = b * SEQ + sc * 512;
        const int col = h * 128 + 16 * w + i16;
#pragma unroll 1
        for (int dir = 0; dir < 2; ++dir) {
            const float* F = (const float*)(p.ws + (dir ? WS_LBK : WS_LF));
            GlaRegs R;
            gla_load<true>(R, F, Q, V, rbs + 64 * (dir ? 7 : 0), dir, h, tid);
            const int ub = ((b * 8 + h) * 2 + dir) * 17;
            f32x4 S[8];
            { const float* up = U + (size_t)(ub + 16) * 16384 + (size_t)(w * 8) * 256 + lane * 4;
#pragma unroll
                for (int j = 0; j < 8; ++j) S[j] = *(const f32x4*)(up + j * 256); }
            for (int s = 0; s < (dir ? 15 - sc : sc); ++s) { const int u = dir ? 15 - s : s;
                const float* up = U + (size_t)(ub + u) * 16384 + (size_t)(w * 8) * 256 + lane * 4; const float* dp = DD + (size_t)(ub + u) * 128 + 4 * g;
#pragma unroll
                for (int j = 0; j < 8; ++j) S[j] = S[j] * *(const f32x4*)(dp + 16 * j) + *(const f32x4*)(up + j * 256); }
            for (int step = 0; step < 8; ++step) {
                const int n = dir ? 7 - step : step, rb = rbs + 64 * n;
                gla_phase_a<true>(R, lds, tid);
                if (step < 7) gla_load<true>(R, F, Q, V, rbs + 64 * (dir ? 6 - step : step + 1), dir, h, tid);
                { const int si = w >> 1, tb = 2 * (w & 1);
                    f32x4 pa[2] = {(f32x4){0.f, 0.f, 0.f, 0.f}, (f32x4){0.f, 0.f, 0.f, 0.f}};
#pragma unroll
                    for (int c = 0; c < 4; ++c) { const LAS unsigned char* ka = lds + GL_KT + troff + (32 * c) * KT_STR + (16 * si) * 2; const bf16x8 a = cat8(lds_tr(ka), lds_tr(ka + 16 * KT_STR));
#pragma unroll
                        for (int tt = 0; tt < 2; ++tt) { const LAS unsigned char* qa = lds + GL_QT + troff + (32 * c) * KT_STR + (16 * (tb + tt)) * 2; const bf16x8 bq = cat8(lds_tr(qa), lds_tr(qa + 16 * KT_STR));
                            pa[tt] = __builtin_amdgcn_mfma_f32_16x16x32_bf16(a, bq, pa[tt], 0, 0, 0); } }
#pragma unroll
                    for (int tt = 0; tt < 2; ++tt) { const int t = 16 * (tb + tt) + i16, s0 = 16 * si + 4 * g; f32x4 v = pa[tt];
#pragma unroll
                        for (int r = 0; r < 4; ++r) v[r] = (s0 + r <= t) ? v[r] : 0.f;
                        u32x2 wv; wv.x = pk2(v[0], v[1]); wv.y = pk2(v[2], v[3]); *(LAS u32x2*)(lds + GL_PL + t * KS_STR + s0 * 2) = wv; } }
                __syncthreads();
                f32x4 O[4];
#pragma unroll
                for (int ti = 0; ti < 4; ++ti) O[ti] = (f32x4){0.f, 0.f, 0.f, 0.f};
                { bf16x8 Sb[4];
#pragma unroll
                    for (int c = 0; c < 4; ++c) { const f32x4 e0 = *(const LAS f32x4*)(lds + GL_EM + (32 * c + 4 * g) * 4), e1 = *(const LAS f32x4*)(lds + GL_EM + (32 * c + 16 + 4 * g) * 4);
                        const f32x4 a = S[2 * c] * e0, bq = S[2 * c + 1] * e1; u32x4 r; r.x = pk2(a[0], a[1]); r.y = pk2(a[2], a[3]); r.z = pk2(bq[0], bq[1]); r.w = pk2(bq[2], bq[3]); Sb[c] = __builtin_bit_cast(bf16x8, r); }
#pragma unroll
                    for (int ti = 0; ti < 4; ++ti)
#pragma unroll
                        for (int c = 0; c < 4; ++c) { const LAS unsigned char* qa = lds + GL_QT + troff + (32 * c) * KT_STR + (16 * ti) * 2; const bf16x8 a = cat8(lds_tr(qa), lds_tr(qa + 16 * KT_STR));
                            O[ti] = __builtin_amdgcn_mfma_f32_16x16x32_bf16(a, Sb[c], O[ti], 0, 0, 0); } }
                bf16x8 Vf[2]; gla_load_vf(Vf, lds, w, i16, g);
#pragma unroll
                for (int ti = 0; ti < 4; ++ti)
#pragma unroll
                    for (int c2 = 0; c2 < 2; ++c2) { const bf16x8 a = lds_pair64(lds + GL_PL + (16 * ti + i16) * KS_STR + (32 * c2 + 4 * g) * 2, 32);
                        O[ti] = __builtin_amdgcn_mfma_f32_16x16x32_bf16(a, Vf[c2], O[ti], 0, 0, 0); }
                gla_state_update(S, Vf, lds, i16, g);
                if (dir == 0) {
#pragma unroll
                    for (int ti = 0; ti < 4; ++ti)
#pragma unroll
                        for (int r = 0; r < 4; ++r) OF[(size_t)(rb + 16 * ti + 4 * g + r) * DM + col] = O[ti][r];
                    __syncthreads();
                } else {
                    float part[4][4];
#pragma unroll
                    for (int ti = 0; ti < 4; ++ti)
#pragma unroll
                        for (int r = 0; r < 4; ++r) { const float o = O[ti][r] + OF[(size_t)(rb + 63 - (16 * ti + 4 * g + r)) * DM + col]; O[ti][r] = o; float s2 = o * o;
                            s2 += __shfl_xor(s2, 1); s2 += __shfl_xor(s2, 2); s2 += __shfl_xor(s2, 4); s2 += __shfl_xor(s2, 8); part[ti][r] = s2; }
                    if (i16 == 0) {
#pragma unroll
                        for (int ti = 0; ti < 4; ++ti) *(LAS f32x4*)(lds + GL_SSQ + (w * 64 + 16 * ti + 4 * g) * 4) = (f32x4){part[ti][0], part[ti][1], part[ti][2], part[ti][3]}; }
                    __syncthreads();
                    if (tid < 64) { float s2 = 0.f;
#pragma unroll
                        for (int ww = 0; ww < 8; ++ww) s2 += ((const LAS float*)(lds + GL_SSQ))[ww * 64 + tid];
                        ((LAS float*)(lds + GL_RSTD))[tid] = 1.f / sqrtf(s2 * (1.f / 128.f) + 1e-6f); }
                    __syncthreads();
#pragma unroll
                    for (int ti = 0; ti < 4; ++ti) { const f32x4 rs = *(const LAS f32x4*)(lds + GL_RSTD + (16 * ti + 4 * g) * 4);
#pragma unroll
                        for (int r = 0; r < 4; ++r) { const size_t off = (size_t)(rb + 63 - (16 * ti + 4 * g + r)) * DM + col;
                            ON[off] = (bf16_t)f2bf(O[ti][r] * rs[r] * ngv * bf2f(G[off])); } }
                }
            }
            asm volatile("s_waitcnt vmcnt(0)" ::: "memory");
            __syncthreads();
        }
    }
}

__device__ __forceinline__ void ph_modffn(const Params& p, unsigned char* lds, int bid, int nblk, int l) {
    int tid_ = threadIdx.x; asm volatile("" : "+v"(tid_));
    const int tid = tid_, lane = tid & 63, wave = tid >> 6, gw = bid * 8 + wave, NGW = nblk * 8;
    float* rw = (float*)lds;
    const float* router = p.in[I_ROUTER] + (size_t)l * DM * NE;
    for (int i = tid; i < DM * NE / 4; i += NTHR) ((f32x4*)rw)[i] = ((const f32x4*)router)[i];
    __syncthreads();
    const float* X = (const float*)(p.ws + WS_X); bf16_t* H = (bf16_t*)(p.ws + WS_H); float* aff = (float*)(p.ws + WS_AFF); int* slot = (int*)(p.ws + WS_SLOT);
    const float* g = p.in[I_NFFN] + (size_t)l * DM; const float* mod = (const float*)(p.ws + WS_MOD);
    for (int row = gw; row < NTOK; row += NGW) {
        const int b = row >> 13, t = row & (SEQ - 1);
        const float* mv = mod + (size_t)(l * 3 + b) * NADA; const float* sh = mv + 3 * DM; const float* sc = mv + 4 * DM;
        f32x4 v[4]; float ss = 0.f;
#pragma unroll
        for (int j = 0; j < 4; ++j) { v[j] = *(const f32x4*)(X + (size_t)row * DM + 256 * j + 4 * lane); ss += (v[j][0] * v[j][0] + v[j][1] * v[j][1]) + (v[j][2] * v[j][2] + v[j][3] * v[j][3]); }
        const float rstd = 1.f / sqrtf(wave_sum(ss) * (1.f / DM) + 1e-6f);
        float lg[16];
#pragma unroll
        for (int e = 0; e < 16; ++e) lg[e] = 0.f;
#pragma unroll
        for (int j = 0; j < 4; ++j) { const int c0 = 256 * j + 4 * lane; const f32x4 gv = *(const f32x4*)(g + c0), shv = *(const f32x4*)(sh + c0), scv = *(const f32x4*)(sc + c0);
            f32x4 h;
#pragma unroll
            for (int i = 0; i < 4; ++i) { h[i] = (v[j][i] * rstd * gv[i]) * (1.f + scv[i]) + shv[i];
                const f32x4 r0 = *(const f32x4*)(rw + (c0 + i) * 16), r1 = *(const f32x4*)(rw + (c0 + i) * 16 + 4), r2 = *(const f32x4*)(rw + (c0 + i) * 16 + 8), r3 = *(const f32x4*)(rw + (c0 + i) * 16 + 12);
#pragma unroll
                for (int e = 0; e < 4; ++e) { lg[e] += h[i] * r0[e]; lg[4 + e] += h[i] * r1[e]; lg[8 + e] += h[i] * r2[e]; lg[12 + e] += h[i] * r3[e]; }
                asm volatile("" ::: "memory"); }
            u32x2 w; w.x = pk2(h[0], h[1]); w.y = pk2(h[2], h[3]); *(u32x2*)(H + (size_t)row * DM + c0) = w; }
        float mx = -3.0e38f;
#pragma unroll
        for (int e = 0; e < 16; ++e) { lg[e] = wave_sum(lg[e]); mx = fmaxf(mx, lg[e]); }
        float den = 0.f;
#pragma unroll
        for (int e = 0; e < 16; ++e) { lg[e] = expf(lg[e] - mx); den += lg[e]; }
        const float inv = 1.f / den;
        float mine = 0.f;
#pragma unroll
        for (int e = 0; e < 16; ++e) mine = (lane == e) ? lg[e] * inv : mine;
        if (lane < 16) { aff[(size_t)(b * NE + lane) * SEQ + t] = mine; slot[(size_t)row * NE + lane] = -1; }
    }
}

__device__ __forceinline__ void ph_topk(const Params& p, unsigned char* lds, int bid, int nblk) {
    unsigned long long* a = (unsigned long long*)lds;
    int tid_ = threadIdx.x; asm volatile("" : "+v"(tid_)); const int tid = tid_;
    const float* aff = (const float*)(p.ws + WS_AFF); int* topi = (int*)(p.ws + WS_TOPI); float* topg = (float*)(p.ws + WS_TOPG); int* slot = (int*)(p.ws + WS_SLOT);
    for (int it = bid; it < NB * NE; it += nblk) {
        const int b = it >> 4, e = it & 15; const float* src = aff + (size_t)it * SEQ;
        for (int i = tid; i < SEQ; i += NTHR) a[i] = ((unsigned long long)__float_as_uint(src[i]) << 32) | (unsigned long long)(0xFFFFFFFFu - (unsigned)i);
        __syncthreads();
        for (int k = 2; k <= SEQ; k <<= 1)
            for (int j = k >> 1; j > 0; j >>= 1) {
                for (int t = tid; t < SEQ / 2; t += NTHR) { const int i = ((t & ~(j - 1)) << 1) | (t & (j - 1)), ixj = i | j; const bool desc = (i & k) == 0;
                    const unsigned long long x = a[i], y = a[ixj]; if ((x < y) == desc) { a[i] = y; a[ixj] = x; } }
                __syncthreads();
            }
        for (int s = tid; s < CAP; s += NTHR) { const unsigned long long x = a[s]; const int idx = (int)(0xFFFFFFFFu - (unsigned)(x & 0xFFFFFFFFull)); const float gt = __uint_as_float((unsigned)(x >> 32));
            const int r = (e * NB + b) * CAP + s; topi[r] = b * SEQ + idx; topg[r] = gt; slot[(size_t)(b * SEQ + idx) * NE + e] = s; }
        __syncthreads();
    }
}

__device__ __forceinline__ void ph_gather(const Params& p, int bid, int nblk) {
    int tid_ = threadIdx.x; asm volatile("" : "+v"(tid_));
    const int tid = tid_, lane = tid & 63, wave = tid >> 6, gw = bid * 8 + wave, NGW = nblk * 8;
    const bf16_t* H = (const bf16_t*)(p.ws + WS_H); bf16_t* XG = (bf16_t*)(p.ws + WS_XG); const int* topi = (const int*)(p.ws + WS_TOPI);
    for (int r = gw; r < NSLOT; r += NGW) { const int src = topi[r];
        const u32x4* s = (const u32x4*)(H + (size_t)src * DM); u32x4* d = (u32x4*)(XG + (size_t)r * DM);
        d[lane] = s[lane]; d[64 + lane] = s[64 + lane]; }
}

__device__ __forceinline__ void ph_combine(const Params& p, int bid, int nblk, int l, bool final_) {
    int tid_ = threadIdx.x; asm volatile("" : "+v"(tid_));
    const int tid = tid_, lane = tid & 63, wave = tid >> 6, gw = bid * 8 + wave, NGW = nblk * 8;
    float* X = (float*)(p.ws + WS_X); bf16_t* H = (bf16_t*)(p.ws + WS_H); const float* Y = (const float*)(p.ws + WS_Y); const int* slot = (const int*)(p.ws + WS_SLOT);
    const float* mod = (const float*)(p.ws + WS_MOD);
    for (int row = gw; row < NTOK; row += NGW) {
        const int b = row >> 13;
        const float* g2 = mod + (size_t)(l * 3 + b) * NADA + 5 * DM;
        f32x4 a[4];
#pragma unroll
        for (int j = 0; j < 4; ++j) a[j] = (f32x4){0.f, 0.f, 0.f, 0.f};
        const int myslot = lane < 16 ? slot[(size_t)row * NE + lane] : -1;
        for (int e = 0; e < NE; ++e) { const int s = __shfl(myslot, e);
            if (s >= 0) { const float* yr = Y + (size_t)((e * NB + b) * CAP + s) * DM;
#pragma unroll
                for (int j = 0; j < 4; ++j) a[j] = a[j] + *(const f32x4*)(yr + 256 * j + 4 * lane); } }
        f32x4 v[4]; float ss = 0.f;
#pragma unroll
        for (int j = 0; j < 4; ++j) { const int c0 = 256 * j + 4 * lane; v[j] = *(const f32x4*)(X + (size_t)row * DM + c0) + *(const f32x4*)(g2 + c0) * a[j];
            ss += (v[j][0] * v[j][0] + v[j][1] * v[j][1]) + (v[j][2] * v[j][2] + v[j][3] * v[j][3]); }
        const float rstd = 1.f / sqrtf(wave_sum(ss) * (1.f / DM) + 1e-6f);
        if (final_) { const float* gf = p.in[I_NFIN];
#pragma unroll
            for (int j = 0; j < 4; ++j) { const int c0 = 256 * j + 4 * lane; const f32x4 gv = *(const f32x4*)(gf + c0); *(f32x4*)(p.out + (size_t)row * DM + c0) = v[j] * rstd * gv; }
        } else {
#pragma unroll
            for (int j = 0; j < 4; ++j) *(f32x4*)(X + (size_t)row * DM + 256 * j + 4 * lane) = v[j];
            const float* mv = mod + (size_t)((l + 1) * 3 + b) * NADA;
            store_mod_bf16(H + (size_t)row * DM, v, rstd, p.in[I_NMIX] + (size_t)(l + 1) * DM, mv, mv + DM, lane);
        }
    }
}

__device__ __forceinline__ void ph_conv(const Params& p, int bid, int nblk) {
    int tid_ = threadIdx.x; asm volatile("" : "+v"(tid_));
    const int tid = tid_, lane = tid & 63, wave = tid >> 6, gw = bid * 8 + wave, NGW = nblk * 8;
    const bf16_t* BG = (const bf16_t*)(p.ws + WS_BG); const bf16_t* CU = (const bf16_t*)(p.ws + WS_CU); bf16_t* Z = (bf16_t*)(p.ws + WS_Z);
    const float* wc = p.in[I_SCCONV];
    for (int row = gw; row < NTOK; row += NGW) { const int t = row & (SEQ - 1);
#pragma unroll
        for (int hh = 0; hh < 2; ++hh) { const int c0 = hh * 512 + 8 * lane; const size_t off = (size_t)row * DM + c0;
            const u16x8 z0 = {0, 0, 0, 0, 0, 0, 0, 0};
            const u16x8 um = t > 0 ? *(const u16x8*)(CU + off - DM) : z0, u0 = *(const u16x8*)(CU + off), up = t < SEQ - 1 ? *(const u16x8*)(CU + off + DM) : z0, bg = *(const u16x8*)(BG + off);
            float o[8];
#pragma unroll
            for (int i = 0; i < 8; ++i) o[i] = bf2f(bg[i]) * (wc[c0 + i] * bf2f(um[i]) + wc[DM + c0 + i] * bf2f(u0[i]) + wc[2 * DM + c0 + i] * bf2f(up[i]));
            u32x4 w; w.x = pk2(o[0], o[1]); w.y = pk2(o[2], o[3]); w.z = pk2(o[4], o[5]); w.w = pk2(o[6], o[7]); *(u32x4*)(Z + off) = w; }
    }
}

#define XB_TMO      128
#define XB_XCNT(j)  (256  + 64 * (j))
#define XB_XSUB(j)  (1280 + 64 * (j))
#define XB_XGEN(j)  (2304 + 64 * (j))
#define XB_TOP      3328
#define XB_TOPGEN   3392
#define XCD_BAR_WORDS 3456
#define XB_SPIN_CAP (1u << 18)
__device__ __forceinline__ unsigned xb_ld(unsigned* p)              { return __hip_atomic_load(p, __ATOMIC_RELAXED, __HIP_MEMORY_SCOPE_AGENT); }
__device__ __forceinline__ unsigned xb_add(unsigned* p, unsigned v) { return __hip_atomic_fetch_add(p, v, __ATOMIC_RELAXED, __HIP_MEMORY_SCOPE_AGENT); }
__device__ __forceinline__ unsigned xb_xcc_id() { return (unsigned)__builtin_amdgcn_s_getreg((3 << 11) | 20) & 0xFu; }
#define XB_SPIN(cond, bar) do { unsigned _sp = 0; while (cond) { __builtin_amdgcn_s_sleep(1); \
    if ((++_sp & 255u) == 0u) { if (xb_ld(&(bar)[XB_TMO])) break; if (_sp > XB_SPIN_CAP) { atomicAdd(&(bar)[XB_TMO], 1u); break; } } } } while (0)
struct XcdBarrier { unsigned* bar; unsigned x; volatile LAS unsigned* st; };
__device__ __forceinline__ XcdBarrier xcd_barrier_post(unsigned* bar, volatile LAS unsigned* st) {
    XcdBarrier b; b.bar = bar; b.x = xb_xcc_id(); b.st = st;
    if (threadIdx.x == 0) (void)xb_add(&bar[XB_XCNT(b.x)], 1u);
    return b;
}
__device__ __forceinline__ void xcd_barrier_complete(unsigned* bar, unsigned x, unsigned& nloc, unsigned& nx) {
    const unsigned G = gridDim.x * gridDim.y * gridDim.z;
    unsigned sum, cnt, mine, sp = 0u;
    for (;;) {
        sum = 0u; cnt = 0u; mine = 0u;
#pragma unroll
        for (unsigned j = 0; j < 16; ++j) { const unsigned c = xb_ld(&bar[XB_XCNT(j)]); sum += c; cnt += (c > 0u) ? 1u : 0u; mine = (j == x) ? c : mine; }
        if (sum == G) break;
        __builtin_amdgcn_s_sleep(1);
        if ((++sp & 255u) == 0u) { if (xb_ld(&bar[XB_TMO])) break; if (sp > XB_SPIN_CAP) { atomicAdd(&bar[XB_TMO], 1u); break; } }
    }
    nloc = mine > 0u ? mine : 1u; nx = cnt > 0u ? cnt : 1u;
}
__device__ __forceinline__ void xcd_barrier(unsigned* bar_, volatile LAS unsigned* st_) {
    XcdBarrier b; b.bar = bar_; b.x = xb_xcc_id(); b.st = st_;
    asm volatile("s_waitcnt vmcnt(0)" ::: "memory");
    __syncthreads();
    if (threadIdx.x == 0) {
        unsigned* bar = b.bar;
        __builtin_amdgcn_s_waitcnt(0);
        unsigned nloc = b.st[0], nx = b.st[1];
        if (nloc == 0u) { xcd_barrier_complete(bar, b.x, nloc, nx); b.st[0] = nloc; b.st[1] = nx; }
        const unsigned old = xb_add(&bar[XB_XSUB(b.x)], 1u);
        const unsigned gen = old / nloc;
        if (old + 1u == (gen + 1u) * nloc) {
            __builtin_amdgcn_fence(__ATOMIC_RELEASE, "agent");
            asm volatile("s_waitcnt vmcnt(0)" ::: "memory");
            const unsigned og = xb_add(&bar[XB_TOP], 1u);
            const unsigned tg = og / nx;
            if (og + 1u == (tg + 1u) * nx) xb_add(&bar[XB_TOPGEN], 1u);
            else XB_SPIN(xb_ld(&bar[XB_TOPGEN]) == tg, bar);
            __builtin_amdgcn_fence(__ATOMIC_ACQUIRE, "agent");
            xb_add(&bar[XB_XGEN(b.x)], 1u);
            asm volatile("s_waitcnt vmcnt(0)" ::: "memory");
        } else {
            XB_SPIN(xb_ld(&bar[XB_XGEN(b.x)]) == gen, bar);
            __builtin_amdgcn_fence(__ATOMIC_ACQUIRE, "agent");
            asm volatile("s_waitcnt vmcnt(0)" ::: "memory");
        }
    }
    __syncthreads();
}

constexpr int NPHASE = 22;
constexpr int MISC_OFF = 131072 + 320;
constexpr int CW_BAR = 4096;
template <int LO, int HI> __global__ void __launch_bounds__(NTHR, 2) mega(Params p) {
    extern __shared__ __attribute__((aligned(16))) unsigned char lds[];
    const int bid = blockIdx.x, nblk = gridDim.x;
    PG8_LAS unsigned char* l3 = (PG8_LAS unsigned char*)lds;
    unsigned char* ws = p.ws;
    const float* mod = (const float*)(ws + WS_MOD);
    constexpr bool MULTI = (HI - LO) > 1;
    if (MULTI) {
        volatile LAS unsigned* MISC = (volatile LAS unsigned*)(l3 + MISC_OFF);
        if (threadIdx.x < 32) MISC[threadIdx.x] = 0u;
        __syncthreads();
        (void)xcd_barrier_post((unsigned*)(ws + WS_CTL) + CW_BAR, MISC + 8);
    }
#define IN(k) (LO <= (k) && (k) < HI)
#ifndef PROBE_DUP
#define PROBE_DUP 0u
#endif
#define DUPQ(k) (((PROBE_DUP) >> (k)) & 1u)
#define BARRIER_NOW() xcd_barrier((unsigned*)(p.ws + WS_CTL) + CW_BAR, (volatile LAS unsigned*)(l3 + MISC_OFF) + 8)
#define SEAM(k) do { if (IN(k) && IN((k) + 1)) xcd_barrier((unsigned*)(p.ws + WS_CTL) + CW_BAR, (volatile LAS unsigned*)(l3 + MISC_OFF) + 8); } while (0)
    if (IN(0)) ph_prep(p, lds, bid, nblk);
    SEAM(0);
    if (IN(1)) { ph_convert(p, lds, bid, nblk); if (DUPQ(1)) { BARRIER_NOW(); ph_convert(p, lds, bid, nblk); } }
    SEAM(1);
    if (IN(2)) ph_mod0(p, bid, nblk);
    SEAM(2);
    if (IN(3)) { pg8::Gemm g{(const bf16_t*)(ws + WS_H), (const bf16_t*)(ws + WS_WHGIN), NROW, 5120, DM}; pg8::StaticOrder S; S.init(NROW, 5120, nblk, bid, 0);
        EpiInProj E{ws};
        pg8::gemm_phase<EpiInProj>(l3, g, S, E); }
    SEAM(3);
#if defined(GLA_SIMPLE)
    if (IN(4)) ph_gla_simple(p, lds, bid, nblk);
    SEAM(4);
    if (IN(5)) ph_onorm(p, bid, nblk);
#else
    if (IN(4)) ph_gla_states(p, lds, bid, nblk);
    SEAM(4);
    if (IN(5)) { ph_gla_out(p, lds, bid, nblk); if (DUPQ(5)) { BARRIER_NOW(); ph_gla_out(p, lds, bid, nblk); } }
#endif
    SEAM(5);
    if (IN(6)) { pg8::Gemm g{(const bf16_t*)(ws + WS_ON), (const bf16_t*)(ws + WS_WHGOUT), NTOK, DM, DM}; pg8::StaticOrder S; S.init(NTOK, DM, nblk, bid, 0);
        EpiResid E{(float*)(ws + WS_X), mod + 2 * DM}; pg8::gemm_phase<EpiResid>(l3, g, S, E); }
    SEAM(6);
#define MOE_BLOCK(l, P0) \
    if (IN(P0)) ph_modffn(p, lds, bid, nblk, l); \
    SEAM(P0); \
    if (IN(P0 + 1)) ph_topk(p, lds, bid, nblk); \
    SEAM(P0 + 1); \
    if (IN(P0 + 2)) ph_gather(p, bid, nblk); \
    SEAM(P0 + 2); \
    if (IN(P0 + 3)) { pg8::Gemm g{(const bf16_t*)(ws + WS_XG), (const bf16_t*)(ws + WS_WMOE1) + (size_t)l * NE * 4096 * DM, NSLOT, 4096, DM}; pg8::StaticOrder S; S.init(NSLOT, 4096, nblk, bid, 8); \
        EpiGLU E{(bf16_t*)(ws + WS_ACT)}; pg8::gemm_phase<EpiGLU>(l3, g, S, E); } \
    SEAM(P0 + 3); \
    if (IN(P0 + 4)) { pg8::Gemm g{(const bf16_t*)(ws + WS_ACT), (const bf16_t*)(ws + WS_WMOE2) + (size_t)l * NE * DM * DE, NSLOT, DM, DE}; pg8::StaticOrder S; S.init(NSLOT, DM, nblk, bid, 8); \
        EpiRowScale E{(float*)(ws + WS_Y), (const float*)(ws + WS_TOPG)}; pg8::gemm_phase<EpiRowScale>(l3, g, S, E); } \
    SEAM(P0 + 4);
    MOE_BLOCK(0, 7)
    if (IN(12)) ph_combine(p, bid, nblk, 0, false);
    SEAM(12);
    if (IN(13)) { pg8::Gemm g{(const bf16_t*)(ws + WS_H), (const bf16_t*)(ws + WS_WSCIN), NTOK, 3072, DM}; pg8::StaticOrder S; S.init(NTOK, 3072, nblk, bid, 0);
        EpiConvIn E{(bf16_t*)(ws + WS_BG), (bf16_t*)(ws + WS_CU)}; pg8::gemm_phase<EpiConvIn>(l3, g, S, E); }
    SEAM(13);
    if (IN(14)) ph_conv(p, bid, nblk);
    SEAM(14);
    if (IN(15)) { pg8::Gemm g{(const bf16_t*)(ws + WS_Z), (const bf16_t*)(ws + WS_WSCOUT), NTOK, DM, DM}; pg8::StaticOrder S; S.init(NTOK, DM, nblk, bid, 0);
        EpiResid E{(float*)(ws + WS_X), mod + (size_t)3 * NADA + 2 * DM}; pg8::gemm_phase<EpiResid>(l3, g, S, E); }
    SEAM(15);
    MOE_BLOCK(1, 16)
#undef MOE_BLOCK
    if (IN(21)) ph_combine(p, bid, nblk, 1, true);
#undef IN
#undef SEAM
}

#ifndef MK_SPLIT
#define MK_SPLIT 0
#endif
#if MK_SPLIT
#include <utility>
template <int... I> static void launch_all(std::integer_sequence<int, I...>, int grid, Params& p, hipStream_t stream) {
    ((void)hipFuncSetAttribute((const void*)mega<I, I + 1>, hipFuncAttributeMaxDynamicSharedMemorySize, LDS_BYTES), ...);
    ((mega<I, I + 1><<<dim3(grid), dim3(NTHR), LDS_BYTES, stream>>>(p)), ...); }
#endif
extern "C" void kernel_launch(void* const* d_in, const int* in_sizes, int n_in, void* d_out, int out_size, void* d_ws, size_t ws_size, hipStream_t stream) {
    static int grid = 0;
    if (grid == 0) {
        if (n_in != 20 || ws_size < WS_END) { fprintf(stderr, "kernel_launch: unexpected inputs (n_in %d, ws %zu, need %zu)\n", n_in, ws_size, (size_t)WS_END); grid = -1; return; }
        int dev = 0, cus = 0, per_cu = 0;
        (void)hipGetDevice(&dev); (void)hipDeviceGetAttribute(&cus, hipDeviceAttributeMultiprocessorCount, dev);
        (void)hipFuncSetAttribute((const void*)mega<0, NPHASE>, hipFuncAttributeMaxDynamicSharedMemorySize, LDS_BYTES);
        if (hipOccupancyMaxActiveBlocksPerMultiprocessor(&per_cu, (const void*)mega<0, NPHASE>, NTHR, LDS_BYTES) != hipSuccess || per_cu < 1) { fprintf(stderr, "kernel_launch: occupancy query failed (%d)\n", per_cu); per_cu = 1; }
        (void)hipGetLastError();
        if (per_cu > 1) per_cu = 1;
        grid = (cus > 0 ? cus : 256) * per_cu;
    }
    if (grid < 0) return;
    Params p{};
    for (int i = 0; i < 20; ++i) p.in[i] = (const float*)d_in[i];
    p.out = (float*)d_out; p.ws = (unsigned char*)d_ws;
#if MK_SPLIT
    launch_all(std::make_integer_sequence<int, NPHASE>{}, grid, p, stream);
#else
    (void)hipMemsetAsync((char*)d_ws + WS_CTL, 0, 65536, stream);
    void* args[] = {&p};
    hipError_t e = hipLaunchCooperativeKernel((const void*)mega<0, NPHASE>, dim3(grid), dim3(NTHR), args, LDS_BYTES, stream);
    if (e != hipSuccess) fprintf(stderr, "kernel_launch: cooperative launch failed: %s (grid %d)\n", hipGetErrorString(e), grid);
#endif
}
```

```cpp
#include <hip/hip_runtime.h>
#include <cstdio>
#include <cstdint>

namespace pg8 {
#define PG8_LAS __attribute__((address_space(3)))
typedef unsigned short bf16_t;
typedef short bf16x8 __attribute__((ext_vector_type(8)));
typedef float f32x4 __attribute__((ext_vector_type(4)));
typedef unsigned u32x4 __attribute__((ext_vector_type(4)));
typedef unsigned u32x2 __attribute__((ext_vector_type(2)));
constexpr int BM = 256, BK = 64, HALF = 128, HTB = HALF * BK * 2, STAGE_BYTES = 8 * HTB, NXCD = 8, WGM = 8;

__host__ __device__ __forceinline__ int lds_byte(int r, int c) { const int st = (r >> 4) * 2 + (c >> 5), rr = r & 15, cc = c & 31, ob = rr * 64 + cc * 2; return st * 1024 + (ob ^ (((ob >> 9) & 1) << 5)); }
__host__ __device__ __forceinline__ void stage_rc(int b, int& R, int& C) { const int st = b / 1024, sb = b % 1024, swz = sb ^ (((sb >> 9) & 1) << 5); R = (st >> 1) * 16 + swz / 64; C = (st & 1) * 32 + (swz % 64) / 2; }
__host__ __device__ __forceinline__ int perm32(int rho) { const int n = rho >> 4, i = rho & 15; return 8 * (i >> 2) + 4 * n + (i & 3); }

struct Unit { int pm, pn, pb; };
struct Gemm { const bf16_t* A; const bf16_t* Bt; int M, N, K; };

struct StaticOrder {
    int nM, nN, nwg, G, c, mpe;
    __device__ void init(int M, int N, int G_, int c_, int mpe_) { nM = M / BM; nN = N / BM; nwg = nM * nN; G = G_; c = c_; mpe = mpe_; }
    __device__ bool next(int i, Unit& u) const {
        const long L = (long)i * G + c; if (L >= nwg) return false;
        int wgid = (int)L; { const int q = nwg / NXCD, r = nwg % NXCD, xcd = wgid % NXCD, off = wgid / NXCD; wgid = (xcd < r ? xcd * (q + 1) : r * (q + 1) + (xcd - r) * q) + off; }
        const int nig = WGM * nN, gid = wgid / nig, fm = gid * WGM, gsz = (nM - fm) < WGM ? (nM - fm) : WGM;
        u.pm = fm + ((wgid % nig) % gsz); u.pn = (wgid % nig) / gsz; u.pb = mpe > 0 ? (u.pm / mpe) * nN + u.pn : u.pn; return true;
    }
};

__device__ __forceinline__ unsigned cvt_pk_bf16(float lo, float hi) { unsigned r; asm volatile("v_cvt_pk_bf16_f32 %0, %1, %2" : "=v"(r) : "v"(lo), "v"(hi)); return r; }

template <class Epi>
__device__ __forceinline__ void gemm_phase(PG8_LAS unsigned char* lds, const Gemm g, const StaticOrder& S, const Epi& E) {
    int tid_ = threadIdx.x; asm volatile("" : "+v"(tid_));
    const int tid = tid_, wid = __builtin_amdgcn_readfirstlane(tid >> 6), lane = tid & 63, wr = wid >> 2, wc = wid & 3, fr = lane & 15, fq = lane >> 4;
    const int K = g.K, nt = K / BK;
    unsigned voffA[2], voffB[2];
#pragma unroll
    for (int i = 0; i < 2; ++i) { int R, C; stage_rc(tid * 16 + i * 8192, R, C); const int Rb = Epi::PERM ? ((R & ~31) + perm32(R & 31)) : R;
        voffA[i] = (unsigned)(R * K + C) * 2u; voffB[i] = (unsigned)(Rb * K + C) * 2u; }
    const size_t kstep = (size_t)(BK * 2);
    const size_t hstep = (size_t)HALF * K * 2;
    const size_t tstep = 2 * hstep;
    const unsigned ldsw = (unsigned)wid * 1024u;
    const int aoff = lds_byte(wr * 64 + fr, fq * 8), boff = lds_byte(wc * 32 + fr, fq * 8);
#define PG8_SA(b, h) (((b) * 2 + (h)) * HTB)
#define PG8_SB(b, h) ((4 + (b) * 2 + (h)) * HTB)
#define PG8_STAGE(bufoff, gbase, voff) do { _Pragma("unroll") for (int _i = 0; _i < 2; ++_i) \
        __builtin_amdgcn_global_load_lds((const unsigned*)((const char*)(gbase) + (voff)[_i]), (PG8_LAS unsigned*)(lds + (bufoff) + ldsw + _i * 8192), 16, 0, 0); } while (0)
#define PG8_LDA(dst, b, h) do { _Pragma("unroll") for (int m = 0; m < 4; ++m) _Pragma("unroll") for (int k = 0; k < 2; ++k) dst[m][k] = *(const PG8_LAS bf16x8*)(lds + PG8_SA(b, h) + aoff + m * 2048 + k * 1024); } while (0)
#define PG8_LDB(dst, b, h) do { _Pragma("unroll") for (int n = 0; n < 2; ++n) _Pragma("unroll") for (int k = 0; k < 2; ++k) dst[n][k] = *(const PG8_LAS bf16x8*)(lds + PG8_SB(b, h) + boff + n * 2048 + k * 1024); } while (0)
#define PG8_MMA(ai, bj, At, Bt) do { __builtin_amdgcn_s_setprio(1); _Pragma("unroll") for (int m = 0; m < 4; ++m) _Pragma("unroll") for (int n = 0; n < 2; ++n) _Pragma("unroll") for (int k = 0; k < 2; ++k) \
        acc[ai][bj][m][n] = __builtin_amdgcn_mfma_f32_16x16x32_bf16(Bt[n][k], At[m][k], acc[ai][bj][m][n], 0, 0, 0); __builtin_amdgcn_s_setprio(0); } while (0)
#define PG8_WAIT_V(n) asm volatile("s_waitcnt vmcnt(" #n ")" ::: "memory")
#define PG8_WAIT_L(n) asm volatile("s_waitcnt lgkmcnt(" #n ")" ::: "memory")
#define PG8_BAR __builtin_amdgcn_s_barrier()
#define PG8_SCHED __builtin_amdgcn_sched_barrier(0)
    Unit cur, nxt; int ui = 0;
    if (!S.next(0, cur)) return;
    f32x4 acc[2][2][4][2];
#pragma unroll
    for (int a = 0; a < 2; ++a)
#pragma unroll
        for (int b = 0; b < 2; ++b)
#pragma unroll
            for (int m = 0; m < 4; ++m)
#pragma unroll
                for (int n = 0; n < 2; ++n) acc[a][b][m][n] = (f32x4){0.f, 0.f, 0.f, 0.f};
    bf16x8 At[4][2], B0[2][2], B1[2][2];
    const char* cA = (const char*)g.A + (size_t)cur.pm * tstep; const char* cB = (const char*)g.Bt + (size_t)cur.pb * tstep;
    PG8_STAGE(PG8_SB(0, 0), cB, voffB); PG8_STAGE(PG8_SB(0, 1), cB + hstep, voffB); PG8_STAGE(PG8_SA(0, 0), cA, voffA); PG8_STAGE(PG8_SA(0, 1), cA + hstep, voffA);
    if (wr == 1) PG8_BAR;
    PG8_WAIT_V(2); PG8_BAR;
    PG8_STAGE(PG8_SB(1, 0), cB + kstep, voffB); PG8_STAGE(PG8_SA(1, 0), cA + kstep, voffA); PG8_STAGE(PG8_SB(1, 1), cB + hstep + kstep, voffB);
    PG8_WAIT_V(6); PG8_BAR;
    for (;;) {
        const bool has_next = S.next(ui + 1, nxt);
        const char* nA = has_next ? (const char*)g.A + (size_t)nxt.pm * tstep : cA; const char* nB = has_next ? (const char*)g.Bt + (size_t)nxt.pb * tstep : cB;
        for (int t = 0; t < nt; t += 2) {
            const bool last = (t == nt - 2);
            const char* a1 = cA + (size_t)(t + 1) * kstep;
            const char* a2 = last ? nA : cA + (size_t)(t + 2) * kstep; const char* b2 = last ? nB : cB + (size_t)(t + 2) * kstep;
            const char* a3 = a2 + kstep; const char* b3 = b2 + kstep;
            PG8_LDB(B0, 0, 0); PG8_LDB(B1, 0, 1); PG8_SCHED; PG8_LDA(At, 0, 0); PG8_STAGE(PG8_SA(1, 1), a1 + hstep, voffA);
            PG8_WAIT_V(8); PG8_WAIT_L(0); PG8_BAR; PG8_MMA(0, 0, At, B0); PG8_MMA(0, 1, At, B1); PG8_BAR; PG8_SCHED;
            PG8_LDA(At, 0, 1); PG8_STAGE(PG8_SB(0, 0), b2, voffB); PG8_STAGE(PG8_SB(0, 1), b2 + hstep, voffB); PG8_STAGE(PG8_SA(0, 0), a2, voffA);
            PG8_WAIT_V(8); PG8_WAIT_L(0); PG8_BAR; PG8_MMA(1, 0, At, B0); PG8_MMA(1, 1, At, B1); PG8_BAR; PG8_SCHED;
            PG8_LDB(B0, 1, 0); PG8_LDB(B1, 1, 1); PG8_SCHED; PG8_LDA(At, 1, 0); PG8_STAGE(PG8_SA(0, 1), a2 + hstep, voffA);
            PG8_WAIT_V(8); PG8_WAIT_L(0); PG8_BAR; PG8_MMA(0, 0, At, B0); PG8_MMA(0, 1, At, B1); PG8_BAR; PG8_SCHED;
            PG8_LDA(At, 1, 1); PG8_STAGE(PG8_SB(1, 0), b3, voffB); PG8_STAGE(PG8_SB(1, 1), b3 + hstep, voffB); PG8_STAGE(PG8_SA(1, 0), a3, voffA);
            PG8_WAIT_V(8); PG8_WAIT_L(0); PG8_BAR; PG8_MMA(1, 0, At, B0); PG8_MMA(1, 1, At, B1); PG8_BAR; PG8_SCHED;
        }
        if (wr == 0) PG8_BAR;
        E(acc, cur, wr, wc, fr, fq);
        if (!has_next) break;
#pragma unroll
        for (int a = 0; a < 2; ++a)
#pragma unroll
            for (int b = 0; b < 2; ++b)
#pragma unroll
                for (int m = 0; m < 4; ++m)
#pragma unroll
                    for (int n = 0; n < 2; ++n) acc[a][b][m][n] = (f32x4){0.f, 0.f, 0.f, 0.f};
        cur = nxt; cA = nA; cB = nB; ++ui;
        if (wr == 1) PG8_BAR;
    }
    PG8_WAIT_V(0);
    PG8_BAR;
#undef PG8_SA
#undef PG8_SB
#undef PG8_STAGE
#undef PG8_LDA
#undef PG8_LDB
#undef PG8_MMA
#undef PG8_WAIT_V
#undef PG8_WAIT_L
#undef PG8_BAR
#undef PG8_SCHED
}
}

#define LAS __attribute__((address_space(3)))
using pg8::bf16_t; using pg8::f32x4; using pg8::u32x4; using pg8::u32x2;
typedef unsigned short u16x8 __attribute__((ext_vector_type(8)));
typedef float f32x2 __attribute__((ext_vector_type(2)));

constexpr int DM = 1024, NB = 2, SEQ = 8192, NTOK = NB * SEQ, CTXL = 256, NCTX = NB * CTXL, NROW = NTOK + NCTX;
constexpr int NE = 16, CAP = 1024, DE = 2048, NSLOT = NE * NB * CAP;
constexpr int NADA = 6 * DM;
constexpr int NTHR = 512;

constexpr size_t MiB = 1u << 20;
constexpr size_t WS_CTL = 0;
constexpr size_t WS_MOD = 1 * MiB;
constexpr size_t WS_LB = WS_MOD + 256 * 1024;
constexpr size_t WS_POSR = WS_LB + 64 * 1024;
constexpr size_t WS_POSC = WS_POSR + 256 * 1024;
constexpr size_t WS_AFF = 2 * MiB;
constexpr size_t WS_TOPI = 3 * MiB;
constexpr size_t WS_TOPG = WS_TOPI + 128 * 1024;
constexpr size_t WS_SLOT = 4 * MiB;
constexpr size_t WS_WHGIN = 6 * MiB;
constexpr size_t WS_WHGOUT = 16 * MiB;
constexpr size_t WS_WSCIN = 18 * MiB;
constexpr size_t WS_WSCOUT = 24 * MiB;
constexpr size_t WS_WMOE1 = 26 * MiB;
constexpr size_t WS_WMOE2 = WS_WMOE1 + 256 * MiB;
constexpr size_t WS_X = WS_WMOE2 + 128 * MiB;
constexpr size_t WS_H = WS_X + 64 * MiB;
constexpr size_t WS_R = WS_H + 34 * MiB;
constexpr size_t WS_Q = WS_R;
constexpr size_t WS_V = WS_Q + 34 * MiB;
constexpr size_t WS_G = WS_V + 34 * MiB;
constexpr size_t WS_LF = WS_G + 34 * MiB;
constexpr size_t WS_LBK = WS_LF + 66 * MiB;
constexpr size_t WS_OF = WS_LBK + 66 * MiB;
constexpr size_t WS_OB = WS_OF + 64 * MiB;
constexpr size_t WS_U = WS_OB;
constexpr size_t WS_DD = WS_OB + 40 * MiB;
constexpr size_t WS_ON = WS_OB + 64 * MiB;
constexpr size_t WS_HG_END = WS_ON + 32 * MiB;
constexpr size_t WS_XG = WS_R;
constexpr size_t WS_ACT = WS_XG + 64 * MiB;
constexpr size_t WS_Y = WS_ACT + 128 * MiB;
constexpr size_t WS_MOE_END = WS_Y + 128 * MiB;
constexpr size_t WS_BG = WS_R;
constexpr size_t WS_CU = WS_BG + 32 * MiB;
constexpr size_t WS_Z = WS_CU + 32 * MiB;
constexpr size_t WS_END = WS_HG_END > WS_MOE_END ? WS_HG_END : WS_MOE_END;
static_assert(WS_END <= 1024 * MiB, "workspace map exceeds 1 GiB");

constexpr int LDS_BYTES = 135168;

struct Params { const float* in[20]; float* out; unsigned char* ws; int ph_lo, ph_hi; };
enum { I_X = 0, I_C, I_CTX, I_CCTX, I_ADAW, I_ADAB, I_NMIX, I_NFFN, I_NFIN, I_HGWIN, I_HGLB, I_HGNORM, I_HGWOUT, I_SCWIN, I_SCCONV, I_SCWOUT, I_ROUTER, I_WGATE, I_WUP, I_WDOWN };

__device__ __forceinline__ unsigned f2bf(float f) { unsigned u = __builtin_bit_cast(unsigned, f); return (u + 0x7fffu + ((u >> 16) & 1u)) >> 16; }
__device__ __forceinline__ unsigned pk2(float lo, float hi) { return f2bf(lo) | (f2bf(hi) << 16); }
__device__ __forceinline__ float bf2f(unsigned short h) { return __builtin_bit_cast(float, (unsigned)h << 16); }
__device__ __forceinline__ float wave_sum(float v) {
#pragma unroll
    for (int o = 1; o < 64; o <<= 1) v += __shfl_xor(v, o);
    return v;
}
__device__ __forceinline__ float sigmoidf_(float x) { return 1.f / (1.f + expf(-x)); }
__device__ __forceinline__ float siluf_(float x) { return x / (1.f + expf(-x)); }

struct EpiInProj {
    static constexpr bool PERM = false;
    unsigned char* ws;
    __device__ __forceinline__ void operator()(const f32x4 (&acc)[2][2][4][2], const pg8::Unit& u, int wr, int wc, int fr, int fq) const {
        const int sec = u.pn >> 2;
        const int row0 = u.pm * 256 + wr * 64 + fr, cb = (u.pn & 3) * 256 + wc * 32 + 4 * fq;
        if (sec == 0 || sec == 1 || sec == 4) {
            bf16_t* O = (bf16_t*)(ws + (sec == 0 ? WS_Q : (sec == 1 ? WS_V : WS_G)));
#pragma unroll
            for (int ai = 0; ai < 2; ++ai)
#pragma unroll
                for (int m = 0; m < 4; ++m) { bf16_t* rp = O + (size_t)(row0 + ai * 128 + m * 16) * DM + cb;
#pragma unroll
                    for (int bj = 0; bj < 2; ++bj)
#pragma unroll
                        for (int n = 0; n < 2; ++n) { f32x4 v = acc[ai][bj][m][n];
                            if (sec == 0) v = v * 0.08838834764831845f;
                            if (sec == 4) { v[0] = siluf_(v[0]); v[1] = siluf_(v[1]); v[2] = siluf_(v[2]); v[3] = siluf_(v[3]); }
                            u32x2 w; w.x = pk2(v[0], v[1]); w.y = pk2(v[2], v[3]); *(u32x2*)(rp + bj * 128 + n * 16) = w; } }
        } else {
            float* O = (float*)(ws + (sec == 2 ? WS_LF : WS_LBK)); const float* lb0 = (const float*)(ws + WS_LB);
            f32x4 lbv[2][2];
#pragma unroll
            for (int bj = 0; bj < 2; ++bj)
#pragma unroll
                for (int n = 0; n < 2; ++n) lbv[bj][n] = *(const f32x4*)(lb0 + cb + bj * 128 + n * 16);
#pragma unroll
            for (int ai = 0; ai < 2; ++ai)
#pragma unroll
                for (int m = 0; m < 4; ++m) { float* rp = O + (size_t)(row0 + ai * 128 + m * 16) * DM + cb;
#pragma unroll
                    for (int bj = 0; bj < 2; ++bj)
#pragma unroll
                        for (int n = 0; n < 2; ++n) { const f32x4 z = acc[ai][bj][m][n], lb = lbv[bj][n]; f32x4 o;
#pragma unroll
                            for (int i = 0; i < 4; ++i) o[i] = lb[i] + (1.f - lb[i]) * sigmoidf_(z[i]);
                            *(f32x4*)(rp + bj * 128 + n * 16) = o; } }
        }
    }
};
struct EpiResid {
    static constexpr bool PERM = false;
    float* X; const float* gate;
    __device__ __forceinline__ void operator()(const f32x4 (&acc)[2][2][4][2], const pg8::Unit& u, int wr, int wc, int fr, int fq) const {
        const int row0 = u.pm * 256 + wr * 64 + fr, cb = u.pn * 256 + wc * 32 + 4 * fq;
        const float* gp = gate + (size_t)((u.pm * 256) / SEQ) * NADA + cb;
        f32x4 gv[2][2];
#pragma unroll
        for (int bj = 0; bj < 2; ++bj)
#pragma unroll
            for (int n = 0; n < 2; ++n) gv[bj][n] = *(const f32x4*)(gp + bj * 128 + n * 16);
#pragma unroll
        for (int ai = 0; ai < 2; ++ai)
#pragma unroll
            for (int m = 0; m < 4; ++m) { float* rp = X + (size_t)(row0 + ai * 128 + m * 16) * DM + cb;
#pragma unroll
                for (int bj = 0; bj < 2; ++bj)
#pragma unroll
                    for (int n = 0; n < 2; ++n) { f32x4* q = (f32x4*)(rp + bj * 128 + n * 16); *q = *q + gv[bj][n] * acc[ai][bj][m][n]; } }
    }
};
struct EpiGLU {
    static constexpr bool PERM = true;
    bf16_t* ACT;
    __device__ __forceinline__ void operator()(const f32x4 (&acc)[2][2][4][2], const pg8::Unit& u, int wr, int wc, int fr, int fq) const {
        const int row0 = u.pm * 256 + wr * 64 + fr, cb = u.pn * 128 + wc * 32 + 8 * fq;
#pragma unroll
        for (int ai = 0; ai < 2; ++ai)
#pragma unroll
            for (int m = 0; m < 4; ++m) { bf16_t* rp = ACT + (size_t)(row0 + ai * 128 + m * 16) * DE + cb;
                f32x4 o[2];
#pragma unroll
                for (int n = 0; n < 2; ++n) { const f32x4 a = acc[ai][0][m][n], w = acc[ai][1][m][n];
#pragma unroll
                    for (int i = 0; i < 4; ++i) o[n][i] = siluf_(a[i]) * w[i]; }
                u32x4 w; w.x = pk2(o[0][0], o[0][1]); w.y = pk2(o[0][2], o[0][3]); w.z = pk2(o[1][0], o[1][1]); w.w = pk2(o[1][2], o[1][3]);
                *(u32x4*)rp = w; }
    }
};
struct EpiRowScale {
    static constexpr bool PERM = false;
    float* Y; const float* rg;
    __device__ __forceinline__ void operator()(const f32x4 (&acc)[2][2][4][2], const pg8::Unit& u, int wr, int wc, int fr, int fq) const {
        const int row0 = u.pm * 256 + wr * 64 + fr, cb = u.pn * 256 + wc * 32 + 4 * fq;
#pragma unroll
        for (int ai = 0; ai < 2; ++ai)
#pragma unroll
            for (int m = 0; m < 4; ++m) { const int row = row0 + ai * 128 + m * 16; const float gsc = rg[row]; float* rp = Y + (size_t)row * DM + cb;
#pragma unroll
                for (int bj = 0; bj < 2; ++bj)
#pragma unroll
                    for (int n = 0; n < 2; ++n) *(f32x4*)(rp + bj * 128 + n * 16) = acc[ai][bj][m][n] * gsc; }
    }
};
struct EpiConvIn {
    static constexpr bool PERM = true;
    bf16_t *BG, *CU;
    __device__ __forceinline__ void operator()(const f32x4 (&acc)[2][2][4][2], const pg8::Unit& u, int wr, int wc, int fr, int fq) const {
        const int row0 = u.pm * 256 + wr * 64 + fr;
        if (u.pn < 4) {
            const int cb = u.pn * 256 + wc * 32 + 8 * fq;
#pragma unroll
            for (int ai = 0; ai < 2; ++ai)
#pragma unroll
                for (int m = 0; m < 4; ++m) { bf16_t* rp = BG + (size_t)(row0 + ai * 128 + m * 16) * DM + cb;
#pragma unroll
                    for (int bj = 0; bj < 2; ++bj) { const f32x4 v0 = acc[ai][bj][m][0], v1 = acc[ai][bj][m][1];
                        u32x4 w; w.x = pk2(v0[0], v0[1]); w.y = pk2(v0[2], v0[3]); w.z = pk2(v1[0], v1[1]); w.w = pk2(v1[2], v1[3]);
                        *(u32x4*)(rp + bj * 128) = w; } }
        } else {
            const int cb = (u.pn - 4) * 128 + wc * 32 + 8 * fq;
#pragma unroll
            for (int ai = 0; ai < 2; ++ai)
#pragma unroll
                for (int m = 0; m < 4; ++m) { bf16_t* rp = CU + (size_t)(row0 + ai * 128 + m * 16) * DM + cb;
                    const f32x4 v0 = acc[ai][0][m][0] * acc[ai][1][m][0], v1 = acc[ai][0][m][1] * acc[ai][1][m][1];
                    u32x4 w; w.x = pk2(v0[0], v0[1]); w.y = pk2(v0[2], v0[3]); w.z = pk2(v1[0], v1[1]); w.w = pk2(v1[2], v1[3]);
                    *(u32x4*)rp = w; }
        }
    }
};

__device__ __forceinline__ void ph_prep(const Params& p, unsigned char* lds, int bid, int nblk) {
    float* sv = (float*)lds;
    float* red = sv + 3 * 1024;
    int tid_ = threadIdx.x; asm volatile("" : "+v"(tid_)); const int tid = tid_;
    const float* c = p.in[I_C]; const float* cctx = p.in[I_CCTX];
    for (int i = tid; i < 3 * 1024; i += NTHR) { const float v = (i < 2048) ? c[i] : cctx[i - 2048]; sv[i] = siluf_(v); }
    __syncthreads();
    const float* ada_w = p.in[I_ADAW]; const float* ada_b = p.in[I_ADAB];
    float* mod = (float*)(p.ws + WS_MOD);
    for (int it = bid; it < 96; it += nblk) {
        const int l = it / 48, j0 = (it % 48) * 128, col = tid & 127, ks = tid >> 7;
        const float* W = ada_w + (size_t)l * DM * NADA + j0 + col;
        float a0 = 0.f, a1 = 0.f, a2 = 0.f;
#pragma unroll 8
        for (int k = ks * 256; k < ks * 256 + 256; ++k) { const float w = W[(size_t)k * NADA]; a0 += sv[k] * w; a1 += sv[1024 + k] * w; a2 += sv[2048 + k] * w; }
        red[(ks * 3 + 0) * 128 + col] = a0; red[(ks * 3 + 1) * 128 + col] = a1; red[(ks * 3 + 2) * 128 + col] = a2;
        __syncthreads();
        if (tid < 384) { const int v = tid >> 7, cc = tid & 127;
            const float s = (red[(0 * 3 + v) * 128 + cc] + red[(1 * 3 + v) * 128 + cc]) + (red[(2 * 3 + v) * 128 + cc] + red[(3 * 3 + v) * 128 + cc]) + ada_b[l * NADA + j0 + cc];
            mod[(size_t)(l * 3 + v) * NADA + j0 + cc] = s; }
        __syncthreads();
    }
    const int gt = bid * NTHR + tid, NT = nblk * NTHR;
    const float* lg = p.in[I_HGLB]; float* lb0 = (float*)(p.ws + WS_LB);
    for (int d = gt; d < DM; d += NT) { const float l0 = lg[d], l1 = lg[DM + d], l2 = lg[2 * DM + d]; const float mx = fmaxf(l0, fmaxf(l1, l2));
        const float e0 = expf(l0 - mx), e1 = expf(l1 - mx), e2 = expf(l2 - mx); lb0[d] = e0 / (e0 + e1 + e2); }
    float* posr = (float*)(p.ws + WS_POSR);
    for (int i = gt; i < (128 + 64) * 512; i += NT) { const int pi = i >> 9, dd = i & 511; const int pos = pi < 128 ? pi : pi - 128; const int fi = dd & 255;
        const float om = exp2f(-(float)fi * (13.287712379549449f / 256.0f)); const float a = (float)pos * om; posr[i] = dd < 256 ? sinf(a) : cosf(a); }
}

__device__ __forceinline__ void transpose_item(const float* W, int N, bf16_t* WT, int K, float* scr, int k0, int n0, size_t drow0, int lane) {
#pragma unroll 8
    for (int i = 0; i < 32; ++i) { const int kk = 2 * i + (lane >> 5); scr[kk * 33 + (lane & 31)] = W[(size_t)(k0 + kk) * N + n0 + (lane & 31)]; }
    __builtin_amdgcn_s_waitcnt(0xc07f); asm volatile("" ::: "memory");
    const int c = lane & 7;
#pragma unroll
    for (int j = 0; j < 4; ++j) { const int n = (lane >> 3) + 8 * j; const float* s = scr + (8 * c) * 33 + n;
        u32x4 o; o.x = pk2(s[0 * 33], s[1 * 33]); o.y = pk2(s[2 * 33], s[3 * 33]); o.z = pk2(s[4 * 33], s[5 * 33]); o.w = pk2(s[6 * 33], s[7 * 33]);
        *(u32x4*)(WT + (drow0 + n) * K + k0 + 8 * c) = o; }
    __builtin_amdgcn_s_waitcnt(0xc07f); asm volatile("" ::: "memory");
}
__device__ __forceinline__ void ph_convert(const Params& p, unsigned char* lds, int bid, int nblk) {
    int tid_ = threadIdx.x; asm volatile("" : "+v"(tid_));
    const int tid = tid_, lane = tid & 63, wave = tid >> 6;
    float* scr = (float*)lds + wave * (64 * 33);
    const int gw = bid * 8 + wave, NGW = nblk * 8;
    constexpr int I_A = 16 * 160, I_B = 16 * 32, I_C_ = 16 * 96, I_D = 16 * 32, I_E = 32 * 1024, I_F = 32 * 1024, I_G = 32 * 1024;
    constexpr int NITEMS = I_A + I_B + I_C_ + I_D + I_E + I_F + I_G;
    for (int it = gw; it < NITEMS; it += NGW) {
        int r = it;
        if (r < I_A) { const int kb = r / 160, nb = r % 160; transpose_item(p.in[I_HGWIN], 5120, (bf16_t*)(p.ws + WS_WHGIN), 1024, scr, kb * 64, nb * 32, (size_t)nb * 32, lane); continue; } r -= I_A;
        if (r < I_B) { const int kb = r / 32, nb = r % 32; transpose_item(p.in[I_HGWOUT], 1024, (bf16_t*)(p.ws + WS_WHGOUT), 1024, scr, kb * 64, nb * 32, (size_t)nb * 32, lane); continue; } r -= I_B;
        if (r < I_C_) { const int kb = r / 96, nb = r % 96, n0 = nb * 32; size_t dr;
            if (n0 < 1024) dr = n0; else { const int np = n0 - 1024, sec = np >> 10, nn = np & 1023; dr = 1024 + (nn >> 7) * 256 + sec * 128 + (nn & 127); }
            transpose_item(p.in[I_SCWIN], 3072, (bf16_t*)(p.ws + WS_WSCIN), 1024, scr, kb * 64, n0, dr, lane); continue; } r -= I_C_;
        if (r < I_D) { const int kb = r / 32, nb = r % 32; transpose_item(p.in[I_SCWOUT], 1024, (bf16_t*)(p.ws + WS_WSCOUT), 1024, scr, kb * 64, nb * 32, (size_t)nb * 32, lane); continue; } r -= I_D;
        if (r < I_E + I_F) { const int up = r >= I_E; if (up) r -= I_E; const int le = r >> 10, q = r & 1023, kb = q >> 6, nb = q & 63, n0 = nb * 32;
            const size_t dr = (size_t)le * 4096 + (n0 >> 7) * 256 + up * 128 + (n0 & 127);
            transpose_item(p.in[up ? I_WUP : I_WGATE] + (size_t)le * 1024 * 2048, 2048, (bf16_t*)(p.ws + WS_WMOE1), 1024, scr, kb * 64, n0, dr, lane); continue; } r -= I_E + I_F;
        { const int le = r >> 10, q = r & 1023, kb = q >> 5, nb = q & 31, n0 = nb * 32;
            transpose_item(p.in[I_WDOWN] + (size_t)le * 2048 * 1024, 1024, (bf16_t*)(p.ws + WS_WMOE2), 2048, scr, kb * 64, n0, (size_t)le * 1024 + n0, lane); }
    }
}

__device__ __forceinline__ void store_mod_bf16(bf16_t* hrow, const f32x4 (&v)[4], float rstd, const float* g, const float* sh, const float* sc, int lane) {
#pragma unroll
    for (int j = 0; j < 4; ++j) { const int c0 = 256 * j + 4 * lane; const f32x4 gv = *(const f32x4*)(g + c0), shv = *(const f32x4*)(sh + c0), scv = *(const f32x4*)(sc + c0);
        f32x4 h;
#pragma unroll
        for (int i = 0; i < 4; ++i) h[i] = (v[j][i] * rstd * gv[i]) * (1.f + scv[i]) + shv[i];
        u32x2 w; w.x = pk2(h[0], h[1]); w.y = pk2(h[2], h[3]); *(u32x2*)(hrow + c0) = w; }
}
__device__ __forceinline__ void ph_mod0(const Params& p, int bid, int nblk) {
    int tid_ = threadIdx.x; asm volatile("" : "+v"(tid_));
    const int tid = tid_, lane = tid & 63, wave = tid >> 6, gw = bid * 8 + wave, NGW = nblk * 8;
    const float* x = p.in[I_X]; const float* ctx = p.in[I_CTX]; const float* g = p.in[I_NMIX];
    const float* mod = (const float*)(p.ws + WS_MOD); const float* posr = (const float*)(p.ws + WS_POSR); const float* posc = (const float*)(p.ws + WS_POSC);
    float* X = (float*)(p.ws + WS_X); bf16_t* H = (bf16_t*)(p.ws + WS_H);
    for (int row = gw; row < NROW; row += NGW) {
        f32x4 v[4]; float ss = 0.f; int vec;
        if (row < NTOK) { const int t = row & (SEQ - 1); vec = row >> 13; const float* pr = posr + (size_t)(t >> 6) * 512; const float* pc = posc + (size_t)(t & 63) * 512;
#pragma unroll
            for (int j = 0; j < 4; ++j) { const int c0 = 256 * j + 4 * lane; const f32x4 pv = *(const f32x4*)((j < 2 ? pr : pc) + (c0 & 511));
                v[j] = *(const f32x4*)(x + (size_t)row * DM + c0) + pv; *(f32x4*)(X + (size_t)row * DM + c0) = v[j]; }
        } else { vec = 2;
#pragma unroll
            for (int j = 0; j < 4; ++j) v[j] = *(const f32x4*)(ctx + (size_t)(row - NTOK) * DM + 256 * j + 4 * lane); }
#pragma unroll
        for (int j = 0; j < 4; ++j) ss += (v[j][0] * v[j][0] + v[j][1] * v[j][1]) + (v[j][2] * v[j][2] + v[j][3] * v[j][3]);
        const float rstd = 1.f / sqrtf(wave_sum(ss) * (1.f / DM) + 1e-6f);
        const float* mv = mod + (size_t)(0 * 3 + vec) * NADA;
        store_mod_bf16(H + (size_t)row * DM, v, rstd, g, mv, mv + DM, lane);
    }
}

__device__ __forceinline__ void ph_gla_simple(const Params& p, unsigned char* lds, int bid, int nblk) {
    float* qs = (float*)lds; float* fs = qs + 4096; float* ks = fs + 4096; float* vs = ks + 4096; float* part = vs + 1024;
    int tid_ = threadIdx.x; asm volatile("" : "+v"(tid_));
    const int tid = tid_, lane = tid & 63, wave = tid >> 6, kk = tid >> 5, vv = tid & 31;
    const bf16_t* Q = (const bf16_t*)(p.ws + WS_Q); const bf16_t* V = (const bf16_t*)(p.ws + WS_V);
    for (int unit = bid; unit < 128; unit += nblk) {
        const int vsl = unit & 3, dir = (unit >> 2) & 1, h = (unit >> 3) & 7, b = unit >> 6;
        const float* LFp = (const float*)(p.ws + (dir ? WS_LBK : WS_LF)); float* O = (float*)(p.ws + (dir ? WS_OB : WS_OF));
        float s[8];
#pragma unroll
        for (int i = 0; i < 8; ++i) s[i] = 0.f;
        for (int bt = 0; bt < 8 + 256; ++bt) {
            const bool isctx = bt < 8; const int nb = isctx ? bt : bt - 8, nbt = isctx ? 8 : 256;
            const int t0 = dir == 0 ? nb * 32 : (nbt - 1 - nb) * 32;
            const size_t rbase = isctx ? (size_t)(NTOK + b * CTXL + t0) : (size_t)(b * SEQ + t0);
            { const int r = tid >> 4, c8 = (tid & 15) * 8; const size_t off = (rbase + r) * DM + h * 128 + c8;
                const u16x8 qv = *(const u16x8*)(Q + off); const f32x4 l0 = *(const f32x4*)(LFp + off), l1 = *(const f32x4*)(LFp + off + 4);
#pragma unroll
                for (int i = 0; i < 8; ++i) { qs[r * 128 + c8 + i] = bf2f(qv[i]); const float f = i < 4 ? l0[i] : l1[i - 4]; fs[r * 128 + c8 + i] = f; ks[r * 128 + c8 + i] = 1.f - f; }
                if (tid < 128) { const int r2 = tid >> 2, c = (tid & 3) * 8; const u16x8 vv8 = *(const u16x8*)(V + (rbase + r2) * DM + h * 128 + vsl * 32 + c);
#pragma unroll
                    for (int i = 0; i < 8; ++i) vs[r2 * 32 + c + i] = bf2f(vv8[i]); } }
            __syncthreads();
            for (int jj = 0; jj < 32; ++jj) { const int j = dir ? 31 - jj : jj; const float vj = vs[j * 32 + vv]; float po = 0.f;
#pragma unroll
                for (int i = 0; i < 8; ++i) { const float f = fs[j * 128 + kk * 8 + i], k_ = ks[j * 128 + kk * 8 + i], q_ = qs[j * 128 + kk * 8 + i]; s[i] = f * s[i] + k_ * vj; po += q_ * s[i]; }
                po += __shfl_xor(po, 32);
                if (!isctx && lane < 32) part[(j * 8 + wave) * 32 + vv] = po; }
            __syncthreads();
            if (!isctx) { const int j = tid >> 4, v2 = (tid & 15) * 2; float o0 = 0.f, o1 = 0.f;
#pragma unroll
                for (int w = 0; w < 8; ++w) { o0 += part[(j * 8 + w) * 32 + v2]; o1 += part[(j * 8 + w) * 32 + v2 + 1]; }
                *(f32x2*)(O + (rbase + j) * DM + h * 128 + vsl * 32 + v2) = (f32x2){o0, o1}; }
        }
        __syncthreads();
    }
}

__device__ __forceinline__ void ph_onorm(const Params& p, int bid, int nblk) {
    int tid_ = threadIdx.x; asm volatile("" : "+v"(tid_));
    const int tid = tid_, lane = tid & 63, wave = tid >> 6, gw = bid * 8 + wave, NGW = nblk * 8;
    const float* OF = (const float*)(p.ws + WS_OF); const float* OB = (const float*)(p.ws + WS_OB); const bf16_t* G = (const bf16_t*)(p.ws + WS_G); bf16_t* ON = (bf16_t*)(p.ws + WS_ON);
    const float* ng = p.in[I_HGNORM];
    const f32x4 gv = *(const f32x4*)(ng + 4 * (lane & 31));
    for (int row = gw; row < NTOK; row += NGW) {
#pragma unroll
        for (int j = 0; j < 4; ++j) { const size_t off = (size_t)row * DM + 256 * j + 4 * lane; const f32x4 o = *(const f32x4*)(OF + off) + *(const f32x4*)(OB + off);
            float ss = (o[0] * o[0] + o[1] * o[1]) + (o[2] * o[2] + o[3] * o[3]);
#pragma unroll
            for (int d = 1; d < 32; d <<= 1) ss += __shfl_xor(ss, d);
            const float rstd = 1.f / sqrtf(ss * (1.f / 128.f) + 1e-6f);
            const u32x2 gg = *(const u32x2*)(G + off);
            const float g0 = bf2f((unsigned short)(gg.x & 0xffffu)), g1 = bf2f((unsigned short)(gg.x >> 16)), g2 = bf2f((unsigned short)(gg.y & 0xffffu)), g3 = bf2f((unsigned short)(gg.y >> 16));
            u32x2 w; w.x = pk2(o[0] * rstd * gv[0] * g0, o[1] * rstd * gv[1] * g1); w.y = pk2(o[2] * rstd * gv[2] * g2, o[3] * rstd * gv[3] * g3);
            *(u32x2*)(ON + off) = w; }
    }
}

typedef short s16x4 __attribute__((ext_vector_type(4)));
typedef short v4i16_t __attribute__((ext_vector_type(4)));
using pg8::bf16x8;
constexpr int KT_STR = 160, KS_STR = 144, V_STR = 288;
constexpr int GL_QT = 0, GL_KT = 20480, GL_KS = 40960, GL_PL = 59392, GL_V = 68608, GL_SEG = 87040, GL_DV = 89088, GL_EM = 89600, GL_SSQ = 90112, GL_RSTD = 92160;
__device__ __forceinline__ s16x4 lds_tr(const LAS unsigned char* p) { return __builtin_bit_cast(s16x4, __builtin_amdgcn_ds_read_tr16_b64_v4i16((LAS v4i16_t*)p)); }
__device__ __forceinline__ bf16x8 cat8(s16x4 a, s16x4 b) { return __builtin_shufflevector(a, b, 0, 1, 2, 3, 4, 5, 6, 7); }
__device__ __forceinline__ bf16x8 lds_pair64(const LAS unsigned char* p, int d2) { const u32x2 a = *(const LAS u32x2*)p, b = *(const LAS u32x2*)(p + d2); u32x4 r; r.x = a.x; r.y = a.y; r.z = b.x; r.w = b.y; return __builtin_bit_cast(bf16x8, r); }

struct GlaRegs { float f[16]; unsigned short q[16]; u32x4 v[2]; };
template <bool WITHQ>
__device__ __forceinline__ void gla_load(GlaRegs& R, const float* F, const bf16_t* Q, const bf16_t* V, int rb, int dir, int h, int tid) {
    const int k = tid & 127, seg = tid >> 7;
#pragma unroll
    for (int i = 0; i < 16; ++i) { const int p = 16 * seg + i; const size_t row = (size_t)(dir ? rb + 63 - p : rb + p);
        R.f[i] = F[row * DM + h * 128 + k]; if (WITHQ) R.q[i] = Q[row * DM + h * 128 + k]; }
#pragma unroll
    for (int i = 0; i < 2; ++i) { const int id = tid + 512 * i, p = id >> 4, c8 = (id & 15) * 8; const size_t row = (size_t)(dir ? rb + 63 - p : rb + p);
        R.v[i] = *(const u32x4*)(V + row * DM + h * 128 + c8); }
}
template <bool G2>
__device__ __forceinline__ void gla_phase_a(const GlaRegs& R, LAS unsigned char* lds, int tid) {
    const int k = tid & 127, seg = tid >> 7;
    LAS float* segtot = (LAS float*)(lds + GL_SEG);
#pragma unroll
    for (int i = 0; i < 2; ++i) { const int id = tid + 512 * i, p = id >> 4, c8 = (id & 15) * 8; *(LAS u32x4*)(lds + GL_V + p * V_STR + c8 * 2) = R.v[i]; }
    if (G2) {
        float c[16]; c[0] = R.f[0];
#pragma unroll
        for (int i = 1; i < 16; ++i) c[i] = c[i - 1] * R.f[i];
        segtot[seg * 128 + k] = c[15];
        __syncthreads();
        const float T0 = segtot[k], T1 = segtot[128 + k], T2 = segtot[256 + k], T3 = segtot[384 + k];
        const float Fs = seg == 0 ? 1.f / (T0 * T1) : (seg == 1 ? 1.f / T1 : (seg == 2 ? 1.f : T2));
        const float cK = T2 * T3;
        if (seg == 0) { ((LAS float*)(lds + GL_DV))[k] = T0 * T1 * cK; ((LAS float*)(lds + GL_EM))[k] = T0 * T1; }
        unsigned wq[8], wk[8], ws_[8];
#pragma unroll
        for (int i = 0; i < 16; i += 2) { float qp[2], kp[2], ks[2];
#pragma unroll
            for (int e = 0; e < 2; ++e) { const float eq = c[i + e] * Fs, inv = __builtin_amdgcn_rcpf(eq), kk = 1.f - R.f[i + e];
                qp[e] = bf2f(R.q[i + e]) * eq; kp[e] = kk * inv; ks[e] = kp[e] * cK; }
            wq[i >> 1] = pk2(qp[0], qp[1]); wk[i >> 1] = pk2(kp[0], kp[1]); ws_[i >> 1] = pk2(ks[0], ks[1]); }
        LAS unsigned char* dq = lds + GL_QT + k * KT_STR + seg * 32; LAS unsigned char* dk = lds + GL_KT + k * KT_STR + seg * 32; LAS unsigned char* ds = lds + GL_KS + k * KS_STR + seg * 32;
        *(LAS u32x4*)dq = (u32x4){wq[0], wq[1], wq[2], wq[3]}; *(LAS u32x4*)(dq + 16) = (u32x4){wq[4], wq[5], wq[6], wq[7]};
        *(LAS u32x4*)dk = (u32x4){wk[0], wk[1], wk[2], wk[3]}; *(LAS u32x4*)(dk + 16) = (u32x4){wk[4], wk[5], wk[6], wk[7]};
        *(LAS u32x4*)ds = (u32x4){ws_[0], ws_[1], ws_[2], ws_[3]}; *(LAS u32x4*)(ds + 16) = (u32x4){ws_[4], ws_[5], ws_[6], ws_[7]};
    } else {
        float sx[16]; sx[15] = 1.f;
#pragma unroll
        for (int i = 14; i >= 0; --i) sx[i] = sx[i + 1] * R.f[i + 1];
        segtot[seg * 128 + k] = sx[0] * R.f[0];
        __syncthreads();
        const float T0 = segtot[k], T1 = segtot[128 + k], T2 = segtot[256 + k], T3 = segtot[384 + k];
        const float later = seg == 0 ? T1 * T2 * T3 : (seg == 1 ? T2 * T3 : (seg == 2 ? T3 : 1.f));
        if (seg == 0) ((LAS float*)(lds + GL_DV))[k] = T0 * T1 * T2 * T3;
        unsigned ws_[8];
#pragma unroll
        for (int i = 0; i < 16; i += 2) ws_[i >> 1] = pk2((1.f - R.f[i]) * sx[i] * later, (1.f - R.f[i + 1]) * sx[i + 1] * later);
        LAS unsigned char* ds = lds + GL_KS + k * KS_STR + seg * 32;
        *(LAS u32x4*)ds = (u32x4){ws_[0], ws_[1], ws_[2], ws_[3]}; *(LAS u32x4*)(ds + 16) = (u32x4){ws_[4], ws_[5], ws_[6], ws_[7]};
    }
    __syncthreads();
}
__device__ __forceinline__ void gla_state_update(f32x4 (&S)[8], const bf16x8 (&Vf)[2], const LAS unsigned char* lds, int i16, int g) {
#pragma unroll
    for (int j = 0; j < 8; ++j) { const f32x4 dv = *(const LAS f32x4*)(lds + GL_DV + (16 * j + 4 * g) * 4); S[j] = S[j] * dv;
#pragma unroll
        for (int c2 = 0; c2 < 2; ++c2) { const bf16x8 a = lds_pair64(lds + GL_KS + (16 * j + i16) * KS_STR + (32 * c2 + 4 * g) * 2, 32);
            S[j] = __builtin_amdgcn_mfma_f32_16x16x32_bf16(a, Vf[c2], S[j], 0, 0, 0); } }
}
__device__ __forceinline__ void gla_load_vf(bf16x8 (&Vf)[2], const LAS unsigned char* lds, int w, int i16, int g) {
    const int q4 = i16 >> 2, pp = i16 & 3;
#pragma unroll
    for (int c2 = 0; c2 < 2; ++c2) { const LAS unsigned char* vb = lds + GL_V + (32 * c2 + 4 * g + q4) * V_STR + (16 * w + 4 * pp) * 2; Vf[c2] = cat8(lds_tr(vb), lds_tr(vb + 16 * V_STR)); }
}

__device__ __forceinline__ void ph_gla_states(const Params& p, unsigned char* lds_, int bid, int nblk) {
    int tid_ = threadIdx.x; asm volatile("" : "+v"(tid_));
    const int tid = tid_, lane = tid & 63, w = __builtin_amdgcn_readfirstlane(tid >> 6), i16 = lane & 15, g = lane >> 4;
    LAS unsigned char* lds = (LAS unsigned char*)lds_;
    const bf16_t* V = (const bf16_t*)(p.ws + WS_V);
    float* U = (float*)(p.ws + WS_U); float* DD = (float*)(p.ws + WS_DD);
    for (int ui = bid; ui < 544; ui += nblk) {
        int b, h, dir, nch, rb0, uidx;
        if (ui < 512) { b = ui >> 8; h = (ui >> 5) & 7; dir = (ui >> 4) & 1; const int sc = ui & 15; nch = 8; rb0 = b * SEQ + sc * 512; uidx = ((b * 8 + h) * 2 + dir) * 17 + sc; }
        else { const int r = ui - 512; b = r >> 4; h = (r >> 1) & 7; dir = r & 1; nch = 4; rb0 = NTOK + b * CTXL; uidx = ((b * 8 + h) * 2 + dir) * 17 + 16; }
        const float* F = (const float*)(p.ws + (dir ? WS_LBK : WS_LF));
        f32x4 S[8];
#pragma unroll
        for (int j = 0; j < 8; ++j) S[j] = (f32x4){0.f, 0.f, 0.f, 0.f};
        float dtot = 1.f;
        GlaRegs R;
        gla_load<false>(R, F, nullptr, V, rb0 + 64 * (dir ? nch - 1 : 0), dir, h, tid);
        for (int step = 0; step < nch; ++step) {
            gla_phase_a<false>(R, lds, tid);
            if (step + 1 < nch) { const int n = dir ? nch - 2 - step : step + 1; gla_load<false>(R, F, nullptr, V, rb0 + 64 * n, dir, h, tid); }
            if (tid < 128) dtot *= ((const LAS float*)(lds + GL_DV))[tid];
            bf16x8 Vf[2]; gla_load_vf(Vf, lds, w, i16, g);
            gla_state_update(S, Vf, lds, i16, g);
            __syncthreads();
        }
        float* up = U + (size_t)uidx * 16384 + (size_t)(w * 8) * 256 + lane * 4;
#pragma unroll
        for (int j = 0; j < 8; ++j) *(f32x4*)(up + j * 256) = S[j];
        if (tid < 128) DD[(size_t)uidx * 128 + tid] = dtot;
    }
}

__device__ __forceinline__ void ph_gla_out(const Params& p, unsigned char* lds_, int bid, int nblk) {
    int tid_ = threadIdx.x; asm volatile("" : "+v"(tid_));
    const int tid = tid_, lane = tid & 63, w = __builtin_amdgcn_readfirstlane(tid >> 6), i16 = lane & 15, g = lane >> 4, q4 = i16 >> 2, pp = i16 & 3;
    LAS unsigned char* lds = (LAS unsigned char*)lds_;
    const bf16_t* Q = (const bf16_t*)(p.ws + WS_Q); const bf16_t* V = (const bf16_t*)(p.ws + WS_V); const bf16_t* G = (const bf16_t*)(p.ws + WS_G);
    const float* U = (const float*)(p.ws + WS_U); const float* DD = (const float*)(p.ws + WS_DD);
    float* OF = (float*)(p.ws + WS_OF); bf16_t* ON = (bf16_t*)(p.ws + WS_ON);
    const float ngv = p.in[I_HGNORM][16 * w + i16];
    const int troff = (4 * g + q4) * KT_STR + (4 * pp) * 2;
    for (int unit = bid; unit < 256; unit += nblk) {
        const int b = unit >> 7, h = (unit >> 4) & 7, sc = unit & 15, rbs = b * SEQ + sc * 512;
        const int col = h * 128 + 16 * w + i16;
#pragma unroll 1
        for (int dir = 0; dir < 2; ++dir) {
            const float* F = (const float*)(p.ws + (dir ? WS_LBK : WS_LF));
            GlaRegs R;
            gla_load<true>(R, F, Q, V, rbs + 64 * (dir ? 7 : 0), dir, h, tid);
            const int ub = ((b * 8 + h) * 2 + dir) * 17;
            f32x4 S[8];
            { const float* up = U + (size_t)(ub + 16) * 16384 + (size_t)(w * 8) * 256 + lane * 4;
#pragma unroll
                for (int j = 0; j < 8; ++j) S[j] = *(const f32x4*)(up + j * 256); }
            for (int s = 0; s < (dir ? 15 - sc : sc); ++s) { const int u = dir ? 15 - s : s;
                const float* up = U + (size_t)(ub + u) * 16384 + (size_t)(w * 8) * 256 + lane * 4; const float* dp = DD + (size_t)(ub + u) * 128 + 4 * g;
#pragma unroll
                for (int j = 0; j < 8; ++j) S[j] = S[j] * *(const f32x4*)(dp + 16 * j) + *(const f32x4*)(up + j * 256); }
            for (int step = 0; step < 8; ++step) {
                const int n = dir ? 7 - step : step, rb = rbs + 64 * n;
                gla_phase_a<true>(R, lds, tid);
                if (step < 7) gla_load<true>(R, F, Q, V, rbs + 64 * (dir ? 6 - step : step + 1), dir, h, tid);
                { const int si = w >> 1, tb = 2 * (w & 1);
                    f32x4 pa[2] = {(f32x4){0.f, 0.f, 0.f, 0.f}, (f32x4){0.f, 0.f, 0.f, 0.f}};
#pragma unroll
                    for (int c = 0; c < 4; ++c) { const LAS unsigned char* ka = lds + GL_KT + troff + (32 * c) * KT_STR + (16 * si) * 2; const bf16x8 a = cat8(lds_tr(ka), lds_tr(ka + 16 * KT_STR));
#pragma unroll
                        for (int tt = 0; tt < 2; ++tt) { const LAS unsigned char* qa = lds + GL_QT + troff + (32 * c) * KT_STR + (16 * (tb + tt)) * 2; const bf16x8 bq = cat8(lds_tr(qa), lds_tr(qa + 16 * KT_STR));
                            pa[tt] = __builtin_amdgcn_mfma_f32_16x16x32_bf16(a, bq, pa[tt], 0, 0, 0); } }
#pragma unroll
                    for (int tt = 0; tt < 2; ++tt) { const int t = 16 * (tb + tt) + i16, s0 = 16 * si + 4 * g; f32x4 v = pa[tt];
#pragma unroll
                        for (int r = 0; r < 4; ++r) v[r] = (s0 + r <= t) ? v[r] : 0.f;
                        u32x2 wv; wv.x = pk2(v[0], v[1]); wv.y = pk2(v[2], v[3]); *(LAS u32x2*)(lds + GL_PL + t * KS_STR + s0 * 2) = wv; } }
                __syncthreads();
                f32x4 O[4];
#pragma unroll
                for (int ti = 0; ti < 4; ++ti) O[ti] = (f32x4){0.f, 0.f, 0.f, 0.f};
                { bf16x8 Sb[4];
#pragma unroll
                    for (int c = 0; c < 4; ++c) { const f32x4 e0 = *(const LAS f32x4*)(lds + GL_EM + (32 * c + 4 * g) * 4), e1 = *(const LAS f32x4*)(lds + GL_EM + (32 * c + 16 + 4 * g) * 4);
                        const f32x4 a = S[2 * c] * e0, bq = S[2 * c + 1] * e1; u32x4 r; r.x = pk2(a[0], a[1]); r.y = pk2(a[2], a[3]); r.z = pk2(bq[0], bq[1]); r.w = pk2(bq[2], bq[3]); Sb[c] = __builtin_bit_cast(bf16x8, r); }
#pragma unroll
                    for (int ti = 0; ti < 4; ++ti)
#pragma unroll
                        for (int c = 0; c < 4; ++c) { const LAS unsigned char* qa = lds + GL_QT + troff + (32 * c) * KT_STR + (16 * ti) * 2; const bf16x8 a = cat8(lds_tr(qa), lds_tr(qa + 16 * KT_STR));
                            O[ti] = __builtin_amdgcn_mfma_f32_16x16x32_bf16(a, Sb[c], O[ti], 0, 0, 0); } }
                bf16x8 Vf[2]; gla_load_vf(Vf, lds, w, i16, g);
#pragma unroll
                for (int ti = 0; ti < 4; ++ti)
#pragma unroll
                    for (int c2 = 0; c2 < 2; ++c2) { const bf16x8 a = lds_pair64(lds + GL_PL + (16 * ti + i16) * KS_STR + (32 * c2 + 4 * g) * 2, 32);
                        O[ti] = __builtin_amdgcn_mfma_f32_16x16x32_bf16(a, Vf[c2], O[ti], 0, 0, 0); }
                gla_state_update(S, Vf, lds, i16, g);
                if (dir == 0) {
#pragma unroll
                    for (int ti = 0; ti < 4; ++ti)
#pragma unroll
                        for (int r = 0; r < 4; ++r) OF[(size_t)(rb + 16 * ti + 4 * g + r) * DM + col] = O[ti][r];
                    __syncthreads();
                } else {
                    float part[4][4];
#pragma unroll
                    for (int ti = 0; ti < 4; ++ti)
#pragma unroll
                        for (int r = 0; r < 4; ++r) { const float o = O[ti][r] + OF[(size_t)(rb + 63 - (16 * ti + 4 * g + r)) * DM + col]; O[ti][r] = o; float s2 = o * o;
                            s2 += __shfl_xor(s2, 1); s2 += __shfl_xor(s2, 2); s2 += __shfl_xor(s2, 4); s2 += __shfl_xor(s2, 8); part[ti][r] = s2; }
                    if (i16 == 0) {
#pragma unroll
                        for (int ti = 0; ti < 4; ++ti) *(LAS f32x4*)(lds + GL_SSQ + (w * 64 + 16 * ti + 4 * g) * 4) = (f32x4){part[ti][0], part[ti][1], part[ti][2], part[ti][3]}; }
                    __syncthreads();
                    if (tid < 64) { float s2 = 0.f;
#pragma unroll
                        for (int ww = 0; ww < 8; ++ww) s2 += ((const LAS float*)(lds + GL_SSQ))[ww * 64 + tid];
                        ((LAS float*)(lds + GL_RSTD))[tid] = 1.f / sqrtf(s2 * (1.f / 128.f) + 1e-6f); }
                    __syncthreads();
#pragma unroll
                    for (int ti = 0; ti < 4; ++ti) { const f32x4 rs = *(const LAS f32x4*)(lds + GL_RSTD + (16 * ti + 4 * g) * 4);
#pragma unroll
                        for (int r = 0; r < 4; ++r) { const size_t off = (size_t)(rb + 63 - (16 * ti + 4 * g + r)) * DM + col;
                            ON[off] = (bf16_t)f2bf(O[ti][r] * rs[r] * ngv * bf2f(G[off])); } }
                }
            }
            asm volatile("s_waitcnt vmcnt(0)" ::: "memory");
            __syncthreads();
        }
    }
}

__device__ __forceinline__ void ph_modffn(const Params& p, unsigned char* lds, int bid, int nblk, int l) {
    int tid_ = threadIdx.x; asm volatile("" : "+v"(tid_));
    const int tid = tid_, lane = tid & 63, wave = tid >> 6;
    float* rw = (float*)lds;
    float* stg = (float*)(lds + 71680);
    const float* router = p.in[I_ROUTER] + (size_t)l * DM * NE;
    for (int i = tid; i < DM * NE / 4; i += NTHR) { const int d = i >> 2; *(f32x4*)(rw + d * 16 + (d >> 2) * 4 + (i & 3) * 4) = ((const f32x4*)router)[i]; }
    __syncthreads();
    const float* X = (const float*)(p.ws + WS_X); bf16_t* H = (bf16_t*)(p.ws + WS_H); float* aff = (float*)(p.ws + WS_AFF); int* slot = (int*)(p.ws + WS_SLOT);
    const float* g = p.in[I_NFFN] + (size_t)l * DM; const float* mod = (const float*)(p.ws + WS_MOD);
    for (int base = bid * 64; base < NTOK; base += nblk * 64) {
        const int b = base >> 13, t0 = base & (SEQ - 1);
        const float* mv = mod + (size_t)(l * 3 + b) * NADA; const float* sh = mv + 3 * DM; const float* sc = mv + 4 * DM;
#pragma unroll 1
        for (int r = 0; r < 8; ++r) {
            const int row = base + 8 * wave + r;
            f32x4 v[4]; float ss = 0.f;
#pragma unroll
            for (int j = 0; j < 4; ++j) { v[j] = *(const f32x4*)(X + (size_t)row * DM + 256 * j + 4 * lane); ss += (v[j][0] * v[j][0] + v[j][1] * v[j][1]) + (v[j][2] * v[j][2] + v[j][3] * v[j][3]); }
            const float rstd = 1.f / sqrtf(wave_sum(ss) * (1.f / DM) + 1e-6f);
            float lg[16];
#pragma unroll
            for (int e = 0; e < 16; ++e) lg[e] = 0.f;
#pragma unroll
            for (int j = 0; j < 4; ++j) { const int c0 = 256 * j + 4 * lane; const f32x4 gv = *(const f32x4*)(g + c0), shv = *(const f32x4*)(sh + c0), scv = *(const f32x4*)(sc + c0);
                f32x4 h;
#pragma unroll
                for (int i = 0; i < 4; ++i) { h[i] = (v[j][i] * rstd * gv[i]) * (1.f + scv[i]) + shv[i];
                    const float* rp = rw + (c0 + i) * 16 + (c0 >> 2) * 4; const f32x4 r0 = *(const f32x4*)(rp), r1 = *(const f32x4*)(rp + 4), r2 = *(const f32x4*)(rp + 8), r3 = *(const f32x4*)(rp + 12);
#pragma unroll
                    for (int e = 0; e < 4; ++e) { lg[e] += h[i] * r0[e]; lg[4 + e] += h[i] * r1[e]; lg[8 + e] += h[i] * r2[e]; lg[12 + e] += h[i] * r3[e]; }
                    asm volatile("" ::: "memory"); }
                u32x2 w; w.x = pk2(h[0], h[1]); w.y = pk2(h[2], h[3]); *(u32x2*)(H + (size_t)row * DM + c0) = w; }
            float a8[8], a4[4], a2[2], a1;
            { const bool hi = (lane & 32) != 0;
#pragma unroll
                for (int i = 0; i < 8; ++i) { const float send = hi ? lg[i] : lg[8 + i], keep = hi ? lg[8 + i] : lg[i]; a8[i] = keep + __shfl_xor(send, 32); } }
            { const bool hi = (lane & 16) != 0;
#pragma unroll
                for (int i = 0; i < 4; ++i) { const float send = hi ? a8[i] : a8[4 + i], keep = hi ? a8[4 + i] : a8[i]; a4[i] = keep + __shfl_xor(send, 16); } }
            { const bool hi = (lane & 8) != 0;
#pragma unroll
                for (int i = 0; i < 2; ++i) { const float send = hi ? a4[i] : a4[2 + i], keep = hi ? a4[2 + i] : a4[i]; a2[i] = keep + __shfl_xor(send, 8); } }
            { const bool hi = (lane & 4) != 0; const float send = hi ? a2[0] : a2[1], keep = hi ? a2[1] : a2[0]; a1 = keep + __shfl_xor(send, 4); }
            a1 += __shfl_xor(a1, 2); a1 += __shfl_xor(a1, 1);
            float mx = a1;
            mx = fmaxf(mx, __shfl_xor(mx, 4)); mx = fmaxf(mx, __shfl_xor(mx, 8)); mx = fmaxf(mx, __shfl_xor(mx, 16)); mx = fmaxf(mx, __shfl_xor(mx, 32));
            const float ex = expf(a1 - mx); float den = ex;
            den += __shfl_xor(den, 4); den += __shfl_xor(den, 8); den += __shfl_xor(den, 16); den += __shfl_xor(den, 32);
            if ((lane & 3) == 0) stg[((lane >> 2) & 15) * 64 + 8 * wave + r] = ex / den;
        }
        __syncthreads();
        { const int e = tid >> 5, tt = (tid & 31) * 2; *(f32x2*)(aff + (size_t)(b * NE + e) * SEQ + t0 + tt) = *(const f32x2*)(stg + e * 64 + tt);
            *(u32x2*)(slot + (size_t)base * NE + 2 * tid) = (u32x2){0xffffffffu, 0xffffffffu}; }
        __syncthreads();
    }
}

__device__ __forceinline__ void ph_topk(const Params& p, unsigned char* lds, int bid, int nblk) {
    int tid_ = threadIdx.x; asm volatile("" : "+v"(tid_)); const int tid = tid_, lane = tid & 63, wave = tid >> 6;
    unsigned* hist = (unsigned*)lds;
    unsigned* ctl = hist + 256;
    unsigned* wsum = ctl + 8;
    const float* aff = (const float*)(p.ws + WS_AFF); int* topi = (int*)(p.ws + WS_TOPI); float* topg = (float*)(p.ws + WS_TOPG); int* slot = (int*)(p.ws + WS_SLOT);
    for (int it = bid; it < NB * NE; it += nblk) {
        const int b = it >> 4, e = it & 15; const float* src = aff + (size_t)it * SEQ + 16 * tid;
        unsigned key[16];
#pragma unroll
        for (int j = 0; j < 4; ++j) { const f32x4 v = *(const f32x4*)(src + 4 * j); key[4 * j] = __float_as_uint(v[0]); key[4 * j + 1] = __float_as_uint(v[1]); key[4 * j + 2] = __float_as_uint(v[2]); key[4 * j + 3] = __float_as_uint(v[3]); }
        unsigned prefix = 0u;
#pragma unroll 1
        for (int bit = 30; bit >= 0; --bit) {
            const unsigned cand = prefix | (1u << bit);
            unsigned cnt = 0u;
#pragma unroll
            for (int i = 0; i < 16; ++i) cnt += (unsigned)__popcll(__ballot(key[i] >= cand));
            if (lane == 0) wsum[(bit & 1) * 8 + wave] = cnt;
            __syncthreads();
            unsigned tot = 0u;
#pragma unroll
            for (int w2 = 0; w2 < 8; ++w2) tot += wsum[(bit & 1) * 8 + w2];
            if (tot >= (unsigned)CAP) prefix = cand;
        }
        __syncthreads();
        unsigned cg = 0u, ce = 0u;
#pragma unroll
        for (int i = 0; i < 16; ++i) { cg += key[i] > prefix ? 1u : 0u; ce += key[i] == prefix ? 1u : 0u; }
        unsigned pk = cg | (ce << 16), inc = pk;
#pragma unroll
        for (int o = 1; o < 64; o <<= 1) { const unsigned t = __shfl_up(inc, o); if (lane >= o) inc += t; }
        if (lane == 63) wsum[wave] = inc;
        __syncthreads();
        unsigned base = 0u, total = 0u;
#pragma unroll
        for (int w2 = 0; w2 < 8; ++w2) { const unsigned t = wsum[w2]; if (w2 < wave) base += t; total += t; }
        const unsigned excl = base + inc - pk;
        unsigned rg = excl & 0xffffu, re = excl >> 16; const unsigned ngt = total & 0xffffu, kth = (unsigned)CAP - ngt;
#pragma unroll
        for (int i = 0; i < 16; ++i) { int s = -1;
            if (key[i] > prefix) { s = (int)rg; ++rg; }
            else if (key[i] == prefix) { if (re < kth) s = (int)(ngt + re); ++re; }
            if (s >= 0) { const int idx = 16 * tid + i, r = (e * NB + b) * CAP + s; topi[r] = b * SEQ + idx; topg[r] = __uint_as_float(key[i]); slot[(size_t)(b * SEQ + idx) * NE + e] = s; } }
        __syncthreads();
    }
}

__device__ __forceinline__ void ph_gather(const Params& p, int bid, int nblk) {
    int tid_ = threadIdx.x; asm volatile("" : "+v"(tid_));
    const int tid = tid_, lane = tid & 63, wave = tid >> 6, gw = bid * 8 + wave, NGW = nblk * 8;
    const bf16_t* H = (const bf16_t*)(p.ws + WS_H); bf16_t* XG = (bf16_t*)(p.ws + WS_XG); const int* topi = (const int*)(p.ws + WS_TOPI);
    for (int r = gw; r < NSLOT; r += NGW) { const int src = topi[r];
        const u32x4* s = (const u32x4*)(H + (size_t)src * DM); u32x4* d = (u32x4*)(XG + (size_t)r * DM);
        d[lane] = s[lane]; d[64 + lane] = s[64 + lane]; }
}

__device__ __forceinline__ void ph_combine(const Params& p, int bid, int nblk, int l, bool final_) {
    int tid_ = threadIdx.x; asm volatile("" : "+v"(tid_));
    const int tid = tid_, lane = tid & 63, wave = tid >> 6, gw = bid * 8 + wave, NGW = nblk * 8;
    float* X = (float*)(p.ws + WS_X); bf16_t* H = (bf16_t*)(p.ws + WS_H); const float* Y = (const float*)(p.ws + WS_Y); const int* slot = (const int*)(p.ws + WS_SLOT);
    const float* mod = (const float*)(p.ws + WS_MOD);
    for (int row = gw; row < NTOK; row += NGW) {
        const int b = row >> 13;
        const float* g2 = mod + (size_t)(l * 3 + b) * NADA + 5 * DM;
        f32x4 a[4];
#pragma unroll
        for (int j = 0; j < 4; ++j) a[j] = (f32x4){0.f, 0.f, 0.f, 0.f};
        const int myslot = lane < 16 ? slot[(size_t)row * NE + lane] : -1;
        for (int e = 0; e < NE; ++e) { const int s = __shfl(myslot, e);
            if (s >= 0) { const float* yr = Y + (size_t)((e * NB + b) * CAP + s) * DM;
#pragma unroll
                for (int j = 0; j < 4; ++j) a[j] = a[j] + *(const f32x4*)(yr + 256 * j + 4 * lane); } }
        f32x4 v[4]; float ss = 0.f;
#pragma unroll
        for (int j = 0; j < 4; ++j) { const int c0 = 256 * j + 4 * lane; v[j] = *(const f32x4*)(X + (size_t)row * DM + c0) + *(const f32x4*)(g2 + c0) * a[j];
            ss += (v[j][0] * v[j][0] + v[j][1] * v[j][1]) + (v[j][2] * v[j][2] + v[j][3] * v[j][3]); }
        const float rstd = 1.f / sqrtf(wave_sum(ss) * (1.f / DM) + 1e-6f);
        if (final_) { const float* gf = p.in[I_NFIN];
#pragma unroll
            for (int j = 0; j < 4; ++j) { const int c0 = 256 * j + 4 * lane; const f32x4 gv = *(const f32x4*)(gf + c0); *(f32x4*)(p.out + (size_t)row * DM + c0) = v[j] * rstd * gv; }
        } else {
#pragma unroll
            for (int j = 0; j < 4; ++j) *(f32x4*)(X + (size_t)row * DM + 256 * j + 4 * lane) = v[j];
            const float* mv = mod + (size_t)((l + 1) * 3 + b) * NADA;
            store_mod_bf16(H + (size_t)row * DM, v, rstd, p.in[I_NMIX] + (size_t)(l + 1) * DM, mv, mv + DM, lane);
        }
    }
}

__device__ __forceinline__ void ph_conv(const Params& p, int bid, int nblk) {
    int tid_ = threadIdx.x; asm volatile("" : "+v"(tid_));
    const int tid = tid_, lane = tid & 63, wave = tid >> 6, gw = bid * 8 + wave, NGW = nblk * 8;
    const bf16_t* BG = (const bf16_t*)(p.ws + WS_BG); const bf16_t* CU = (const bf16_t*)(p.ws + WS_CU); bf16_t* Z = (bf16_t*)(p.ws + WS_Z);
    const float* wc = p.in[I_SCCONV];
    for (int row = gw; row < NTOK; row += NGW) { const int t = row & (SEQ - 1);
#pragma unroll
        for (int hh = 0; hh < 2; ++hh) { const int c0 = hh * 512 + 8 * lane; const size_t off = (size_t)row * DM + c0;
            const u16x8 z0 = {0, 0, 0, 0, 0, 0, 0, 0};
            const u16x8 um = t > 0 ? *(const u16x8*)(CU + off - DM) : z0, u0 = *(const u16x8*)(CU + off), up = t < SEQ - 1 ? *(const u16x8*)(CU + off + DM) : z0, bg = *(const u16x8*)(BG + off);
            float o[8];
#pragma unroll
            for (int i = 0; i < 8; ++i) o[i] = bf2f(bg[i]) * (wc[c0 + i] * bf2f(um[i]) + wc[DM + c0 + i] * bf2f(u0[i]) + wc[2 * DM + c0 + i] * bf2f(up[i]));
            u32x4 w; w.x = pk2(o[0], o[1]); w.y = pk2(o[2], o[3]); w.z = pk2(o[4], o[5]); w.w = pk2(o[6], o[7]); *(u32x4*)(Z + off) = w; }
    }
}

#define XB_TMO      128
#define XB_XCNT(j)  (256  + 64 * (j))
#define XB_XSUB(j)  (1280 + 64 * (j))
#define XB_XGEN(j)  (2304 + 64 * (j))
#define XB_TOP      3328
#define XB_TOPGEN   3392
#define XCD_BAR_WORDS 3456
#define XB_SPIN_CAP (1u << 18)
__device__ __forceinline__ unsigned xb_ld(unsigned* p)              { return __hip_atomic_load(p, __ATOMIC_RELAXED, __HIP_MEMORY_SCOPE_AGENT); }
__device__ __forceinline__ unsigned xb_add(unsigned* p, unsigned v) { return __hip_atomic_fetch_add(p, v, __ATOMIC_RELAXED, __HIP_MEMORY_SCOPE_AGENT); }
__device__ __forceinline__ unsigned xb_xcc_id() { return (unsigned)__builtin_amdgcn_s_getreg((3 << 11) | 20) & 0xFu; }
#define XB_SPIN(cond, bar) do { unsigned _sp = 0; while (cond) { __builtin_amdgcn_s_sleep(1); \
    if ((++_sp & 255u) == 0u) { if (xb_ld(&(bar)[XB_TMO])) break; if (_sp > XB_SPIN_CAP) { atomicAdd(&(bar)[XB_TMO], 1u); break; } } } } while (0)
struct XcdBarrier { unsigned* bar; unsigned x; volatile LAS unsigned* st; };
__device__ __forceinline__ XcdBarrier xcd_barrier_post(unsigned* bar, volatile LAS unsigned* st) {
    XcdBarrier b; b.bar = bar; b.x = xb_xcc_id(); b.st = st;
    if (threadIdx.x == 0) (void)xb_add(&bar[XB_XCNT(b.x)], 1u);
    return b;
}
__device__ __forceinline__ void xcd_barrier_complete(unsigned* bar, unsigned x, unsigned& nloc, unsigned& nx) {
    const unsigned G = gridDim.x * gridDim.y * gridDim.z;
    unsigned sum, cnt, mine, sp = 0u;
    for (;;) {
        sum = 0u; cnt = 0u; mine = 0u;
#pragma unroll
        for (unsigned j = 0; j < 16; ++j) { const unsigned c = xb_ld(&bar[XB_XCNT(j)]); sum += c; cnt += (c > 0u) ? 1u : 0u; mine = (j == x) ? c : mine; }
        if (sum == G) break;
        __builtin_amdgcn_s_sleep(1);
        if ((++sp & 255u) == 0u) { if (xb_ld(&bar[XB_TMO])) break; if (sp > XB_SPIN_CAP) { atomicAdd(&bar[XB_TMO], 1u); break; } }
    }
    nloc = mine > 0u ? mine : 1u; nx = cnt > 0u ? cnt : 1u;
}
__device__ __forceinline__ void xcd_barrier(unsigned* bar_, volatile LAS unsigned* st_) {
    XcdBarrier b; b.bar = bar_; b.x = xb_xcc_id(); b.st = st_;
    asm volatile("s_waitcnt vmcnt(0)" ::: "memory");
    __syncthreads();
    if (threadIdx.x == 0) {
        unsigned* bar = b.bar;
        __builtin_amdgcn_s_waitcnt(0);
        unsigned nloc = b.st[0], nx = b.st[1];
        if (nloc == 0u) { xcd_barrier_complete(bar, b.x, nloc, nx); b.st[0] = nloc; b.st[1] = nx; }
        const unsigned old = xb_add(&bar[XB_XSUB(b.x)], 1u);
        const unsigned gen = old / nloc;
        if (old + 1u == (gen + 1u) * nloc) {
            __builtin_amdgcn_fence(__ATOMIC_RELEASE, "agent");
            asm volatile("s_waitcnt vmcnt(0)" ::: "memory");
            const unsigned og = xb_add(&bar[XB_TOP], 1u);
            const unsigned tg = og / nx;
            if (og + 1u == (tg + 1u) * nx) xb_add(&bar[XB_TOPGEN], 1u);
            else XB_SPIN(xb_ld(&bar[XB_TOPGEN]) == tg, bar);
            __builtin_amdgcn_fence(__ATOMIC_ACQUIRE, "agent");
            xb_add(&bar[XB_XGEN(b.x)], 1u);
            asm volatile("s_waitcnt vmcnt(0)" ::: "memory");
        } else {
            XB_SPIN(xb_ld(&bar[XB_XGEN(b.x)]) == gen, bar);
            __builtin_amdgcn_fence(__ATOMIC_ACQUIRE, "agent");
            asm volatile("s_waitcnt vmcnt(0)" ::: "memory");
        }
    }
    __syncthreads();
}

constexpr int NPHASE = 22;
constexpr int MISC_OFF = 131072 + 320;
constexpr int CW_BAR = 4096;
template <int LO, int HI> __global__ void __launch_bounds__(NTHR, 2) mega(Params p) {
    extern __shared__ __attribute__((aligned(16))) unsigned char lds[];
    const int bid = blockIdx.x, nblk = gridDim.x;
    PG8_LAS unsigned char* l3 = (PG8_LAS unsigned char*)lds;
    unsigned char* ws = p.ws;
    const float* mod = (const float*)(ws + WS_MOD);
    constexpr bool MULTI = (HI - LO) > 1;
    if (MULTI) {
        volatile LAS unsigned* MISC = (volatile LAS unsigned*)(l3 + MISC_OFF);
        if (threadIdx.x < 32) MISC[threadIdx.x] = 0u;
        __syncthreads();
        (void)xcd_barrier_post((unsigned*)(ws + WS_CTL) + CW_BAR, MISC + 8);
    }
#define IN(k) (LO <= (k) && (k) < HI)
#ifndef PROBE_DUP
#define PROBE_DUP 0u
#endif
#define DUPQ(k) (((PROBE_DUP) >> (k)) & 1u)
#define BARRIER_NOW() xcd_barrier((unsigned*)(p.ws + WS_CTL) + CW_BAR, (volatile LAS unsigned*)(l3 + MISC_OFF) + 8)
#define SEAM(k) do { if (IN(k) && IN((k) + 1)) xcd_barrier((unsigned*)(p.ws + WS_CTL) + CW_BAR, (volatile LAS unsigned*)(l3 + MISC_OFF) + 8); } while (0)
#define PHASE(k, ...) do { if (IN(k)) { __VA_ARGS__; if (DUPQ(k)) { BARRIER_NOW(); __VA_ARGS__; } } SEAM(k); } while (0)
#define GEMM_INPROJ() do { pg8::Gemm g{(const bf16_t*)(ws + WS_H), (const bf16_t*)(ws + WS_WHGIN), NROW, 5120, DM}; pg8::StaticOrder S; S.init(NROW, 5120, nblk, bid, 0); EpiInProj E{ws}; pg8::gemm_phase<EpiInProj>(l3, g, S, E); } while (0)
#define GEMM_OUT(AOFF, WOFF, GATE) do { pg8::Gemm g{(const bf16_t*)(ws + (AOFF)), (const bf16_t*)(ws + (WOFF)), NTOK, DM, DM}; pg8::StaticOrder S; S.init(NTOK, DM, nblk, bid, 0); EpiResid E{(float*)(ws + WS_X), (GATE)}; pg8::gemm_phase<EpiResid>(l3, g, S, E); } while (0)
#define GEMM_MOE1(l) do { pg8::Gemm g{(const bf16_t*)(ws + WS_XG), (const bf16_t*)(ws + WS_WMOE1) + (size_t)(l) * NE * 4096 * DM, NSLOT, 4096, DM}; pg8::StaticOrder S; S.init(NSLOT, 4096, nblk, bid, 8); EpiGLU E{(bf16_t*)(ws + WS_ACT)}; pg8::gemm_phase<EpiGLU>(l3, g, S, E); } while (0)
#define GEMM_MOE2(l) do { pg8::Gemm g{(const bf16_t*)(ws + WS_ACT), (const bf16_t*)(ws + WS_WMOE2) + (size_t)(l) * NE * DM * DE, NSLOT, DM, DE}; pg8::StaticOrder S; S.init(NSLOT, DM, nblk, bid, 8); EpiRowScale E{(float*)(ws + WS_Y), (const float*)(ws + WS_TOPG)}; pg8::gemm_phase<EpiRowScale>(l3, g, S, E); } while (0)
#define GEMM_CONVIN() do { pg8::Gemm g{(const bf16_t*)(ws + WS_H), (const bf16_t*)(ws + WS_WSCIN), NTOK, 3072, DM}; pg8::StaticOrder S; S.init(NTOK, 3072, nblk, bid, 0); EpiConvIn E{(bf16_t*)(ws + WS_BG), (bf16_t*)(ws + WS_CU)}; pg8::gemm_phase<EpiConvIn>(l3, g, S, E); } while (0)
    PHASE(0, ph_prep(p, lds, bid, nblk));
    PHASE(1, ph_convert(p, lds, bid, nblk));
    PHASE(2, ph_mod0(p, bid, nblk));
    PHASE(3, GEMM_INPROJ());
#if defined(GLA_SIMPLE)
    PHASE(4, ph_gla_simple(p, lds, bid, nblk));
    PHASE(5, ph_onorm(p, bid, nblk));
#else
    PHASE(4, ph_gla_states(p, lds, bid, nblk));
    PHASE(5, ph_gla_out(p, lds, bid, nblk));
#endif
    if (IN(6)) GEMM_OUT(WS_ON, WS_WHGOUT, mod + 2 * DM);
    SEAM(6);
    PHASE(7, ph_modffn(p, lds, bid, nblk, 0));
    PHASE(8, ph_topk(p, lds, bid, nblk));
    PHASE(9, ph_gather(p, bid, nblk));
    PHASE(10, GEMM_MOE1(0));
    PHASE(11, GEMM_MOE2(0));
    if (IN(12)) ph_combine(p, bid, nblk, 0, false);
    SEAM(12);
    PHASE(13, GEMM_CONVIN());
    PHASE(14, ph_conv(p, bid, nblk));
    if (IN(15)) GEMM_OUT(WS_Z, WS_WSCOUT, mod + (size_t)3 * NADA + 2 * DM);
    SEAM(15);
    PHASE(16, ph_modffn(p, lds, bid, nblk, 1));
    PHASE(17, ph_topk(p, lds, bid, nblk));
    PHASE(18, ph_gather(p, bid, nblk));
    PHASE(19, GEMM_MOE1(1));
    PHASE(20, GEMM_MOE2(1));
    if (IN(21)) ph_combine(p, bid, nblk, 1, true);
#undef IN
#undef SEAM
}

#ifndef MK_SPLIT
#define MK_SPLIT 0
#endif
#if MK_SPLIT
#include <utility>
template <int... I> static void launch_all(std::integer_sequence<int, I...>, int grid, Params& p, hipStream_t stream) {
    ((void)hipFuncSetAttribute((const void*)mega<I, I + 1>, hipFuncAttributeMaxDynamicSharedMemorySize, LDS_BYTES), ...);
    ((mega<I, I + 1><<<dim3(grid), dim3(NTHR), LDS_BYTES, stream>>>(p)), ...); }
#endif
extern "C" void kernel_launch(void* const* d_in, const int* in_sizes, int n_in, void* d_out, int out_size, void* d_ws, size_t ws_size, hipStream_t stream) {
    static int grid = 0;
    if (grid == 0) {
        if (n_in != 20 || ws_size < WS_END) { fprintf(stderr, "kernel_launch: unexpected inputs (n_in %d, ws %zu, need %zu)\n", n_in, ws_size, (size_t)WS_END); grid = -1; return; }
        int dev = 0, cus = 0, per_cu = 0;
        (void)hipGetDevice(&dev); (void)hipDeviceGetAttribute(&cus, hipDeviceAttributeMultiprocessorCount, dev);
        (void)hipFuncSetAttribute((const void*)mega<0, NPHASE>, hipFuncAttributeMaxDynamicSharedMemorySize, LDS_BYTES);
        if (hipOccupancyMaxActiveBlocksPerMultiprocessor(&per_cu, (const void*)mega<0, NPHASE>, NTHR, LDS_BYTES) != hipSuccess || per_cu < 1) { fprintf(stderr, "kernel_launch: occupancy query failed (%d)\n", per_cu); per_cu = 1; }
        (void)hipGetLastError();
        if (per_cu > 1) per_cu = 1;
        grid = (cus > 0 ? cus : 256) * per_cu;
    }
    if (grid < 0) return;
    Params p{};
    for (int i = 0; i < 20; ++i) p.in[i] = (const float*)d_in[i];
    p.out = (float*)d_out; p.ws = (unsigned char*)d_ws;
#if MK_SPLIT
    launch_all(std::make_integer_sequence<int, NPHASE>{}, grid, p, stream);
#else
    (void)hipMemsetAsync((char*)d_ws + WS_CTL, 0, 65536, stream);
    void* args[] = {&p};
    hipError_t e = hipLaunchCooperativeKernel((const void*)mega<0, NPHASE>, dim3(grid), dim3(NTHR), args, LDS_BYTES, stream);
    if (e != hipSuccess) fprintf(stderr, "kernel_launch: cooperative launch failed: %s (grid %d)\n", hipGetErrorString(e), grid);
#endif
}
```

```cpp
#include <hip/hip_runtime.h>
#include <cstdio>
#include <cstdint>

namespace pg8 {
#define PG8_LAS __attribute__((address_space(3)))
typedef unsigned short bf16_t;
typedef short bf16x8 __attribute__((ext_vector_type(8)));
typedef float f32x4 __attribute__((ext_vector_type(4)));
typedef unsigned u32x4 __attribute__((ext_vector_type(4)));
typedef unsigned u32x2 __attribute__((ext_vector_type(2)));
constexpr int BM = 256, BK = 64, HALF = 128, HTB = HALF * BK * 2, STAGE_BYTES = 8 * HTB, NXCD = 8, WGM = 8;

__host__ __device__ __forceinline__ int lds_byte(int r, int c) { const int st = (r >> 4) * 2 + (c >> 5), rr = r & 15, cc = c & 31, ob = rr * 64 + cc * 2; return st * 1024 + (ob ^ (((ob >> 9) & 1) << 5)); }
__host__ __device__ __forceinline__ void stage_rc(int b, int& R, int& C) { const int st = b / 1024, sb = b % 1024, swz = sb ^ (((sb >> 9) & 1) << 5); R = (st >> 1) * 16 + swz / 64; C = (st & 1) * 32 + (swz % 64) / 2; }
__host__ __device__ __forceinline__ int perm32(int rho) { const int n = rho >> 4, i = rho & 15; return 8 * (i >> 2) + 4 * n + (i & 3); }

struct Unit { int pm, pn, pb; };
struct Gemm { const bf16_t* A; const bf16_t* Bt; int M, N, K; };

struct StaticOrder {
    int nM, nN, nwg, G, c, mpe;
    __device__ void init(int M, int N, int G_, int c_, int mpe_) { nM = M / BM; nN = N / BM; nwg = nM * nN; G = G_; c = c_; mpe = mpe_; }
    __device__ bool next(int i, Unit& u) const {
        const long L = (long)i * G + c; if (L >= nwg) return false;
        int wgid = (int)L; { const int q = nwg / NXCD, r = nwg % NXCD, xcd = wgid % NXCD, off = wgid / NXCD; wgid = (xcd < r ? xcd * (q + 1) : r * (q + 1) + (xcd - r) * q) + off; }
        const int nig = WGM * nN, gid = wgid / nig, fm = gid * WGM, gsz = (nM - fm) < WGM ? (nM - fm) : WGM;
        u.pm = fm + ((wgid % nig) % gsz); u.pn = (wgid % nig) / gsz; u.pb = mpe > 0 ? (u.pm / mpe) * nN + u.pn : u.pn; return true;
    }
};

__device__ __forceinline__ unsigned cvt_pk_bf16(float lo, float hi) { unsigned r; asm volatile("v_cvt_pk_bf16_f32 %0, %1, %2" : "=v"(r) : "v"(lo), "v"(hi)); return r; }

struct OneUnit {
    int pm, pn;
    __device__ bool next(int i, Unit& u) const { if (i != 0) return false; u.pm = pm; u.pn = pn; u.pb = pn; return true; }
};
template <class Epi, class Sched, bool GATHER>
__device__ __forceinline__ void gemm_phase(PG8_LAS unsigned char* lds, const Gemm g, const Sched& S, const Epi& E, const int* gidx) {
    int tid_ = threadIdx.x; asm volatile("" : "+v"(tid_));
    const int tid = tid_, wid = __builtin_amdgcn_readfirstlane(tid >> 6), lane = tid & 63, wr = wid >> 2, wc = wid & 3, fr = lane & 15, fq = lane >> 4;
    const int K = g.K, nt = K / BK;
    unsigned voffA[2], voffB[2]; int rA[2], cA2[2];
#pragma unroll
    for (int i = 0; i < 2; ++i) { int R, C; stage_rc(tid * 16 + i * 8192, R, C); const int Rb = Epi::PERM ? ((R & ~31) + perm32(R & 31)) : R;
        voffA[i] = (unsigned)(R * K + C) * 2u; voffB[i] = (unsigned)(Rb * K + C) * 2u; rA[i] = R; cA2[i] = C * 2; }
    unsigned gcur[2][2], gnxt[2][2];
#define PG8_GOFF(dst, u) do { _Pragma("unroll") for (int _h = 0; _h < 2; ++_h) _Pragma("unroll") for (int _i = 0; _i < 2; ++_i) \
        dst[_h][_i] = (unsigned)gidx[(u).pm * BM + _h * HALF + rA[_i]] * (unsigned)(K * 2) + (unsigned)cA2[_i]; } while (0)
    const size_t kstep = (size_t)(BK * 2);
    const size_t hstep = (size_t)HALF * K * 2;
    const size_t tstep = 2 * hstep;
    const unsigned ldsw = (unsigned)wid * 1024u;
    const int aoff = lds_byte(wr * 64 + fr, fq * 8), boff = lds_byte(wc * 32 + fr, fq * 8);
#define PG8_SA(b, h) (((b) * 2 + (h)) * HTB)
#define PG8_SB(b, h) ((4 + (b) * 2 + (h)) * HTB)
#define PG8_STAGE(bufoff, gbase, voff) do { _Pragma("unroll") for (int _i = 0; _i < 2; ++_i) \
        __builtin_amdgcn_global_load_lds((const unsigned*)((const char*)(gbase) + (voff)[_i]), (PG8_LAS unsigned*)(lds + (bufoff) + ldsw + _i * 8192), 16, 0, 0); } while (0)
#define PG8_STAGE_A(bufoff, half, kb, NX) do { _Pragma("unroll") for (int _i = 0; _i < 2; ++_i) { \
        const char* _src = GATHER ? (const char*)g.A + (kb) + ((NX) ? gnxt[half][_i] : gcur[half][_i]) : ((NX) ? nA : cA) + (size_t)(half) * hstep + (kb) + voffA[_i]; \
        __builtin_amdgcn_global_load_lds((const unsigned*)_src, (PG8_LAS unsigned*)(lds + (bufoff) + ldsw + _i * 8192), 16, 0, 0); } } while (0)
#define PG8_LDA(dst, b, h) do { _Pragma("unroll") for (int m = 0; m < 4; ++m) _Pragma("unroll") for (int k = 0; k < 2; ++k) dst[m][k] = *(const PG8_LAS bf16x8*)(lds + PG8_SA(b, h) + aoff + m * 2048 + k * 1024); } while (0)
#define PG8_LDB(dst, b, h) do { _Pragma("unroll") for (int n = 0; n < 2; ++n) _Pragma("unroll") for (int k = 0; k < 2; ++k) dst[n][k] = *(const PG8_LAS bf16x8*)(lds + PG8_SB(b, h) + boff + n * 2048 + k * 1024); } while (0)
#define PG8_MMA(ai, bj, At, Bt) do { __builtin_amdgcn_s_setprio(1); _Pragma("unroll") for (int m = 0; m < 4; ++m) _Pragma("unroll") for (int n = 0; n < 2; ++n) _Pragma("unroll") for (int k = 0; k < 2; ++k) \
        acc[ai][bj][m][n] = __builtin_amdgcn_mfma_f32_16x16x32_bf16(Bt[n][k], At[m][k], acc[ai][bj][m][n], 0, 0, 0); __builtin_amdgcn_s_setprio(0); } while (0)
#define PG8_WAIT_V(n) asm volatile("s_waitcnt vmcnt(" #n ")" ::: "memory")
#define PG8_WAIT_L(n) asm volatile("s_waitcnt lgkmcnt(" #n ")" ::: "memory")
#define PG8_BAR __builtin_amdgcn_s_barrier()
#define PG8_SCHED __builtin_amdgcn_sched_barrier(0)
    Unit cur, nxt; int ui = 0;
    if (!S.next(0, cur)) return;
    f32x4 acc[2][2][4][2];
#pragma unroll
    for (int a = 0; a < 2; ++a)
#pragma unroll
        for (int b = 0; b < 2; ++b)
#pragma unroll
            for (int m = 0; m < 4; ++m)
#pragma unroll
                for (int n = 0; n < 2; ++n) acc[a][b][m][n] = (f32x4){0.f, 0.f, 0.f, 0.f};
    bf16x8 At[4][2], B0[2][2], B1[2][2];
    const char* cA = GATHER ? (const char*)g.A : (const char*)g.A + (size_t)cur.pm * tstep; const char* cB = (const char*)g.Bt + (size_t)cur.pb * tstep; const char* nA = cA;
    if (GATHER) { PG8_GOFF(gcur, cur); }
    PG8_STAGE(PG8_SB(0, 0), cB, voffB); PG8_STAGE(PG8_SB(0, 1), cB + hstep, voffB); PG8_STAGE_A(PG8_SA(0, 0), 0, 0, false); PG8_STAGE_A(PG8_SA(0, 1), 1, 0, false);
    if (wr == 1) PG8_BAR;
    PG8_WAIT_V(2); PG8_BAR;
    PG8_STAGE(PG8_SB(1, 0), cB + kstep, voffB); PG8_STAGE_A(PG8_SA(1, 0), 0, kstep, false); PG8_STAGE(PG8_SB(1, 1), cB + hstep + kstep, voffB);
    PG8_WAIT_V(6); PG8_BAR;
    for (;;) {
        const bool has_next = S.next(ui + 1, nxt);
        nA = GATHER ? cA : (has_next ? (const char*)g.A + (size_t)nxt.pm * tstep : cA); const char* nB = has_next ? (const char*)g.Bt + (size_t)nxt.pb * tstep : cB;
        if (GATHER) { if (has_next) { PG8_GOFF(gnxt, nxt); } else {
#pragma unroll
            for (int _h = 0; _h < 2; ++_h)
#pragma unroll
                for (int _i = 0; _i < 2; ++_i) gnxt[_h][_i] = gcur[_h][_i]; } }
        for (int t = 0; t < nt; t += 2) {
            const bool last = (t == nt - 2);
            const size_t k1 = (size_t)(t + 1) * kstep, k2 = last ? 0 : (size_t)(t + 2) * kstep, k3 = k2 + kstep;
            const char* b2 = last ? nB : cB + (size_t)(t + 2) * kstep; const char* b3 = b2 + kstep;
            PG8_LDB(B0, 0, 0); PG8_LDB(B1, 0, 1); PG8_SCHED; PG8_LDA(At, 0, 0); PG8_STAGE_A(PG8_SA(1, 1), 1, k1, false);
            PG8_WAIT_V(8); PG8_WAIT_L(0); PG8_BAR; PG8_MMA(0, 0, At, B0); PG8_MMA(0, 1, At, B1); PG8_BAR; PG8_SCHED;
            PG8_LDA(At, 0, 1); PG8_STAGE(PG8_SB(0, 0), b2, voffB); PG8_STAGE(PG8_SB(0, 1), b2 + hstep, voffB); PG8_STAGE_A(PG8_SA(0, 0), 0, k2, last);
            PG8_WAIT_V(8); PG8_WAIT_L(0); PG8_BAR; PG8_MMA(1, 0, At, B0); PG8_MMA(1, 1, At, B1); PG8_BAR; PG8_SCHED;
            PG8_LDB(B0, 1, 0); PG8_LDB(B1, 1, 1); PG8_SCHED; PG8_LDA(At, 1, 0); PG8_STAGE_A(PG8_SA(0, 1), 1, k2, last);
            PG8_WAIT_V(8); PG8_WAIT_L(0); PG8_BAR; PG8_MMA(0, 0, At, B0); PG8_MMA(0, 1, At, B1); PG8_BAR; PG8_SCHED;
            PG8_LDA(At, 1, 1); PG8_STAGE(PG8_SB(1, 0), b3, voffB); PG8_STAGE(PG8_SB(1, 1), b3 + hstep, voffB); PG8_STAGE_A(PG8_SA(1, 0), 0, k3, last);
            PG8_WAIT_V(8); PG8_WAIT_L(0); PG8_BAR; PG8_MMA(1, 0, At, B0); PG8_MMA(1, 1, At, B1); PG8_BAR; PG8_SCHED;
        }
        if (wr == 0) PG8_BAR;
        E(acc, cur, wr, wc, fr, fq);
        if (!has_next) break;
#pragma unroll
        for (int a = 0; a < 2; ++a)
#pragma unroll
            for (int b = 0; b < 2; ++b)
#pragma unroll
                for (int m = 0; m < 4; ++m)
#pragma unroll
                    for (int n = 0; n < 2; ++n) acc[a][b][m][n] = (f32x4){0.f, 0.f, 0.f, 0.f};
        cur = nxt; cA = nA; cB = nB; ++ui;
        if (GATHER) {
#pragma unroll
            for (int _h = 0; _h < 2; ++_h)
#pragma unroll
                for (int _i = 0; _i < 2; ++_i) gcur[_h][_i] = gnxt[_h][_i]; }
        if (wr == 1) PG8_BAR;
    }
    PG8_WAIT_V(0);
    PG8_BAR;
#undef PG8_SA
#undef PG8_SB
#undef PG8_STAGE
#undef PG8_STAGE_A
#undef PG8_GOFF
#undef PG8_LDA
#undef PG8_LDB
#undef PG8_MMA
#undef PG8_WAIT_V
#undef PG8_WAIT_L
#undef PG8_BAR
#undef PG8_SCHED
}
}

#define LAS __attribute__((address_space(3)))
using pg8::bf16_t; using pg8::f32x4; using pg8::u32x4; using pg8::u32x2;
typedef unsigned short u16x8 __attribute__((ext_vector_type(8)));
typedef float f32x2 __attribute__((ext_vector_type(2)));

constexpr int DM = 1024, NB = 2, SEQ = 8192, NTOK = NB * SEQ, CTXL = 256, NCTX = NB * CTXL, NROW = NTOK + NCTX;
constexpr int NE = 16, CAP = 1024, DE = 2048, NSLOT = NE * NB * CAP;
constexpr int NADA = 6 * DM;
constexpr int NTHR = 512;

constexpr size_t MiB = 1u << 20;
constexpr size_t WS_CTL = 0;
constexpr size_t WS_MOD = 1 * MiB;
constexpr size_t WS_LB = WS_MOD + 256 * 1024;
constexpr size_t WS_POSR = WS_LB + 64 * 1024;
constexpr size_t WS_POSC = WS_POSR + 256 * 1024;
constexpr size_t WS_AFF = 2 * MiB;
constexpr size_t WS_TOPI = 3 * MiB;
constexpr size_t WS_TOPG = WS_TOPI + 128 * 1024;
constexpr size_t WS_SLOT = 4 * MiB;
constexpr size_t WS_WHGIN = 6 * MiB;
constexpr size_t WS_WHGOUT = 16 * MiB;
constexpr size_t WS_WSCIN = 18 * MiB;
constexpr size_t WS_WSCOUT = 24 * MiB;
constexpr size_t WS_WMOE1 = 26 * MiB;
constexpr size_t WS_WMOE2 = WS_WMOE1 + 256 * MiB;
constexpr size_t WS_X = WS_WMOE2 + 128 * MiB;
constexpr size_t WS_H = WS_X + 64 * MiB;
constexpr size_t WS_R = WS_H + 34 * MiB;
constexpr size_t WS_Q = WS_R;
constexpr size_t WS_V = WS_Q + 34 * MiB;
constexpr size_t WS_G = WS_V + 34 * MiB;
constexpr size_t WS_LF = WS_G + 34 * MiB;
constexpr size_t WS_LBK = WS_LF + 66 * MiB;
constexpr size_t WS_OF = WS_LBK + 66 * MiB;
constexpr size_t WS_OB = WS_OF + 64 * MiB;
constexpr size_t WS_U = WS_OB;
constexpr size_t WS_DD = WS_OB + 40 * MiB;
constexpr size_t WS_ON = WS_OB + 64 * MiB;
constexpr size_t WS_HG_END = WS_ON + 32 * MiB;
constexpr size_t WS_XG = WS_R;
constexpr size_t WS_ACT = WS_XG + 64 * MiB;
constexpr size_t WS_Y = WS_ACT + 128 * MiB;
constexpr size_t WS_MOE_END = WS_Y + 128 * MiB;
constexpr size_t WS_BG = WS_R;
constexpr size_t WS_CU = WS_BG + 32 * MiB;
constexpr size_t WS_Z = WS_CU + 32 * MiB;
constexpr size_t WS_END = WS_HG_END > WS_MOE_END ? WS_HG_END : WS_MOE_END;
static_assert(WS_END <= 1024 * MiB, "workspace map exceeds 1 GiB");

constexpr int LDS_BYTES = 135168;

struct Params { const float* in[20]; float* out; unsigned char* ws; int ph_lo, ph_hi; };
enum { I_X = 0, I_C, I_CTX, I_CCTX, I_ADAW, I_ADAB, I_NMIX, I_NFFN, I_NFIN, I_HGWIN, I_HGLB, I_HGNORM, I_HGWOUT, I_SCWIN, I_SCCONV, I_SCWOUT, I_ROUTER, I_WGATE, I_WUP, I_WDOWN };

__device__ __forceinline__ unsigned f2bf(float f) { unsigned u = __builtin_bit_cast(unsigned, f); return (u + 0x7fffu + ((u >> 16) & 1u)) >> 16; }
__device__ __forceinline__ unsigned pk2(float lo, float hi) { return f2bf(lo) | (f2bf(hi) << 16); }
__device__ __forceinline__ float bf2f(unsigned short h) { return __builtin_bit_cast(float, (unsigned)h << 16); }
__device__ __forceinline__ float wave_sum(float v) {
#pragma unroll
    for (int o = 1; o < 64; o <<= 1) v += __shfl_xor(v, o);
    return v;
}
__device__ __forceinline__ float sigmoidf_(float x) { return 1.f / (1.f + expf(-x)); }
__device__ __forceinline__ float fsigmoid(float x) { return __builtin_amdgcn_rcpf(1.f + __builtin_amdgcn_exp2f(-1.4426950408889634f * x)); }
__device__ __forceinline__ float fsilu(float x) { return x * fsigmoid(x); }
__device__ __forceinline__ float siluf_(float x) { return x / (1.f + expf(-x)); }

struct EpiInProj {
    static constexpr bool PERM = false;
    unsigned char* ws;
    __device__ __forceinline__ void operator()(const f32x4 (&acc)[2][2][4][2], const pg8::Unit& u, int wr, int wc, int fr, int fq) const {
        const int sec = u.pn >> 2;
        const int row0 = u.pm * 256 + wr * 64 + fr, cb = (u.pn & 3) * 256 + wc * 32 + 4 * fq;
        if (sec == 0 || sec == 1 || sec == 4) {
            bf16_t* O = (bf16_t*)(ws + (sec == 0 ? WS_Q : (sec == 1 ? WS_V : WS_G)));
#pragma unroll
            for (int ai = 0; ai < 2; ++ai)
#pragma unroll
                for (int m = 0; m < 4; ++m) { bf16_t* rp = O + (size_t)(row0 + ai * 128 + m * 16) * DM + cb;
#pragma unroll
                    for (int bj = 0; bj < 2; ++bj)
#pragma unroll
                        for (int n = 0; n < 2; ++n) { f32x4 v = acc[ai][bj][m][n];
                            if (sec == 0) v = v * 0.08838834764831845f;
                            if (sec == 4) { v[0] = fsilu(v[0]); v[1] = fsilu(v[1]); v[2] = fsilu(v[2]); v[3] = fsilu(v[3]); }
                            u32x2 w; w.x = pk2(v[0], v[1]); w.y = pk2(v[2], v[3]); *(u32x2*)(rp + bj * 128 + n * 16) = w; } }
        } else {
            float* O = (float*)(ws + (sec == 2 ? WS_LF : WS_LBK)); const float* lb0 = (const float*)(ws + WS_LB);
            f32x4 lbv[2][2];
#pragma unroll
            for (int bj = 0; bj < 2; ++bj)
#pragma unroll
                for (int n = 0; n < 2; ++n) lbv[bj][n] = *(const f32x4*)(lb0 + cb + bj * 128 + n * 16);
#pragma unroll
            for (int ai = 0; ai < 2; ++ai)
#pragma unroll
                for (int m = 0; m < 4; ++m) { float* rp = O + (size_t)(row0 + ai * 128 + m * 16) * DM + cb;
#pragma unroll
                    for (int bj = 0; bj < 2; ++bj)
#pragma unroll
                        for (int n = 0; n < 2; ++n) { const f32x4 z = acc[ai][bj][m][n], lb = lbv[bj][n]; f32x4 o;
#pragma unroll
                            for (int i = 0; i < 4; ++i) o[i] = lb[i] + (1.f - lb[i]) * fsigmoid(z[i]);
                            *(f32x4*)(rp + bj * 128 + n * 16) = o; } }
        }
    }
};
struct EpiResid {
    static constexpr bool PERM = false;
    float* X; const float* gate;
    __device__ __forceinline__ void operator()(const f32x4 (&acc)[2][2][4][2], const pg8::Unit& u, int wr, int wc, int fr, int fq) const {
        const int row0 = u.pm * 256 + wr * 64 + fr, cb = u.pn * 256 + wc * 32 + 4 * fq;
        const float* gp = gate + (size_t)((u.pm * 256) / SEQ) * NADA + cb;
        f32x4 gv[2][2];
#pragma unroll
        for (int bj = 0; bj < 2; ++bj)
#pragma unroll
            for (int n = 0; n < 2; ++n) gv[bj][n] = *(const f32x4*)(gp + bj * 128 + n * 16);
#pragma unroll
        for (int ai = 0; ai < 2; ++ai)
#pragma unroll
            for (int m = 0; m < 4; ++m) { float* rp = X + (size_t)(row0 + ai * 128 + m * 16) * DM + cb;
#pragma unroll
                for (int bj = 0; bj < 2; ++bj)
#pragma unroll
                    for (int n = 0; n < 2; ++n) { f32x4* q = (f32x4*)(rp + bj * 128 + n * 16); *q = *q + gv[bj][n] * acc[ai][bj][m][n]; } }
    }
};
struct EpiGLU {
    static constexpr bool PERM = true;
    bf16_t* ACT;
    __device__ __forceinline__ void operator()(const f32x4 (&acc)[2][2][4][2], const pg8::Unit& u, int wr, int wc, int fr, int fq) const {
        const int row0 = u.pm * 256 + wr * 64 + fr, cb = u.pn * 128 + wc * 32 + 8 * fq;
#pragma unroll
        for (int ai = 0; ai < 2; ++ai)
#pragma unroll
            for (int m = 0; m < 4; ++m) { bf16_t* rp = ACT + (size_t)(row0 + ai * 128 + m * 16) * DE + cb;
                f32x4 o[2];
#pragma unroll
                for (int n = 0; n < 2; ++n) { const f32x4 a = acc[ai][0][m][n], w = acc[ai][1][m][n];
#pragma unroll
                    for (int i = 0; i < 4; ++i) o[n][i] = fsilu(a[i]) * w[i]; }
                u32x4 w; w.x = pk2(o[0][0], o[0][1]); w.y = pk2(o[0][2], o[0][3]); w.z = pk2(o[1][0], o[1][1]); w.w = pk2(o[1][2], o[1][3]);
                *(u32x4*)rp = w; }
    }
};
struct EpiRowScale {
    static constexpr bool PERM = true;
    bf16_t* Y; const float* rg;
    __device__ __forceinline__ void operator()(const f32x4 (&acc)[2][2][4][2], const pg8::Unit& u, int wr, int wc, int fr, int fq) const {
        const int row0 = u.pm * 256 + wr * 64 + fr, cb = u.pn * 256 + wc * 32 + 8 * fq;
#pragma unroll
        for (int ai = 0; ai < 2; ++ai)
#pragma unroll
            for (int m = 0; m < 4; ++m) { const int row = row0 + ai * 128 + m * 16; const float gsc = rg[row]; bf16_t* rp = Y + (size_t)row * DM + cb;
#pragma unroll
                for (int bj = 0; bj < 2; ++bj) { const f32x4 v0 = acc[ai][bj][m][0] * gsc, v1 = acc[ai][bj][m][1] * gsc;
                    u32x4 w; w.x = pk2(v0[0], v0[1]); w.y = pk2(v0[2], v0[3]); w.z = pk2(v1[0], v1[1]); w.w = pk2(v1[2], v1[3]);
                    *(u32x4*)(rp + bj * 128) = w; } }
    }
};
struct EpiConvIn {
    static constexpr bool PERM = true;
    bf16_t *BG, *CU;
    __device__ __forceinline__ void operator()(const f32x4 (&acc)[2][2][4][2], const pg8::Unit& u, int wr, int wc, int fr, int fq) const {
        const int row0 = u.pm * 256 + wr * 64 + fr;
        if (u.pn < 4) {
            const int cb = u.pn * 256 + wc * 32 + 8 * fq;
#pragma unroll
            for (int ai = 0; ai < 2; ++ai)
#pragma unroll
                for (int m = 0; m < 4; ++m) { bf16_t* rp = BG + (size_t)(row0 + ai * 128 + m * 16) * DM + cb;
#pragma unroll
                    for (int bj = 0; bj < 2; ++bj) { const f32x4 v0 = acc[ai][bj][m][0], v1 = acc[ai][bj][m][1];
                        u32x4 w; w.x = pk2(v0[0], v0[1]); w.y = pk2(v0[2], v0[3]); w.z = pk2(v1[0], v1[1]); w.w = pk2(v1[2], v1[3]);
                        *(u32x4*)(rp + bj * 128) = w; } }
        } else {
            const int cb = (u.pn - 4) * 128 + wc * 32 + 8 * fq;
#pragma unroll
            for (int ai = 0; ai < 2; ++ai)
#pragma unroll
                for (int m = 0; m < 4; ++m) { bf16_t* rp = CU + (size_t)(row0 + ai * 128 + m * 16) * DM + cb;
                    const f32x4 v0 = acc[ai][0][m][0] * acc[ai][1][m][0], v1 = acc[ai][0][m][1] * acc[ai][1][m][1];
                    u32x4 w; w.x = pk2(v0[0], v0[1]); w.y = pk2(v0[2], v0[3]); w.z = pk2(v1[0], v1[1]); w.w = pk2(v1[2], v1[3]);
                    *(u32x4*)rp = w; }
        }
    }
};

__device__ __forceinline__ void ph_prep(const Params& p, unsigned char* lds, int bid, int nblk) {
    float* sv = (float*)lds;
    float* red = sv + 3 * 1024;
    int tid_ = threadIdx.x; asm volatile("" : "+v"(tid_)); const int tid = tid_;
    const float* c = p.in[I_C]; const float* cctx = p.in[I_CCTX];
    for (int i = tid; i < 3 * 1024; i += NTHR) { const float v = (i < 2048) ? c[i] : cctx[i - 2048]; sv[i] = siluf_(v); }
    __syncthreads();
    const float* ada_w = p.in[I_ADAW]; const float* ada_b = p.in[I_ADAB];
    float* mod = (float*)(p.ws + WS_MOD);
    for (int it = bid; it < 96; it += nblk) {
        const int l = it / 48, j0 = (it % 48) * 128, col = tid & 127, ks = tid >> 7;
        const float* W = ada_w + (size_t)l * DM * NADA + j0 + col;
        float a0 = 0.f, a1 = 0.f, a2 = 0.f;
#pragma unroll 8
        for (int k = ks * 256; k < ks * 256 + 256; ++k) { const float w = W[(size_t)k * NADA]; a0 += sv[k] * w; a1 += sv[1024 + k] * w; a2 += sv[2048 + k] * w; }
        red[(ks * 3 + 0) * 128 + col] = a0; red[(ks * 3 + 1) * 128 + col] = a1; red[(ks * 3 + 2) * 128 + col] = a2;
        __syncthreads();
        if (tid < 384) { const int v = tid >> 7, cc = tid & 127;
            const float s = (red[(0 * 3 + v) * 128 + cc] + red[(1 * 3 + v) * 128 + cc]) + (red[(2 * 3 + v) * 128 + cc] + red[(3 * 3 + v) * 128 + cc]) + ada_b[l * NADA + j0 + cc];
            mod[(size_t)(l * 3 + v) * NADA + j0 + cc] = s; }
        __syncthreads();
    }
    const int gt = bid * NTHR + tid, NT = nblk * NTHR;
    const float* lg = p.in[I_HGLB]; float* lb0 = (float*)(p.ws + WS_LB);
    for (int d = gt; d < DM; d += NT) { const float l0 = lg[d], l1 = lg[DM + d], l2 = lg[2 * DM + d]; const float mx = fmaxf(l0, fmaxf(l1, l2));
        const float e0 = expf(l0 - mx), e1 = expf(l1 - mx), e2 = expf(l2 - mx); lb0[d] = e0 / (e0 + e1 + e2); }
    float* posr = (float*)(p.ws + WS_POSR);
    for (int i = gt; i < (128 + 64) * 512; i += NT) { const int pi = i >> 9, dd = i & 511; const int pos = pi < 128 ? pi : pi - 128; const int fi = dd & 255;
        const float om = exp2f(-(float)fi * (13.287712379549449f / 256.0f)); const float a = (float)pos * om; posr[i] = dd < 256 ? sinf(a) : cosf(a); }
}

__device__ __forceinline__ void transpose_item(const float* W, int N, bf16_t* WT, int K, float* scr, int k0, int n0, size_t drow0, int lane) {
#pragma unroll 8
    for (int i = 0; i < 32; ++i) { const int kk = 2 * i + (lane >> 5); scr[kk * 33 + (lane & 31)] = W[(size_t)(k0 + kk) * N + n0 + (lane & 31)]; }
    __builtin_amdgcn_s_waitcnt(0xc07f); asm volatile("" ::: "memory");
    const int c = lane & 7;
#pragma unroll
    for (int j = 0; j < 4; ++j) { const int n = (lane >> 3) + 8 * j; const float* s = scr + (8 * c) * 33 + n;
        u32x4 o; o.x = pk2(s[0 * 33], s[1 * 33]); o.y = pk2(s[2 * 33], s[3 * 33]); o.z = pk2(s[4 * 33], s[5 * 33]); o.w = pk2(s[6 * 33], s[7 * 33]);
        *(u32x4*)(WT + (drow0 + n) * K + k0 + 8 * c) = o; }
    __builtin_amdgcn_s_waitcnt(0xc07f); asm volatile("" ::: "memory");
}
__device__ __forceinline__ void ph_convert(const Params& p, unsigned char* lds, int bid, int nblk) {
    int tid_ = threadIdx.x; asm volatile("" : "+v"(tid_));
    const int tid = tid_, lane = tid & 63, wave = tid >> 6;
    float* scr = (float*)lds + wave * (64 * 33);
    const int gw = bid * 8 + wave, NGW = nblk * 8;
    constexpr int I_A = 16 * 160, I_B = 16 * 32, I_C_ = 16 * 96, I_D = 16 * 32, I_E = 32 * 1024, I_F = 32 * 1024, I_G = 32 * 1024;
    constexpr int NITEMS = I_A + I_B + I_C_ + I_D + I_E + I_F + I_G;
    for (int it = gw; it < NITEMS; it += NGW) {
        int r = it;
        if (r < I_A) { const int kb = r / 160, nb = r % 160; transpose_item(p.in[I_HGWIN], 5120, (bf16_t*)(p.ws + WS_WHGIN), 1024, scr, kb * 64, nb * 32, (size_t)nb * 32, lane); continue; } r -= I_A;
        if (r < I_B) { const int kb = r / 32, nb = r % 32; transpose_item(p.in[I_HGWOUT], 1024, (bf16_t*)(p.ws + WS_WHGOUT), 1024, scr, kb * 64, nb * 32, (size_t)nb * 32, lane); continue; } r -= I_B;
        if (r < I_C_) { const int kb = r / 96, nb = r % 96, n0 = nb * 32; size_t dr;
            if (n0 < 1024) dr = n0; else { const int np = n0 - 1024, sec = np >> 10, nn = np & 1023; dr = 1024 + (nn >> 7) * 256 + sec * 128 + (nn & 127); }
            transpose_item(p.in[I_SCWIN], 3072, (bf16_t*)(p.ws + WS_WSCIN), 1024, scr, kb * 64, n0, dr, lane); continue; } r -= I_C_;
        if (r < I_D) { const int kb = r / 32, nb = r % 32; transpose_item(p.in[I_SCWOUT], 1024, (bf16_t*)(p.ws + WS_WSCOUT), 1024, scr, kb * 64, nb * 32, (size_t)nb * 32, lane); continue; } r -= I_D;
        if (r < I_E + I_F) { const int up = r >= I_E; if (up) r -= I_E; const int le = r >> 10, q = r & 1023, kb = q >> 6, nb = q & 63, n0 = nb * 32;
            const size_t dr = (size_t)le * 4096 + (n0 >> 7) * 256 + up * 128 + (n0 & 127);
            transpose_item(p.in[up ? I_WUP : I_WGATE] + (size_t)le * 1024 * 2048, 2048, (bf16_t*)(p.ws + WS_WMOE1), 1024, scr, kb * 64, n0, dr, lane); continue; } r -= I_E + I_F;
        { const int le = r >> 10, q = r & 1023, kb = q >> 5, nb = q & 31, n0 = nb * 32;
            transpose_item(p.in[I_WDOWN] + (size_t)le * 2048 * 1024, 1024, (bf16_t*)(p.ws + WS_WMOE2), 2048, scr, kb * 64, n0, (size_t)le * 1024 + n0, lane); }
    }
}

__device__ __forceinline__ void store_mod_bf16(bf16_t* hrow, const f32x4 (&v)[4], float rstd, const float* g, const float* sh, const float* sc, int lane) {
#pragma unroll
    for (int j = 0; j < 4; ++j) { const int c0 = 256 * j + 4 * lane; const f32x4 gv = *(const f32x4*)(g + c0), shv = *(const f32x4*)(sh + c0), scv = *(const f32x4*)(sc + c0);
        f32x4 h;
#pragma unroll
        for (int i = 0; i < 4; ++i) h[i] = (v[j][i] * rstd * gv[i]) * (1.f + scv[i]) + shv[i];
        u32x2 w; w.x = pk2(h[0], h[1]); w.y = pk2(h[2], h[3]); *(u32x2*)(hrow + c0) = w; }
}
__device__ __forceinline__ void ph_mod0(const Params& p, int row_lo, int row_hi, int wk, int nwk) {
    int tid_ = threadIdx.x; asm volatile("" : "+v"(tid_));
    const int tid = tid_, lane = tid & 63, wave = tid >> 6, gw = wk * 8 + wave, NGW = nwk * 8;
    const float* x = p.in[I_X]; const float* ctx = p.in[I_CTX]; const float* g = p.in[I_NMIX];
    const float* mod = (const float*)(p.ws + WS_MOD); const float* posr = (const float*)(p.ws + WS_POSR); const float* posc = (const float*)(p.ws + WS_POSC);
    float* X = (float*)(p.ws + WS_X); bf16_t* H = (bf16_t*)(p.ws + WS_H);
    for (int row = row_lo + gw; row < row_hi; row += NGW) {
        f32x4 v[4]; float ss = 0.f; int vec;
        if (row < NTOK) { const int t = row & (SEQ - 1); vec = row >> 13; const float* pr = posr + (size_t)(t >> 6) * 512; const float* pc = posc + (size_t)(t & 63) * 512;
#pragma unroll
            for (int j = 0; j < 4; ++j) { const int c0 = 256 * j + 4 * lane; const f32x4 pv = *(const f32x4*)((j < 2 ? pr : pc) + (c0 & 511));
                v[j] = *(const f32x4*)(x + (size_t)row * DM + c0) + pv; *(f32x4*)(X + (size_t)row * DM + c0) = v[j]; }
        } else { vec = 2;
#pragma unroll
            for (int j = 0; j < 4; ++j) v[j] = *(const f32x4*)(ctx + (size_t)(row - NTOK) * DM + 256 * j + 4 * lane); }
#pragma unroll
        for (int j = 0; j < 4; ++j) ss += (v[j][0] * v[j][0] + v[j][1] * v[j][1]) + (v[j][2] * v[j][2] + v[j][3] * v[j][3]);
        const float rstd = 1.f / sqrtf(wave_sum(ss) * (1.f / DM) + 1e-6f);
        const float* mv = mod + (size_t)(0 * 3 + vec) * NADA;
        store_mod_bf16(H + (size_t)row * DM, v, rstd, g, mv, mv + DM, lane);
    }
}

__device__ __forceinline__ void ph_gla_simple(const Params& p, unsigned char* lds, int bid, int nblk) {
    float* qs = (float*)lds; float* fs = qs + 4096; float* ks = fs + 4096; float* vs = ks + 4096; float* part = vs + 1024;
    int tid_ = threadIdx.x; asm volatile("" : "+v"(tid_));
    const int tid = tid_, lane = tid & 63, wave = tid >> 6, kk = tid >> 5, vv = tid & 31;
    const bf16_t* Q = (const bf16_t*)(p.ws + WS_Q); const bf16_t* V = (const bf16_t*)(p.ws + WS_V);
    for (int unit = bid; unit < 128; unit += nblk) {
        const int vsl = unit & 3, dir = (unit >> 2) & 1, h = (unit >> 3) & 7, b = unit >> 6;
        const float* LFp = (const float*)(p.ws + (dir ? WS_LBK : WS_LF)); float* O = (float*)(p.ws + (dir ? WS_OB : WS_OF));
        float s[8];
#pragma unroll
        for (int i = 0; i < 8; ++i) s[i] = 0.f;
        for (int bt = 0; bt < 8 + 256; ++bt) {
            const bool isctx = bt < 8; const int nb = isctx ? bt : bt - 8, nbt = isctx ? 8 : 256;
            const int t0 = dir == 0 ? nb * 32 : (nbt - 1 - nb) * 32;
            const size_t rbase = isctx ? (size_t)(NTOK + b * CTXL + t0) : (size_t)(b * SEQ + t0);
            { const int r = tid >> 4, c8 = (tid & 15) * 8; const size_t off = (rbase + r) * DM + h * 128 + c8;
                const u16x8 qv = *(const u16x8*)(Q + off); const f32x4 l0 = *(const f32x4*)(LFp + off), l1 = *(const f32x4*)(LFp + off + 4);
#pragma unroll
                for (int i = 0; i < 8; ++i) { qs[r * 128 + c8 + i] = bf2f(qv[i]); const float f = i < 4 ? l0[i] : l1[i - 4]; fs[r * 128 + c8 + i] = f; ks[r * 128 + c8 + i] = 1.f - f; }
                if (tid < 128) { const int r2 = tid >> 2, c = (tid & 3) * 8; const u16x8 vv8 = *(const u16x8*)(V + (rbase + r2) * DM + h * 128 + vsl * 32 + c);
#pragma unroll
                    for (int i = 0; i < 8; ++i) vs[r2 * 32 + c + i] = bf2f(vv8[i]); } }
            __syncthreads();
            for (int jj = 0; jj < 32; ++jj) { const int j = dir ? 31 - jj : jj; const float vj = vs[j * 32 + vv]; float po = 0.f;
#pragma unroll
                for (int i = 0; i < 8; ++i) { const float f = fs[j * 128 + kk * 8 + i], k_ = ks[j * 128 + kk * 8 + i], q_ = qs[j * 128 + kk * 8 + i]; s[i] = f * s[i] + k_ * vj; po += q_ * s[i]; }
                po += __shfl_xor(po, 32);
                if (!isctx && lane < 32) part[(j * 8 + wave) * 32 + vv] = po; }
            __syncthreads();
            if (!isctx) { const int j = tid >> 4, v2 = (tid & 15) * 2; float o0 = 0.f, o1 = 0.f;
#pragma unroll
                for (int w = 0; w < 8; ++w) { o0 += part[(j * 8 + w) * 32 + v2]; o1 += part[(j * 8 + w) * 32 + v2 + 1]; }
                *(f32x2*)(O + (rbase + j) * DM + h * 128 + vsl * 32 + v2) = (f32x2){o0, o1}; }
        }
        __syncthreads();
    }
}

__device__ __forceinline__ void ph_onorm(const Params& p, int bid, int nblk) {
    int tid_ = threadIdx.x; asm volatile("" : "+v"(tid_));
    const int tid = tid_, lane = tid & 63, wave = tid >> 6, gw = bid * 8 + wave, NGW = nblk * 8;
    const float* OF = (const float*)(p.ws + WS_OF); const float* OB = (const float*)(p.ws + WS_OB); const bf16_t* G = (const bf16_t*)(p.ws + WS_G); bf16_t* ON = (bf16_t*)(p.ws + WS_ON);
    const float* ng = p.in[I_HGNORM];
    const f32x4 gv = *(const f32x4*)(ng + 4 * (lane & 31));
    for (int row = gw; row < NTOK; row += NGW) {
#pragma unroll
        for (int j = 0; j < 4; ++j) { const size_t off = (size_t)row * DM + 256 * j + 4 * lane; const f32x4 o = *(const f32x4*)(OF + off) + *(const f32x4*)(OB + off);
            float ss = (o[0] * o[0] + o[1] * o[1]) + (o[2] * o[2] + o[3] * o[3]);
#pragma unroll
            for (int d = 1; d < 32; d <<= 1) ss += __shfl_xor(ss, d);
            const float rstd = 1.f / sqrtf(ss * (1.f / 128.f) + 1e-6f);
            const u32x2 gg = *(const u32x2*)(G + off);
            const float g0 = bf2f((unsigned short)(gg.x & 0xffffu)), g1 = bf2f((unsigned short)(gg.x >> 16)), g2 = bf2f((unsigned short)(gg.y & 0xffffu)), g3 = bf2f((unsigned short)(gg.y >> 16));
            u32x2 w; w.x = pk2(o[0] * rstd * gv[0] * g0, o[1] * rstd * gv[1] * g1); w.y = pk2(o[2] * rstd * gv[2] * g2, o[3] * rstd * gv[3] * g3);
            *(u32x2*)(ON + off) = w; }
    }
}

typedef short s16x4 __attribute__((ext_vector_type(4)));
typedef short v4i16_t __attribute__((ext_vector_type(4)));
using pg8::bf16x8;
constexpr int KT_STR = 160, KS_STR = 144, V_STR = 288;
constexpr int GL_QT = 0, GL_KT = 20480, GL_KS = 40960, GL_PL = 59392, GL_V = 68608, GL_SEG = 87040, GL_DV = 89088, GL_EM = 89600, GL_SSQ = 90112, GL_RSTD = 92160;
__device__ __forceinline__ s16x4 lds_tr(const LAS unsigned char* p) { return __builtin_bit_cast(s16x4, __builtin_amdgcn_ds_read_tr16_b64_v4i16((LAS v4i16_t*)p)); }
__device__ __forceinline__ bf16x8 cat8(s16x4 a, s16x4 b) { return __builtin_shufflevector(a, b, 0, 1, 2, 3, 4, 5, 6, 7); }
__device__ __forceinline__ bf16x8 lds_pair64(const LAS unsigned char* p, int d2) { const u32x2 a = *(const LAS u32x2*)p, b = *(const LAS u32x2*)(p + d2); u32x4 r; r.x = a.x; r.y = a.y; r.z = b.x; r.w = b.y; return __builtin_bit_cast(bf16x8, r); }

struct GlaRegs { float f[16]; unsigned short q[16]; u32x4 v[2]; };
template <bool WITHQ>
__device__ __forceinline__ void gla_load(GlaRegs& R, const float* F, const bf16_t* Q, const bf16_t* V, int rb, int dir, int h, int tid) {
    const int k = tid & 127, seg = tid >> 7;
#pragma unroll
    for (int i = 0; i < 16; ++i) { const int p = 16 * seg + i; const size_t row = (size_t)(dir ? rb + 63 - p : rb + p);
        R.f[i] = F[row * DM + h * 128 + k]; if (WITHQ) R.q[i] = Q[row * DM + h * 128 + k]; }
#pragma unroll
    for (int i = 0; i < 2; ++i) { const int id = tid + 512 * i, p = id >> 4, c8 = (id & 15) * 8; const size_t row = (size_t)(dir ? rb + 63 - p : rb + p);
        R.v[i] = *(const u32x4*)(V + row * DM + h * 128 + c8); }
}
template <bool G2>
__device__ __forceinline__ void gla_phase_a(const GlaRegs& R, LAS unsigned char* lds, int tid) {
    const int k = tid & 127, seg = tid >> 7;
    LAS float* segtot = (LAS float*)(lds + GL_SEG);
#pragma unroll
    for (int i = 0; i < 2; ++i) { const int id = tid + 512 * i, p = id >> 4, c8 = (id & 15) * 8; *(LAS u32x4*)(lds + GL_V + p * V_STR + c8 * 2) = R.v[i]; }
    if (G2) {
        float c[16]; c[0] = R.f[0];
#pragma unroll
        for (int i = 1; i < 16; ++i) c[i] = c[i - 1] * R.f[i];
        segtot[seg * 128 + k] = c[15];
        __syncthreads();
        const float T0 = segtot[k], T1 = segtot[128 + k], T2 = segtot[256 + k], T3 = segtot[384 + k];
        const float Fs = seg == 0 ? 1.f / (T0 * T1) : (seg == 1 ? 1.f / T1 : (seg == 2 ? 1.f : T2));
        const float cK = T2 * T3;
        if (seg == 0) { ((LAS float*)(lds + GL_DV))[k] = T0 * T1 * cK; ((LAS float*)(lds + GL_EM))[k] = T0 * T1; }
        unsigned wq[8], wk[8], ws_[8];
#pragma unroll
        for (int i = 0; i < 16; i += 2) { float qp[2], kp[2], ks[2];
#pragma unroll
            for (int e = 0; e < 2; ++e) { const float eq = c[i + e] * Fs, inv = __builtin_amdgcn_rcpf(eq), kk = 1.f - R.f[i + e];
                qp[e] = bf2f(R.q[i + e]) * eq; kp[e] = kk * inv; ks[e] = kp[e] * cK; }
            wq[i >> 1] = pk2(qp[0], qp[1]); wk[i >> 1] = pk2(kp[0], kp[1]); ws_[i >> 1] = pk2(ks[0], ks[1]); }
        LAS unsigned char* dq = lds + GL_QT + k * KT_STR + seg * 32; LAS unsigned char* dk = lds + GL_KT + k * KT_STR + seg * 32; LAS unsigned char* ds = lds + GL_KS + k * KS_STR + seg * 32;
        *(LAS u32x4*)dq = (u32x4){wq[0], wq[1], wq[2], wq[3]}; *(LAS u32x4*)(dq + 16) = (u32x4){wq[4], wq[5], wq[6], wq[7]};
        *(LAS u32x4*)dk = (u32x4){wk[0], wk[1], wk[2], wk[3]}; *(LAS u32x4*)(dk + 16) = (u32x4){wk[4], wk[5], wk[6], wk[7]};
        *(LAS u32x4*)ds = (u32x4){ws_[0], ws_[1], ws_[2], ws_[3]}; *(LAS u32x4*)(ds + 16) = (u32x4){ws_[4], ws_[5], ws_[6], ws_[7]};
    } else {
        float sx[16]; sx[15] = 1.f;
#pragma unroll
        for (int i = 14; i >= 0; --i) sx[i] = sx[i + 1] * R.f[i + 1];
        segtot[seg * 128 + k] = sx[0] * R.f[0];
        __syncthreads();
        const float T0 = segtot[k], T1 = segtot[128 + k], T2 = segtot[256 + k], T3 = segtot[384 + k];
        const float later = seg == 0 ? T1 * T2 * T3 : (seg == 1 ? T2 * T3 : (seg == 2 ? T3 : 1.f));
        if (seg == 0) ((LAS float*)(lds + GL_DV))[k] = T0 * T1 * T2 * T3;
        unsigned ws_[8];
#pragma unroll
        for (int i = 0; i < 16; i += 2) ws_[i >> 1] = pk2((1.f - R.f[i]) * sx[i] * later, (1.f - R.f[i + 1]) * sx[i + 1] * later);
        LAS unsigned char* ds = lds + GL_KS + k * KS_STR + seg * 32;
        *(LAS u32x4*)ds = (u32x4){ws_[0], ws_[1], ws_[2], ws_[3]}; *(LAS u32x4*)(ds + 16) = (u32x4){ws_[4], ws_[5], ws_[6], ws_[7]};
    }
    __syncthreads();
}
__device__ __forceinline__ void gla_state_update(f32x4 (&S)[8], const bf16x8 (&Vf)[2], const LAS unsigned char* lds, int i16, int g) {
#pragma unroll
    for (int j = 0; j < 8; ++j) { const f32x4 dv = *(const LAS f32x4*)(lds + GL_DV + (16 * j + 4 * g) * 4); S[j] = S[j] * dv;
#pragma unroll
        for (int c2 = 0; c2 < 2; ++c2) { const bf16x8 a = lds_pair64(lds + GL_KS + (16 * j + i16) * KS_STR + (32 * c2 + 4 * g) * 2, 32);
            S[j] = __builtin_amdgcn_mfma_f32_16x16x32_bf16(a, Vf[c2], S[j], 0, 0, 0); } }
}
__device__ __forceinline__ void gla_load_vf(bf16x8 (&Vf)[2], const LAS unsigned char* lds, int w, int i16, int g) {
    const int q4 = i16 >> 2, pp = i16 & 3;
#pragma unroll
    for (int c2 = 0; c2 < 2; ++c2) { const LAS unsigned char* vb = lds + GL_V + (32 * c2 + 4 * g + q4) * V_STR + (16 * w + 4 * pp) * 2; Vf[c2] = cat8(lds_tr(vb), lds_tr(vb + 16 * V_STR)); }
}

__device__ __forceinline__ void ph_gla_states(const Params& p, unsigned char* lds_, int bid, int nblk) {
    int tid_ = threadIdx.x; asm volatile("" : "+v"(tid_));
    const int tid = tid_, lane = tid & 63, w = __builtin_amdgcn_readfirstlane(tid >> 6), i16 = lane & 15, g = lane >> 4;
    LAS unsigned char* lds = (LAS unsigned char*)lds_;
    const bf16_t* V = (const bf16_t*)(p.ws + WS_V);
    float* U = (float*)(p.ws + WS_U); float* DD = (float*)(p.ws + WS_DD);
    for (int ui = bid; ui < 544; ui += nblk) {
        int b, h, dir, nch, rb0, uidx;
        if (ui < 512) { b = ui >> 8; h = (ui >> 5) & 7; dir = (ui >> 4) & 1; const int sc = ui & 15; nch = 8; rb0 = b * SEQ + sc * 512; uidx = ((b * 8 + h) * 2 + dir) * 17 + sc; }
        else { const int r = ui - 512; b = r >> 4; h = (r >> 1) & 7; dir = r & 1; nch = 4; rb0 = NTOK + b * CTXL; uidx = ((b * 8 + h) * 2 + dir) * 17 + 16; }
        const float* F = (const float*)(p.ws + (dir ? WS_LBK : WS_LF));
        f32x4 S[8];
#pragma unroll
        for (int j = 0; j < 8; ++j) S[j] = (f32x4){0.f, 0.f, 0.f, 0.f};
        float dtot = 1.f;
        GlaRegs R;
        gla_load<false>(R, F, nullptr, V, rb0 + 64 * (dir ? nch - 1 : 0), dir, h, tid);
        for (int step = 0; step < nch; ++step) {
            gla_phase_a<false>(R, lds, tid);
            if (step + 1 < nch) { const int n = dir ? nch - 2 - step : step + 1; gla_load<false>(R, F, nullptr, V, rb0 + 64 * n, dir, h, tid); }
            if (tid < 128) dtot *= ((const LAS float*)(lds + GL_DV))[tid];
            bf16x8 Vf[2]; gla_load_vf(Vf, lds, w, i16, g);
            gla_state_update(S, Vf, lds, i16, g);
            __syncthreads();
        }
        float* up = U + (size_t)uidx * 16384 + (size_t)(w * 8) * 256 + lane * 4;
#pragma unroll
        for (int j = 0; j < 8; ++j) *(f32x4*)(up + j * 256) = S[j];
        if (tid < 128) DD[(size_t)uidx * 128 + tid] = dtot;
    }
}

__device__ __forceinline__ void ph_gla_out(const Params& p, unsigned char* lds_, int bid, int nblk) {
    int tid_ = threadIdx.x; asm volatile("" : "+v"(tid_));
    const int tid = tid_, lane = tid & 63, w = __builtin_amdgcn_readfirstlane(tid >> 6), i16 = lane & 15, g = lane >> 4, q4 = i16 >> 2, pp = i16 & 3;
    LAS unsigned char* lds = (LAS unsigned char*)lds_;
    const bf16_t* Q = (const bf16_t*)(p.ws + WS_Q); const bf16_t* V = (const bf16_t*)(p.ws + WS_V); const bf16_t* G = (const bf16_t*)(p.ws + WS_G);
    const float* U = (const float*)(p.ws + WS_U); const float* DD = (const float*)(p.ws + WS_DD);
    float* OF = (float*)(p.ws + WS_OF); bf16_t* ON = (bf16_t*)(p.ws + WS_ON);
    const float ngv = p.in[I_HGNORM][16 * w + i16];
    const int troff = (4 * g + q4) * KT_STR + (4 * pp) * 2;
    for (int unit = bid; unit < 256; unit += nblk) {
        const int b = unit >> 7, h = (unit >> 4) & 7, sc = unit & 15, rbs = b * SEQ + sc * 512;
        const int col = h * 128 + 16 * w + i16;
#pragma unroll 1
        for (int dir = 0; dir < 2; ++dir) {
            const float* F = (const float*)(p.ws + (dir ? WS_LBK : WS_LF));
            GlaRegs R;
            gla_load<true>(R, F, Q, V, rbs + 64 * (dir ? 7 : 0), dir, h, tid);
            const int ub = ((b * 8 + h) * 2 + dir) * 17;
            f32x4 S[8];
            { const float* up = U + (size_t)(ub + 16) * 16384 + (size_t)(w * 8) * 256 + lane * 4;
#pragma unroll
                for (int j = 0; j < 8; ++j) S[j] = *(const f32x4*)(up + j * 256); }
            for (int s = 0; s < (dir ? 15 - sc : sc); ++s) { const int u = dir ? 15 - s : s;
                const float* up = U + (size_t)(ub + u) * 16384 + (size_t)(w * 8) * 256 + lane * 4; const float* dp = DD + (size_t)(ub + u) * 128 + 4 * g;
#pragma unroll
                for (int j = 0; j < 8; ++j) S[j] = S[j] * *(const f32x4*)(dp + 16 * j) + *(const f32x4*)(up + j * 256); }
            for (int step = 0; step < 8; ++step) {
                const int n = dir ? 7 - step : step, rb = rbs + 64 * n;
                gla_phase_a<true>(R, lds, tid);
                if (step < 7) gla_load<true>(R, F, Q, V, rbs + 64 * (dir ? 6 - step : step + 1), dir, h, tid);
                { const int si = w >> 1, tb = 2 * (w & 1);
                    f32x4 pa[2] = {(f32x4){0.f, 0.f, 0.f, 0.f}, (f32x4){0.f, 0.f, 0.f, 0.f}};
#pragma unroll
                    for (int c = 0; c < 4; ++c) { const LAS unsigned char* ka = lds + GL_KT + troff + (32 * c) * KT_STR + (16 * si) * 2; const bf16x8 a = cat8(lds_tr(ka), lds_tr(ka + 16 * KT_STR));
#pragma unroll
                        for (int tt = 0; tt < 2; ++tt) { const LAS unsigned char* qa = lds + GL_QT + troff + (32 * c) * KT_STR + (16 * (tb + tt)) * 2; const bf16x8 bq = cat8(lds_tr(qa), lds_tr(qa + 16 * KT_STR));
                            pa[tt] = __builtin_amdgcn_mfma_f32_16x16x32_bf16(a, bq, pa[tt], 0, 0, 0); } }
#pragma unroll
                    for (int tt = 0; tt < 2; ++tt) { const int t = 16 * (tb + tt) + i16, s0 = 16 * si + 4 * g; f32x4 v = pa[tt];
#pragma unroll
                        for (int r = 0; r < 4; ++r) v[r] = (s0 + r <= t) ? v[r] : 0.f;
                        u32x2 wv; wv.x = pk2(v[0], v[1]); wv.y = pk2(v[2], v[3]); *(LAS u32x2*)(lds + GL_PL + t * KS_STR + s0 * 2) = wv; } }
                __syncthreads();
                f32x4 O[4];
#pragma unroll
                for (int ti = 0; ti < 4; ++ti) O[ti] = (f32x4){0.f, 0.f, 0.f, 0.f};
                { bf16x8 Sb[4];
#pragma unroll
                    for (int c = 0; c < 4; ++c) { const f32x4 e0 = *(const LAS f32x4*)(lds + GL_EM + (32 * c + 4 * g) * 4), e1 = *(const LAS f32x4*)(lds + GL_EM + (32 * c + 16 + 4 * g) * 4);
                        const f32x4 a = S[2 * c] * e0, bq = S[2 * c + 1] * e1; u32x4 r; r.x = pk2(a[0], a[1]); r.y = pk2(a[2], a[3]); r.z = pk2(bq[0], bq[1]); r.w = pk2(bq[2], bq[3]); Sb[c] = __builtin_bit_cast(bf16x8, r); }
#pragma unroll
                    for (int ti = 0; ti < 4; ++ti)
#pragma unroll
                        for (int c = 0; c < 4; ++c) { const LAS unsigned char* qa = lds + GL_QT + troff + (32 * c) * KT_STR + (16 * ti) * 2; const bf16x8 a = cat8(lds_tr(qa), lds_tr(qa + 16 * KT_STR));
                            O[ti] = __builtin_amdgcn_mfma_f32_16x16x32_bf16(a, Sb[c], O[ti], 0, 0, 0); } }
                bf16x8 Vf[2]; gla_load_vf(Vf, lds, w, i16, g);
#pragma unroll
                for (int ti = 0; ti < 4; ++ti)
#pragma unroll
                    for (int c2 = 0; c2 < 2; ++c2) { const bf16x8 a = lds_pair64(lds + GL_PL + (16 * ti + i16) * KS_STR + (32 * c2 + 4 * g) * 2, 32);
                        O[ti] = __builtin_amdgcn_mfma_f32_16x16x32_bf16(a, Vf[c2], O[ti], 0, 0, 0); }
                gla_state_update(S, Vf, lds, i16, g);
                if (dir == 0) {
#pragma unroll
                    for (int ti = 0; ti < 4; ++ti)
#pragma unroll
                        for (int r = 0; r < 4; ++r) OF[(size_t)(rb + 16 * ti + 4 * g + r) * DM + col] = O[ti][r];
                    __syncthreads();
                } else {
                    float part[4][4];
#pragma unroll
                    for (int ti = 0; ti < 4; ++ti)
#pragma unroll
                        for (int r = 0; r < 4; ++r) { const float o = O[ti][r] + OF[(size_t)(rb + 63 - (16 * ti + 4 * g + r)) * DM + col]; O[ti][r] = o; float s2 = o * o;
                            s2 += __shfl_xor(s2, 1); s2 += __shfl_xor(s2, 2); s2 += __shfl_xor(s2, 4); s2 += __shfl_xor(s2, 8); part[ti][r] = s2; }
                    if (i16 == 0) {
#pragma unroll
                        for (int ti = 0; ti < 4; ++ti) *(LAS f32x4*)(lds + GL_SSQ + (w * 64 + 16 * ti + 4 * g) * 4) = (f32x4){part[ti][0], part[ti][1], part[ti][2], part[ti][3]}; }
                    __syncthreads();
                    if (tid < 64) { float s2 = 0.f;
#pragma unroll
                        for (int ww = 0; ww < 8; ++ww) s2 += ((const LAS float*)(lds + GL_SSQ))[ww * 64 + tid];
                        ((LAS float*)(lds + GL_RSTD))[tid] = 1.f / sqrtf(s2 * (1.f / 128.f) + 1e-6f); }
                    __syncthreads();
#pragma unroll
                    for (int ti = 0; ti < 4; ++ti) { const f32x4 rs = *(const LAS f32x4*)(lds + GL_RSTD + (16 * ti + 4 * g) * 4);
#pragma unroll
                        for (int r = 0; r < 4; ++r) { const size_t off = (size_t)(rb + 63 - (16 * ti + 4 * g + r)) * DM + col;
                            ON[off] = (bf16_t)f2bf(O[ti][r] * rs[r] * ngv * bf2f(G[off])); } }
                }
            }
            asm volatile("s_waitcnt vmcnt(0)" ::: "memory");
            __syncthreads();
        }
    }
}

__device__ __forceinline__ void ph_modffn(const Params& p, unsigned char* lds, int bid, int nblk, int l) {
    int tid_ = threadIdx.x; asm volatile("" : "+v"(tid_));
    const int tid = tid_, lane = tid & 63, wave = tid >> 6;
    float* rw = (float*)lds;
    float* stg = (float*)(lds + 71680);
    const float* router = p.in[I_ROUTER] + (size_t)l * DM * NE;
    for (int i = tid; i < DM * NE / 4; i += NTHR) { const int d = i >> 2; *(f32x4*)(rw + d * 16 + (d >> 2) * 4 + (i & 3) * 4) = ((const f32x4*)router)[i]; }
    __syncthreads();
    const float* X = (const float*)(p.ws + WS_X); bf16_t* H = (bf16_t*)(p.ws + WS_H); float* aff = (float*)(p.ws + WS_AFF); int* slot = (int*)(p.ws + WS_SLOT);
    const float* g = p.in[I_NFFN] + (size_t)l * DM; const float* mod = (const float*)(p.ws + WS_MOD);
    for (int base = bid * 64; base < NTOK; base += nblk * 64) {
        const int b = base >> 13, t0 = base & (SEQ - 1);
        const float* mv = mod + (size_t)(l * 3 + b) * NADA; const float* sh = mv + 3 * DM; const float* sc = mv + 4 * DM;
#pragma unroll 1
        for (int r = 0; r < 8; ++r) {
            const int row = base + 8 * wave + r;
            f32x4 v[4]; float ss = 0.f;
#pragma unroll
            for (int j = 0; j < 4; ++j) { v[j] = *(const f32x4*)(X + (size_t)row * DM + 256 * j + 4 * lane); ss += (v[j][0] * v[j][0] + v[j][1] * v[j][1]) + (v[j][2] * v[j][2] + v[j][3] * v[j][3]); }
            const float rstd = 1.f / sqrtf(wave_sum(ss) * (1.f / DM) + 1e-6f);
            float lg[16];
#pragma unroll
            for (int e = 0; e < 16; ++e) lg[e] = 0.f;
#pragma unroll
            for (int j = 0; j < 4; ++j) { const int c0 = 256 * j + 4 * lane; const f32x4 gv = *(const f32x4*)(g + c0), shv = *(const f32x4*)(sh + c0), scv = *(const f32x4*)(sc + c0);
                f32x4 h;
#pragma unroll
                for (int i = 0; i < 4; ++i) { h[i] = (v[j][i] * rstd * gv[i]) * (1.f + scv[i]) + shv[i];
                    const float* rp = rw + (c0 + i) * 16 + (c0 >> 2) * 4; const f32x4 r0 = *(const f32x4*)(rp), r1 = *(const f32x4*)(rp + 4), r2 = *(const f32x4*)(rp + 8), r3 = *(const f32x4*)(rp + 12);
#pragma unroll
                    for (int e = 0; e < 4; ++e) { lg[e] += h[i] * r0[e]; lg[4 + e] += h[i] * r1[e]; lg[8 + e] += h[i] * r2[e]; lg[12 + e] += h[i] * r3[e]; }
                    asm volatile("" ::: "memory"); }
                u32x2 w; w.x = pk2(h[0], h[1]); w.y = pk2(h[2], h[3]); *(u32x2*)(H + (size_t)row * DM + c0) = w; }
            float a8[8], a4[4], a2[2], a1;
            { const bool hi = (lane & 32) != 0;
#pragma unroll
                for (int i = 0; i < 8; ++i) { const float send = hi ? lg[i] : lg[8 + i], keep = hi ? lg[8 + i] : lg[i]; a8[i] = keep + __shfl_xor(send, 32); } }
            { const bool hi = (lane & 16) != 0;
#pragma unroll
                for (int i = 0; i < 4; ++i) { const float send = hi ? a8[i] : a8[4 + i], keep = hi ? a8[4 + i] : a8[i]; a4[i] = keep + __shfl_xor(send, 16); } }
            { const bool hi = (lane & 8) != 0;
#pragma unroll
                for (int i = 0; i < 2; ++i) { const float send = hi ? a4[i] : a4[2 + i], keep = hi ? a4[2 + i] : a4[i]; a2[i] = keep + __shfl_xor(send, 8); } }
            { const bool hi = (lane & 4) != 0; const float send = hi ? a2[0] : a2[1], keep = hi ? a2[1] : a2[0]; a1 = keep + __shfl_xor(send, 4); }
            a1 += __shfl_xor(a1, 2); a1 += __shfl_xor(a1, 1);
            float mx = a1;
            mx = fmaxf(mx, __shfl_xor(mx, 4)); mx = fmaxf(mx, __shfl_xor(mx, 8)); mx = fmaxf(mx, __shfl_xor(mx, 16)); mx = fmaxf(mx, __shfl_xor(mx, 32));
            const float ex = expf(a1 - mx); float den = ex;
            den += __shfl_xor(den, 4); den += __shfl_xor(den, 8); den += __shfl_xor(den, 16); den += __shfl_xor(den, 32);
            if ((lane & 3) == 0) stg[((lane >> 2) & 15) * 64 + 8 * wave + r] = ex / den;
        }
        __syncthreads();
        { const int e = tid >> 5, tt = (tid & 31) * 2; *(f32x2*)(aff + (size_t)(b * NE + e) * SEQ + t0 + tt) = *(const f32x2*)(stg + e * 64 + tt);
            *(u32x2*)(slot + (size_t)base * NE + 2 * tid) = (u32x2){0xffffffffu, 0xffffffffu}; }
        __syncthreads();
    }
}

__device__ __forceinline__ void ph_topk(const Params& p, unsigned char* lds, int bid, int nblk) {
    int tid_ = threadIdx.x; asm volatile("" : "+v"(tid_)); const int tid = tid_, lane = tid & 63, wave = tid >> 6;
    unsigned* hist = (unsigned*)lds;
    unsigned* ctl = hist + 256;
    unsigned* wsum = ctl + 8;
    const float* aff = (const float*)(p.ws + WS_AFF); int* topi = (int*)(p.ws + WS_TOPI); float* topg = (float*)(p.ws + WS_TOPG); int* slot = (int*)(p.ws + WS_SLOT);
    for (int it = bid; it < NB * NE; it += nblk) {
        const int b = it >> 4, e = it & 15; const float* src = aff + (size_t)it * SEQ + 16 * tid;
        unsigned key[16];
#pragma unroll
        for (int j = 0; j < 4; ++j) { const f32x4 v = *(const f32x4*)(src + 4 * j); key[4 * j] = __float_as_uint(v[0]); key[4 * j + 1] = __float_as_uint(v[1]); key[4 * j + 2] = __float_as_uint(v[2]); key[4 * j + 3] = __float_as_uint(v[3]); }
        unsigned prefix = 0u;
#pragma unroll 1
        for (int bit = 30; bit >= 0; --bit) {
            const unsigned cand = prefix | (1u << bit);
            unsigned cnt = 0u;
#pragma unroll
            for (int i = 0; i < 16; ++i) cnt += (unsigned)__popcll(__ballot(key[i] >= cand));
            if (lane == 0) wsum[(bit & 1) * 8 + wave] = cnt;
            __syncthreads();
            unsigned tot = 0u;
#pragma unroll
            for (int w2 = 0; w2 < 8; ++w2) tot += wsum[(bit & 1) * 8 + w2];
            if (tot >= (unsigned)CAP) prefix = cand;
        }
        __syncthreads();
        unsigned cg = 0u, ce = 0u;
#pragma unroll
        for (int i = 0; i < 16; ++i) { cg += key[i] > prefix ? 1u : 0u; ce += key[i] == prefix ? 1u : 0u; }
        unsigned pk = cg | (ce << 16), inc = pk;
#pragma unroll
        for (int o = 1; o < 64; o <<= 1) { const unsigned t = __shfl_up(inc, o); if (lane >= o) inc += t; }
        if (lane == 63) wsum[wave] = inc;
        __syncthreads();
        unsigned base = 0u, total = 0u;
#pragma unroll
        for (int w2 = 0; w2 < 8; ++w2) { const unsigned t = wsum[w2]; if (w2 < wave) base += t; total += t; }
        const unsigned excl = base + inc - pk;
        unsigned rg = excl & 0xffffu, re = excl >> 16; const unsigned ngt = total & 0xffffu, kth = (unsigned)CAP - ngt;
#pragma unroll
        for (int i = 0; i < 16; ++i) { int s = -1;
            if (key[i] > prefix) { s = (int)rg; ++rg; }
            else if (key[i] == prefix) { if (re < kth) s = (int)(ngt + re); ++re; }
            if (s >= 0) { const int idx = 16 * tid + i, r = (e * NB + b) * CAP + s; topi[r] = b * SEQ + idx; topg[r] = __uint_as_float(key[i]); slot[(size_t)(b * SEQ + idx) * NE + e] = s; } }
        __syncthreads();
    }
}

__device__ __forceinline__ void ph_gather(const Params& p, int bid, int nblk) {
    int tid_ = threadIdx.x; asm volatile("" : "+v"(tid_));
    const int tid = tid_, lane = tid & 63, wave = tid >> 6, gw = bid * 8 + wave, NGW = nblk * 8;
    const bf16_t* H = (const bf16_t*)(p.ws + WS_H); bf16_t* XG = (bf16_t*)(p.ws + WS_XG); const int* topi = (const int*)(p.ws + WS_TOPI);
    for (int r = gw; r < NSLOT; r += NGW) { const int src = topi[r];
        const u32x4* s = (const u32x4*)(H + (size_t)src * DM); u32x4* d = (u32x4*)(XG + (size_t)r * DM);
        d[lane] = s[lane]; d[64 + lane] = s[64 + lane]; }
}

__device__ __forceinline__ void ph_combine(const Params& p, int bid, int nblk, int l, bool final_) {
    int tid_ = threadIdx.x; asm volatile("" : "+v"(tid_));
    const int tid = tid_, lane = tid & 63, wave = tid >> 6, gw = bid * 8 + wave, NGW = nblk * 8;
    float* X = (float*)(p.ws + WS_X); bf16_t* H = (bf16_t*)(p.ws + WS_H); const bf16_t* Y = (const bf16_t*)(p.ws + WS_Y); const int* slot = (const int*)(p.ws + WS_SLOT);
    const float* mod = (const float*)(p.ws + WS_MOD);
    for (int row = gw; row < NTOK; row += NGW) {
        const int b = row >> 13;
        const float* g2 = mod + (size_t)(l * 3 + b) * NADA + 5 * DM;
        f32x4 a[4];
#pragma unroll
        for (int j = 0; j < 4; ++j) a[j] = (f32x4){0.f, 0.f, 0.f, 0.f};
        const int myslot = lane < 16 ? slot[(size_t)row * NE + lane] : -1;
        for (int e = 0; e < NE; ++e) { const int s = __shfl(myslot, e);
            if (s >= 0) { const bf16_t* yr = Y + (size_t)((e * NB + b) * CAP + s) * DM;
#pragma unroll
                for (int j = 0; j < 4; ++j) { const u32x2 yv = *(const u32x2*)(yr + 256 * j + 4 * lane);
                    a[j][0] += __uint_as_float(yv.x << 16); a[j][1] += __uint_as_float(yv.x & 0xffff0000u); a[j][2] += __uint_as_float(yv.y << 16); a[j][3] += __uint_as_float(yv.y & 0xffff0000u); } } }
        f32x4 v[4]; float ss = 0.f;
#pragma unroll
        for (int j = 0; j < 4; ++j) { const int c0 = 256 * j + 4 * lane; v[j] = *(const f32x4*)(X + (size_t)row * DM + c0) + *(const f32x4*)(g2 + c0) * a[j];
            ss += (v[j][0] * v[j][0] + v[j][1] * v[j][1]) + (v[j][2] * v[j][2] + v[j][3] * v[j][3]); }
        const float rstd = 1.f / sqrtf(wave_sum(ss) * (1.f / DM) + 1e-6f);
        if (final_) { const float* gf = p.in[I_NFIN];
#pragma unroll
            for (int j = 0; j < 4; ++j) { const int c0 = 256 * j + 4 * lane; const f32x4 gv = *(const f32x4*)(gf + c0); *(f32x4*)(p.out + (size_t)row * DM + c0) = v[j] * rstd * gv; }
        } else {
#pragma unroll
            for (int j = 0; j < 4; ++j) *(f32x4*)(X + (size_t)row * DM + 256 * j + 4 * lane) = v[j];
            const float* mv = mod + (size_t)((l + 1) * 3 + b) * NADA;
            store_mod_bf16(H + (size_t)row * DM, v, rstd, p.in[I_NMIX] + (size_t)(l + 1) * DM, mv, mv + DM, lane);
        }
    }
}

__device__ __forceinline__ void ph_conv(const Params& p, int bid, int nblk) {
    int tid_ = threadIdx.x; asm volatile("" : "+v"(tid_));
    const int tid = tid_, lane = tid & 63, wave = tid >> 6, gw = bid * 8 + wave, NGW = nblk * 8;
    const bf16_t* BG = (const bf16_t*)(p.ws + WS_BG); const bf16_t* CU = (const bf16_t*)(p.ws + WS_CU); bf16_t* Z = (bf16_t*)(p.ws + WS_Z);
    const float* wc = p.in[I_SCCONV];
    for (int row = gw; row < NTOK; row += NGW) { const int t = row & (SEQ - 1);
#pragma unroll
        for (int hh = 0; hh < 2; ++hh) { const int c0 = hh * 512 + 8 * lane; const size_t off = (size_t)row * DM + c0;
            const u16x8 z0 = {0, 0, 0, 0, 0, 0, 0, 0};
            const u16x8 um = t > 0 ? *(const u16x8*)(CU + off - DM) : z0, u0 = *(const u16x8*)(CU + off), up = t < SEQ - 1 ? *(const u16x8*)(CU + off + DM) : z0, bg = *(const u16x8*)(BG + off);
            float o[8];
#pragma unroll
            for (int i = 0; i < 8; ++i) o[i] = bf2f(bg[i]) * (wc[c0 + i] * bf2f(um[i]) + wc[DM + c0 + i] * bf2f(u0[i]) + wc[2 * DM + c0 + i] * bf2f(up[i]));
            u32x4 w; w.x = pk2(o[0], o[1]); w.y = pk2(o[2], o[3]); w.z = pk2(o[4], o[5]); w.w = pk2(o[6], o[7]); *(u32x4*)(Z + off) = w; }
    }
}

#define XB_TMO      128
#define XB_XCNT(j)  (256  + 64 * (j))
#define XB_XSUB(j)  (1280 + 64 * (j))
#define XB_XGEN(j)  (2304 + 64 * (j))
#define XB_TOP      3328
#define XB_TOPGEN   3392
#define XCD_BAR_WORDS 3456
#define XB_SPIN_CAP (1u << 18)
__device__ __forceinline__ unsigned xb_ld(unsigned* p)              { return __hip_atomic_load(p, __ATOMIC_RELAXED, __HIP_MEMORY_SCOPE_AGENT); }
__device__ __forceinline__ unsigned xb_add(unsigned* p, unsigned v) { return __hip_atomic_fetch_add(p, v, __ATOMIC_RELAXED, __HIP_MEMORY_SCOPE_AGENT); }
__device__ __forceinline__ unsigned xb_xcc_id() { return (unsigned)__builtin_amdgcn_s_getreg((3 << 11) | 20) & 0xFu; }
#define XB_SPIN(cond, bar) do { unsigned _sp = 0; while (cond) { __builtin_amdgcn_s_sleep(1); \
    if ((++_sp & 255u) == 0u) { if (xb_ld(&(bar)[XB_TMO])) break; if (_sp > XB_SPIN_CAP) { atomicAdd(&(bar)[XB_TMO], 1u); break; } } } } while (0)
struct XcdBarrier { unsigned* bar; unsigned x; volatile LAS unsigned* st; };
__device__ __forceinline__ XcdBarrier xcd_barrier_post(unsigned* bar, volatile LAS unsigned* st) {
    XcdBarrier b; b.bar = bar; b.x = xb_xcc_id(); b.st = st;
    if (threadIdx.x == 0) (void)xb_add(&bar[XB_XCNT(b.x)], 1u);
    return b;
}
__device__ __forceinline__ void xcd_barrier_complete(unsigned* bar, unsigned x, unsigned& nloc, unsigned& nx) {
    const unsigned G = gridDim.x * gridDim.y * gridDim.z;
    unsigned sum, cnt, mine, sp = 0u;
    for (;;) {
        sum = 0u; cnt = 0u; mine = 0u;
#pragma unroll
        for (unsigned j = 0; j < 16; ++j) { const unsigned c = xb_ld(&bar[XB_XCNT(j)]); sum += c; cnt += (c > 0u) ? 1u : 0u; mine = (j == x) ? c : mine; }
        if (sum == G) break;
        __builtin_amdgcn_s_sleep(1);
        if ((++sp & 255u) == 0u) { if (xb_ld(&bar[XB_TMO])) break; if (sp > XB_SPIN_CAP) { atomicAdd(&bar[XB_TMO], 1u); break; } }
    }
    nloc = mine > 0u ? mine : 1u; nx = cnt > 0u ? cnt : 1u;
}
__device__ __forceinline__ void xcd_barrier(unsigned* bar_, volatile LAS unsigned* st_) {
    XcdBarrier b; b.bar = bar_; b.x = xb_xcc_id(); b.st = st_;
    asm volatile("s_waitcnt vmcnt(0)" ::: "memory");
    __syncthreads();
    if (threadIdx.x == 0) {
        unsigned* bar = b.bar;
        __builtin_amdgcn_s_waitcnt(0);
        unsigned nloc = b.st[0], nx = b.st[1];
        if (nloc == 0u) { xcd_barrier_complete(bar, b.x, nloc, nx); b.st[0] = nloc; b.st[1] = nx; }
        const unsigned old = xb_add(&bar[XB_XSUB(b.x)], 1u);
        const unsigned gen = old / nloc;
        if (old + 1u == (gen + 1u) * nloc) {
            __builtin_amdgcn_fence(__ATOMIC_RELEASE, "agent");
            asm volatile("s_waitcnt vmcnt(0)" ::: "memory");
            const unsigned og = xb_add(&bar[XB_TOP], 1u);
            const unsigned tg = og / nx;
            if (og + 1u == (tg + 1u) * nx) xb_add(&bar[XB_TOPGEN], 1u);
            else XB_SPIN(xb_ld(&bar[XB_TOPGEN]) == tg, bar);
            __builtin_amdgcn_fence(__ATOMIC_ACQUIRE, "agent");
            xb_add(&bar[XB_XGEN(b.x)], 1u);
            asm volatile("s_waitcnt vmcnt(0)" ::: "memory");
        } else {
            XB_SPIN(xb_ld(&bar[XB_XGEN(b.x)]) == gen, bar);
            __builtin_amdgcn_fence(__ATOMIC_ACQUIRE, "agent");
            asm volatile("s_waitcnt vmcnt(0)" ::: "memory");
        }
    }
    __syncthreads();
}

constexpr int NPHASE = 19;
constexpr int MISC_OFF = 131072 + 320;
constexpr int CW_BAR = 4096;
constexpr int CW_CTX = 1024;
template <int LO, int HI> __global__ void __launch_bounds__(NTHR, 2) mega(Params p) {
    extern __shared__ __attribute__((aligned(16))) unsigned char lds[];
    const int bid = blockIdx.x, nblk = gridDim.x;
    PG8_LAS unsigned char* l3 = (PG8_LAS unsigned char*)lds;
    unsigned char* ws = p.ws;
    const float* mod = (const float*)(ws + WS_MOD);
    constexpr bool MULTI = (HI - LO) > 1;
    if (MULTI) {
        volatile LAS unsigned* MISC = (volatile LAS unsigned*)(l3 + MISC_OFF);
        if (threadIdx.x < 32) MISC[threadIdx.x] = 0u;
        __syncthreads();
        (void)xcd_barrier_post((unsigned*)(ws + WS_CTL) + CW_BAR, MISC + 8);
    }
#define IN(k) (LO <= (k) && (k) < HI)
#ifndef PROBE_DUP
#define PROBE_DUP 0u
#endif
#define DUPQ(k) (((PROBE_DUP) >> (k)) & 1u)
#define BARRIER_NOW() xcd_barrier((unsigned*)(p.ws + WS_CTL) + CW_BAR, (volatile LAS unsigned*)(l3 + MISC_OFF) + 8)
#define SEAM(k) do { if (IN(k) && IN((k) + 1)) xcd_barrier((unsigned*)(p.ws + WS_CTL) + CW_BAR, (volatile LAS unsigned*)(l3 + MISC_OFF) + 8); } while (0)
#define PHASE(k, ...) do { if (IN(k)) { __VA_ARGS__; if (DUPQ(k)) { BARRIER_NOW(); __VA_ARGS__; } } SEAM(k); } while (0)
#define GEMM_INPROJ() do { pg8::Gemm g{(const bf16_t*)(ws + WS_H), (const bf16_t*)(ws + WS_WHGIN), NTOK, 5120, DM}; pg8::StaticOrder S; S.init(NTOK, 5120, nblk, bid, 0); EpiInProj E{ws}; pg8::gemm_phase<EpiInProj, pg8::StaticOrder, false>(l3, g, S, E, nullptr); } while (0)
#define GEMM_OUT(AOFF, WOFF, GATE) do { pg8::Gemm g{(const bf16_t*)(ws + (AOFF)), (const bf16_t*)(ws + (WOFF)), NTOK, DM, DM}; pg8::StaticOrder S; S.init(NTOK, DM, nblk, bid, 0); EpiResid E{(float*)(ws + WS_X), (GATE)}; pg8::gemm_phase<EpiResid, pg8::StaticOrder, false>(l3, g, S, E, nullptr); } while (0)
#define GEMM_MOE1(l) do { pg8::Gemm g{(const bf16_t*)(ws + WS_H), (const bf16_t*)(ws + WS_WMOE1) + (size_t)(l) * NE * 4096 * DM, NSLOT, 4096, DM}; pg8::StaticOrder S; S.init(NSLOT, 4096, nblk, bid, 8); EpiGLU E{(bf16_t*)(ws + WS_ACT)}; pg8::gemm_phase<EpiGLU, pg8::StaticOrder, true>(l3, g, S, E, (const int*)(ws + WS_TOPI)); } while (0)
#define GEMM_MOE2(l) do { pg8::Gemm g{(const bf16_t*)(ws + WS_ACT), (const bf16_t*)(ws + WS_WMOE2) + (size_t)(l) * NE * DM * DE, NSLOT, DM, DE}; pg8::StaticOrder S; S.init(NSLOT, DM, nblk, bid, 8); EpiRowScale E{(bf16_t*)(ws + WS_Y), (const float*)(ws + WS_TOPG)}; pg8::gemm_phase<EpiRowScale, pg8::StaticOrder, false>(l3, g, S, E, nullptr); } while (0)
#define GEMM_CONVIN() do { pg8::Gemm g{(const bf16_t*)(ws + WS_H), (const bf16_t*)(ws + WS_WSCIN), NTOK, 3072, DM}; pg8::StaticOrder S; S.init(NTOK, 3072, nblk, bid, 0); EpiConvIn E{(bf16_t*)(ws + WS_BG), (bf16_t*)(ws + WS_CU)}; pg8::gemm_phase<EpiConvIn, pg8::StaticOrder, false>(l3, g, S, E, nullptr); } while (0)
#define MOD0_PHASE() do { if (nblk >= 48) { if (bid < 24) { ph_mod0(p, NTOK + (bid * NCTX) / 24, NTOK + ((bid + 1) * NCTX) / 24, 0, 1); \
              \
            asm volatile("s_waitcnt vmcnt(0)" ::: "memory"); __syncthreads(); \
            if (threadIdx.x == 0) { unsigned* cnt = (unsigned*)(p.ws + WS_CTL) + CW_CTX; __builtin_amdgcn_fence(__ATOMIC_RELEASE, "agent"); asm volatile("s_waitcnt vmcnt(0)" ::: "memory"); \
                xb_add(cnt, 1u); unsigned sp_ = 0u; while (xb_ld(cnt) < 24u) { __builtin_amdgcn_s_sleep(1); if (++sp_ > (1u << 22)) break; } \
                __builtin_amdgcn_fence(__ATOMIC_ACQUIRE, "agent"); asm volatile("s_waitcnt vmcnt(0)" ::: "memory"); } \
            __syncthreads(); \
            pg8::Gemm g{(const bf16_t*)(ws + WS_H), (const bf16_t*)(ws + WS_WHGIN), NROW, 5120, DM}; pg8::OneUnit S{64 + bid / 12, 4 + bid % 12}; EpiInProj E{ws}; pg8::gemm_phase<EpiInProj, pg8::OneUnit, false>(l3, g, S, E, nullptr); } \
          else ph_mod0(p, 0, NTOK, bid - 24, nblk - 24); } \
        else { ph_mod0(p, 0, NROW, bid, nblk); } } while (0)
#define CTX_TILES_FALLBACK() do { if (nblk < 48) { BARRIER_NOW(); pg8::Gemm g{(const bf16_t*)(ws + WS_H), (const bf16_t*)(ws + WS_WHGIN), NROW, 5120, DM}; \
        for (int ti = bid; ti < 24; ti += nblk) { pg8::OneUnit S{64 + ti / 12, 4 + ti % 12}; EpiInProj E{ws}; pg8::gemm_phase<EpiInProj, pg8::OneUnit, false>(l3, g, S, E, nullptr); } } } while (0)
    PHASE(0, ph_prep(p, lds, bid, nblk); __syncthreads(); ph_convert(p, lds, bid, nblk));
    if (IN(1)) { MOD0_PHASE(); CTX_TILES_FALLBACK(); }
    SEAM(1);
    PHASE(2, GEMM_INPROJ());
    PHASE(3, ph_gla_states(p, lds, bid, nblk));
    PHASE(4, ph_gla_out(p, lds, bid, nblk));
    if (IN(5)) GEMM_OUT(WS_ON, WS_WHGOUT, mod + 2 * DM);
    SEAM(5);
    PHASE(6, ph_modffn(p, lds, bid, nblk, 0));
    PHASE(7, ph_topk(p, lds, bid, nblk));
    PHASE(8, GEMM_MOE1(0));
    PHASE(9, GEMM_MOE2(0));
    if (IN(10)) ph_combine(p, bid, nblk, 0, false);
    SEAM(10);
    PHASE(11, GEMM_CONVIN());
    PHASE(12, ph_conv(p, bid, nblk));
    if (IN(13)) GEMM_OUT(WS_Z, WS_WSCOUT, mod + (size_t)3 * NADA + 2 * DM);
    SEAM(13);
    PHASE(14, ph_modffn(p, lds, bid, nblk, 1));
    PHASE(15, ph_topk(p, lds, bid, nblk));
    PHASE(16, GEMM_MOE1(1));
    PHASE(17, GEMM_MOE2(1));
    if (IN(18)) ph_combine(p, bid, nblk, 1, true);
#undef IN
#undef SEAM
}

#ifndef MK_SPLIT
#define MK_SPLIT 0
#endif
#if MK_SPLIT
#include <utility>
template <int... I> static void launch_all(std::integer_sequence<int, I...>, int grid, Params& p, hipStream_t stream) {
    ((void)hipFuncSetAttribute((const void*)mega<I, I + 1>, hipFuncAttributeMaxDynamicSharedMemorySize, LDS_BYTES), ...);
    ((mega<I, I + 1><<<dim3(grid), dim3(NTHR), LDS_BYTES, stream>>>(p)), ...); }
#endif
extern "C" void kernel_launch(void* const* d_in, const int* in_sizes, int n_in, void* d_out, int out_size, void* d_ws, size_t ws_size, hipStream_t stream) {
    static int grid = 0;
    if (grid == 0) {
        if (n_in != 20 || ws_size < WS_END) { fprintf(stderr, "kernel_launch: unexpected inputs (n_in %d, ws %zu, need %zu)\n", n_in, ws_size, (size_t)WS_END); grid = -1; return; }
        int dev = 0, cus = 0, per_cu = 0;
        (void)hipGetDevice(&dev); (void)hipDeviceGetAttribute(&cus, hipDeviceAttributeMultiprocessorCount, dev);
        (void)hipFuncSetAttribute((const void*)mega<0, NPHASE>, hipFuncAttributeMaxDynamicSharedMemorySize, LDS_BYTES);
        if (hipOccupancyMaxActiveBlocksPerMultiprocessor(&per_cu, (const void*)mega<0, NPHASE>, NTHR, LDS_BYTES) != hipSuccess || per_cu < 1) { fprintf(stderr, "kernel_launch: occupancy query failed (%d)\n", per_cu); per_cu = 1; }
        (void)hipGetLastError();
        if (per_cu > 1) per_cu = 1;
        grid = (cus > 0 ? cus : 256) * per_cu;
    }
    if (grid < 0) return;
    Params p{};
    for (int i = 0; i < 20; ++i) p.in[i] = (const float*)d_in[i];
    p.out = (float*)d_out; p.ws = (unsigned char*)d_ws;
#if MK_SPLIT
    launch_all(std::make_integer_sequence<int, NPHASE>{}, grid, p, stream);
#else
    (void)hipMemsetAsync((char*)d_ws + WS_CTL, 0, 65536, stream);
    void* args[] = {&p};
    hipError_t e = hipLaunchCooperativeKernel((const void*)mega<0, NPHASE>, dim3(grid), dim3(NTHR), args, LDS_BYTES, stream);
    if (e != hipSuccess) fprintf(stderr, "kernel_launch: cooperative launch failed: %s (grid %d)\n", hipGetErrorString(e), grid);
#endif
}
```

```cpp
#include <hip/hip_runtime.h>
#include <cstdio>
#include <cstdint>

namespace pg8 {
#define PG8_LAS __attribute__((address_space(3)))
typedef unsigned short bf16_t;
typedef short bf16x8 __attribute__((ext_vector_type(8)));
typedef float f32x4 __attribute__((ext_vector_type(4)));
typedef unsigned u32x4 __attribute__((ext_vector_type(4)));
typedef unsigned u32x2 __attribute__((ext_vector_type(2)));
constexpr int BM = 256, BK = 64, HALF = 128, HTB = HALF * BK * 2, STAGE_BYTES = 8 * HTB, NXCD = 8, WGM = 8;

__host__ __device__ __forceinline__ int lds_byte(int r, int c) { const int st = (r >> 4) * 2 + (c >> 5), rr = r & 15, cc = c & 31, ob = rr * 64 + cc * 2; return st * 1024 + (ob ^ (((ob >> 9) & 1) << 5)); }
__host__ __device__ __forceinline__ void stage_rc(int b, int& R, int& C) { const int st = b / 1024, sb = b % 1024, swz = sb ^ (((sb >> 9) & 1) << 5); R = (st >> 1) * 16 + swz / 64; C = (st & 1) * 32 + (swz % 64) / 2; }
__host__ __device__ __forceinline__ int perm32(int rho) { const int n = rho >> 4, i = rho & 15; return 8 * (i >> 2) + 4 * n + (i & 3); }

struct Unit { int pm, pn, pb; };
struct Gemm { const bf16_t* A; const bf16_t* Bt; int M, N, K; };

struct StaticOrder {
    int nM, nN, nwg, G, c, mpe;
    __device__ void init(int M, int N, int G_, int c_, int mpe_) { nM = M / BM; nN = N / BM; nwg = nM * nN; G = G_; c = c_; mpe = mpe_; }
    __device__ bool next(int i, Unit& u) const {
        const long L = (long)i * G + c; if (L >= nwg) return false;
        int wgid = (int)L; { const int q = nwg / NXCD, r = nwg % NXCD, xcd = wgid % NXCD, off = wgid / NXCD; wgid = (xcd < r ? xcd * (q + 1) : r * (q + 1) + (xcd - r) * q) + off; }
        const int nig = WGM * nN, gid = wgid / nig, fm = gid * WGM, gsz = (nM - fm) < WGM ? (nM - fm) : WGM;
        u.pm = fm + ((wgid % nig) % gsz); u.pn = (wgid % nig) / gsz; u.pb = mpe > 0 ? (u.pm / mpe) * nN + u.pn : u.pn; return true;
    }
};

__device__ __forceinline__ unsigned cvt_pk_bf16(float lo, float hi) { unsigned r; asm volatile("v_cvt_pk_bf16_f32 %0, %1, %2" : "=v"(r) : "v"(lo), "v"(hi)); return r; }

struct RangeOrder {
    StaticOrder S; int lo, hi;
    __device__ bool next(int i, Unit& u) const { return (lo + i < hi) ? S.next(lo + i, u) : false; }
};
struct OneUnit {
    int pm, pn;
    __device__ bool next(int i, Unit& u) const { if (i != 0) return false; u.pm = pm; u.pn = pn; u.pb = pn; return true; }
};
template <class Epi, class Sched, bool GATHER>
__device__ __forceinline__ void gemm_phase(PG8_LAS unsigned char* lds, const Gemm g, const Sched& S, const Epi& E, const int* gidx) {
    int tid_ = threadIdx.x; asm volatile("" : "+v"(tid_));
    const int tid = tid_, wid = __builtin_amdgcn_readfirstlane(tid >> 6), lane = tid & 63, wr = wid >> 2, wc = wid & 3, fr = lane & 15, fq = lane >> 4;
    const int K = g.K, nt = K / BK;
    unsigned voffA[2], voffB[2]; int rA[2], cA2[2];
#pragma unroll
    for (int i = 0; i < 2; ++i) { int R, C; stage_rc(tid * 16 + i * 8192, R, C); const int Rb = Epi::PERM ? ((R & ~31) + perm32(R & 31)) : R;
        voffA[i] = (unsigned)(R * K + C) * 2u; voffB[i] = (unsigned)(Rb * K + C) * 2u; rA[i] = R; cA2[i] = C * 2; }
    unsigned gcur[2][2], gnxt[2][2];
#define PG8_GOFF(dst, u) do { _Pragma("unroll") for (int _h = 0; _h < 2; ++_h) _Pragma("unroll") for (int _i = 0; _i < 2; ++_i) \
        dst[_h][_i] = (unsigned)gidx[(u).pm * BM + _h * HALF + rA[_i]] * (unsigned)(K * 2) + (unsigned)cA2[_i]; } while (0)
    const size_t kstep = (size_t)(BK * 2);
    const size_t hstep = (size_t)HALF * K * 2;
    const size_t tstep = 2 * hstep;
    const unsigned ldsw = (unsigned)wid * 1024u;
    const int aoff = lds_byte(wr * 64 + fr, fq * 8), boff = lds_byte(wc * 32 + fr, fq * 8);
#define PG8_SA(b, h) (((b) * 2 + (h)) * HTB)
#define PG8_SB(b, h) ((4 + (b) * 2 + (h)) * HTB)
#define PG8_STAGE(bufoff, gbase, voff) do { _Pragma("unroll") for (int _i = 0; _i < 2; ++_i) \
        __builtin_amdgcn_global_load_lds((const unsigned*)((const char*)(gbase) + (voff)[_i]), (PG8_LAS unsigned*)(lds + (bufoff) + ldsw + _i * 8192), 16, 0, 0); } while (0)
#define PG8_STAGE_A(bufoff, half, kb, NX) do { _Pragma("unroll") for (int _i = 0; _i < 2; ++_i) { \
        const char* _src = GATHER ? (const char*)g.A + (kb) + ((NX) ? gnxt[half][_i] : gcur[half][_i]) : ((NX) ? nA : cA) + (size_t)(half) * hstep + (kb) + voffA[_i]; \
        __builtin_amdgcn_global_load_lds((const unsigned*)_src, (PG8_LAS unsigned*)(lds + (bufoff) + ldsw + _i * 8192), 16, 0, 0); } } while (0)
#define PG8_LDA(dst, b, h) do { _Pragma("unroll") for (int m = 0; m < 4; ++m) _Pragma("unroll") for (int k = 0; k < 2; ++k) dst[m][k] = *(const PG8_LAS bf16x8*)(lds + PG8_SA(b, h) + aoff + m * 2048 + k * 1024); } while (0)
#define PG8_LDB(dst, b, h) do { _Pragma("unroll") for (int n = 0; n < 2; ++n) _Pragma("unroll") for (int k = 0; k < 2; ++k) dst[n][k] = *(const PG8_LAS bf16x8*)(lds + PG8_SB(b, h) + boff + n * 2048 + k * 1024); } while (0)
#define PG8_MMA(ai, bj, At, Bt) do { __builtin_amdgcn_s_setprio(1); _Pragma("unroll") for (int m = 0; m < 4; ++m) _Pragma("unroll") for (int n = 0; n < 2; ++n) _Pragma("unroll") for (int k = 0; k < 2; ++k) \
        acc[ai][bj][m][n] = __builtin_amdgcn_mfma_f32_16x16x32_bf16(Bt[n][k], At[m][k], acc[ai][bj][m][n], 0, 0, 0); __builtin_amdgcn_s_setprio(0); } while (0)
#define PG8_WAIT_V(n) asm volatile("s_waitcnt vmcnt(" #n ")" ::: "memory")
#define PG8_WAIT_L(n) asm volatile("s_waitcnt lgkmcnt(" #n ")" ::: "memory")
#define PG8_BAR __builtin_amdgcn_s_barrier()
#define PG8_SCHED __builtin_amdgcn_sched_barrier(0)
    Unit cur, nxt; int ui = 0;
    if (!S.next(0, cur)) return;
    f32x4 acc[2][2][4][2];
#pragma unroll
    for (int a = 0; a < 2; ++a)
#pragma unroll
        for (int b = 0; b < 2; ++b)
#pragma unroll
            for (int m = 0; m < 4; ++m)
#pragma unroll
                for (int n = 0; n < 2; ++n) acc[a][b][m][n] = (f32x4){0.f, 0.f, 0.f, 0.f};
    bf16x8 At[4][2], B0[2][2], B1[2][2];
    const char* cA = GATHER ? (const char*)g.A : (const char*)g.A + (size_t)cur.pm * tstep; const char* cB = (const char*)g.Bt + (size_t)cur.pb * tstep; const char* nA = cA;
    if (GATHER) { PG8_GOFF(gcur, cur); }
    PG8_STAGE(PG8_SB(0, 0), cB, voffB); PG8_STAGE(PG8_SB(0, 1), cB + hstep, voffB); PG8_STAGE_A(PG8_SA(0, 0), 0, 0, false); PG8_STAGE_A(PG8_SA(0, 1), 1, 0, false);
    if (wr == 1) PG8_BAR;
    PG8_WAIT_V(2); PG8_BAR;
    PG8_STAGE(PG8_SB(1, 0), cB + kstep, voffB); PG8_STAGE_A(PG8_SA(1, 0), 0, kstep, false); PG8_STAGE(PG8_SB(1, 1), cB + hstep + kstep, voffB);
    PG8_WAIT_V(6); PG8_BAR;
    for (;;) {
        const bool has_next = S.next(ui + 1, nxt);
        nA = GATHER ? cA : (has_next ? (const char*)g.A + (size_t)nxt.pm * tstep : cA); const char* nB = has_next ? (const char*)g.Bt + (size_t)nxt.pb * tstep : cB;
        if (GATHER) { if (has_next) { PG8_GOFF(gnxt, nxt); } else {
#pragma unroll
            for (int _h = 0; _h < 2; ++_h)
#pragma unroll
                for (int _i = 0; _i < 2; ++_i) gnxt[_h][_i] = gcur[_h][_i]; } }
        for (int t = 0; t < nt; t += 2) {
            const bool last = (t == nt - 2);
            const size_t k1 = (size_t)(t + 1) * kstep, k2 = last ? 0 : (size_t)(t + 2) * kstep, k3 = k2 + kstep;
            const char* b2 = last ? nB : cB + (size_t)(t + 2) * kstep; const char* b3 = b2 + kstep;
            PG8_LDB(B0, 0, 0); PG8_LDB(B1, 0, 1); PG8_SCHED; PG8_LDA(At, 0, 0); PG8_STAGE_A(PG8_SA(1, 1), 1, k1, false);
            PG8_WAIT_V(8); PG8_WAIT_L(0); PG8_BAR; PG8_MMA(0, 0, At, B0); PG8_MMA(0, 1, At, B1); PG8_BAR; PG8_SCHED;
            PG8_LDA(At, 0, 1); PG8_STAGE(PG8_SB(0, 0), b2, voffB); PG8_STAGE(PG8_SB(0, 1), b2 + hstep, voffB); PG8_STAGE_A(PG8_SA(0, 0), 0, k2, last);
            PG8_WAIT_V(8); PG8_WAIT_L(0); PG8_BAR; PG8_MMA(1, 0, At, B0); PG8_MMA(1, 1, At, B1); PG8_BAR; PG8_SCHED;
            PG8_LDB(B0, 1, 0); PG8_LDB(B1, 1, 1); PG8_SCHED; PG8_LDA(At, 1, 0); PG8_STAGE_A(PG8_SA(0, 1), 1, k2, last);
            PG8_WAIT_V(8); PG8_WAIT_L(0); PG8_BAR; PG8_MMA(0, 0, At, B0); PG8_MMA(0, 1, At, B1); PG8_BAR; PG8_SCHED;
            PG8_LDA(At, 1, 1); PG8_STAGE(PG8_SB(1, 0), b3, voffB); PG8_STAGE(PG8_SB(1, 1), b3 + hstep, voffB); PG8_STAGE_A(PG8_SA(1, 0), 0, k3, last);
            PG8_WAIT_V(8); PG8_WAIT_L(0); PG8_BAR; PG8_MMA(1, 0, At, B0); PG8_MMA(1, 1, At, B1); PG8_BAR; PG8_SCHED;
        }
        if (wr == 0) PG8_BAR;
        E(acc, cur, wr, wc, fr, fq);
        if (!has_next) break;
#pragma unroll
        for (int a = 0; a < 2; ++a)
#pragma unroll
            for (int b = 0; b < 2; ++b)
#pragma unroll
                for (int m = 0; m < 4; ++m)
#pragma unroll
                    for (int n = 0; n < 2; ++n) acc[a][b][m][n] = (f32x4){0.f, 0.f, 0.f, 0.f};
        cur = nxt; cA = nA; cB = nB; ++ui;
        if (GATHER) {
#pragma unroll
            for (int _h = 0; _h < 2; ++_h)
#pragma unroll
                for (int _i = 0; _i < 2; ++_i) gcur[_h][_i] = gnxt[_h][_i]; }
        if (wr == 1) PG8_BAR;
    }
    PG8_WAIT_V(0);
    PG8_BAR;
#undef PG8_SA
#undef PG8_SB
#undef PG8_STAGE
#undef PG8_STAGE_A
#undef PG8_GOFF
#undef PG8_LDA
#undef PG8_LDB
#undef PG8_MMA
#undef PG8_WAIT_V
#undef PG8_WAIT_L
#undef PG8_BAR
#undef PG8_SCHED
}
}

#define LAS __attribute__((address_space(3)))
using pg8::bf16_t; using pg8::f32x4; using pg8::u32x4; using pg8::u32x2;
typedef unsigned short u16x8 __attribute__((ext_vector_type(8)));
typedef float f32x2 __attribute__((ext_vector_type(2)));

constexpr int DM = 1024, NB = 2, SEQ = 8192, NTOK = NB * SEQ, CTXL = 256, NCTX = NB * CTXL, NROW = NTOK + NCTX;
constexpr int NE = 16, CAP = 1024, DE = 2048, NSLOT = NE * NB * CAP;
constexpr int NADA = 6 * DM;
constexpr int NTHR = 512;

constexpr size_t MiB = 1u << 20;
constexpr size_t WS_CTL = 0;
constexpr size_t WS_MOD = 1 * MiB;
constexpr size_t WS_LB = WS_MOD + 256 * 1024;
constexpr size_t WS_POSR = WS_LB + 64 * 1024;
constexpr size_t WS_POSC = WS_POSR + 256 * 1024;
constexpr size_t WS_AFF = 2 * MiB;
constexpr size_t WS_TOPI = 3 * MiB;
constexpr size_t WS_TOPG = WS_TOPI + 128 * 1024;
constexpr size_t WS_SLOT = 4 * MiB;
constexpr size_t WS_WHGIN = 6 * MiB;
constexpr size_t WS_WHGOUT = 16 * MiB;
constexpr size_t WS_WSCIN = 18 * MiB;
constexpr size_t WS_WSCOUT = 24 * MiB;
constexpr size_t WS_WMOE1 = 26 * MiB;
constexpr size_t WS_WMOE2 = WS_WMOE1 + 256 * MiB;
constexpr size_t WS_X = WS_WMOE2 + 128 * MiB;
constexpr size_t WS_H = WS_X + 64 * MiB;
constexpr size_t WS_R = WS_H + 34 * MiB;
constexpr size_t WS_Q = WS_R;
constexpr size_t WS_V = WS_Q + 34 * MiB;
constexpr size_t WS_G = WS_V + 34 * MiB;
constexpr size_t WS_LF = WS_G + 34 * MiB;
constexpr size_t WS_LBK = WS_LF + 66 * MiB;
constexpr size_t WS_OF = WS_LBK + 66 * MiB;
constexpr size_t WS_OB = WS_OF + 64 * MiB;
constexpr size_t WS_U = WS_OB;
constexpr size_t WS_DD = WS_OB + 40 * MiB;
constexpr size_t WS_ON = WS_OB + 64 * MiB;
constexpr size_t WS_HG_END = WS_ON + 32 * MiB;
constexpr size_t WS_XG = WS_R;
constexpr size_t WS_ACT = WS_XG + 64 * MiB;
constexpr size_t WS_Y = WS_ACT + 128 * MiB;
constexpr size_t WS_MOE_END = WS_Y + 128 * MiB;
constexpr size_t WS_BG = WS_R;
constexpr size_t WS_CU = WS_BG + 32 * MiB;
constexpr size_t WS_Z = WS_CU + 32 * MiB;
constexpr size_t WS_END = WS_HG_END > WS_MOE_END ? WS_HG_END : WS_MOE_END;
static_assert(WS_END <= 1024 * MiB, "workspace map exceeds 1 GiB");

constexpr int LDS_BYTES = 147456;

struct Params { const float* in[20]; float* out; unsigned char* ws; int ph_lo, ph_hi; };
enum { I_X = 0, I_C, I_CTX, I_CCTX, I_ADAW, I_ADAB, I_NMIX, I_NFFN, I_NFIN, I_HGWIN, I_HGLB, I_HGNORM, I_HGWOUT, I_SCWIN, I_SCCONV, I_SCWOUT, I_ROUTER, I_WGATE, I_WUP, I_WDOWN };

typedef __bf16 bf16x2_t __attribute__((ext_vector_type(2)));
__device__ __forceinline__ unsigned pk2(float lo, float hi) { const f32x2 v = {lo, hi}; return __builtin_bit_cast(unsigned, __builtin_convertvector(v, bf16x2_t)); }
__device__ __forceinline__ unsigned f2bf(float f) { return pk2(f, 0.f) & 0xffffu; }
__device__ __forceinline__ float bf2f(unsigned short h) { return __builtin_bit_cast(float, (unsigned)h << 16); }
__device__ __forceinline__ float wave_sum(float v) {
#pragma unroll
    for (int o = 1; o < 64; o <<= 1) v += __shfl_xor(v, o);
    return v;
}
__device__ __forceinline__ float sigmoidf_(float x) { return 1.f / (1.f + expf(-x)); }
__device__ __forceinline__ float fsigmoid(float x) { return __builtin_amdgcn_rcpf(1.f + __builtin_amdgcn_exp2f(-1.4426950408889634f * x)); }
__device__ __forceinline__ float fsilu(float x) { return x * fsigmoid(x); }
__device__ __forceinline__ float siluf_(float x) { return x / (1.f + expf(-x)); }

struct EpiInProj {
    static constexpr bool PERM = false;
    unsigned char* ws;
    __device__ __forceinline__ void operator()(const f32x4 (&acc)[2][2][4][2], const pg8::Unit& u, int wr, int wc, int fr, int fq) const {
        const int sec = u.pn >> 2;
        const int row0 = u.pm * 256 + wr * 64 + fr, cb = (u.pn & 3) * 256 + wc * 32 + 4 * fq;
        if (sec == 0 || sec == 1 || sec == 4) {
            bf16_t* O = (bf16_t*)(ws + (sec == 0 ? WS_Q : (sec == 1 ? WS_V : WS_G)));
#pragma unroll
            for (int ai = 0; ai < 2; ++ai)
#pragma unroll
                for (int m = 0; m < 4; ++m) { bf16_t* rp = O + (size_t)(row0 + ai * 128 + m * 16) * DM + cb;
#pragma unroll
                    for (int bj = 0; bj < 2; ++bj)
#pragma unroll
                        for (int n = 0; n < 2; ++n) { f32x4 v = acc[ai][bj][m][n];
                            if (sec == 0) v = v * 0.08838834764831845f;
                            if (sec == 4) { v[0] = fsilu(v[0]); v[1] = fsilu(v[1]); v[2] = fsilu(v[2]); v[3] = fsilu(v[3]); }
                            u32x2 w; w.x = pk2(v[0], v[1]); w.y = pk2(v[2], v[3]); *(u32x2*)(rp + bj * 128 + n * 16) = w; } }
        } else {
            float* O = (float*)(ws + (sec == 2 ? WS_LF : WS_LBK)); const float* lb0 = (const float*)(ws + WS_LB);
            f32x4 lbv[2][2];
#pragma unroll
            for (int bj = 0; bj < 2; ++bj)
#pragma unroll
                for (int n = 0; n < 2; ++n) lbv[bj][n] = *(const f32x4*)(lb0 + cb + bj * 128 + n * 16);
#pragma unroll
            for (int ai = 0; ai < 2; ++ai)
#pragma unroll
                for (int m = 0; m < 4; ++m) { float* rp = O + (size_t)(row0 + ai * 128 + m * 16) * DM + cb;
#pragma unroll
                    for (int bj = 0; bj < 2; ++bj)
#pragma unroll
                        for (int n = 0; n < 2; ++n) { const f32x4 z = acc[ai][bj][m][n], lb = lbv[bj][n]; f32x4 o;
#pragma unroll
                            for (int i = 0; i < 4; ++i) o[i] = lb[i] + (1.f - lb[i]) * fsigmoid(z[i]);
                            *(f32x4*)(rp + bj * 128 + n * 16) = o; } }
        }
    }
};
struct EpiResid {
    static constexpr bool PERM = false;
    float* X; const float* gate;
    __device__ __forceinline__ void operator()(const f32x4 (&acc)[2][2][4][2], const pg8::Unit& u, int wr, int wc, int fr, int fq) const {
        const int row0 = u.pm * 256 + wr * 64 + fr, cb = u.pn * 256 + wc * 32 + 4 * fq;
        const float* gp = gate + (size_t)((u.pm * 256) / SEQ) * NADA + cb;
        f32x4 gv[2][2];
#pragma unroll
        for (int bj = 0; bj < 2; ++bj)
#pragma unroll
            for (int n = 0; n < 2; ++n) gv[bj][n] = *(const f32x4*)(gp + bj * 128 + n * 16);
#pragma unroll
        for (int ai = 0; ai < 2; ++ai)
#pragma unroll
            for (int m = 0; m < 4; ++m) { float* rp = X + (size_t)(row0 + ai * 128 + m * 16) * DM + cb;
#pragma unroll
                for (int bj = 0; bj < 2; ++bj)
#pragma unroll
                    for (int n = 0; n < 2; ++n) { f32x4* q = (f32x4*)(rp + bj * 128 + n * 16); *q = *q + gv[bj][n] * acc[ai][bj][m][n]; } }
    }
};
struct EpiGLU {
    static constexpr bool PERM = true;
    bf16_t* ACT;
    __device__ __forceinline__ void operator()(const f32x4 (&acc)[2][2][4][2], const pg8::Unit& u, int wr, int wc, int fr, int fq) const {
        const int row0 = u.pm * 256 + wr * 64 + fr, cb = u.pn * 128 + wc * 32 + 8 * fq;
#pragma unroll
        for (int ai = 0; ai < 2; ++ai)
#pragma unroll
            for (int m = 0; m < 4; ++m) { bf16_t* rp = ACT + (size_t)(row0 + ai * 128 + m * 16) * DE + cb;
                f32x4 o[2];
#pragma unroll
                for (int n = 0; n < 2; ++n) { const f32x4 a = acc[ai][0][m][n], w = acc[ai][1][m][n];
#pragma unroll
                    for (int i = 0; i < 4; ++i) o[n][i] = fsilu(a[i]) * w[i]; }
                u32x4 w; w.x = pk2(o[0][0], o[0][1]); w.y = pk2(o[0][2], o[0][3]); w.z = pk2(o[1][0], o[1][1]); w.w = pk2(o[1][2], o[1][3]);
                *(u32x4*)rp = w; }
    }
};
struct EpiRowScale {
    static constexpr bool PERM = true;
    bf16_t* Y; const float* rg;
    __device__ __forceinline__ void operator()(const f32x4 (&acc)[2][2][4][2], const pg8::Unit& u, int wr, int wc, int fr, int fq) const {
        const int row0 = u.pm * 256 + wr * 64 + fr, cb = u.pn * 256 + wc * 32 + 8 * fq;
#pragma unroll
        for (int ai = 0; ai < 2; ++ai)
#pragma unroll
            for (int m = 0; m < 4; ++m) { const int row = row0 + ai * 128 + m * 16; const float gsc = rg[row]; bf16_t* rp = Y + (size_t)row * DM + cb;
#pragma unroll
                for (int bj = 0; bj < 2; ++bj) { const f32x4 v0 = acc[ai][bj][m][0] * gsc, v1 = acc[ai][bj][m][1] * gsc;
                    u32x4 w; w.x = pk2(v0[0], v0[1]); w.y = pk2(v0[2], v0[3]); w.z = pk2(v1[0], v1[1]); w.w = pk2(v1[2], v1[3]);
                    *(u32x4*)(rp + bj * 128) = w; } }
    }
};
struct EpiConvIn {
    static constexpr bool PERM = true;
    bf16_t *BG, *CU;
    __device__ __forceinline__ void operator()(const f32x4 (&acc)[2][2][4][2], const pg8::Unit& u, int wr, int wc, int fr, int fq) const {
        const int row0 = u.pm * 256 + wr * 64 + fr;
        if (u.pn < 4) {
            const int cb = u.pn * 256 + wc * 32 + 8 * fq;
#pragma unroll
            for (int ai = 0; ai < 2; ++ai)
#pragma unroll
                for (int m = 0; m < 4; ++m) { bf16_t* rp = BG + (size_t)(row0 + ai * 128 + m * 16) * DM + cb;
#pragma unroll
                    for (int bj = 0; bj < 2; ++bj) { const f32x4 v0 = acc[ai][bj][m][0], v1 = acc[ai][bj][m][1];
                        u32x4 w; w.x = pk2(v0[0], v0[1]); w.y = pk2(v0[2], v0[3]); w.z = pk2(v1[0], v1[1]); w.w = pk2(v1[2], v1[3]);
                        *(u32x4*)(rp + bj * 128) = w; } }
        } else {
            const int cb = (u.pn - 4) * 128 + wc * 32 + 8 * fq;
#pragma unroll
            for (int ai = 0; ai < 2; ++ai)
#pragma unroll
                for (int m = 0; m < 4; ++m) { bf16_t* rp = CU + (size_t)(row0 + ai * 128 + m * 16) * DM + cb;
                    const f32x4 v0 = acc[ai][0][m][0] * acc[ai][1][m][0], v1 = acc[ai][0][m][1] * acc[ai][1][m][1];
                    u32x4 w; w.x = pk2(v0[0], v0[1]); w.y = pk2(v0[2], v0[3]); w.z = pk2(v1[0], v1[1]); w.w = pk2(v1[2], v1[3]);
                    *(u32x4*)rp = w; }
        }
    }
};

__device__ __forceinline__ void ph_prep(const Params& p, unsigned char* lds, int bid, int nblk) {
    float* sv = (float*)lds;
    float* red = sv + 3 * 1024;
    int tid_ = threadIdx.x; asm volatile("" : "+v"(tid_)); const int tid = tid_;
    const float* c = p.in[I_C]; const float* cctx = p.in[I_CCTX];
    for (int i = tid; i < 3 * 1024; i += NTHR) { const float v = (i < 2048) ? c[i] : cctx[i - 2048]; sv[i] = siluf_(v); }
    __syncthreads();
    const float* ada_w = p.in[I_ADAW]; const float* ada_b = p.in[I_ADAB];
    float* mod = (float*)(p.ws + WS_MOD);
    for (int it = bid; it < 96; it += nblk) {
        const int l = it / 48, j0 = (it % 48) * 128, col = tid & 127, ks = tid >> 7;
        const float* W = ada_w + (size_t)l * DM * NADA + j0 + col;
        float a0 = 0.f, a1 = 0.f, a2 = 0.f;
#pragma unroll 8
        for (int k = ks * 256; k < ks * 256 + 256; ++k) { const float w = W[(size_t)k * NADA]; a0 += sv[k] * w; a1 += sv[1024 + k] * w; a2 += sv[2048 + k] * w; }
        red[(ks * 3 + 0) * 128 + col] = a0; red[(ks * 3 + 1) * 128 + col] = a1; red[(ks * 3 + 2) * 128 + col] = a2;
        __syncthreads();
        if (tid < 384) { const int v = tid >> 7, cc = tid & 127;
            const float s = (red[(0 * 3 + v) * 128 + cc] + red[(1 * 3 + v) * 128 + cc]) + (red[(2 * 3 + v) * 128 + cc] + red[(3 * 3 + v) * 128 + cc]) + ada_b[l * NADA + j0 + cc];
            mod[(size_t)(l * 3 + v) * NADA + j0 + cc] = s; }
        __syncthreads();
    }
    const int gt = bid * NTHR + tid, NT = nblk * NTHR;
    const float* lg = p.in[I_HGLB]; float* lb0 = (float*)(p.ws + WS_LB);
    for (int d = gt; d < DM; d += NT) { const float l0 = lg[d], l1 = lg[DM + d], l2 = lg[2 * DM + d]; const float mx = fmaxf(l0, fmaxf(l1, l2));
        const float e0 = expf(l0 - mx), e1 = expf(l1 - mx), e2 = expf(l2 - mx); lb0[d] = e0 / (e0 + e1 + e2); }
    float* posr = (float*)(p.ws + WS_POSR);
    for (int i = gt; i < (128 + 64) * 512; i += NT) { const int pi = i >> 9, dd = i & 511; const int pos = pi < 128 ? pi : pi - 128; const int fi = dd & 255;
        const float om = exp2f(-(float)fi * (13.287712379549449f / 256.0f)); const float a = (float)pos * om; posr[i] = dd < 256 ? sinf(a) : cosf(a); }
}

__device__ __forceinline__ void transpose_item(const float* W, int N, bf16_t* WT, int K, float* scr, int k0, int n0, size_t drow0, int lane) {
#pragma unroll
    for (int i = 0; i < 8; ++i) { const int kk = 8 * i + (lane >> 3); const f32x4 v = *(const f32x4*)(W + (size_t)(k0 + kk) * N + n0 + (lane & 7) * 4); float* d = scr + kk * 33 + (lane & 7) * 4; d[0] = v[0]; d[1] = v[1]; d[2] = v[2]; d[3] = v[3]; }
    __builtin_amdgcn_s_waitcnt(0xc07f); asm volatile("" ::: "memory");
    const int c = lane & 7;
#pragma unroll
    for (int j = 0; j < 4; ++j) { const int n = (lane >> 3) + 8 * j; const float* s = scr + (8 * c) * 33 + n;
        u32x4 o; o.x = pk2(s[0 * 33], s[1 * 33]); o.y = pk2(s[2 * 33], s[3 * 33]); o.z = pk2(s[4 * 33], s[5 * 33]); o.w = pk2(s[6 * 33], s[7 * 33]);
        *(u32x4*)(WT + (drow0 + n) * K + k0 + 8 * c) = o; }
    __builtin_amdgcn_s_waitcnt(0xc07f); asm volatile("" ::: "memory");
}
__device__ __forceinline__ void ph_convert_small(const Params& p, unsigned char* lds, int bid, int nblk) {
    int tid_ = threadIdx.x; asm volatile("" : "+v"(tid_));
    const int tid = tid_, lane = tid & 63, wave = tid >> 6;
    float* scr = (float*)lds + wave * (64 * 33);
    const int gw = bid * 8 + wave, NGW = nblk * 8;
    constexpr int I_A = 16 * 160, I_B = 16 * 32, I_C_ = 16 * 96, I_D = 16 * 32;
    for (int it = gw; it < I_A + I_B + I_C_ + I_D; it += NGW) {
        int r = it;
        if (r < I_A) { const int kb = r / 160, nb = r % 160; transpose_item(p.in[I_HGWIN], 5120, (bf16_t*)(p.ws + WS_WHGIN), 1024, scr, kb * 64, nb * 32, (size_t)nb * 32, lane); continue; } r -= I_A;
        if (r < I_B) { const int kb = r / 32, nb = r % 32; transpose_item(p.in[I_HGWOUT], 1024, (bf16_t*)(p.ws + WS_WHGOUT), 1024, scr, kb * 64, nb * 32, (size_t)nb * 32, lane); continue; } r -= I_B;
        if (r < I_C_) { const int kb = r / 96, nb = r % 96, n0 = nb * 32; size_t dr;
            if (n0 < 1024) dr = n0; else { const int np = n0 - 1024, sec = np >> 10, nn = np & 1023; dr = 1024 + (nn >> 7) * 256 + sec * 128 + (nn & 127); }
            transpose_item(p.in[I_SCWIN], 3072, (bf16_t*)(p.ws + WS_WSCIN), 1024, scr, kb * 64, n0, dr, lane); continue; } r -= I_C_;
        { const int kb = r / 32, nb = r % 32; transpose_item(p.in[I_SCWOUT], 1024, (bf16_t*)(p.ws + WS_WSCOUT), 1024, scr, kb * 64, nb * 32, (size_t)nb * 32, lane); }
    }
}
struct CvtItem { const float* src; bf16_t* dst; int N, K; };
__device__ __forceinline__ CvtItem moe_item(const Params& p, int l, int r) {
    CvtItem c;
    if (r < 32768) { const int up = r >= 16384; if (up) r -= 16384; const int le = l * 16 + (r >> 10), q = r & 1023, kb = q >> 6, nb = q & 63, n0 = nb * 32;
        const size_t dr = (size_t)le * 4096 + (n0 >> 7) * 256 + up * 128 + (n0 & 127);
        c.src = p.in[up ? I_WUP : I_WGATE] + (size_t)le * 1024 * 2048 + (size_t)(kb * 64) * 2048 + n0; c.dst = (bf16_t*)(p.ws + WS_WMOE1) + dr * 1024 + kb * 64; c.N = 2048; c.K = 1024; }
    else { r -= 32768; const int le = l * 16 + (r >> 10), q = r & 1023, kb = q >> 5, nb = q & 31, n0 = nb * 32;
        c.src = p.in[I_WDOWN] + (size_t)le * 2048 * 1024 + (size_t)(kb * 64) * 1024 + n0; c.dst = (bf16_t*)(p.ws + WS_WMOE2) + ((size_t)le * 1024 + n0) * 2048 + kb * 64; c.N = 1024; c.K = 2048; }
    return c;
}
__device__ __forceinline__ void convert_moe_slice(const Params& p, unsigned char* lds, int bid, int nblk, int l, int lo, int hi) {
    int tid_ = threadIdx.x; asm volatile("" : "+v"(tid_));
    const int tid = tid_, lane = tid & 63, wave = tid >> 6;
    float* scr = (float*)lds + wave * (64 * 33);
    const int gw = bid * 8 + wave, NGW = nblk * 8;
    constexpr int NI = 3;
    for (int it = lo + gw; it < hi; it += NGW * NI) {
        f32x4 v[NI][8]; CvtItem ci[NI];
#pragma unroll
        for (int u = 0; u < NI; ++u) { const int r = it + u * NGW; ci[u] = moe_item(p, l, r < hi ? r : it);
#pragma unroll
            for (int i = 0; i < 8; ++i) v[u][i] = __builtin_nontemporal_load((const f32x4*)(ci[u].src + (size_t)(8 * i + (lane >> 3)) * ci[u].N + (lane & 7) * 4)); }
#pragma unroll
        for (int u = 0; u < NI; ++u) { if (it + u * NGW < hi) {
#pragma unroll
            for (int i = 0; i < 8; ++i) { float* d = scr + (8 * i + (lane >> 3)) * 33 + (lane & 7) * 4; d[0] = v[u][i][0]; d[1] = v[u][i][1]; d[2] = v[u][i][2]; d[3] = v[u][i][3]; }
            __builtin_amdgcn_s_waitcnt(0xc07f); asm volatile("" ::: "memory");
            const int c = lane & 7;
#pragma unroll
            for (int j = 0; j < 4; ++j) { const int n = (lane >> 3) + 8 * j; const float* sp = scr + (8 * c) * 33 + n;
                u32x4 o; o.x = pk2(sp[0 * 33], sp[1 * 33]); o.y = pk2(sp[2 * 33], sp[3 * 33]); o.z = pk2(sp[4 * 33], sp[5 * 33]); o.w = pk2(sp[6 * 33], sp[7 * 33]);
                __builtin_nontemporal_store(o, (u32x4*)(ci[u].dst + (size_t)n * ci[u].K + 8 * c)); }
            __builtin_amdgcn_s_waitcnt(0xc07f); asm volatile("" ::: "memory"); } }
    }
    __syncthreads();
}

__device__ __forceinline__ void store_mod_bf16(bf16_t* hrow, const f32x4 (&v)[4], float rstd, const float* g, const float* sh, const float* sc, int lane) {
#pragma unroll
    for (int j = 0; j < 4; ++j) { const int c0 = 256 * j + 4 * lane; const f32x4 gv = *(const f32x4*)(g + c0), shv = *(const f32x4*)(sh + c0), scv = *(const f32x4*)(sc + c0);
        f32x4 h;
#pragma unroll
        for (int i = 0; i < 4; ++i) h[i] = (v[j][i] * rstd * gv[i]) * (1.f + scv[i]) + shv[i];
        u32x2 w; w.x = pk2(h[0], h[1]); w.y = pk2(h[2], h[3]); *(u32x2*)(hrow + c0) = w; }
}
__device__ __forceinline__ void ph_mod0(const Params& p, int row_lo, int row_hi, int wk, int nwk) {
    int tid_ = threadIdx.x; asm volatile("" : "+v"(tid_));
    const int tid = tid_, lane = tid & 63, wave = tid >> 6, gw = wk * 8 + wave, NGW = nwk * 8;
    const float* x = p.in[I_X]; const float* ctx = p.in[I_CTX]; const float* g = p.in[I_NMIX];
    const float* mod = (const float*)(p.ws + WS_MOD); const float* posr = (const float*)(p.ws + WS_POSR); const float* posc = (const float*)(p.ws + WS_POSC);
    float* X = (float*)(p.ws + WS_X); bf16_t* H = (bf16_t*)(p.ws + WS_H);
    f32x4 nx[4];
    { const int row = row_lo + gw; if (row < row_hi) { const float* src = row < NTOK ? x + (size_t)row * DM : ctx + (size_t)(row - NTOK) * DM;
#pragma unroll
        for (int j = 0; j < 4; ++j) nx[j] = *(const f32x4*)(src + 256 * j + 4 * lane); } }
    for (int row = row_lo + gw; row < row_hi; row += NGW) {
        f32x4 v[4]; float ss = 0.f; int vec;
#pragma unroll
        for (int j = 0; j < 4; ++j) v[j] = nx[j];
        { const int r2 = row + NGW; if (r2 < row_hi) { const float* src = r2 < NTOK ? x + (size_t)r2 * DM : ctx + (size_t)(r2 - NTOK) * DM;
#pragma unroll
            for (int j = 0; j < 4; ++j) nx[j] = *(const f32x4*)(src + 256 * j + 4 * lane); } }
        if (row < NTOK) { const int t = row & (SEQ - 1); vec = row >> 13; const float* pr = posr + (size_t)(t >> 6) * 512; const float* pc = posc + (size_t)(t & 63) * 512;
#pragma unroll
            for (int j = 0; j < 4; ++j) { const int c0 = 256 * j + 4 * lane; const f32x4 pv = *(const f32x4*)((j < 2 ? pr : pc) + (c0 & 511));
                v[j] = v[j] + pv; *(f32x4*)(X + (size_t)row * DM + c0) = v[j]; }
        } else vec = 2;
#pragma unroll
        for (int j = 0; j < 4; ++j) ss += (v[j][0] * v[j][0] + v[j][1] * v[j][1]) + (v[j][2] * v[j][2] + v[j][3] * v[j][3]);
        const float rstd = 1.f / sqrtf(wave_sum(ss) * (1.f / DM) + 1e-6f);
        const float* mv = mod + (size_t)(0 * 3 + vec) * NADA;
        store_mod_bf16(H + (size_t)row * DM, v, rstd, g, mv, mv + DM, lane);
    }
}

__device__ __forceinline__ void ph_gla_simple(const Params& p, unsigned char* lds, int bid, int nblk) {
    float* qs = (float*)lds; float* fs = qs + 4096; float* ks = fs + 4096; float* vs = ks + 4096; float* part = vs + 1024;
    int tid_ = threadIdx.x; asm volatile("" : "+v"(tid_));
    const int tid = tid_, lane = tid & 63, wave = tid >> 6, kk = tid >> 5, vv = tid & 31;
    const bf16_t* Q = (const bf16_t*)(p.ws + WS_Q); const bf16_t* V = (const bf16_t*)(p.ws + WS_V);
    for (int unit = bid; unit < 128; unit += nblk) {
        const int vsl = unit & 3, dir = (unit >> 2) & 1, h = (unit >> 3) & 7, b = unit >> 6;
        const float* LFp = (const float*)(p.ws + (dir ? WS_LBK : WS_LF)); float* O = (float*)(p.ws + (dir ? WS_OB : WS_OF));
        float s[8];
#pragma unroll
        for (int i = 0; i < 8; ++i) s[i] = 0.f;
        for (int bt = 0; bt < 8 + 256; ++bt) {
            const bool isctx = bt < 8; const int nb = isctx ? bt : bt - 8, nbt = isctx ? 8 : 256;
            const int t0 = dir == 0 ? nb * 32 : (nbt - 1 - nb) * 32;
            const size_t rbase = isctx ? (size_t)(NTOK + b * CTXL + t0) : (size_t)(b * SEQ + t0);
            { const int r = tid >> 4, c8 = (tid & 15) * 8; const size_t off = (rbase + r) * DM + h * 128 + c8;
                const u16x8 qv = *(const u16x8*)(Q + off); const f32x4 l0 = *(const f32x4*)(LFp + off), l1 = *(const f32x4*)(LFp + off + 4);
#pragma unroll
                for (int i = 0; i < 8; ++i) { qs[r * 128 + c8 + i] = bf2f(qv[i]); const float f = i < 4 ? l0[i] : l1[i - 4]; fs[r * 128 + c8 + i] = f; ks[r * 128 + c8 + i] = 1.f - f; }
                if (tid < 128) { const int r2 = tid >> 2, c = (tid & 3) * 8; const u16x8 vv8 = *(const u16x8*)(V + (rbase + r2) * DM + h * 128 + vsl * 32 + c);
#pragma unroll
                    for (int i = 0; i < 8; ++i) vs[r2 * 32 + c + i] = bf2f(vv8[i]); } }
            __syncthreads();
            for (int jj = 0; jj < 32; ++jj) { const int j = dir ? 31 - jj : jj; const float vj = vs[j * 32 + vv]; float po = 0.f;
#pragma unroll
                for (int i = 0; i < 8; ++i) { const float f = fs[j * 128 + kk * 8 + i], k_ = ks[j * 128 + kk * 8 + i], q_ = qs[j * 128 + kk * 8 + i]; s[i] = f * s[i] + k_ * vj; po += q_ * s[i]; }
                po += __shfl_xor(po, 32);
                if (!isctx && lane < 32) part[(j * 8 + wave) * 32 + vv] = po; }
            __syncthreads();
            if (!isctx) { const int j = tid >> 4, v2 = (tid & 15) * 2; float o0 = 0.f, o1 = 0.f;
#pragma unroll
                for (int w = 0; w < 8; ++w) { o0 += part[(j * 8 + w) * 32 + v2]; o1 += part[(j * 8 + w) * 32 + v2 + 1]; }
                *(f32x2*)(O + (rbase + j) * DM + h * 128 + vsl * 32 + v2) = (f32x2){o0, o1}; }
        }
        __syncthreads();
    }
}

__device__ __forceinline__ void ph_onorm(const Params& p, int bid, int nblk) {
    int tid_ = threadIdx.x; asm volatile("" : "+v"(tid_));
    const int tid = tid_, lane = tid & 63, wave = tid >> 6, gw = bid * 8 + wave, NGW = nblk * 8;
    const float* OF = (const float*)(p.ws + WS_OF); const float* OB = (const float*)(p.ws + WS_OB); const bf16_t* G = (const bf16_t*)(p.ws + WS_G); bf16_t* ON = (bf16_t*)(p.ws + WS_ON);
    const float* ng = p.in[I_HGNORM];
    const f32x4 gv = *(const f32x4*)(ng + 4 * (lane & 31));
    for (int row = gw; row < NTOK; row += NGW) {
#pragma unroll
        for (int j = 0; j < 4; ++j) { const size_t off = (size_t)row * DM + 256 * j + 4 * lane; const f32x4 o = *(const f32x4*)(OF + off) + *(const f32x4*)(OB + off);
            float ss = (o[0] * o[0] + o[1] * o[1]) + (o[2] * o[2] + o[3] * o[3]);
#pragma unroll
            for (int d = 1; d < 32; d <<= 1) ss += __shfl_xor(ss, d);
            const float rstd = 1.f / sqrtf(ss * (1.f / 128.f) + 1e-6f);
            const u32x2 gg = *(const u32x2*)(G + off);
            const float g0 = bf2f((unsigned short)(gg.x & 0xffffu)), g1 = bf2f((unsigned short)(gg.x >> 16)), g2 = bf2f((unsigned short)(gg.y & 0xffffu)), g3 = bf2f((unsigned short)(gg.y >> 16));
            u32x2 w; w.x = pk2(o[0] * rstd * gv[0] * g0, o[1] * rstd * gv[1] * g1); w.y = pk2(o[2] * rstd * gv[2] * g2, o[3] * rstd * gv[3] * g3);
            *(u32x2*)(ON + off) = w; }
    }
}

typedef short s16x4 __attribute__((ext_vector_type(4)));
typedef short v4i16_t __attribute__((ext_vector_type(4)));
using pg8::bf16x8;
constexpr int KT_STR = 160, KS_STR = 144, V_STR = 288;
constexpr int GL_QT = 0, GL_KT = 20480, GL_KS = 40960, GL_PL = 59392, GL_V = 68608, GL_SEG = 87040, GL_DV = 89088, GL_EM = 89600, GL_SSQ = 90112, GL_RSTD = 92160;
__device__ __forceinline__ s16x4 lds_tr(const LAS unsigned char* p) { return __builtin_bit_cast(s16x4, __builtin_amdgcn_ds_read_tr16_b64_v4i16((LAS v4i16_t*)p)); }
__device__ __forceinline__ bf16x8 cat8(s16x4 a, s16x4 b) { return __builtin_shufflevector(a, b, 0, 1, 2, 3, 4, 5, 6, 7); }
__device__ __forceinline__ bf16x8 lds_pair64(const LAS unsigned char* p, int d2) { const u32x2 a = *(const LAS u32x2*)p, b = *(const LAS u32x2*)(p + d2); u32x4 r; r.x = a.x; r.y = a.y; r.z = b.x; r.w = b.y; return __builtin_bit_cast(bf16x8, r); }

template <int CTRL> __device__ __forceinline__ float dpp_f(float x) { return __builtin_bit_cast(float, __builtin_amdgcn_update_dpp(0, __builtin_bit_cast(int, x), CTRL, 0xf, 0xf, true)); }
__device__ __forceinline__ float row16_sum(float x) {
    x += dpp_f<0xB1>(x);
    x += dpp_f<0x4E>(x);
    x += dpp_f<0x141>(x);
    x += dpp_f<0x140>(x);
    return x;
}
constexpr int GL_RF = 92416, GL_RQ = 125184, GL_END = 141568;
struct GlaRegs { f32x4 f[4]; u32x4 q[2]; u32x4 v[2]; };
template <bool WITHQ>
__device__ __forceinline__ void gla_load(GlaRegs& R, const float* F, const bf16_t* Q, const bf16_t* V, int rb, int h, int tid) {
    const unsigned lf = (unsigned)((tid >> 5) * DM + (tid & 31) * 4), lq = (unsigned)((tid >> 4) * DM + (tid & 15) * 8);
#pragma unroll
    for (int i = 0; i < 4; ++i) { const float* fb = F + (size_t)(rb + 16 * i) * DM + h * 128; R.f[i] = *(const f32x4*)(fb + lf); }
#pragma unroll
    for (int i = 0; i < 2; ++i) { const size_t ub = (size_t)(rb + 32 * i) * DM + h * 128;
        if (WITHQ) R.q[i] = *(const u32x4*)(Q + ub + lq); R.v[i] = *(const u32x4*)(V + ub + lq); }
}
template <bool WITHQ>
__device__ __forceinline__ void gla_put_raw(const GlaRegs& R, LAS unsigned char* lds, int dir, int tid) {
#pragma unroll
    for (int i = 0; i < 4; ++i) { const int id = tid + 512 * i, row = id >> 5, c4 = (id & 31) * 4, p = dir ? 63 - row : row; *(LAS f32x4*)(lds + GL_RF + p * 512 + c4 * 4) = R.f[i]; }
#pragma unroll
    for (int i = 0; i < 2; ++i) { const int id = tid + 512 * i, row = id >> 4, c8 = (id & 15) * 8, p = dir ? 63 - row : row;
        if (WITHQ) *(LAS u32x4*)(lds + GL_RQ + p * 256 + c8 * 2) = R.q[i]; *(LAS u32x4*)(lds + GL_V + p * V_STR + c8 * 2) = R.v[i]; }
}
template <bool G2>
__device__ __forceinline__ void gla_phase_a(LAS unsigned char* lds, int tid) {
    const int k = tid & 127, seg = tid >> 7;
    LAS float* segtot = (LAS float*)(lds + GL_SEG);
    float f[16];
#pragma unroll
    for (int i = 0; i < 16; ++i) f[i] = *(const LAS float*)(lds + GL_RF + (16 * seg + i) * 512 + k * 4);
    if (G2) {
        unsigned short q[16];
#pragma unroll
        for (int i = 0; i < 16; ++i) q[i] = *(const LAS unsigned short*)(lds + GL_RQ + (16 * seg + i) * 256 + k * 2);
        float c[16]; c[0] = f[0];
#pragma unroll
        for (int i = 1; i < 16; ++i) c[i] = c[i - 1] * f[i];
        segtot[seg * 128 + k] = c[15];
        __syncthreads();
        const float T0 = segtot[k], T1 = segtot[128 + k], T2 = segtot[256 + k], T3 = segtot[384 + k];
        const float Fs = seg == 0 ? 1.f / (T0 * T1) : (seg == 1 ? 1.f / T1 : (seg == 2 ? 1.f : T2));
        const float cK = T2 * T3;
        if (seg == 0) { ((LAS float*)(lds + GL_DV))[k] = T0 * T1 * cK; ((LAS float*)(lds + GL_EM))[k] = T0 * T1; }
        unsigned wq[8], wk[8], ws_[8];
#pragma unroll
        for (int i = 0; i < 16; i += 2) { float qp[2], kp[2], ks[2];
#pragma unroll
            for (int e = 0; e < 2; ++e) { const float eq = c[i + e] * Fs, inv = __builtin_amdgcn_rcpf(eq), kk = 1.f - f[i + e];
                qp[e] = bf2f(q[i + e]) * eq; kp[e] = kk * inv; ks[e] = kp[e] * cK; }
            wq[i >> 1] = pk2(qp[0], qp[1]); wk[i >> 1] = pk2(kp[0], kp[1]); ws_[i >> 1] = pk2(ks[0], ks[1]); }
        LAS unsigned char* dq = lds + GL_QT + k * KT_STR + seg * 32; LAS unsigned char* dk = lds + GL_KT + k * KT_STR + seg * 32; LAS unsigned char* ds = lds + GL_KS + k * KS_STR + seg * 32;
        *(LAS u32x4*)dq = (u32x4){wq[0], wq[1], wq[2], wq[3]}; *(LAS u32x4*)(dq + 16) = (u32x4){wq[4], wq[5], wq[6], wq[7]};
        *(LAS u32x4*)dk = (u32x4){wk[0], wk[1], wk[2], wk[3]}; *(LAS u32x4*)(dk + 16) = (u32x4){wk[4], wk[5], wk[6], wk[7]};
        *(LAS u32x4*)ds = (u32x4){ws_[0], ws_[1], ws_[2], ws_[3]}; *(LAS u32x4*)(ds + 16) = (u32x4){ws_[4], ws_[5], ws_[6], ws_[7]};
    } else {
        float sx[16]; sx[15] = 1.f;
#pragma unroll
        for (int i = 14; i >= 0; --i) sx[i] = sx[i + 1] * f[i + 1];
        segtot[seg * 128 + k] = sx[0] * f[0];
        __syncthreads();
        const float T0 = segtot[k], T1 = segtot[128 + k], T2 = segtot[256 + k], T3 = segtot[384 + k];
        const float later = seg == 0 ? T1 * T2 * T3 : (seg == 1 ? T2 * T3 : (seg == 2 ? T3 : 1.f));
        if (seg == 0) ((LAS float*)(lds + GL_DV))[k] = T0 * T1 * T2 * T3;
        unsigned ws_[8];
#pragma unroll
        for (int i = 0; i < 16; i += 2) ws_[i >> 1] = pk2((1.f - f[i]) * sx[i] * later, (1.f - f[i + 1]) * sx[i + 1] * later);
        LAS unsigned char* ds = lds + GL_KS + k * KS_STR + seg * 32;
        *(LAS u32x4*)ds = (u32x4){ws_[0], ws_[1], ws_[2], ws_[3]}; *(LAS u32x4*)(ds + 16) = (u32x4){ws_[4], ws_[5], ws_[6], ws_[7]};
    }
    __syncthreads();
}
__device__ __forceinline__ void gla_state_update(f32x4 (&S)[8], const bf16x8 (&Vf)[2], const LAS unsigned char* lds, int i16, int g) {
#pragma unroll
    for (int j = 0; j < 8; ++j) { const f32x4 dv = *(const LAS f32x4*)(lds + GL_DV + (16 * j + 4 * g) * 4); S[j] = S[j] * dv;
#pragma unroll
        for (int c2 = 0; c2 < 2; ++c2) { const bf16x8 a = lds_pair64(lds + GL_KS + (16 * j + i16) * KS_STR + (32 * c2 + 4 * g) * 2, 32);
            S[j] = __builtin_amdgcn_mfma_f32_16x16x32_bf16(a, Vf[c2], S[j], 0, 0, 0); }
        if (j & 1) asm volatile("" ::: "memory"); }
}
__device__ __forceinline__ void gla_load_vf(bf16x8 (&Vf)[2], const LAS unsigned char* lds, int w, int i16, int g) {
    const int q4 = i16 >> 2, pp = i16 & 3;
#pragma unroll
    for (int c2 = 0; c2 < 2; ++c2) { const LAS unsigned char* vb = lds + GL_V + (32 * c2 + 4 * g + q4) * V_STR + (16 * w + 4 * pp) * 2; Vf[c2] = cat8(lds_tr(vb), lds_tr(vb + 16 * V_STR)); }
}

__device__ __forceinline__ void ph_gla_states(const Params& p, unsigned char* lds_, int bid, int nblk) {
    int tid_ = threadIdx.x; asm volatile("" : "+v"(tid_));
    const int tid = tid_, lane = tid & 63, w = __builtin_amdgcn_readfirstlane(tid >> 6), i16 = lane & 15, g = lane >> 4;
    LAS unsigned char* lds = (LAS unsigned char*)lds_;
    const bf16_t* V = (const bf16_t*)(p.ws + WS_V);
    float* U = (float*)(p.ws + WS_U); float* DD = (float*)(p.ws + WS_DD);
    for (int ui = bid; ui < 544; ui += nblk) {
        int b, h, dir, nch, rb0, uidx;
        if (ui < 512) { b = ui >> 8; h = (ui >> 5) & 7; dir = (ui >> 4) & 1; const int sc = ui & 15; nch = 8; rb0 = b * SEQ + sc * 512; uidx = ((b * 8 + h) * 2 + dir) * 17 + sc; }
        else { const int r = ui - 512; b = r >> 4; h = (r >> 1) & 7; dir = r & 1; nch = 4; rb0 = NTOK + b * CTXL; uidx = ((b * 8 + h) * 2 + dir) * 17 + 16; }
        const float* F = (const float*)(p.ws + (dir ? WS_LBK : WS_LF));
        f32x4 S[8];
#pragma unroll
        for (int j = 0; j < 8; ++j) S[j] = (f32x4){0.f, 0.f, 0.f, 0.f};
        float dtot = 1.f;
        GlaRegs R;
        gla_load<false>(R, F, nullptr, V, rb0 + 64 * (dir ? nch - 1 : 0), h, tid);
        for (int step = 0; step < nch; ++step) {
            gla_put_raw<false>(R, lds, dir, tid);
            __syncthreads();
            if (step + 1 < nch) gla_load<false>(R, F, nullptr, V, rb0 + 64 * (dir ? nch - 2 - step : step + 1), h, tid);
            gla_phase_a<false>(lds, tid);
            if (tid < 128) dtot *= ((const LAS float*)(lds + GL_DV))[tid];
            bf16x8 Vf[2]; gla_load_vf(Vf, lds, w, i16, g);
            gla_state_update(S, Vf, lds, i16, g);
            __syncthreads();
        }
        float* up = U + (size_t)uidx * 16384 + (size_t)(w * 8) * 256 + lane * 4;
#pragma unroll
        for (int j = 0; j < 8; ++j) *(f32x4*)(up + j * 256) = S[j];
        if (tid < 128) DD[(size_t)uidx * 128 + tid] = dtot;
    }
}

__device__ __forceinline__ void ph_gla_out(const Params& p, unsigned char* lds_, int bid, int nblk) {
    int tid_ = threadIdx.x; asm volatile("" : "+v"(tid_));
    const int tid = tid_, lane = tid & 63, w = __builtin_amdgcn_readfirstlane(tid >> 6), i16 = lane & 15, g = lane >> 4, q4 = i16 >> 2, pp = i16 & 3;
    LAS unsigned char* lds = (LAS unsigned char*)lds_;
    const bf16_t* Q = (const bf16_t*)(p.ws + WS_Q); const bf16_t* V = (const bf16_t*)(p.ws + WS_V); const bf16_t* G = (const bf16_t*)(p.ws + WS_G);
    const float* U = (const float*)(p.ws + WS_U); const float* DD = (const float*)(p.ws + WS_DD);
    float* OFL = (float*)(p.ws + WS_OF); bf16_t* ON = (bf16_t*)(p.ws + WS_ON);
    const float ngv = p.in[I_HGNORM][16 * w + i16];
    const int troff = (4 * g + q4) * KT_STR + (4 * pp) * 2;
    for (int unit = bid; unit < 256; unit += nblk) {
        const int b = unit >> 7, h = (unit >> 4) & 7, sc = unit & 15, rbs = b * SEQ + sc * 512;
        const unsigned loff = (unsigned)((3 - g) * 4 * DM + i16);
#pragma unroll 1
        for (int dir = 0; dir < 2; ++dir) {
            const float* F = (const float*)(p.ws + (dir ? WS_LBK : WS_LF));
            GlaRegs R;
            gla_load<true>(R, F, Q, V, rbs + 64 * (dir ? 7 : 0), h, tid);
            const int ub = ((b * 8 + h) * 2 + dir) * 17;
            f32x4 S[8];
            { const float* up = U + (size_t)(ub + 16) * 16384 + (size_t)(w * 8) * 256 + lane * 4;
#pragma unroll
                for (int j = 0; j < 8; ++j) S[j] = *(const f32x4*)(up + j * 256); }
            { const int nf = dir ? 15 - sc : sc;
                LAS float* dl = (LAS float*)(lds + GL_QT);
                for (int i = tid; i < 16 * 128; i += NTHR) dl[i] = DD[(size_t)ub * 128 + i];
                __syncthreads();
                f32x4 Ua[8];
#define FOLD_LOAD(UU, s_) do { const int u_ = dir ? 15 - (s_) : (s_); const float* up_ = U + (size_t)(ub + u_) * 16384 + (size_t)(w * 8) * 256 + lane * 4; \
                    _Pragma("unroll") for (int j = 0; j < 8; ++j) UU[j] = *(const f32x4*)(up_ + j * 256); } while (0)
                if (nf > 0) FOLD_LOAD(Ua, 0);
                for (int s = 0; s < nf; ++s) { const int u = dir ? 15 - s : s;
#pragma unroll
                    for (int j = 0; j < 8; ++j) S[j] = S[j] * *(const LAS f32x4*)(dl + u * 128 + 16 * j + 4 * g) + Ua[j];
                    if (s + 1 < nf) FOLD_LOAD(Ua, s + 1); }
#undef FOLD_LOAD
                __syncthreads();
            }
            for (int step = 0; step < 8; ++step) {
                const int n = dir ? 7 - step : step, rb = rbs + 64 * n;
                gla_put_raw<true>(R, lds, dir, tid);
                __syncthreads();
                if (step < 7) gla_load<true>(R, F, Q, V, rbs + 64 * (dir ? 6 - step : step + 1), h, tid);
                gla_phase_a<true>(lds, tid);
                f32x4 O[4];
                if (dir) { const float* ob = OFL + ((size_t)((unit * 8 + n) * 8 + w) * 4) * 256 + ((3 - g) * 16 + i16) * 4;
#pragma unroll
                    for (int ti = 0; ti < 4; ++ti) { const f32x4 t4 = *(const f32x4*)(ob + (3 - ti) * 256); O[ti] = (f32x4){t4[3], t4[2], t4[1], t4[0]}; } }
                else {
#pragma unroll
                    for (int ti = 0; ti < 4; ++ti) O[ti] = (f32x4){0.f, 0.f, 0.f, 0.f}; }
                { const int si = w >> 1, tb = 2 * (w & 1);
                    f32x4 pa[2] = {(f32x4){0.f, 0.f, 0.f, 0.f}, (f32x4){0.f, 0.f, 0.f, 0.f}};
#pragma unroll
                    for (int c = 0; c < 4; ++c) { const LAS unsigned char* ka = lds + GL_KT + troff + (32 * c) * KT_STR + (16 * si) * 2; const bf16x8 a = cat8(lds_tr(ka), lds_tr(ka + 16 * KT_STR));
#pragma unroll
                        for (int tt = 0; tt < 2; ++tt) { const LAS unsigned char* qa = lds + GL_QT + troff + (32 * c) * KT_STR + (16 * (tb + tt)) * 2; const bf16x8 bq = cat8(lds_tr(qa), lds_tr(qa + 16 * KT_STR));
                            pa[tt] = __builtin_amdgcn_mfma_f32_16x16x32_bf16(a, bq, pa[tt], 0, 0, 0); } }
#pragma unroll
                    for (int tt = 0; tt < 2; ++tt) { const int t = 16 * (tb + tt) + i16, s0 = 16 * si + 4 * g; f32x4 v = pa[tt];
#pragma unroll
                        for (int r = 0; r < 4; ++r) v[r] = (s0 + r <= t) ? v[r] : 0.f;
                        u32x2 wv; wv.x = pk2(v[0], v[1]); wv.y = pk2(v[2], v[3]); *(LAS u32x2*)(lds + GL_PL + t * KS_STR + s0 * 2) = wv; } }
                __syncthreads();
                {
#pragma unroll
                    for (int c = 0; c < 4; ++c) { const f32x4 e0 = *(const LAS f32x4*)(lds + GL_EM + (32 * c + 4 * g) * 4), e1 = *(const LAS f32x4*)(lds + GL_EM + (32 * c + 16 + 4 * g) * 4);
                        const f32x4 a0 = S[2 * c] * e0, b0 = S[2 * c + 1] * e1; u32x4 r; r.x = pk2(a0[0], a0[1]); r.y = pk2(a0[2], a0[3]); r.z = pk2(b0[0], b0[1]); r.w = pk2(b0[2], b0[3]); const bf16x8 Sb = __builtin_bit_cast(bf16x8, r);
#pragma unroll
                        for (int ti = 0; ti < 4; ++ti) { const LAS unsigned char* qa = lds + GL_QT + troff + (32 * c) * KT_STR + (16 * ti) * 2; const bf16x8 a = cat8(lds_tr(qa), lds_tr(qa + 16 * KT_STR));
                            O[ti] = __builtin_amdgcn_mfma_f32_16x16x32_bf16(a, Sb, O[ti], 0, 0, 0); }
                        asm volatile("" ::: "memory"); } }
                bf16x8 Vf[2]; gla_load_vf(Vf, lds, w, i16, g);
#pragma unroll
                for (int ti = 0; ti < 4; ++ti) {
#pragma unroll
                    for (int c2 = 0; c2 < 2; ++c2) { const bf16x8 a = lds_pair64(lds + GL_PL + (16 * ti + i16) * KS_STR + (32 * c2 + 4 * g) * 2, 32);
                        O[ti] = __builtin_amdgcn_mfma_f32_16x16x32_bf16(a, Vf[c2], O[ti], 0, 0, 0); }
                    if (ti & 1) asm volatile("" ::: "memory"); }
                gla_state_update(S, Vf, lds, i16, g);
                if (dir == 0) {
                    float* ob = OFL + ((size_t)((unit * 8 + n) * 8 + w) * 4) * 256 + lane * 4;
#pragma unroll
                    for (int ti = 0; ti < 4; ++ti) *(f32x4*)(ob + ti * 256) = O[ti];
                    __syncthreads();
                } else {
                    float part[4][4];
#pragma unroll
                    for (int ti = 0; ti < 4; ++ti)
#pragma unroll
                        for (int r = 0; r < 4; ++r) { const float o = O[ti][r]; part[ti][r] = row16_sum(o * o); }
                    unsigned short gq[4][4];
#pragma unroll
                    for (int ti = 0; ti < 4; ++ti)
#pragma unroll
                        for (int r = 0; r < 4; ++r) { const bf16_t* gb = G + (size_t)(rb + 51 - 16 * ti - r) * DM + h * 128 + 16 * w; gq[ti][r] = gb[loff]; }
                    if (i16 == 0) {
#pragma unroll
                        for (int ti = 0; ti < 4; ++ti) *(LAS f32x4*)(lds + GL_SSQ + (w * 64 + 16 * ti + 4 * g) * 4) = (f32x4){part[ti][0], part[ti][1], part[ti][2], part[ti][3]}; }
                    __syncthreads();
                    if (tid < 64) { float s2 = 0.f;
#pragma unroll
                        for (int ww = 0; ww < 8; ++ww) s2 += ((const LAS float*)(lds + GL_SSQ))[ww * 64 + tid];
                        ((LAS float*)(lds + GL_RSTD))[tid] = 1.f / sqrtf(s2 * (1.f / 128.f) + 1e-6f); }
                    __syncthreads();
#pragma unroll
                    for (int ti = 0; ti < 4; ++ti) { const f32x4 rs = *(const LAS f32x4*)(lds + GL_RSTD + (16 * ti + 4 * g) * 4);
#pragma unroll
                        for (int r = 0; r < 4; ++r) { bf16_t* ob2 = ON + (size_t)(rb + 51 - 16 * ti - r) * DM + h * 128 + 16 * w;
                            ob2[loff] = (bf16_t)f2bf(O[ti][r] * rs[r] * ngv * bf2f(gq[ti][r])); } }
                }
            }
            asm volatile("s_waitcnt vmcnt(0)" ::: "memory");
            __syncthreads();
        }
    }
}

__device__ __forceinline__ void ph_modffn(const Params& p, unsigned char* lds, int bid, int nblk, int l) {
    int tid_ = threadIdx.x; asm volatile("" : "+v"(tid_));
    const int tid = tid_, lane = tid & 63, wave = tid >> 6;
    float* rw = (float*)lds;
    float* stg = (float*)(lds + 71680);
    const float* router = p.in[I_ROUTER] + (size_t)l * DM * NE;
    for (int i = tid; i < DM * NE / 4; i += NTHR) { const int d = i >> 2; *(f32x4*)(rw + d * 16 + (d >> 2) * 4 + (i & 3) * 4) = ((const f32x4*)router)[i]; }
    __syncthreads();
    const float* X = (const float*)(p.ws + WS_X); bf16_t* H = (bf16_t*)(p.ws + WS_H); float* aff = (float*)(p.ws + WS_AFF); int* slot = (int*)(p.ws + WS_SLOT);
    const float* g = p.in[I_NFFN] + (size_t)l * DM; const float* mod = (const float*)(p.ws + WS_MOD);
    for (int base = bid * 64; base < NTOK; base += nblk * 64) {
        const int b = base >> 13, t0 = base & (SEQ - 1);
        const float* mv = mod + (size_t)(l * 3 + b) * NADA; const float* sh = mv + 3 * DM; const float* sc = mv + 4 * DM;
        f32x4 nxv[4];
#pragma unroll
        for (int j = 0; j < 4; ++j) nxv[j] = *(const f32x4*)(X + (size_t)(base + 8 * wave) * DM + 256 * j + 4 * lane);
#pragma unroll 1
        for (int r = 0; r < 8; ++r) {
            const int row = base + 8 * wave + r;
            f32x4 v[4]; float ss = 0.f;
#pragma unroll
            for (int j = 0; j < 4; ++j) { v[j] = nxv[j]; ss += (v[j][0] * v[j][0] + v[j][1] * v[j][1]) + (v[j][2] * v[j][2] + v[j][3] * v[j][3]); }
            if (r < 7) {
#pragma unroll
                for (int j = 0; j < 4; ++j) nxv[j] = *(const f32x4*)(X + (size_t)(row + 1) * DM + 256 * j + 4 * lane); }
            const float rstd = 1.f / sqrtf(wave_sum(ss) * (1.f / DM) + 1e-6f);
            float lg[16];
#pragma unroll
            for (int e = 0; e < 16; ++e) lg[e] = 0.f;
#pragma unroll
            for (int j = 0; j < 4; ++j) { const int c0 = 256 * j + 4 * lane; const f32x4 gv = *(const f32x4*)(g + c0), shv = *(const f32x4*)(sh + c0), scv = *(const f32x4*)(sc + c0);
                f32x4 h;
#pragma unroll
                for (int i = 0; i < 4; ++i) { h[i] = (v[j][i] * rstd * gv[i]) * (1.f + scv[i]) + shv[i];
                    const float* rp = rw + (c0 + i) * 16 + (c0 >> 2) * 4; const f32x4 r0 = *(const f32x4*)(rp), r1 = *(const f32x4*)(rp + 4), r2 = *(const f32x4*)(rp + 8), r3 = *(const f32x4*)(rp + 12);
#pragma unroll
                    for (int e = 0; e < 4; ++e) { lg[e] += h[i] * r0[e]; lg[4 + e] += h[i] * r1[e]; lg[8 + e] += h[i] * r2[e]; lg[12 + e] += h[i] * r3[e]; }
                    asm volatile("" ::: "memory"); }
                u32x2 w; w.x = pk2(h[0], h[1]); w.y = pk2(h[2], h[3]); *(u32x2*)(H + (size_t)row * DM + c0) = w; }
            float a8[8], a4[4], a2[2], a1;
            { const bool hi = (lane & 32) != 0;
#pragma unroll
                for (int i = 0; i < 8; ++i) { const float send = hi ? lg[i] : lg[8 + i], keep = hi ? lg[8 + i] : lg[i]; a8[i] = keep + __shfl_xor(send, 32); } }
            { const bool hi = (lane & 16) != 0;
#pragma unroll
                for (int i = 0; i < 4; ++i) { const float send = hi ? a8[i] : a8[4 + i], keep = hi ? a8[4 + i] : a8[i]; a4[i] = keep + __shfl_xor(send, 16); } }
            { const bool hi = (lane & 8) != 0;
#pragma unroll
                for (int i = 0; i < 2; ++i) { const float send = hi ? a4[i] : a4[2 + i], keep = hi ? a4[2 + i] : a4[i]; a2[i] = keep + __shfl_xor(send, 8); } }
            { const bool hi = (lane & 4) != 0; const float send = hi ? a2[0] : a2[1], keep = hi ? a2[1] : a2[0]; a1 = keep + __shfl_xor(send, 4); }
            a1 += __shfl_xor(a1, 2); a1 += __shfl_xor(a1, 1);
            float mx = a1;
            mx = fmaxf(mx, __shfl_xor(mx, 4)); mx = fmaxf(mx, __shfl_xor(mx, 8)); mx = fmaxf(mx, __shfl_xor(mx, 16)); mx = fmaxf(mx, __shfl_xor(mx, 32));
            const float ex = expf(a1 - mx); float den = ex;
            den += __shfl_xor(den, 4); den += __shfl_xor(den, 8); den += __shfl_xor(den, 16); den += __shfl_xor(den, 32);
            if ((lane & 3) == 0) stg[((lane >> 2) & 15) * 64 + 8 * wave + r] = ex / den;
        }
        __syncthreads();
        { const int e = tid >> 5, tt = (tid & 31) * 2; *(f32x2*)(aff + (size_t)(b * NE + e) * SEQ + t0 + tt) = *(const f32x2*)(stg + e * 64 + tt);
            *(u32x2*)(slot + (size_t)base * NE + 2 * tid) = (u32x2){0xffffffffu, 0xffffffffu}; }
        __syncthreads();
    }
}

__device__ __forceinline__ void ph_topk(const Params& p, unsigned char* lds, int bid, int nblk) {
    int tid_ = threadIdx.x; asm volatile("" : "+v"(tid_)); const int tid = tid_, lane = tid & 63, wave = tid >> 6;
    unsigned* hist = (unsigned*)lds;
    unsigned* ctl = hist + 256;
    unsigned* wsum = ctl + 8;
    const float* aff = (const float*)(p.ws + WS_AFF); int* topi = (int*)(p.ws + WS_TOPI); float* topg = (float*)(p.ws + WS_TOPG); int* slot = (int*)(p.ws + WS_SLOT);
    for (int it = bid; it < NB * NE; it += nblk) {
        const int b = it >> 4, e = it & 15; const float* src = aff + (size_t)it * SEQ + 16 * tid;
        unsigned key[16];
#pragma unroll
        for (int j = 0; j < 4; ++j) { const f32x4 v = *(const f32x4*)(src + 4 * j); key[4 * j] = __float_as_uint(v[0]); key[4 * j + 1] = __float_as_uint(v[1]); key[4 * j + 2] = __float_as_uint(v[2]); key[4 * j + 3] = __float_as_uint(v[3]); }
        unsigned prefix = 0u;
#pragma unroll 1
        for (int bit = 30; bit >= 0; --bit) {
            const unsigned cand = prefix | (1u << bit);
            unsigned cnt = 0u;
#pragma unroll
            for (int i = 0; i < 16; ++i) cnt += (unsigned)__popcll(__ballot(key[i] >= cand));
            if (lane == 0) wsum[(bit & 1) * 8 + wave] = cnt;
            __syncthreads();
            unsigned tot = 0u;
#pragma unroll
            for (int w2 = 0; w2 < 8; ++w2) tot += wsum[(bit & 1) * 8 + w2];
            if (tot >= (unsigned)CAP) prefix = cand;
        }
        __syncthreads();
        unsigned cg = 0u, ce = 0u;
#pragma unroll
        for (int i = 0; i < 16; ++i) { cg += key[i] > prefix ? 1u : 0u; ce += key[i] == prefix ? 1u : 0u; }
        unsigned pk = cg | (ce << 16), inc = pk;
#pragma unroll
        for (int o = 1; o < 64; o <<= 1) { const unsigned t = __shfl_up(inc, o); if (lane >= o) inc += t; }
        if (lane == 63) wsum[wave] = inc;
        __syncthreads();
        unsigned base = 0u, total = 0u;
#pragma unroll
        for (int w2 = 0; w2 < 8; ++w2) { const unsigned t = wsum[w2]; if (w2 < wave) base += t; total += t; }
        const unsigned excl = base + inc - pk;
        unsigned rg = excl & 0xffffu, re = excl >> 16; const unsigned ngt = total & 0xffffu, kth = (unsigned)CAP - ngt;
#pragma unroll
        for (int i = 0; i < 16; ++i) { int s = -1;
            if (key[i] > prefix) { s = (int)rg; ++rg; }
            else if (key[i] == prefix) { if (re < kth) s = (int)(ngt + re); ++re; }
            if (s >= 0) { const int idx = 16 * tid + i, r = (e * NB + b) * CAP + s; topi[r] = b * SEQ + idx; topg[r] = __uint_as_float(key[i]); slot[(size_t)(b * SEQ + idx) * NE + e] = s; } }
        __syncthreads();
    }
}

__device__ __forceinline__ void ph_gather(const Params& p, int bid, int nblk) {
    int tid_ = threadIdx.x; asm volatile("" : "+v"(tid_));
    const int tid = tid_, lane = tid & 63, wave = tid >> 6, gw = bid * 8 + wave, NGW = nblk * 8;
    const bf16_t* H = (const bf16_t*)(p.ws + WS_H); bf16_t* XG = (bf16_t*)(p.ws + WS_XG); const int* topi = (const int*)(p.ws + WS_TOPI);
    for (int r = gw; r < NSLOT; r += NGW) { const int src = topi[r];
        const u32x4* s = (const u32x4*)(H + (size_t)src * DM); u32x4* d = (u32x4*)(XG + (size_t)r * DM);
        d[lane] = s[lane]; d[64 + lane] = s[64 + lane]; }
}

__device__ __forceinline__ void ph_combine(const Params& p, int bid, int nblk, int l, bool final_) {
    int tid_ = threadIdx.x; asm volatile("" : "+v"(tid_));
    const int tid = tid_, lane = tid & 63, wave = tid >> 6, gw = bid * 8 + wave, NGW = nblk * 8;
    float* X = (float*)(p.ws + WS_X); bf16_t* H = (bf16_t*)(p.ws + WS_H); const bf16_t* Y = (const bf16_t*)(p.ws + WS_Y); const int* slot = (const int*)(p.ws + WS_SLOT);
    const float* mod = (const float*)(p.ws + WS_MOD);
    int nslot = -1; f32x4 nxv[4];
    if (gw < NTOK) { nslot = lane < 16 ? slot[(size_t)gw * NE + lane] : -1;
#pragma unroll
        for (int j = 0; j < 4; ++j) nxv[j] = *(const f32x4*)(X + (size_t)gw * DM + 256 * j + 4 * lane); }
    for (int row = gw; row < NTOK; row += NGW) {
        const int b = row >> 13;
        const float* g2 = mod + (size_t)(l * 3 + b) * NADA + 5 * DM;
        const int myslot = nslot; f32x4 xv[4];
#pragma unroll
        for (int j = 0; j < 4; ++j) xv[j] = nxv[j];
        unsigned long long m = __ballot(myslot >= 0) & 0xffffull;
        f32x4 a[4];
#pragma unroll
        for (int j = 0; j < 4; ++j) a[j] = (f32x4){0.f, 0.f, 0.f, 0.f};
        u32x2 ya[4], yb[4];
#define YLOAD(dst, e_) do { const int s_ = __shfl(myslot, (e_)); const bf16_t* yr_ = Y + (size_t)(((e_) * NB + b) * CAP + s_) * DM; \
            _Pragma("unroll") for (int j = 0; j < 4; ++j) dst[j] = *(const u32x2*)(yr_ + 256 * j + 4 * lane); } while (0)
        if (m) { const int e0 = __builtin_ctzll(m); m &= m - 1; YLOAD(ya, e0); }
        const bool any = __ballot(myslot >= 0) & 0xffffull;
        { const int r2 = row + NGW; if (r2 < NTOK) { nslot = lane < 16 ? slot[(size_t)r2 * NE + lane] : -1;
#pragma unroll
            for (int j = 0; j < 4; ++j) nxv[j] = *(const f32x4*)(X + (size_t)r2 * DM + 256 * j + 4 * lane); } }
        if (any) for (;;) {
            const bool more = m != 0ull;
            if (more) { const int e1 = __builtin_ctzll(m); m &= m - 1; YLOAD(yb, e1); }
#pragma unroll
            for (int j = 0; j < 4; ++j) { a[j][0] += __uint_as_float(ya[j].x << 16); a[j][1] += __uint_as_float(ya[j].x & 0xffff0000u); a[j][2] += __uint_as_float(ya[j].y << 16); a[j][3] += __uint_as_float(ya[j].y & 0xffff0000u); }
            if (!more) break;
#pragma unroll
            for (int j = 0; j < 4; ++j) ya[j] = yb[j];
        }
#undef YLOAD
        f32x4 v[4]; float ss = 0.f;
#pragma unroll
        for (int j = 0; j < 4; ++j) { const int c0 = 256 * j + 4 * lane; v[j] = xv[j] + *(const f32x4*)(g2 + c0) * a[j];
            ss += (v[j][0] * v[j][0] + v[j][1] * v[j][1]) + (v[j][2] * v[j][2] + v[j][3] * v[j][3]); }
        const float rstd = 1.f / sqrtf(wave_sum(ss) * (1.f / DM) + 1e-6f);
        if (final_) { const float* gf = p.in[I_NFIN];
#pragma unroll
            for (int j = 0; j < 4; ++j) { const int c0 = 256 * j + 4 * lane; const f32x4 gv = *(const f32x4*)(gf + c0); *(f32x4*)(p.out + (size_t)row * DM + c0) = v[j] * rstd * gv; }
        } else {
#pragma unroll
            for (int j = 0; j < 4; ++j) *(f32x4*)(X + (size_t)row * DM + 256 * j + 4 * lane) = v[j];
            const float* mv = mod + (size_t)((l + 1) * 3 + b) * NADA;
            store_mod_bf16(H + (size_t)row * DM, v, rstd, p.in[I_NMIX] + (size_t)(l + 1) * DM, mv, mv + DM, lane);
        }
    }
}

__device__ __forceinline__ void ph_conv(const Params& p, int bid, int nblk) {
    int tid_ = threadIdx.x; asm volatile("" : "+v"(tid_));
    const int tid = tid_, lane = tid & 63, wave = tid >> 6, gw = bid * 8 + wave, NGW = nblk * 8;
    const bf16_t* BG = (const bf16_t*)(p.ws + WS_BG); const bf16_t* CU = (const bf16_t*)(p.ws + WS_CU); bf16_t* Z = (bf16_t*)(p.ws + WS_Z);
    const float* wc = p.in[I_SCCONV];
    for (int row = gw; row < NTOK; row += NGW) { const int t = row & (SEQ - 1);
#pragma unroll
        for (int hh = 0; hh < 2; ++hh) { const int c0 = hh * 512 + 8 * lane; const size_t off = (size_t)row * DM + c0;
            const u16x8 z0 = {0, 0, 0, 0, 0, 0, 0, 0};
            const u16x8 um = t > 0 ? *(const u16x8*)(CU + off - DM) : z0, u0 = *(const u16x8*)(CU + off), up = t < SEQ - 1 ? *(const u16x8*)(CU + off + DM) : z0, bg = *(const u16x8*)(BG + off);
            float o[8];
#pragma unroll
            for (int i = 0; i < 8; ++i) o[i] = bf2f(bg[i]) * (wc[c0 + i] * bf2f(um[i]) + wc[DM + c0 + i] * bf2f(u0[i]) + wc[2 * DM + c0 + i] * bf2f(up[i]));
            u32x4 w; w.x = pk2(o[0], o[1]); w.y = pk2(o[2], o[3]); w.z = pk2(o[4], o[5]); w.w = pk2(o[6], o[7]); *(u32x4*)(Z + off) = w; }
    }
}

#define XB_TMO      128
#define XB_XCNT(j)  (256  + 64 * (j))
#define XB_XSUB(j)  (1280 + 64 * (j))
#define XB_XGEN(j)  (2304 + 64 * (j))
#define XB_TOP      3328
#define XB_TOPGEN   3392
#define XCD_BAR_WORDS 3456
#define XB_SPIN_CAP (1u << 18)
__device__ __forceinline__ unsigned xb_ld(unsigned* p)              { return __hip_atomic_load(p, __ATOMIC_RELAXED, __HIP_MEMORY_SCOPE_AGENT); }
__device__ __forceinline__ unsigned xb_add(unsigned* p, unsigned v) { return __hip_atomic_fetch_add(p, v, __ATOMIC_RELAXED, __HIP_MEMORY_SCOPE_AGENT); }
__device__ __forceinline__ unsigned xb_xcc_id() { return (unsigned)__builtin_amdgcn_s_getreg((3 << 11) | 20) & 0xFu; }
#define XB_SPIN(cond, bar) do { unsigned _sp = 0; while (cond) { __builtin_amdgcn_s_sleep(1); \
    if ((++_sp & 255u) == 0u) { if (xb_ld(&(bar)[XB_TMO])) break; if (_sp > XB_SPIN_CAP) { atomicAdd(&(bar)[XB_TMO], 1u); break; } } } } while (0)
struct XcdBarrier { unsigned* bar; unsigned x; volatile LAS unsigned* st; };
__device__ __forceinline__ XcdBarrier xcd_barrier_post(unsigned* bar, volatile LAS unsigned* st) {
    XcdBarrier b; b.bar = bar; b.x = xb_xcc_id(); b.st = st;
    if (threadIdx.x == 0) (void)xb_add(&bar[XB_XCNT(b.x)], 1u);
    return b;
}
__device__ __forceinline__ void xcd_barrier_complete(unsigned* bar, unsigned x, unsigned& nloc, unsigned& nx) {
    const unsigned G = gridDim.x * gridDim.y * gridDim.z;
    unsigned sum, cnt, mine, sp = 0u;
    for (;;) {
        sum = 0u; cnt = 0u; mine = 0u;
#pragma unroll
        for (unsigned j = 0; j < 16; ++j) { const unsigned c = xb_ld(&bar[XB_XCNT(j)]); sum += c; cnt += (c > 0u) ? 1u : 0u; mine = (j == x) ? c : mine; }
        if (sum == G) break;
        __builtin_amdgcn_s_sleep(1);
        if ((++sp & 255u) == 0u) { if (xb_ld(&bar[XB_TMO])) break; if (sp > XB_SPIN_CAP) { atomicAdd(&bar[XB_TMO], 1u); break; } }
    }
    nloc = mine > 0u ? mine : 1u; nx = cnt > 0u ? cnt : 1u;
}
__device__ __forceinline__ void xcd_barrier(unsigned* bar_, volatile LAS unsigned* st_) {
    XcdBarrier b; b.bar = bar_; b.x = xb_xcc_id(); b.st = st_;
    asm volatile("s_waitcnt vmcnt(0)" ::: "memory");
    __syncthreads();
    if (threadIdx.x == 0) {
        unsigned* bar = b.bar;
        __builtin_amdgcn_s_waitcnt(0);
        unsigned nloc = b.st[0], nx = b.st[1];
        if (nloc == 0u) { xcd_barrier_complete(bar, b.x, nloc, nx); b.st[0] = nloc; b.st[1] = nx; }
        const unsigned epoch = b.st[2] + 1u; b.st[2] = epoch;
        const unsigned old = xb_add(&bar[XB_XSUB(b.x)], 1u);
        if (old + 1u == epoch * nloc) {
            __builtin_amdgcn_fence(__ATOMIC_RELEASE, "agent");
            asm volatile("s_waitcnt vmcnt(0)" ::: "memory");
            (void)xb_add(&bar[XB_TOP], 1u);
        }
        XB_SPIN(xb_ld(&bar[XB_TOP]) < epoch * nx, bar);
        __builtin_amdgcn_fence(__ATOMIC_ACQUIRE, "agent");
        asm volatile("s_waitcnt vmcnt(0)" ::: "memory");
    }
    __syncthreads();
}

constexpr int NPHASE = 19;
constexpr int MISC_OFF = 146944;
constexpr int CW_BAR = 4096;
constexpr int CW_CTX = 1024;
template <int LO, int HI> __global__ void __launch_bounds__(NTHR, 2) mega(Params p) {
    extern __shared__ __attribute__((aligned(16))) unsigned char lds[];
    const int bid = blockIdx.x, nblk = gridDim.x;
    PG8_LAS unsigned char* l3 = (PG8_LAS unsigned char*)lds;
    unsigned char* ws = p.ws;
    const float* mod = (const float*)(ws + WS_MOD);
    constexpr bool MULTI = (HI - LO) > 1;
    if (MULTI) {
        volatile LAS unsigned* MISC = (volatile LAS unsigned*)(l3 + MISC_OFF);
        if (threadIdx.x < 32) MISC[threadIdx.x] = 0u;
        __syncthreads();
        (void)xcd_barrier_post((unsigned*)(ws + WS_CTL) + CW_BAR, MISC + 8);
    }
#define IN(k) (LO <= (k) && (k) < HI)
#ifndef PROBE_DUP
#define PROBE_DUP 0u
#endif
#define DUPQ(k) (((PROBE_DUP) >> (k)) & 1u)
#define BARRIER_NOW() xcd_barrier((unsigned*)(p.ws + WS_CTL) + CW_BAR, (volatile LAS unsigned*)(l3 + MISC_OFF) + 8)
#define SEAM(k) do { if (IN(k) && IN((k) + 1)) xcd_barrier((unsigned*)(p.ws + WS_CTL) + CW_BAR, (volatile LAS unsigned*)(l3 + MISC_OFF) + 8); } while (0)
#define PHASE(k, ...) do { if (IN(k)) { __VA_ARGS__; if (DUPQ(k)) { BARRIER_NOW(); __VA_ARGS__; } } SEAM(k); } while (0)
#define GEMM_INPROJ() do { pg8::Gemm g{(const bf16_t*)(ws + WS_H), (const bf16_t*)(ws + WS_WHGIN), NTOK, 5120, DM}; pg8::StaticOrder S; S.init(NTOK, 5120, nblk, bid, 0); EpiInProj E{ws}; pg8::gemm_phase<EpiInProj, pg8::StaticOrder, false>(l3, g, S, E, nullptr); } while (0)
#define GEMM_OUT(AOFF, WOFF, GATE) do { pg8::Gemm g{(const bf16_t*)(ws + (AOFF)), (const bf16_t*)(ws + (WOFF)), NTOK, DM, DM}; pg8::StaticOrder S; S.init(NTOK, DM, nblk, bid, 0); EpiResid E{(float*)(ws + WS_X), (GATE)}; pg8::gemm_phase<EpiResid, pg8::StaticOrder, false>(l3, g, S, E, nullptr); } while (0)
#define GEMM_MOE1(l) do { pg8::Gemm g{(const bf16_t*)(ws + WS_H), (const bf16_t*)(ws + WS_WMOE1) + (size_t)(l) * NE * 4096 * DM, NSLOT, 4096, DM}; pg8::StaticOrder S; S.init(NSLOT, 4096, nblk, bid, 8); EpiGLU E{(bf16_t*)(ws + WS_ACT)}; pg8::gemm_phase<EpiGLU, pg8::StaticOrder, true>(l3, g, S, E, (const int*)(ws + WS_TOPI)); } while (0)
#define GEMM_MOE2(l) do { pg8::Gemm g{(const bf16_t*)(ws + WS_ACT), (const bf16_t*)(ws + WS_WMOE2) + (size_t)(l) * NE * DM * DE, NSLOT, DM, DE}; pg8::StaticOrder S; S.init(NSLOT, DM, nblk, bid, 8); EpiRowScale E{(bf16_t*)(ws + WS_Y), (const float*)(ws + WS_TOPG)}; pg8::gemm_phase<EpiRowScale, pg8::StaticOrder, false>(l3, g, S, E, nullptr); } while (0)
#define GEMM_CONVIN() do { pg8::Gemm g{(const bf16_t*)(ws + WS_H), (const bf16_t*)(ws + WS_WSCIN), NTOK, 3072, DM}; pg8::StaticOrder S; S.init(NTOK, 3072, nblk, bid, 0); EpiConvIn E{(bf16_t*)(ws + WS_BG), (bf16_t*)(ws + WS_CU)}; pg8::gemm_phase<EpiConvIn, pg8::StaticOrder, false>(l3, g, S, E, nullptr); } while (0)
#define MOD0_PHASE() do { if (nblk >= 48) { if (bid < 24) { ph_mod0(p, NTOK + (bid * NCTX) / 24, NTOK + ((bid + 1) * NCTX) / 24, 0, 1); \
              \
            asm volatile("s_waitcnt vmcnt(0)" ::: "memory"); __syncthreads(); \
            if (threadIdx.x == 0) { unsigned* cnt = (unsigned*)(p.ws + WS_CTL) + CW_CTX; __builtin_amdgcn_fence(__ATOMIC_RELEASE, "agent"); asm volatile("s_waitcnt vmcnt(0)" ::: "memory"); \
                xb_add(cnt, 1u); unsigned sp_ = 0u; while (xb_ld(cnt) < 24u) { __builtin_amdgcn_s_sleep(1); if (++sp_ > (1u << 22)) break; } \
                __builtin_amdgcn_fence(__ATOMIC_ACQUIRE, "agent"); asm volatile("s_waitcnt vmcnt(0)" ::: "memory"); } \
            __syncthreads(); \
            pg8::Gemm g{(const bf16_t*)(ws + WS_H), (const bf16_t*)(ws + WS_WHGIN), NROW, 5120, DM}; pg8::OneUnit S{64 + bid / 12, 4 + bid % 12}; EpiInProj E{ws}; pg8::gemm_phase<EpiInProj, pg8::OneUnit, false>(l3, g, S, E, nullptr); } \
          else ph_mod0(p, 0, NTOK, bid - 24, nblk - 24); } \
        else { ph_mod0(p, 0, NROW, bid, nblk); } } while (0)
#define CTX_TILES_FALLBACK() do { if (nblk < 48) { BARRIER_NOW(); pg8::Gemm g{(const bf16_t*)(ws + WS_H), (const bf16_t*)(ws + WS_WHGIN), NROW, 5120, DM}; \
        for (int ti = bid; ti < 24; ti += nblk) { pg8::OneUnit S{64 + ti / 12, 4 + ti % 12}; EpiInProj E{ws}; pg8::gemm_phase<EpiInProj, pg8::OneUnit, false>(l3, g, S, E, nullptr); } } } while (0)
    PHASE(0, ph_prep(p, lds, bid, nblk); __syncthreads(); ph_convert_small(p, lds, bid, nblk));
    if (IN(1)) { MOD0_PHASE(); CTX_TILES_FALLBACK(); }
    SEAM(1);
#define HOSTED(GEMM_RANGE, NR, NCH, LAYER) do { const bool odd_ = (bid & 1) != 0; \
        _Pragma("unroll 1") for (int ch_ = 0; ch_ < (NCH); ++ch_) { \
            if (odd_) convert_moe_slice(p, lds, bid, nblk, LAYER, (49152 * ch_) / (NCH), (49152 * (ch_ + 1)) / (NCH)); \
            GEMM_RANGE(ch_ * ((NR) / (NCH)), (ch_ + 1) * ((NR) / (NCH))); __syncthreads(); \
            if (!odd_) convert_moe_slice(p, lds, bid, nblk, LAYER, (49152 * ch_) / (NCH), (49152 * (ch_ + 1)) / (NCH)); } } while (0)
#define GEMM_INPROJ_R(LO_, HI_) do { pg8::Gemm g{(const bf16_t*)(ws + WS_H), (const bf16_t*)(ws + WS_WHGIN), NTOK, 5120, DM}; pg8::RangeOrder S; S.S.init(NTOK, 5120, nblk, bid, 0); S.lo = (LO_); S.hi = (HI_); EpiInProj E{ws}; pg8::gemm_phase<EpiInProj, pg8::RangeOrder, false>(l3, g, S, E, nullptr); } while (0)
#define GEMM_MOE1_R0(LO_, HI_) do { pg8::Gemm g{(const bf16_t*)(ws + WS_H), (const bf16_t*)(ws + WS_WMOE1), NSLOT, 4096, DM}; pg8::RangeOrder S; S.S.init(NSLOT, 4096, nblk, bid, 8); S.lo = (LO_); S.hi = (HI_); EpiGLU E{(bf16_t*)(ws + WS_ACT)}; pg8::gemm_phase<EpiGLU, pg8::RangeOrder, true>(l3, g, S, E, (const int*)(ws + WS_TOPI)); } while (0)
    PHASE(2, HOSTED(GEMM_INPROJ_R, 5, 1, 0));
    PHASE(3, ph_gla_states(p, lds, bid, nblk));
    PHASE(4, ph_gla_out(p, lds, bid, nblk));
    if (IN(5)) GEMM_OUT(WS_ON, WS_WHGOUT, mod + 2 * DM);
    SEAM(5);
    PHASE(6, ph_modffn(p, lds, bid, nblk, 0));
    PHASE(7, ph_topk(p, lds, bid, nblk));
    PHASE(8, HOSTED(GEMM_MOE1_R0, 8, 1, 1));
    PHASE(9, GEMM_MOE2(0));
    if (IN(10)) ph_combine(p, bid, nblk, 0, false);
    SEAM(10);
    PHASE(11, GEMM_CONVIN());
    PHASE(12, ph_conv(p, bid, nblk));
    if (IN(13)) GEMM_OUT(WS_Z, WS_WSCOUT, mod + (size_t)3 * NADA + 2 * DM);
    SEAM(13);
    PHASE(14, ph_modffn(p, lds, bid, nblk, 1));
    PHASE(15, ph_topk(p, lds, bid, nblk));
    PHASE(16, GEMM_MOE1(1));
    PHASE(17, GEMM_MOE2(1));
    if (IN(18)) ph_combine(p, bid, nblk, 1, true);
#undef IN
#undef SEAM
}

#ifndef MK_SPLIT
#define MK_SPLIT 0
#endif
#if MK_SPLIT
#include <utility>
template <int... I> static void launch_all(std::integer_sequence<int, I...>, int grid, Params& p, hipStream_t stream) {
    ((void)hipFuncSetAttribute((const void*)mega<I, I + 1>, hipFuncAttributeMaxDynamicSharedMemorySize, LDS_BYTES), ...);
    ((mega<I, I + 1><<<dim3(grid), dim3(NTHR), LDS_BYTES, stream>>>(p)), ...); }
#endif
extern "C" void kernel_launch(void* const* d_in, const int* in_sizes, int n_in, void* d_out, int out_size, void* d_ws, size_t ws_size, hipStream_t stream) {
    static int grid = 0;
    if (grid == 0) {
        if (n_in != 20 || ws_size < WS_END) { fprintf(stderr, "kernel_launch: unexpected inputs (n_in %d, ws %zu, need %zu)\n", n_in, ws_size, (size_t)WS_END); grid = -1; return; }
        int dev = 0, cus = 0, per_cu = 0;
        (void)hipGetDevice(&dev); (void)hipDeviceGetAttribute(&cus, hipDeviceAttributeMultiprocessorCount, dev);
        (void)hipFuncSetAttribute((const void*)mega<0, NPHASE>, hipFuncAttributeMaxDynamicSharedMemorySize, LDS_BYTES);
        if (hipOccupancyMaxActiveBlocksPerMultiprocessor(&per_cu, (const void*)mega<0, NPHASE>, NTHR, LDS_BYTES) != hipSuccess || per_cu < 1) { fprintf(stderr, "kernel_launch: occupancy query failed (%d)\n", per_cu); per_cu = 1; }
        (void)hipGetLastError();
        if (per_cu > 1) per_cu = 1;
        grid = (cus > 0 ? cus : 256) * per_cu;
    }
    if (grid < 0) return;
    Params p{};
    for (int i = 0; i < 20; ++i) p.in[i] = (const float*)d_in[i];
    p.out = (float*)d_out; p.ws = (unsigned char*)d_ws;
#if MK_SPLIT
    launch_all(std::make_integer_sequence<int, NPHASE>{}, grid, p, stream);
#else
    (void)hipMemsetAsync((char*)d_ws + WS_CTL, 0, 65536, stream);
    void* args[] = {&p};
    hipError_t e = hipLaunchCooperativeKernel((const void*)mega<0, NPHASE>, dim3(grid), dim3(NTHR), args, LDS_BYTES, stream);
    if (e != hipSuccess) fprintf(stderr, "kernel_launch: cooperative launch failed: %s (grid %d)\n", hipGetErrorString(e), grid);
#endif
}
```

```cpp
#include <hip/hip_runtime.h>
#include <cstdio>
#include <cstdint>

namespace pg8 {
#define PG8_LAS __attribute__((address_space(3)))
typedef unsigned short bf16_t;
typedef short bf16x8 __attribute__((ext_vector_type(8)));
typedef float f32x4 __attribute__((ext_vector_type(4)));
typedef unsigned u32x4 __attribute__((ext_vector_type(4)));
typedef unsigned u32x2 __attribute__((ext_vector_type(2)));
constexpr int BM = 256, BK = 64, HALF = 128, HTB = HALF * BK * 2, STAGE_BYTES = 8 * HTB, NXCD = 8, WGM = 8;

__host__ __device__ __forceinline__ int lds_byte(int r, int c) { const int st = (r >> 4) * 2 + (c >> 5), rr = r & 15, cc = c & 31, ob = rr * 64 + cc * 2; return st * 1024 + (ob ^ (((ob >> 9) & 1) << 5)); }
__host__ __device__ __forceinline__ void stage_rc(int b, int& R, int& C) { const int st = b / 1024, sb = b % 1024, swz = sb ^ (((sb >> 9) & 1) << 5); R = (st >> 1) * 16 + swz / 64; C = (st & 1) * 32 + (swz % 64) / 2; }
__host__ __device__ __forceinline__ int perm32(int rho) { const int n = rho >> 4, i = rho & 15; return 8 * (i >> 2) + 4 * n + (i & 3); }

struct Unit { int pm, pn, pb; };
struct Gemm { const bf16_t* A; const bf16_t* Bt; int M, N, K; };

struct StaticOrder {
    int nM, nN, nwg, G, c, mpe;
    __device__ void init(int M, int N, int G_, int c_, int mpe_) { nM = M / BM; nN = N / BM; nwg = nM * nN; G = G_; c = c_; mpe = mpe_; }
    __device__ bool next(int i, Unit& u) const {
        const long L = (long)i * G + c; if (L >= nwg) return false;
        int wgid = (int)L; { const int q = nwg / NXCD, r = nwg % NXCD, xcd = wgid % NXCD, off = wgid / NXCD; wgid = (xcd < r ? xcd * (q + 1) : r * (q + 1) + (xcd - r) * q) + off; }
        const int nig = WGM * nN, gid = wgid / nig, fm = gid * WGM, gsz = (nM - fm) < WGM ? (nM - fm) : WGM;
        u.pm = fm + ((wgid % nig) % gsz); u.pn = (wgid % nig) / gsz; u.pb = mpe > 0 ? (u.pm / mpe) * nN + u.pn : u.pn; return true;
    }
};

__device__ __forceinline__ unsigned cvt_pk_bf16(float lo, float hi) { unsigned r; asm volatile("v_cvt_pk_bf16_f32 %0, %1, %2" : "=v"(r) : "v"(lo), "v"(hi)); return r; }

struct RangeOrder {
    StaticOrder S; int lo, hi;
    __device__ bool next(int i, Unit& u) const { return (lo + i < hi) ? S.next(lo + i, u) : false; }
};
struct OneUnit {
    int pm, pn;
    __device__ bool next(int i, Unit& u) const { if (i != 0) return false; u.pm = pm; u.pn = pn; u.pb = pn; return true; }
};
template <class Epi, class Sched, bool GATHER>
__device__ __forceinline__ void gemm_phase(PG8_LAS unsigned char* lds, const Gemm g, const Sched& S, const Epi& E, const int* gidx) {
    int tid_ = threadIdx.x; asm volatile("" : "+v"(tid_));
    const int tid = tid_, wid = __builtin_amdgcn_readfirstlane(tid >> 6), lane = tid & 63, wr = wid >> 2, wc = wid & 3, fr = lane & 15, fq = lane >> 4;
    const int K = g.K, nt = K / BK;
    unsigned voffA[2], voffB[2]; int rA[2], cA2[2];
#pragma unroll
    for (int i = 0; i < 2; ++i) { int R, C; stage_rc(tid * 16 + i * 8192, R, C); const int Rb = Epi::PERM ? ((R & ~31) + perm32(R & 31)) : R;
        voffA[i] = (unsigned)(R * K + C) * 2u; voffB[i] = (unsigned)(Rb * K + C) * 2u; rA[i] = R; cA2[i] = C * 2; }
    unsigned gcur[2][2], gnxt[2][2];
#define PG8_GOFF(dst, u) do { _Pragma("unroll") for (int _h = 0; _h < 2; ++_h) _Pragma("unroll") for (int _i = 0; _i < 2; ++_i) \
        dst[_h][_i] = (unsigned)gidx[(u).pm * BM + _h * HALF + rA[_i]] * (unsigned)(K * 2) + (unsigned)cA2[_i]; } while (0)
    const size_t kstep = (size_t)(BK * 2);
    const size_t hstep = (size_t)HALF * K * 2;
    const size_t tstep = 2 * hstep;
    const unsigned ldsw = (unsigned)wid * 1024u;
    const int aoff = lds_byte(wr * 64 + fr, fq * 8), boff = lds_byte(wc * 32 + fr, fq * 8);
#define PG8_SA(b, h) (((b) * 2 + (h)) * HTB)
#define PG8_SB(b, h) ((4 + (b) * 2 + (h)) * HTB)
#define PG8_STAGE(bufoff, gbase, voff) do { _Pragma("unroll") for (int _i = 0; _i < 2; ++_i) \
        __builtin_amdgcn_global_load_lds((const unsigned*)((const char*)(gbase) + (voff)[_i]), (PG8_LAS unsigned*)(lds + (bufoff) + ldsw + _i * 8192), 16, 0, 0); } while (0)
#define PG8_STAGE_A(bufoff, half, kb, NX) do { _Pragma("unroll") for (int _i = 0; _i < 2; ++_i) { \
        const char* _src = GATHER ? (const char*)g.A + (kb) + ((NX) ? gnxt[half][_i] : gcur[half][_i]) : ((NX) ? nA : cA) + (size_t)(half) * hstep + (kb) + voffA[_i]; \
        __builtin_amdgcn_global_load_lds((const unsigned*)_src, (PG8_LAS unsigned*)(lds + (bufoff) + ldsw + _i * 8192), 16, 0, 0); } } while (0)
#define PG8_LDA(dst, b, h) do { _Pragma("unroll") for (int m = 0; m < 4; ++m) _Pragma("unroll") for (int k = 0; k < 2; ++k) dst[m][k] = *(const PG8_LAS bf16x8*)(lds + PG8_SA(b, h) + aoff + m * 2048 + k * 1024); } while (0)
#define PG8_LDB(dst, b, h) do { _Pragma("unroll") for (int n = 0; n < 2; ++n) _Pragma("unroll") for (int k = 0; k < 2; ++k) dst[n][k] = *(const PG8_LAS bf16x8*)(lds + PG8_SB(b, h) + boff + n * 2048 + k * 1024); } while (0)
#define PG8_MMA(ai, bj, At, Bt) do { __builtin_amdgcn_s_setprio(1); _Pragma("unroll") for (int m = 0; m < 4; ++m) _Pragma("unroll") for (int n = 0; n < 2; ++n) _Pragma("unroll") for (int k = 0; k < 2; ++k) \
        acc[ai][bj][m][n] = __builtin_amdgcn_mfma_f32_16x16x32_bf16(Bt[n][k], At[m][k], acc[ai][bj][m][n], 0, 0, 0); __builtin_amdgcn_s_setprio(0); } while (0)
#define PG8_WAIT_V(n) asm volatile("s_waitcnt vmcnt(" #n ")" ::: "memory")
#define PG8_WAIT_L(n) asm volatile("s_waitcnt lgkmcnt(" #n ")" ::: "memory")
#define PG8_BAR __builtin_amdgcn_s_barrier()
#define PG8_SCHED __builtin_amdgcn_sched_barrier(0)
    Unit cur, nxt; int ui = 0;
    if (!S.next(0, cur)) return;
    f32x4 acc[2][2][4][2];
#pragma unroll
    for (int a = 0; a < 2; ++a)
#pragma unroll
        for (int b = 0; b < 2; ++b)
#pragma unroll
            for (int m = 0; m < 4; ++m)
#pragma unroll
                for (int n = 0; n < 2; ++n) acc[a][b][m][n] = (f32x4){0.f, 0.f, 0.f, 0.f};
    bf16x8 At[4][2], B0[2][2], B1[2][2];
    const char* cA = GATHER ? (const char*)g.A : (const char*)g.A + (size_t)cur.pm * tstep; const char* cB = (const char*)g.Bt + (size_t)cur.pb * tstep; const char* nA = cA;
    if (GATHER) { PG8_GOFF(gcur, cur); }
    PG8_STAGE(PG8_SB(0, 0), cB, voffB); PG8_STAGE(PG8_SB(0, 1), cB + hstep, voffB); PG8_STAGE_A(PG8_SA(0, 0), 0, 0, false); PG8_STAGE_A(PG8_SA(0, 1), 1, 0, false);
    if (wr == 1) PG8_BAR;
    PG8_WAIT_V(2); PG8_BAR;
    PG8_STAGE(PG8_SB(1, 0), cB + kstep, voffB); PG8_STAGE_A(PG8_SA(1, 0), 0, kstep, false); PG8_STAGE(PG8_SB(1, 1), cB + hstep + kstep, voffB);
    PG8_WAIT_V(6); PG8_BAR;
    for (;;) {
        const bool has_next = S.next(ui + 1, nxt);
        nA = GATHER ? cA : (has_next ? (const char*)g.A + (size_t)nxt.pm * tstep : cA); const char* nB = has_next ? (const char*)g.Bt + (size_t)nxt.pb * tstep : cB;
        if (GATHER) { if (has_next) { PG8_GOFF(gnxt, nxt); } else {
#pragma unroll
            for (int _h = 0; _h < 2; ++_h)
#pragma unroll
                for (int _i = 0; _i < 2; ++_i) gnxt[_h][_i] = gcur[_h][_i]; } }
        for (int t = 0; t < nt; t += 2) {
            const bool last = (t == nt - 2);
            const size_t k1 = (size_t)(t + 1) * kstep, k2 = last ? 0 : (size_t)(t + 2) * kstep, k3 = k2 + kstep;
            const char* b2 = last ? nB : cB + (size_t)(t + 2) * kstep; const char* b3 = b2 + kstep;
            PG8_LDB(B0, 0, 0); PG8_LDB(B1, 0, 1); PG8_SCHED; PG8_LDA(At, 0, 0); PG8_STAGE_A(PG8_SA(1, 1), 1, k1, false);
            PG8_WAIT_V(8); PG8_WAIT_L(0); PG8_BAR; PG8_MMA(0, 0, At, B0); PG8_MMA(0, 1, At, B1); PG8_BAR; PG8_SCHED;
            PG8_LDA(At, 0, 1); PG8_STAGE(PG8_SB(0, 0), b2, voffB); PG8_STAGE(PG8_SB(0, 1), b2 + hstep, voffB); PG8_STAGE_A(PG8_SA(0, 0), 0, k2, last);
            PG8_WAIT_V(8); PG8_WAIT_L(0); PG8_BAR; PG8_MMA(1, 0, At, B0); PG8_MMA(1, 1, At, B1); PG8_BAR; PG8_SCHED;
            PG8_LDB(B0, 1, 0); PG8_LDB(B1, 1, 1); PG8_SCHED; PG8_LDA(At, 1, 0); PG8_STAGE_A(PG8_SA(0, 1), 1, k2, last);
            PG8_WAIT_V(8); PG8_WAIT_L(0); PG8_BAR; PG8_MMA(0, 0, At, B0); PG8_MMA(0, 1, At, B1); PG8_BAR; PG8_SCHED;
            PG8_LDA(At, 1, 1); PG8_STAGE(PG8_SB(1, 0), b3, voffB); PG8_STAGE(PG8_SB(1, 1), b3 + hstep, voffB); PG8_STAGE_A(PG8_SA(1, 0), 0, k3, last);
            PG8_WAIT_V(8); PG8_WAIT_L(0); PG8_BAR; PG8_MMA(1, 0, At, B0); PG8_MMA(1, 1, At, B1); PG8_BAR; PG8_SCHED;
        }
        if (wr == 0) PG8_BAR;
        E(acc, cur, wr, wc, fr, fq);
        if (!has_next) break;
#pragma unroll
        for (int a = 0; a < 2; ++a)
#pragma unroll
            for (int b = 0; b < 2; ++b)
#pragma unroll
                for (int m = 0; m < 4; ++m)
#pragma unroll
                    for (int n = 0; n < 2; ++n) acc[a][b][m][n] = (f32x4){0.f, 0.f, 0.f, 0.f};
        cur = nxt; cA = nA; cB = nB; ++ui;
        if (GATHER) {
#pragma unroll
            for (int _h = 0; _h < 2; ++_h)
#pragma unroll
                for (int _i = 0; _i < 2; ++_i) gcur[_h][_i] = gnxt[_h][_i]; }
        if (wr == 1) PG8_BAR;
    }
    PG8_WAIT_V(0);
    PG8_BAR;
#undef PG8_SA
#undef PG8_SB
#undef PG8_STAGE
#undef PG8_STAGE_A
#undef PG8_GOFF
#undef PG8_LDA
#undef PG8_LDB
#undef PG8_MMA
#undef PG8_WAIT_V
#undef PG8_WAIT_L
#undef PG8_BAR
#undef PG8_SCHED
}
}

#define LAS __attribute__((address_space(3)))
using pg8::bf16_t; using pg8::f32x4; using pg8::u32x4; using pg8::u32x2;
typedef unsigned short u16x8 __attribute__((ext_vector_type(8)));
typedef float f32x2 __attribute__((ext_vector_type(2)));

constexpr int DM = 1024, NB = 2, SEQ = 8192, NTOK = NB * SEQ, CTXL = 256, NCTX = NB * CTXL, NROW = NTOK + NCTX;
constexpr int NE = 16, CAP = 1024, DE = 2048, NSLOT = NE * NB * CAP;
constexpr int NADA = 6 * DM;
constexpr int NTHR = 512;

constexpr size_t MiB = 1u << 20;
constexpr size_t WS_CTL = 0;
constexpr size_t WS_MOD = 1 * MiB;
constexpr size_t WS_LB = WS_MOD + 256 * 1024;
constexpr size_t WS_POSR = WS_LB + 64 * 1024;
constexpr size_t WS_POSC = WS_POSR + 256 * 1024;
constexpr size_t WS_AFF = 2 * MiB;
constexpr size_t WS_TOPI = 3 * MiB;
constexpr size_t WS_TOPG = WS_TOPI + 128 * 1024;
constexpr size_t WS_SLOT = 4 * MiB;
constexpr size_t WS_WHGIN = 6 * MiB;
constexpr size_t WS_WHGOUT = 16 * MiB;
constexpr size_t WS_WSCIN = 18 * MiB;
constexpr size_t WS_WSCOUT = 24 * MiB;
constexpr size_t WS_WMOE1 = 26 * MiB;
constexpr size_t WS_WMOE2 = WS_WMOE1 + 256 * MiB;
constexpr size_t WS_X = WS_WMOE2 + 128 * MiB;
constexpr size_t WS_H = WS_X + 64 * MiB;
constexpr size_t WS_R = WS_H + 34 * MiB;
constexpr size_t WS_Q = WS_R;
constexpr size_t WS_V = WS_Q + 34 * MiB;
constexpr size_t WS_G = WS_V + 34 * MiB;
constexpr size_t WS_LF = WS_G + 34 * MiB;
constexpr size_t WS_LBK = WS_LF + 66 * MiB;
constexpr size_t WS_OF = WS_LBK + 66 * MiB;
constexpr size_t WS_OB = WS_OF + 64 * MiB;
constexpr size_t WS_U = WS_OB;
constexpr size_t WS_DD = WS_OB + 40 * MiB;
constexpr size_t WS_ON = WS_OB + 64 * MiB;
constexpr size_t WS_HG_END = WS_ON + 32 * MiB;
constexpr size_t WS_XG = WS_R;
constexpr size_t WS_ACT = WS_XG + 64 * MiB;
constexpr size_t WS_Y = WS_ACT + 128 * MiB;
constexpr size_t WS_MOE_END = WS_Y + 128 * MiB;
constexpr size_t WS_BG = WS_R;
constexpr size_t WS_CU = WS_BG + 32 * MiB;
constexpr size_t WS_Z = WS_CU + 32 * MiB;
constexpr size_t WS_END = WS_HG_END > WS_MOE_END ? WS_HG_END : WS_MOE_END;
static_assert(WS_END <= 1024 * MiB, "workspace map exceeds 1 GiB");

constexpr int LDS_BYTES = 147456;

struct Params { const float* in[20]; float* out; unsigned char* ws; int ph_lo, ph_hi; };
enum { I_X = 0, I_C, I_CTX, I_CCTX, I_ADAW, I_ADAB, I_NMIX, I_NFFN, I_NFIN, I_HGWIN, I_HGLB, I_HGNORM, I_HGWOUT, I_SCWIN, I_SCCONV, I_SCWOUT, I_ROUTER, I_WGATE, I_WUP, I_WDOWN };

typedef __bf16 bf16x2_t __attribute__((ext_vector_type(2)));
__device__ __forceinline__ unsigned pk2(float lo, float hi) { const f32x2 v = {lo, hi}; return __builtin_bit_cast(unsigned, __builtin_convertvector(v, bf16x2_t)); }
__device__ __forceinline__ unsigned f2bf(float f) { return pk2(f, 0.f) & 0xffffu; }
__device__ __forceinline__ float bf2f(unsigned short h) { return __builtin_bit_cast(float, (unsigned)h << 16); }
template <int CTRL> __device__ __forceinline__ float dpp_f(float x) { return __builtin_bit_cast(float, __builtin_amdgcn_update_dpp(0, __builtin_bit_cast(int, x), CTRL, 0xf, 0xf, true)); }
__device__ __forceinline__ float row16_sum(float x) {
    x += dpp_f<0xB1>(x);
    x += dpp_f<0x4E>(x);
    x += dpp_f<0x141>(x);
    x += dpp_f<0x140>(x);
    return x;
}
__device__ __forceinline__ float wave_sum(float v) { v = row16_sum(v); v += __shfl_xor(v, 16); v += __shfl_xor(v, 32); return v; }
__device__ __forceinline__ float sigmoidf_(float x) { return 1.f / (1.f + expf(-x)); }
__device__ __forceinline__ float fsigmoid(float x) { return __builtin_amdgcn_rcpf(1.f + __builtin_amdgcn_exp2f(-1.4426950408889634f * x)); }
__device__ __forceinline__ float fsilu(float x) { return x * fsigmoid(x); }
__device__ __forceinline__ float siluf_(float x) { return x / (1.f + expf(-x)); }

struct EpiInProj {
    static constexpr bool PERM = false;
    unsigned char* ws;
    __device__ __forceinline__ void operator()(const f32x4 (&acc)[2][2][4][2], const pg8::Unit& u, int wr, int wc, int fr, int fq) const {
        const int sec = u.pn >> 2;
        const int row0 = u.pm * 256 + wr * 64 + fr, cb = (u.pn & 3) * 256 + wc * 32 + 4 * fq;
        if (sec == 0 || sec == 1 || sec == 4) {
            bf16_t* O = (bf16_t*)(ws + (sec == 0 ? WS_Q : (sec == 1 ? WS_V : WS_G)));
#pragma unroll
            for (int ai = 0; ai < 2; ++ai)
#pragma unroll
                for (int m = 0; m < 4; ++m) { bf16_t* rp = O + (size_t)(row0 + ai * 128 + m * 16) * DM + cb;
#pragma unroll
                    for (int bj = 0; bj < 2; ++bj)
#pragma unroll
                        for (int n = 0; n < 2; ++n) { f32x4 v = acc[ai][bj][m][n];
                            if (sec == 0) v = v * 0.08838834764831845f;
                            if (sec == 4) { v[0] = fsilu(v[0]); v[1] = fsilu(v[1]); v[2] = fsilu(v[2]); v[3] = fsilu(v[3]); }
                            u32x2 w; w.x = pk2(v[0], v[1]); w.y = pk2(v[2], v[3]); *(u32x2*)(rp + bj * 128 + n * 16) = w; } }
        } else {
            float* O = (float*)(ws + (sec == 2 ? WS_LF : WS_LBK)); const float* lb0 = (const float*)(ws + WS_LB);
            f32x4 lbv[2][2];
#pragma unroll
            for (int bj = 0; bj < 2; ++bj)
#pragma unroll
                for (int n = 0; n < 2; ++n) lbv[bj][n] = *(const f32x4*)(lb0 + cb + bj * 128 + n * 16);
#pragma unroll
            for (int ai = 0; ai < 2; ++ai)
#pragma unroll
                for (int m = 0; m < 4; ++m) { float* rp = O + (size_t)(row0 + ai * 128 + m * 16) * DM + cb;
#pragma unroll
                    for (int bj = 0; bj < 2; ++bj)
#pragma unroll
                        for (int n = 0; n < 2; ++n) { const f32x4 z = acc[ai][bj][m][n], lb = lbv[bj][n]; f32x4 o;
#pragma unroll
                            for (int i = 0; i < 4; ++i) o[i] = lb[i] + (1.f - lb[i]) * fsigmoid(z[i]);
                            *(f32x4*)(rp + bj * 128 + n * 16) = o; } }
        }
    }
};
struct EpiResid {
    static constexpr bool PERM = false;
    float* X; const float* gate;
    __device__ __forceinline__ void operator()(const f32x4 (&acc)[2][2][4][2], const pg8::Unit& u, int wr, int wc, int fr, int fq) const {
        const int row0 = u.pm * 256 + wr * 64 + fr, cb = u.pn * 256 + wc * 32 + 4 * fq;
        const float* gp = gate + (size_t)((u.pm * 256) / SEQ) * NADA + cb;
        f32x4 gv[2][2];
#pragma unroll
        for (int bj = 0; bj < 2; ++bj)
#pragma unroll
            for (int n = 0; n < 2; ++n) gv[bj][n] = *(const f32x4*)(gp + bj * 128 + n * 16);
#pragma unroll
        for (int ai = 0; ai < 2; ++ai)
#pragma unroll
            for (int m = 0; m < 4; ++m) { float* rp = X + (size_t)(row0 + ai * 128 + m * 16) * DM + cb;
#pragma unroll
                for (int bj = 0; bj < 2; ++bj)
#pragma unroll
                    for (int n = 0; n < 2; ++n) { f32x4* q = (f32x4*)(rp + bj * 128 + n * 16); *q = *q + gv[bj][n] * acc[ai][bj][m][n]; } }
    }
};
struct EpiGLU {
    static constexpr bool PERM = true;
    bf16_t* ACT;
    __device__ __forceinline__ void operator()(const f32x4 (&acc)[2][2][4][2], const pg8::Unit& u, int wr, int wc, int fr, int fq) const {
        const int row0 = u.pm * 256 + wr * 64 + fr, cb = u.pn * 128 + wc * 32 + 8 * fq;
#pragma unroll
        for (int ai = 0; ai < 2; ++ai)
#pragma unroll
            for (int m = 0; m < 4; ++m) { bf16_t* rp = ACT + (size_t)(row0 + ai * 128 + m * 16) * DE + cb;
                f32x4 o[2];
#pragma unroll
                for (int n = 0; n < 2; ++n) { const f32x4 a = acc[ai][0][m][n], w = acc[ai][1][m][n];
#pragma unroll
                    for (int i = 0; i < 4; ++i) o[n][i] = fsilu(a[i]) * w[i]; }
                u32x4 w; w.x = pk2(o[0][0], o[0][1]); w.y = pk2(o[0][2], o[0][3]); w.z = pk2(o[1][0], o[1][1]); w.w = pk2(o[1][2], o[1][3]);
                *(u32x4*)rp = w; }
    }
};
struct EpiRowScale {
    static constexpr bool PERM = true;
    bf16_t* Y; const float* rg;
    __device__ __forceinline__ void operator()(const f32x4 (&acc)[2][2][4][2], const pg8::Unit& u, int wr, int wc, int fr, int fq) const {
        const int row0 = u.pm * 256 + wr * 64 + fr, cb = u.pn * 256 + wc * 32 + 8 * fq;
#pragma unroll
        for (int ai = 0; ai < 2; ++ai)
#pragma unroll
            for (int m = 0; m < 4; ++m) { const int row = row0 + ai * 128 + m * 16; const float gsc = rg[row]; bf16_t* rp = Y + (size_t)row * DM + cb;
#pragma unroll
                for (int bj = 0; bj < 2; ++bj) { const f32x4 v0 = acc[ai][bj][m][0] * gsc, v1 = acc[ai][bj][m][1] * gsc;
                    u32x4 w; w.x = pk2(v0[0], v0[1]); w.y = pk2(v0[2], v0[3]); w.z = pk2(v1[0], v1[1]); w.w = pk2(v1[2], v1[3]);
                    *(u32x4*)(rp + bj * 128) = w; } }
    }
};
struct EpiConvIn {
    static constexpr bool PERM = true;
    bf16_t *BG, *CU;
    __device__ __forceinline__ void operator()(const f32x4 (&acc)[2][2][4][2], const pg8::Unit& u, int wr, int wc, int fr, int fq) const {
        const int row0 = u.pm * 256 + wr * 64 + fr;
        if (u.pn < 4) {
            const int cb = u.pn * 256 + wc * 32 + 8 * fq;
#pragma unroll
            for (int ai = 0; ai < 2; ++ai)
#pragma unroll
                for (int m = 0; m < 4; ++m) { bf16_t* rp = BG + (size_t)(row0 + ai * 128 + m * 16) * DM + cb;
#pragma unroll
                    for (int bj = 0; bj < 2; ++bj) { const f32x4 v0 = acc[ai][bj][m][0], v1 = acc[ai][bj][m][1];
                        u32x4 w; w.x = pk2(v0[0], v0[1]); w.y = pk2(v0[2], v0[3]); w.z = pk2(v1[0], v1[1]); w.w = pk2(v1[2], v1[3]);
                        *(u32x4*)(rp + bj * 128) = w; } }
        } else {
            const int cb = (u.pn - 4) * 128 + wc * 32 + 8 * fq;
#pragma unroll
            for (int ai = 0; ai < 2; ++ai)
#pragma unroll
                for (int m = 0; m < 4; ++m) { bf16_t* rp = CU + (size_t)(row0 + ai * 128 + m * 16) * DM + cb;
                    const f32x4 v0 = acc[ai][0][m][0] * acc[ai][1][m][0], v1 = acc[ai][0][m][1] * acc[ai][1][m][1];
                    u32x4 w; w.x = pk2(v0[0], v0[1]); w.y = pk2(v0[2], v0[3]); w.z = pk2(v1[0], v1[1]); w.w = pk2(v1[2], v1[3]);
                    *(u32x4*)rp = w; }
        }
    }
};

__device__ __forceinline__ void ph_prep(const Params& p, unsigned char* lds, int bid, int nblk) {
    float* sv = (float*)lds;
    float* red = sv + 3 * 1024;
    int tid_ = threadIdx.x; asm volatile("" : "+v"(tid_)); const int tid = tid_;
    const float* c = p.in[I_C]; const float* cctx = p.in[I_CCTX];
    for (int i = tid; i < 3 * 1024; i += NTHR) { const float v = (i < 2048) ? c[i] : cctx[i - 2048]; sv[i] = siluf_(v); }
    __syncthreads();
    const float* ada_w = p.in[I_ADAW]; const float* ada_b = p.in[I_ADAB];
    float* mod = (float*)(p.ws + WS_MOD);
    for (int it = bid; it < 96; it += nblk) {
        const int l = it / 48, j0 = (it % 48) * 128, col = tid & 127, ks = tid >> 7;
        const float* W = ada_w + (size_t)l * DM * NADA + j0 + col;
        float a0 = 0.f, a1 = 0.f, a2 = 0.f;
#pragma unroll 8
        for (int k = ks * 256; k < ks * 256 + 256; ++k) { const float w = W[(size_t)k * NADA]; a0 += sv[k] * w; a1 += sv[1024 + k] * w; a2 += sv[2048 + k] * w; }
        red[(ks * 3 + 0) * 128 + col] = a0; red[(ks * 3 + 1) * 128 + col] = a1; red[(ks * 3 + 2) * 128 + col] = a2;
        __syncthreads();
        if (tid < 384) { const int v = tid >> 7, cc = tid & 127;
            const float s = (red[(0 * 3 + v) * 128 + cc] + red[(1 * 3 + v) * 128 + cc]) + (red[(2 * 3 + v) * 128 + cc] + red[(3 * 3 + v) * 128 + cc]) + ada_b[l * NADA + j0 + cc];
            mod[(size_t)(l * 3 + v) * NADA + j0 + cc] = s; }
        __syncthreads();
    }
    const int gt = bid * NTHR + tid, NT = nblk * NTHR;
    const float* lg = p.in[I_HGLB]; float* lb0 = (float*)(p.ws + WS_LB);
    for (int d = gt; d < DM; d += NT) { const float l0 = lg[d], l1 = lg[DM + d], l2 = lg[2 * DM + d]; const float mx = fmaxf(l0, fmaxf(l1, l2));
        const float e0 = expf(l0 - mx), e1 = expf(l1 - mx), e2 = expf(l2 - mx); lb0[d] = e0 / (e0 + e1 + e2); }
    float* posr = (float*)(p.ws + WS_POSR);
    for (int i = gt; i < (128 + 64) * 512; i += NT) { const int pi = i >> 9, dd = i & 511; const int pos = pi < 128 ? pi : pi - 128; const int fi = dd & 255;
        const float om = exp2f(-(float)fi * (13.287712379549449f / 256.0f)); const float a = (float)pos * om; posr[i] = dd < 256 ? sinf(a) : cosf(a); }
}

__device__ __forceinline__ void transpose_item(const float* W, int N, bf16_t* WT, int K, float* scr, int k0, int n0, size_t drow0, int lane) {
#pragma unroll
    for (int i = 0; i < 8; ++i) { const int kk = 8 * i + (lane >> 3); const f32x4 v = *(const f32x4*)(W + (size_t)(k0 + kk) * N + n0 + (lane & 7) * 4); float* d = scr + kk * 33 + (lane & 7) * 4; d[0] = v[0]; d[1] = v[1]; d[2] = v[2]; d[3] = v[3]; }
    __builtin_amdgcn_s_waitcnt(0xc07f); asm volatile("" ::: "memory");
    const int c = lane & 7;
#pragma unroll
    for (int j = 0; j < 4; ++j) { const int n = (lane >> 3) + 8 * j; const float* s = scr + (8 * c) * 33 + n;
        u32x4 o; o.x = pk2(s[0 * 33], s[1 * 33]); o.y = pk2(s[2 * 33], s[3 * 33]); o.z = pk2(s[4 * 33], s[5 * 33]); o.w = pk2(s[6 * 33], s[7 * 33]);
        *(u32x4*)(WT + (drow0 + n) * K + k0 + 8 * c) = o; }
    __builtin_amdgcn_s_waitcnt(0xc07f); asm volatile("" ::: "memory");
}
__device__ __forceinline__ void ph_convert_small(const Params& p, unsigned char* lds, int bid, int nblk) {
    int tid_ = threadIdx.x; asm volatile("" : "+v"(tid_));
    const int tid = tid_, lane = tid & 63, wave = tid >> 6;
    float* scr = (float*)lds + wave * (64 * 33);
    const int gw = bid * 8 + wave, NGW = nblk * 8;
    constexpr int I_A = 16 * 160, I_B = 16 * 32, I_C_ = 16 * 96, I_D = 16 * 32;
    for (int it = gw; it < I_A + I_B + I_C_ + I_D; it += NGW) {
        int r = it;
        if (r < I_A) { const int kb = r / 160, nb = r % 160; transpose_item(p.in[I_HGWIN], 5120, (bf16_t*)(p.ws + WS_WHGIN), 1024, scr, kb * 64, nb * 32, (size_t)nb * 32, lane); continue; } r -= I_A;
        if (r < I_B) { const int kb = r / 32, nb = r % 32; transpose_item(p.in[I_HGWOUT], 1024, (bf16_t*)(p.ws + WS_WHGOUT), 1024, scr, kb * 64, nb * 32, (size_t)nb * 32, lane); continue; } r -= I_B;
        if (r < I_C_) { const int kb = r / 96, nb = r % 96, n0 = nb * 32; size_t dr;
            if (n0 < 1024) dr = n0; else { const int np = n0 - 1024, sec = np >> 10, nn = np & 1023; dr = 1024 + (nn >> 7) * 256 + sec * 128 + (nn & 127); }
            transpose_item(p.in[I_SCWIN], 3072, (bf16_t*)(p.ws + WS_WSCIN), 1024, scr, kb * 64, n0, dr, lane); continue; } r -= I_C_;
        { const int kb = r / 32, nb = r % 32; transpose_item(p.in[I_SCWOUT], 1024, (bf16_t*)(p.ws + WS_WSCOUT), 1024, scr, kb * 64, nb * 32, (size_t)nb * 32, lane); }
    }
}
struct CvtItem { const float* src; bf16_t* dst; int N, K; };
__device__ __forceinline__ CvtItem moe_item(const Params& p, int l, int r) {
    CvtItem c;
    if (r < 32768) { const int up = r >= 16384; if (up) r -= 16384; const int le = l * 16 + (r >> 10), q = r & 1023, kb = q >> 6, nb = q & 63, n0 = nb * 32;
        const size_t dr = (size_t)le * 4096 + (n0 >> 7) * 256 + up * 128 + (n0 & 127);
        c.src = p.in[up ? I_WUP : I_WGATE] + (size_t)le * 1024 * 2048 + (size_t)(kb * 64) * 2048 + n0; c.dst = (bf16_t*)(p.ws + WS_WMOE1) + dr * 1024 + kb * 64; c.N = 2048; c.K = 1024; }
    else { r -= 32768; const int le = l * 16 + (r >> 10), q = r & 1023, kb = q >> 5, nb = q & 31, n0 = nb * 32;
        c.src = p.in[I_WDOWN] + (size_t)le * 2048 * 1024 + (size_t)(kb * 64) * 1024 + n0; c.dst = (bf16_t*)(p.ws + WS_WMOE2) + ((size_t)le * 1024 + n0) * 2048 + kb * 64; c.N = 1024; c.K = 2048; }
    return c;
}
__device__ __forceinline__ void convert_moe_slice(const Params& p, unsigned char* lds, int bid, int nblk, int l, int lo, int hi) {
    int tid_ = threadIdx.x; asm volatile("" : "+v"(tid_));
    const int tid = tid_, lane = tid & 63, wave = tid >> 6;
    float* scr = (float*)lds + wave * (64 * 33);
    const int gw = bid * 8 + wave, NGW = nblk * 8;
    constexpr int NI = 3;
    for (int it = lo + gw; it < hi; it += NGW * NI) {
        f32x4 v[NI][8]; CvtItem ci[NI];
#pragma unroll
        for (int u = 0; u < NI; ++u) { const int r = it + u * NGW; ci[u] = moe_item(p, l, r < hi ? r : it);
#pragma unroll
            for (int i = 0; i < 8; ++i) v[u][i] = __builtin_nontemporal_load((const f32x4*)(ci[u].src + (size_t)(8 * i + (lane >> 3)) * ci[u].N + (lane & 7) * 4)); }
#pragma unroll
        for (int u = 0; u < NI; ++u) { if (it + u * NGW < hi) {
#pragma unroll
            for (int i = 0; i < 8; ++i) { float* d = scr + (8 * i + (lane >> 3)) * 33 + (lane & 7) * 4; d[0] = v[u][i][0]; d[1] = v[u][i][1]; d[2] = v[u][i][2]; d[3] = v[u][i][3]; }
            __builtin_amdgcn_s_waitcnt(0xc07f); asm volatile("" ::: "memory");
            const int c = lane & 7;
#pragma unroll
            for (int j = 0; j < 4; ++j) { const int n = (lane >> 3) + 8 * j; const float* sp = scr + (8 * c) * 33 + n;
                u32x4 o; o.x = pk2(sp[0 * 33], sp[1 * 33]); o.y = pk2(sp[2 * 33], sp[3 * 33]); o.z = pk2(sp[4 * 33], sp[5 * 33]); o.w = pk2(sp[6 * 33], sp[7 * 33]);
                __builtin_nontemporal_store(o, (u32x4*)(ci[u].dst + (size_t)n * ci[u].K + 8 * c)); }
            __builtin_amdgcn_s_waitcnt(0xc07f); asm volatile("" ::: "memory"); } }
    }
    __syncthreads();
}

__device__ __forceinline__ void store_mod_bf16(bf16_t* hrow, const f32x4 (&v)[4], float rstd, const float* g, const float* sh, const float* sc, int lane) {
#pragma unroll
    for (int j = 0; j < 4; ++j) { const int c0 = 256 * j + 4 * lane; const f32x4 gv = *(const f32x4*)(g + c0), shv = *(const f32x4*)(sh + c0), scv = *(const f32x4*)(sc + c0);
        f32x4 h;
#pragma unroll
        for (int i = 0; i < 4; ++i) h[i] = (v[j][i] * rstd * gv[i]) * (1.f + scv[i]) + shv[i];
        u32x2 w; w.x = pk2(h[0], h[1]); w.y = pk2(h[2], h[3]); *(u32x2*)(hrow + c0) = w; }
}
__device__ __forceinline__ void ph_mod0(const Params& p, int row_lo, int row_hi, int wk, int nwk) {
    int tid_ = threadIdx.x; asm volatile("" : "+v"(tid_));
    const int tid = tid_, lane = tid & 63, wave = tid >> 6, gw = wk * 8 + wave, NGW = nwk * 8;
    const float* x = p.in[I_X]; const float* ctx = p.in[I_CTX]; const float* g = p.in[I_NMIX];
    const float* mod = (const float*)(p.ws + WS_MOD); const float* posr = (const float*)(p.ws + WS_POSR); const float* posc = (const float*)(p.ws + WS_POSC);
    float* X = (float*)(p.ws + WS_X); bf16_t* H = (bf16_t*)(p.ws + WS_H);
    f32x4 nx[4];
    { const int row = row_lo + gw; if (row < row_hi) { const float* src = row < NTOK ? x + (size_t)row * DM : ctx + (size_t)(row - NTOK) * DM;
#pragma unroll
        for (int j = 0; j < 4; ++j) nx[j] = *(const f32x4*)(src + 256 * j + 4 * lane); } }
    for (int row = row_lo + gw; row < row_hi; row += NGW) {
        f32x4 v[4]; float ss = 0.f; int vec;
#pragma unroll
        for (int j = 0; j < 4; ++j) v[j] = nx[j];
        { const int r2 = row + NGW; if (r2 < row_hi) { const float* src = r2 < NTOK ? x + (size_t)r2 * DM : ctx + (size_t)(r2 - NTOK) * DM;
#pragma unroll
            for (int j = 0; j < 4; ++j) nx[j] = *(const f32x4*)(src + 256 * j + 4 * lane); } }
        if (row < NTOK) { const int t = row & (SEQ - 1); vec = row >> 13; const float* pr = posr + (size_t)(t >> 6) * 512; const float* pc = posc + (size_t)(t & 63) * 512;
#pragma unroll
            for (int j = 0; j < 4; ++j) { const int c0 = 256 * j + 4 * lane; const f32x4 pv = *(const f32x4*)((j < 2 ? pr : pc) + (c0 & 511));
                v[j] = v[j] + pv; *(f32x4*)(X + (size_t)row * DM + c0) = v[j]; }
        } else vec = 2;
#pragma unroll
        for (int j = 0; j < 4; ++j) ss += (v[j][0] * v[j][0] + v[j][1] * v[j][1]) + (v[j][2] * v[j][2] + v[j][3] * v[j][3]);
        const float rstd = 1.f / sqrtf(wave_sum(ss) * (1.f / DM) + 1e-6f);
        const float* mv = mod + (size_t)(0 * 3 + vec) * NADA;
        store_mod_bf16(H + (size_t)row * DM, v, rstd, g, mv, mv + DM, lane);
    }
}

__device__ __forceinline__ void ph_gla_simple(const Params& p, unsigned char* lds, int bid, int nblk) {
    float* qs = (float*)lds; float* fs = qs + 4096; float* ks = fs + 4096; float* vs = ks + 4096; float* part = vs + 1024;
    int tid_ = threadIdx.x; asm volatile("" : "+v"(tid_));
    const int tid = tid_, lane = tid & 63, wave = tid >> 6, kk = tid >> 5, vv = tid & 31;
    const bf16_t* Q = (const bf16_t*)(p.ws + WS_Q); const bf16_t* V = (const bf16_t*)(p.ws + WS_V);
    for (int unit = bid; unit < 128; unit += nblk) {
        const int vsl = unit & 3, dir = (unit >> 2) & 1, h = (unit >> 3) & 7, b = unit >> 6;
        const float* LFp = (const float*)(p.ws + (dir ? WS_LBK : WS_LF)); float* O = (float*)(p.ws + (dir ? WS_OB : WS_OF));
        float s[8];
#pragma unroll
        for (int i = 0; i < 8; ++i) s[i] = 0.f;
        for (int bt = 0; bt < 8 + 256; ++bt) {
            const bool isctx = bt < 8; const int nb = isctx ? bt : bt - 8, nbt = isctx ? 8 : 256;
            const int t0 = dir == 0 ? nb * 32 : (nbt - 1 - nb) * 32;
            const size_t rbase = isctx ? (size_t)(NTOK + b * CTXL + t0) : (size_t)(b * SEQ + t0);
            { const int r = tid >> 4, c8 = (tid & 15) * 8; const size_t off = (rbase + r) * DM + h * 128 + c8;
                const u16x8 qv = *(const u16x8*)(Q + off); const f32x4 l0 = *(const f32x4*)(LFp + off), l1 = *(const f32x4*)(LFp + off + 4);
#pragma unroll
                for (int i = 0; i < 8; ++i) { qs[r * 128 + c8 + i] = bf2f(qv[i]); const float f = i < 4 ? l0[i] : l1[i - 4]; fs[r * 128 + c8 + i] = f; ks[r * 128 + c8 + i] = 1.f - f; }
                if (tid < 128) { const int r2 = tid >> 2, c = (tid & 3) * 8; const u16x8 vv8 = *(const u16x8*)(V + (rbase + r2) * DM + h * 128 + vsl * 32 + c);
#pragma unroll
                    for (int i = 0; i < 8; ++i) vs[r2 * 32 + c + i] = bf2f(vv8[i]); } }
            __syncthreads();
            for (int jj = 0; jj < 32; ++jj) { const int j = dir ? 31 - jj : jj; const float vj = vs[j * 32 + vv]; float po = 0.f;
#pragma unroll
                for (int i = 0; i < 8; ++i) { const float f = fs[j * 128 + kk * 8 + i], k_ = ks[j * 128 + kk * 8 + i], q_ = qs[j * 128 + kk * 8 + i]; s[i] = f * s[i] + k_ * vj; po += q_ * s[i]; }
                po += __shfl_xor(po, 32);
                if (!isctx && lane < 32) part[(j * 8 + wave) * 32 + vv] = po; }
            __syncthreads();
            if (!isctx) { const int j = tid >> 4, v2 = (tid & 15) * 2; float o0 = 0.f, o1 = 0.f;
#pragma unroll
                for (int w = 0; w < 8; ++w) { o0 += part[(j * 8 + w) * 32 + v2]; o1 += part[(j * 8 + w) * 32 + v2 + 1]; }
                *(f32x2*)(O + (rbase + j) * DM + h * 128 + vsl * 32 + v2) = (f32x2){o0, o1}; }
        }
        __syncthreads();
    }
}

__device__ __forceinline__ void ph_onorm(const Params& p, int bid, int nblk) {
    int tid_ = threadIdx.x; asm volatile("" : "+v"(tid_));
    const int tid = tid_, lane = tid & 63, wave = tid >> 6, gw = bid * 8 + wave, NGW = nblk * 8;
    const float* OF = (const float*)(p.ws + WS_OF); const float* OB = (const float*)(p.ws + WS_OB); const bf16_t* G = (const bf16_t*)(p.ws + WS_G); bf16_t* ON = (bf16_t*)(p.ws + WS_ON);
    const float* ng = p.in[I_HGNORM];
    const f32x4 gv = *(const f32x4*)(ng + 4 * (lane & 31));
    for (int row = gw; row < NTOK; row += NGW) {
#pragma unroll
        for (int j = 0; j < 4; ++j) { const size_t off = (size_t)row * DM + 256 * j + 4 * lane; const f32x4 o = *(const f32x4*)(OF + off) + *(const f32x4*)(OB + off);
            float ss = (o[0] * o[0] + o[1] * o[1]) + (o[2] * o[2] + o[3] * o[3]);
#pragma unroll
            for (int d = 1; d < 32; d <<= 1) ss += __shfl_xor(ss, d);
            const float rstd = 1.f / sqrtf(ss * (1.f / 128.f) + 1e-6f);
            const u32x2 gg = *(const u32x2*)(G + off);
            const float g0 = bf2f((unsigned short)(gg.x & 0xffffu)), g1 = bf2f((unsigned short)(gg.x >> 16)), g2 = bf2f((unsigned short)(gg.y & 0xffffu)), g3 = bf2f((unsigned short)(gg.y >> 16));
            u32x2 w; w.x = pk2(o[0] * rstd * gv[0] * g0, o[1] * rstd * gv[1] * g1); w.y = pk2(o[2] * rstd * gv[2] * g2, o[3] * rstd * gv[3] * g3);
            *(u32x2*)(ON + off) = w; }
    }
}

typedef short s16x4 __attribute__((ext_vector_type(4)));
typedef short v4i16_t __attribute__((ext_vector_type(4)));
using pg8::bf16x8;
constexpr int KT_STR = 160, KS_STR = 144, V_STR = 288;
constexpr int GL_QT = 0, GL_KT = 20480, GL_KS = 40960, GL_PL = 59392, GL_V = 68608, GL_SEG = 87040, GL_DV = 89088, GL_EM = 89600, GL_SSQ = 90112, GL_RSTD = 92160;
__device__ __forceinline__ s16x4 lds_tr(const LAS unsigned char* p) { return __builtin_bit_cast(s16x4, __builtin_amdgcn_ds_read_tr16_b64_v4i16((LAS v4i16_t*)p)); }
__device__ __forceinline__ bf16x8 cat8(s16x4 a, s16x4 b) { return __builtin_shufflevector(a, b, 0, 1, 2, 3, 4, 5, 6, 7); }
__device__ __forceinline__ bf16x8 lds_pair64(const LAS unsigned char* p, int d2) { const u32x2 a = *(const LAS u32x2*)p, b = *(const LAS u32x2*)(p + d2); u32x4 r; r.x = a.x; r.y = a.y; r.z = b.x; r.w = b.y; return __builtin_bit_cast(bf16x8, r); }

constexpr int GL_RF = 92416, GL_RQ = 125184, GL_END = 141568;
struct GlaRegs { f32x4 f[4]; u32x4 q[2]; u32x4 v[2]; };
template <bool WITHQ>
__device__ __forceinline__ void gla_load(GlaRegs& R, const float* F, const bf16_t* Q, const bf16_t* V, int rb, int h, int tid) {
    const unsigned lf = (unsigned)((tid >> 5) * DM + (tid & 31) * 4), lq = (unsigned)((tid >> 4) * DM + (tid & 15) * 8);
#pragma unroll
    for (int i = 0; i < 4; ++i) { const float* fb = F + (size_t)(rb + 16 * i) * DM + h * 128; R.f[i] = *(const f32x4*)(fb + lf); }
#pragma unroll
    for (int i = 0; i < 2; ++i) { const size_t ub = (size_t)(rb + 32 * i) * DM + h * 128;
        if (WITHQ) R.q[i] = *(const u32x4*)(Q + ub + lq); R.v[i] = *(const u32x4*)(V + ub + lq); }
}
template <bool WITHQ>
__device__ __forceinline__ void gla_put_raw(const GlaRegs& R, LAS unsigned char* lds, int dir, int tid) {
#pragma unroll
    for (int i = 0; i < 4; ++i) { const int id = tid + 512 * i, row = id >> 5, c4 = (id & 31) * 4, p = dir ? 63 - row : row; *(LAS f32x4*)(lds + GL_RF + p * 512 + c4 * 4) = R.f[i]; }
#pragma unroll
    for (int i = 0; i < 2; ++i) { const int id = tid + 512 * i, row = id >> 4, c8 = (id & 15) * 8, p = dir ? 63 - row : row;
        if (WITHQ) *(LAS u32x4*)(lds + GL_RQ + p * 256 + c8 * 2) = R.q[i]; *(LAS u32x4*)(lds + GL_V + p * V_STR + c8 * 2) = R.v[i]; }
}
template <bool G2>
__device__ __forceinline__ void gla_phase_a(LAS unsigned char* lds, int tid) {
    const int k = tid & 127, seg = tid >> 7;
    LAS float* segtot = (LAS float*)(lds + GL_SEG);
    float f[16];
#pragma unroll
    for (int i = 0; i < 16; ++i) f[i] = *(const LAS float*)(lds + GL_RF + (16 * seg + i) * 512 + k * 4);
    if (G2) {
        unsigned short q[16];
#pragma unroll
        for (int i = 0; i < 16; ++i) q[i] = *(const LAS unsigned short*)(lds + GL_RQ + (16 * seg + i) * 256 + k * 2);
        float c[16]; c[0] = f[0];
#pragma unroll
        for (int i = 1; i < 16; ++i) c[i] = c[i - 1] * f[i];
        segtot[seg * 128 + k] = c[15];
        __syncthreads();
        const float T0 = segtot[k], T1 = segtot[128 + k], T2 = segtot[256 + k], T3 = segtot[384 + k];
        const float Fs = seg == 0 ? 1.f / (T0 * T1) : (seg == 1 ? 1.f / T1 : (seg == 2 ? 1.f : T2));
        const float cK = T2 * T3;
        if (seg == 0) { ((LAS float*)(lds + GL_DV))[k] = T0 * T1 * cK; ((LAS float*)(lds + GL_EM))[k] = T0 * T1; }
        unsigned wq[8], wk[8], ws_[8];
#pragma unroll
        for (int i = 0; i < 16; i += 2) { float qp[2], kp[2], ks[2];
#pragma unroll
            for (int e = 0; e < 2; ++e) { const float eq = c[i + e] * Fs, inv = __builtin_amdgcn_rcpf(eq), kk = 1.f - f[i + e];
                qp[e] = bf2f(q[i + e]) * eq; kp[e] = kk * inv; ks[e] = kp[e] * cK; }
            wq[i >> 1] = pk2(qp[0], qp[1]); wk[i >> 1] = pk2(kp[0], kp[1]); ws_[i >> 1] = pk2(ks[0], ks[1]); }
        LAS unsigned char* dq = lds + GL_QT + k * KT_STR + seg * 32; LAS unsigned char* dk = lds + GL_KT + k * KT_STR + seg * 32; LAS unsigned char* ds = lds + GL_KS + k * KS_STR + seg * 32;
        *(LAS u32x4*)dq = (u32x4){wq[0], wq[1], wq[2], wq[3]}; *(LAS u32x4*)(dq + 16) = (u32x4){wq[4], wq[5], wq[6], wq[7]};
        *(LAS u32x4*)dk = (u32x4){wk[0], wk[1], wk[2], wk[3]}; *(LAS u32x4*)(dk + 16) = (u32x4){wk[4], wk[5], wk[6], wk[7]};
        *(LAS u32x4*)ds = (u32x4){ws_[0], ws_[1], ws_[2], ws_[3]}; *(LAS u32x4*)(ds + 16) = (u32x4){ws_[4], ws_[5], ws_[6], ws_[7]};
    } else {
        float sx[16]; sx[15] = 1.f;
#pragma unroll
        for (int i = 14; i >= 0; --i) sx[i] = sx[i + 1] * f[i + 1];
        segtot[seg * 128 + k] = sx[0] * f[0];
        __syncthreads();
        const float T0 = segtot[k], T1 = segtot[128 + k], T2 = segtot[256 + k], T3 = segtot[384 + k];
        const float later = seg == 0 ? T1 * T2 * T3 : (seg == 1 ? T2 * T3 : (seg == 2 ? T3 : 1.f));
        if (seg == 0) ((LAS float*)(lds + GL_DV))[k] = T0 * T1 * T2 * T3;
        unsigned ws_[8];
#pragma unroll
        for (int i = 0; i < 16; i += 2) ws_[i >> 1] = pk2((1.f - f[i]) * sx[i] * later, (1.f - f[i + 1]) * sx[i + 1] * later);
        LAS unsigned char* ds = lds + GL_KS + k * KS_STR + seg * 32;
        *(LAS u32x4*)ds = (u32x4){ws_[0], ws_[1], ws_[2], ws_[3]}; *(LAS u32x4*)(ds + 16) = (u32x4){ws_[4], ws_[5], ws_[6], ws_[7]};
    }
    __syncthreads();
}
__device__ __forceinline__ void gla_state_update(f32x4 (&S)[8], const bf16x8 (&Vf)[2], const LAS unsigned char* lds, int i16, int g) {
#pragma unroll
    for (int j = 0; j < 8; ++j) { const f32x4 dv = *(const LAS f32x4*)(lds + GL_DV + (16 * j + 4 * g) * 4); S[j] = S[j] * dv;
#pragma unroll
        for (int c2 = 0; c2 < 2; ++c2) { const bf16x8 a = lds_pair64(lds + GL_KS + (16 * j + i16) * KS_STR + (32 * c2 + 4 * g) * 2, 32);
            S[j] = __builtin_amdgcn_mfma_f32_16x16x32_bf16(a, Vf[c2], S[j], 0, 0, 0); }
        if (j & 1) asm volatile("" ::: "memory"); }
}
__device__ __forceinline__ void gla_load_vf(bf16x8 (&Vf)[2], const LAS unsigned char* lds, int w, int i16, int g) {
    const int q4 = i16 >> 2, pp = i16 & 3;
#pragma unroll
    for (int c2 = 0; c2 < 2; ++c2) { const LAS unsigned char* vb = lds + GL_V + (32 * c2 + 4 * g + q4) * V_STR + (16 * w + 4 * pp) * 2; Vf[c2] = cat8(lds_tr(vb), lds_tr(vb + 16 * V_STR)); }
}

__device__ __forceinline__ void ph_gla_states(const Params& p, unsigned char* lds_, int bid, int nblk) {
    int tid_ = threadIdx.x; asm volatile("" : "+v"(tid_));
    const int tid = tid_, lane = tid & 63, w = __builtin_amdgcn_readfirstlane(tid >> 6), i16 = lane & 15, g = lane >> 4;
    LAS unsigned char* lds = (LAS unsigned char*)lds_;
    const bf16_t* V = (const bf16_t*)(p.ws + WS_V);
    float* U = (float*)(p.ws + WS_U); float* DD = (float*)(p.ws + WS_DD);
    for (int ui = bid; ui < 544; ui += nblk) {
        int b, h, dir, nch, rb0, uidx;
        if (ui < 512) { b = ui >> 8; h = (ui >> 5) & 7; dir = (ui >> 4) & 1; const int sc = ui & 15; nch = 8; rb0 = b * SEQ + sc * 512; uidx = ((b * 8 + h) * 2 + dir) * 17 + sc; }
        else { const int r = ui - 512; b = r >> 4; h = (r >> 1) & 7; dir = r & 1; nch = 4; rb0 = NTOK + b * CTXL; uidx = ((b * 8 + h) * 2 + dir) * 17 + 16; }
        const float* F = (const float*)(p.ws + (dir ? WS_LBK : WS_LF));
        f32x4 S[8];
#pragma unroll
        for (int j = 0; j < 8; ++j) S[j] = (f32x4){0.f, 0.f, 0.f, 0.f};
        float dtot = 1.f;
        GlaRegs R;
        gla_load<false>(R, F, nullptr, V, rb0 + 64 * (dir ? nch - 1 : 0), h, tid);
        for (int step = 0; step < nch; ++step) {
            gla_put_raw<false>(R, lds, dir, tid);
            __syncthreads();
            if (step + 1 < nch) gla_load<false>(R, F, nullptr, V, rb0 + 64 * (dir ? nch - 2 - step : step + 1), h, tid);
            gla_phase_a<false>(lds, tid);
            if (tid < 128) dtot *= ((const LAS float*)(lds + GL_DV))[tid];
            bf16x8 Vf[2]; gla_load_vf(Vf, lds, w, i16, g);
            gla_state_update(S, Vf, lds, i16, g);
            __syncthreads();
        }
        float* up = U + (size_t)uidx * 16384 + (size_t)(w * 8) * 256 + lane * 4;
#pragma unroll
        for (int j = 0; j < 8; ++j) *(f32x4*)(up + j * 256) = S[j];
        if (tid < 128) DD[(size_t)uidx * 128 + tid] = dtot;
    }
}

__device__ __forceinline__ void ph_gla_out(const Params& p, unsigned char* lds_, int bid, int nblk) {
    int tid_ = threadIdx.x; asm volatile("" : "+v"(tid_));
    const int tid = tid_, lane = tid & 63, w = __builtin_amdgcn_readfirstlane(tid >> 6), i16 = lane & 15, g = lane >> 4, q4 = i16 >> 2, pp = i16 & 3;
    LAS unsigned char* lds = (LAS unsigned char*)lds_;
    const bf16_t* Q = (const bf16_t*)(p.ws + WS_Q); const bf16_t* V = (const bf16_t*)(p.ws + WS_V); const bf16_t* G = (const bf16_t*)(p.ws + WS_G);
    const float* U = (const float*)(p.ws + WS_U); const float* DD = (const float*)(p.ws + WS_DD);
    float* OFL = (float*)(p.ws + WS_OF); bf16_t* ON = (bf16_t*)(p.ws + WS_ON);
    const float ngv = p.in[I_HGNORM][16 * w + i16];
    const int troff = (4 * g + q4) * KT_STR + (4 * pp) * 2;
    for (int unit = bid; unit < 256; unit += nblk) {
        const int b = unit >> 7, h = (unit >> 4) & 7, sc = unit & 15, rbs = b * SEQ + sc * 512;
        const unsigned loff = (unsigned)((3 - g) * 4 * DM + i16);
#pragma unroll 1
        for (int dir = 0; dir < 2; ++dir) {
            const float* F = (const float*)(p.ws + (dir ? WS_LBK : WS_LF));
            GlaRegs R;
            gla_load<true>(R, F, Q, V, rbs + 64 * (dir ? 7 : 0), h, tid);
            const int ub = ((b * 8 + h) * 2 + dir) * 17;
            f32x4 S[8];
            { const float* up = U + (size_t)(ub + 16) * 16384 + (size_t)(w * 8) * 256 + lane * 4;
#pragma unroll
                for (int j = 0; j < 8; ++j) S[j] = *(const f32x4*)(up + j * 256); }
            { const int nf = dir ? 15 - sc : sc;
                LAS float* dl = (LAS float*)(lds + GL_QT);
                for (int i = tid; i < 16 * 128; i += NTHR) dl[i] = DD[(size_t)ub * 128 + i];
                __syncthreads();
                f32x4 Ua[8];
#define FOLD_LOAD(UU, s_) do { const int u_ = dir ? 15 - (s_) : (s_); const float* up_ = U + (size_t)(ub + u_) * 16384 + (size_t)(w * 8) * 256 + lane * 4; \
                    _Pragma("unroll") for (int j = 0; j < 8; ++j) UU[j] = *(const f32x4*)(up_ + j * 256); } while (0)
                if (nf > 0) FOLD_LOAD(Ua, 0);
                for (int s = 0; s < nf; ++s) { const int u = dir ? 15 - s : s;
#pragma unroll
                    for (int j = 0; j < 8; ++j) S[j] = S[j] * *(const LAS f32x4*)(dl + u * 128 + 16 * j + 4 * g) + Ua[j];
                    if (s + 1 < nf) FOLD_LOAD(Ua, s + 1); }
#undef FOLD_LOAD
                __syncthreads();
            }
            for (int step = 0; step < 8; ++step) {
                const int n = dir ? 7 - step : step, rb = rbs + 64 * n;
                gla_put_raw<true>(R, lds, dir, tid);
                __syncthreads();
                if (step < 7) gla_load<true>(R, F, Q, V, rbs + 64 * (dir ? 6 - step : step + 1), h, tid);
                gla_phase_a<true>(lds, tid);
                f32x4 O[4];
                if (dir) { const float* ob = OFL + ((size_t)((unit * 8 + n) * 8 + w) * 4) * 256 + ((3 - g) * 16 + i16) * 4;
#pragma unroll
                    for (int ti = 0; ti < 4; ++ti) { const f32x4 t4 = *(const f32x4*)(ob + (3 - ti) * 256); O[ti] = (f32x4){t4[3], t4[2], t4[1], t4[0]}; } }
                else {
#pragma unroll
                    for (int ti = 0; ti < 4; ++ti) O[ti] = (f32x4){0.f, 0.f, 0.f, 0.f}; }
                { const int si = w >> 1, tb = 2 * (w & 1);
                    f32x4 pa[2] = {(f32x4){0.f, 0.f, 0.f, 0.f}, (f32x4){0.f, 0.f, 0.f, 0.f}};
#pragma unroll
                    for (int c = 0; c < 4; ++c) { const LAS unsigned char* ka = lds + GL_KT + troff + (32 * c) * KT_STR + (16 * si) * 2; const bf16x8 a = cat8(lds_tr(ka), lds_tr(ka + 16 * KT_STR));
#pragma unroll
                        for (int tt = 0; tt < 2; ++tt) { const LAS unsigned char* qa = lds + GL_QT + troff + (32 * c) * KT_STR + (16 * (tb + tt)) * 2; const bf16x8 bq = cat8(lds_tr(qa), lds_tr(qa + 16 * KT_STR));
                            pa[tt] = __builtin_amdgcn_mfma_f32_16x16x32_bf16(a, bq, pa[tt], 0, 0, 0); } }
#pragma unroll
                    for (int tt = 0; tt < 2; ++tt) { const int t = 16 * (tb + tt) + i16, s0 = 16 * si + 4 * g; f32x4 v = pa[tt];
#pragma unroll
                        for (int r = 0; r < 4; ++r) v[r] = (s0 + r <= t) ? v[r] : 0.f;
                        u32x2 wv; wv.x = pk2(v[0], v[1]); wv.y = pk2(v[2], v[3]); *(LAS u32x2*)(lds + GL_PL + t * KS_STR + s0 * 2) = wv; } }
                __syncthreads();
                {
#pragma unroll
                    for (int c = 0; c < 4; ++c) { const f32x4 e0 = *(const LAS f32x4*)(lds + GL_EM + (32 * c + 4 * g) * 4), e1 = *(const LAS f32x4*)(lds + GL_EM + (32 * c + 16 + 4 * g) * 4);
                        const f32x4 a0 = S[2 * c] * e0, b0 = S[2 * c + 1] * e1; u32x4 r; r.x = pk2(a0[0], a0[1]); r.y = pk2(a0[2], a0[3]); r.z = pk2(b0[0], b0[1]); r.w = pk2(b0[2], b0[3]); const bf16x8 Sb = __builtin_bit_cast(bf16x8, r);
#pragma unroll
                        for (int ti = 0; ti < 4; ++ti) { const LAS unsigned char* qa = lds + GL_QT + troff + (32 * c) * KT_STR + (16 * ti) * 2; const bf16x8 a = cat8(lds_tr(qa), lds_tr(qa + 16 * KT_STR));
                            O[ti] = __builtin_amdgcn_mfma_f32_16x16x32_bf16(a, Sb, O[ti], 0, 0, 0); }
                        asm volatile("" ::: "memory"); } }
                bf16x8 Vf[2]; gla_load_vf(Vf, lds, w, i16, g);
#pragma unroll
                for (int ti = 0; ti < 4; ++ti) {
#pragma unroll
                    for (int c2 = 0; c2 < 2; ++c2) { const bf16x8 a = lds_pair64(lds + GL_PL + (16 * ti + i16) * KS_STR + (32 * c2 + 4 * g) * 2, 32);
                        O[ti] = __builtin_amdgcn_mfma_f32_16x16x32_bf16(a, Vf[c2], O[ti], 0, 0, 0); }
                    if (ti & 1) asm volatile("" ::: "memory"); }
                gla_state_update(S, Vf, lds, i16, g);
                if (dir == 0) {
                    float* ob = OFL + ((size_t)((unit * 8 + n) * 8 + w) * 4) * 256 + lane * 4;
#pragma unroll
                    for (int ti = 0; ti < 4; ++ti) *(f32x4*)(ob + ti * 256) = O[ti];
                    __syncthreads();
                } else {
                    float part[4][4];
#pragma unroll
                    for (int ti = 0; ti < 4; ++ti)
#pragma unroll
                        for (int r = 0; r < 4; ++r) { const float o = O[ti][r]; part[ti][r] = row16_sum(o * o); }
                    unsigned short gq[4][4];
#pragma unroll
                    for (int ti = 0; ti < 4; ++ti)
#pragma unroll
                        for (int r = 0; r < 4; ++r) { const bf16_t* gb = G + (size_t)(rb + 51 - 16 * ti - r) * DM + h * 128 + 16 * w; gq[ti][r] = gb[loff]; }
                    if (i16 == 0) {
#pragma unroll
                        for (int ti = 0; ti < 4; ++ti) *(LAS f32x4*)(lds + GL_SSQ + (w * 64 + 16 * ti + 4 * g) * 4) = (f32x4){part[ti][0], part[ti][1], part[ti][2], part[ti][3]}; }
                    __syncthreads();
                    if (tid < 64) { float s2 = 0.f;
#pragma unroll
                        for (int ww = 0; ww < 8; ++ww) s2 += ((const LAS float*)(lds + GL_SSQ))[ww * 64 + tid];
                        ((LAS float*)(lds + GL_RSTD))[tid] = 1.f / sqrtf(s2 * (1.f / 128.f) + 1e-6f); }
                    __syncthreads();
#pragma unroll
                    for (int ti = 0; ti < 4; ++ti) { const f32x4 rs = *(const LAS f32x4*)(lds + GL_RSTD + (16 * ti + 4 * g) * 4);
#pragma unroll
                        for (int r = 0; r < 4; ++r) { bf16_t* ob2 = ON + (size_t)(rb + 51 - 16 * ti - r) * DM + h * 128 + 16 * w;
                            ob2[loff] = (bf16_t)f2bf(O[ti][r] * rs[r] * ngv * bf2f(gq[ti][r])); } }
                }
            }
            asm volatile("s_waitcnt vmcnt(0)" ::: "memory");
            __syncthreads();
        }
    }
}

__device__ __forceinline__ void ph_modffn(const Params& p, unsigned char* lds, int bid, int nblk, int l) {
    int tid_ = threadIdx.x; asm volatile("" : "+v"(tid_));
    const int tid = tid_, lane = tid & 63, wave = tid >> 6;
    float* rw = (float*)lds;
    float* stg = (float*)(lds + 71680);
    const float* router = p.in[I_ROUTER] + (size_t)l * DM * NE;
    for (int i = tid; i < DM * NE / 4; i += NTHR) { const int d = i >> 2; *(f32x4*)(rw + d * 16 + (d >> 2) * 4 + (i & 3) * 4) = ((const f32x4*)router)[i]; }
    __syncthreads();
    const float* X = (const float*)(p.ws + WS_X); bf16_t* H = (bf16_t*)(p.ws + WS_H); float* aff = (float*)(p.ws + WS_AFF); int* slot = (int*)(p.ws + WS_SLOT);
    const float* g = p.in[I_NFFN] + (size_t)l * DM; const float* mod = (const float*)(p.ws + WS_MOD);
    for (int base = bid * 64; base < NTOK; base += nblk * 64) {
        const int b = base >> 13, t0 = base & (SEQ - 1);
        const float* mv = mod + (size_t)(l * 3 + b) * NADA; const float* sh = mv + 3 * DM; const float* sc = mv + 4 * DM;
        f32x4 nxv[4];
#pragma unroll
        for (int j = 0; j < 4; ++j) nxv[j] = *(const f32x4*)(X + (size_t)(base + 8 * wave) * DM + 256 * j + 4 * lane);
#pragma unroll 1
        for (int r = 0; r < 8; ++r) {
            const int row = base + 8 * wave + r;
            f32x4 v[4]; float ss = 0.f;
#pragma unroll
            for (int j = 0; j < 4; ++j) { v[j] = nxv[j]; ss += (v[j][0] * v[j][0] + v[j][1] * v[j][1]) + (v[j][2] * v[j][2] + v[j][3] * v[j][3]); }
            if (r < 7) {
#pragma unroll
                for (int j = 0; j < 4; ++j) nxv[j] = *(const f32x4*)(X + (size_t)(row + 1) * DM + 256 * j + 4 * lane); }
            const float rstd = 1.f / sqrtf(wave_sum(ss) * (1.f / DM) + 1e-6f);
            float lg[16];
#pragma unroll
            for (int e = 0; e < 16; ++e) lg[e] = 0.f;
#pragma unroll
            for (int j = 0; j < 4; ++j) { const int c0 = 256 * j + 4 * lane; const f32x4 gv = *(const f32x4*)(g + c0), shv = *(const f32x4*)(sh + c0), scv = *(const f32x4*)(sc + c0);
                f32x4 h;
#pragma unroll
                for (int i = 0; i < 4; ++i) { h[i] = (v[j][i] * rstd * gv[i]) * (1.f + scv[i]) + shv[i];
                    const float* rp = rw + (c0 + i) * 16 + (c0 >> 2) * 4; const f32x4 r0 = *(const f32x4*)(rp), r1 = *(const f32x4*)(rp + 4), r2 = *(const f32x4*)(rp + 8), r3 = *(const f32x4*)(rp + 12);
#pragma unroll
                    for (int e = 0; e < 4; ++e) { lg[e] += h[i] * r0[e]; lg[4 + e] += h[i] * r1[e]; lg[8 + e] += h[i] * r2[e]; lg[12 + e] += h[i] * r3[e]; }
                    asm volatile("" ::: "memory"); }
                u32x2 w; w.x = pk2(h[0], h[1]); w.y = pk2(h[2], h[3]); *(u32x2*)(H + (size_t)row * DM + c0) = w; }
            float a8[8], a4[4], a2[2], a1;
            { const bool hi = (lane & 32) != 0;
#pragma unroll
                for (int i = 0; i < 8; ++i) { const float send = hi ? lg[i] : lg[8 + i], keep = hi ? lg[8 + i] : lg[i]; a8[i] = keep + __shfl_xor(send, 32); } }
            { const bool hi = (lane & 16) != 0;
#pragma unroll
                for (int i = 0; i < 4; ++i) { const float send = hi ? a8[i] : a8[4 + i], keep = hi ? a8[4 + i] : a8[i]; a4[i] = keep + __shfl_xor(send, 16); } }
            { const bool hi = (lane & 8) != 0;
#pragma unroll
                for (int i = 0; i < 2; ++i) { const float send = hi ? a4[i] : a4[2 + i], keep = hi ? a4[2 + i] : a4[i]; a2[i] = keep + __shfl_xor(send, 8); } }
            { const bool hi = (lane & 4) != 0; const float send = hi ? a2[0] : a2[1], keep = hi ? a2[1] : a2[0]; a1 = keep + __shfl_xor(send, 4); }
            a1 += dpp_f<0x4E>(a1); a1 += dpp_f<0xB1>(a1);
            float mx = a1;
            mx = fmaxf(mx, __shfl_xor(mx, 4)); mx = fmaxf(mx, __shfl_xor(mx, 8)); mx = fmaxf(mx, __shfl_xor(mx, 16)); mx = fmaxf(mx, __shfl_xor(mx, 32));
            const float ex = expf(a1 - mx); float den = ex;
            den += __shfl_xor(den, 4); den += __shfl_xor(den, 8); den += __shfl_xor(den, 16); den += __shfl_xor(den, 32);
            if ((lane & 3) == 0) stg[((lane >> 2) & 15) * 64 + 8 * wave + r] = ex / den;
        }
        __syncthreads();
        { const int e = tid >> 5, tt = (tid & 31) * 2; *(f32x2*)(aff + (size_t)(b * NE + e) * SEQ + t0 + tt) = *(const f32x2*)(stg + e * 64 + tt);
            *(u32x2*)(slot + (size_t)base * NE + 2 * tid) = (u32x2){0xffffffffu, 0xffffffffu}; }
        __syncthreads();
    }
}

__device__ __forceinline__ void ph_topk(const Params& p, unsigned char* lds, int bid, int nblk) {
    int tid_ = threadIdx.x; asm volatile("" : "+v"(tid_)); const int tid = tid_, lane = tid & 63, wave = tid >> 6;
    unsigned* hist = (unsigned*)lds;
    unsigned* ctl = hist + 256;
    unsigned* wsum = ctl + 8;
    const float* aff = (const float*)(p.ws + WS_AFF); int* topi = (int*)(p.ws + WS_TOPI); float* topg = (float*)(p.ws + WS_TOPG); int* slot = (int*)(p.ws + WS_SLOT);
    for (int it = bid; it < NB * NE; it += nblk) {
        const int b = it >> 4, e = it & 15; const float* src = aff + (size_t)it * SEQ + 16 * tid;
        unsigned key[16];
#pragma unroll
        for (int j = 0; j < 4; ++j) { const f32x4 v = *(const f32x4*)(src + 4 * j); key[4 * j] = __float_as_uint(v[0]); key[4 * j + 1] = __float_as_uint(v[1]); key[4 * j + 2] = __float_as_uint(v[2]); key[4 * j + 3] = __float_as_uint(v[3]); }
        unsigned prefix = 0u;
#pragma unroll 1
        for (int bit = 30; bit >= 0; --bit) {
            const unsigned cand = prefix | (1u << bit);
            unsigned cnt = 0u;
#pragma unroll
            for (int i = 0; i < 16; ++i) cnt += (unsigned)__popcll(__ballot(key[i] >= cand));
            if (lane == 0) wsum[(bit & 1) * 8 + wave] = cnt;
            __syncthreads();
            unsigned tot = 0u;
#pragma unroll
            for (int w2 = 0; w2 < 8; ++w2) tot += wsum[(bit & 1) * 8 + w2];
            if (tot >= (unsigned)CAP) prefix = cand;
        }
        __syncthreads();
        unsigned cg = 0u, ce = 0u;
#pragma unroll
        for (int i = 0; i < 16; ++i) { cg += key[i] > prefix ? 1u : 0u; ce += key[i] == prefix ? 1u : 0u; }
        unsigned pk = cg | (ce << 16), inc = pk;
#pragma unroll
        for (int o = 1; o < 64; o <<= 1) { const unsigned t = __shfl_up(inc, o); if (lane >= o) inc += t; }
        if (lane == 63) wsum[wave] = inc;
        __syncthreads();
        unsigned base = 0u, total = 0u;
#pragma unroll
        for (int w2 = 0; w2 < 8; ++w2) { const unsigned t = wsum[w2]; if (w2 < wave) base += t; total += t; }
        const unsigned excl = base + inc - pk;
        unsigned rg = excl & 0xffffu, re = excl >> 16; const unsigned ngt = total & 0xffffu, kth = (unsigned)CAP - ngt;
#pragma unroll
        for (int i = 0; i < 16; ++i) { int s = -1;
            if (key[i] > prefix) { s = (int)rg; ++rg; }
            else if (key[i] == prefix) { if (re < kth) s = (int)(ngt + re); ++re; }
            if (s >= 0) { const int idx = 16 * tid + i, r = (e * NB + b) * CAP + s; topi[r] = b * SEQ + idx; topg[r] = __uint_as_float(key[i]); slot[(size_t)(b * SEQ + idx) * NE + e] = s; } }
        __syncthreads();
    }
}

__device__ __forceinline__ void ph_gather(const Params& p, int bid, int nblk) {
    int tid_ = threadIdx.x; asm volatile("" : "+v"(tid_));
    const int tid = tid_, lane = tid & 63, wave = tid >> 6, gw = bid * 8 + wave, NGW = nblk * 8;
    const bf16_t* H = (const bf16_t*)(p.ws + WS_H); bf16_t* XG = (bf16_t*)(p.ws + WS_XG); const int* topi = (const int*)(p.ws + WS_TOPI);
    for (int r = gw; r < NSLOT; r += NGW) { const int src = topi[r];
        const u32x4* s = (const u32x4*)(H + (size_t)src * DM); u32x4* d = (u32x4*)(XG + (size_t)r * DM);
        d[lane] = s[lane]; d[64 + lane] = s[64 + lane]; }
}

__device__ __forceinline__ void ph_combine(const Params& p, int bid, int nblk, int l, bool final_) {
    int tid_ = threadIdx.x; asm volatile("" : "+v"(tid_));
    const int tid = tid_, lane = tid & 63, wave = tid >> 6, gw = bid * 8 + wave, NGW = nblk * 8;
    float* X = (float*)(p.ws + WS_X); bf16_t* H = (bf16_t*)(p.ws + WS_H); const bf16_t* Y = (const bf16_t*)(p.ws + WS_Y); const int* slot = (const int*)(p.ws + WS_SLOT);
    const float* mod = (const float*)(p.ws + WS_MOD);
    int nslot = -1; f32x4 nxv[4];
    if (gw < NTOK) { nslot = lane < 16 ? slot[(size_t)gw * NE + lane] : -1;
#pragma unroll
        for (int j = 0; j < 4; ++j) nxv[j] = *(const f32x4*)(X + (size_t)gw * DM + 256 * j + 4 * lane); }
    for (int row = gw; row < NTOK; row += NGW) {
        const int b = row >> 13;
        const float* g2 = mod + (size_t)(l * 3 + b) * NADA + 5 * DM;
        const int myslot = nslot; f32x4 xv[4];
#pragma unroll
        for (int j = 0; j < 4; ++j) xv[j] = nxv[j];
        unsigned long long m = __ballot(myslot >= 0) & 0xffffull;
        f32x4 a[4];
#pragma unroll
        for (int j = 0; j < 4; ++j) a[j] = (f32x4){0.f, 0.f, 0.f, 0.f};
        u32x2 ya[4], yb[4];
#define YLOAD(dst, e_) do { const int s_ = __shfl(myslot, (e_)); const bf16_t* yr_ = Y + (size_t)(((e_) * NB + b) * CAP + s_) * DM; \
            _Pragma("unroll") for (int j = 0; j < 4; ++j) dst[j] = *(const u32x2*)(yr_ + 256 * j + 4 * lane); } while (0)
        if (m) { const int e0 = __builtin_ctzll(m); m &= m - 1; YLOAD(ya, e0); }
        const bool any = __ballot(myslot >= 0) & 0xffffull;
        { const int r2 = row + NGW; if (r2 < NTOK) { nslot = lane < 16 ? slot[(size_t)r2 * NE + lane] : -1;
#pragma unroll
            for (int j = 0; j < 4; ++j) nxv[j] = *(const f32x4*)(X + (size_t)r2 * DM + 256 * j + 4 * lane); } }
        if (any) for (;;) {
            const bool more = m != 0ull;
            if (more) { const int e1 = __builtin_ctzll(m); m &= m - 1; YLOAD(yb, e1); }
#pragma unroll
            for (int j = 0; j < 4; ++j) { a[j][0] += __uint_as_float(ya[j].x << 16); a[j][1] += __uint_as_float(ya[j].x & 0xffff0000u); a[j][2] += __uint_as_float(ya[j].y << 16); a[j][3] += __uint_as_float(ya[j].y & 0xffff0000u); }
            if (!more) break;
#pragma unroll
            for (int j = 0; j < 4; ++j) ya[j] = yb[j];
        }
#undef YLOAD
        f32x4 v[4]; float ss = 0.f;
#pragma unroll
        for (int j = 0; j < 4; ++j) { const int c0 = 256 * j + 4 * lane; v[j] = xv[j] + *(const f32x4*)(g2 + c0) * a[j];
            ss += (v[j][0] * v[j][0] + v[j][1] * v[j][1]) + (v[j][2] * v[j][2] + v[j][3] * v[j][3]); }
        const float rstd = 1.f / sqrtf(wave_sum(ss) * (1.f / DM) + 1e-6f);
        if (final_) { const float* gf = p.in[I_NFIN];
#pragma unroll
            for (int j = 0; j < 4; ++j) { const int c0 = 256 * j + 4 * lane; const f32x4 gv = *(const f32x4*)(gf + c0); *(f32x4*)(p.out + (size_t)row * DM + c0) = v[j] * rstd * gv; }
        } else {
#pragma unroll
            for (int j = 0; j < 4; ++j) *(f32x4*)(X + (size_t)row * DM + 256 * j + 4 * lane) = v[j];
            const float* mv = mod + (size_t)((l + 1) * 3 + b) * NADA;
            store_mod_bf16(H + (size_t)row * DM, v, rstd, p.in[I_NMIX] + (size_t)(l + 1) * DM, mv, mv + DM, lane);
        }
    }
}

__device__ __forceinline__ void ph_conv(const Params& p, int bid, int nblk) {
    int tid_ = threadIdx.x; asm volatile("" : "+v"(tid_));
    const int tid = tid_, lane = tid & 63, wave = tid >> 6, gw = bid * 8 + wave, NGW = nblk * 8;
    const bf16_t* BG = (const bf16_t*)(p.ws + WS_BG); const bf16_t* CU = (const bf16_t*)(p.ws + WS_CU); bf16_t* Z = (bf16_t*)(p.ws + WS_Z);
    const float* wc = p.in[I_SCCONV];
    for (int row = gw; row < NTOK; row += NGW) { const int t = row & (SEQ - 1);
#pragma unroll
        for (int hh = 0; hh < 2; ++hh) { const int c0 = hh * 512 + 8 * lane; const size_t off = (size_t)row * DM + c0;
            const u16x8 z0 = {0, 0, 0, 0, 0, 0, 0, 0};
            const u16x8 um = t > 0 ? *(const u16x8*)(CU + off - DM) : z0, u0 = *(const u16x8*)(CU + off), up = t < SEQ - 1 ? *(const u16x8*)(CU + off + DM) : z0, bg = *(const u16x8*)(BG + off);
            float o[8];
#pragma unroll
            for (int i = 0; i < 8; ++i) o[i] = bf2f(bg[i]) * (wc[c0 + i] * bf2f(um[i]) + wc[DM + c0 + i] * bf2f(u0[i]) + wc[2 * DM + c0 + i] * bf2f(up[i]));
            u32x4 w; w.x = pk2(o[0], o[1]); w.y = pk2(o[2], o[3]); w.z = pk2(o[4], o[5]); w.w = pk2(o[6], o[7]); *(u32x4*)(Z + off) = w; }
    }
}

#define XB_TMO      128
#define XB_XCNT(j)  (256  + 64 * (j))
#define XB_XSUB(j)  (1280 + 64 * (j))
#define XB_XGEN(j)  (2304 + 64 * (j))
#define XB_TOP      3328
#define XB_TOPGEN   3392
#define XCD_BAR_WORDS 3456
#define XB_SPIN_CAP (1u << 18)
__device__ __forceinline__ unsigned xb_ld(unsigned* p)              { return __hip_atomic_load(p, __ATOMIC_RELAXED, __HIP_MEMORY_SCOPE_AGENT); }
__device__ __forceinline__ unsigned xb_add(unsigned* p, unsigned v) { return __hip_atomic_fetch_add(p, v, __ATOMIC_RELAXED, __HIP_MEMORY_SCOPE_AGENT); }
__device__ __forceinline__ unsigned xb_xcc_id() { return (unsigned)__builtin_amdgcn_s_getreg((3 << 11) | 20) & 0xFu; }
#define XB_SPIN(cond, bar) do { unsigned _sp = 0; while (cond) { __builtin_amdgcn_s_sleep(1); \
    if ((++_sp & 255u) == 0u) { if (xb_ld(&(bar)[XB_TMO])) break; if (_sp > XB_SPIN_CAP) { atomicAdd(&(bar)[XB_TMO], 1u); break; } } } } while (0)
struct XcdBarrier { unsigned* bar; unsigned x; volatile LAS unsigned* st; };
__device__ __forceinline__ XcdBarrier xcd_barrier_post(unsigned* bar, volatile LAS unsigned* st) {
    XcdBarrier b; b.bar = bar; b.x = xb_xcc_id(); b.st = st;
    if (threadIdx.x == 0) (void)xb_add(&bar[XB_XCNT(b.x)], 1u);
    return b;
}
__device__ __forceinline__ void xcd_barrier_complete(unsigned* bar, unsigned x, unsigned& nloc, unsigned& nx) {
    const unsigned G = gridDim.x * gridDim.y * gridDim.z;
    unsigned sum, cnt, mine, sp = 0u;
    for (;;) {
        sum = 0u; cnt = 0u; mine = 0u;
#pragma unroll
        for (unsigned j = 0; j < 16; ++j) { const unsigned c = xb_ld(&bar[XB_XCNT(j)]); sum += c; cnt += (c > 0u) ? 1u : 0u; mine = (j == x) ? c : mine; }
        if (sum == G) break;
        __builtin_amdgcn_s_sleep(1);
        if ((++sp & 255u) == 0u) { if (xb_ld(&bar[XB_TMO])) break; if (sp > XB_SPIN_CAP) { atomicAdd(&bar[XB_TMO], 1u); break; } }
    }
    nloc = mine > 0u ? mine : 1u; nx = cnt > 0u ? cnt : 1u;
}
__device__ __forceinline__ void xcd_barrier(unsigned* bar_, volatile LAS unsigned* st_) {
    XcdBarrier b; b.bar = bar_; b.x = xb_xcc_id(); b.st = st_;
    asm volatile("s_waitcnt vmcnt(0)" ::: "memory");
    __syncthreads();
    if (threadIdx.x == 0) {
        unsigned* bar = b.bar;
        __builtin_amdgcn_s_waitcnt(0);
        unsigned nloc = b.st[0], nx = b.st[1];
        if (nloc == 0u) { xcd_barrier_complete(bar, b.x, nloc, nx); b.st[0] = nloc; b.st[1] = nx; }
        const unsigned epoch = b.st[2] + 1u; b.st[2] = epoch;
        const unsigned old = xb_add(&bar[XB_XSUB(b.x)], 1u);
        if (old + 1u == epoch * nloc) {
            __builtin_amdgcn_fence(__ATOMIC_RELEASE, "agent");
            asm volatile("s_waitcnt vmcnt(0)" ::: "memory");
            (void)xb_add(&bar[XB_TOP], 1u);
        }
        XB_SPIN(xb_ld(&bar[XB_TOP]) < epoch * nx, bar);
        __builtin_amdgcn_fence(__ATOMIC_ACQUIRE, "agent");
        asm volatile("s_waitcnt vmcnt(0)" ::: "memory");
    }
    __syncthreads();
}

constexpr int NPHASE = 19;
constexpr int CV_A1 = 232 * 32, CV_A2 = CV_A1 + 224 * 24, CV_A3 = CV_A2 + 224 * 24, CV_B1 = 224 * 24, CV_ALL = 49152;
constexpr int MISC_OFF = 146944;
constexpr int CW_BAR = 4096;
constexpr int CW_CTX = 1024;
template <int LO, int HI> __global__ void __launch_bounds__(NTHR, 2) mega(Params p) {
    extern __shared__ __attribute__((aligned(16))) unsigned char lds[];
    const int bid = blockIdx.x, nblk = gridDim.x;
    PG8_LAS unsigned char* l3 = (PG8_LAS unsigned char*)lds;
    unsigned char* ws = p.ws;
    const float* mod = (const float*)(ws + WS_MOD);
    constexpr bool MULTI = (HI - LO) > 1;
    if (MULTI) {
        volatile LAS unsigned* MISC = (volatile LAS unsigned*)(l3 + MISC_OFF);
        if (threadIdx.x < 32) MISC[threadIdx.x] = 0u;
        __syncthreads();
        (void)xcd_barrier_post((unsigned*)(ws + WS_CTL) + CW_BAR, MISC + 8);
    }
#define IN(k) (LO <= (k) && (k) < HI)
#ifndef PROBE_DUP
#define PROBE_DUP 0u
#endif
#define DUPQ(k) (((PROBE_DUP) >> (k)) & 1u)
#define BARRIER_NOW() xcd_barrier((unsigned*)(p.ws + WS_CTL) + CW_BAR, (volatile LAS unsigned*)(l3 + MISC_OFF) + 8)
#define SEAM(k) do { if (IN(k) && IN((k) + 1)) xcd_barrier((unsigned*)(p.ws + WS_CTL) + CW_BAR, (volatile LAS unsigned*)(l3 + MISC_OFF) + 8); } while (0)
#define PHASE(k, ...) do { if (IN(k)) { __VA_ARGS__; if (DUPQ(k)) { BARRIER_NOW(); __VA_ARGS__; } } SEAM(k); } while (0)
#define GEMM_INPROJ() do { pg8::Gemm g{(const bf16_t*)(ws + WS_H), (const bf16_t*)(ws + WS_WHGIN), NTOK, 5120, DM}; pg8::StaticOrder S; S.init(NTOK, 5120, nblk, bid, 0); EpiInProj E{ws}; pg8::gemm_phase<EpiInProj, pg8::StaticOrder, false>(l3, g, S, E, nullptr); } while (0)
#define GEMM_OUT(AOFF, WOFF, GATE) do { pg8::Gemm g{(const bf16_t*)(ws + (AOFF)), (const bf16_t*)(ws + (WOFF)), NTOK, DM, DM}; pg8::StaticOrder S; S.init(NTOK, DM, nblk, bid, 0); EpiResid E{(float*)(ws + WS_X), (GATE)}; pg8::gemm_phase<EpiResid, pg8::StaticOrder, false>(l3, g, S, E, nullptr); } while (0)
#define GEMM_MOE1(l) do { pg8::Gemm g{(const bf16_t*)(ws + WS_H), (const bf16_t*)(ws + WS_WMOE1) + (size_t)(l) * NE * 4096 * DM, NSLOT, 4096, DM}; pg8::StaticOrder S; S.init(NSLOT, 4096, nblk, bid, 8); EpiGLU E{(bf16_t*)(ws + WS_ACT)}; pg8::gemm_phase<EpiGLU, pg8::StaticOrder, true>(l3, g, S, E, (const int*)(ws + WS_TOPI)); } while (0)
#define GEMM_MOE2(l) do { pg8::Gemm g{(const bf16_t*)(ws + WS_ACT), (const bf16_t*)(ws + WS_WMOE2) + (size_t)(l) * NE * DM * DE, NSLOT, DM, DE}; pg8::StaticOrder S; S.init(NSLOT, DM, nblk, bid, 8); EpiRowScale E{(bf16_t*)(ws + WS_Y), (const float*)(ws + WS_TOPG)}; pg8::gemm_phase<EpiRowScale, pg8::StaticOrder, false>(l3, g, S, E, nullptr); } while (0)
#define GEMM_CONVIN() do { pg8::Gemm g{(const bf16_t*)(ws + WS_H), (const bf16_t*)(ws + WS_WSCIN), NTOK, 3072, DM}; pg8::StaticOrder S; S.init(NTOK, 3072, nblk, bid, 0); EpiConvIn E{(bf16_t*)(ws + WS_BG), (bf16_t*)(ws + WS_CU)}; pg8::gemm_phase<EpiConvIn, pg8::StaticOrder, false>(l3, g, S, E, nullptr); } while (0)
#define MOD0_PHASE() do { if (nblk >= 48) { if (bid < 24) { ph_mod0(p, NTOK + (bid * NCTX) / 24, NTOK + ((bid + 1) * NCTX) / 24, 0, 1); \
              \
            asm volatile("s_waitcnt vmcnt(0)" ::: "memory"); __syncthreads(); \
            if (threadIdx.x == 0) { unsigned* cnt = (unsigned*)(p.ws + WS_CTL) + CW_CTX; __builtin_amdgcn_fence(__ATOMIC_RELEASE, "agent"); asm volatile("s_waitcnt vmcnt(0)" ::: "memory"); \
                xb_add(cnt, 1u); unsigned sp_ = 0u; while (xb_ld(cnt) < 24u) { __builtin_amdgcn_s_sleep(1); if (++sp_ > (1u << 22)) break; } \
                __builtin_amdgcn_fence(__ATOMIC_ACQUIRE, "agent"); asm volatile("s_waitcnt vmcnt(0)" ::: "memory"); } \
            __syncthreads(); \
            pg8::Gemm g{(const bf16_t*)(ws + WS_H), (const bf16_t*)(ws + WS_WHGIN), NROW, 5120, DM}; pg8::OneUnit S{64 + bid / 12, 4 + bid % 12}; EpiInProj E{ws}; pg8::gemm_phase<EpiInProj, pg8::OneUnit, false>(l3, g, S, E, nullptr); } \
          else { ph_mod0(p, 0, NTOK, bid - 24, nblk - 24); if (nblk > 64) { __syncthreads(); convert_moe_slice(p, lds, bid - 24, nblk - 24, 0, 0, CV_A1); } } } \
        else { ph_mod0(p, 0, NROW, bid, nblk); } } while (0)
#define CTX_TILES_FALLBACK() do { if (nblk < 48) { BARRIER_NOW(); pg8::Gemm g{(const bf16_t*)(ws + WS_H), (const bf16_t*)(ws + WS_WHGIN), NROW, 5120, DM}; \
        for (int ti = bid; ti < 24; ti += nblk) { pg8::OneUnit S{64 + ti / 12, 4 + ti % 12}; EpiInProj E{ws}; pg8::gemm_phase<EpiInProj, pg8::OneUnit, false>(l3, g, S, E, nullptr); } } } while (0)
    PHASE(0, ph_prep(p, lds, bid, nblk); __syncthreads(); ph_convert_small(p, lds, bid, nblk));
    if (IN(1)) { MOD0_PHASE(); CTX_TILES_FALLBACK(); }
    SEAM(1);
#define HOSTED(GEMM_RANGE, NR, LAYER, ILO, IHI) do { const bool odd_ = (bid & 1) != 0; \
        if (odd_) convert_moe_slice(p, lds, bid, nblk, LAYER, ILO, IHI); \
        GEMM_RANGE(0, NR); __syncthreads(); \
        if (!odd_) convert_moe_slice(p, lds, bid, nblk, LAYER, ILO, IHI); } while (0)
#define GEMM_INPROJ_R(LO_, HI_) do { pg8::Gemm g{(const bf16_t*)(ws + WS_H), (const bf16_t*)(ws + WS_WHGIN), NTOK, 5120, DM}; pg8::RangeOrder S; S.S.init(NTOK, 5120, nblk, bid, 0); S.lo = (LO_); S.hi = (HI_); EpiInProj E{ws}; pg8::gemm_phase<EpiInProj, pg8::RangeOrder, false>(l3, g, S, E, nullptr); } while (0)
#define GEMM_MOE1_R0(LO_, HI_) do { pg8::Gemm g{(const bf16_t*)(ws + WS_H), (const bf16_t*)(ws + WS_WMOE1), NSLOT, 4096, DM}; pg8::RangeOrder S; S.S.init(NSLOT, 4096, nblk, bid, 8); S.lo = (LO_); S.hi = (HI_); EpiGLU E{(bf16_t*)(ws + WS_ACT)}; pg8::gemm_phase<EpiGLU, pg8::RangeOrder, true>(l3, g, S, E, (const int*)(ws + WS_TOPI)); } while (0)
    PHASE(2, HOSTED(GEMM_INPROJ_R, 5, 0, (nblk > 64 ? CV_A3 : 0), CV_ALL));
    PHASE(3, ph_gla_states(p, lds, bid, nblk); if (nblk > 64 && bid >= 32) { __syncthreads(); convert_moe_slice(p, lds, bid - 32, nblk - 32, 0, CV_A1, CV_A2); });
    PHASE(4, ph_gla_out(p, lds, bid, nblk));
    if (IN(5)) GEMM_OUT(WS_ON, WS_WHGOUT, mod + 2 * DM);
    SEAM(5);
    PHASE(6, ph_modffn(p, lds, bid, nblk, 0));
    PHASE(7, if (nblk > 64 && bid >= 32) convert_moe_slice(p, lds, bid - 32, nblk - 32, 0, CV_A2, CV_A3); else ph_topk(p, lds, bid, nblk));
    PHASE(8, HOSTED(GEMM_MOE1_R0, 8, 1, (nblk > 64 ? CV_B1 : 0), CV_ALL));
    PHASE(9, GEMM_MOE2(0));
    if (IN(10)) ph_combine(p, bid, nblk, 0, false);
    SEAM(10);
    PHASE(11, GEMM_CONVIN());
    PHASE(12, ph_conv(p, bid, nblk));
    if (IN(13)) GEMM_OUT(WS_Z, WS_WSCOUT, mod + (size_t)3 * NADA + 2 * DM);
    SEAM(13);
    PHASE(14, ph_modffn(p, lds, bid, nblk, 1));
    PHASE(15, if (nblk > 64 && bid >= 32) convert_moe_slice(p, lds, bid - 32, nblk - 32, 1, 0, CV_B1); else ph_topk(p, lds, bid, nblk));
    PHASE(16, GEMM_MOE1(1));
    PHASE(17, GEMM_MOE2(1));
    if (IN(18)) ph_combine(p, bid, nblk, 1, true);
#undef IN
#undef SEAM
}

#ifndef MK_SPLIT
#define MK_SPLIT 0
#endif
#if MK_SPLIT
#include <utility>
template <int... I> static void launch_all(std::integer_sequence<int, I...>, int grid, Params& p, hipStream_t stream) {
    ((void)hipFuncSetAttribute((const void*)mega<I, I + 1>, hipFuncAttributeMaxDynamicSharedMemorySize, LDS_BYTES), ...);
    ((mega<I, I + 1><<<dim3(grid), dim3(NTHR), LDS_BYTES, stream>>>(p)), ...); }
#endif
extern "C" void kernel_launch(void* const* d_in, const int* in_sizes, int n_in, void* d_out, int out_size, void* d_ws, size_t ws_size, hipStream_t stream) {
    static int grid = 0;
    if (grid == 0) {
        if (n_in != 20 || ws_size < WS_END) { fprintf(stderr, "kernel_launch: unexpected inputs (n_in %d, ws %zu, need %zu)\n", n_in, ws_size, (size_t)WS_END); grid = -1; return; }
        int dev = 0, cus = 0, per_cu = 0;
        (void)hipGetDevice(&dev); (void)hipDeviceGetAttribute(&cus, hipDeviceAttributeMultiprocessorCount, dev);
        (void)hipFuncSetAttribute((const void*)mega<0, NPHASE>, hipFuncAttributeMaxDynamicSharedMemorySize, LDS_BYTES);
        if (hipOccupancyMaxActiveBlocksPerMultiprocessor(&per_cu, (const void*)mega<0, NPHASE>, NTHR, LDS_BYTES) != hipSuccess || per_cu < 1) { fprintf(stderr, "kernel_launch: occupancy query failed (%d)\n", per_cu); per_cu = 1; }
        (void)hipGetLastError();
        if (per_cu > 1) per_cu = 1;
        grid = (cus > 0 ? cus : 256) * per_cu;
    }
    if (grid < 0) return;
    Params p{};
    for (int i = 0; i < 20; ++i) p.in[i] = (const float*)d_in[i];
    p.out = (float*)d_out; p.ws = (unsigned char*)d_ws;
#if MK_SPLIT
    launch_all(std::make_integer_sequence<int, NPHASE>{}, grid, p, stream);
#else
    (void)hipMemsetAsync((char*)d_ws + WS_CTL, 0, 65536, stream);
    void* args[] = {&p};
    hipError_t e = hipLaunchCooperativeKernel((const void*)mega<0, NPHASE>, dim3(grid), dim3(NTHR), args, LDS_BYTES, stream);
    if (e != hipSuccess) fprintf(stderr, "kernel_launch: cooperative launch failed: %s (grid %d)\n", hipGetErrorString(e), grid);
#endif
}
```

```cpp
#include <hip/hip_runtime.h>
#include <cstdio>
#include <cstdint>

namespace pg8 {
#define PG8_LAS __attribute__((address_space(3)))
typedef unsigned short bf16_t;
typedef short bf16x8 __attribute__((ext_vector_type(8)));
typedef float f32x4 __attribute__((ext_vector_type(4)));
typedef unsigned u32x4 __attribute__((ext_vector_type(4)));
typedef unsigned u32x2 __attribute__((ext_vector_type(2)));
constexpr int BM = 256, BK = 64, HALF = 128, HTB = HALF * BK * 2, STAGE_BYTES = 8 * HTB, NXCD = 8, WGM = 8;

__host__ __device__ __forceinline__ int lds_byte(int r, int c) { const int st = (r >> 4) * 2 + (c >> 5), rr = r & 15, cc = c & 31, ob = rr * 64 + cc * 2; return st * 1024 + (ob ^ (((ob >> 9) & 1) << 5)); }
__host__ __device__ __forceinline__ void stage_rc(int b, int& R, int& C) { const int st = b / 1024, sb = b % 1024, swz = sb ^ (((sb >> 9) & 1) << 5); R = (st >> 1) * 16 + swz / 64; C = (st & 1) * 32 + (swz % 64) / 2; }
__host__ __device__ __forceinline__ int perm32(int rho) { const int n = rho >> 4, i = rho & 15; return 8 * (i >> 2) + 4 * n + (i & 3); }

struct Unit { int pm, pn, pb; };
struct Gemm { const bf16_t* A; const bf16_t* Bt; int M, N, K; };

struct StaticOrder {
    int nM, nN, nwg, G, c, mpe;
    __device__ void init(int M, int N, int G_, int c_, int mpe_) { nM = M / BM; nN = N / BM; nwg = nM * nN; G = G_; c = c_; mpe = mpe_; }
    __device__ bool next(int i, Unit& u) const {
        const long L = (long)i * G + c; if (L >= nwg) return false;
        int wgid = (int)L; { const int q = nwg / NXCD, r = nwg % NXCD, xcd = wgid % NXCD, off = wgid / NXCD; wgid = (xcd < r ? xcd * (q + 1) : r * (q + 1) + (xcd - r) * q) + off; }
        const int nig = WGM * nN, gid = wgid / nig, fm = gid * WGM, gsz = (nM - fm) < WGM ? (nM - fm) : WGM;
        u.pm = fm + ((wgid % nig) % gsz); u.pn = (wgid % nig) / gsz; u.pb = mpe > 0 ? (u.pm / mpe) * nN + u.pn : u.pn; return true;
    }
};

__device__ __forceinline__ unsigned cvt_pk_bf16(float lo, float hi) { unsigned r; asm volatile("v_cvt_pk_bf16_f32 %0, %1, %2" : "=v"(r) : "v"(lo), "v"(hi)); return r; }

struct RangeOrder {
    StaticOrder S; int lo, hi;
    __device__ bool next(int i, Unit& u) const { return (lo + i < hi) ? S.next(lo + i, u) : false; }
};
struct OneUnit {
    int pm, pn;
    __device__ bool next(int i, Unit& u) const { if (i != 0) return false; u.pm = pm; u.pn = pn; u.pb = pn; return true; }
};
template <class Epi, class Sched, bool GATHER>
__device__ __forceinline__ void gemm_phase(PG8_LAS unsigned char* lds, const Gemm g, const Sched& S, const Epi& E, const int* gidx) {
    int tid_ = threadIdx.x; asm volatile("" : "+v"(tid_));
    const int tid = tid_, wid = __builtin_amdgcn_readfirstlane(tid >> 6), lane = tid & 63, wr = wid >> 2, wc = wid & 3, fr = lane & 15, fq = lane >> 4;
    const int K = g.K, nt = K / BK;
    unsigned voffA[2], voffB[2]; int rA[2], cA2[2];
#pragma unroll
    for (int i = 0; i < 2; ++i) { int R, C; stage_rc(tid * 16 + i * 8192, R, C); const int Rb = Epi::PERM ? ((R & ~31) + perm32(R & 31)) : R;
        voffA[i] = (unsigned)(R * K + C) * 2u; voffB[i] = (unsigned)(Rb * K + C) * 2u; rA[i] = R; cA2[i] = C * 2; }
    unsigned gcur[2][2], gnxt[2][2];
#define PG8_GOFF(dst, u) do { _Pragma("unroll") for (int _h = 0; _h < 2; ++_h) _Pragma("unroll") for (int _i = 0; _i < 2; ++_i) \
        dst[_h][_i] = (unsigned)gidx[(u).pm * BM + _h * HALF + rA[_i]] * (unsigned)(K * 2) + (unsigned)cA2[_i]; } while (0)
    const size_t kstep = (size_t)(BK * 2);
    const size_t hstep = (size_t)HALF * K * 2;
    const size_t tstep = 2 * hstep;
    const unsigned ldsw = (unsigned)wid * 1024u;
    const int aoff = lds_byte(wr * 64 + fr, fq * 8), boff = lds_byte(wc * 32 + fr, fq * 8);
#define PG8_SA(b, h) (((b) * 2 + (h)) * HTB)
#define PG8_SB(b, h) ((4 + (b) * 2 + (h)) * HTB)
#define PG8_STAGE(bufoff, gbase, voff) do { _Pragma("unroll") for (int _i = 0; _i < 2; ++_i) \
        __builtin_amdgcn_global_load_lds((const unsigned*)((const char*)(gbase) + (voff)[_i]), (PG8_LAS unsigned*)(lds + (bufoff) + ldsw + _i * 8192), 16, 0, 0); } while (0)
#define PG8_STAGE_A(bufoff, half, kb, NX) do { _Pragma("unroll") for (int _i = 0; _i < 2; ++_i) { \
        const char* _src = GATHER ? (const char*)g.A + (kb) + ((NX) ? gnxt[half][_i] : gcur[half][_i]) : ((NX) ? nA : cA) + (size_t)(half) * hstep + (kb) + voffA[_i]; \
        __builtin_amdgcn_global_load_lds((const unsigned*)_src, (PG8_LAS unsigned*)(lds + (bufoff) + ldsw + _i * 8192), 16, 0, 0); } } while (0)
#define PG8_LDA(dst, b, h) do { _Pragma("unroll") for (int m = 0; m < 4; ++m) _Pragma("unroll") for (int k = 0; k < 2; ++k) dst[m][k] = *(const PG8_LAS bf16x8*)(lds + PG8_SA(b, h) + aoff + m * 2048 + k * 1024); } while (0)
#define PG8_LDB(dst, b, h) do { _Pragma("unroll") for (int n = 0; n < 2; ++n) _Pragma("unroll") for (int k = 0; k < 2; ++k) dst[n][k] = *(const PG8_LAS bf16x8*)(lds + PG8_SB(b, h) + boff + n * 2048 + k * 1024); } while (0)
#define PG8_MMA(ai, bj, At, Bt) do { __builtin_amdgcn_s_setprio(1); _Pragma("unroll") for (int m = 0; m < 4; ++m) _Pragma("unroll") for (int n = 0; n < 2; ++n) _Pragma("unroll") for (int k = 0; k < 2; ++k) \
        acc[ai][bj][m][n] = __builtin_amdgcn_mfma_f32_16x16x32_bf16(Bt[n][k], At[m][k], acc[ai][bj][m][n], 0, 0, 0); __builtin_amdgcn_s_setprio(0); } while (0)
#define PG8_WAIT_V(n) asm volatile("s_waitcnt vmcnt(" #n ")" ::: "memory")
#define PG8_WAIT_L(n) asm volatile("s_waitcnt lgkmcnt(" #n ")" ::: "memory")
#define PG8_BAR __builtin_amdgcn_s_barrier()
#define PG8_SCHED __builtin_amdgcn_sched_barrier(0)
    Unit cur, nxt; int ui = 0;
    if (!S.next(0, cur)) return;
    f32x4 acc[2][2][4][2];
#pragma unroll
    for (int a = 0; a < 2; ++a)
#pragma unroll
        for (int b = 0; b < 2; ++b)
#pragma unroll
            for (int m = 0; m < 4; ++m)
#pragma unroll
                for (int n = 0; n < 2; ++n) acc[a][b][m][n] = (f32x4){0.f, 0.f, 0.f, 0.f};
    bf16x8 At[4][2], B0[2][2], B1[2][2];
    const char* cA = GATHER ? (const char*)g.A : (const char*)g.A + (size_t)cur.pm * tstep; const char* cB = (const char*)g.Bt + (size_t)cur.pb * tstep; const char* nA = cA;
    if (GATHER) { PG8_GOFF(gcur, cur); }
    PG8_STAGE(PG8_SB(0, 0), cB, voffB); PG8_STAGE(PG8_SB(0, 1), cB + hstep, voffB); PG8_STAGE_A(PG8_SA(0, 0), 0, 0, false); PG8_STAGE_A(PG8_SA(0, 1), 1, 0, false);
    if (wr == 1) PG8_BAR;
    PG8_WAIT_V(2); PG8_BAR;
    PG8_STAGE(PG8_SB(1, 0), cB + kstep, voffB); PG8_STAGE_A(PG8_SA(1, 0), 0, kstep, false); PG8_STAGE(PG8_SB(1, 1), cB + hstep + kstep, voffB);
    PG8_WAIT_V(6); PG8_BAR;
    for (;;) {
        const bool has_next = S.next(ui + 1, nxt);
        nA = GATHER ? cA : (has_next ? (const char*)g.A + (size_t)nxt.pm * tstep : cA); const char* nB = has_next ? (const char*)g.Bt + (size_t)nxt.pb * tstep : cB;
        if (GATHER) { if (has_next) { PG8_GOFF(gnxt, nxt); } else {
#pragma unroll
            for (int _h = 0; _h < 2; ++_h)
#pragma unroll
                for (int _i = 0; _i < 2; ++_i) gnxt[_h][_i] = gcur[_h][_i]; } }
        for (int t = 0; t < nt; t += 2) {
            const bool last = (t == nt - 2);
            const size_t k1 = (size_t)(t + 1) * kstep, k2 = last ? 0 : (size_t)(t + 2) * kstep, k3 = k2 + kstep;
            const char* b2 = last ? nB : cB + (size_t)(t + 2) * kstep; const char* b3 = b2 + kstep;
            PG8_LDB(B0, 0, 0); PG8_LDB(B1, 0, 1); PG8_SCHED; PG8_LDA(At, 0, 0); PG8_STAGE_A(PG8_SA(1, 1), 1, k1, false);
            PG8_WAIT_V(8); PG8_WAIT_L(0); PG8_BAR; PG8_MMA(0, 0, At, B0); PG8_MMA(0, 1, At, B1); PG8_BAR; PG8_SCHED;
            PG8_LDA(At, 0, 1); PG8_STAGE(PG8_SB(0, 0), b2, voffB); PG8_STAGE(PG8_SB(0, 1), b2 + hstep, voffB); PG8_STAGE_A(PG8_SA(0, 0), 0, k2, last);
            PG8_WAIT_V(8); PG8_WAIT_L(0); PG8_BAR; PG8_MMA(1, 0, At, B0); PG8_MMA(1, 1, At, B1); PG8_BAR; PG8_SCHED;
            PG8_LDB(B0, 1, 0); PG8_LDB(B1, 1, 1); PG8_SCHED; PG8_LDA(At, 1, 0); PG8_STAGE_A(PG8_SA(0, 1), 1, k2, last);
            PG8_WAIT_V(8); PG8_WAIT_L(0); PG8_BAR; PG8_MMA(0, 0, At, B0); PG8_MMA(0, 1, At, B1); PG8_BAR; PG8_SCHED;
            PG8_LDA(At, 1, 1); PG8_STAGE(PG8_SB(1, 0), b3, voffB); PG8_STAGE(PG8_SB(1, 1), b3 + hstep, voffB); PG8_STAGE_A(PG8_SA(1, 0), 0, k3, last);
            PG8_WAIT_V(8); PG8_WAIT_L(0); PG8_BAR; PG8_MMA(1, 0, At, B0); PG8_MMA(1, 1, At, B1); PG8_BAR; PG8_SCHED;
        }
        if (wr == 0) PG8_BAR;
        E(acc, cur, wr, wc, fr, fq);
        if (!has_next) break;
#pragma unroll
        for (int a = 0; a < 2; ++a)
#pragma unroll
            for (int b = 0; b < 2; ++b)
#pragma unroll
                for (int m = 0; m < 4; ++m)
#pragma unroll
                    for (int n = 0; n < 2; ++n) acc[a][b][m][n] = (f32x4){0.f, 0.f, 0.f, 0.f};
        cur = nxt; cA = nA; cB = nB; ++ui;
        if (GATHER) {
#pragma unroll
            for (int _h = 0; _h < 2; ++_h)
#pragma unroll
                for (int _i = 0; _i < 2; ++_i) gcur[_h][_i] = gnxt[_h][_i]; }
        if (wr == 1) PG8_BAR;
    }
    PG8_WAIT_V(0);
    PG8_BAR;
#undef PG8_SA
#undef PG8_SB
#undef PG8_STAGE
#undef PG8_STAGE_A
#undef PG8_GOFF
#undef PG8_LDA
#undef PG8_LDB
#undef PG8_MMA
#undef PG8_WAIT_V
#undef PG8_WAIT_L
#undef PG8_BAR
#undef PG8_SCHED
}
}

#define LAS __attribute__((address_space(3)))
using pg8::bf16_t; using pg8::f32x4; using pg8::u32x4; using pg8::u32x2;
typedef unsigned short u16x8 __attribute__((ext_vector_type(8)));
typedef float f32x2 __attribute__((ext_vector_type(2)));

constexpr int DM = 1024, NB = 2, SEQ = 8192, NTOK = NB * SEQ, CTXL = 256, NCTX = NB * CTXL, NROW = NTOK + NCTX;
constexpr int NE = 16, CAP = 1024, DE = 2048, NSLOT = NE * NB * CAP;
constexpr int NADA = 6 * DM;
constexpr int NTHR = 512;

constexpr size_t MiB = 1u << 20;
constexpr size_t WS_CTL = 0;
constexpr size_t WS_MOD = 1 * MiB;
constexpr size_t WS_LB = WS_MOD + 256 * 1024;
constexpr size_t WS_POSR = WS_LB + 64 * 1024;
constexpr size_t WS_POSC = WS_POSR + 256 * 1024;
constexpr size_t WS_AFF = 2 * MiB;
constexpr size_t WS_TOPI = 3 * MiB;
constexpr size_t WS_TOPG = WS_TOPI + 128 * 1024;
constexpr size_t WS_SLOT = 4 * MiB;
constexpr size_t WS_WHGIN = 6 * MiB;
constexpr size_t WS_WHGOUT = 16 * MiB;
constexpr size_t WS_WSCIN = 18 * MiB;
constexpr size_t WS_WSCOUT = 24 * MiB;
constexpr size_t WS_WMOE1 = 26 * MiB;
constexpr size_t WS_WMOE2 = WS_WMOE1 + 256 * MiB;
constexpr size_t WS_X = WS_WMOE2 + 128 * MiB;
constexpr size_t WS_H = WS_X + 64 * MiB;
constexpr size_t WS_R = WS_H + 34 * MiB;
constexpr size_t WS_Q = WS_R;
constexpr size_t WS_V = WS_Q + 34 * MiB;
constexpr size_t WS_G = WS_V + 34 * MiB;
constexpr size_t WS_LF = WS_G + 34 * MiB;
constexpr size_t WS_LBK = WS_LF + 66 * MiB;
constexpr size_t WS_OF = WS_LBK + 66 * MiB;
constexpr size_t WS_OB = WS_OF + 64 * MiB;
constexpr size_t WS_U = WS_OB;
constexpr size_t WS_DD = WS_OB + 40 * MiB;
constexpr size_t WS_ON = WS_OB + 64 * MiB;
constexpr size_t WS_HG_END = WS_ON + 32 * MiB;
constexpr size_t WS_XG = WS_R;
constexpr size_t WS_ACT = WS_XG + 64 * MiB;
constexpr size_t WS_Y = WS_ACT + 128 * MiB;
constexpr size_t WS_MOE_END = WS_Y + 128 * MiB;
constexpr size_t WS_BG = WS_R;
constexpr size_t WS_CU = WS_BG + 32 * MiB;
constexpr size_t WS_Z = WS_CU + 32 * MiB;
constexpr size_t WS_END = WS_HG_END > WS_MOE_END ? WS_HG_END : WS_MOE_END;
static_assert(WS_END <= 1024 * MiB, "workspace map exceeds 1 GiB");

constexpr int LDS_BYTES = 147456;

struct Params { const float* in[20]; float* out; unsigned char* ws; int ph_lo, ph_hi; };
enum { I_X = 0, I_C, I_CTX, I_CCTX, I_ADAW, I_ADAB, I_NMIX, I_NFFN, I_NFIN, I_HGWIN, I_HGLB, I_HGNORM, I_HGWOUT, I_SCWIN, I_SCCONV, I_SCWOUT, I_ROUTER, I_WGATE, I_WUP, I_WDOWN };

typedef __bf16 bf16x2_t __attribute__((ext_vector_type(2)));
__device__ __forceinline__ unsigned pk2(float lo, float hi) { const f32x2 v = {lo, hi}; return __builtin_bit_cast(unsigned, __builtin_convertvector(v, bf16x2_t)); }
__device__ __forceinline__ unsigned f2bf(float f) { return pk2(f, 0.f) & 0xffffu; }
__device__ __forceinline__ float bf2f(unsigned short h) { return __builtin_bit_cast(float, (unsigned)h << 16); }
template <int CTRL> __device__ __forceinline__ float dpp_f(float x) { return __builtin_bit_cast(float, __builtin_amdgcn_update_dpp(0, __builtin_bit_cast(int, x), CTRL, 0xf, 0xf, true)); }
__device__ __forceinline__ float row16_sum(float x) {
    x += dpp_f<0xB1>(x);
    x += dpp_f<0x4E>(x);
    x += dpp_f<0x141>(x);
    x += dpp_f<0x140>(x);
    return x;
}
__device__ __forceinline__ float wave_sum(float v) { v = row16_sum(v); v += __shfl_xor(v, 16); v += __shfl_xor(v, 32); return v; }
__device__ __forceinline__ float sigmoidf_(float x) { return 1.f / (1.f + expf(-x)); }
__device__ __forceinline__ float fsigmoid(float x) { return __builtin_amdgcn_rcpf(1.f + __builtin_amdgcn_exp2f(-1.4426950408889634f * x)); }
__device__ __forceinline__ float fsilu(float x) { return x * fsigmoid(x); }
__device__ __forceinline__ float siluf_(float x) { return x / (1.f + expf(-x)); }

struct EpiInProj {
    static constexpr bool PERM = false;
    unsigned char* ws;
    __device__ __forceinline__ void operator()(const f32x4 (&acc)[2][2][4][2], const pg8::Unit& u, int wr, int wc, int fr, int fq) const {
        const int sec = u.pn >> 2;
        const int row0 = u.pm * 256 + wr * 64 + fr, cb = (u.pn & 3) * 256 + wc * 32 + 4 * fq;
        if (sec == 0 || sec == 1 || sec == 4) {
            bf16_t* O = (bf16_t*)(ws + (sec == 0 ? WS_Q : (sec == 1 ? WS_V : WS_G)));
#pragma unroll
            for (int ai = 0; ai < 2; ++ai)
#pragma unroll
                for (int m = 0; m < 4; ++m) { bf16_t* rp = O + (size_t)(row0 + ai * 128 + m * 16) * DM + cb;
#pragma unroll
                    for (int bj = 0; bj < 2; ++bj)
#pragma unroll
                        for (int n = 0; n < 2; ++n) { f32x4 v = acc[ai][bj][m][n];
                            if (sec == 0) v = v * 0.08838834764831845f;
                            if (sec == 4) { v[0] = fsilu(v[0]); v[1] = fsilu(v[1]); v[2] = fsilu(v[2]); v[3] = fsilu(v[3]); }
                            u32x2 w; w.x = pk2(v[0], v[1]); w.y = pk2(v[2], v[3]); *(u32x2*)(rp + bj * 128 + n * 16) = w; } }
        } else {
            float* O = (float*)(ws + (sec == 2 ? WS_LF : WS_LBK)); const float* lb0 = (const float*)(ws + WS_LB);
            f32x4 lbv[2][2];
#pragma unroll
            for (int bj = 0; bj < 2; ++bj)
#pragma unroll
                for (int n = 0; n < 2; ++n) lbv[bj][n] = *(const f32x4*)(lb0 + cb + bj * 128 + n * 16);
#pragma unroll
            for (int ai = 0; ai < 2; ++ai)
#pragma unroll
                for (int m = 0; m < 4; ++m) { float* rp = O + (size_t)(row0 + ai * 128 + m * 16) * DM + cb;
#pragma unroll
                    for (int bj = 0; bj < 2; ++bj)
#pragma unroll
                        for (int n = 0; n < 2; ++n) { const f32x4 z = acc[ai][bj][m][n], lb = lbv[bj][n]; f32x4 o;
#pragma unroll
                            for (int i = 0; i < 4; ++i) o[i] = lb[i] + (1.f - lb[i]) * fsigmoid(z[i]);
                            *(f32x4*)(rp + bj * 128 + n * 16) = o; } }
        }
    }
};
struct EpiResid {
    static constexpr bool PERM = false;
    float* X; const float* gate;
    __device__ __forceinline__ void operator()(const f32x4 (&acc)[2][2][4][2], const pg8::Unit& u, int wr, int wc, int fr, int fq) const {
        const int row0 = u.pm * 256 + wr * 64 + fr, cb = u.pn * 256 + wc * 32 + 4 * fq;
        const float* gp = gate + (size_t)((u.pm * 256) / SEQ) * NADA + cb;
        f32x4 gv[2][2];
#pragma unroll
        for (int bj = 0; bj < 2; ++bj)
#pragma unroll
            for (int n = 0; n < 2; ++n) gv[bj][n] = *(const f32x4*)(gp + bj * 128 + n * 16);
#pragma unroll
        for (int ai = 0; ai < 2; ++ai)
#pragma unroll
            for (int m = 0; m < 4; ++m) { float* rp = X + (size_t)(row0 + ai * 128 + m * 16) * DM + cb;
#pragma unroll
                for (int bj = 0; bj < 2; ++bj)
#pragma unroll
                    for (int n = 0; n < 2; ++n) { f32x4* q = (f32x4*)(rp + bj * 128 + n * 16); *q = *q + gv[bj][n] * acc[ai][bj][m][n]; } }
    }
};
struct EpiGLU {
    static constexpr bool PERM = true;
    bf16_t* ACT;
    __device__ __forceinline__ void operator()(const f32x4 (&acc)[2][2][4][2], const pg8::Unit& u, int wr, int wc, int fr, int fq) const {
        const int row0 = u.pm * 256 + wr * 64 + fr, cb = u.pn * 128 + wc * 32 + 8 * fq;
#pragma unroll
        for (int ai = 0; ai < 2; ++ai)
#pragma unroll
            for (int m = 0; m < 4; ++m) { bf16_t* rp = ACT + (size_t)(row0 + ai * 128 + m * 16) * DE + cb;
                f32x4 o[2];
#pragma unroll
                for (int n = 0; n < 2; ++n) { const f32x4 a = acc[ai][0][m][n], w = acc[ai][1][m][n];
#pragma unroll
                    for (int i = 0; i < 4; ++i) o[n][i] = fsilu(a[i]) * w[i]; }
                u32x4 w; w.x = pk2(o[0][0], o[0][1]); w.y = pk2(o[0][2], o[0][3]); w.z = pk2(o[1][0], o[1][1]); w.w = pk2(o[1][2], o[1][3]);
                *(u32x4*)rp = w; }
    }
};
struct EpiRowScale {
    static constexpr bool PERM = true;
    bf16_t* Y; const float* rg;
    __device__ __forceinline__ void operator()(const f32x4 (&acc)[2][2][4][2], const pg8::Unit& u, int wr, int wc, int fr, int fq) const {
        const int row0 = u.pm * 256 + wr * 64 + fr, cb = u.pn * 256 + wc * 32 + 8 * fq;
#pragma unroll
        for (int ai = 0; ai < 2; ++ai)
#pragma unroll
            for (int m = 0; m < 4; ++m) { const int row = row0 + ai * 128 + m * 16; const float gsc = rg[row]; bf16_t* rp = Y + (size_t)row * DM + cb;
#pragma unroll
                for (int bj = 0; bj < 2; ++bj) { const f32x4 v0 = acc[ai][bj][m][0] * gsc, v1 = acc[ai][bj][m][1] * gsc;
                    u32x4 w; w.x = pk2(v0[0], v0[1]); w.y = pk2(v0[2], v0[3]); w.z = pk2(v1[0], v1[1]); w.w = pk2(v1[2], v1[3]);
                    *(u32x4*)(rp + bj * 128) = w; } }
    }
};
struct EpiConvIn {
    static constexpr bool PERM = true;
    bf16_t *BG, *CU;
    __device__ __forceinline__ void operator()(const f32x4 (&acc)[2][2][4][2], const pg8::Unit& u, int wr, int wc, int fr, int fq) const {
        const int row0 = u.pm * 256 + wr * 64 + fr;
        if (u.pn < 4) {
            const int cb = u.pn * 256 + wc * 32 + 8 * fq;
#pragma unroll
            for (int ai = 0; ai < 2; ++ai)
#pragma unroll
                for (int m = 0; m < 4; ++m) { bf16_t* rp = BG + (size_t)(row0 + ai * 128 + m * 16) * DM + cb;
#pragma unroll
                    for (int bj = 0; bj < 2; ++bj) { const f32x4 v0 = acc[ai][bj][m][0], v1 = acc[ai][bj][m][1];
                        u32x4 w; w.x = pk2(v0[0], v0[1]); w.y = pk2(v0[2], v0[3]); w.z = pk2(v1[0], v1[1]); w.w = pk2(v1[2], v1[3]);
                        *(u32x4*)(rp + bj * 128) = w; } }
        } else {
            const int cb = (u.pn - 4) * 128 + wc * 32 + 8 * fq;
#pragma unroll
            for (int ai = 0; ai < 2; ++ai)
#pragma unroll
                for (int m = 0; m < 4; ++m) { bf16_t* rp = CU + (size_t)(row0 + ai * 128 + m * 16) * DM + cb;
                    const f32x4 v0 = acc[ai][0][m][0] * acc[ai][1][m][0], v1 = acc[ai][0][m][1] * acc[ai][1][m][1];
                    u32x4 w; w.x = pk2(v0[0], v0[1]); w.y = pk2(v0[2], v0[3]); w.z = pk2(v1[0], v1[1]); w.w = pk2(v1[2], v1[3]);
                    *(u32x4*)rp = w; }
        }
    }
};

__device__ __forceinline__ void ph_prep(const Params& p, unsigned char* lds, int bid, int nblk) {
    float* sv = (float*)lds;
    float* red = sv + 3 * 1024;
    int tid_ = threadIdx.x; asm volatile("" : "+v"(tid_)); const int tid = tid_;
    const float* c = p.in[I_C]; const float* cctx = p.in[I_CCTX];
    for (int i = tid; i < 3 * 1024; i += NTHR) { const float v = (i < 2048) ? c[i] : cctx[i - 2048]; sv[i] = siluf_(v); }
    __syncthreads();
    const float* ada_w = p.in[I_ADAW]; const float* ada_b = p.in[I_ADAB];
    float* mod = (float*)(p.ws + WS_MOD);
    for (int it = bid; it < 192; it += nblk) {
        const int l = it / 96, j0 = (it % 96) * 64, col = tid & 63, ks = tid >> 6;
        const float* W = ada_w + (size_t)l * DM * NADA + j0 + col;
        float a0 = 0.f, a1 = 0.f, a2 = 0.f;
#pragma unroll 16
        for (int k = ks * 128; k < ks * 128 + 128; ++k) { const float w = W[(size_t)k * NADA]; a0 += sv[k] * w; a1 += sv[1024 + k] * w; a2 += sv[2048 + k] * w; }
        red[(ks * 3 + 0) * 64 + col] = a0; red[(ks * 3 + 1) * 64 + col] = a1; red[(ks * 3 + 2) * 64 + col] = a2;
        __syncthreads();
        if (tid < 192) { const int v = tid >> 6, cc = tid & 63; float s = ada_b[l * NADA + j0 + cc];
#pragma unroll
            for (int k2 = 0; k2 < 8; ++k2) s += red[(k2 * 3 + v) * 64 + cc];
            mod[(size_t)(l * 3 + v) * NADA + j0 + cc] = s; }
        __syncthreads();
    }
    const int gt = bid * NTHR + tid, NT = nblk * NTHR;
    const float* lg = p.in[I_HGLB]; float* lb0 = (float*)(p.ws + WS_LB);
    for (int d = gt; d < DM; d += NT) { const float l0 = lg[d], l1 = lg[DM + d], l2 = lg[2 * DM + d]; const float mx = fmaxf(l0, fmaxf(l1, l2));
        const float e0 = expf(l0 - mx), e1 = expf(l1 - mx), e2 = expf(l2 - mx); lb0[d] = e0 / (e0 + e1 + e2); }
    float* posr = (float*)(p.ws + WS_POSR);
    for (int i = gt; i < (128 + 64) * 512; i += NT) { const int pi = i >> 9, dd = i & 511; const int pos = pi < 128 ? pi : pi - 128; const int fi = dd & 255;
        const float om = exp2f(-(float)fi * (13.287712379549449f / 256.0f)); const float a = (float)pos * om; posr[i] = dd < 256 ? sinf(a) : cosf(a); }
}

__device__ __forceinline__ void transpose_item(const float* W, int N, bf16_t* WT, int K, float* scr, int k0, int n0, size_t drow0, int lane) {
#pragma unroll
    for (int i = 0; i < 8; ++i) { const int kk = 8 * i + (lane >> 3); const f32x4 v = *(const f32x4*)(W + (size_t)(k0 + kk) * N + n0 + (lane & 7) * 4); float* d = scr + kk * 33 + (lane & 7) * 4; d[0] = v[0]; d[1] = v[1]; d[2] = v[2]; d[3] = v[3]; }
    __builtin_amdgcn_s_waitcnt(0xc07f); asm volatile("" ::: "memory");
    const int c = lane & 7;
#pragma unroll
    for (int j = 0; j < 4; ++j) { const int n = (lane >> 3) + 8 * j; const float* s = scr + (8 * c) * 33 + n;
        u32x4 o; o.x = pk2(s[0 * 33], s[1 * 33]); o.y = pk2(s[2 * 33], s[3 * 33]); o.z = pk2(s[4 * 33], s[5 * 33]); o.w = pk2(s[6 * 33], s[7 * 33]);
        *(u32x4*)(WT + (drow0 + n) * K + k0 + 8 * c) = o; }
    __builtin_amdgcn_s_waitcnt(0xc07f); asm volatile("" ::: "memory");
}
__device__ __forceinline__ void ph_convert_small(const Params& p, unsigned char* lds, int bid, int nblk) {
    int tid_ = threadIdx.x; asm volatile("" : "+v"(tid_));
    const int tid = tid_, lane = tid & 63, wave = tid >> 6;
    float* scr = (float*)lds + wave * (64 * 33);
    const int gw = bid * 8 + wave, NGW = nblk * 8;
    constexpr int I_A = 16 * 160, I_B = 16 * 32, I_C_ = 16 * 96, I_D = 16 * 32;
    for (int it = gw; it < I_A + I_B + I_C_ + I_D; it += NGW) {
        int r = it;
        if (r < I_A) { const int kb = r / 160, nb = r % 160; transpose_item(p.in[I_HGWIN], 5120, (bf16_t*)(p.ws + WS_WHGIN), 1024, scr, kb * 64, nb * 32, (size_t)nb * 32, lane); continue; } r -= I_A;
        if (r < I_B) { const int kb = r / 32, nb = r % 32; transpose_item(p.in[I_HGWOUT], 1024, (bf16_t*)(p.ws + WS_WHGOUT), 1024, scr, kb * 64, nb * 32, (size_t)nb * 32, lane); continue; } r -= I_B;
        if (r < I_C_) { const int kb = r / 96, nb = r % 96, n0 = nb * 32; size_t dr;
            if (n0 < 1024) dr = n0; else { const int np = n0 - 1024, sec = np >> 10, nn = np & 1023; dr = 1024 + (nn >> 7) * 256 + sec * 128 + (nn & 127); }
            transpose_item(p.in[I_SCWIN], 3072, (bf16_t*)(p.ws + WS_WSCIN), 1024, scr, kb * 64, n0, dr, lane); continue; } r -= I_C_;
        { const int kb = r / 32, nb = r % 32; transpose_item(p.in[I_SCWOUT], 1024, (bf16_t*)(p.ws + WS_WSCOUT), 1024, scr, kb * 64, nb * 32, (size_t)nb * 32, lane); }
    }
}
struct CvtItem { const float* src; bf16_t* dst; int N, K; };
__device__ __forceinline__ CvtItem moe_item(const Params& p, int l, int r) {
    CvtItem c;
    if (r < 32768) { const int up = r >= 16384; if (up) r -= 16384; const int le = l * 16 + (r >> 10), q = r & 1023, kb = q >> 6, nb = q & 63, n0 = nb * 32;
        const size_t dr = (size_t)le * 4096 + (n0 >> 7) * 256 + up * 128 + (n0 & 127);
        c.src = p.in[up ? I_WUP : I_WGATE] + (size_t)le * 1024 * 2048 + (size_t)(kb * 64) * 2048 + n0; c.dst = (bf16_t*)(p.ws + WS_WMOE1) + dr * 1024 + kb * 64; c.N = 2048; c.K = 1024; }
    else { r -= 32768; const int le = l * 16 + (r >> 10), q = r & 1023, kb = q >> 5, nb = q & 31, n0 = nb * 32;
        c.src = p.in[I_WDOWN] + (size_t)le * 2048 * 1024 + (size_t)(kb * 64) * 1024 + n0; c.dst = (bf16_t*)(p.ws + WS_WMOE2) + ((size_t)le * 1024 + n0) * 2048 + kb * 64; c.N = 1024; c.K = 2048; }
    return c;
}
__device__ __forceinline__ void convert_moe_slice(const Params& p, unsigned char* lds, int bid, int nblk, int l, int lo, int hi) {
    int tid_ = threadIdx.x; asm volatile("" : "+v"(tid_));
    const int tid = tid_, lane = tid & 63, wave = tid >> 6;
    float* scr = (float*)lds + wave * (64 * 33);
    const int gw = bid * 8 + wave, NGW = nblk * 8;
    constexpr int NI = 3;
    for (int it = lo + gw; it < hi; it += NGW * NI) {
        f32x4 v[NI][8]; CvtItem ci[NI];
#pragma unroll
        for (int u = 0; u < NI; ++u) { const int r = it + u * NGW; ci[u] = moe_item(p, l, r < hi ? r : it);
#pragma unroll
            for (int i = 0; i < 8; ++i) v[u][i] = __builtin_nontemporal_load((const f32x4*)(ci[u].src + (size_t)(8 * i + (lane >> 3)) * ci[u].N + (lane & 7) * 4)); }
#pragma unroll
        for (int u = 0; u < NI; ++u) { if (it + u * NGW < hi) {
#pragma unroll
            for (int i = 0; i < 8; ++i) { float* d = scr + (8 * i + (lane >> 3)) * 33 + (lane & 7) * 4; d[0] = v[u][i][0]; d[1] = v[u][i][1]; d[2] = v[u][i][2]; d[3] = v[u][i][3]; }
            __builtin_amdgcn_s_waitcnt(0xc07f); asm volatile("" ::: "memory");
            const int c = lane & 7;
#pragma unroll
            for (int j = 0; j < 4; ++j) { const int n = (lane >> 3) + 8 * j; const float* sp = scr + (8 * c) * 33 + n;
                u32x4 o; o.x = pk2(sp[0 * 33], sp[1 * 33]); o.y = pk2(sp[2 * 33], sp[3 * 33]); o.z = pk2(sp[4 * 33], sp[5 * 33]); o.w = pk2(sp[6 * 33], sp[7 * 33]);
                __builtin_nontemporal_store(o, (u32x4*)(ci[u].dst + (size_t)n * ci[u].K + 8 * c)); }
            __builtin_amdgcn_s_waitcnt(0xc07f); asm volatile("" ::: "memory"); } }
    }
    __syncthreads();
}

__device__ __forceinline__ void store_mod_bf16(bf16_t* hrow, const f32x4 (&v)[4], float rstd, const float* g, const float* sh, const float* sc, int lane) {
#pragma unroll
    for (int j = 0; j < 4; ++j) { const int c0 = 256 * j + 4 * lane; const f32x4 gv = *(const f32x4*)(g + c0), shv = *(const f32x4*)(sh + c0), scv = *(const f32x4*)(sc + c0);
        f32x4 h;
#pragma unroll
        for (int i = 0; i < 4; ++i) h[i] = (v[j][i] * rstd * gv[i]) * (1.f + scv[i]) + shv[i];
        u32x2 w; w.x = pk2(h[0], h[1]); w.y = pk2(h[2], h[3]); *(u32x2*)(hrow + c0) = w; }
}
__device__ __forceinline__ void ph_mod0(const Params& p, int row_lo, int row_hi, int wk, int nwk) {
    int tid_ = threadIdx.x; asm volatile("" : "+v"(tid_));
    const int tid = tid_, lane = tid & 63, wave = tid >> 6, gw = wk * 8 + wave, NGW = nwk * 8;
    const float* x = p.in[I_X]; const float* ctx = p.in[I_CTX]; const float* g = p.in[I_NMIX];
    const float* mod = (const float*)(p.ws + WS_MOD); const float* posr = (const float*)(p.ws + WS_POSR); const float* posc = (const float*)(p.ws + WS_POSC);
    float* X = (float*)(p.ws + WS_X); bf16_t* H = (bf16_t*)(p.ws + WS_H);
    f32x4 nx[4];
    { const int row = row_lo + gw; if (row < row_hi) { const float* src = row < NTOK ? x + (size_t)row * DM : ctx + (size_t)(row - NTOK) * DM;
#pragma unroll
        for (int j = 0; j < 4; ++j) nx[j] = *(const f32x4*)(src + 256 * j + 4 * lane); } }
    for (int row = row_lo + gw; row < row_hi; row += NGW) {
        f32x4 v[4]; float ss = 0.f; int vec;
#pragma unroll
        for (int j = 0; j < 4; ++j) v[j] = nx[j];
        { const int r2 = row + NGW; if (r2 < row_hi) { const float* src = r2 < NTOK ? x + (size_t)r2 * DM : ctx + (size_t)(r2 - NTOK) * DM;
#pragma unroll
            for (int j = 0; j < 4; ++j) nx[j] = *(const f32x4*)(src + 256 * j + 4 * lane); } }
        if (row < NTOK) { const int t = row & (SEQ - 1); vec = row >> 13; const float* pr = posr + (size_t)(t >> 6) * 512; const float* pc = posc + (size_t)(t & 63) * 512;
#pragma unroll
            for (int j = 0; j < 4; ++j) { const int c0 = 256 * j + 4 * lane; const f32x4 pv = *(const f32x4*)((j < 2 ? pr : pc) + (c0 & 511));
                v[j] = v[j] + pv; *(f32x4*)(X + (size_t)row * DM + c0) = v[j]; }
        } else vec = 2;
#pragma unroll
        for (int j = 0; j < 4; ++j) ss += (v[j][0] * v[j][0] + v[j][1] * v[j][1]) + (v[j][2] * v[j][2] + v[j][3] * v[j][3]);
        const float rstd = 1.f / sqrtf(wave_sum(ss) * (1.f / DM) + 1e-6f);
        const float* mv = mod + (size_t)(0 * 3 + vec) * NADA;
        store_mod_bf16(H + (size_t)row * DM, v, rstd, g, mv, mv + DM, lane);
    }
}

typedef short s16x4 __attribute__((ext_vector_type(4)));
typedef short v4i16_t __attribute__((ext_vector_type(4)));
using pg8::bf16x8;
constexpr int KT_STR = 160, KS_STR = 144, V_STR = 288;
constexpr int GL_QT = 0, GL_KT = 20480, GL_KS = 40960, GL_PL = 59392, GL_V = 68608, GL_SEG = 87040, GL_DV = 89088, GL_EM = 89600, GL_SSQ = 90112, GL_RSTD = 92160;
__device__ __forceinline__ s16x4 lds_tr(const LAS unsigned char* p) { return __builtin_bit_cast(s16x4, __builtin_amdgcn_ds_read_tr16_b64_v4i16((LAS v4i16_t*)p)); }
__device__ __forceinline__ bf16x8 cat8(s16x4 a, s16x4 b) { return __builtin_shufflevector(a, b, 0, 1, 2, 3, 4, 5, 6, 7); }
__device__ __forceinline__ bf16x8 lds_pair64(const LAS unsigned char* p, int d2) { const u32x2 a = *(const LAS u32x2*)p, b = *(const LAS u32x2*)(p + d2); u32x4 r; r.x = a.x; r.y = a.y; r.z = b.x; r.w = b.y; return __builtin_bit_cast(bf16x8, r); }

constexpr int ON_STR = 272;
constexpr int GL_RF = 92416, GL_RQ = 125184, GL_END = 141568;
struct GlaRegs { f32x4 f[4]; u32x4 q[2]; u32x4 v[2]; };
template <bool WITHQ>
__device__ __forceinline__ void gla_load(GlaRegs& R, const float* F, const bf16_t* Q, const bf16_t* V, int rb, int h, int tid) {
    const unsigned lf = (unsigned)((tid >> 5) * DM + (tid & 31) * 4), lq = (unsigned)((tid >> 4) * DM + (tid & 15) * 8);
#pragma unroll
    for (int i = 0; i < 4; ++i) { const float* fb = F + (size_t)(rb + 16 * i) * DM + h * 128; R.f[i] = *(const f32x4*)(fb + lf); }
#pragma unroll
    for (int i = 0; i < 2; ++i) { const size_t ub = (size_t)(rb + 32 * i) * DM + h * 128;
        if (WITHQ) R.q[i] = *(const u32x4*)(Q + ub + lq); R.v[i] = *(const u32x4*)(V + ub + lq); }
}
template <bool WITHQ>
__device__ __forceinline__ void gla_put_raw(const GlaRegs& R, LAS unsigned char* lds, int dir, int tid) {
#pragma unroll
    for (int i = 0; i < 4; ++i) { const int id = tid + 512 * i, row = id >> 5, c4 = (id & 31) * 4, p = dir ? 63 - row : row; *(LAS f32x4*)(lds + GL_RF + p * 512 + c4 * 4) = R.f[i]; }
#pragma unroll
    for (int i = 0; i < 2; ++i) { const int id = tid + 512 * i, row = id >> 4, c8 = (id & 15) * 8, p = dir ? 63 - row : row;
        if (WITHQ) *(LAS u32x4*)(lds + GL_RQ + p * 256 + c8 * 2) = R.q[i]; *(LAS u32x4*)(lds + GL_V + p * V_STR + c8 * 2) = R.v[i]; }
}
template <bool G2>
__device__ __forceinline__ void gla_phase_a(LAS unsigned char* lds, int tid) {
    const int k = tid & 127, seg = tid >> 7;
    LAS float* segtot = (LAS float*)(lds + GL_SEG);
    float f[16];
#pragma unroll
    for (int i = 0; i < 16; ++i) f[i] = *(const LAS float*)(lds + GL_RF + (16 * seg + i) * 512 + k * 4);
    if (G2) {
        unsigned short q[16];
#pragma unroll
        for (int i = 0; i < 16; ++i) q[i] = *(const LAS unsigned short*)(lds + GL_RQ + (16 * seg + i) * 256 + k * 2);
        float c[16]; c[0] = f[0];
#pragma unroll
        for (int i = 1; i < 16; ++i) c[i] = c[i - 1] * f[i];
        segtot[seg * 128 + k] = c[15];
        __syncthreads();
        const float T0 = segtot[k], T1 = segtot[128 + k], T2 = segtot[256 + k], T3 = segtot[384 + k];
        const float Fs = seg == 0 ? 1.f / (T0 * T1) : (seg == 1 ? 1.f / T1 : (seg == 2 ? 1.f : T2));
        const float cK = T2 * T3;
        if (seg == 0) { ((LAS float*)(lds + GL_DV))[k] = T0 * T1 * cK; ((LAS float*)(lds + GL_EM))[k] = T0 * T1; }
        unsigned wq[8], wk[8], ws_[8];
#pragma unroll
        for (int i = 0; i < 16; i += 2) { float qp[2], kp[2], ks[2];
#pragma unroll
            for (int e = 0; e < 2; ++e) { const float eq = c[i + e] * Fs, inv = __builtin_amdgcn_rcpf(eq), kk = 1.f - f[i + e];
                qp[e] = bf2f(q[i + e]) * eq; kp[e] = kk * inv; ks[e] = kp[e] * cK; }
            wq[i >> 1] = pk2(qp[0], qp[1]); wk[i >> 1] = pk2(kp[0], kp[1]); ws_[i >> 1] = pk2(ks[0], ks[1]); }
        LAS unsigned char* dq = lds + GL_QT + k * KT_STR + seg * 32; LAS unsigned char* dk = lds + GL_KT + k * KT_STR + seg * 32; LAS unsigned char* ds = lds + GL_KS + k * KS_STR + seg * 32;
        *(LAS u32x4*)dq = (u32x4){wq[0], wq[1], wq[2], wq[3]}; *(LAS u32x4*)(dq + 16) = (u32x4){wq[4], wq[5], wq[6], wq[7]};
        *(LAS u32x4*)dk = (u32x4){wk[0], wk[1], wk[2], wk[3]}; *(LAS u32x4*)(dk + 16) = (u32x4){wk[4], wk[5], wk[6], wk[7]};
        *(LAS u32x4*)ds = (u32x4){ws_[0], ws_[1], ws_[2], ws_[3]}; *(LAS u32x4*)(ds + 16) = (u32x4){ws_[4], ws_[5], ws_[6], ws_[7]};
    } else {
        float sx[16]; sx[15] = 1.f;
#pragma unroll
        for (int i = 14; i >= 0; --i) sx[i] = sx[i + 1] * f[i + 1];
        segtot[seg * 128 + k] = sx[0] * f[0];
        __syncthreads();
        const float T0 = segtot[k], T1 = segtot[128 + k], T2 = segtot[256 + k], T3 = segtot[384 + k];
        const float later = seg == 0 ? T1 * T2 * T3 : (seg == 1 ? T2 * T3 : (seg == 2 ? T3 : 1.f));
        if (seg == 0) ((LAS float*)(lds + GL_DV))[k] = T0 * T1 * T2 * T3;
        unsigned ws_[8];
#pragma unroll
        for (int i = 0; i < 16; i += 2) ws_[i >> 1] = pk2((1.f - f[i]) * sx[i] * later, (1.f - f[i + 1]) * sx[i + 1] * later);
        LAS unsigned char* ds = lds + GL_KS + k * KS_STR + seg * 32;
        *(LAS u32x4*)ds = (u32x4){ws_[0], ws_[1], ws_[2], ws_[3]}; *(LAS u32x4*)(ds + 16) = (u32x4){ws_[4], ws_[5], ws_[6], ws_[7]};
    }
    __syncthreads();
}
__device__ __forceinline__ void gla_state_update(f32x4 (&S)[8], const bf16x8 (&Vf)[2], const LAS unsigned char* lds, int i16, int g) {
#pragma unroll
    for (int j = 0; j < 8; ++j) { const f32x4 dv = *(const LAS f32x4*)(lds + GL_DV + (16 * j + 4 * g) * 4); S[j] = S[j] * dv;
#pragma unroll
        for (int c2 = 0; c2 < 2; ++c2) { const bf16x8 a = lds_pair64(lds + GL_KS + (16 * j + i16) * KS_STR + (32 * c2 + 4 * g) * 2, 32);
            S[j] = __builtin_amdgcn_mfma_f32_16x16x32_bf16(a, Vf[c2], S[j], 0, 0, 0); }
        if (j & 1) asm volatile("" ::: "memory"); }
}
__device__ __forceinline__ void gla_load_vf(bf16x8 (&Vf)[2], const LAS unsigned char* lds, int w, int i16, int g) {
    const int q4 = i16 >> 2, pp = i16 & 3;
#pragma unroll
    for (int c2 = 0; c2 < 2; ++c2) { const LAS unsigned char* vb = lds + GL_V + (32 * c2 + 4 * g + q4) * V_STR + (16 * w + 4 * pp) * 2; Vf[c2] = cat8(lds_tr(vb), lds_tr(vb + 16 * V_STR)); }
}

__device__ __forceinline__ void ph_gla_states(const Params& p, unsigned char* lds_, int bid, int nblk) {
    int tid_ = threadIdx.x; asm volatile("" : "+v"(tid_));
    const int tid = tid_, lane = tid & 63, w = __builtin_amdgcn_readfirstlane(tid >> 6), i16 = lane & 15, g = lane >> 4;
    LAS unsigned char* lds = (LAS unsigned char*)lds_;
    const bf16_t* V = (const bf16_t*)(p.ws + WS_V);
    float* U = (float*)(p.ws + WS_U); float* DD = (float*)(p.ws + WS_DD);
    for (int ui = bid; ui < 544; ui += nblk) {
        int b, h, dir, nch, rb0, uidx;
        if (ui < 512) { b = ui >> 8; h = (ui >> 5) & 7; dir = (ui >> 4) & 1; const int sc = ui & 15; nch = 8; rb0 = b * SEQ + sc * 512; uidx = ((b * 8 + h) * 2 + dir) * 17 + sc; }
        else { const int r = ui - 512; b = r >> 4; h = (r >> 1) & 7; dir = r & 1; nch = 4; rb0 = NTOK + b * CTXL; uidx = ((b * 8 + h) * 2 + dir) * 17 + 16; }
        const float* F = (const float*)(p.ws + (dir ? WS_LBK : WS_LF));
        f32x4 S[8];
#pragma unroll
        for (int j = 0; j < 8; ++j) S[j] = (f32x4){0.f, 0.f, 0.f, 0.f};
        float dtot = 1.f;
        GlaRegs R;
        gla_load<false>(R, F, nullptr, V, rb0 + 64 * (dir ? nch - 1 : 0), h, tid);
        for (int step = 0; step < nch; ++step) {
            gla_put_raw<false>(R, lds, dir, tid);
            __syncthreads();
            if (step + 1 < nch) gla_load<false>(R, F, nullptr, V, rb0 + 64 * (dir ? nch - 2 - step : step + 1), h, tid);
            gla_phase_a<false>(lds, tid);
            if (tid < 128) dtot *= ((const LAS float*)(lds + GL_DV))[tid];
            bf16x8 Vf[2]; gla_load_vf(Vf, lds, w, i16, g);
            gla_state_update(S, Vf, lds, i16, g);
            __syncthreads();
        }
        float* up = U + (size_t)uidx * 16384 + (size_t)(w * 8) * 256 + lane * 4;
#pragma unroll
        for (int j = 0; j < 8; ++j) *(f32x4*)(up + j * 256) = S[j];
        if (tid < 128) DD[(size_t)uidx * 128 + tid] = dtot;
    }
}

__device__ __forceinline__ void ph_gla_out(const Params& p, unsigned char* lds_, int bid, int nblk) {
    int tid_ = threadIdx.x; asm volatile("" : "+v"(tid_));
    const int tid = tid_, lane = tid & 63, w = __builtin_amdgcn_readfirstlane(tid >> 6), i16 = lane & 15, g = lane >> 4, q4 = i16 >> 2, pp = i16 & 3;
    LAS unsigned char* lds = (LAS unsigned char*)lds_;
    const bf16_t* Q = (const bf16_t*)(p.ws + WS_Q); const bf16_t* V = (const bf16_t*)(p.ws + WS_V); const bf16_t* G = (const bf16_t*)(p.ws + WS_G);
    const float* U = (const float*)(p.ws + WS_U); const float* DD = (const float*)(p.ws + WS_DD);
    float* OFL = (float*)(p.ws + WS_OF); bf16_t* ON = (bf16_t*)(p.ws + WS_ON);
    const float ngv = p.in[I_HGNORM][16 * w + i16];
    const int troff = (4 * g + q4) * KT_STR + (4 * pp) * 2;
    for (int unit = bid; unit < 256; unit += nblk) {
        const int b = unit >> 7, h = (unit >> 4) & 7, sc = unit & 15, rbs = b * SEQ + sc * 512;
        const unsigned loff = (unsigned)((3 - g) * 4 * DM + i16);
#pragma unroll 1
        for (int dir = 0; dir < 2; ++dir) {
            const float* F = (const float*)(p.ws + (dir ? WS_LBK : WS_LF));
            GlaRegs R;
            gla_load<true>(R, F, Q, V, rbs + 64 * (dir ? 7 : 0), h, tid);
            int on_rb = -1;
#define GLA_ON_FLUSH() do { _Pragma("unroll") for (int i_ = 0; i_ < 2; ++i_) { const int id_ = tid + 512 * i_, row_ = id_ >> 4, c8_ = (id_ & 15) * 8; \
                *(u32x4*)(ON + (size_t)(on_rb + row_) * DM + h * 128 + c8_) = *(const LAS u32x4*)(lds + GL_QT + row_ * ON_STR + c8_ * 2); } } while (0)
            const int ub = ((b * 8 + h) * 2 + dir) * 17;
            f32x4 S[8];
            { const float* up = U + (size_t)(ub + 16) * 16384 + (size_t)(w * 8) * 256 + lane * 4;
#pragma unroll
                for (int j = 0; j < 8; ++j) S[j] = *(const f32x4*)(up + j * 256); }
            { const int nf = dir ? 15 - sc : sc;
                LAS float* dl = (LAS float*)(lds + GL_QT);
                for (int i = tid; i < 16 * 128; i += NTHR) dl[i] = DD[(size_t)ub * 128 + i];
                __syncthreads();
                f32x4 Ua[8];
#define FOLD_LOAD(UU, s_) do { const int u_ = dir ? 15 - (s_) : (s_); const float* up_ = U + (size_t)(ub + u_) * 16384 + (size_t)(w * 8) * 256 + lane * 4; \
                    _Pragma("unroll") for (int j = 0; j < 8; ++j) UU[j] = *(const f32x4*)(up_ + j * 256); } while (0)
                if (nf > 0) FOLD_LOAD(Ua, 0);
                for (int s = 0; s < nf; ++s) { const int u = dir ? 15 - s : s;
#pragma unroll
                    for (int j = 0; j < 8; ++j) S[j] = S[j] * *(const LAS f32x4*)(dl + u * 128 + 16 * j + 4 * g) + Ua[j];
                    if (s + 1 < nf) FOLD_LOAD(Ua, s + 1); }
#undef FOLD_LOAD
                __syncthreads();
            }
            for (int step = 0; step < 8; ++step) {
                const int n = dir ? 7 - step : step, rb = rbs + 64 * n;
                gla_put_raw<true>(R, lds, dir, tid);
                __syncthreads();
                if (on_rb >= 0) { GLA_ON_FLUSH(); on_rb = -1; }
                if (step < 7) gla_load<true>(R, F, Q, V, rbs + 64 * (dir ? 6 - step : step + 1), h, tid);
                gla_phase_a<true>(lds, tid);
                f32x4 O[4];
                if (dir) { const float* ob = OFL + ((size_t)((unit * 8 + n) * 8 + w) * 4) * 256 + ((3 - g) * 16 + i16) * 4;
#pragma unroll
                    for (int ti = 0; ti < 4; ++ti) { const f32x4 t4 = *(const f32x4*)(ob + (3 - ti) * 256); O[ti] = (f32x4){t4[3], t4[2], t4[1], t4[0]}; } }
                else {
#pragma unroll
                    for (int ti = 0; ti < 4; ++ti) O[ti] = (f32x4){0.f, 0.f, 0.f, 0.f}; }
                { const int si = w >> 1, tb = 2 * (w & 1);
                    f32x4 pa[2] = {(f32x4){0.f, 0.f, 0.f, 0.f}, (f32x4){0.f, 0.f, 0.f, 0.f}};
#pragma unroll
                    for (int c = 0; c < 4; ++c) { const LAS unsigned char* ka = lds + GL_KT + troff + (32 * c) * KT_STR + (16 * si) * 2; const bf16x8 a = cat8(lds_tr(ka), lds_tr(ka + 16 * KT_STR));
#pragma unroll
                        for (int tt = 0; tt < 2; ++tt) { const LAS unsigned char* qa = lds + GL_QT + troff + (32 * c) * KT_STR + (16 * (tb + tt)) * 2; const bf16x8 bq = cat8(lds_tr(qa), lds_tr(qa + 16 * KT_STR));
                            pa[tt] = __builtin_amdgcn_mfma_f32_16x16x32_bf16(a, bq, pa[tt], 0, 0, 0); } }
#pragma unroll
                    for (int tt = 0; tt < 2; ++tt) { const int t = 16 * (tb + tt) + i16, s0 = 16 * si + 4 * g; f32x4 v = pa[tt];
#pragma unroll
                        for (int r = 0; r < 4; ++r) v[r] = (s0 + r <= t) ? v[r] : 0.f;
                        u32x2 wv; wv.x = pk2(v[0], v[1]); wv.y = pk2(v[2], v[3]); *(LAS u32x2*)(lds + GL_PL + t * KS_STR + s0 * 2) = wv; } }
                __syncthreads();
                {
#pragma unroll
                    for (int c = 0; c < 4; ++c) { const f32x4 e0 = *(const LAS f32x4*)(lds + GL_EM + (32 * c + 4 * g) * 4), e1 = *(const LAS f32x4*)(lds + GL_EM + (32 * c + 16 + 4 * g) * 4);
                        const f32x4 a0 = S[2 * c] * e0, b0 = S[2 * c + 1] * e1; u32x4 r; r.x = pk2(a0[0], a0[1]); r.y = pk2(a0[2], a0[3]); r.z = pk2(b0[0], b0[1]); r.w = pk2(b0[2], b0[3]); const bf16x8 Sb = __builtin_bit_cast(bf16x8, r);
#pragma unroll
                        for (int ti = 0; ti < 4; ++ti) { const LAS unsigned char* qa = lds + GL_QT + troff + (32 * c) * KT_STR + (16 * ti) * 2; const bf16x8 a = cat8(lds_tr(qa), lds_tr(qa + 16 * KT_STR));
                            O[ti] = __builtin_amdgcn_mfma_f32_16x16x32_bf16(a, Sb, O[ti], 0, 0, 0); }
                        asm volatile("" ::: "memory"); } }
                bf16x8 Vf[2]; gla_load_vf(Vf, lds, w, i16, g);
#pragma unroll
                for (int ti = 0; ti < 4; ++ti) {
#pragma unroll
                    for (int c2 = 0; c2 < 2; ++c2) { const bf16x8 a = lds_pair64(lds + GL_PL + (16 * ti + i16) * KS_STR + (32 * c2 + 4 * g) * 2, 32);
                        O[ti] = __builtin_amdgcn_mfma_f32_16x16x32_bf16(a, Vf[c2], O[ti], 0, 0, 0); }
                    if (ti & 1) asm volatile("" ::: "memory"); }
                gla_state_update(S, Vf, lds, i16, g);
                if (dir == 0) {
                    float* ob = OFL + ((size_t)((unit * 8 + n) * 8 + w) * 4) * 256 + lane * 4;
#pragma unroll
                    for (int ti = 0; ti < 4; ++ti) *(f32x4*)(ob + ti * 256) = O[ti];
                    __syncthreads();
                } else {
                    float part[4][4];
#pragma unroll
                    for (int ti = 0; ti < 4; ++ti)
#pragma unroll
                        for (int r = 0; r < 4; ++r) { const float o = O[ti][r]; part[ti][r] = row16_sum(o * o); }
                    unsigned short gq[4][4];
#pragma unroll
                    for (int ti = 0; ti < 4; ++ti)
#pragma unroll
                        for (int r = 0; r < 4; ++r) { const bf16_t* gb = G + (size_t)(rb + 51 - 16 * ti - r) * DM + h * 128 + 16 * w; gq[ti][r] = gb[loff]; }
                    if (i16 == 0) {
#pragma unroll
                        for (int ti = 0; ti < 4; ++ti) *(LAS f32x4*)(lds + GL_SSQ + (w * 64 + 16 * ti + 4 * g) * 4) = (f32x4){part[ti][0], part[ti][1], part[ti][2], part[ti][3]}; }
                    __syncthreads();
                    if (tid < 64) { float s2 = 0.f;
#pragma unroll
                        for (int ww = 0; ww < 8; ++ww) s2 += ((const LAS float*)(lds + GL_SSQ))[ww * 64 + tid];
                        ((LAS float*)(lds + GL_RSTD))[tid] = 1.f / sqrtf(s2 * (1.f / 128.f) + 1e-6f); }
                    __syncthreads();
#pragma unroll
                    for (int ti = 0; ti < 4; ++ti) { const f32x4 rs = *(const LAS f32x4*)(lds + GL_RSTD + (16 * ti + 4 * g) * 4);
#pragma unroll
                        for (int r = 0; r < 4; ++r) *(LAS unsigned short*)(lds + GL_QT + (63 - (16 * ti + 4 * g + r)) * ON_STR + (16 * w + i16) * 2) = (unsigned short)f2bf(O[ti][r] * rs[r] * ngv * bf2f(gq[ti][r])); }
                    on_rb = rb;
                }
            }
            if (on_rb >= 0) { __syncthreads(); GLA_ON_FLUSH(); on_rb = -1; }
            asm volatile("s_waitcnt vmcnt(0)" ::: "memory");
            __syncthreads();
        }
    }
}

__device__ __forceinline__ void ph_modffn(const Params& p, unsigned char* lds, int bid, int nblk, int l) {
    int tid_ = threadIdx.x; asm volatile("" : "+v"(tid_));
    const int tid = tid_, lane = tid & 63, wave = tid >> 6;
    float* rw = (float*)lds;
    float* stg = (float*)(lds + 71680);
    const float* router = p.in[I_ROUTER] + (size_t)l * DM * NE;
    for (int i = tid; i < DM * NE / 4; i += NTHR) { const int d = i >> 2; *(f32x4*)(rw + d * 16 + (d >> 2) * 4 + (i & 3) * 4) = ((const f32x4*)router)[i]; }
    __syncthreads();
    const float* X = (const float*)(p.ws + WS_X); bf16_t* H = (bf16_t*)(p.ws + WS_H); float* aff = (float*)(p.ws + WS_AFF); int* slot = (int*)(p.ws + WS_SLOT);
    const float* g = p.in[I_NFFN] + (size_t)l * DM; const float* mod = (const float*)(p.ws + WS_MOD);
    for (int base = bid * 64; base < NTOK; base += nblk * 64) {
        const int b = base >> 13, t0 = base & (SEQ - 1);
        const float* mv = mod + (size_t)(l * 3 + b) * NADA; const float* sh = mv + 3 * DM; const float* sc = mv + 4 * DM;
        f32x4 nxv[4];
#pragma unroll
        for (int j = 0; j < 4; ++j) nxv[j] = *(const f32x4*)(X + (size_t)(base + 8 * wave) * DM + 256 * j + 4 * lane);
#pragma unroll 1
        for (int r = 0; r < 8; ++r) {
            const int row = base + 8 * wave + r;
            f32x4 v[4]; float ss = 0.f;
#pragma unroll
            for (int j = 0; j < 4; ++j) { v[j] = nxv[j]; ss += (v[j][0] * v[j][0] + v[j][1] * v[j][1]) + (v[j][2] * v[j][2] + v[j][3] * v[j][3]); }
            if (r < 7) {
#pragma unroll
                for (int j = 0; j < 4; ++j) nxv[j] = *(const f32x4*)(X + (size_t)(row + 1) * DM + 256 * j + 4 * lane); }
            const float rstd = 1.f / sqrtf(wave_sum(ss) * (1.f / DM) + 1e-6f);
            float lg[16];
#pragma unroll
            for (int e = 0; e < 16; ++e) lg[e] = 0.f;
#pragma unroll
            for (int j = 0; j < 4; ++j) { const int c0 = 256 * j + 4 * lane; const f32x4 gv = *(const f32x4*)(g + c0), shv = *(const f32x4*)(sh + c0), scv = *(const f32x4*)(sc + c0);
                f32x4 h;
#pragma unroll
                for (int i = 0; i < 4; ++i) { h[i] = (v[j][i] * rstd * gv[i]) * (1.f + scv[i]) + shv[i];
                    const float* rp = rw + (c0 + i) * 16 + (c0 >> 2) * 4; const f32x4 r0 = *(const f32x4*)(rp), r1 = *(const f32x4*)(rp + 4), r2 = *(const f32x4*)(rp + 8), r3 = *(const f32x4*)(rp + 12);
#pragma unroll
                    for (int e = 0; e < 4; ++e) { lg[e] += h[i] * r0[e]; lg[4 + e] += h[i] * r1[e]; lg[8 + e] += h[i] * r2[e]; lg[12 + e] += h[i] * r3[e]; }
                    asm volatile("" ::: "memory"); }
                u32x2 w; w.x = pk2(h[0], h[1]); w.y = pk2(h[2], h[3]); *(u32x2*)(H + (size_t)row * DM + c0) = w; }
            float a8[8], a4[4], a2[2], a1;
            { const bool hi = (lane & 32) != 0;
#pragma unroll
                for (int i = 0; i < 8; ++i) { const float send = hi ? lg[i] : lg[8 + i], keep = hi ? lg[8 + i] : lg[i]; a8[i] = keep + __shfl_xor(send, 32); } }
            { const bool hi = (lane & 16) != 0;
#pragma unroll
                for (int i = 0; i < 4; ++i) { const float send = hi ? a8[i] : a8[4 + i], keep = hi ? a8[4 + i] : a8[i]; a4[i] = keep + __shfl_xor(send, 16); } }
            { const bool hi = (lane & 8) != 0;
#pragma unroll
                for (int i = 0; i < 2; ++i) { const float send = hi ? a4[i] : a4[2 + i], keep = hi ? a4[2 + i] : a4[i]; a2[i] = keep + __shfl_xor(send, 8); } }
            { const bool hi = (lane & 4) != 0; const float send = hi ? a2[0] : a2[1], keep = hi ? a2[1] : a2[0]; a1 = keep + __shfl_xor(send, 4); }
            a1 += dpp_f<0x4E>(a1); a1 += dpp_f<0xB1>(a1);
            float mx = a1;
            mx = fmaxf(mx, __shfl_xor(mx, 4)); mx = fmaxf(mx, __shfl_xor(mx, 8)); mx = fmaxf(mx, __shfl_xor(mx, 16)); mx = fmaxf(mx, __shfl_xor(mx, 32));
            const float ex = expf(a1 - mx); float den = ex;
            den += __shfl_xor(den, 4); den += __shfl_xor(den, 8); den += __shfl_xor(den, 16); den += __shfl_xor(den, 32);
            if ((lane & 3) == 0) stg[((lane >> 2) & 15) * 64 + 8 * wave + r] = ex / den;
        }
        __syncthreads();
        { const int e = tid >> 5, tt = (tid & 31) * 2; *(f32x2*)(aff + (size_t)(b * NE + e) * SEQ + t0 + tt) = *(const f32x2*)(stg + e * 64 + tt);
            *(u32x2*)(slot + (size_t)base * NE + 2 * tid) = (u32x2){0xffffffffu, 0xffffffffu}; }
        __syncthreads();
    }
}

__device__ __forceinline__ void ph_topk(const Params& p, unsigned char* lds, int bid, int nblk) {
    int tid_ = threadIdx.x; asm volatile("" : "+v"(tid_)); const int tid = tid_, lane = tid & 63, wave = tid >> 6;
    unsigned* hist = (unsigned*)lds;
    unsigned* ctl = hist + 256;
    unsigned* wsum = ctl + 8;
    const float* aff = (const float*)(p.ws + WS_AFF); int* topi = (int*)(p.ws + WS_TOPI); float* topg = (float*)(p.ws + WS_TOPG); int* slot = (int*)(p.ws + WS_SLOT);
    for (int it = bid; it < NB * NE; it += nblk) {
        const int b = it >> 4, e = it & 15; const float* src = aff + (size_t)it * SEQ + 16 * tid;
        unsigned key[16];
#pragma unroll
        for (int j = 0; j < 4; ++j) { const f32x4 v = *(const f32x4*)(src + 4 * j); key[4 * j] = __float_as_uint(v[0]); key[4 * j + 1] = __float_as_uint(v[1]); key[4 * j + 2] = __float_as_uint(v[2]); key[4 * j + 3] = __float_as_uint(v[3]); }
        unsigned prefix = 0u;
#pragma unroll 1
        for (int bit = 30; bit >= 0; --bit) {
            const unsigned cand = prefix | (1u << bit);
            unsigned cnt = 0u;
#pragma unroll
            for (int i = 0; i < 16; ++i) cnt += (unsigned)__popcll(__ballot(key[i] >= cand));
            if (lane == 0) wsum[(bit & 1) * 8 + wave] = cnt;
            __syncthreads();
            unsigned tot = 0u;
#pragma unroll
            for (int w2 = 0; w2 < 8; ++w2) tot += wsum[(bit & 1) * 8 + w2];
            if (tot >= (unsigned)CAP) prefix = cand;
        }
        __syncthreads();
        unsigned cg = 0u, ce = 0u;
#pragma unroll
        for (int i = 0; i < 16; ++i) { cg += key[i] > prefix ? 1u : 0u; ce += key[i] == prefix ? 1u : 0u; }
        unsigned pk = cg | (ce << 16), inc = pk;
#pragma unroll
        for (int o = 1; o < 64; o <<= 1) { const unsigned t = __shfl_up(inc, o); if (lane >= o) inc += t; }
        if (lane == 63) wsum[wave] = inc;
        __syncthreads();
        unsigned base = 0u, total = 0u;
#pragma unroll
        for (int w2 = 0; w2 < 8; ++w2) { const unsigned t = wsum[w2]; if (w2 < wave) base += t; total += t; }
        const unsigned excl = base + inc - pk;
        unsigned rg = excl & 0xffffu, re = excl >> 16; const unsigned ngt = total & 0xffffu, kth = (unsigned)CAP - ngt;
#pragma unroll
        for (int i = 0; i < 16; ++i) { int s = -1;
            if (key[i] > prefix) { s = (int)rg; ++rg; }
            else if (key[i] == prefix) { if (re < kth) s = (int)(ngt + re); ++re; }
            if (s >= 0) { const int idx = 16 * tid + i, r = (e * NB + b) * CAP + s; topi[r] = b * SEQ + idx; topg[r] = __uint_as_float(key[i]); slot[(size_t)(b * SEQ + idx) * NE + e] = s; } }
        __syncthreads();
    }
}

__device__ __forceinline__ void ph_combine(const Params& p, int bid, int nblk, int l, bool final_) {
    int tid_ = threadIdx.x; asm volatile("" : "+v"(tid_));
    const int tid = tid_, lane = tid & 63, wave = tid >> 6, gw = bid * 8 + wave, NGW = nblk * 8;
    float* X = (float*)(p.ws + WS_X); bf16_t* H = (bf16_t*)(p.ws + WS_H); const bf16_t* Y = (const bf16_t*)(p.ws + WS_Y); const int* slot = (const int*)(p.ws + WS_SLOT);
    const float* mod = (const float*)(p.ws + WS_MOD);
    int nslot = -1; f32x4 nxv[4];
    if (gw < NTOK) { nslot = lane < 16 ? slot[(size_t)gw * NE + lane] : -1;
#pragma unroll
        for (int j = 0; j < 4; ++j) nxv[j] = *(const f32x4*)(X + (size_t)gw * DM + 256 * j + 4 * lane); }
    for (int row = gw; row < NTOK; row += NGW) {
        const int b = row >> 13;
        const float* g2 = mod + (size_t)(l * 3 + b) * NADA + 5 * DM;
        const int myslot = nslot; f32x4 xv[4];
#pragma unroll
        for (int j = 0; j < 4; ++j) xv[j] = nxv[j];
        unsigned long long m = __ballot(myslot >= 0) & 0xffffull;
        f32x4 a[4];
#pragma unroll
        for (int j = 0; j < 4; ++j) a[j] = (f32x4){0.f, 0.f, 0.f, 0.f};
        u32x2 ya[4], yb[4];
#define YLOAD(dst, e_) do { const int s_ = __shfl(myslot, (e_)); const bf16_t* yr_ = Y + (size_t)(((e_) * NB + b) * CAP + s_) * DM; \
            _Pragma("unroll") for (int j = 0; j < 4; ++j) dst[j] = *(const u32x2*)(yr_ + 256 * j + 4 * lane); } while (0)
        if (m) { const int e0 = __builtin_ctzll(m); m &= m - 1; YLOAD(ya, e0); }
        const bool any = __ballot(myslot >= 0) & 0xffffull;
        { const int r2 = row + NGW; if (r2 < NTOK) { nslot = lane < 16 ? slot[(size_t)r2 * NE + lane] : -1;
#pragma unroll
            for (int j = 0; j < 4; ++j) nxv[j] = *(const f32x4*)(X + (size_t)r2 * DM + 256 * j + 4 * lane); } }
        if (any) for (;;) {
            const bool more = m != 0ull;
            if (more) { const int e1 = __builtin_ctzll(m); m &= m - 1; YLOAD(yb, e1); }
#pragma unroll
            for (int j = 0; j < 4; ++j) { a[j][0] += __uint_as_float(ya[j].x << 16); a[j][1] += __uint_as_float(ya[j].x & 0xffff0000u); a[j][2] += __uint_as_float(ya[j].y << 16); a[j][3] += __uint_as_float(ya[j].y & 0xffff0000u); }
            if (!more) break;
#pragma unroll
            for (int j = 0; j < 4; ++j) ya[j] = yb[j];
        }
#undef YLOAD
        f32x4 v[4]; float ss = 0.f;
#pragma unroll
        for (int j = 0; j < 4; ++j) { const int c0 = 256 * j + 4 * lane; v[j] = xv[j] + *(const f32x4*)(g2 + c0) * a[j];
            ss += (v[j][0] * v[j][0] + v[j][1] * v[j][1]) + (v[j][2] * v[j][2] + v[j][3] * v[j][3]); }
        const float rstd = 1.f / sqrtf(wave_sum(ss) * (1.f / DM) + 1e-6f);
        if (final_) { const float* gf = p.in[I_NFIN];
#pragma unroll
            for (int j = 0; j < 4; ++j) { const int c0 = 256 * j + 4 * lane; const f32x4 gv = *(const f32x4*)(gf + c0); *(f32x4*)(p.out + (size_t)row * DM + c0) = v[j] * rstd * gv; }
        } else {
#pragma unroll
            for (int j = 0; j < 4; ++j) *(f32x4*)(X + (size_t)row * DM + 256 * j + 4 * lane) = v[j];
            const float* mv = mod + (size_t)((l + 1) * 3 + b) * NADA;
            store_mod_bf16(H + (size_t)row * DM, v, rstd, p.in[I_NMIX] + (size_t)(l + 1) * DM, mv, mv + DM, lane);
        }
    }
}

__device__ __forceinline__ void ph_conv(const Params& p, int bid, int nblk) {
    int tid_ = threadIdx.x; asm volatile("" : "+v"(tid_));
    const int tid = tid_, lane = tid & 63, wave = tid >> 6, gw = bid * 8 + wave, NGW = nblk * 8;
    const bf16_t* BG = (const bf16_t*)(p.ws + WS_BG); const bf16_t* CU = (const bf16_t*)(p.ws + WS_CU); bf16_t* Z = (bf16_t*)(p.ws + WS_Z);
    const float* wc = p.in[I_SCCONV];
    for (int row = gw; row < NTOK; row += NGW) { const int t = row & (SEQ - 1);
#pragma unroll
        for (int hh = 0; hh < 2; ++hh) { const int c0 = hh * 512 + 8 * lane; const size_t off = (size_t)row * DM + c0;
            const u16x8 z0 = {0, 0, 0, 0, 0, 0, 0, 0};
            const u16x8 um = t > 0 ? *(const u16x8*)(CU + off - DM) : z0, u0 = *(const u16x8*)(CU + off), up = t < SEQ - 1 ? *(const u16x8*)(CU + off + DM) : z0, bg = *(const u16x8*)(BG + off);
            float o[8];
#pragma unroll
            for (int i = 0; i < 8; ++i) o[i] = bf2f(bg[i]) * (wc[c0 + i] * bf2f(um[i]) + wc[DM + c0 + i] * bf2f(u0[i]) + wc[2 * DM + c0 + i] * bf2f(up[i]));
            u32x4 w; w.x = pk2(o[0], o[1]); w.y = pk2(o[2], o[3]); w.z = pk2(o[4], o[5]); w.w = pk2(o[6], o[7]); *(u32x4*)(Z + off) = w; }
    }
}

#define XB_TMO      128
#define XB_XCNT(j)  (256  + 64 * (j))
#define XB_XSUB(j)  (1280 + 64 * (j))
#define XB_XGEN(j)  (2304 + 64 * (j))
#define XB_TOP      3328
#define XB_TOPGEN   3392
#define XCD_BAR_WORDS 3456
#define XB_SPIN_CAP (1u << 18)
__device__ __forceinline__ unsigned xb_ld(unsigned* p)              { return __hip_atomic_load(p, __ATOMIC_RELAXED, __HIP_MEMORY_SCOPE_AGENT); }
__device__ __forceinline__ unsigned xb_add(unsigned* p, unsigned v) { return __hip_atomic_fetch_add(p, v, __ATOMIC_RELAXED, __HIP_MEMORY_SCOPE_AGENT); }
__device__ __forceinline__ unsigned xb_xcc_id() { return (unsigned)__builtin_amdgcn_s_getreg((3 << 11) | 20) & 0xFu; }
#define XB_SPIN(cond, bar) do { unsigned _sp = 0; while (cond) { __builtin_amdgcn_s_sleep(1); \
    if ((++_sp & 255u) == 0u) { if (xb_ld(&(bar)[XB_TMO])) break; if (_sp > XB_SPIN_CAP) { atomicAdd(&(bar)[XB_TMO], 1u); break; } } } } while (0)
struct XcdBarrier { unsigned* bar; unsigned x; volatile LAS unsigned* st; };
__device__ __forceinline__ XcdBarrier xcd_barrier_post(unsigned* bar, volatile LAS unsigned* st) {
    XcdBarrier b; b.bar = bar; b.x = xb_xcc_id(); b.st = st;
    if (threadIdx.x == 0) (void)xb_add(&bar[XB_XCNT(b.x)], 1u);
    return b;
}
__device__ __forceinline__ void xcd_barrier_complete(unsigned* bar, unsigned x, unsigned& nloc, unsigned& nx) {
    const unsigned G = gridDim.x * gridDim.y * gridDim.z;
    unsigned sum, cnt, mine, sp = 0u;
    for (;;) {
        sum = 0u; cnt = 0u; mine = 0u;
#pragma unroll
        for (unsigned j = 0; j < 16; ++j) { const unsigned c = xb_ld(&bar[XB_XCNT(j)]); sum += c; cnt += (c > 0u) ? 1u : 0u; mine = (j == x) ? c : mine; }
        if (sum == G) break;
        __builtin_amdgcn_s_sleep(1);
        if ((++sp & 255u) == 0u) { if (xb_ld(&bar[XB_TMO])) break; if (sp > XB_SPIN_CAP) { atomicAdd(&bar[XB_TMO], 1u); break; } }
    }
    nloc = mine > 0u ? mine : 1u; nx = cnt > 0u ? cnt : 1u;
}
__device__ __forceinline__ void xcd_barrier(unsigned* bar_, volatile LAS unsigned* st_) {
    XcdBarrier b; b.bar = bar_; b.x = xb_xcc_id(); b.st = st_;
    asm volatile("s_waitcnt vmcnt(0)" ::: "memory");
    __syncthreads();
    if (threadIdx.x == 0) {
        unsigned* bar = b.bar;
        __builtin_amdgcn_s_waitcnt(0);
        unsigned nloc = b.st[0], nx = b.st[1];
        if (nloc == 0u) { xcd_barrier_complete(bar, b.x, nloc, nx); b.st[0] = nloc; b.st[1] = nx; }
        const unsigned epoch = b.st[2] + 1u; b.st[2] = epoch;
        const unsigned old = xb_add(&bar[XB_XSUB(b.x)], 1u);
        if (old + 1u == epoch * nloc) {
            __builtin_amdgcn_fence(__ATOMIC_RELEASE, "agent");
            asm volatile("s_waitcnt vmcnt(0)" ::: "memory");
            (void)xb_add(&bar[XB_TOP], 1u);
        }
        XB_SPIN(xb_ld(&bar[XB_TOP]) < epoch * nx, bar);
        __builtin_amdgcn_fence(__ATOMIC_ACQUIRE, "agent");
        asm volatile("s_waitcnt vmcnt(0)" ::: "memory");
    }
    __syncthreads();
}

constexpr int NPHASE = 19;
constexpr int CV_A1 = 232 * 32, CV_A2 = CV_A1 + 224 * 24, CV_A3 = CV_A2 + 224 * 24, CV_B1 = 224 * 24, CV_ALL = 49152;
constexpr int MISC_OFF = 146944;
constexpr int CW_BAR = 4096;
constexpr int CW_CTX = 1024;
template <int LO, int HI> __global__ void __launch_bounds__(NTHR, 2) mega(Params p) {
    extern __shared__ __attribute__((aligned(16))) unsigned char lds[];
    const int bid = blockIdx.x, nblk = gridDim.x;
    PG8_LAS unsigned char* l3 = (PG8_LAS unsigned char*)lds;
    unsigned char* ws = p.ws;
    const float* mod = (const float*)(ws + WS_MOD);
    constexpr bool MULTI = (HI - LO) > 1;
    if (MULTI) {
        volatile LAS unsigned* MISC = (volatile LAS unsigned*)(l3 + MISC_OFF);
        if (threadIdx.x < 32) MISC[threadIdx.x] = 0u;
        __syncthreads();
        (void)xcd_barrier_post((unsigned*)(ws + WS_CTL) + CW_BAR, MISC + 8);
    }
#define IN(k) (LO <= (k) && (k) < HI)
#ifndef PROBE_DUP
#define PROBE_DUP 0u
#endif
#define DUPQ(k) (((PROBE_DUP) >> (k)) & 1u)
#define BARRIER_NOW() xcd_barrier((unsigned*)(p.ws + WS_CTL) + CW_BAR, (volatile LAS unsigned*)(l3 + MISC_OFF) + 8)
#define SEAM(k) do { if (IN(k) && IN((k) + 1)) xcd_barrier((unsigned*)(p.ws + WS_CTL) + CW_BAR, (volatile LAS unsigned*)(l3 + MISC_OFF) + 8); } while (0)
#define PHASE(k, ...) do { if (IN(k)) { __VA_ARGS__; if (DUPQ(k)) { BARRIER_NOW(); __VA_ARGS__; } } SEAM(k); } while (0)
#define GEMM_INPROJ() do { pg8::Gemm g{(const bf16_t*)(ws + WS_H), (const bf16_t*)(ws + WS_WHGIN), NTOK, 5120, DM}; pg8::StaticOrder S; S.init(NTOK, 5120, nblk, bid, 0); EpiInProj E{ws}; pg8::gemm_phase<EpiInProj, pg8::StaticOrder, false>(l3, g, S, E, nullptr); } while (0)
#define GEMM_OUT(AOFF, WOFF, GATE) do { pg8::Gemm g{(const bf16_t*)(ws + (AOFF)), (const bf16_t*)(ws + (WOFF)), NTOK, DM, DM}; pg8::StaticOrder S; S.init(NTOK, DM, nblk, bid, 0); EpiResid E{(float*)(ws + WS_X), (GATE)}; pg8::gemm_phase<EpiResid, pg8::StaticOrder, false>(l3, g, S, E, nullptr); } while (0)
#define GEMM_MOE1(l) do { pg8::Gemm g{(const bf16_t*)(ws + WS_H), (const bf16_t*)(ws + WS_WMOE1) + (size_t)(l) * NE * 4096 * DM, NSLOT, 4096, DM}; pg8::StaticOrder S; S.init(NSLOT, 4096, nblk, bid, 8); EpiGLU E{(bf16_t*)(ws + WS_ACT)}; pg8::gemm_phase<EpiGLU, pg8::StaticOrder, true>(l3, g, S, E, (const int*)(ws + WS_TOPI)); } while (0)
#define GEMM_MOE2(l) do { pg8::Gemm g{(const bf16_t*)(ws + WS_ACT), (const bf16_t*)(ws + WS_WMOE2) + (size_t)(l) * NE * DM * DE, NSLOT, DM, DE}; pg8::StaticOrder S; S.init(NSLOT, DM, nblk, bid, 8); EpiRowScale E{(bf16_t*)(ws + WS_Y), (const float*)(ws + WS_TOPG)}; pg8::gemm_phase<EpiRowScale, pg8::StaticOrder, false>(l3, g, S, E, nullptr); } while (0)
#define GEMM_CONVIN() do { pg8::Gemm g{(const bf16_t*)(ws + WS_H), (const bf16_t*)(ws + WS_WSCIN), NTOK, 3072, DM}; pg8::StaticOrder S; S.init(NTOK, 3072, nblk, bid, 0); EpiConvIn E{(bf16_t*)(ws + WS_BG), (bf16_t*)(ws + WS_CU)}; pg8::gemm_phase<EpiConvIn, pg8::StaticOrder, false>(l3, g, S, E, nullptr); } while (0)
#define MOD0_PHASE() do { if (nblk >= 48) { if (bid < 24) { ph_mod0(p, NTOK + (bid * NCTX) / 24, NTOK + ((bid + 1) * NCTX) / 24, 0, 1); \
              \
            asm volatile("s_waitcnt vmcnt(0)" ::: "memory"); __syncthreads(); \
            if (threadIdx.x == 0) { unsigned* cnt = (unsigned*)(p.ws + WS_CTL) + CW_CTX; __builtin_amdgcn_fence(__ATOMIC_RELEASE, "agent"); asm volatile("s_waitcnt vmcnt(0)" ::: "memory"); \
                xb_add(cnt, 1u); unsigned sp_ = 0u; while (xb_ld(cnt) < 24u) { __builtin_amdgcn_s_sleep(1); if (++sp_ > (1u << 22)) break; } \
                __builtin_amdgcn_fence(__ATOMIC_ACQUIRE, "agent"); asm volatile("s_waitcnt vmcnt(0)" ::: "memory"); } \
            __syncthreads(); \
            pg8::Gemm g{(const bf16_t*)(ws + WS_H), (const bf16_t*)(ws + WS_WHGIN), NROW, 5120, DM}; pg8::OneUnit S{64 + bid / 12, 4 + bid % 12}; EpiInProj E{ws}; pg8::gemm_phase<EpiInProj, pg8::OneUnit, false>(l3, g, S, E, nullptr); } \
          else { ph_mod0(p, 0, NTOK, bid - 24, nblk - 24); if (nblk > 64) { __syncthreads(); convert_moe_slice(p, lds, bid - 24, nblk - 24, 0, 0, CV_A1); } } } \
        else { ph_mod0(p, 0, NROW, bid, nblk); } } while (0)
#define CTX_TILES_FALLBACK() do { if (nblk < 48) { BARRIER_NOW(); pg8::Gemm g{(const bf16_t*)(ws + WS_H), (const bf16_t*)(ws + WS_WHGIN), NROW, 5120, DM}; \
        for (int ti = bid; ti < 24; ti += nblk) { pg8::OneUnit S{64 + ti / 12, 4 + ti % 12}; EpiInProj E{ws}; pg8::gemm_phase<EpiInProj, pg8::OneUnit, false>(l3, g, S, E, nullptr); } } } while (0)
    PHASE(0, ph_prep(p, lds, bid, nblk); __syncthreads(); ph_convert_small(p, lds, bid, nblk));
    if (IN(1)) { MOD0_PHASE(); CTX_TILES_FALLBACK(); }
    SEAM(1);
#define HOSTED(GEMM_RANGE, NR, LAYER, ILO, IHI) do { const bool odd_ = (bid & 1) != 0; \
        if (odd_) convert_moe_slice(p, lds, bid, nblk, LAYER, ILO, IHI); \
        GEMM_RANGE(0, NR); __syncthreads(); \
        if (!odd_) convert_moe_slice(p, lds, bid, nblk, LAYER, ILO, IHI); } while (0)
#define GEMM_INPROJ_R(LO_, HI_) do { pg8::Gemm g{(const bf16_t*)(ws + WS_H), (const bf16_t*)(ws + WS_WHGIN), NTOK, 5120, DM}; pg8::RangeOrder S; S.S.init(NTOK, 5120, nblk, bid, 0); S.lo = (LO_); S.hi = (HI_); EpiInProj E{ws}; pg8::gemm_phase<EpiInProj, pg8::RangeOrder, false>(l3, g, S, E, nullptr); } while (0)
#define GEMM_MOE1_R0(LO_, HI_) do { pg8::Gemm g{(const bf16_t*)(ws + WS_H), (const bf16_t*)(ws + WS_WMOE1), NSLOT, 4096, DM}; pg8::RangeOrder S; S.S.init(NSLOT, 4096, nblk, bid, 8); S.lo = (LO_); S.hi = (HI_); EpiGLU E{(bf16_t*)(ws + WS_ACT)}; pg8::gemm_phase<EpiGLU, pg8::RangeOrder, true>(l3, g, S, E, (const int*)(ws + WS_TOPI)); } while (0)
    PHASE(2, HOSTED(GEMM_INPROJ_R, 5, 0, (nblk > 64 ? CV_A3 : 0), CV_ALL));
    PHASE(3, ph_gla_states(p, lds, bid, nblk); if (nblk > 64 && bid >= 32) { __syncthreads(); convert_moe_slice(p, lds, bid - 32, nblk - 32, 0, CV_A1, CV_A2); });
    PHASE(4, ph_gla_out(p, lds, bid, nblk));
    if (IN(5)) GEMM_OUT(WS_ON, WS_WHGOUT, mod + 2 * DM);
    SEAM(5);
    PHASE(6, ph_modffn(p, lds, bid, nblk, 0));
    PHASE(7, if (nblk > 64 && bid >= 32) convert_moe_slice(p, lds, bid - 32, nblk - 32, 0, CV_A2, CV_A3); else ph_topk(p, lds, bid, nblk));
    PHASE(8, HOSTED(GEMM_MOE1_R0, 8, 1, (nblk > 64 ? CV_B1 : 0), CV_ALL));
    PHASE(9, GEMM_MOE2(0));
    if (IN(10)) ph_combine(p, bid, nblk, 0, false);
    SEAM(10);
    PHASE(11, GEMM_CONVIN());
    PHASE(12, ph_conv(p, bid, nblk));
    if (IN(13)) GEMM_OUT(WS_Z, WS_WSCOUT, mod + (size_t)3 * NADA + 2 * DM);
    SEAM(13);
    PHASE(14, ph_modffn(p, lds, bid, nblk, 1));
    PHASE(15, if (nblk > 64 && bid >= 32) convert_moe_slice(p, lds, bid - 32, nblk - 32, 1, 0, CV_B1); else ph_topk(p, lds, bid, nblk));
    PHASE(16, GEMM_MOE1(1));
    PHASE(17, GEMM_MOE2(1));
    if (IN(18)) ph_combine(p, bid, nblk, 1, true);
#undef IN
#undef SEAM
}

#ifndef MK_SPLIT
#define MK_SPLIT 0
#endif
#if MK_SPLIT
#include <utility>
template <int... I> static void launch_all(std::integer_sequence<int, I...>, int grid, Params& p, hipStream_t stream) {
    ((void)hipFuncSetAttribute((const void*)mega<I, I + 1>, hipFuncAttributeMaxDynamicSharedMemorySize, LDS_BYTES), ...);
    ((mega<I, I + 1><<<dim3(grid), dim3(NTHR), LDS_BYTES, stream>>>(p)), ...); }
#endif
extern "C" void kernel_launch(void* const* d_in, const int* in_sizes, int n_in, void* d_out, int out_size, void* d_ws, size_t ws_size, hipStream_t stream) {
    static int grid = 0;
    if (grid == 0) {
        if (n_in != 20 || ws_size < WS_END) { fprintf(stderr, "kernel_launch: unexpected inputs (n_in %d, ws %zu, need %zu)\n", n_in, ws_size, (size_t)WS_END); grid = -1; return; }
        int dev = 0, cus = 0, per_cu = 0;
        (void)hipGetDevice(&dev); (void)hipDeviceGetAttribute(&cus, hipDeviceAttributeMultiprocessorCount, dev);
        (void)hipFuncSetAttribute((const void*)mega<0, NPHASE>, hipFuncAttributeMaxDynamicSharedMemorySize, LDS_BYTES);
        if (hipOccupancyMaxActiveBlocksPerMultiprocessor(&per_cu, (const void*)mega<0, NPHASE>, NTHR, LDS_BYTES) != hipSuccess || per_cu < 1) { fprintf(stderr, "kernel_launch: occupancy query failed (%d)\n", per_cu); per_cu = 1; }
        (void)hipGetLastError();
        if (per_cu > 1) per_cu = 1;
        grid = (cus > 0 ? cus : 256) * per_cu;
    }
    if (grid < 0) return;
    Params p{};
    for (int i = 0; i < 20; ++i) p.in[i] = (const float*)d_in[i];
    p.out = (float*)d_out; p.ws = (unsigned char*)d_ws;
#if MK_SPLIT
    launch_all(std::make_integer_sequence<int, NPHASE>{}, grid, p, stream);
#else
    (void)hipMemsetAsync((char*)d_ws + WS_CTL, 0, 65536, stream);
    void* args[] = {&p};
    hipError_t e = hipLaunchCooperativeKernel((const void*)mega<0, NPHASE>, dim3(grid), dim3(NTHR), args, LDS_BYTES, stream);
    if (e != hipSuccess) fprintf(stderr, "kernel_launch: cooperative launch failed: %s (grid %d)\n", hipGetErrorString(e), grid);
#endif
}
```

```cpp
#include <hip/hip_runtime.h>
#include <cstdio>
#include <cstdint>

namespace pg8 {
#define PG8_LAS __attribute__((address_space(3)))
typedef unsigned short bf16_t;
typedef short bf16x8 __attribute__((ext_vector_type(8)));
typedef float f32x4 __attribute__((ext_vector_type(4)));
typedef unsigned u32x4 __attribute__((ext_vector_type(4)));
typedef unsigned u32x2 __attribute__((ext_vector_type(2)));
constexpr int BM = 256, BK = 64, HALF = 128, HTB = HALF * BK * 2, STAGE_BYTES = 8 * HTB, NXCD = 8, WGM = 8;

__host__ __device__ __forceinline__ int lds_byte(int r, int c) { const int st = (r >> 4) * 2 + (c >> 5), rr = r & 15, cc = c & 31, ob = rr * 64 + cc * 2; return st * 1024 + (ob ^ (((ob >> 9) & 1) << 5)); }
__host__ __device__ __forceinline__ void stage_rc(int b, int& R, int& C) { const int st = b / 1024, sb = b % 1024, swz = sb ^ (((sb >> 9) & 1) << 5); R = (st >> 1) * 16 + swz / 64; C = (st & 1) * 32 + (swz % 64) / 2; }
__host__ __device__ __forceinline__ int perm32(int rho) { const int n = rho >> 4, i = rho & 15; return 8 * (i >> 2) + 4 * n + (i & 3); }

struct Unit { int pm, pn, pb; };
struct Gemm { const bf16_t* A; const bf16_t* Bt; int M, N, K; };

struct StaticOrder {
    int nM, nN, nwg, G, c, mpe;
    __device__ void init(int M, int N, int G_, int c_, int mpe_) { nM = M / BM; nN = N / BM; nwg = nM * nN; G = G_; c = c_; mpe = mpe_; }
    __device__ bool next(int i, Unit& u) const {
        const long L = (long)i * G + c; if (L >= nwg) return false;
        int wgid = (int)L; { const int q = nwg / NXCD, r = nwg % NXCD, xcd = wgid % NXCD, off = wgid / NXCD; wgid = (xcd < r ? xcd * (q + 1) : r * (q + 1) + (xcd - r) * q) + off; }
        const int nig = WGM * nN, gid = wgid / nig, fm = gid * WGM, gsz = (nM - fm) < WGM ? (nM - fm) : WGM;
        u.pm = fm + ((wgid % nig) % gsz); u.pn = (wgid % nig) / gsz; u.pb = mpe > 0 ? (u.pm / mpe) * nN + u.pn : u.pn; return true;
    }
};

__device__ __forceinline__ unsigned cvt_pk_bf16(float lo, float hi) { unsigned r; asm volatile("v_cvt_pk_bf16_f32 %0, %1, %2" : "=v"(r) : "v"(lo), "v"(hi)); return r; }

struct RangeOrder {
    StaticOrder S; int lo, hi;
    __device__ bool next(int i, Unit& u) const { return (lo + i < hi) ? S.next(lo + i, u) : false; }
};
struct OneUnit {
    int pm, pn;
    __device__ bool next(int i, Unit& u) const { if (i != 0) return false; u.pm = pm; u.pn = pn; u.pb = pn; return true; }
};
template <class Epi, class Sched, bool GATHER>
__device__ __forceinline__ void gemm_phase(PG8_LAS unsigned char* lds, const Gemm g, const Sched& S, const Epi& E, const int* gidx) {
    int tid_ = threadIdx.x; asm volatile("" : "+v"(tid_));
    const int tid = tid_, wid = __builtin_amdgcn_readfirstlane(tid >> 6), lane = tid & 63, wr = wid >> 2, wc = wid & 3, fr = lane & 15, fq = lane >> 4;
    const int K = g.K, nt = K / BK;
    unsigned voffA[2], voffB[2]; int rA[2], cA2[2];
#pragma unroll
    for (int i = 0; i < 2; ++i) { int R, C; stage_rc(tid * 16 + i * 8192, R, C); const int Rb = Epi::PERM ? ((R & ~31) + perm32(R & 31)) : R;
        voffA[i] = (unsigned)(R * K + C) * 2u; voffB[i] = (unsigned)(Rb * K + C) * 2u; rA[i] = R; cA2[i] = C * 2; }
    unsigned gcur[2][2], gnxt[2][2];
#define PG8_GOFF(dst, u) do { _Pragma("unroll") for (int _h = 0; _h < 2; ++_h) _Pragma("unroll") for (int _i = 0; _i < 2; ++_i) \
        dst[_h][_i] = (unsigned)gidx[(u).pm * BM + _h * HALF + rA[_i]] * (unsigned)(K * 2) + (unsigned)cA2[_i]; } while (0)
    const size_t kstep = (size_t)(BK * 2);
    const size_t hstep = (size_t)HALF * K * 2;
    const size_t tstep = 2 * hstep;
    const unsigned ldsw = (unsigned)wid * 1024u;
    const int aoff = lds_byte(wr * 64 + fr, fq * 8), boff = lds_byte(wc * 32 + fr, fq * 8);
#define PG8_SA(b, h) (((b) * 2 + (h)) * HTB)
#define PG8_SB(b, h) ((4 + (b) * 2 + (h)) * HTB)
#define PG8_STAGE(bufoff, gbase, voff) do { _Pragma("unroll") for (int _i = 0; _i < 2; ++_i) \
        __builtin_amdgcn_global_load_lds((const unsigned*)((const char*)(gbase) + (voff)[_i]), (PG8_LAS unsigned*)(lds + (bufoff) + ldsw + _i * 8192), 16, 0, 0); } while (0)
#define PG8_STAGE_A(bufoff, half, kb, NX) do { _Pragma("unroll") for (int _i = 0; _i < 2; ++_i) { \
        const char* _src = GATHER ? (const char*)g.A + (kb) + ((NX) ? gnxt[half][_i] : gcur[half][_i]) : ((NX) ? nA : cA) + (size_t)(half) * hstep + (kb) + voffA[_i]; \
        __builtin_amdgcn_global_load_lds((const unsigned*)_src, (PG8_LAS unsigned*)(lds + (bufoff) + ldsw + _i * 8192), 16, 0, 0); } } while (0)
#define PG8_LDA(dst, b, h) do { _Pragma("unroll") for (int m = 0; m < 4; ++m) _Pragma("unroll") for (int k = 0; k < 2; ++k) dst[m][k] = *(const PG8_LAS bf16x8*)(lds + PG8_SA(b, h) + aoff + m * 2048 + k * 1024); } while (0)
#define PG8_LDB(dst, b, h) do { _Pragma("unroll") for (int n = 0; n < 2; ++n) _Pragma("unroll") for (int k = 0; k < 2; ++k) dst[n][k] = *(const PG8_LAS bf16x8*)(lds + PG8_SB(b, h) + boff + n * 2048 + k * 1024); } while (0)
#define PG8_MMA(ai, bj, At, Bt) do { __builtin_amdgcn_s_setprio(1); _Pragma("unroll") for (int m = 0; m < 4; ++m) _Pragma("unroll") for (int n = 0; n < 2; ++n) _Pragma("unroll") for (int k = 0; k < 2; ++k) \
        acc[ai][bj][m][n] = __builtin_amdgcn_mfma_f32_16x16x32_bf16(Bt[n][k], At[m][k], acc[ai][bj][m][n], 0, 0, 0); __builtin_amdgcn_s_setprio(0); } while (0)
#define PG8_WAIT_V(n) asm volatile("s_waitcnt vmcnt(" #n ")" ::: "memory")
#define PG8_WAIT_L(n) asm volatile("s_waitcnt lgkmcnt(" #n ")" ::: "memory")
#define PG8_BAR __builtin_amdgcn_s_barrier()
#define PG8_SCHED __builtin_amdgcn_sched_barrier(0)
    Unit cur, nxt; int ui = 0;
    if (!S.next(0, cur)) return;
    f32x4 acc[2][2][4][2];
#pragma unroll
    for (int a = 0; a < 2; ++a)
#pragma unroll
        for (int b = 0; b < 2; ++b)
#pragma unroll
            for (int m = 0; m < 4; ++m)
#pragma unroll
                for (int n = 0; n < 2; ++n) acc[a][b][m][n] = (f32x4){0.f, 0.f, 0.f, 0.f};
    bf16x8 At[4][2], B0[2][2], B1[2][2];
    const char* cA = GATHER ? (const char*)g.A : (const char*)g.A + (size_t)cur.pm * tstep; const char* cB = (const char*)g.Bt + (size_t)cur.pb * tstep; const char* nA = cA;
    if (GATHER) { PG8_GOFF(gcur, cur); }
    PG8_STAGE(PG8_SB(0, 0), cB, voffB); PG8_STAGE(PG8_SB(0, 1), cB + hstep, voffB); PG8_STAGE_A(PG8_SA(0, 0), 0, 0, false); PG8_STAGE_A(PG8_SA(0, 1), 1, 0, false);
    if (wr == 1) PG8_BAR;
    PG8_WAIT_V(2); PG8_BAR;
    PG8_STAGE(PG8_SB(1, 0), cB + kstep, voffB); PG8_STAGE_A(PG8_SA(1, 0), 0, kstep, false); PG8_STAGE(PG8_SB(1, 1), cB + hstep + kstep, voffB);
    PG8_WAIT_V(6); PG8_BAR;
    for (;;) {
        const bool has_next = S.next(ui + 1, nxt);
        nA = GATHER ? cA : (has_next ? (const char*)g.A + (size_t)nxt.pm * tstep : cA); const char* nB = has_next ? (const char*)g.Bt + (size_t)nxt.pb * tstep : cB;
        if (GATHER) { if (has_next) { PG8_GOFF(gnxt, nxt); } else {
#pragma unroll
            for (int _h = 0; _h < 2; ++_h)
#pragma unroll
                for (int _i = 0; _i < 2; ++_i) gnxt[_h][_i] = gcur[_h][_i]; } }
        for (int t = 0; t < nt; t += 2) {
            const bool last = (t == nt - 2);
            const size_t k1 = (size_t)(t + 1) * kstep, k2 = last ? 0 : (size_t)(t + 2) * kstep, k3 = k2 + kstep;
            const char* b2 = last ? nB : cB + (size_t)(t + 2) * kstep; const char* b3 = b2 + kstep;
            PG8_LDB(B0, 0, 0); PG8_LDB(B1, 0, 1); PG8_SCHED; PG8_LDA(At, 0, 0); PG8_STAGE_A(PG8_SA(1, 1), 1, k1, false);
            PG8_WAIT_V(8); PG8_WAIT_L(0); PG8_BAR; PG8_MMA(0, 0, At, B0); PG8_MMA(0, 1, At, B1); PG8_BAR; PG8_SCHED;
            PG8_LDA(At, 0, 1); PG8_STAGE(PG8_SB(0, 0), b2, voffB); PG8_STAGE(PG8_SB(0, 1), b2 + hstep, voffB); PG8_STAGE_A(PG8_SA(0, 0), 0, k2, last);
            PG8_WAIT_V(8); PG8_WAIT_L(0); PG8_BAR; PG8_MMA(1, 0, At, B0); PG8_MMA(1, 1, At, B1); PG8_BAR; PG8_SCHED;
            PG8_LDB(B0, 1, 0); PG8_LDB(B1, 1, 1); PG8_SCHED; PG8_LDA(At, 1, 0); PG8_STAGE_A(PG8_SA(0, 1), 1, k2, last);
            PG8_WAIT_V(8); PG8_WAIT_L(0); PG8_BAR; PG8_MMA(0, 0, At, B0); PG8_MMA(0, 1, At, B1); PG8_BAR; PG8_SCHED;
            PG8_LDA(At, 1, 1); PG8_STAGE(PG8_SB(1, 0), b3, voffB); PG8_STAGE(PG8_SB(1, 1), b3 + hstep, voffB); PG8_STAGE_A(PG8_SA(1, 0), 0, k3, last);
            PG8_WAIT_V(8); PG8_WAIT_L(0); PG8_BAR; PG8_MMA(1, 0, At, B0); PG8_MMA(1, 1, At, B1); PG8_BAR; PG8_SCHED;
        }
        if (wr == 0) PG8_BAR;
        E(acc, cur, wr, wc, fr, fq);
        if (!has_next) break;
#pragma unroll
        for (int a = 0; a < 2; ++a)
#pragma unroll
            for (int b = 0; b < 2; ++b)
#pragma unroll
                for (int m = 0; m < 4; ++m)
#pragma unroll
                    for (int n = 0; n < 2; ++n) acc[a][b][m][n] = (f32x4){0.f, 0.f, 0.f, 0.f};
        cur = nxt; cA = nA; cB = nB; ++ui;
        if (GATHER) {
#pragma unroll
            for (int _h = 0; _h < 2; ++_h)
#pragma unroll
                for (int _i = 0; _i < 2; ++_i) gcur[_h][_i] = gnxt[_h][_i]; }
        if (wr == 1) PG8_BAR;
    }
    PG8_WAIT_V(0);
    PG8_BAR;
#undef PG8_SA
#undef PG8_SB
#undef PG8_STAGE
#undef PG8_STAGE_A
#undef PG8_GOFF
#undef PG8_LDA
#undef PG8_LDB
#undef PG8_MMA
#undef PG8_WAIT_V
#undef PG8_WAIT_L
#undef PG8_BAR
#undef PG8_SCHED
}
}

#define LAS __attribute__((address_space(3)))
using pg8::bf16_t; using pg8::f32x4; using pg8::u32x4; using pg8::u32x2;
typedef unsigned short u16x8 __attribute__((ext_vector_type(8)));
typedef float f32x2 __attribute__((ext_vector_type(2)));

constexpr int DM = 1024, NB = 2, SEQ = 8192, NTOK = NB * SEQ, CTXL = 256, NCTX = NB * CTXL, NROW = NTOK + NCTX;
constexpr int NE = 16, CAP = 1024, DE = 2048, NSLOT = NE * NB * CAP;
constexpr int NADA = 6 * DM;
constexpr int NTHR = 512;

constexpr size_t MiB = 1u << 20;
constexpr size_t WS_CTL = 0;
constexpr size_t WS_MOD = 1 * MiB;
constexpr size_t WS_LB = WS_MOD + 256 * 1024;
constexpr size_t WS_POSR = WS_LB + 64 * 1024;
constexpr size_t WS_POSC = WS_POSR + 256 * 1024;
constexpr size_t WS_AFF = 2 * MiB;
constexpr size_t WS_TOPI = 3 * MiB;
constexpr size_t WS_TOPG = WS_TOPI + 128 * 1024;
constexpr size_t WS_SLOT = 4 * MiB;
constexpr size_t WS_WHGIN = 6 * MiB;
constexpr size_t WS_WHGOUT = 16 * MiB;
constexpr size_t WS_WSCIN = 18 * MiB;
constexpr size_t WS_WSCOUT = 24 * MiB;
constexpr size_t WS_WMOE1 = 26 * MiB;
constexpr size_t WS_WMOE2 = WS_WMOE1 + 256 * MiB;
constexpr size_t WS_X = WS_WMOE2 + 128 * MiB;
constexpr size_t WS_H = WS_X + 64 * MiB;
constexpr size_t WS_R = WS_H + 34 * MiB;
constexpr size_t WS_Q = WS_R;
constexpr size_t WS_V = WS_Q + 34 * MiB;
constexpr size_t WS_G = WS_V + 34 * MiB;
constexpr size_t WS_LF = WS_G + 34 * MiB;
constexpr size_t WS_LBK = WS_LF + 66 * MiB;
constexpr size_t WS_OF = WS_LBK + 66 * MiB;
constexpr size_t WS_OB = WS_OF + 64 * MiB;
constexpr size_t WS_U = WS_OB;
constexpr size_t WS_DD = WS_OB + 40 * MiB;
constexpr size_t WS_ON = WS_OB + 64 * MiB;
constexpr size_t WS_HG_END = WS_ON + 32 * MiB;
constexpr size_t WS_XG = WS_R;
constexpr size_t WS_ACT = WS_XG + 64 * MiB;
constexpr size_t WS_Y = WS_ACT + 128 * MiB;
constexpr size_t WS_MOE_END = WS_Y + 128 * MiB;
constexpr size_t WS_BG = WS_R;
constexpr size_t WS_CU = WS_BG + 32 * MiB;
constexpr size_t WS_Z = WS_CU + 32 * MiB;
constexpr size_t WS_END = WS_HG_END > WS_MOE_END ? WS_HG_END : WS_MOE_END;
static_assert(WS_END <= 1024 * MiB, "workspace map exceeds 1 GiB");

constexpr int LDS_BYTES = 147456;

struct Params { const float* in[20]; float* out; unsigned char* ws; int ph_lo, ph_hi; };
enum { I_X = 0, I_C, I_CTX, I_CCTX, I_ADAW, I_ADAB, I_NMIX, I_NFFN, I_NFIN, I_HGWIN, I_HGLB, I_HGNORM, I_HGWOUT, I_SCWIN, I_SCCONV, I_SCWOUT, I_ROUTER, I_WGATE, I_WUP, I_WDOWN };

typedef __bf16 bf16x2_t __attribute__((ext_vector_type(2)));
__device__ __forceinline__ unsigned pk2(float lo, float hi) { const f32x2 v = {lo, hi}; return __builtin_bit_cast(unsigned, __builtin_convertvector(v, bf16x2_t)); }
__device__ __forceinline__ unsigned f2bf(float f) { return pk2(f, 0.f) & 0xffffu; }
__device__ __forceinline__ float bf2f(unsigned short h) { return __builtin_bit_cast(float, (unsigned)h << 16); }
template <int CTRL> __device__ __forceinline__ float dpp_f(float x) { return __builtin_bit_cast(float, __builtin_amdgcn_update_dpp(0, __builtin_bit_cast(int, x), CTRL, 0xf, 0xf, true)); }
__device__ __forceinline__ float row16_sum(float x) {
    x += dpp_f<0xB1>(x);
    x += dpp_f<0x4E>(x);
    x += dpp_f<0x141>(x);
    x += dpp_f<0x140>(x);
    return x;
}
__device__ __forceinline__ float wave_sum(float v) { v = row16_sum(v); v += __shfl_xor(v, 16); v += __shfl_xor(v, 32); return v; }
__device__ __forceinline__ float sigmoidf_(float x) { return 1.f / (1.f + expf(-x)); }
__device__ __forceinline__ float fsigmoid(float x) { return __builtin_amdgcn_rcpf(1.f + __builtin_amdgcn_exp2f(-1.4426950408889634f * x)); }
__device__ __forceinline__ float fsilu(float x) { return x * fsigmoid(x); }
__device__ __forceinline__ float siluf_(float x) { return x / (1.f + expf(-x)); }

struct EpiInProj {
    static constexpr bool PERM = false;
    unsigned char* ws;
    __device__ __forceinline__ void operator()(const f32x4 (&acc)[2][2][4][2], const pg8::Unit& u, int wr, int wc, int fr, int fq) const {
        const int sec = u.pn >> 2;
        const int row0 = u.pm * 256 + wr * 64 + fr, cb = (u.pn & 3) * 256 + wc * 32 + 4 * fq;
        if (sec == 0 || sec == 1 || sec == 4) {
            bf16_t* O = (bf16_t*)(ws + (sec == 0 ? WS_Q : (sec == 1 ? WS_V : WS_G)));
#pragma unroll
            for (int ai = 0; ai < 2; ++ai)
#pragma unroll
                for (int m = 0; m < 4; ++m) { bf16_t* rp = O + (size_t)(row0 + ai * 128 + m * 16) * DM + cb;
#pragma unroll
                    for (int bj = 0; bj < 2; ++bj)
#pragma unroll
                        for (int n = 0; n < 2; ++n) { f32x4 v = acc[ai][bj][m][n];
                            if (sec == 0) v = v * 0.08838834764831845f;
                            if (sec == 4) { v[0] = fsilu(v[0]); v[1] = fsilu(v[1]); v[2] = fsilu(v[2]); v[3] = fsilu(v[3]); }
                            u32x2 w; w.x = pk2(v[0], v[1]); w.y = pk2(v[2], v[3]); *(u32x2*)(rp + bj * 128 + n * 16) = w; } }
        } else {
            float* O = (float*)(ws + (sec == 2 ? WS_LF : WS_LBK)); const float* lb0 = (const float*)(ws + WS_LB);
            f32x4 lbv[2][2];
#pragma unroll
            for (int bj = 0; bj < 2; ++bj)
#pragma unroll
                for (int n = 0; n < 2; ++n) lbv[bj][n] = *(const f32x4*)(lb0 + cb + bj * 128 + n * 16);
#pragma unroll
            for (int ai = 0; ai < 2; ++ai)
#pragma unroll
                for (int m = 0; m < 4; ++m) { float* rp = O + (size_t)(row0 + ai * 128 + m * 16) * DM + cb;
#pragma unroll
                    for (int bj = 0; bj < 2; ++bj)
#pragma unroll
                        for (int n = 0; n < 2; ++n) { const f32x4 z = acc[ai][bj][m][n], lb = lbv[bj][n]; f32x4 o;
#pragma unroll
                            for (int i = 0; i < 4; ++i) o[i] = lb[i] + (1.f - lb[i]) * fsigmoid(z[i]);
                            *(f32x4*)(rp + bj * 128 + n * 16) = o; } }
        }
    }
};
struct EpiResid {
    static constexpr bool PERM = false;
    float* X; const float* gate;
    __device__ __forceinline__ void operator()(const f32x4 (&acc)[2][2][4][2], const pg8::Unit& u, int wr, int wc, int fr, int fq) const {
        const int row0 = u.pm * 256 + wr * 64 + fr, cb = u.pn * 256 + wc * 32 + 4 * fq;
        const float* gp = gate + (size_t)((u.pm * 256) / SEQ) * NADA + cb;
        f32x4 gv[2][2];
#pragma unroll
        for (int bj = 0; bj < 2; ++bj)
#pragma unroll
            for (int n = 0; n < 2; ++n) gv[bj][n] = *(const f32x4*)(gp + bj * 128 + n * 16);
#pragma unroll
        for (int ai = 0; ai < 2; ++ai)
#pragma unroll
            for (int m = 0; m < 4; ++m) { float* rp = X + (size_t)(row0 + ai * 128 + m * 16) * DM + cb;
#pragma unroll
                for (int bj = 0; bj < 2; ++bj)
#pragma unroll
                    for (int n = 0; n < 2; ++n) { f32x4* q = (f32x4*)(rp + bj * 128 + n * 16); *q = *q + gv[bj][n] * acc[ai][bj][m][n]; } }
    }
};
struct EpiGLU {
    static constexpr bool PERM = true;
    bf16_t* ACT;
    __device__ __forceinline__ void operator()(const f32x4 (&acc)[2][2][4][2], const pg8::Unit& u, int wr, int wc, int fr, int fq) const {
        const int row0 = u.pm * 256 + wr * 64 + fr, cb = u.pn * 128 + wc * 32 + 8 * fq;
#pragma unroll
        for (int ai = 0; ai < 2; ++ai)
#pragma unroll
            for (int m = 0; m < 4; ++m) { bf16_t* rp = ACT + (size_t)(row0 + ai * 128 + m * 16) * DE + cb;
                f32x4 o[2];
#pragma unroll
                for (int n = 0; n < 2; ++n) { const f32x4 a = acc[ai][0][m][n], w = acc[ai][1][m][n];
#pragma unroll
                    for (int i = 0; i < 4; ++i) o[n][i] = fsilu(a[i]) * w[i]; }
                u32x4 w; w.x = pk2(o[0][0], o[0][1]); w.y = pk2(o[0][2], o[0][3]); w.z = pk2(o[1][0], o[1][1]); w.w = pk2(o[1][2], o[1][3]);
                *(u32x4*)rp = w; }
    }
};
struct EpiRowScale {
    static constexpr bool PERM = true;
    bf16_t* Y; const float* rg;
    __device__ __forceinline__ void operator()(const f32x4 (&acc)[2][2][4][2], const pg8::Unit& u, int wr, int wc, int fr, int fq) const {
        const int row0 = u.pm * 256 + wr * 64 + fr, cb = u.pn * 256 + wc * 32 + 8 * fq;
#pragma unroll
        for (int ai = 0; ai < 2; ++ai)
#pragma unroll
            for (int m = 0; m < 4; ++m) { const int row = row0 + ai * 128 + m * 16; const float gsc = rg[row]; bf16_t* rp = Y + (size_t)row * DM + cb;
#pragma unroll
                for (int bj = 0; bj < 2; ++bj) { const f32x4 v0 = acc[ai][bj][m][0] * gsc, v1 = acc[ai][bj][m][1] * gsc;
                    u32x4 w; w.x = pk2(v0[0], v0[1]); w.y = pk2(v0[2], v0[3]); w.z = pk2(v1[0], v1[1]); w.w = pk2(v1[2], v1[3]);
                    *(u32x4*)(rp + bj * 128) = w; } }
    }
};
struct EpiConvIn {
    static constexpr bool PERM = true;
    bf16_t *BG, *CU;
    __device__ __forceinline__ void operator()(const f32x4 (&acc)[2][2][4][2], const pg8::Unit& u, int wr, int wc, int fr, int fq) const {
        const int row0 = u.pm * 256 + wr * 64 + fr;
        if (u.pn < 4) {
            const int cb = u.pn * 256 + wc * 32 + 8 * fq;
#pragma unroll
            for (int ai = 0; ai < 2; ++ai)
#pragma unroll
                for (int m = 0; m < 4; ++m) { bf16_t* rp = BG + (size_t)(row0 + ai * 128 + m * 16) * DM + cb;
#pragma unroll
                    for (int bj = 0; bj < 2; ++bj) { const f32x4 v0 = acc[ai][bj][m][0], v1 = acc[ai][bj][m][1];
                        u32x4 w; w.x = pk2(v0[0], v0[1]); w.y = pk2(v0[2], v0[3]); w.z = pk2(v1[0], v1[1]); w.w = pk2(v1[2], v1[3]);
                        *(u32x4*)(rp + bj * 128) = w; } }
        } else {
            const int cb = (u.pn - 4) * 128 + wc * 32 + 8 * fq;
#pragma unroll
            for (int ai = 0; ai < 2; ++ai)
#pragma unroll
                for (int m = 0; m < 4; ++m) { bf16_t* rp = CU + (size_t)(row0 + ai * 128 + m * 16) * DM + cb;
                    const f32x4 v0 = acc[ai][0][m][0] * acc[ai][1][m][0], v1 = acc[ai][0][m][1] * acc[ai][1][m][1];
                    u32x4 w; w.x = pk2(v0[0], v0[1]); w.y = pk2(v0[2], v0[3]); w.z = pk2(v1[0], v1[1]); w.w = pk2(v1[2], v1[3]);
                    *(u32x4*)rp = w; }
        }
    }
};

__device__ __forceinline__ void ph_prep(const Params& p, unsigned char* lds, int bid, int nblk) {
    float* sv = (float*)lds;
    float* red = sv + 3 * 1024;
    int tid_ = threadIdx.x; asm volatile("" : "+v"(tid_)); const int tid = tid_;
    const float* c = p.in[I_C]; const float* cctx = p.in[I_CCTX];
    for (int i = tid; i < 3 * 1024; i += NTHR) { const float v = (i < 2048) ? c[i] : cctx[i - 2048]; sv[i] = siluf_(v); }
    __syncthreads();
    const float* ada_w = p.in[I_ADAW]; const float* ada_b = p.in[I_ADAB];
    float* mod = (float*)(p.ws + WS_MOD);
    for (int it = bid; it < 192; it += nblk) {
        const int l = it / 96, j0 = (it % 96) * 64, col = tid & 63, ks = tid >> 6;
        const float* W = ada_w + (size_t)l * DM * NADA + j0 + col;
        float a0 = 0.f, a1 = 0.f, a2 = 0.f;
#pragma unroll 16
        for (int k = ks * 128; k < ks * 128 + 128; ++k) { const float w = W[(size_t)k * NADA]; a0 += sv[k] * w; a1 += sv[1024 + k] * w; a2 += sv[2048 + k] * w; }
        red[(ks * 3 + 0) * 64 + col] = a0; red[(ks * 3 + 1) * 64 + col] = a1; red[(ks * 3 + 2) * 64 + col] = a2;
        __syncthreads();
        if (tid < 192) { const int v = tid >> 6, cc = tid & 63; float s = ada_b[l * NADA + j0 + cc];
#pragma unroll
            for (int k2 = 0; k2 < 8; ++k2) s += red[(k2 * 3 + v) * 64 + cc];
            mod[(size_t)(l * 3 + v) * NADA + j0 + cc] = s; }
        __syncthreads();
    }
    const int gt = bid * NTHR + tid, NT = nblk * NTHR;
    const float* lg = p.in[I_HGLB]; float* lb0 = (float*)(p.ws + WS_LB);
    for (int d = gt; d < DM; d += NT) { const float l0 = lg[d], l1 = lg[DM + d], l2 = lg[2 * DM + d]; const float mx = fmaxf(l0, fmaxf(l1, l2));
        const float e0 = expf(l0 - mx), e1 = expf(l1 - mx), e2 = expf(l2 - mx); lb0[d] = e0 / (e0 + e1 + e2); }
    float* posr = (float*)(p.ws + WS_POSR);
    for (int i = gt; i < (128 + 64) * 512; i += NT) { const int pi = i >> 9, dd = i & 511; const int pos = pi < 128 ? pi : pi - 128; const int fi = dd & 255;
        const float om = exp2f(-(float)fi * (13.287712379549449f / 256.0f)); const float a = (float)pos * om; posr[i] = dd < 256 ? sinf(a) : cosf(a); }
}

__device__ __forceinline__ void transpose_item(const float* W, int N, bf16_t* WT, int K, float* scr, int k0, int n0, size_t drow0, int lane) {
#pragma unroll
    for (int i = 0; i < 8; ++i) { const int kk = 8 * i + (lane >> 3); const f32x4 v = *(const f32x4*)(W + (size_t)(k0 + kk) * N + n0 + (lane & 7) * 4); float* d = scr + kk * 33 + (lane & 7) * 4; d[0] = v[0]; d[1] = v[1]; d[2] = v[2]; d[3] = v[3]; }
    __builtin_amdgcn_s_waitcnt(0xc07f); asm volatile("" ::: "memory");
    const int c = lane & 7;
#pragma unroll
    for (int j = 0; j < 4; ++j) { const int n = (lane >> 3) + 8 * j; const float* s = scr + (8 * c) * 33 + n;
        u32x4 o; o.x = pk2(s[0 * 33], s[1 * 33]); o.y = pk2(s[2 * 33], s[3 * 33]); o.z = pk2(s[4 * 33], s[5 * 33]); o.w = pk2(s[6 * 33], s[7 * 33]);
        *(u32x4*)(WT + (drow0 + n) * K + k0 + 8 * c) = o; }
    __builtin_amdgcn_s_waitcnt(0xc07f); asm volatile("" ::: "memory");
}
__device__ __forceinline__ void ph_convert_small(const Params& p, unsigned char* lds, int bid, int nblk) {
    int tid_ = threadIdx.x; asm volatile("" : "+v"(tid_));
    const int tid = tid_, lane = tid & 63, wave = tid >> 6;
    float* scr = (float*)lds + wave * (64 * 33);
    const int gw = bid * 8 + wave, NGW = nblk * 8;
    constexpr int I_A = 16 * 160, I_B = 16 * 32, I_C_ = 16 * 96, I_D = 16 * 32;
    for (int it = gw; it < I_A + I_B + I_C_ + I_D; it += NGW) {
        int r = it;
        if (r < I_A) { const int kb = r / 160, nb = r % 160; transpose_item(p.in[I_HGWIN], 5120, (bf16_t*)(p.ws + WS_WHGIN), 1024, scr, kb * 64, nb * 32, (size_t)nb * 32, lane); continue; } r -= I_A;
        if (r < I_B) { const int kb = r / 32, nb = r % 32; transpose_item(p.in[I_HGWOUT], 1024, (bf16_t*)(p.ws + WS_WHGOUT), 1024, scr, kb * 64, nb * 32, (size_t)nb * 32, lane); continue; } r -= I_B;
        if (r < I_C_) { const int kb = r / 96, nb = r % 96, n0 = nb * 32; size_t dr;
            if (n0 < 1024) dr = n0; else { const int np = n0 - 1024, sec = np >> 10, nn = np & 1023; dr = 1024 + (nn >> 7) * 256 + sec * 128 + (nn & 127); }
            transpose_item(p.in[I_SCWIN], 3072, (bf16_t*)(p.ws + WS_WSCIN), 1024, scr, kb * 64, n0, dr, lane); continue; } r -= I_C_;
        { const int kb = r / 32, nb = r % 32; transpose_item(p.in[I_SCWOUT], 1024, (bf16_t*)(p.ws + WS_WSCOUT), 1024, scr, kb * 64, nb * 32, (size_t)nb * 32, lane); }
    }
}
struct CvtItem { const float* src; bf16_t* dst; int N, K; };
__device__ __forceinline__ CvtItem moe_item(const Params& p, int l, int r) {
    CvtItem c;
    if (r < 32768) { const int up = r >= 16384; if (up) r -= 16384; const int le = l * 16 + (r >> 10), q = r & 1023, kb = q >> 6, nb = q & 63, n0 = nb * 32;
        const size_t dr = (size_t)le * 4096 + (n0 >> 7) * 256 + up * 128 + (n0 & 127);
        c.src = p.in[up ? I_WUP : I_WGATE] + (size_t)le * 1024 * 2048 + (size_t)(kb * 64) * 2048 + n0; c.dst = (bf16_t*)(p.ws + WS_WMOE1) + dr * 1024 + kb * 64; c.N = 2048; c.K = 1024; }
    else { r -= 32768; const int le = l * 16 + (r >> 10), q = r & 1023, kb = q >> 5, nb = q & 31, n0 = nb * 32;
        c.src = p.in[I_WDOWN] + (size_t)le * 2048 * 1024 + (size_t)(kb * 64) * 1024 + n0; c.dst = (bf16_t*)(p.ws + WS_WMOE2) + ((size_t)le * 1024 + n0) * 2048 + kb * 64; c.N = 1024; c.K = 2048; }
    return c;
}
__device__ __forceinline__ void convert_moe_slice(const Params& p, unsigned char* lds, int bid, int nblk, int l, int lo, int hi) {
    int tid_ = threadIdx.x; asm volatile("" : "+v"(tid_));
    const int tid = tid_, lane = tid & 63, wave = tid >> 6;
    float* scr = (float*)lds + wave * (64 * 33);
    const int gw = bid * 8 + wave, NGW = nblk * 8;
    constexpr int NI = 3;
    for (int it = lo + gw; it < hi; it += NGW * NI) {
        f32x4 v[NI][8]; CvtItem ci[NI];
#pragma unroll
        for (int u = 0; u < NI; ++u) { const int r = it + u * NGW; ci[u] = moe_item(p, l, r < hi ? r : it);
#pragma unroll
            for (int i = 0; i < 8; ++i) v[u][i] = __builtin_nontemporal_load((const f32x4*)(ci[u].src + (size_t)(8 * i + (lane >> 3)) * ci[u].N + (lane & 7) * 4)); }
#pragma unroll
        for (int u = 0; u < NI; ++u) { if (it + u * NGW < hi) {
#pragma unroll
            for (int i = 0; i < 8; ++i) { float* d = scr + (8 * i + (lane >> 3)) * 33 + (lane & 7) * 4; d[0] = v[u][i][0]; d[1] = v[u][i][1]; d[2] = v[u][i][2]; d[3] = v[u][i][3]; }
            __builtin_amdgcn_s_waitcnt(0xc07f); asm volatile("" ::: "memory");
            const int c = lane & 7;
#pragma unroll
            for (int j = 0; j < 4; ++j) { const int n = (lane >> 3) + 8 * j; const float* sp = scr + (8 * c) * 33 + n;
                u32x4 o; o.x = pk2(sp[0 * 33], sp[1 * 33]); o.y = pk2(sp[2 * 33], sp[3 * 33]); o.z = pk2(sp[4 * 33], sp[5 * 33]); o.w = pk2(sp[6 * 33], sp[7 * 33]);
                __builtin_nontemporal_store(o, (u32x4*)(ci[u].dst + (size_t)n * ci[u].K + 8 * c)); }
            __builtin_amdgcn_s_waitcnt(0xc07f); asm volatile("" ::: "memory"); } }
    }
    __syncthreads();
}

constexpr int CV_ITEMS = 49152, CW_Q = 1536;
constexpr int MW_LAYER = 12, MW_BASE = 13, MW_EMPTY = 14, MW_REL = 15;
__device__ __forceinline__ bool cvt_batch(const Params& p, unsigned char* lds, volatile LAS unsigned* MISC, unsigned layer_mask) {
    int tid_ = threadIdx.x; asm volatile("" : "+v"(tid_));
    const int tid = tid_, lane = tid & 63, wave = tid >> 6;
    if (tid == 0) {
        unsigned* q = (unsigned*)(p.ws + WS_CTL) + CW_Q; unsigned empty = MISC[MW_EMPTY]; int layer = -1; unsigned base = 0u;
#pragma unroll
        for (int l = 0; l < 2; ++l) if (layer < 0 && ((layer_mask >> l) & 1u) && !((empty >> l) & 1u)) {
            const unsigned b0 = __hip_atomic_fetch_add(q + 64 * l, 8u, __ATOMIC_RELAXED, __HIP_MEMORY_SCOPE_AGENT);
            if (b0 < (unsigned)CV_ITEMS) { layer = l; base = b0; } else empty |= 1u << l; }
        MISC[MW_EMPTY] = empty; MISC[MW_LAYER] = (unsigned)layer; MISC[MW_BASE] = base;
    }
    __syncthreads();
    const int layer = (int)MISC[MW_LAYER]; const int item = (int)MISC[MW_BASE] + wave;
    if (layer < 0) return false;
    float* scr = (float*)lds + wave * (64 * 33);
    if (item < CV_ITEMS) {
        const CvtItem ci = moe_item(p, layer, item);
        f32x4 v[8];
#pragma unroll
        for (int i = 0; i < 8; ++i) v[i] = __builtin_nontemporal_load((const f32x4*)(ci.src + (size_t)(8 * i + (lane >> 3)) * ci.N + (lane & 7) * 4));
#pragma unroll
        for (int i = 0; i < 8; ++i) { float* d = scr + (8 * i + (lane >> 3)) * 33 + (lane & 7) * 4; d[0] = v[i][0]; d[1] = v[i][1]; d[2] = v[i][2]; d[3] = v[i][3]; }
        __builtin_amdgcn_s_waitcnt(0xc07f); asm volatile("" ::: "memory");
        const int c = lane & 7;
#pragma unroll
        for (int j = 0; j < 4; ++j) { const int n = (lane >> 3) + 8 * j; const float* sp = scr + (8 * c) * 33 + n;
            u32x4 o; o.x = pk2(sp[0 * 33], sp[1 * 33]); o.y = pk2(sp[2 * 33], sp[3 * 33]); o.z = pk2(sp[4 * 33], sp[5 * 33]); o.w = pk2(sp[6 * 33], sp[7 * 33]);
            __builtin_nontemporal_store(o, (u32x4*)(ci.dst + (size_t)n * ci.K + 8 * c)); }
    }
    __syncthreads();
    return true;
}
__device__ __forceinline__ void cvt_budget(const Params& p, unsigned char* lds, volatile LAS unsigned* MISC, unsigned layer_mask, int nbatch) {
    for (int i = 0; i < nbatch; ++i) if (!cvt_batch(p, lds, MISC, layer_mask)) break;
}

__device__ __forceinline__ void store_mod_bf16(bf16_t* hrow, const f32x4 (&v)[4], float rstd, const float* g, const float* sh, const float* sc, int lane) {
#pragma unroll
    for (int j = 0; j < 4; ++j) { const int c0 = 256 * j + 4 * lane; const f32x4 gv = *(const f32x4*)(g + c0), shv = *(const f32x4*)(sh + c0), scv = *(const f32x4*)(sc + c0);
        f32x4 h;
#pragma unroll
        for (int i = 0; i < 4; ++i) h[i] = (v[j][i] * rstd * gv[i]) * (1.f + scv[i]) + shv[i];
        u32x2 w; w.x = pk2(h[0], h[1]); w.y = pk2(h[2], h[3]); *(u32x2*)(hrow + c0) = w; }
}
__device__ __forceinline__ void ph_mod0(const Params& p, int row_lo, int row_hi, int wk, int nwk) {
    int tid_ = threadIdx.x; asm volatile("" : "+v"(tid_));
    const int tid = tid_, lane = tid & 63, wave = tid >> 6, gw = wk * 8 + wave, NGW = nwk * 8;
    const float* x = p.in[I_X]; const float* ctx = p.in[I_CTX]; const float* g = p.in[I_NMIX];
    const float* mod = (const float*)(p.ws + WS_MOD); const float* posr = (const float*)(p.ws + WS_POSR); const float* posc = (const float*)(p.ws + WS_POSC);
    float* X = (float*)(p.ws + WS_X); bf16_t* H = (bf16_t*)(p.ws + WS_H);
    f32x4 nx[4];
    { const int row = row_lo + gw; if (row < row_hi) { const float* src = row < NTOK ? x + (size_t)row * DM : ctx + (size_t)(row - NTOK) * DM;
#pragma unroll
        for (int j = 0; j < 4; ++j) nx[j] = *(const f32x4*)(src + 256 * j + 4 * lane); } }
    for (int row = row_lo + gw; row < row_hi; row += NGW) {
        f32x4 v[4]; float ss = 0.f; int vec;
#pragma unroll
        for (int j = 0; j < 4; ++j) v[j] = nx[j];
        { const int r2 = row + NGW; if (r2 < row_hi) { const float* src = r2 < NTOK ? x + (size_t)r2 * DM : ctx + (size_t)(r2 - NTOK) * DM;
#pragma unroll
            for (int j = 0; j < 4; ++j) nx[j] = *(const f32x4*)(src + 256 * j + 4 * lane); } }
        if (row < NTOK) { const int t = row & (SEQ - 1); vec = row >> 13; const float* pr = posr + (size_t)(t >> 6) * 512; const float* pc = posc + (size_t)(t & 63) * 512;
#pragma unroll
            for (int j = 0; j < 4; ++j) { const int c0 = 256 * j + 4 * lane; const f32x4 pv = *(const f32x4*)((j < 2 ? pr : pc) + (c0 & 511));
                v[j] = v[j] + pv; *(f32x4*)(X + (size_t)row * DM + c0) = v[j]; }
        } else vec = 2;
#pragma unroll
        for (int j = 0; j < 4; ++j) ss += (v[j][0] * v[j][0] + v[j][1] * v[j][1]) + (v[j][2] * v[j][2] + v[j][3] * v[j][3]);
        const float rstd = 1.f / sqrtf(wave_sum(ss) * (1.f / DM) + 1e-6f);
        const float* mv = mod + (size_t)(0 * 3 + vec) * NADA;
        store_mod_bf16(H + (size_t)row * DM, v, rstd, g, mv, mv + DM, lane);
    }
}

typedef short s16x4 __attribute__((ext_vector_type(4)));
typedef short v4i16_t __attribute__((ext_vector_type(4)));
using pg8::bf16x8;
constexpr int KT_STR = 160, KS_STR = 144, V_STR = 288;
constexpr int GL_QT = 0, GL_KT = 20480, GL_KS = 40960, GL_PL = 59392, GL_V = 68608, GL_SEG = 87040, GL_DV = 89088, GL_EM = 89600, GL_SSQ = 90112, GL_RSTD = 92160;
__device__ __forceinline__ s16x4 lds_tr(const LAS unsigned char* p) { return __builtin_bit_cast(s16x4, __builtin_amdgcn_ds_read_tr16_b64_v4i16((LAS v4i16_t*)p)); }
__device__ __forceinline__ bf16x8 cat8(s16x4 a, s16x4 b) { return __builtin_shufflevector(a, b, 0, 1, 2, 3, 4, 5, 6, 7); }
__device__ __forceinline__ bf16x8 lds_pair64(const LAS unsigned char* p, int d2) { const u32x2 a = *(const LAS u32x2*)p, b = *(const LAS u32x2*)(p + d2); u32x4 r; r.x = a.x; r.y = a.y; r.z = b.x; r.w = b.y; return __builtin_bit_cast(bf16x8, r); }

constexpr int ON_STR = 272;
constexpr int GL_RF = 92416, GL_RQ = 125184, GL_END = 141568;
struct GlaRegs { f32x4 f[4]; u32x4 q[2]; u32x4 v[2]; };
template <bool WITHQ>
__device__ __forceinline__ void gla_load(GlaRegs& R, const float* F, const bf16_t* Q, const bf16_t* V, int rb, int h, int tid) {
    const unsigned lf = (unsigned)((tid >> 5) * DM + (tid & 31) * 4), lq = (unsigned)((tid >> 4) * DM + (tid & 15) * 8);
#pragma unroll
    for (int i = 0; i < 4; ++i) { const float* fb = F + (size_t)(rb + 16 * i) * DM + h * 128; R.f[i] = *(const f32x4*)(fb + lf); }
#pragma unroll
    for (int i = 0; i < 2; ++i) { const size_t ub = (size_t)(rb + 32 * i) * DM + h * 128;
        if (WITHQ) R.q[i] = *(const u32x4*)(Q + ub + lq); R.v[i] = *(const u32x4*)(V + ub + lq); }
}
template <bool WITHQ>
__device__ __forceinline__ void gla_put_raw(const GlaRegs& R, LAS unsigned char* lds, int dir, int tid) {
#pragma unroll
    for (int i = 0; i < 4; ++i) { const int id = tid + 512 * i, row = id >> 5, c4 = (id & 31) * 4, p = dir ? 63 - row : row; *(LAS f32x4*)(lds + GL_RF + p * 512 + c4 * 4) = R.f[i]; }
#pragma unroll
    for (int i = 0; i < 2; ++i) { const int id = tid + 512 * i, row = id >> 4, c8 = (id & 15) * 8, p = dir ? 63 - row : row;
        if (WITHQ) *(LAS u32x4*)(lds + GL_RQ + p * 256 + c8 * 2) = R.q[i]; *(LAS u32x4*)(lds + GL_V + p * V_STR + c8 * 2) = R.v[i]; }
}
template <bool G2>
__device__ __forceinline__ void gla_phase_a(LAS unsigned char* lds, int tid) {
    const int k = tid & 127, seg = tid >> 7;
    LAS float* segtot = (LAS float*)(lds + GL_SEG);
    float f[16];
#pragma unroll
    for (int i = 0; i < 16; ++i) f[i] = *(const LAS float*)(lds + GL_RF + (16 * seg + i) * 512 + k * 4);
    if (G2) {
        unsigned short q[16];
#pragma unroll
        for (int i = 0; i < 16; ++i) q[i] = *(const LAS unsigned short*)(lds + GL_RQ + (16 * seg + i) * 256 + k * 2);
        float c[16]; c[0] = f[0];
#pragma unroll
        for (int i = 1; i < 16; ++i) c[i] = c[i - 1] * f[i];
        segtot[seg * 128 + k] = c[15];
        __syncthreads();
        const float T0 = segtot[k], T1 = segtot[128 + k], T2 = segtot[256 + k], T3 = segtot[384 + k];
        const float Fs = seg == 0 ? 1.f / (T0 * T1) : (seg == 1 ? 1.f / T1 : (seg == 2 ? 1.f : T2));
        const float cK = T2 * T3;
        if (seg == 0) { ((LAS float*)(lds + GL_DV))[k] = T0 * T1 * cK; ((LAS float*)(lds + GL_EM))[k] = T0 * T1; }
        unsigned wq[8], wk[8], ws_[8];
#pragma unroll
        for (int i = 0; i < 16; i += 2) { float qp[2], kp[2], ks[2];
#pragma unroll
            for (int e = 0; e < 2; ++e) { const float eq = c[i + e] * Fs, inv = __builtin_amdgcn_rcpf(eq), kk = 1.f - f[i + e];
                qp[e] = bf2f(q[i + e]) * eq; kp[e] = kk * inv; ks[e] = kp[e] * cK; }
            wq[i >> 1] = pk2(qp[0], qp[1]); wk[i >> 1] = pk2(kp[0], kp[1]); ws_[i >> 1] = pk2(ks[0], ks[1]); }
        LAS unsigned char* dq = lds + GL_QT + k * KT_STR + seg * 32; LAS unsigned char* dk = lds + GL_KT + k * KT_STR + seg * 32; LAS unsigned char* ds = lds + GL_KS + k * KS_STR + seg * 32;
        *(LAS u32x4*)dq = (u32x4){wq[0], wq[1], wq[2], wq[3]}; *(LAS u32x4*)(dq + 16) = (u32x4){wq[4], wq[5], wq[6], wq[7]};
        *(LAS u32x4*)dk = (u32x4){wk[0], wk[1], wk[2], wk[3]}; *(LAS u32x4*)(dk + 16) = (u32x4){wk[4], wk[5], wk[6], wk[7]};
        *(LAS u32x4*)ds = (u32x4){ws_[0], ws_[1], ws_[2], ws_[3]}; *(LAS u32x4*)(ds + 16) = (u32x4){ws_[4], ws_[5], ws_[6], ws_[7]};
    } else {
        float sx[16]; sx[15] = 1.f;
#pragma unroll
        for (int i = 14; i >= 0; --i) sx[i] = sx[i + 1] * f[i + 1];
        segtot[seg * 128 + k] = sx[0] * f[0];
        __syncthreads();
        const float T0 = segtot[k], T1 = segtot[128 + k], T2 = segtot[256 + k], T3 = segtot[384 + k];
        const float later = seg == 0 ? T1 * T2 * T3 : (seg == 1 ? T2 * T3 : (seg == 2 ? T3 : 1.f));
        if (seg == 0) ((LAS float*)(lds + GL_DV))[k] = T0 * T1 * T2 * T3;
        unsigned ws_[8];
#pragma unroll
        for (int i = 0; i < 16; i += 2) ws_[i >> 1] = pk2((1.f - f[i]) * sx[i] * later, (1.f - f[i + 1]) * sx[i + 1] * later);
        LAS unsigned char* ds = lds + GL_KS + k * KS_STR + seg * 32;
        *(LAS u32x4*)ds = (u32x4){ws_[0], ws_[1], ws_[2], ws_[3]}; *(LAS u32x4*)(ds + 16) = (u32x4){ws_[4], ws_[5], ws_[6], ws_[7]};
    }
    __syncthreads();
}
__device__ __forceinline__ void gla_state_update(f32x4 (&S)[8], const bf16x8 (&Vf)[2], const LAS unsigned char* lds, int i16, int g) {
#pragma unroll
    for (int j = 0; j < 8; ++j) { const f32x4 dv = *(const LAS f32x4*)(lds + GL_DV + (16 * j + 4 * g) * 4); S[j] = S[j] * dv;
#pragma unroll
        for (int c2 = 0; c2 < 2; ++c2) { const bf16x8 a = lds_pair64(lds + GL_KS + (16 * j + i16) * KS_STR + (32 * c2 + 4 * g) * 2, 32);
            S[j] = __builtin_amdgcn_mfma_f32_16x16x32_bf16(a, Vf[c2], S[j], 0, 0, 0); }
        if (j & 1) asm volatile("" ::: "memory"); }
}
__device__ __forceinline__ void gla_load_vf(bf16x8 (&Vf)[2], const LAS unsigned char* lds, int w, int i16, int g) {
    const int q4 = i16 >> 2, pp = i16 & 3;
#pragma unroll
    for (int c2 = 0; c2 < 2; ++c2) { const LAS unsigned char* vb = lds + GL_V + (32 * c2 + 4 * g + q4) * V_STR + (16 * w + 4 * pp) * 2; Vf[c2] = cat8(lds_tr(vb), lds_tr(vb + 16 * V_STR)); }
}

__device__ __forceinline__ void ph_gla_states(const Params& p, unsigned char* lds_, int bid, int nblk) {
    int tid_ = threadIdx.x; asm volatile("" : "+v"(tid_));
    const int tid = tid_, lane = tid & 63, w = __builtin_amdgcn_readfirstlane(tid >> 6), i16 = lane & 15, g = lane >> 4;
    LAS unsigned char* lds = (LAS unsigned char*)lds_;
    const bf16_t* V = (const bf16_t*)(p.ws + WS_V);
    float* U = (float*)(p.ws + WS_U); float* DD = (float*)(p.ws + WS_DD);
    for (int ui = bid; ui < 544; ui += nblk) {
        int b, h, dir, nch, rb0, uidx;
        if (ui < 512) { b = ui >> 8; h = (ui >> 5) & 7; dir = (ui >> 4) & 1; const int sc = ui & 15; nch = 8; rb0 = b * SEQ + sc * 512; uidx = ((b * 8 + h) * 2 + dir) * 17 + sc; }
        else { const int r = ui - 512; b = r >> 4; h = (r >> 1) & 7; dir = r & 1; nch = 4; rb0 = NTOK + b * CTXL; uidx = ((b * 8 + h) * 2 + dir) * 17 + 16; }
        const float* F = (const float*)(p.ws + (dir ? WS_LBK : WS_LF));
        f32x4 S[8];
#pragma unroll
        for (int j = 0; j < 8; ++j) S[j] = (f32x4){0.f, 0.f, 0.f, 0.f};
        float dtot = 1.f;
        GlaRegs R;
        gla_load<false>(R, F, nullptr, V, rb0 + 64 * (dir ? nch - 1 : 0), h, tid);
        for (int step = 0; step < nch; ++step) {
            gla_put_raw<false>(R, lds, dir, tid);
            __syncthreads();
            if (step + 1 < nch) gla_load<false>(R, F, nullptr, V, rb0 + 64 * (dir ? nch - 2 - step : step + 1), h, tid);
            gla_phase_a<false>(lds, tid);
            if (tid < 128) dtot *= ((const LAS float*)(lds + GL_DV))[tid];
            bf16x8 Vf[2]; gla_load_vf(Vf, lds, w, i16, g);
            gla_state_update(S, Vf, lds, i16, g);
            __syncthreads();
        }
        float* up = U + (size_t)uidx * 16384 + (size_t)(w * 8) * 256 + lane * 4;
#pragma unroll
        for (int j = 0; j < 8; ++j) *(f32x4*)(up + j * 256) = S[j];
        if (tid < 128) DD[(size_t)uidx * 128 + tid] = dtot;
    }
}

__device__ __forceinline__ void ph_gla_out(const Params& p, unsigned char* lds_, int bid, int nblk) {
    int tid_ = threadIdx.x; asm volatile("" : "+v"(tid_));
    const int tid = tid_, lane = tid & 63, w = __builtin_amdgcn_readfirstlane(tid >> 6), i16 = lane & 15, g = lane >> 4, q4 = i16 >> 2, pp = i16 & 3;
    LAS unsigned char* lds = (LAS unsigned char*)lds_;
    const bf16_t* Q = (const bf16_t*)(p.ws + WS_Q); const bf16_t* V = (const bf16_t*)(p.ws + WS_V); const bf16_t* G = (const bf16_t*)(p.ws + WS_G);
    const float* U = (const float*)(p.ws + WS_U); const float* DD = (const float*)(p.ws + WS_DD);
    float* OFL = (float*)(p.ws + WS_OF); bf16_t* ON = (bf16_t*)(p.ws + WS_ON);
    const float ngv = p.in[I_HGNORM][16 * w + i16];
    const int troff = (4 * g + q4) * KT_STR + (4 * pp) * 2;
    for (int unit = bid; unit < 256; unit += nblk) {
        const int b = unit >> 7, h = (unit >> 4) & 7, sc = unit & 15, rbs = b * SEQ + sc * 512;
        const unsigned loff = (unsigned)((3 - g) * 4 * DM + i16);
#pragma unroll 1
        for (int dir = 0; dir < 2; ++dir) {
            const float* F = (const float*)(p.ws + (dir ? WS_LBK : WS_LF));
            GlaRegs R;
            gla_load<true>(R, F, Q, V, rbs + 64 * (dir ? 7 : 0), h, tid);
            int on_rb = -1;
#define GLA_ON_FLUSH() do { _Pragma("unroll") for (int i_ = 0; i_ < 2; ++i_) { const int id_ = tid + 512 * i_, row_ = id_ >> 4, c8_ = (id_ & 15) * 8; \
                *(u32x4*)(ON + (size_t)(on_rb + row_) * DM + h * 128 + c8_) = *(const LAS u32x4*)(lds + GL_QT + row_ * ON_STR + c8_ * 2); } } while (0)
            const int ub = ((b * 8 + h) * 2 + dir) * 17;
            f32x4 S[8];
            { const float* up = U + (size_t)(ub + 16) * 16384 + (size_t)(w * 8) * 256 + lane * 4;
#pragma unroll
                for (int j = 0; j < 8; ++j) S[j] = *(const f32x4*)(up + j * 256); }
            { const int nf = dir ? 15 - sc : sc;
                LAS float* dl = (LAS float*)(lds + GL_QT);
                for (int i = tid; i < 16 * 128; i += NTHR) dl[i] = DD[(size_t)ub * 128 + i];
                __syncthreads();
                f32x4 Ua[8];
#define FOLD_LOAD(UU, s_) do { const int u_ = dir ? 15 - (s_) : (s_); const float* up_ = U + (size_t)(ub + u_) * 16384 + (size_t)(w * 8) * 256 + lane * 4; \
                    _Pragma("unroll") for (int j = 0; j < 8; ++j) UU[j] = *(const f32x4*)(up_ + j * 256); } while (0)
                if (nf > 0) FOLD_LOAD(Ua, 0);
                for (int s = 0; s < nf; ++s) { const int u = dir ? 15 - s : s;
#pragma unroll
                    for (int j = 0; j < 8; ++j) S[j] = S[j] * *(const LAS f32x4*)(dl + u * 128 + 16 * j + 4 * g) + Ua[j];
                    if (s + 1 < nf) FOLD_LOAD(Ua, s + 1); }
#undef FOLD_LOAD
                __syncthreads();
            }
            for (int step = 0; step < 8; ++step) {
                const int n = dir ? 7 - step : step, rb = rbs + 64 * n;
                gla_put_raw<true>(R, lds, dir, tid);
                __syncthreads();
                if (on_rb >= 0) { GLA_ON_FLUSH(); on_rb = -1; }
                if (step < 7) gla_load<true>(R, F, Q, V, rbs + 64 * (dir ? 6 - step : step + 1), h, tid);
                gla_phase_a<true>(lds, tid);
                f32x4 O[4];
                if (dir) { const float* ob = OFL + ((size_t)((unit * 8 + n) * 8 + w) * 4) * 256 + ((3 - g) * 16 + i16) * 4;
#pragma unroll
                    for (int ti = 0; ti < 4; ++ti) { const f32x4 t4 = *(const f32x4*)(ob + (3 - ti) * 256); O[ti] = (f32x4){t4[3], t4[2], t4[1], t4[0]}; } }
                else {
#pragma unroll
                    for (int ti = 0; ti < 4; ++ti) O[ti] = (f32x4){0.f, 0.f, 0.f, 0.f}; }
                { const int si = w >> 1, tb = 2 * (w & 1);
                    f32x4 pa[2] = {(f32x4){0.f, 0.f, 0.f, 0.f}, (f32x4){0.f, 0.f, 0.f, 0.f}};
#pragma unroll
                    for (int c = 0; c < 4; ++c) { const LAS unsigned char* ka = lds + GL_KT + troff + (32 * c) * KT_STR + (16 * si) * 2; const bf16x8 a = cat8(lds_tr(ka), lds_tr(ka + 16 * KT_STR));
#pragma unroll
                        for (int tt = 0; tt < 2; ++tt) { const LAS unsigned char* qa = lds + GL_QT + troff + (32 * c) * KT_STR + (16 * (tb + tt)) * 2; const bf16x8 bq = cat8(lds_tr(qa), lds_tr(qa + 16 * KT_STR));
                            pa[tt] = __builtin_amdgcn_mfma_f32_16x16x32_bf16(a, bq, pa[tt], 0, 0, 0); } }
#pragma unroll
                    for (int tt = 0; tt < 2; ++tt) { const int t = 16 * (tb + tt) + i16, s0 = 16 * si + 4 * g; f32x4 v = pa[tt];
#pragma unroll
                        for (int r = 0; r < 4; ++r) v[r] = (s0 + r <= t) ? v[r] : 0.f;
                        u32x2 wv; wv.x = pk2(v[0], v[1]); wv.y = pk2(v[2], v[3]); *(LAS u32x2*)(lds + GL_PL + t * KS_STR + s0 * 2) = wv; } }
                __syncthreads();
                {
#pragma unroll
                    for (int c = 0; c < 4; ++c) { const f32x4 e0 = *(const LAS f32x4*)(lds + GL_EM + (32 * c + 4 * g) * 4), e1 = *(const LAS f32x4*)(lds + GL_EM + (32 * c + 16 + 4 * g) * 4);
                        const f32x4 a0 = S[2 * c] * e0, b0 = S[2 * c + 1] * e1; u32x4 r; r.x = pk2(a0[0], a0[1]); r.y = pk2(a0[2], a0[3]); r.z = pk2(b0[0], b0[1]); r.w = pk2(b0[2], b0[3]); const bf16x8 Sb = __builtin_bit_cast(bf16x8, r);
#pragma unroll
                        for (int ti = 0; ti < 4; ++ti) { const LAS unsigned char* qa = lds + GL_QT + troff + (32 * c) * KT_STR + (16 * ti) * 2; const bf16x8 a = cat8(lds_tr(qa), lds_tr(qa + 16 * KT_STR));
                            O[ti] = __builtin_amdgcn_mfma_f32_16x16x32_bf16(a, Sb, O[ti], 0, 0, 0); }
                        asm volatile("" ::: "memory"); } }
                bf16x8 Vf[2]; gla_load_vf(Vf, lds, w, i16, g);
#pragma unroll
                for (int ti = 0; ti < 4; ++ti) {
#pragma unroll
                    for (int c2 = 0; c2 < 2; ++c2) { const bf16x8 a = lds_pair64(lds + GL_PL + (16 * ti + i16) * KS_STR + (32 * c2 + 4 * g) * 2, 32);
                        O[ti] = __builtin_amdgcn_mfma_f32_16x16x32_bf16(a, Vf[c2], O[ti], 0, 0, 0); }
                    if (ti & 1) asm volatile("" ::: "memory"); }
                gla_state_update(S, Vf, lds, i16, g);
                if (dir == 0) {
                    float* ob = OFL + ((size_t)((unit * 8 + n) * 8 + w) * 4) * 256 + lane * 4;
#pragma unroll
                    for (int ti = 0; ti < 4; ++ti) *(f32x4*)(ob + ti * 256) = O[ti];
                    __syncthreads();
                } else {
                    float part[4][4];
#pragma unroll
                    for (int ti = 0; ti < 4; ++ti)
#pragma unroll
                        for (int r = 0; r < 4; ++r) { const float o = O[ti][r]; part[ti][r] = row16_sum(o * o); }
                    unsigned short gq[4][4];
#pragma unroll
                    for (int ti = 0; ti < 4; ++ti)
#pragma unroll
                        for (int r = 0; r < 4; ++r) { const bf16_t* gb = G + (size_t)(rb + 51 - 16 * ti - r) * DM + h * 128 + 16 * w; gq[ti][r] = gb[loff]; }
                    if (i16 == 0) {
#pragma unroll
                        for (int ti = 0; ti < 4; ++ti) *(LAS f32x4*)(lds + GL_SSQ + (w * 64 + 16 * ti + 4 * g) * 4) = (f32x4){part[ti][0], part[ti][1], part[ti][2], part[ti][3]}; }
                    __syncthreads();
                    if (tid < 64) { float s2 = 0.f;
#pragma unroll
                        for (int ww = 0; ww < 8; ++ww) s2 += ((const LAS float*)(lds + GL_SSQ))[ww * 64 + tid];
                        ((LAS float*)(lds + GL_RSTD))[tid] = 1.f / sqrtf(s2 * (1.f / 128.f) + 1e-6f); }
                    __syncthreads();
#pragma unroll
                    for (int ti = 0; ti < 4; ++ti) { const f32x4 rs = *(const LAS f32x4*)(lds + GL_RSTD + (16 * ti + 4 * g) * 4);
#pragma unroll
                        for (int r = 0; r < 4; ++r) *(LAS unsigned short*)(lds + GL_QT + (63 - (16 * ti + 4 * g + r)) * ON_STR + (16 * w + i16) * 2) = (unsigned short)f2bf(O[ti][r] * rs[r] * ngv * bf2f(gq[ti][r])); }
                    on_rb = rb;
                }
            }
            if (on_rb >= 0) { __syncthreads(); GLA_ON_FLUSH(); on_rb = -1; }
            asm volatile("s_waitcnt vmcnt(0)" ::: "memory");
            __syncthreads();
        }
    }
}

__device__ __forceinline__ void ph_modffn(const Params& p, unsigned char* lds, int bid, int nblk, int l) {
    int tid_ = threadIdx.x; asm volatile("" : "+v"(tid_));
    const int tid = tid_, lane = tid & 63, wave = tid >> 6;
    float* rw = (float*)lds;
    float* stg = (float*)(lds + 71680);
    const float* router = p.in[I_ROUTER] + (size_t)l * DM * NE;
    for (int i = tid; i < DM * NE / 4; i += NTHR) { const int d = i >> 2; *(f32x4*)(rw + d * 16 + (d >> 2) * 4 + (i & 3) * 4) = ((const f32x4*)router)[i]; }
    __syncthreads();
    const float* X = (const float*)(p.ws + WS_X); bf16_t* H = (bf16_t*)(p.ws + WS_H); float* aff = (float*)(p.ws + WS_AFF); int* slot = (int*)(p.ws + WS_SLOT);
    const float* g = p.in[I_NFFN] + (size_t)l * DM; const float* mod = (const float*)(p.ws + WS_MOD);
    for (int base = bid * 64; base < NTOK; base += nblk * 64) {
        const int b = base >> 13, t0 = base & (SEQ - 1);
        const float* mv = mod + (size_t)(l * 3 + b) * NADA; const float* sh = mv + 3 * DM; const float* sc = mv + 4 * DM;
        f32x4 nxv[4];
#pragma unroll
        for (int j = 0; j < 4; ++j) nxv[j] = *(const f32x4*)(X + (size_t)(base + 8 * wave) * DM + 256 * j + 4 * lane);
#pragma unroll 1
        for (int r = 0; r < 8; ++r) {
            const int row = base + 8 * wave + r;
            f32x4 v[4]; float ss = 0.f;
#pragma unroll
            for (int j = 0; j < 4; ++j) { v[j] = nxv[j]; ss += (v[j][0] * v[j][0] + v[j][1] * v[j][1]) + (v[j][2] * v[j][2] + v[j][3] * v[j][3]); }
            if (r < 7) {
#pragma unroll
                for (int j = 0; j < 4; ++j) nxv[j] = *(const f32x4*)(X + (size_t)(row + 1) * DM + 256 * j + 4 * lane); }
            const float rstd = 1.f / sqrtf(wave_sum(ss) * (1.f / DM) + 1e-6f);
            float lg[16];
#pragma unroll
            for (int e = 0; e < 16; ++e) lg[e] = 0.f;
#pragma unroll
            for (int j = 0; j < 4; ++j) { const int c0 = 256 * j + 4 * lane; const f32x4 gv = *(const f32x4*)(g + c0), shv = *(const f32x4*)(sh + c0), scv = *(const f32x4*)(sc + c0);
                f32x4 h;
#pragma unroll
                for (int i = 0; i < 4; ++i) { h[i] = (v[j][i] * rstd * gv[i]) * (1.f + scv[i]) + shv[i];
                    const float* rp = rw + (c0 + i) * 16 + (c0 >> 2) * 4; const f32x4 r0 = *(const f32x4*)(rp), r1 = *(const f32x4*)(rp + 4), r2 = *(const f32x4*)(rp + 8), r3 = *(const f32x4*)(rp + 12);
#pragma unroll
                    for (int e = 0; e < 4; ++e) { lg[e] += h[i] * r0[e]; lg[4 + e] += h[i] * r1[e]; lg[8 + e] += h[i] * r2[e]; lg[12 + e] += h[i] * r3[e]; }
                    asm volatile("" ::: "memory"); }
                u32x2 w; w.x = pk2(h[0], h[1]); w.y = pk2(h[2], h[3]); *(u32x2*)(H + (size_t)row * DM + c0) = w; }
            float a8[8], a4[4], a2[2], a1;
            { const bool hi = (lane & 32) != 0;
#pragma unroll
                for (int i = 0; i < 8; ++i) { const float send = hi ? lg[i] : lg[8 + i], keep = hi ? lg[8 + i] : lg[i]; a8[i] = keep + __shfl_xor(send, 32); } }
            { const bool hi = (lane & 16) != 0;
#pragma unroll
                for (int i = 0; i < 4; ++i) { const float send = hi ? a8[i] : a8[4 + i], keep = hi ? a8[4 + i] : a8[i]; a4[i] = keep + __shfl_xor(send, 16); } }
            { const bool hi = (lane & 8) != 0;
#pragma unroll
                for (int i = 0; i < 2; ++i) { const float send = hi ? a4[i] : a4[2 + i], keep = hi ? a4[2 + i] : a4[i]; a2[i] = keep + __shfl_xor(send, 8); } }
            { const bool hi = (lane & 4) != 0; const float send = hi ? a2[0] : a2[1], keep = hi ? a2[1] : a2[0]; a1 = keep + __shfl_xor(send, 4); }
            a1 += dpp_f<0x4E>(a1); a1 += dpp_f<0xB1>(a1);
            float mx = a1;
            mx = fmaxf(mx, __shfl_xor(mx, 4)); mx = fmaxf(mx, __shfl_xor(mx, 8)); mx = fmaxf(mx, __shfl_xor(mx, 16)); mx = fmaxf(mx, __shfl_xor(mx, 32));
            const float ex = expf(a1 - mx); float den = ex;
            den += __shfl_xor(den, 4); den += __shfl_xor(den, 8); den += __shfl_xor(den, 16); den += __shfl_xor(den, 32);
            if ((lane & 3) == 0) stg[((lane >> 2) & 15) * 64 + 8 * wave + r] = ex / den;
        }
        __syncthreads();
        { const int e = tid >> 5, tt = (tid & 31) * 2; *(f32x2*)(aff + (size_t)(b * NE + e) * SEQ + t0 + tt) = *(const f32x2*)(stg + e * 64 + tt);
            *(u32x2*)(slot + (size_t)base * NE + 2 * tid) = (u32x2){0xffffffffu, 0xffffffffu}; }
        __syncthreads();
    }
}

__device__ __forceinline__ void ph_topk(const Params& p, unsigned char* lds, int bid, int nblk) {
    int tid_ = threadIdx.x; asm volatile("" : "+v"(tid_)); const int tid = tid_, lane = tid & 63, wave = tid >> 6;
    unsigned* hist = (unsigned*)lds;
    unsigned* ctl = hist + 256;
    unsigned* wsum = ctl + 8;
    const float* aff = (const float*)(p.ws + WS_AFF); int* topi = (int*)(p.ws + WS_TOPI); float* topg = (float*)(p.ws + WS_TOPG); int* slot = (int*)(p.ws + WS_SLOT);
    for (int it = bid; it < NB * NE; it += nblk) {
        const int b = it >> 4, e = it & 15; const float* src = aff + (size_t)it * SEQ + 16 * tid;
        unsigned key[16];
#pragma unroll
        for (int j = 0; j < 4; ++j) { const f32x4 v = *(const f32x4*)(src + 4 * j); key[4 * j] = __float_as_uint(v[0]); key[4 * j + 1] = __float_as_uint(v[1]); key[4 * j + 2] = __float_as_uint(v[2]); key[4 * j + 3] = __float_as_uint(v[3]); }
        unsigned prefix = 0u;
#pragma unroll 1
        for (int bit = 30; bit >= 0; --bit) {
            const unsigned cand = prefix | (1u << bit);
            unsigned cnt = 0u;
#pragma unroll
            for (int i = 0; i < 16; ++i) cnt += (unsigned)__popcll(__ballot(key[i] >= cand));
            if (lane == 0) wsum[(bit & 1) * 8 + wave] = cnt;
            __syncthreads();
            unsigned tot = 0u;
#pragma unroll
            for (int w2 = 0; w2 < 8; ++w2) tot += wsum[(bit & 1) * 8 + w2];
            if (tot >= (unsigned)CAP) prefix = cand;
        }
        __syncthreads();
        unsigned cg = 0u, ce = 0u;
#pragma unroll
        for (int i = 0; i < 16; ++i) { cg += key[i] > prefix ? 1u : 0u; ce += key[i] == prefix ? 1u : 0u; }
        unsigned pk = cg | (ce << 16), inc = pk;
#pragma unroll
        for (int o = 1; o < 64; o <<= 1) { const unsigned t = __shfl_up(inc, o); if (lane >= o) inc += t; }
        if (lane == 63) wsum[wave] = inc;
        __syncthreads();
        unsigned base = 0u, total = 0u;
#pragma unroll
        for (int w2 = 0; w2 < 8; ++w2) { const unsigned t = wsum[w2]; if (w2 < wave) base += t; total += t; }
        const unsigned excl = base + inc - pk;
        unsigned rg = excl & 0xffffu, re = excl >> 16; const unsigned ngt = total & 0xffffu, kth = (unsigned)CAP - ngt;
#pragma unroll
        for (int i = 0; i < 16; ++i) { int s = -1;
            if (key[i] > prefix) { s = (int)rg; ++rg; }
            else if (key[i] == prefix) { if (re < kth) s = (int)(ngt + re); ++re; }
            if (s >= 0) { const int idx = 16 * tid + i, r = (e * NB + b) * CAP + s; topi[r] = b * SEQ + idx; topg[r] = __uint_as_float(key[i]); slot[(size_t)(b * SEQ + idx) * NE + e] = s; } }
        __syncthreads();
    }
}

__device__ __forceinline__ void ph_combine(const Params& p, int bid, int nblk, int l, bool final_) {
    int tid_ = threadIdx.x; asm volatile("" : "+v"(tid_));
    const int tid = tid_, lane = tid & 63, wave = tid >> 6, gw = bid * 8 + wave, NGW = nblk * 8;
    float* X = (float*)(p.ws + WS_X); bf16_t* H = (bf16_t*)(p.ws + WS_H); const bf16_t* Y = (const bf16_t*)(p.ws + WS_Y); const int* slot = (const int*)(p.ws + WS_SLOT);
    const float* mod = (const float*)(p.ws + WS_MOD);
    int nslot = -1; f32x4 nxv[4];
    if (gw < NTOK) { nslot = lane < 16 ? slot[(size_t)gw * NE + lane] : -1;
#pragma unroll
        for (int j = 0; j < 4; ++j) nxv[j] = *(const f32x4*)(X + (size_t)gw * DM + 256 * j + 4 * lane); }
    for (int row = gw; row < NTOK; row += NGW) {
        const int b = row >> 13;
        const float* g2 = mod + (size_t)(l * 3 + b) * NADA + 5 * DM;
        const int myslot = nslot; f32x4 xv[4];
#pragma unroll
        for (int j = 0; j < 4; ++j) xv[j] = nxv[j];
        unsigned long long m = __ballot(myslot >= 0) & 0xffffull;
        f32x4 a[4];
#pragma unroll
        for (int j = 0; j < 4; ++j) a[j] = (f32x4){0.f, 0.f, 0.f, 0.f};
        u32x2 ya[4], yb[4];
#define YLOAD(dst, e_) do { const int s_ = __shfl(myslot, (e_)); const bf16_t* yr_ = Y + (size_t)(((e_) * NB + b) * CAP + s_) * DM; \
            _Pragma("unroll") for (int j = 0; j < 4; ++j) dst[j] = *(const u32x2*)(yr_ + 256 * j + 4 * lane); } while (0)
        if (m) { const int e0 = __builtin_ctzll(m); m &= m - 1; YLOAD(ya, e0); }
        const bool any = __ballot(myslot >= 0) & 0xffffull;
        { const int r2 = row + NGW; if (r2 < NTOK) { nslot = lane < 16 ? slot[(size_t)r2 * NE + lane] : -1;
#pragma unroll
            for (int j = 0; j < 4; ++j) nxv[j] = *(const f32x4*)(X + (size_t)r2 * DM + 256 * j + 4 * lane); } }
        if (any) for (;;) {
            const bool more = m != 0ull;
            if (more) { const int e1 = __builtin_ctzll(m); m &= m - 1; YLOAD(yb, e1); }
#pragma unroll
            for (int j = 0; j < 4; ++j) { a[j][0] += __uint_as_float(ya[j].x << 16); a[j][1] += __uint_as_float(ya[j].x & 0xffff0000u); a[j][2] += __uint_as_float(ya[j].y << 16); a[j][3] += __uint_as_float(ya[j].y & 0xffff0000u); }
            if (!more) break;
#pragma unroll
            for (int j = 0; j < 4; ++j) ya[j] = yb[j];
        }
#undef YLOAD
        f32x4 v[4]; float ss = 0.f;
#pragma unroll
        for (int j = 0; j < 4; ++j) { const int c0 = 256 * j + 4 * lane; v[j] = xv[j] + *(const f32x4*)(g2 + c0) * a[j];
            ss += (v[j][0] * v[j][0] + v[j][1] * v[j][1]) + (v[j][2] * v[j][2] + v[j][3] * v[j][3]); }
        const float rstd = 1.f / sqrtf(wave_sum(ss) * (1.f / DM) + 1e-6f);
        if (final_) { const float* gf = p.in[I_NFIN];
#pragma unroll
            for (int j = 0; j < 4; ++j) { const int c0 = 256 * j + 4 * lane; const f32x4 gv = *(const f32x4*)(gf + c0); *(f32x4*)(p.out + (size_t)row * DM + c0) = v[j] * rstd * gv; }
        } else {
#pragma unroll
            for (int j = 0; j < 4; ++j) *(f32x4*)(X + (size_t)row * DM + 256 * j + 4 * lane) = v[j];
            const float* mv = mod + (size_t)((l + 1) * 3 + b) * NADA;
            store_mod_bf16(H + (size_t)row * DM, v, rstd, p.in[I_NMIX] + (size_t)(l + 1) * DM, mv, mv + DM, lane);
        }
    }
}

__device__ __forceinline__ void ph_conv(const Params& p, int bid, int nblk) {
    int tid_ = threadIdx.x; asm volatile("" : "+v"(tid_));
    const int tid = tid_, lane = tid & 63, wave = tid >> 6, gw = bid * 8 + wave, NGW = nblk * 8;
    const bf16_t* BG = (const bf16_t*)(p.ws + WS_BG); const bf16_t* CU = (const bf16_t*)(p.ws + WS_CU); bf16_t* Z = (bf16_t*)(p.ws + WS_Z);
    const float* wc = p.in[I_SCCONV];
    for (int row = gw; row < NTOK; row += NGW) { const int t = row & (SEQ - 1);
#pragma unroll
        for (int hh = 0; hh < 2; ++hh) { const int c0 = hh * 512 + 8 * lane; const size_t off = (size_t)row * DM + c0;
            const u16x8 z0 = {0, 0, 0, 0, 0, 0, 0, 0};
            const u16x8 um = t > 0 ? *(const u16x8*)(CU + off - DM) : z0, u0 = *(const u16x8*)(CU + off), up = t < SEQ - 1 ? *(const u16x8*)(CU + off + DM) : z0, bg = *(const u16x8*)(BG + off);
            float o[8];
#pragma unroll
            for (int i = 0; i < 8; ++i) o[i] = bf2f(bg[i]) * (wc[c0 + i] * bf2f(um[i]) + wc[DM + c0 + i] * bf2f(u0[i]) + wc[2 * DM + c0 + i] * bf2f(up[i]));
            u32x4 w; w.x = pk2(o[0], o[1]); w.y = pk2(o[2], o[3]); w.z = pk2(o[4], o[5]); w.w = pk2(o[6], o[7]); *(u32x4*)(Z + off) = w; }
    }
}

#define XB_TMO      128
#define XB_XCNT(j)  (256  + 64 * (j))
#define XB_XSUB(j)  (1280 + 64 * (j))
#define XB_XGEN(j)  (2304 + 64 * (j))
#define XB_TOP      3328
#define XB_TOPGEN   3392
#define XCD_BAR_WORDS 3456
#define XB_SPIN_CAP (1u << 18)
__device__ __forceinline__ unsigned xb_ld(unsigned* p)              { return __hip_atomic_load(p, __ATOMIC_RELAXED, __HIP_MEMORY_SCOPE_AGENT); }
__device__ __forceinline__ unsigned xb_add(unsigned* p, unsigned v) { return __hip_atomic_fetch_add(p, v, __ATOMIC_RELAXED, __HIP_MEMORY_SCOPE_AGENT); }
__device__ __forceinline__ unsigned xb_xcc_id() { return (unsigned)__builtin_amdgcn_s_getreg((3 << 11) | 20) & 0xFu; }
#define XB_SPIN(cond, bar) do { unsigned _sp = 0; while (cond) { __builtin_amdgcn_s_sleep(1); \
    if ((++_sp & 255u) == 0u) { if (xb_ld(&(bar)[XB_TMO])) break; if (_sp > XB_SPIN_CAP) { atomicAdd(&(bar)[XB_TMO], 1u); break; } } } } while (0)
struct XcdBarrier { unsigned* bar; unsigned x; volatile LAS unsigned* st; };
__device__ __forceinline__ XcdBarrier xcd_barrier_post(unsigned* bar, volatile LAS unsigned* st) {
    XcdBarrier b; b.bar = bar; b.x = xb_xcc_id(); b.st = st;
    if (threadIdx.x == 0) (void)xb_add(&bar[XB_XCNT(b.x)], 1u);
    return b;
}
__device__ __forceinline__ void xcd_barrier_complete(unsigned* bar, unsigned x, unsigned& nloc, unsigned& nx) {
    const unsigned G = gridDim.x * gridDim.y * gridDim.z;
    unsigned sum, cnt, mine, sp = 0u;
    for (;;) {
        sum = 0u; cnt = 0u; mine = 0u;
#pragma unroll
        for (unsigned j = 0; j < 16; ++j) { const unsigned c = xb_ld(&bar[XB_XCNT(j)]); sum += c; cnt += (c > 0u) ? 1u : 0u; mine = (j == x) ? c : mine; }
        if (sum == G) break;
        __builtin_amdgcn_s_sleep(1);
        if ((++sp & 255u) == 0u) { if (xb_ld(&bar[XB_TMO])) break; if (sp > XB_SPIN_CAP) { atomicAdd(&bar[XB_TMO], 1u); break; } }
    }
    nloc = mine > 0u ? mine : 1u; nx = cnt > 0u ? cnt : 1u;
}
__device__ __forceinline__ void xcd_barrier(const Params& p, unsigned char* lds, unsigned* bar_, volatile LAS unsigned* MISC, unsigned filler) {
    volatile LAS unsigned* st_ = MISC + 8;
    XcdBarrier b; b.bar = bar_; b.x = xb_xcc_id(); b.st = st_;
    asm volatile("s_waitcnt vmcnt(0)" ::: "memory");
    __syncthreads();
    unsigned target = 0u;
    if (threadIdx.x == 0) {
        unsigned* bar = b.bar;
        __builtin_amdgcn_s_waitcnt(0);
        unsigned nloc = b.st[0], nx = b.st[1];
        if (nloc == 0u) { xcd_barrier_complete(bar, b.x, nloc, nx); b.st[0] = nloc; b.st[1] = nx; }
        const unsigned epoch = b.st[2] + 1u; b.st[2] = epoch;
        const unsigned old = xb_add(&bar[XB_XSUB(b.x)], 1u);
        if (old + 1u == epoch * nloc) {
            __builtin_amdgcn_fence(__ATOMIC_RELEASE, "agent");
            asm volatile("s_waitcnt vmcnt(0)" ::: "memory");
            (void)xb_add(&bar[XB_TOP], 1u);
        }
        target = epoch * nx;
    }
    if (filler) {
        for (;;) {
            if (threadIdx.x == 0) MISC[MW_REL] = (xb_ld(&b.bar[XB_TOP]) >= target || xb_ld(&b.bar[XB_TMO])) ? 1u : 0u;
            __syncthreads();
            const unsigned rel = MISC[MW_REL];
            __syncthreads();
            if (rel) break;
            if (!cvt_batch(p, lds, MISC, filler)) break;
        }
    }
    if (threadIdx.x == 0) {
        XB_SPIN(xb_ld(&b.bar[XB_TOP]) < target, b.bar);
        __builtin_amdgcn_fence(__ATOMIC_ACQUIRE, "agent");
        asm volatile("s_waitcnt vmcnt(0)" ::: "memory");
    }
    __syncthreads();
}

constexpr int NPHASE = 19;
constexpr int CVB_P2 = 2, CVB_P8 = 4;
constexpr int MISC_OFF = 146944;
constexpr int CW_BAR = 4096;
constexpr int CW_CTX = 1024;
template <int LO, int HI> __global__ void __launch_bounds__(NTHR, 2) mega(Params p) {
    extern __shared__ __attribute__((aligned(16))) unsigned char lds[];
    const int bid = blockIdx.x, nblk = gridDim.x;
    PG8_LAS unsigned char* l3 = (PG8_LAS unsigned char*)lds;
    unsigned char* ws = p.ws;
    const float* mod = (const float*)(ws + WS_MOD);
    constexpr bool MULTI = (HI - LO) > 1;
    if (MULTI) {
        volatile LAS unsigned* MISC = (volatile LAS unsigned*)(l3 + MISC_OFF);
        if (threadIdx.x < 32) MISC[threadIdx.x] = 0u;
        __syncthreads();
        (void)xcd_barrier_post((unsigned*)(ws + WS_CTL) + CW_BAR, MISC + 8);
    }
#define IN(k) (LO <= (k) && (k) < HI)
#ifndef PROBE_DUP
#define PROBE_DUP 0u
#endif
#define DUPQ(k) (((PROBE_DUP) >> (k)) & 1u)
#define MISCP ((volatile LAS unsigned*)(l3 + MISC_OFF))
#define BARRIER_MASK(m) xcd_barrier(p, lds, (unsigned*)(p.ws + WS_CTL) + CW_BAR, MISCP, (m))
#define BARRIER_NOW() BARRIER_MASK(0u)
#define SEAM(k) do { if (IN(k) && IN((k) + 1)) BARRIER_MASK(((k) <= 6 ? 1u : 0u) | ((k) <= 14 ? 2u : 0u)); } while (0)
#define PHASE(k, ...) do { if (IN(k)) { __VA_ARGS__; if (DUPQ(k)) { BARRIER_NOW(); __VA_ARGS__; } } SEAM(k); } while (0)
#define GEMM_INPROJ() do { pg8::Gemm g{(const bf16_t*)(ws + WS_H), (const bf16_t*)(ws + WS_WHGIN), NTOK, 5120, DM}; pg8::StaticOrder S; S.init(NTOK, 5120, nblk, bid, 0); EpiInProj E{ws}; pg8::gemm_phase<EpiInProj, pg8::StaticOrder, false>(l3, g, S, E, nullptr); } while (0)
#define GEMM_OUT(AOFF, WOFF, GATE) do { pg8::Gemm g{(const bf16_t*)(ws + (AOFF)), (const bf16_t*)(ws + (WOFF)), NTOK, DM, DM}; pg8::StaticOrder S; S.init(NTOK, DM, nblk, bid, 0); EpiResid E{(float*)(ws + WS_X), (GATE)}; pg8::gemm_phase<EpiResid, pg8::StaticOrder, false>(l3, g, S, E, nullptr); } while (0)
#define GEMM_MOE1(l) do { pg8::Gemm g{(const bf16_t*)(ws + WS_H), (const bf16_t*)(ws + WS_WMOE1) + (size_t)(l) * NE * 4096 * DM, NSLOT, 4096, DM}; pg8::StaticOrder S; S.init(NSLOT, 4096, nblk, bid, 8); EpiGLU E{(bf16_t*)(ws + WS_ACT)}; pg8::gemm_phase<EpiGLU, pg8::StaticOrder, true>(l3, g, S, E, (const int*)(ws + WS_TOPI)); } while (0)
#define GEMM_MOE2(l) do { pg8::Gemm g{(const bf16_t*)(ws + WS_ACT), (const bf16_t*)(ws + WS_WMOE2) + (size_t)(l) * NE * DM * DE, NSLOT, DM, DE}; pg8::StaticOrder S; S.init(NSLOT, DM, nblk, bid, 8); EpiRowScale E{(bf16_t*)(ws + WS_Y), (const float*)(ws + WS_TOPG)}; pg8::gemm_phase<EpiRowScale, pg8::StaticOrder, false>(l3, g, S, E, nullptr); } while (0)
#define GEMM_CONVIN() do { pg8::Gemm g{(const bf16_t*)(ws + WS_H), (const bf16_t*)(ws + WS_WSCIN), NTOK, 3072, DM}; pg8::StaticOrder S; S.init(NTOK, 3072, nblk, bid, 0); EpiConvIn E{(bf16_t*)(ws + WS_BG), (bf16_t*)(ws + WS_CU)}; pg8::gemm_phase<EpiConvIn, pg8::StaticOrder, false>(l3, g, S, E, nullptr); } while (0)
#define MOD0_PHASE() do { if (nblk >= 48) { if (bid < 24) { ph_mod0(p, NTOK + (bid * NCTX) / 24, NTOK + ((bid + 1) * NCTX) / 24, 0, 1); \
              \
            asm volatile("s_waitcnt vmcnt(0)" ::: "memory"); __syncthreads(); \
            if (threadIdx.x == 0) { unsigned* cnt = (unsigned*)(p.ws + WS_CTL) + CW_CTX; __builtin_amdgcn_fence(__ATOMIC_RELEASE, "agent"); asm volatile("s_waitcnt vmcnt(0)" ::: "memory"); \
                xb_add(cnt, 1u); unsigned sp_ = 0u; while (xb_ld(cnt) < 24u) { __builtin_amdgcn_s_sleep(1); if (++sp_ > (1u << 22)) break; } \
                __builtin_amdgcn_fence(__ATOMIC_ACQUIRE, "agent"); asm volatile("s_waitcnt vmcnt(0)" ::: "memory"); } \
            __syncthreads(); \
            pg8::Gemm g{(const bf16_t*)(ws + WS_H), (const bf16_t*)(ws + WS_WHGIN), NROW, 5120, DM}; pg8::OneUnit S{64 + bid / 12, 4 + bid % 12}; EpiInProj E{ws}; pg8::gemm_phase<EpiInProj, pg8::OneUnit, false>(l3, g, S, E, nullptr); } \
          else ph_mod0(p, 0, NTOK, bid - 24, nblk - 24); } \
        else { ph_mod0(p, 0, NROW, bid, nblk); } } while (0)
#define CTX_TILES_FALLBACK() do { if (nblk < 48) { BARRIER_NOW(); pg8::Gemm g{(const bf16_t*)(ws + WS_H), (const bf16_t*)(ws + WS_WHGIN), NROW, 5120, DM}; \
        for (int ti = bid; ti < 24; ti += nblk) { pg8::OneUnit S{64 + ti / 12, 4 + ti % 12}; EpiInProj E{ws}; pg8::gemm_phase<EpiInProj, pg8::OneUnit, false>(l3, g, S, E, nullptr); } } } while (0)
    PHASE(0, ph_prep(p, lds, bid, nblk); __syncthreads(); ph_convert_small(p, lds, bid, nblk));
    if (IN(1)) { MOD0_PHASE(); CTX_TILES_FALLBACK(); }
    SEAM(1);
#define HOSTED(GEMM_RANGE, NR, NBATCH) do { const bool odd_ = (bid & 1) != 0; \
        if (odd_) cvt_budget(p, lds, MISCP, 3u, NBATCH); \
        GEMM_RANGE(0, NR); __syncthreads(); \
        if (!odd_) cvt_budget(p, lds, MISCP, 3u, NBATCH); } while (0)
#define GEMM_INPROJ_R(LO_, HI_) do { pg8::Gemm g{(const bf16_t*)(ws + WS_H), (const bf16_t*)(ws + WS_WHGIN), NTOK, 5120, DM}; pg8::RangeOrder S; S.S.init(NTOK, 5120, nblk, bid, 0); S.lo = (LO_); S.hi = (HI_); EpiInProj E{ws}; pg8::gemm_phase<EpiInProj, pg8::RangeOrder, false>(l3, g, S, E, nullptr); } while (0)
#define GEMM_MOE1_R0(LO_, HI_) do { pg8::Gemm g{(const bf16_t*)(ws + WS_H), (const bf16_t*)(ws + WS_WMOE1), NSLOT, 4096, DM}; pg8::RangeOrder S; S.S.init(NSLOT, 4096, nblk, bid, 8); S.lo = (LO_); S.hi = (HI_); EpiGLU E{(bf16_t*)(ws + WS_ACT)}; pg8::gemm_phase<EpiGLU, pg8::RangeOrder, true>(l3, g, S, E, (const int*)(ws + WS_TOPI)); } while (0)
    PHASE(2, HOSTED(GEMM_INPROJ_R, 5, CVB_P2));
    PHASE(3, ph_gla_states(p, lds, bid, nblk));
    PHASE(4, ph_gla_out(p, lds, bid, nblk));
    if (IN(5)) GEMM_OUT(WS_ON, WS_WHGOUT, mod + 2 * DM);
    SEAM(5);
    PHASE(6, ph_modffn(p, lds, bid, nblk, 0));
    PHASE(7, if (bid < NB * NE) ph_topk(p, lds, bid, nblk); if (nblk <= NB * NE || bid >= NB * NE) { __syncthreads(); cvt_budget(p, lds, MISCP, 1u, 1 << 20); });
    PHASE(8, HOSTED(GEMM_MOE1_R0, 8, CVB_P8));
    PHASE(9, GEMM_MOE2(0));
    if (IN(10)) ph_combine(p, bid, nblk, 0, false);
    SEAM(10);
    PHASE(11, GEMM_CONVIN());
    PHASE(12, ph_conv(p, bid, nblk));
    if (IN(13)) GEMM_OUT(WS_Z, WS_WSCOUT, mod + (size_t)3 * NADA + 2 * DM);
    SEAM(13);
    PHASE(14, ph_modffn(p, lds, bid, nblk, 1));
    PHASE(15, if (bid < NB * NE) ph_topk(p, lds, bid, nblk); if (nblk <= NB * NE || bid >= NB * NE) { __syncthreads(); cvt_budget(p, lds, MISCP, 2u, 1 << 20); });
    PHASE(16, GEMM_MOE1(1));
    PHASE(17, GEMM_MOE2(1));
    if (IN(18)) ph_combine(p, bid, nblk, 1, true);
#undef IN
#undef SEAM
}

#ifndef MK_SPLIT
#define MK_SPLIT 0
#endif
#if MK_SPLIT
#include <utility>
template <int... I> static void launch_all(std::integer_sequence<int, I...>, int grid, Params& p, hipStream_t stream) {
    ((void)hipFuncSetAttribute((const void*)mega<I, I + 1>, hipFuncAttributeMaxDynamicSharedMemorySize, LDS_BYTES), ...);
    ((mega<I, I + 1><<<dim3(grid), dim3(NTHR), LDS_BYTES, stream>>>(p)), ...); }
#endif
extern "C" void kernel_launch(void* const* d_in, const int* in_sizes, int n_in, void* d_out, int out_size, void* d_ws, size_t ws_size, hipStream_t stream) {
    static int grid = 0;
    if (grid == 0) {
        if (n_in != 20 || ws_size < WS_END) { fprintf(stderr, "kernel_launch: unexpected inputs (n_in %d, ws %zu, need %zu)\n", n_in, ws_size, (size_t)WS_END); grid = -1; return; }
        int dev = 0, cus = 0, per_cu = 0;
        (void)hipGetDevice(&dev); (void)hipDeviceGetAttribute(&cus, hipDeviceAttributeMultiprocessorCount, dev);
        (void)hipFuncSetAttribute((const void*)mega<0, NPHASE>, hipFuncAttributeMaxDynamicSharedMemorySize, LDS_BYTES);
        if (hipOccupancyMaxActiveBlocksPerMultiprocessor(&per_cu, (const void*)mega<0, NPHASE>, NTHR, LDS_BYTES) != hipSuccess || per_cu < 1) { fprintf(stderr, "kernel_launch: occupancy query failed (%d)\n", per_cu); per_cu = 1; }
        (void)hipGetLastError();
        if (per_cu > 1) per_cu = 1;
        grid = (cus > 0 ? cus : 256) * per_cu;
    }
    if (grid < 0) return;
    Params p{};
    for (int i = 0; i < 20; ++i) p.in[i] = (const float*)d_in[i];
    p.out = (float*)d_out; p.ws = (unsigned char*)d_ws;
#if MK_SPLIT
    launch_all(std::make_integer_sequence<int, NPHASE>{}, grid, p, stream);
#else
    (void)hipMemsetAsync((char*)d_ws + WS_CTL, 0, 65536, stream);
    void* args[] = {&p};
    hipError_t e = hipLaunchCooperativeKernel((const void*)mega<0, NPHASE>, dim3(grid), dim3(NTHR), args, LDS_BYTES, stream);
    if (e != hipSuccess) fprintf(stderr, "kernel_launch: cooperative launch failed: %s (grid %d)\n", hipGetErrorString(e), grid);
#endif
}
```

```cpp
#include <hip/hip_runtime.h>
#include <cstdio>
#include <cstdint>

namespace pg8 {
#define PG8_LAS __attribute__((address_space(3)))
typedef unsigned short bf16_t;
typedef short bf16x8 __attribute__((ext_vector_type(8)));
typedef float f32x4 __attribute__((ext_vector_type(4)));
typedef unsigned u32x4 __attribute__((ext_vector_type(4)));
typedef unsigned u32x2 __attribute__((ext_vector_type(2)));
constexpr int BM = 256, BK = 64, HALF = 128, HTB = HALF * BK * 2, STAGE_BYTES = 8 * HTB, NXCD = 8, WGM = 8;

__host__ __device__ __forceinline__ int lds_byte(int r, int c) { const int st = (r >> 4) * 2 + (c >> 5), rr = r & 15, cc = c & 31, ob = rr * 64 + cc * 2; return st * 1024 + (ob ^ (((ob >> 9) & 1) << 5)); }
__host__ __device__ __forceinline__ void stage_rc(int b, int& R, int& C) { const int st = b / 1024, sb = b % 1024, swz = sb ^ (((sb >> 9) & 1) << 5); R = (st >> 1) * 16 + swz / 64; C = (st & 1) * 32 + (swz % 64) / 2; }
__host__ __device__ __forceinline__ int perm32(int rho) { const int n = rho >> 4, i = rho & 15; return 8 * (i >> 2) + 4 * n + (i & 3); }

struct Unit { int pm, pn, pb; };
struct Gemm { const bf16_t* A; const bf16_t* Bt; int M, N, K; };

struct StaticOrder {
    int nM, nN, nwg, G, c, mpe;
    __device__ void init(int M, int N, int G_, int c_, int mpe_) { nM = M / BM; nN = N / BM; nwg = nM * nN; G = G_; c = c_; mpe = mpe_; }
    __device__ bool next(int i, Unit& u) const {
        const long L = (long)i * G + c; if (L >= nwg) return false;
        int wgid = (int)L; { const int q = nwg / NXCD, r = nwg % NXCD, xcd = wgid % NXCD, off = wgid / NXCD; wgid = (xcd < r ? xcd * (q + 1) : r * (q + 1) + (xcd - r) * q) + off; }
        const int nig = WGM * nN, gid = wgid / nig, fm = gid * WGM, gsz = (nM - fm) < WGM ? (nM - fm) : WGM;
        u.pm = fm + ((wgid % nig) % gsz); u.pn = (wgid % nig) / gsz; u.pb = mpe > 0 ? (u.pm / mpe) * nN + u.pn : u.pn; return true;
    }
};

__device__ __forceinline__ unsigned cvt_pk_bf16(float lo, float hi) { unsigned r; asm volatile("v_cvt_pk_bf16_f32 %0, %1, %2" : "=v"(r) : "v"(lo), "v"(hi)); return r; }

struct RangeOrder {
    StaticOrder S; int lo, hi;
    __device__ bool next(int i, Unit& u) const { return (lo + i < hi) ? S.next(lo + i, u) : false; }
};
struct OneUnit {
    int pm, pn;
    __device__ bool next(int i, Unit& u) const { if (i != 0) return false; u.pm = pm; u.pn = pn; u.pb = pn; return true; }
};
template <class Epi, class Sched, bool GATHER>
__device__ __forceinline__ void gemm_phase(PG8_LAS unsigned char* lds, const Gemm g, const Sched& S, const Epi& E, const int* gidx) {
    int tid_ = threadIdx.x; asm volatile("" : "+v"(tid_));
    const int tid = tid_, wid = __builtin_amdgcn_readfirstlane(tid >> 6), lane = tid & 63, wr = wid >> 2, wc = wid & 3, fr = lane & 15, fq = lane >> 4;
    const int K = g.K, nt = K / BK;
    unsigned voffA[2], voffB[2]; int rA[2], cA2[2];
#pragma unroll
    for (int i = 0; i < 2; ++i) { int R, C; stage_rc(tid * 16 + i * 8192, R, C); const int Rb = Epi::PERM ? ((R & ~31) + perm32(R & 31)) : R;
        voffA[i] = (unsigned)(R * K + C) * 2u; voffB[i] = (unsigned)(Rb * K + C) * 2u; rA[i] = R; cA2[i] = C * 2; }
    unsigned gcur[2][2], gnxt[2][2];
#define PG8_GOFF(dst, u) do { _Pragma("unroll") for (int _h = 0; _h < 2; ++_h) _Pragma("unroll") for (int _i = 0; _i < 2; ++_i) \
        dst[_h][_i] = (unsigned)gidx[(u).pm * BM + _h * HALF + rA[_i]] * (unsigned)(K * 2) + (unsigned)cA2[_i]; } while (0)
    const size_t kstep = (size_t)(BK * 2);
    const size_t hstep = (size_t)HALF * K * 2;
    const size_t tstep = 2 * hstep;
    const unsigned ldsw = (unsigned)wid * 1024u;
    const int aoff = lds_byte(wr * 64 + fr, fq * 8), boff = lds_byte(wc * 32 + fr, fq * 8);
#define PG8_SA(b, h) (((b) * 2 + (h)) * HTB)
#define PG8_SB(b, h) ((4 + (b) * 2 + (h)) * HTB)
#define PG8_STAGE(bufoff, gbase, voff) do { _Pragma("unroll") for (int _i = 0; _i < 2; ++_i) \
        __builtin_amdgcn_global_load_lds((const unsigned*)((const char*)(gbase) + (voff)[_i]), (PG8_LAS unsigned*)(lds + (bufoff) + ldsw + _i * 8192), 16, 0, 0); } while (0)
#define PG8_STAGE_A(bufoff, half, kb, NX) do { _Pragma("unroll") for (int _i = 0; _i < 2; ++_i) { \
        const char* _src = GATHER ? (const char*)g.A + (kb) + ((NX) ? gnxt[half][_i] : gcur[half][_i]) : ((NX) ? nA : cA) + (size_t)(half) * hstep + (kb) + voffA[_i]; \
        __builtin_amdgcn_global_load_lds((const unsigned*)_src, (PG8_LAS unsigned*)(lds + (bufoff) + ldsw + _i * 8192), 16, 0, 0); } } while (0)
#define PG8_LDA(dst, b, h) do { _Pragma("unroll") for (int m = 0; m < 4; ++m) _Pragma("unroll") for (int k = 0; k < 2; ++k) dst[m][k] = *(const PG8_LAS bf16x8*)(lds + PG8_SA(b, h) + aoff + m * 2048 + k * 1024); } while (0)
#define PG8_LDB(dst, b, h) do { _Pragma("unroll") for (int n = 0; n < 2; ++n) _Pragma("unroll") for (int k = 0; k < 2; ++k) dst[n][k] = *(const PG8_LAS bf16x8*)(lds + PG8_SB(b, h) + boff + n * 2048 + k * 1024); } while (0)
#define PG8_MMA(ai, bj, At, Bt) do { __builtin_amdgcn_s_setprio(1); _Pragma("unroll") for (int m = 0; m < 4; ++m) _Pragma("unroll") for (int n = 0; n < 2; ++n) _Pragma("unroll") for (int k = 0; k < 2; ++k) \
        acc[ai][bj][m][n] = __builtin_amdgcn_mfma_f32_16x16x32_bf16(Bt[n][k], At[m][k], acc[ai][bj][m][n], 0, 0, 0); __builtin_amdgcn_s_setprio(0); } while (0)
#define PG8_WAIT_V(n) asm volatile("s_waitcnt vmcnt(" #n ")" ::: "memory")
#define PG8_WAIT_L(n) asm volatile("s_waitcnt lgkmcnt(" #n ")" ::: "memory")
#define PG8_BAR __builtin_amdgcn_s_barrier()
#define PG8_SCHED __builtin_amdgcn_sched_barrier(0)
    Unit cur, nxt; int ui = 0;
    if (!S.next(0, cur)) return;
    f32x4 acc[2][2][4][2];
#pragma unroll
    for (int a = 0; a < 2; ++a)
#pragma unroll
        for (int b = 0; b < 2; ++b)
#pragma unroll
            for (int m = 0; m < 4; ++m)
#pragma unroll
                for (int n = 0; n < 2; ++n) acc[a][b][m][n] = (f32x4){0.f, 0.f, 0.f, 0.f};
    bf16x8 At[4][2], B0[2][2], B1[2][2];
    const char* cA = GATHER ? (const char*)g.A : (const char*)g.A + (size_t)cur.pm * tstep; const char* cB = (const char*)g.Bt + (size_t)cur.pb * tstep; const char* nA = cA;
    if (GATHER) { PG8_GOFF(gcur, cur); }
    PG8_STAGE(PG8_SB(0, 0), cB, voffB); PG8_STAGE(PG8_SB(0, 1), cB + hstep, voffB); PG8_STAGE_A(PG8_SA(0, 0), 0, 0, false); PG8_STAGE_A(PG8_SA(0, 1), 1, 0, false);
    if (wr == 1) PG8_BAR;
    PG8_WAIT_V(2); PG8_BAR;
    PG8_STAGE(PG8_SB(1, 0), cB + kstep, voffB); PG8_STAGE_A(PG8_SA(1, 0), 0, kstep, false); PG8_STAGE(PG8_SB(1, 1), cB + hstep + kstep, voffB);
    PG8_WAIT_V(6); PG8_BAR;
    for (;;) {
        const bool has_next = S.next(ui + 1, nxt);
        nA = GATHER ? cA : (has_next ? (const char*)g.A + (size_t)nxt.pm * tstep : cA); const char* nB = has_next ? (const char*)g.Bt + (size_t)nxt.pb * tstep : cB;
        if (GATHER) { if (has_next) { PG8_GOFF(gnxt, nxt); } else {
#pragma unroll
            for (int _h = 0; _h < 2; ++_h)
#pragma unroll
                for (int _i = 0; _i < 2; ++_i) gnxt[_h][_i] = gcur[_h][_i]; } }
        for (int t = 0; t < nt; t += 2) {
            const bool last = (t == nt - 2);
            const size_t k1 = (size_t)(t + 1) * kstep, k2 = last ? 0 : (size_t)(t + 2) * kstep, k3 = k2 + kstep;
            const char* b2 = last ? nB : cB + (size_t)(t + 2) * kstep; const char* b3 = b2 + kstep;
            PG8_LDB(B0, 0, 0); PG8_LDB(B1, 0, 1); PG8_SCHED; PG8_LDA(At, 0, 0); PG8_STAGE_A(PG8_SA(1, 1), 1, k1, false);
            PG8_WAIT_V(8); PG8_WAIT_L(0); PG8_BAR; PG8_MMA(0, 0, At, B0); PG8_MMA(0, 1, At, B1); PG8_BAR; PG8_SCHED;
            PG8_LDA(At, 0, 1); PG8_STAGE(PG8_SB(0, 0), b2, voffB); PG8_STAGE(PG8_SB(0, 1), b2 + hstep, voffB); PG8_STAGE_A(PG8_SA(0, 0), 0, k2, last);
            PG8_WAIT_V(8); PG8_WAIT_L(0); PG8_BAR; PG8_MMA(1, 0, At, B0); PG8_MMA(1, 1, At, B1); PG8_BAR; PG8_SCHED;
            PG8_LDB(B0, 1, 0); PG8_LDB(B1, 1, 1); PG8_SCHED; PG8_LDA(At, 1, 0); PG8_STAGE_A(PG8_SA(0, 1), 1, k2, last);
            PG8_WAIT_V(8); PG8_WAIT_L(0); PG8_BAR; PG8_MMA(0, 0, At, B0); PG8_MMA(0, 1, At, B1); PG8_BAR; PG8_SCHED;
            PG8_LDA(At, 1, 1); PG8_STAGE(PG8_SB(1, 0), b3, voffB); PG8_STAGE(PG8_SB(1, 1), b3 + hstep, voffB); PG8_STAGE_A(PG8_SA(1, 0), 0, k3, last);
            PG8_WAIT_V(8); PG8_WAIT_L(0); PG8_BAR; PG8_MMA(1, 0, At, B0); PG8_MMA(1, 1, At, B1); PG8_BAR; PG8_SCHED;
        }
        if (wr == 0) PG8_BAR;
        E(acc, cur, wr, wc, fr, fq);
        if (!has_next) break;
#pragma unroll
        for (int a = 0; a < 2; ++a)
#pragma unroll
            for (int b = 0; b < 2; ++b)
#pragma unroll
                for (int m = 0; m < 4; ++m)
#pragma unroll
                    for (int n = 0; n < 2; ++n) acc[a][b][m][n] = (f32x4){0.f, 0.f, 0.f, 0.f};
        cur = nxt; cA = nA; cB = nB; ++ui;
        if (GATHER) {
#pragma unroll
            for (int _h = 0; _h < 2; ++_h)
#pragma unroll
                for (int _i = 0; _i < 2; ++_i) gcur[_h][_i] = gnxt[_h][_i]; }
        if (wr == 1) PG8_BAR;
    }
    PG8_WAIT_V(0);
    PG8_BAR;
#undef PG8_SA
#undef PG8_SB
#undef PG8_STAGE
#undef PG8_STAGE_A
#undef PG8_GOFF
#undef PG8_LDA
#undef PG8_LDB
#undef PG8_MMA
#undef PG8_WAIT_V
#undef PG8_WAIT_L
#undef PG8_BAR
#undef PG8_SCHED
}
}

#define LAS __attribute__((address_space(3)))
using pg8::bf16_t; using pg8::f32x4; using pg8::u32x4; using pg8::u32x2;
typedef unsigned short u16x8 __attribute__((ext_vector_type(8)));
typedef float f32x2 __attribute__((ext_vector_type(2)));

constexpr int DM = 1024, NB = 2, SEQ = 8192, NTOK = NB * SEQ, CTXL = 256, NCTX = NB * CTXL, NROW = NTOK + NCTX;
constexpr int NE = 16, CAP = 1024, DE = 2048, NSLOT = NE * NB * CAP;
constexpr int NADA = 6 * DM;
constexpr int NTHR = 512;

constexpr size_t MiB = 1u << 20;
constexpr size_t WS_CTL = 0;
constexpr size_t WS_MOD = 1 * MiB;
constexpr size_t WS_LB = WS_MOD + 256 * 1024;
constexpr size_t WS_POSR = WS_LB + 64 * 1024;
constexpr size_t WS_POSC = WS_POSR + 256 * 1024;
constexpr size_t WS_AFF = 2 * MiB;
constexpr size_t WS_TOPI = 3 * MiB;
constexpr size_t WS_TOPG = WS_TOPI + 128 * 1024;
constexpr size_t WS_SLOT = 4 * MiB;
constexpr size_t WS_WHGIN = 6 * MiB;
constexpr size_t WS_WHGOUT = 16 * MiB;
constexpr size_t WS_WSCIN = 18 * MiB;
constexpr size_t WS_WSCOUT = 24 * MiB;
constexpr size_t WS_WMOE1 = 26 * MiB;
constexpr size_t WS_WMOE2 = WS_WMOE1 + 256 * MiB;
constexpr size_t WS_X = WS_WMOE2 + 128 * MiB;
constexpr size_t WS_H = WS_X + 64 * MiB;
constexpr size_t WS_R = WS_H + 34 * MiB;
constexpr size_t WS_Q = WS_R;
constexpr size_t WS_V = WS_Q + 34 * MiB;
constexpr size_t WS_G = WS_V + 34 * MiB;
constexpr size_t WS_LF = WS_G + 34 * MiB;
constexpr size_t WS_LBK = WS_LF + 66 * MiB;
constexpr size_t WS_OF = WS_LBK + 66 * MiB;
constexpr size_t WS_OB = WS_OF + 64 * MiB;
constexpr size_t WS_U = WS_OB;
constexpr size_t WS_DD = WS_OB + 40 * MiB;
constexpr size_t WS_ON = WS_OB + 64 * MiB;
constexpr size_t WS_HG_END = WS_ON + 32 * MiB;
constexpr size_t WS_XG = WS_R;
constexpr size_t WS_ACT = WS_XG + 64 * MiB;
constexpr size_t WS_Y = WS_ACT + 128 * MiB;
constexpr size_t WS_MOE_END = WS_Y + 128 * MiB;
constexpr size_t WS_BG = WS_R;
constexpr size_t WS_CU = WS_BG + 32 * MiB;
constexpr size_t WS_Z = WS_CU + 32 * MiB;
constexpr size_t WS_END = WS_HG_END > WS_MOE_END ? WS_HG_END : WS_MOE_END;
static_assert(WS_END <= 1024 * MiB, "workspace map exceeds 1 GiB");

constexpr int LDS_BYTES = 147456;

struct Params { const float* in[20]; float* out; unsigned char* ws; int ph_lo, ph_hi; };
enum { I_X = 0, I_C, I_CTX, I_CCTX, I_ADAW, I_ADAB, I_NMIX, I_NFFN, I_NFIN, I_HGWIN, I_HGLB, I_HGNORM, I_HGWOUT, I_SCWIN, I_SCCONV, I_SCWOUT, I_ROUTER, I_WGATE, I_WUP, I_WDOWN };

typedef __bf16 bf16x2_t __attribute__((ext_vector_type(2)));
__device__ __forceinline__ unsigned pk2(float lo, float hi) { const f32x2 v = {lo, hi}; return __builtin_bit_cast(unsigned, __builtin_convertvector(v, bf16x2_t)); }
__device__ __forceinline__ unsigned f2bf(float f) { return pk2(f, 0.f) & 0xffffu; }
__device__ __forceinline__ float bf2f(unsigned short h) { return __builtin_bit_cast(float, (unsigned)h << 16); }
template <int CTRL> __device__ __forceinline__ float dpp_f(float x) { return __builtin_bit_cast(float, __builtin_amdgcn_update_dpp(0, __builtin_bit_cast(int, x), CTRL, 0xf, 0xf, true)); }
__device__ __forceinline__ float row16_sum(float x) {
    x += dpp_f<0xB1>(x);
    x += dpp_f<0x4E>(x);
    x += dpp_f<0x141>(x);
    x += dpp_f<0x140>(x);
    return x;
}
__device__ __forceinline__ float wave_sum(float v) { v = row16_sum(v); v += __shfl_xor(v, 16); v += __shfl_xor(v, 32); return v; }
__device__ __forceinline__ float sigmoidf_(float x) { return 1.f / (1.f + expf(-x)); }
__device__ __forceinline__ float fsigmoid(float x) { return __builtin_amdgcn_rcpf(1.f + __builtin_amdgcn_exp2f(-1.4426950408889634f * x)); }
__device__ __forceinline__ float fsilu(float x) { return x * fsigmoid(x); }
__device__ __forceinline__ float siluf_(float x) { return x / (1.f + expf(-x)); }

struct EpiInProj {
    static constexpr bool PERM = false;
    unsigned char* ws;
    __device__ __forceinline__ void operator()(const f32x4 (&acc)[2][2][4][2], const pg8::Unit& u, int wr, int wc, int fr, int fq) const {
        const int sec = u.pn >> 2;
        const int row0 = u.pm * 256 + wr * 64 + fr, cb = (u.pn & 3) * 256 + wc * 32 + 4 * fq;
        if (sec == 0 || sec == 1 || sec == 4) {
            bf16_t* O = (bf16_t*)(ws + (sec == 0 ? WS_Q : (sec == 1 ? WS_V : WS_G)));
#pragma unroll
            for (int ai = 0; ai < 2; ++ai)
#pragma unroll
                for (int m = 0; m < 4; ++m) { bf16_t* rp = O + (size_t)(row0 + ai * 128 + m * 16) * DM + cb;
#pragma unroll
                    for (int bj = 0; bj < 2; ++bj)
#pragma unroll
                        for (int n = 0; n < 2; ++n) { f32x4 v = acc[ai][bj][m][n];
                            if (sec == 0) v = v * 0.08838834764831845f;
                            if (sec == 4) { v[0] = fsilu(v[0]); v[1] = fsilu(v[1]); v[2] = fsilu(v[2]); v[3] = fsilu(v[3]); }
                            u32x2 w; w.x = pk2(v[0], v[1]); w.y = pk2(v[2], v[3]); *(u32x2*)(rp + bj * 128 + n * 16) = w; } }
        } else {
            float* O = (float*)(ws + (sec == 2 ? WS_LF : WS_LBK)); const float* lb0 = (const float*)(ws + WS_LB);
            f32x4 lbv[2][2];
#pragma unroll
            for (int bj = 0; bj < 2; ++bj)
#pragma unroll
                for (int n = 0; n < 2; ++n) lbv[bj][n] = *(const f32x4*)(lb0 + cb + bj * 128 + n * 16);
#pragma unroll
            for (int ai = 0; ai < 2; ++ai)
#pragma unroll
                for (int m = 0; m < 4; ++m) { float* rp = O + (size_t)(row0 + ai * 128 + m * 16) * DM + cb;
#pragma unroll
                    for (int bj = 0; bj < 2; ++bj)
#pragma unroll
                        for (int n = 0; n < 2; ++n) { const f32x4 z = acc[ai][bj][m][n], lb = lbv[bj][n]; f32x4 o;
#pragma unroll
                            for (int i = 0; i < 4; ++i) o[i] = lb[i] + (1.f - lb[i]) * fsigmoid(z[i]);
                            *(f32x4*)(rp + bj * 128 + n * 16) = o; } }
        }
    }
};
struct EpiResid {
    static constexpr bool PERM = false;
    float* X; const float* gate;
    __device__ __forceinline__ void operator()(const f32x4 (&acc)[2][2][4][2], const pg8::Unit& u, int wr, int wc, int fr, int fq) const {
        const int row0 = u.pm * 256 + wr * 64 + fr, cb = u.pn * 256 + wc * 32 + 4 * fq;
        const float* gp = gate + (size_t)((u.pm * 256) / SEQ) * NADA + cb;
        f32x4 gv[2][2];
#pragma unroll
        for (int bj = 0; bj < 2; ++bj)
#pragma unroll
            for (int n = 0; n < 2; ++n) gv[bj][n] = *(const f32x4*)(gp + bj * 128 + n * 16);
#pragma unroll
        for (int ai = 0; ai < 2; ++ai)
#pragma unroll
            for (int m = 0; m < 4; ++m) { float* rp = X + (size_t)(row0 + ai * 128 + m * 16) * DM + cb;
#pragma unroll
                for (int bj = 0; bj < 2; ++bj)
#pragma unroll
                    for (int n = 0; n < 2; ++n) { f32x4* q = (f32x4*)(rp + bj * 128 + n * 16); *q = *q + gv[bj][n] * acc[ai][bj][m][n]; } }
    }
};
struct EpiGLU {
    static constexpr bool PERM = true;
    bf16_t* ACT;
    __device__ __forceinline__ void operator()(const f32x4 (&acc)[2][2][4][2], const pg8::Unit& u, int wr, int wc, int fr, int fq) const {
        const int row0 = u.pm * 256 + wr * 64 + fr, cb = u.pn * 128 + wc * 32 + 8 * fq;
#pragma unroll
        for (int ai = 0; ai < 2; ++ai)
#pragma unroll
            for (int m = 0; m < 4; ++m) { bf16_t* rp = ACT + (size_t)(row0 + ai * 128 + m * 16) * DE + cb;
                f32x4 o[2];
#pragma unroll
                for (int n = 0; n < 2; ++n) { const f32x4 a = acc[ai][0][m][n], w = acc[ai][1][m][n];
#pragma unroll
                    for (int i = 0; i < 4; ++i) o[n][i] = fsilu(a[i]) * w[i]; }
                u32x4 w; w.x = pk2(o[0][0], o[0][1]); w.y = pk2(o[0][2], o[0][3]); w.z = pk2(o[1][0], o[1][1]); w.w = pk2(o[1][2], o[1][3]);
                *(u32x4*)rp = w; }
    }
};
struct EpiRowScale {
    static constexpr bool PERM = true;
    bf16_t* Y; const float* rg;
    __device__ __forceinline__ void operator()(const f32x4 (&acc)[2][2][4][2], const pg8::Unit& u, int wr, int wc, int fr, int fq) const {
        const int row0 = u.pm * 256 + wr * 64 + fr, cb = u.pn * 256 + wc * 32 + 8 * fq;
#pragma unroll
        for (int ai = 0; ai < 2; ++ai)
#pragma unroll
            for (int m = 0; m < 4; ++m) { const int row = row0 + ai * 128 + m * 16; const float gsc = rg[row]; bf16_t* rp = Y + (size_t)row * DM + cb;
#pragma unroll
                for (int bj = 0; bj < 2; ++bj) { const f32x4 v0 = acc[ai][bj][m][0] * gsc, v1 = acc[ai][bj][m][1] * gsc;
                    u32x4 w; w.x = pk2(v0[0], v0[1]); w.y = pk2(v0[2], v0[3]); w.z = pk2(v1[0], v1[1]); w.w = pk2(v1[2], v1[3]);
                    *(u32x4*)(rp + bj * 128) = w; } }
    }
};
struct EpiConvIn {
    static constexpr bool PERM = true;
    bf16_t *BG, *CU;
    __device__ __forceinline__ void operator()(const f32x4 (&acc)[2][2][4][2], const pg8::Unit& u, int wr, int wc, int fr, int fq) const {
        const int row0 = u.pm * 256 + wr * 64 + fr;
        if (u.pn < 4) {
            const int cb = u.pn * 256 + wc * 32 + 8 * fq;
#pragma unroll
            for (int ai = 0; ai < 2; ++ai)
#pragma unroll
                for (int m = 0; m < 4; ++m) { bf16_t* rp = BG + (size_t)(row0 + ai * 128 + m * 16) * DM + cb;
#pragma unroll
                    for (int bj = 0; bj < 2; ++bj) { const f32x4 v0 = acc[ai][bj][m][0], v1 = acc[ai][bj][m][1];
                        u32x4 w; w.x = pk2(v0[0], v0[1]); w.y = pk2(v0[2], v0[3]); w.z = pk2(v1[0], v1[1]); w.w = pk2(v1[2], v1[3]);
                        *(u32x4*)(rp + bj * 128) = w; } }
        } else {
            const int cb = (u.pn - 4) * 128 + wc * 32 + 8 * fq;
#pragma unroll
            for (int ai = 0; ai < 2; ++ai)
#pragma unroll
                for (int m = 0; m < 4; ++m) { bf16_t* rp = CU + (size_t)(row0 + ai * 128 + m * 16) * DM + cb;
                    const f32x4 v0 = acc[ai][0][m][0] * acc[ai][1][m][0], v1 = acc[ai][0][m][1] * acc[ai][1][m][1];
                    u32x4 w; w.x = pk2(v0[0], v0[1]); w.y = pk2(v0[2], v0[3]); w.z = pk2(v1[0], v1[1]); w.w = pk2(v1[2], v1[3]);
                    *(u32x4*)rp = w; }
        }
    }
};

__device__ __forceinline__ void ph_prep(const Params& p, unsigned char* lds, int bid, int nblk) {
    float* sv = (float*)lds;
    float* red = sv + 3 * 1024;
    int tid_ = threadIdx.x; asm volatile("" : "+v"(tid_)); const int tid = tid_;
    const float* c = p.in[I_C]; const float* cctx = p.in[I_CCTX];
    for (int i = tid; i < 3 * 1024; i += NTHR) { const float v = (i < 2048) ? c[i] : cctx[i - 2048]; sv[i] = siluf_(v); }
    __syncthreads();
    const float* ada_w = p.in[I_ADAW]; const float* ada_b = p.in[I_ADAB];
    float* mod = (float*)(p.ws + WS_MOD);
    for (int it = bid; it < 192; it += nblk) {
        const int l = it / 96, j0 = (it % 96) * 64, col = tid & 63, ks = tid >> 6;
        const float* W = ada_w + (size_t)l * DM * NADA + j0 + col;
        float a0 = 0.f, a1 = 0.f, a2 = 0.f;
#pragma unroll 16
        for (int k = ks * 128; k < ks * 128 + 128; ++k) { const float w = W[(size_t)k * NADA]; a0 += sv[k] * w; a1 += sv[1024 + k] * w; a2 += sv[2048 + k] * w; }
        red[(ks * 3 + 0) * 64 + col] = a0; red[(ks * 3 + 1) * 64 + col] = a1; red[(ks * 3 + 2) * 64 + col] = a2;
        __syncthreads();
        if (tid < 192) { const int v = tid >> 6, cc = tid & 63; float s = ada_b[l * NADA + j0 + cc];
#pragma unroll
            for (int k2 = 0; k2 < 8; ++k2) s += red[(k2 * 3 + v) * 64 + cc];
            mod[(size_t)(l * 3 + v) * NADA + j0 + cc] = s; }
        __syncthreads();
    }
    const int gt = bid * NTHR + tid, NT = nblk * NTHR;
    const float* lg = p.in[I_HGLB]; float* lb0 = (float*)(p.ws + WS_LB);
    for (int d = gt; d < DM; d += NT) { const float l0 = lg[d], l1 = lg[DM + d], l2 = lg[2 * DM + d]; const float mx = fmaxf(l0, fmaxf(l1, l2));
        const float e0 = expf(l0 - mx), e1 = expf(l1 - mx), e2 = expf(l2 - mx); lb0[d] = e0 / (e0 + e1 + e2); }
    float* posr = (float*)(p.ws + WS_POSR);
    for (int i = gt; i < (128 + 64) * 512; i += NT) { const int pi = i >> 9, dd = i & 511; const int pos = pi < 128 ? pi : pi - 128; const int fi = dd & 255;
        const float om = exp2f(-(float)fi * (13.287712379549449f / 256.0f)); const float a = (float)pos * om; posr[i] = dd < 256 ? sinf(a) : cosf(a); }
}

__device__ __forceinline__ void transpose_item(const float* W, int N, bf16_t* WT, int K, float* scr, int k0, int n0, size_t drow0, int lane) {
#pragma unroll
    for (int i = 0; i < 8; ++i) { const int kk = 8 * i + (lane >> 3); const f32x4 v = *(const f32x4*)(W + (size_t)(k0 + kk) * N + n0 + (lane & 7) * 4); float* d = scr + kk * 33 + (lane & 7) * 4; d[0] = v[0]; d[1] = v[1]; d[2] = v[2]; d[3] = v[3]; }
    __builtin_amdgcn_s_waitcnt(0xc07f); asm volatile("" ::: "memory");
    const int c = lane & 7;
#pragma unroll
    for (int j = 0; j < 4; ++j) { const int n = (lane >> 3) + 8 * j; const float* s = scr + (8 * c) * 33 + n;
        u32x4 o; o.x = pk2(s[0 * 33], s[1 * 33]); o.y = pk2(s[2 * 33], s[3 * 33]); o.z = pk2(s[4 * 33], s[5 * 33]); o.w = pk2(s[6 * 33], s[7 * 33]);
        *(u32x4*)(WT + (drow0 + n) * K + k0 + 8 * c) = o; }
    __builtin_amdgcn_s_waitcnt(0xc07f); asm volatile("" ::: "memory");
}
__device__ __forceinline__ void ph_convert_small(const Params& p, unsigned char* lds, int bid, int nblk) {
    int tid_ = threadIdx.x; asm volatile("" : "+v"(tid_));
    const int tid = tid_, lane = tid & 63, wave = tid >> 6;
    float* scr = (float*)lds + wave * (64 * 33);
    const int gw = bid * 8 + wave, NGW = nblk * 8;
    constexpr int I_A = 16 * 160, I_B = 16 * 32, I_C_ = 16 * 96, I_D = 16 * 32;
    for (int it = gw; it < I_A + I_B + I_C_ + I_D; it += NGW) {
        int r = it;
        if (r < I_A) { const int kb = r / 160, nb = r % 160; transpose_item(p.in[I_HGWIN], 5120, (bf16_t*)(p.ws + WS_WHGIN), 1024, scr, kb * 64, nb * 32, (size_t)nb * 32, lane); continue; } r -= I_A;
        if (r < I_B) { const int kb = r / 32, nb = r % 32; transpose_item(p.in[I_HGWOUT], 1024, (bf16_t*)(p.ws + WS_WHGOUT), 1024, scr, kb * 64, nb * 32, (size_t)nb * 32, lane); continue; } r -= I_B;
        if (r < I_C_) { const int kb = r / 96, nb = r % 96, n0 = nb * 32; size_t dr;
            if (n0 < 1024) dr = n0; else { const int np = n0 - 1024, sec = np >> 10, nn = np & 1023; dr = 1024 + (nn >> 7) * 256 + sec * 128 + (nn & 127); }
            transpose_item(p.in[I_SCWIN], 3072, (bf16_t*)(p.ws + WS_WSCIN), 1024, scr, kb * 64, n0, dr, lane); continue; } r -= I_C_;
        { const int kb = r / 32, nb = r % 32; transpose_item(p.in[I_SCWOUT], 1024, (bf16_t*)(p.ws + WS_WSCOUT), 1024, scr, kb * 64, nb * 32, (size_t)nb * 32, lane); }
    }
}
struct CvtItem { const float* src; bf16_t* dst; int N, K; };
__device__ __forceinline__ CvtItem moe_item(const Params& p, int l, int r) {
    CvtItem c;
    if (r < 32768) { const int up = r >= 16384; if (up) r -= 16384; const int le = l * 16 + (r >> 10), q = r & 1023, kb = q >> 6, nb = q & 63, n0 = nb * 32;
        const size_t dr = (size_t)le * 4096 + (n0 >> 7) * 256 + up * 128 + (n0 & 127);
        c.src = p.in[up ? I_WUP : I_WGATE] + (size_t)le * 1024 * 2048 + (size_t)(kb * 64) * 2048 + n0; c.dst = (bf16_t*)(p.ws + WS_WMOE1) + dr * 1024 + kb * 64; c.N = 2048; c.K = 1024; }
    else { r -= 32768; const int le = l * 16 + (r >> 10), q = r & 1023, kb = q >> 5, nb = q & 31, n0 = nb * 32;
        c.src = p.in[I_WDOWN] + (size_t)le * 2048 * 1024 + (size_t)(kb * 64) * 1024 + n0; c.dst = (bf16_t*)(p.ws + WS_WMOE2) + ((size_t)le * 1024 + n0) * 2048 + kb * 64; c.N = 1024; c.K = 2048; }
    return c;
}
__device__ __forceinline__ void convert_moe_slice(const Params& p, unsigned char* lds, int bid, int nblk, int l, int lo, int hi) {
    int tid_ = threadIdx.x; asm volatile("" : "+v"(tid_));
    const int tid = tid_, lane = tid & 63, wave = tid >> 6;
    float* scr = (float*)lds + wave * (64 * 33);
    const int gw = bid * 8 + wave, NGW = nblk * 8;
    constexpr int NI = 3;
    for (int it = lo + gw; it < hi; it += NGW * NI) {
        f32x4 v[NI][8]; CvtItem ci[NI];
#pragma unroll
        for (int u = 0; u < NI; ++u) { const int r = it + u * NGW; ci[u] = moe_item(p, l, r < hi ? r : it);
#pragma unroll
            for (int i = 0; i < 8; ++i) v[u][i] = __builtin_nontemporal_load((const f32x4*)(ci[u].src + (size_t)(8 * i + (lane >> 3)) * ci[u].N + (lane & 7) * 4)); }
#pragma unroll
        for (int u = 0; u < NI; ++u) { if (it + u * NGW < hi) {
#pragma unroll
            for (int i = 0; i < 8; ++i) { float* d = scr + (8 * i + (lane >> 3)) * 33 + (lane & 7) * 4; d[0] = v[u][i][0]; d[1] = v[u][i][1]; d[2] = v[u][i][2]; d[3] = v[u][i][3]; }
            __builtin_amdgcn_s_waitcnt(0xc07f); asm volatile("" ::: "memory");
            const int c = lane & 7;
#pragma unroll
            for (int j = 0; j < 4; ++j) { const int n = (lane >> 3) + 8 * j; const float* sp = scr + (8 * c) * 33 + n;
                u32x4 o; o.x = pk2(sp[0 * 33], sp[1 * 33]); o.y = pk2(sp[2 * 33], sp[3 * 33]); o.z = pk2(sp[4 * 33], sp[5 * 33]); o.w = pk2(sp[6 * 33], sp[7 * 33]);
                __builtin_nontemporal_store(o, (u32x4*)(ci[u].dst + (size_t)n * ci[u].K + 8 * c)); }
            __builtin_amdgcn_s_waitcnt(0xc07f); asm volatile("" ::: "memory"); } }
    }
    __syncthreads();
}

constexpr int CV_ITEMS = 49152, CW_Q = 1536;
constexpr int MW_LAYER = 12, MW_BASE = 13, MW_EMPTY = 14, MW_REL = 15, MW_LAST = 16;
__device__ __forceinline__ bool cvt_batch(const Params& p, unsigned char* lds, volatile LAS unsigned* MISC, unsigned layer_mask) {
    int tid_ = threadIdx.x; asm volatile("" : "+v"(tid_));
    const int tid = tid_, lane = tid & 63, wave = tid >> 6;
    if (tid == 0) {
        unsigned* q = (unsigned*)(p.ws + WS_CTL) + CW_Q; unsigned empty = MISC[MW_EMPTY]; int layer = -1; unsigned base = 0u;
#pragma unroll
        for (int l = 0; l < 2; ++l) if (layer < 0 && ((layer_mask >> l) & 1u) && !((empty >> l) & 1u)) {
            const unsigned b0 = __hip_atomic_fetch_add(q + 64 * l, 8u, __ATOMIC_RELAXED, __HIP_MEMORY_SCOPE_AGENT);
            if (b0 < (unsigned)CV_ITEMS) { layer = l; base = b0; MISC[MW_LAST + l] = b0 + 8u; } else empty |= 1u << l; }
        MISC[MW_EMPTY] = empty; MISC[MW_LAYER] = (unsigned)layer; MISC[MW_BASE] = base;
    }
    __syncthreads();
    const int layer = (int)MISC[MW_LAYER]; const int item = (int)MISC[MW_BASE] + wave;
    if (layer < 0) return false;
    float* scr = (float*)lds + wave * (64 * 33);
    if (item < CV_ITEMS) {
        const CvtItem ci = moe_item(p, layer, item);
        f32x4 v[8];
#pragma unroll
        for (int i = 0; i < 8; ++i) v[i] = __builtin_nontemporal_load((const f32x4*)(ci.src + (size_t)(8 * i + (lane >> 3)) * ci.N + (lane & 7) * 4));
#pragma unroll
        for (int i = 0; i < 8; ++i) { float* d = scr + (8 * i + (lane >> 3)) * 33 + (lane & 7) * 4; d[0] = v[i][0]; d[1] = v[i][1]; d[2] = v[i][2]; d[3] = v[i][3]; }
        __builtin_amdgcn_s_waitcnt(0xc07f); asm volatile("" ::: "memory");
        const int c = lane & 7;
#pragma unroll
        for (int j = 0; j < 4; ++j) { const int n = (lane >> 3) + 8 * j; const float* sp = scr + (8 * c) * 33 + n;
            u32x4 o; o.x = pk2(sp[0 * 33], sp[1 * 33]); o.y = pk2(sp[2 * 33], sp[3 * 33]); o.z = pk2(sp[4 * 33], sp[5 * 33]); o.w = pk2(sp[6 * 33], sp[7 * 33]);
            __builtin_nontemporal_store(o, (u32x4*)(ci.dst + (size_t)n * ci.K + 8 * c)); }
    }
    __syncthreads();
    return true;
}
__device__ __forceinline__ void cvt_drain_until(const Params& p, unsigned char* lds, volatile LAS unsigned* MISC, int l, unsigned limit) {
    for (;;) { if ((MISC[MW_EMPTY] >> l) & 1u) break; if (MISC[MW_LAST + l] >= limit) break; if (!cvt_batch(p, lds, MISC, 1u << l)) break; }
}
__device__ __forceinline__ void cvt_budget(const Params& p, unsigned char* lds, volatile LAS unsigned* MISC, unsigned layer_mask, int nbatch) {
    for (int i = 0; i < nbatch; ++i) if (!cvt_batch(p, lds, MISC, layer_mask)) break;
}

__device__ __forceinline__ void store_mod_bf16(bf16_t* hrow, const f32x4 (&v)[4], float rstd, const float* g, const float* sh, const float* sc, int lane) {
#pragma unroll
    for (int j = 0; j < 4; ++j) { const int c0 = 256 * j + 4 * lane; const f32x4 gv = *(const f32x4*)(g + c0), shv = *(const f32x4*)(sh + c0), scv = *(const f32x4*)(sc + c0);
        f32x4 h;
#pragma unroll
        for (int i = 0; i < 4; ++i) h[i] = (v[j][i] * rstd * gv[i]) * (1.f + scv[i]) + shv[i];
        u32x2 w; w.x = pk2(h[0], h[1]); w.y = pk2(h[2], h[3]); *(u32x2*)(hrow + c0) = w; }
}
__device__ __forceinline__ void ph_mod0(const Params& p, int row_lo, int row_hi, int wk, int nwk) {
    int tid_ = threadIdx.x; asm volatile("" : "+v"(tid_));
    const int tid = tid_, lane = tid & 63, wave = tid >> 6, gw = wk * 8 + wave, NGW = nwk * 8;
    const float* x = p.in[I_X]; const float* ctx = p.in[I_CTX]; const float* g = p.in[I_NMIX];
    const float* mod = (const float*)(p.ws + WS_MOD); const float* posr = (const float*)(p.ws + WS_POSR); const float* posc = (const float*)(p.ws + WS_POSC);
    float* X = (float*)(p.ws + WS_X); bf16_t* H = (bf16_t*)(p.ws + WS_H);
    f32x4 nx[4];
    { const int row = row_lo + gw; if (row < row_hi) { const float* src = row < NTOK ? x + (size_t)row * DM : ctx + (size_t)(row - NTOK) * DM;
#pragma unroll
        for (int j = 0; j < 4; ++j) nx[j] = *(const f32x4*)(src + 256 * j + 4 * lane); } }
    for (int row = row_lo + gw; row < row_hi; row += NGW) {
        f32x4 v[4]; float ss = 0.f; int vec;
#pragma unroll
        for (int j = 0; j < 4; ++j) v[j] = nx[j];
        { const int r2 = row + NGW; if (r2 < row_hi) { const float* src = r2 < NTOK ? x + (size_t)r2 * DM : ctx + (size_t)(r2 - NTOK) * DM;
#pragma unroll
            for (int j = 0; j < 4; ++j) nx[j] = *(const f32x4*)(src + 256 * j + 4 * lane); } }
        if (row < NTOK) { const int t = row & (SEQ - 1); vec = row >> 13; const float* pr = posr + (size_t)(t >> 6) * 512; const float* pc = posc + (size_t)(t & 63) * 512;
#pragma unroll
            for (int j = 0; j < 4; ++j) { const int c0 = 256 * j + 4 * lane; const f32x4 pv = *(const f32x4*)((j < 2 ? pr : pc) + (c0 & 511));
                v[j] = v[j] + pv; *(f32x4*)(X + (size_t)row * DM + c0) = v[j]; }
        } else vec = 2;
#pragma unroll
        for (int j = 0; j < 4; ++j) ss += (v[j][0] * v[j][0] + v[j][1] * v[j][1]) + (v[j][2] * v[j][2] + v[j][3] * v[j][3]);
        const float rstd = 1.f / sqrtf(wave_sum(ss) * (1.f / DM) + 1e-6f);
        const float* mv = mod + (size_t)(0 * 3 + vec) * NADA;
        store_mod_bf16(H + (size_t)row * DM, v, rstd, g, mv, mv + DM, lane);
    }
}

typedef short s16x4 __attribute__((ext_vector_type(4)));
typedef short v4i16_t __attribute__((ext_vector_type(4)));
using pg8::bf16x8;
constexpr int KT_STR = 160, KS_STR = 144, V_STR = 288;
constexpr int GL_QT = 0, GL_KT = 20480, GL_KS = 40960, GL_PL = 59392, GL_V = 68608, GL_SEG = 87040, GL_DV = 89088, GL_EM = 89600, GL_SSQ = 90112, GL_RSTD = 92160;
__device__ __forceinline__ s16x4 lds_tr(const LAS unsigned char* p) { return __builtin_bit_cast(s16x4, __builtin_amdgcn_ds_read_tr16_b64_v4i16((LAS v4i16_t*)p)); }
__device__ __forceinline__ bf16x8 cat8(s16x4 a, s16x4 b) { return __builtin_shufflevector(a, b, 0, 1, 2, 3, 4, 5, 6, 7); }
__device__ __forceinline__ bf16x8 lds_pair64(const LAS unsigned char* p, int d2) { const u32x2 a = *(const LAS u32x2*)p, b = *(const LAS u32x2*)(p + d2); u32x4 r; r.x = a.x; r.y = a.y; r.z = b.x; r.w = b.y; return __builtin_bit_cast(bf16x8, r); }

constexpr int ON_STR = 272;
constexpr int GL_RF = 92416, GL_RQ = 125184, GL_END = 141568;
struct GlaRegs { f32x4 f[4]; u32x4 q[2]; u32x4 v[2]; };
template <bool WITHQ>
__device__ __forceinline__ void gla_load(GlaRegs& R, const float* F, const bf16_t* Q, const bf16_t* V, int rb, int h, int tid) {
    const unsigned lf = (unsigned)((tid >> 5) * DM + (tid & 31) * 4), lq = (unsigned)((tid >> 4) * DM + (tid & 15) * 8);
#pragma unroll
    for (int i = 0; i < 4; ++i) { const float* fb = F + (size_t)(rb + 16 * i) * DM + h * 128; R.f[i] = *(const f32x4*)(fb + lf); }
#pragma unroll
    for (int i = 0; i < 2; ++i) { const size_t ub = (size_t)(rb + 32 * i) * DM + h * 128;
        if (WITHQ) R.q[i] = *(const u32x4*)(Q + ub + lq); R.v[i] = *(const u32x4*)(V + ub + lq); }
}
template <bool WITHQ>
__device__ __forceinline__ void gla_put_raw(const GlaRegs& R, LAS unsigned char* lds, int dir, int tid) {
#pragma unroll
    for (int i = 0; i < 4; ++i) { const int id = tid + 512 * i, row = id >> 5, c4 = (id & 31) * 4, p = dir ? 63 - row : row; *(LAS f32x4*)(lds + GL_RF + p * 512 + c4 * 4) = R.f[i]; }
#pragma unroll
    for (int i = 0; i < 2; ++i) { const int id = tid + 512 * i, row = id >> 4, c8 = (id & 15) * 8, p = dir ? 63 - row : row;
        if (WITHQ) *(LAS u32x4*)(lds + GL_RQ + p * 256 + c8 * 2) = R.q[i]; *(LAS u32x4*)(lds + GL_V + p * V_STR + c8 * 2) = R.v[i]; }
}
template <bool G2>
__device__ __forceinline__ void gla_phase_a(LAS unsigned char* lds, int tid) {
    const int k = tid & 127, seg = tid >> 7;
    LAS float* segtot = (LAS float*)(lds + GL_SEG);
    float f[16];
#pragma unroll
    for (int i = 0; i < 16; ++i) f[i] = *(const LAS float*)(lds + GL_RF + (16 * seg + i) * 512 + k * 4);
    if (G2) {
        unsigned short q[16];
#pragma unroll
        for (int i = 0; i < 16; ++i) q[i] = *(const LAS unsigned short*)(lds + GL_RQ + (16 * seg + i) * 256 + k * 2);
        float c[16]; c[0] = f[0];
#pragma unroll
        for (int i = 1; i < 16; ++i) c[i] = c[i - 1] * f[i];
        segtot[seg * 128 + k] = c[15];
        __syncthreads();
        const float T0 = segtot[k], T1 = segtot[128 + k], T2 = segtot[256 + k], T3 = segtot[384 + k];
        const float Fs = seg == 0 ? 1.f / (T0 * T1) : (seg == 1 ? 1.f / T1 : (seg == 2 ? 1.f : T2));
        const float cK = T2 * T3;
        if (seg == 0) { ((LAS float*)(lds + GL_DV))[k] = T0 * T1 * cK; ((LAS float*)(lds + GL_EM))[k] = T0 * T1; }
        unsigned wq[8], wk[8], ws_[8];
#pragma unroll
        for (int i = 0; i < 16; i += 2) { float qp[2], kp[2], ks[2];
#pragma unroll
            for (int e = 0; e < 2; ++e) { const float eq = c[i + e] * Fs, inv = __builtin_amdgcn_rcpf(eq), kk = 1.f - f[i + e];
                qp[e] = bf2f(q[i + e]) * eq; kp[e] = kk * inv; ks[e] = kp[e] * cK; }
            wq[i >> 1] = pk2(qp[0], qp[1]); wk[i >> 1] = pk2(kp[0], kp[1]); ws_[i >> 1] = pk2(ks[0], ks[1]); }
        LAS unsigned char* dq = lds + GL_QT + k * KT_STR + seg * 32; LAS unsigned char* dk = lds + GL_KT + k * KT_STR + seg * 32; LAS unsigned char* ds = lds + GL_KS + k * KS_STR + seg * 32;
        *(LAS u32x4*)dq = (u32x4){wq[0], wq[1], wq[2], wq[3]}; *(LAS u32x4*)(dq + 16) = (u32x4){wq[4], wq[5], wq[6], wq[7]};
        *(LAS u32x4*)dk = (u32x4){wk[0], wk[1], wk[2], wk[3]}; *(LAS u32x4*)(dk + 16) = (u32x4){wk[4], wk[5], wk[6], wk[7]};
        *(LAS u32x4*)ds = (u32x4){ws_[0], ws_[1], ws_[2], ws_[3]}; *(LAS u32x4*)(ds + 16) = (u32x4){ws_[4], ws_[5], ws_[6], ws_[7]};
    } else {
        float sx[16]; sx[15] = 1.f;
#pragma unroll
        for (int i = 14; i >= 0; --i) sx[i] = sx[i + 1] * f[i + 1];
        segtot[seg * 128 + k] = sx[0] * f[0];
        __syncthreads();
        const float T0 = segtot[k], T1 = segtot[128 + k], T2 = segtot[256 + k], T3 = segtot[384 + k];
        const float later = seg == 0 ? T1 * T2 * T3 : (seg == 1 ? T2 * T3 : (seg == 2 ? T3 : 1.f));
        if (seg == 0) ((LAS float*)(lds + GL_DV))[k] = T0 * T1 * T2 * T3;
        unsigned ws_[8];
#pragma unroll
        for (int i = 0; i < 16; i += 2) ws_[i >> 1] = pk2((1.f - f[i]) * sx[i] * later, (1.f - f[i + 1]) * sx[i + 1] * later);
        LAS unsigned char* ds = lds + GL_KS + k * KS_STR + seg * 32;
        *(LAS u32x4*)ds = (u32x4){ws_[0], ws_[1], ws_[2], ws_[3]}; *(LAS u32x4*)(ds + 16) = (u32x4){ws_[4], ws_[5], ws_[6], ws_[7]};
    }
    __syncthreads();
}
__device__ __forceinline__ void gla_state_update(f32x4 (&S)[8], const bf16x8 (&Vf)[2], const LAS unsigned char* lds, int i16, int g) {
#pragma unroll
    for (int j = 0; j < 8; ++j) { const f32x4 dv = *(const LAS f32x4*)(lds + GL_DV + (16 * j + 4 * g) * 4); S[j] = S[j] * dv;
#pragma unroll
        for (int c2 = 0; c2 < 2; ++c2) { const bf16x8 a = lds_pair64(lds + GL_KS + (16 * j + i16) * KS_STR + (32 * c2 + 4 * g) * 2, 32);
            S[j] = __builtin_amdgcn_mfma_f32_16x16x32_bf16(a, Vf[c2], S[j], 0, 0, 0); }
        if (j & 1) asm volatile("" ::: "memory"); }
}
__device__ __forceinline__ void gla_load_vf(bf16x8 (&Vf)[2], const LAS unsigned char* lds, int w, int i16, int g) {
    const int q4 = i16 >> 2, pp = i16 & 3;
#pragma unroll
    for (int c2 = 0; c2 < 2; ++c2) { const LAS unsigned char* vb = lds + GL_V + (32 * c2 + 4 * g + q4) * V_STR + (16 * w + 4 * pp) * 2; Vf[c2] = cat8(lds_tr(vb), lds_tr(vb + 16 * V_STR)); }
}

__device__ __forceinline__ void ph_gla_states(const Params& p, unsigned char* lds_, int bid, int nblk) {
    int tid_ = threadIdx.x; asm volatile("" : "+v"(tid_));
    const int tid = tid_, lane = tid & 63, w = __builtin_amdgcn_readfirstlane(tid >> 6), i16 = lane & 15, g = lane >> 4;
    LAS unsigned char* lds = (LAS unsigned char*)lds_;
    const bf16_t* V = (const bf16_t*)(p.ws + WS_V);
    float* U = (float*)(p.ws + WS_U); float* DD = (float*)(p.ws + WS_DD);
    for (int ui = bid; ui < 544; ui += nblk) {
        int b, h, dir, nch, rb0, uidx;
        if (ui < 512) { b = ui >> 8; h = (ui >> 5) & 7; dir = (ui >> 4) & 1; const int sc = ui & 15; nch = 8; rb0 = b * SEQ + sc * 512; uidx = ((b * 8 + h) * 2 + dir) * 17 + sc; }
        else { const int r = ui - 512; b = r >> 4; h = (r >> 1) & 7; dir = r & 1; nch = 4; rb0 = NTOK + b * CTXL; uidx = ((b * 8 + h) * 2 + dir) * 17 + 16; }
        const float* F = (const float*)(p.ws + (dir ? WS_LBK : WS_LF));
        f32x4 S[8];
#pragma unroll
        for (int j = 0; j < 8; ++j) S[j] = (f32x4){0.f, 0.f, 0.f, 0.f};
        float dtot = 1.f;
        GlaRegs R;
        gla_load<false>(R, F, nullptr, V, rb0 + 64 * (dir ? nch - 1 : 0), h, tid);
        for (int step = 0; step < nch; ++step) {
            gla_put_raw<false>(R, lds, dir, tid);
            __syncthreads();
            if (step + 1 < nch) gla_load<false>(R, F, nullptr, V, rb0 + 64 * (dir ? nch - 2 - step : step + 1), h, tid);
            gla_phase_a<false>(lds, tid);
            if (tid < 128) dtot *= ((const LAS float*)(lds + GL_DV))[tid];
            bf16x8 Vf[2]; gla_load_vf(Vf, lds, w, i16, g);
            gla_state_update(S, Vf, lds, i16, g);
            __syncthreads();
        }
        float* up = U + (size_t)uidx * 16384 + (size_t)(w * 8) * 256 + lane * 4;
#pragma unroll
        for (int j = 0; j < 8; ++j) *(f32x4*)(up + j * 256) = S[j];
        if (tid < 128) DD[(size_t)uidx * 128 + tid] = dtot;
    }
}

__device__ __forceinline__ void ph_gla_out(const Params& p, unsigned char* lds_, int bid, int nblk) {
    int tid_ = threadIdx.x; asm volatile("" : "+v"(tid_));
    const int tid = tid_, lane = tid & 63, w = __builtin_amdgcn_readfirstlane(tid >> 6), i16 = lane & 15, g = lane >> 4, q4 = i16 >> 2, pp = i16 & 3;
    LAS unsigned char* lds = (LAS unsigned char*)lds_;
    const bf16_t* Q = (const bf16_t*)(p.ws + WS_Q); const bf16_t* V = (const bf16_t*)(p.ws + WS_V); const bf16_t* G = (const bf16_t*)(p.ws + WS_G);
    const float* U = (const float*)(p.ws + WS_U); const float* DD = (const float*)(p.ws + WS_DD);
    float* OFL = (float*)(p.ws + WS_OF); bf16_t* ON = (bf16_t*)(p.ws + WS_ON);
    const float ngv = p.in[I_HGNORM][16 * w + i16];
    const int troff = (4 * g + q4) * KT_STR + (4 * pp) * 2;
    for (int unit = bid; unit < 256; unit += nblk) {
        const int b = unit >> 7, h = (unit >> 4) & 7, sc = unit & 15, rbs = b * SEQ + sc * 512;
        const unsigned loff = (unsigned)((3 - g) * 4 * DM + i16);
#pragma unroll 1
        for (int dir = 0; dir < 2; ++dir) {
            const float* F = (const float*)(p.ws + (dir ? WS_LBK : WS_LF));
            GlaRegs R;
            gla_load<true>(R, F, Q, V, rbs + 64 * (dir ? 7 : 0), h, tid);
            int on_rb = -1;
#define GLA_ON_FLUSH() do { _Pragma("unroll") for (int i_ = 0; i_ < 2; ++i_) { const int id_ = tid + 512 * i_, row_ = id_ >> 4, c8_ = (id_ & 15) * 8; \
                *(u32x4*)(ON + (size_t)(on_rb + row_) * DM + h * 128 + c8_) = *(const LAS u32x4*)(lds + GL_QT + row_ * ON_STR + c8_ * 2); } } while (0)
            const int ub = ((b * 8 + h) * 2 + dir) * 17;
            f32x4 S[8];
            { const float* up = U + (size_t)(ub + 16) * 16384 + (size_t)(w * 8) * 256 + lane * 4;
#pragma unroll
                for (int j = 0; j < 8; ++j) S[j] = *(const f32x4*)(up + j * 256); }
            { const int nf = dir ? 15 - sc : sc;
                LAS float* dl = (LAS float*)(lds + GL_QT);
                for (int i = tid; i < 16 * 128; i += NTHR) dl[i] = DD[(size_t)ub * 128 + i];
                __syncthreads();
                f32x4 Ua[8];
#define FOLD_LOAD(UU, s_) do { const int u_ = dir ? 15 - (s_) : (s_); const float* up_ = U + (size_t)(ub + u_) * 16384 + (size_t)(w * 8) * 256 + lane * 4; \
                    _Pragma("unroll") for (int j = 0; j < 8; ++j) UU[j] = *(const f32x4*)(up_ + j * 256); } while (0)
                if (nf > 0) FOLD_LOAD(Ua, 0);
                for (int s = 0; s < nf; ++s) { const int u = dir ? 15 - s : s;
#pragma unroll
                    for (int j = 0; j < 8; ++j) S[j] = S[j] * *(const LAS f32x4*)(dl + u * 128 + 16 * j + 4 * g) + Ua[j];
                    if (s + 1 < nf) FOLD_LOAD(Ua, s + 1); }
#undef FOLD_LOAD
                __syncthreads();
            }
            for (int step = 0; step < 8; ++step) {
                const int n = dir ? 7 - step : step, rb = rbs + 64 * n;
                gla_put_raw<true>(R, lds, dir, tid);
                __syncthreads();
                if (on_rb >= 0) { GLA_ON_FLUSH(); on_rb = -1; }
                if (step < 7) gla_load<true>(R, F, Q, V, rbs + 64 * (dir ? 6 - step : step + 1), h, tid);
                gla_phase_a<true>(lds, tid);
                f32x4 O[4];
                if (dir) { const float* ob = OFL + ((size_t)((unit * 8 + n) * 8 + w) * 4) * 256 + ((3 - g) * 16 + i16) * 4;
#pragma unroll
                    for (int ti = 0; ti < 4; ++ti) { const f32x4 t4 = *(const f32x4*)(ob + (3 - ti) * 256); O[ti] = (f32x4){t4[3], t4[2], t4[1], t4[0]}; } }
                else {
#pragma unroll
                    for (int ti = 0; ti < 4; ++ti) O[ti] = (f32x4){0.f, 0.f, 0.f, 0.f}; }
                { const int si = w >> 1, tb = 2 * (w & 1);
                    f32x4 pa[2] = {(f32x4){0.f, 0.f, 0.f, 0.f}, (f32x4){0.f, 0.f, 0.f, 0.f}};
#pragma unroll
                    for (int c = 0; c < 4; ++c) { const LAS unsigned char* ka = lds + GL_KT + troff + (32 * c) * KT_STR + (16 * si) * 2; const bf16x8 a = cat8(lds_tr(ka), lds_tr(ka + 16 * KT_STR));
#pragma unroll
                        for (int tt = 0; tt < 2; ++tt) { const LAS unsigned char* qa = lds + GL_QT + troff + (32 * c) * KT_STR + (16 * (tb + tt)) * 2; const bf16x8 bq = cat8(lds_tr(qa), lds_tr(qa + 16 * KT_STR));
                            pa[tt] = __builtin_amdgcn_mfma_f32_16x16x32_bf16(a, bq, pa[tt], 0, 0, 0); } }
#pragma unroll
                    for (int tt = 0; tt < 2; ++tt) { const int t = 16 * (tb + tt) + i16, s0 = 16 * si + 4 * g; f32x4 v = pa[tt];
#pragma unroll
                        for (int r = 0; r < 4; ++r) v[r] = (s0 + r <= t) ? v[r] : 0.f;
                        u32x2 wv; wv.x = pk2(v[0], v[1]); wv.y = pk2(v[2], v[3]); *(LAS u32x2*)(lds + GL_PL + t * KS_STR + s0 * 2) = wv; } }
                __syncthreads();
                {
#pragma unroll
                    for (int c = 0; c < 4; ++c) { const f32x4 e0 = *(const LAS f32x4*)(lds + GL_EM + (32 * c + 4 * g) * 4), e1 = *(const LAS f32x4*)(lds + GL_EM + (32 * c + 16 + 4 * g) * 4);
                        const f32x4 a0 = S[2 * c] * e0, b0 = S[2 * c + 1] * e1; u32x4 r; r.x = pk2(a0[0], a0[1]); r.y = pk2(a0[2], a0[3]); r.z = pk2(b0[0], b0[1]); r.w = pk2(b0[2], b0[3]); const bf16x8 Sb = __builtin_bit_cast(bf16x8, r);
#pragma unroll
                        for (int ti = 0; ti < 4; ++ti) { const LAS unsigned char* qa = lds + GL_QT + troff + (32 * c) * KT_STR + (16 * ti) * 2; const bf16x8 a = cat8(lds_tr(qa), lds_tr(qa + 16 * KT_STR));
                            O[ti] = __builtin_amdgcn_mfma_f32_16x16x32_bf16(a, Sb, O[ti], 0, 0, 0); }
                        asm volatile("" ::: "memory"); } }
                bf16x8 Vf[2]; gla_load_vf(Vf, lds, w, i16, g);
#pragma unroll
                for (int ti = 0; ti < 4; ++ti) {
#pragma unroll
                    for (int c2 = 0; c2 < 2; ++c2) { const bf16x8 a = lds_pair64(lds + GL_PL + (16 * ti + i16) * KS_STR + (32 * c2 + 4 * g) * 2, 32);
                        O[ti] = __builtin_amdgcn_mfma_f32_16x16x32_bf16(a, Vf[c2], O[ti], 0, 0, 0); }
                    if (ti & 1) asm volatile("" ::: "memory"); }
                gla_state_update(S, Vf, lds, i16, g);
                if (dir == 0) {
                    float* ob = OFL + ((size_t)((unit * 8 + n) * 8 + w) * 4) * 256 + lane * 4;
#pragma unroll
                    for (int ti = 0; ti < 4; ++ti) *(f32x4*)(ob + ti * 256) = O[ti];
                    __syncthreads();
                } else {
                    float part[4][4];
#pragma unroll
                    for (int ti = 0; ti < 4; ++ti)
#pragma unroll
                        for (int r = 0; r < 4; ++r) { const float o = O[ti][r]; part[ti][r] = row16_sum(o * o); }
                    unsigned short gq[4][4];
#pragma unroll
                    for (int ti = 0; ti < 4; ++ti)
#pragma unroll
                        for (int r = 0; r < 4; ++r) { const bf16_t* gb = G + (size_t)(rb + 51 - 16 * ti - r) * DM + h * 128 + 16 * w; gq[ti][r] = gb[loff]; }
                    if (i16 == 0) {
#pragma unroll
                        for (int ti = 0; ti < 4; ++ti) *(LAS f32x4*)(lds + GL_SSQ + (w * 64 + 16 * ti + 4 * g) * 4) = (f32x4){part[ti][0], part[ti][1], part[ti][2], part[ti][3]}; }
                    __syncthreads();
                    if (tid < 64) { float s2 = 0.f;
#pragma unroll
                        for (int ww = 0; ww < 8; ++ww) s2 += ((const LAS float*)(lds + GL_SSQ))[ww * 64 + tid];
                        ((LAS float*)(lds + GL_RSTD))[tid] = 1.f / sqrtf(s2 * (1.f / 128.f) + 1e-6f); }
                    __syncthreads();
#pragma unroll
                    for (int ti = 0; ti < 4; ++ti) { const f32x4 rs = *(const LAS f32x4*)(lds + GL_RSTD + (16 * ti + 4 * g) * 4);
#pragma unroll
                        for (int r = 0; r < 4; ++r) *(LAS unsigned short*)(lds + GL_QT + (63 - (16 * ti + 4 * g + r)) * ON_STR + (16 * w + i16) * 2) = (unsigned short)f2bf(O[ti][r] * rs[r] * ngv * bf2f(gq[ti][r])); }
                    on_rb = rb;
                }
            }
            if (on_rb >= 0) { __syncthreads(); GLA_ON_FLUSH(); on_rb = -1; }
            asm volatile("s_waitcnt vmcnt(0)" ::: "memory");
            __syncthreads();
        }
    }
}

__device__ __forceinline__ void ph_modffn(const Params& p, unsigned char* lds, int bid, int nblk, int l) {
    int tid_ = threadIdx.x; asm volatile("" : "+v"(tid_));
    const int tid = tid_, lane = tid & 63, wave = tid >> 6;
    float* rw = (float*)lds;
    float* stg = (float*)(lds + 71680);
    const float* router = p.in[I_ROUTER] + (size_t)l * DM * NE;
    for (int i = tid; i < DM * NE / 4; i += NTHR) { const int d = i >> 2; *(f32x4*)(rw + d * 16 + (d >> 2) * 4 + (i & 3) * 4) = ((const f32x4*)router)[i]; }
    __syncthreads();
    const float* X = (const float*)(p.ws + WS_X); bf16_t* H = (bf16_t*)(p.ws + WS_H); float* aff = (float*)(p.ws + WS_AFF); int* slot = (int*)(p.ws + WS_SLOT);
    const float* g = p.in[I_NFFN] + (size_t)l * DM; const float* mod = (const float*)(p.ws + WS_MOD);
    for (int base = bid * 64; base < NTOK; base += nblk * 64) {
        const int b = base >> 13, t0 = base & (SEQ - 1);
        const float* mv = mod + (size_t)(l * 3 + b) * NADA; const float* sh = mv + 3 * DM; const float* sc = mv + 4 * DM;
        f32x4 nxv[4];
#pragma unroll
        for (int j = 0; j < 4; ++j) nxv[j] = *(const f32x4*)(X + (size_t)(base + 8 * wave) * DM + 256 * j + 4 * lane);
#pragma unroll 1
        for (int r = 0; r < 8; ++r) {
            const int row = base + 8 * wave + r;
            f32x4 v[4]; float ss = 0.f;
#pragma unroll
            for (int j = 0; j < 4; ++j) { v[j] = nxv[j]; ss += (v[j][0] * v[j][0] + v[j][1] * v[j][1]) + (v[j][2] * v[j][2] + v[j][3] * v[j][3]); }
            if (r < 7) {
#pragma unroll
                for (int j = 0; j < 4; ++j) nxv[j] = *(const f32x4*)(X + (size_t)(row + 1) * DM + 256 * j + 4 * lane); }
            const float rstd = 1.f / sqrtf(wave_sum(ss) * (1.f / DM) + 1e-6f);
            float lg[16];
#pragma unroll
            for (int e = 0; e < 16; ++e) lg[e] = 0.f;
#pragma unroll
            for (int j = 0; j < 4; ++j) { const int c0 = 256 * j + 4 * lane; const f32x4 gv = *(const f32x4*)(g + c0), shv = *(const f32x4*)(sh + c0), scv = *(const f32x4*)(sc + c0);
                f32x4 h;
#pragma unroll
                for (int i = 0; i < 4; ++i) { h[i] = (v[j][i] * rstd * gv[i]) * (1.f + scv[i]) + shv[i];
                    const float* rp = rw + (c0 + i) * 16 + (c0 >> 2) * 4; const f32x4 r0 = *(const f32x4*)(rp), r1 = *(const f32x4*)(rp + 4), r2 = *(const f32x4*)(rp + 8), r3 = *(const f32x4*)(rp + 12);
#pragma unroll
                    for (int e = 0; e < 4; ++e) { lg[e] += h[i] * r0[e]; lg[4 + e] += h[i] * r1[e]; lg[8 + e] += h[i] * r2[e]; lg[12 + e] += h[i] * r3[e]; }
                    asm volatile("" ::: "memory"); }
                u32x2 w; w.x = pk2(h[0], h[1]); w.y = pk2(h[2], h[3]); *(u32x2*)(H + (size_t)row * DM + c0) = w; }
            float a8[8], a4[4], a2[2], a1;
            { const bool hi = (lane & 32) != 0;
#pragma unroll
                for (int i = 0; i < 8; ++i) { const float send = hi ? lg[i] : lg[8 + i], keep = hi ? lg[8 + i] : lg[i]; a8[i] = keep + __shfl_xor(send, 32); } }
            { const bool hi = (lane & 16) != 0;
#pragma unroll
                for (int i = 0; i < 4; ++i) { const float send = hi ? a8[i] : a8[4 + i], keep = hi ? a8[4 + i] : a8[i]; a4[i] = keep + __shfl_xor(send, 16); } }
            { const bool hi = (lane & 8) != 0;
#pragma unroll
                for (int i = 0; i < 2; ++i) { const float send = hi ? a4[i] : a4[2 + i], keep = hi ? a4[2 + i] : a4[i]; a2[i] = keep + __shfl_xor(send, 8); } }
            { const bool hi = (lane & 4) != 0; const float send = hi ? a2[0] : a2[1], keep = hi ? a2[1] : a2[0]; a1 = keep + __shfl_xor(send, 4); }
            a1 += dpp_f<0x4E>(a1); a1 += dpp_f<0xB1>(a1);
            float mx = a1;
            mx = fmaxf(mx, __shfl_xor(mx, 4)); mx = fmaxf(mx, __shfl_xor(mx, 8)); mx = fmaxf(mx, __shfl_xor(mx, 16)); mx = fmaxf(mx, __shfl_xor(mx, 32));
            const float ex = expf(a1 - mx); float den = ex;
            den += __shfl_xor(den, 4); den += __shfl_xor(den, 8); den += __shfl_xor(den, 16); den += __shfl_xor(den, 32);
            if ((lane & 3) == 0) stg[((lane >> 2) & 15) * 64 + 8 * wave + r] = ex / den;
        }
        __syncthreads();
        { const int e = tid >> 5, tt = (tid & 31) * 2; *(f32x2*)(aff + (size_t)(b * NE + e) * SEQ + t0 + tt) = *(const f32x2*)(stg + e * 64 + tt);
            *(u32x2*)(slot + (size_t)base * NE + 2 * tid) = (u32x2){0xffffffffu, 0xffffffffu}; }
        __syncthreads();
    }
}

__device__ __forceinline__ void ph_topk(const Params& p, unsigned char* lds, int bid, int nblk) {
    int tid_ = threadIdx.x; asm volatile("" : "+v"(tid_)); const int tid = tid_, lane = tid & 63, wave = tid >> 6;
    unsigned* hist = (unsigned*)lds;
    unsigned* ctl = hist + 256;
    unsigned* wsum = ctl + 8;
    const float* aff = (const float*)(p.ws + WS_AFF); int* topi = (int*)(p.ws + WS_TOPI); float* topg = (float*)(p.ws + WS_TOPG); int* slot = (int*)(p.ws + WS_SLOT);
    for (int it = bid; it < NB * NE; it += nblk) {
        const int b = it >> 4, e = it & 15; const float* src = aff + (size_t)it * SEQ + 16 * tid;
        unsigned key[16];
#pragma unroll
        for (int j = 0; j < 4; ++j) { const f32x4 v = *(const f32x4*)(src + 4 * j); key[4 * j] = __float_as_uint(v[0]); key[4 * j + 1] = __float_as_uint(v[1]); key[4 * j + 2] = __float_as_uint(v[2]); key[4 * j + 3] = __float_as_uint(v[3]); }
        unsigned prefix = 0u;
#pragma unroll 1
        for (int bit = 30; bit >= 0; --bit) {
            const unsigned cand = prefix | (1u << bit);
            unsigned cnt = 0u;
#pragma unroll
            for (int i = 0; i < 16; ++i) cnt += (unsigned)__popcll(__ballot(key[i] >= cand));
            if (lane == 0) wsum[(bit & 1) * 8 + wave] = cnt;
            __syncthreads();
            unsigned tot = 0u;
#pragma unroll
            for (int w2 = 0; w2 < 8; ++w2) tot += wsum[(bit & 1) * 8 + w2];
            if (tot >= (unsigned)CAP) prefix = cand;
        }
        __syncthreads();
        unsigned cg = 0u, ce = 0u;
#pragma unroll
        for (int i = 0; i < 16; ++i) { cg += key[i] > prefix ? 1u : 0u; ce += key[i] == prefix ? 1u : 0u; }
        unsigned pk = cg | (ce << 16), inc = pk;
#pragma unroll
        for (int o = 1; o < 64; o <<= 1) { const unsigned t = __shfl_up(inc, o); if (lane >= o) inc += t; }
        if (lane == 63) wsum[wave] = inc;
        __syncthreads();
        unsigned base = 0u, total = 0u;
#pragma unroll
        for (int w2 = 0; w2 < 8; ++w2) { const unsigned t = wsum[w2]; if (w2 < wave) base += t; total += t; }
        const unsigned excl = base + inc - pk;
        unsigned rg = excl & 0xffffu, re = excl >> 16; const unsigned ngt = total & 0xffffu, kth = (unsigned)CAP - ngt;
#pragma unroll
        for (int i = 0; i < 16; ++i) { int s = -1;
            if (key[i] > prefix) { s = (int)rg; ++rg; }
            else if (key[i] == prefix) { if (re < kth) s = (int)(ngt + re); ++re; }
            if (s >= 0) { const int idx = 16 * tid + i, r = (e * NB + b) * CAP + s; topi[r] = b * SEQ + idx; topg[r] = __uint_as_float(key[i]); slot[(size_t)(b * SEQ + idx) * NE + e] = s; } }
        __syncthreads();
    }
}

__device__ __forceinline__ void ph_combine(const Params& p, int bid, int nblk, int l, bool final_) {
    int tid_ = threadIdx.x; asm volatile("" : "+v"(tid_));
    const int tid = tid_, lane = tid & 63, wave = tid >> 6, gw = bid * 8 + wave, NGW = nblk * 8;
    float* X = (float*)(p.ws + WS_X); bf16_t* H = (bf16_t*)(p.ws + WS_H); const bf16_t* Y = (const bf16_t*)(p.ws + WS_Y); const int* slot = (const int*)(p.ws + WS_SLOT);
    const float* mod = (const float*)(p.ws + WS_MOD);
    int nslot = -1; f32x4 nxv[4];
    if (gw < NTOK) { nslot = lane < 16 ? slot[(size_t)gw * NE + lane] : -1;
#pragma unroll
        for (int j = 0; j < 4; ++j) nxv[j] = *(const f32x4*)(X + (size_t)gw * DM + 256 * j + 4 * lane); }
    for (int row = gw; row < NTOK; row += NGW) {
        const int b = row >> 13;
        const float* g2 = mod + (size_t)(l * 3 + b) * NADA + 5 * DM;
        const int myslot = nslot; f32x4 xv[4];
#pragma unroll
        for (int j = 0; j < 4; ++j) xv[j] = nxv[j];
        unsigned long long m = __ballot(myslot >= 0) & 0xffffull;
        f32x4 a[4];
#pragma unroll
        for (int j = 0; j < 4; ++j) a[j] = (f32x4){0.f, 0.f, 0.f, 0.f};
        u32x2 ya[4], yb[4];
#define YLOAD(dst, e_) do { const int s_ = __shfl(myslot, (e_)); const bf16_t* yr_ = Y + (size_t)(((e_) * NB + b) * CAP + s_) * DM; \
            _Pragma("unroll") for (int j = 0; j < 4; ++j) dst[j] = *(const u32x2*)(yr_ + 256 * j + 4 * lane); } while (0)
        if (m) { const int e0 = __builtin_ctzll(m); m &= m - 1; YLOAD(ya, e0); }
        const bool any = __ballot(myslot >= 0) & 0xffffull;
        { const int r2 = row + NGW; if (r2 < NTOK) { nslot = lane < 16 ? slot[(size_t)r2 * NE + lane] : -1;
#pragma unroll
            for (int j = 0; j < 4; ++j) nxv[j] = *(const f32x4*)(X + (size_t)r2 * DM + 256 * j + 4 * lane); } }
        if (any) for (;;) {
            const bool more = m != 0ull;
            if (more) { const int e1 = __builtin_ctzll(m); m &= m - 1; YLOAD(yb, e1); }
#pragma unroll
            for (int j = 0; j < 4; ++j) { a[j][0] += __uint_as_float(ya[j].x << 16); a[j][1] += __uint_as_float(ya[j].x & 0xffff0000u); a[j][2] += __uint_as_float(ya[j].y << 16); a[j][3] += __uint_as_float(ya[j].y & 0xffff0000u); }
            if (!more) break;
#pragma unroll
            for (int j = 0; j < 4; ++j) ya[j] = yb[j];
        }
#undef YLOAD
        f32x4 v[4]; float ss = 0.f;
#pragma unroll
        for (int j = 0; j < 4; ++j) { const int c0 = 256 * j + 4 * lane; v[j] = xv[j] + *(const f32x4*)(g2 + c0) * a[j];
            ss += (v[j][0] * v[j][0] + v[j][1] * v[j][1]) + (v[j][2] * v[j][2] + v[j][3] * v[j][3]); }
        const float rstd = 1.f / sqrtf(wave_sum(ss) * (1.f / DM) + 1e-6f);
        if (final_) { const float* gf = p.in[I_NFIN];
#pragma unroll
            for (int j = 0; j < 4; ++j) { const int c0 = 256 * j + 4 * lane; const f32x4 gv = *(const f32x4*)(gf + c0); *(f32x4*)(p.out + (size_t)row * DM + c0) = v[j] * rstd * gv; }
        } else {
#pragma unroll
            for (int j = 0; j < 4; ++j) *(f32x4*)(X + (size_t)row * DM + 256 * j + 4 * lane) = v[j];
            const float* mv = mod + (size_t)((l + 1) * 3 + b) * NADA;
            store_mod_bf16(H + (size_t)row * DM, v, rstd, p.in[I_NMIX] + (size_t)(l + 1) * DM, mv, mv + DM, lane);
        }
    }
}

__device__ __forceinline__ void ph_conv(const Params& p, int bid, int nblk) {
    int tid_ = threadIdx.x; asm volatile("" : "+v"(tid_));
    const int tid = tid_, lane = tid & 63, wave = tid >> 6, gw = bid * 8 + wave, NGW = nblk * 8;
    const bf16_t* BG = (const bf16_t*)(p.ws + WS_BG); const bf16_t* CU = (const bf16_t*)(p.ws + WS_CU); bf16_t* Z = (bf16_t*)(p.ws + WS_Z);
    const float* wc = p.in[I_SCCONV];
    for (int row = gw; row < NTOK; row += NGW) { const int t = row & (SEQ - 1);
#pragma unroll
        for (int hh = 0; hh < 2; ++hh) { const int c0 = hh * 512 + 8 * lane; const size_t off = (size_t)row * DM + c0;
            const u16x8 z0 = {0, 0, 0, 0, 0, 0, 0, 0};
            const u16x8 um = t > 0 ? *(const u16x8*)(CU + off - DM) : z0, u0 = *(const u16x8*)(CU + off), up = t < SEQ - 1 ? *(const u16x8*)(CU + off + DM) : z0, bg = *(const u16x8*)(BG + off);
            float o[8];
#pragma unroll
            for (int i = 0; i < 8; ++i) o[i] = bf2f(bg[i]) * (wc[c0 + i] * bf2f(um[i]) + wc[DM + c0 + i] * bf2f(u0[i]) + wc[2 * DM + c0 + i] * bf2f(up[i]));
            u32x4 w; w.x = pk2(o[0], o[1]); w.y = pk2(o[2], o[3]); w.z = pk2(o[4], o[5]); w.w = pk2(o[6], o[7]); *(u32x4*)(Z + off) = w; }
    }
}

#define XB_TMO      128
#define XB_XCNT(j)  (256  + 64 * (j))
#define XB_XSUB(j)  (1280 + 64 * (j))
#define XB_XGEN(j)  (2304 + 64 * (j))
#define XB_TOP      3328
#define XB_TOPGEN   3392
#define XCD_BAR_WORDS 3456
#define XB_SPIN_CAP (1u << 18)
__device__ __forceinline__ unsigned xb_ld(unsigned* p)              { return __hip_atomic_load(p, __ATOMIC_RELAXED, __HIP_MEMORY_SCOPE_AGENT); }
__device__ __forceinline__ unsigned xb_add(unsigned* p, unsigned v) { return __hip_atomic_fetch_add(p, v, __ATOMIC_RELAXED, __HIP_MEMORY_SCOPE_AGENT); }
__device__ __forceinline__ unsigned xb_xcc_id() { return (unsigned)__builtin_amdgcn_s_getreg((3 << 11) | 20) & 0xFu; }
#define XB_SPIN(cond, bar) do { unsigned _sp = 0; while (cond) { __builtin_amdgcn_s_sleep(1); \
    if ((++_sp & 255u) == 0u) { if (xb_ld(&(bar)[XB_TMO])) break; if (_sp > XB_SPIN_CAP) { atomicAdd(&(bar)[XB_TMO], 1u); break; } } } } while (0)
struct XcdBarrier { unsigned* bar; unsigned x; volatile LAS unsigned* st; };
__device__ __forceinline__ XcdBarrier xcd_barrier_post(unsigned* bar, volatile LAS unsigned* st) {
    XcdBarrier b; b.bar = bar; b.x = xb_xcc_id(); b.st = st;
    if (threadIdx.x == 0) (void)xb_add(&bar[XB_XCNT(b.x)], 1u);
    return b;
}
__device__ __forceinline__ void xcd_barrier_complete(unsigned* bar, unsigned x, unsigned& nloc, unsigned& nx) {
    const unsigned G = gridDim.x * gridDim.y * gridDim.z;
    unsigned sum, cnt, mine, sp = 0u;
    for (;;) {
        sum = 0u; cnt = 0u; mine = 0u;
#pragma unroll
        for (unsigned j = 0; j < 16; ++j) { const unsigned c = xb_ld(&bar[XB_XCNT(j)]); sum += c; cnt += (c > 0u) ? 1u : 0u; mine = (j == x) ? c : mine; }
        if (sum == G) break;
        __builtin_amdgcn_s_sleep(1);
        if ((++sp & 255u) == 0u) { if (xb_ld(&bar[XB_TMO])) break; if (sp > XB_SPIN_CAP) { atomicAdd(&bar[XB_TMO], 1u); break; } }
    }
    nloc = mine > 0u ? mine : 1u; nx = cnt > 0u ? cnt : 1u;
}
__device__ __forceinline__ void xcd_barrier(const Params& p, unsigned char* lds, unsigned* bar_, volatile LAS unsigned* MISC, unsigned filler) {
    volatile LAS unsigned* st_ = MISC + 8;
    XcdBarrier b; b.bar = bar_; b.x = xb_xcc_id(); b.st = st_;
    asm volatile("s_waitcnt vmcnt(0)" ::: "memory");
    __syncthreads();
    unsigned target = 0u;
    if (threadIdx.x == 0) {
        unsigned* bar = b.bar;
        __builtin_amdgcn_s_waitcnt(0);
        unsigned nloc = b.st[0], nx = b.st[1];
        if (nloc == 0u) { xcd_barrier_complete(bar, b.x, nloc, nx); b.st[0] = nloc; b.st[1] = nx; }
        const unsigned epoch = b.st[2] + 1u; b.st[2] = epoch;
        const unsigned old = xb_add(&bar[XB_XSUB(b.x)], 1u);
        if (old + 1u == epoch * nloc) {
            __builtin_amdgcn_fence(__ATOMIC_RELEASE, "agent");
            asm volatile("s_waitcnt vmcnt(0)" ::: "memory");
            (void)xb_add(&bar[XB_TOP], 1u);
        }
        target = epoch * nx;
    }
    if (filler) {
        for (;;) {
            if (threadIdx.x == 0) MISC[MW_REL] = (xb_ld(&b.bar[XB_TOP]) >= target || xb_ld(&b.bar[XB_TMO])) ? 1u : 0u;
            __syncthreads();
            const unsigned rel = MISC[MW_REL];
            __syncthreads();
            if (rel) break;
            if (!cvt_batch(p, lds, MISC, filler)) break;
        }
    }
    if (threadIdx.x == 0) {
        XB_SPIN(xb_ld(&b.bar[XB_TOP]) < target, b.bar);
        __builtin_amdgcn_fence(__ATOMIC_ACQUIRE, "agent");
        asm volatile("s_waitcnt vmcnt(0)" ::: "memory");
    }
    __syncthreads();
}

constexpr int NPHASE = 19;
constexpr int CVB_P2 = 2, CVB_P8 = 4;
constexpr int MISC_OFF = 146944;
constexpr int CW_BAR = 4096;
constexpr int CW_CTX = 1024;
template <int LO, int HI> __global__ void __launch_bounds__(NTHR, 2) mega(Params p) {
    extern __shared__ __attribute__((aligned(16))) unsigned char lds[];
    const int bid = blockIdx.x, nblk = gridDim.x;
    PG8_LAS unsigned char* l3 = (PG8_LAS unsigned char*)lds;
    unsigned char* ws = p.ws;
    const float* mod = (const float*)(ws + WS_MOD);
    constexpr bool MULTI = (HI - LO) > 1;
    if (MULTI) {
        volatile LAS unsigned* MISC = (volatile LAS unsigned*)(l3 + MISC_OFF);
        if (threadIdx.x < 32) MISC[threadIdx.x] = 0u;
        __syncthreads();
        (void)xcd_barrier_post((unsigned*)(ws + WS_CTL) + CW_BAR, MISC + 8);
    }
#define IN(k) (LO <= (k) && (k) < HI)
#ifndef PROBE_DUP
#define PROBE_DUP 0u
#endif
#define DUPQ(k) (((PROBE_DUP) >> (k)) & 1u)
#define MISCP ((volatile LAS unsigned*)(l3 + MISC_OFF))
#define BARRIER_MASK(m) xcd_barrier(p, lds, (unsigned*)(p.ws + WS_CTL) + CW_BAR, MISCP, (m))
#define BARRIER_NOW() BARRIER_MASK(0u)
#define SEAM(k) do { if (IN(k) && IN((k) + 1)) BARRIER_MASK(((k) <= 7 ? 1u : 0u) | ((k) <= 15 ? 2u : 0u)); } while (0)
#define PHASE(k, ...) do { if (IN(k)) { __VA_ARGS__; if (DUPQ(k)) { BARRIER_NOW(); __VA_ARGS__; } } SEAM(k); } while (0)
#define GEMM_INPROJ() do { pg8::Gemm g{(const bf16_t*)(ws + WS_H), (const bf16_t*)(ws + WS_WHGIN), NTOK, 5120, DM}; pg8::StaticOrder S; S.init(NTOK, 5120, nblk, bid, 0); EpiInProj E{ws}; pg8::gemm_phase<EpiInProj, pg8::StaticOrder, false>(l3, g, S, E, nullptr); } while (0)
#define GEMM_OUT(AOFF, WOFF, GATE) do { pg8::Gemm g{(const bf16_t*)(ws + (AOFF)), (const bf16_t*)(ws + (WOFF)), NTOK, DM, DM}; pg8::StaticOrder S; S.init(NTOK, DM, nblk, bid, 0); EpiResid E{(float*)(ws + WS_X), (GATE)}; pg8::gemm_phase<EpiResid, pg8::StaticOrder, false>(l3, g, S, E, nullptr); } while (0)
#define GEMM_MOE1(l) do { pg8::Gemm g{(const bf16_t*)(ws + WS_H), (const bf16_t*)(ws + WS_WMOE1) + (size_t)(l) * NE * 4096 * DM, NSLOT, 4096, DM}; pg8::StaticOrder S; S.init(NSLOT, 4096, nblk, bid, 8); EpiGLU E{(bf16_t*)(ws + WS_ACT)}; pg8::gemm_phase<EpiGLU, pg8::StaticOrder, true>(l3, g, S, E, (const int*)(ws + WS_TOPI)); } while (0)
#define GEMM_MOE2(l) do { pg8::Gemm g{(const bf16_t*)(ws + WS_ACT), (const bf16_t*)(ws + WS_WMOE2) + (size_t)(l) * NE * DM * DE, NSLOT, DM, DE}; pg8::StaticOrder S; S.init(NSLOT, DM, nblk, bid, 8); EpiRowScale E{(bf16_t*)(ws + WS_Y), (const float*)(ws + WS_TOPG)}; pg8::gemm_phase<EpiRowScale, pg8::StaticOrder, false>(l3, g, S, E, nullptr); } while (0)
#define GEMM_CONVIN() do { pg8::Gemm g{(const bf16_t*)(ws + WS_H), (const bf16_t*)(ws + WS_WSCIN), NTOK, 3072, DM}; pg8::StaticOrder S; S.init(NTOK, 3072, nblk, bid, 0); EpiConvIn E{(bf16_t*)(ws + WS_BG), (bf16_t*)(ws + WS_CU)}; pg8::gemm_phase<EpiConvIn, pg8::StaticOrder, false>(l3, g, S, E, nullptr); } while (0)
#define MOD0_PHASE() do { if (nblk >= 48) { if (bid < 24) { ph_mod0(p, NTOK + (bid * NCTX) / 24, NTOK + ((bid + 1) * NCTX) / 24, 0, 1); \
              \
            asm volatile("s_waitcnt vmcnt(0)" ::: "memory"); __syncthreads(); \
            if (threadIdx.x == 0) { unsigned* cnt = (unsigned*)(p.ws + WS_CTL) + CW_CTX; __builtin_amdgcn_fence(__ATOMIC_RELEASE, "agent"); asm volatile("s_waitcnt vmcnt(0)" ::: "memory"); \
                xb_add(cnt, 1u); unsigned sp_ = 0u; while (xb_ld(cnt) < 24u) { __builtin_amdgcn_s_sleep(1); if (++sp_ > (1u << 22)) break; } \
                __builtin_amdgcn_fence(__ATOMIC_ACQUIRE, "agent"); asm volatile("s_waitcnt vmcnt(0)" ::: "memory"); } \
            __syncthreads(); \
            pg8::Gemm g{(const bf16_t*)(ws + WS_H), (const bf16_t*)(ws + WS_WHGIN), NROW, 5120, DM}; pg8::OneUnit S{64 + bid / 12, 4 + bid % 12}; EpiInProj E{ws}; pg8::gemm_phase<EpiInProj, pg8::OneUnit, false>(l3, g, S, E, nullptr); } \
          else ph_mod0(p, 0, NTOK, bid - 24, nblk - 24); } \
        else { ph_mod0(p, 0, NROW, bid, nblk); } } while (0)
#define CTX_TILES_FALLBACK() do { if (nblk < 48) { BARRIER_NOW(); pg8::Gemm g{(const bf16_t*)(ws + WS_H), (const bf16_t*)(ws + WS_WHGIN), NROW, 5120, DM}; \
        for (int ti = bid; ti < 24; ti += nblk) { pg8::OneUnit S{64 + ti / 12, 4 + ti % 12}; EpiInProj E{ws}; pg8::gemm_phase<EpiInProj, pg8::OneUnit, false>(l3, g, S, E, nullptr); } } } while (0)
    PHASE(0, ph_prep(p, lds, bid, nblk); __syncthreads(); ph_convert_small(p, lds, bid, nblk));
    if (IN(1)) { MOD0_PHASE(); CTX_TILES_FALLBACK(); }
    SEAM(1);
#define HOSTED(GEMM_RANGE, NR, NBATCH) do { const bool odd_ = (bid & 1) != 0; \
        if (odd_) cvt_budget(p, lds, MISCP, 3u, NBATCH); \
        GEMM_RANGE(0, NR); __syncthreads(); \
        if (!odd_) cvt_budget(p, lds, MISCP, 3u, NBATCH); } while (0)
#define GEMM_INPROJ_R(LO_, HI_) do { pg8::Gemm g{(const bf16_t*)(ws + WS_H), (const bf16_t*)(ws + WS_WHGIN), NTOK, 5120, DM}; pg8::RangeOrder S; S.S.init(NTOK, 5120, nblk, bid, 0); S.lo = (LO_); S.hi = (HI_); EpiInProj E{ws}; pg8::gemm_phase<EpiInProj, pg8::RangeOrder, false>(l3, g, S, E, nullptr); } while (0)
#define GEMM_MOE1_R0(LO_, HI_) do { pg8::Gemm g{(const bf16_t*)(ws + WS_H), (const bf16_t*)(ws + WS_WMOE1), NSLOT, 4096, DM}; pg8::RangeOrder S; S.S.init(NSLOT, 4096, nblk, bid, 8); S.lo = (LO_); S.hi = (HI_); EpiGLU E{(bf16_t*)(ws + WS_ACT)}; pg8::gemm_phase<EpiGLU, pg8::RangeOrder, true>(l3, g, S, E, (const int*)(ws + WS_TOPI)); } while (0)
    PHASE(2, HOSTED(GEMM_INPROJ_R, 5, CVB_P2));
    PHASE(3, ph_gla_states(p, lds, bid, nblk));
    PHASE(4, ph_gla_out(p, lds, bid, nblk));
    if (IN(5)) GEMM_OUT(WS_ON, WS_WHGOUT, mod + 2 * DM);
    SEAM(5);
    PHASE(6, ph_modffn(p, lds, bid, nblk, 0));
    PHASE(7, ph_topk(p, lds, bid, nblk); __syncthreads(); cvt_drain_until(p, lds, MISCP, 0, 32768u));
    PHASE(8, HOSTED(GEMM_MOE1_R0, 8, CVB_P8); cvt_drain_until(p, lds, MISCP, 0, (unsigned)CV_ITEMS));
    PHASE(9, GEMM_MOE2(0));
    if (IN(10)) ph_combine(p, bid, nblk, 0, false);
    SEAM(10);
    PHASE(11, GEMM_CONVIN());
    PHASE(12, ph_conv(p, bid, nblk));
    if (IN(13)) GEMM_OUT(WS_Z, WS_WSCOUT, mod + (size_t)3 * NADA + 2 * DM);
    SEAM(13);
    PHASE(14, ph_modffn(p, lds, bid, nblk, 1));
    PHASE(15, ph_topk(p, lds, bid, nblk); __syncthreads(); cvt_drain_until(p, lds, MISCP, 1, 32768u));
    PHASE(16, GEMM_MOE1(1); __syncthreads(); cvt_drain_until(p, lds, MISCP, 1, (unsigned)CV_ITEMS));
    PHASE(17, GEMM_MOE2(1));
    if (IN(18)) ph_combine(p, bid, nblk, 1, true);
#undef IN
#undef SEAM
}

#ifndef MK_SPLIT
#define MK_SPLIT 0
#endif
#if MK_SPLIT
#include <utility>
template <int... I> static void launch_all(std::integer_sequence<int, I...>, int grid, Params& p, hipStream_t stream) {
    ((void)hipFuncSetAttribute((const void*)mega<I, I + 1>, hipFuncAttributeMaxDynamicSharedMemorySize, LDS_BYTES), ...);
    ((mega<I, I + 1><<<dim3(grid), dim3(NTHR), LDS_BYTES, stream>>>(p)), ...); }
#endif
extern "C" void kernel_launch(void* const* d_in, const int* in_sizes, int n_in, void* d_out, int out_size, void* d_ws, size_t ws_size, hipStream_t stream) {
    static int grid = 0;
    if (grid == 0) {
        if (n_in != 20 || ws_size < WS_END) { fprintf(stderr, "kernel_launch: unexpected inputs (n_in %d, ws %zu, need %zu)\n", n_in, ws_size, (size_t)WS_END); grid = -1; return; }
        int dev = 0, cus = 0, per_cu = 0;
        (void)hipGetDevice(&dev); (void)hipDeviceGetAttribute(&cus, hipDeviceAttributeMultiprocessorCount, dev);
        (void)hipFuncSetAttribute((const void*)mega<0, NPHASE>, hipFuncAttributeMaxDynamicSharedMemorySize, LDS_BYTES);
        if (hipOccupancyMaxActiveBlocksPerMultiprocessor(&per_cu, (const void*)mega<0, NPHASE>, NTHR, LDS_BYTES) != hipSuccess || per_cu < 1) { fprintf(stderr, "kernel_launch: occupancy query failed (%d)\n", per_cu); per_cu = 1; }
        (void)hipGetLastError();
        if (per_cu > 1) per_cu = 1;
        grid = (cus > 0 ? cus : 256) * per_cu;
    }
    if (grid < 0) return;
    Params p{};
    for (int i = 0; i < 20; ++i) p.in[i] = (const float*)d_in[i];
    p.out = (float*)d_out; p.ws = (unsigned char*)d_ws;
#if MK_SPLIT
    launch_all(std::make_integer_sequence<int, NPHASE>{}, grid, p, stream);
#else
    (void)hipMemsetAsync((char*)d_ws + WS_CTL, 0, 65536, stream);
    void* args[] = {&p};
    hipError_t e = hipLaunchCooperativeKernel((const void*)mega<0, NPHASE>, dim3(grid), dim3(NTHR), args, LDS_BYTES, stream);
    if (e != hipSuccess) fprintf(stderr, "kernel_launch: cooperative launch failed: %s (grid %d)\n", hipGetErrorString(e), grid);
#endif
}
```

```cpp
#include <hip/hip_runtime.h>
#include <cstdio>
#include <cstdint>

namespace pg8 {
#define PG8_LAS __attribute__((address_space(3)))
typedef unsigned short bf16_t;
typedef short bf16x8 __attribute__((ext_vector_type(8)));
typedef float f32x4 __attribute__((ext_vector_type(4)));
typedef unsigned u32x4 __attribute__((ext_vector_type(4)));
typedef unsigned u32x2 __attribute__((ext_vector_type(2)));
constexpr int BM = 256, BK = 64, HALF = 128, HTB = HALF * BK * 2, STAGE_BYTES = 8 * HTB, NXCD = 8, WGM = 8;

__host__ __device__ __forceinline__ int lds_byte(int r, int c) { const int st = (r >> 4) * 2 + (c >> 5), rr = r & 15, cc = c & 31, ob = rr * 64 + cc * 2; return st * 1024 + (ob ^ (((ob >> 9) & 1) << 5)); }
__host__ __device__ __forceinline__ void stage_rc(int b, int& R, int& C) { const int st = b / 1024, sb = b % 1024, swz = sb ^ (((sb >> 9) & 1) << 5); R = (st >> 1) * 16 + swz / 64; C = (st & 1) * 32 + (swz % 64) / 2; }
__host__ __device__ __forceinline__ int perm32(int rho) { const int n = rho >> 4, i = rho & 15; return 8 * (i >> 2) + 4 * n + (i & 3); }

struct Unit { int pm, pn, pb; };
struct Gemm { const bf16_t* A; const bf16_t* Bt; int M, N, K; };

struct StaticOrder {
    int nM, nN, nwg, G, c, mpe;
    __device__ void init(int M, int N, int G_, int c_, int mpe_) { nM = M / BM; nN = N / BM; nwg = nM * nN; G = G_; c = c_; mpe = mpe_; }
    __device__ bool next(int i, Unit& u) const {
        const long L = (long)i * G + c; if (L >= nwg) return false;
        int wgid = (int)L; { const int q = nwg / NXCD, r = nwg % NXCD, xcd = wgid % NXCD, off = wgid / NXCD; wgid = (xcd < r ? xcd * (q + 1) : r * (q + 1) + (xcd - r) * q) + off; }
        const int nig = WGM * nN, gid = wgid / nig, fm = gid * WGM, gsz = (nM - fm) < WGM ? (nM - fm) : WGM;
        u.pm = fm + ((wgid % nig) % gsz); u.pn = (wgid % nig) / gsz; u.pb = mpe > 0 ? (u.pm / mpe) * nN + u.pn : u.pn; return true;
    }
};

__device__ __forceinline__ unsigned cvt_pk_bf16(float lo, float hi) { unsigned r; asm volatile("v_cvt_pk_bf16_f32 %0, %1, %2" : "=v"(r) : "v"(lo), "v"(hi)); return r; }

struct RangeOrder {
    StaticOrder S; int lo, hi;
    __device__ bool next(int i, Unit& u) const { return (lo + i < hi) ? S.next(lo + i, u) : false; }
};
struct OneUnit {
    int pm, pn;
    __device__ bool next(int i, Unit& u) const { if (i != 0) return false; u.pm = pm; u.pn = pn; u.pb = pn; return true; }
};
template <class Epi, class Sched, bool GATHER>
__device__ __forceinline__ void gemm_phase(PG8_LAS unsigned char* lds, const Gemm g, const Sched& S, const Epi& E, const int* gidx) {
    int tid_ = threadIdx.x; asm volatile("" : "+v"(tid_));
    const int tid = tid_, wid = __builtin_amdgcn_readfirstlane(tid >> 6), lane = tid & 63, wr = wid >> 2, wc = wid & 3, fr = lane & 15, fq = lane >> 4;
    const int K = g.K, nt = K / BK;
    unsigned voffA[2], voffB[2]; int rA[2], cA2[2];
#pragma unroll
    for (int i = 0; i < 2; ++i) { int R, C; stage_rc(tid * 16 + i * 8192, R, C); const int Rb = Epi::PERM ? ((R & ~31) + perm32(R & 31)) : R;
        voffA[i] = (unsigned)(R * K + C) * 2u; voffB[i] = (unsigned)(Rb * K + C) * 2u; rA[i] = R; cA2[i] = C * 2; }
    unsigned gcur[2][2], gnxt[2][2];
#define PG8_GOFF(dst, u) do { _Pragma("unroll") for (int _h = 0; _h < 2; ++_h) _Pragma("unroll") for (int _i = 0; _i < 2; ++_i) \
        dst[_h][_i] = (unsigned)gidx[(u).pm * BM + _h * HALF + rA[_i]] * (unsigned)(K * 2) + (unsigned)cA2[_i]; } while (0)
    const size_t kstep = (size_t)(BK * 2);
    const size_t hstep = (size_t)HALF * K * 2;
    const size_t tstep = 2 * hstep;
    const unsigned ldsw = (unsigned)wid * 1024u;
    const int aoff = lds_byte(wr * 64 + fr, fq * 8), boff = lds_byte(wc * 32 + fr, fq * 8);
#define PG8_SA(b, h) (((b) * 2 + (h)) * HTB)
#define PG8_SB(b, h) ((4 + (b) * 2 + (h)) * HTB)
#define PG8_STAGE(bufoff, gbase, voff) do { _Pragma("unroll") for (int _i = 0; _i < 2; ++_i) \
        __builtin_amdgcn_global_load_lds((const unsigned*)((const char*)(gbase) + (voff)[_i]), (PG8_LAS unsigned*)(lds + (bufoff) + ldsw + _i * 8192), 16, 0, 0); } while (0)
#define PG8_STAGE_A(bufoff, half, kb, NX) do { _Pragma("unroll") for (int _i = 0; _i < 2; ++_i) { \
        const char* _src = GATHER ? (const char*)g.A + (kb) + ((NX) ? gnxt[half][_i] : gcur[half][_i]) : ((NX) ? nA : cA) + (size_t)(half) * hstep + (kb) + voffA[_i]; \
        __builtin_amdgcn_global_load_lds((const unsigned*)_src, (PG8_LAS unsigned*)(lds + (bufoff) + ldsw + _i * 8192), 16, 0, 0); } } while (0)
#define PG8_LDA(dst, b, h) do { _Pragma("unroll") for (int m = 0; m < 4; ++m) _Pragma("unroll") for (int k = 0; k < 2; ++k) dst[m][k] = *(const PG8_LAS bf16x8*)(lds + PG8_SA(b, h) + aoff + m * 2048 + k * 1024); } while (0)
#define PG8_LDB(dst, b, h) do { _Pragma("unroll") for (int n = 0; n < 2; ++n) _Pragma("unroll") for (int k = 0; k < 2; ++k) dst[n][k] = *(const PG8_LAS bf16x8*)(lds + PG8_SB(b, h) + boff + n * 2048 + k * 1024); } while (0)
#define PG8_MMA(ai, bj, At, Bt) do { __builtin_amdgcn_s_setprio(1); _Pragma("unroll") for (int m = 0; m < 4; ++m) _Pragma("unroll") for (int n = 0; n < 2; ++n) _Pragma("unroll") for (int k = 0; k < 2; ++k) \
        acc[ai][bj][m][n] = __builtin_amdgcn_mfma_f32_16x16x32_bf16(Bt[n][k], At[m][k], acc[ai][bj][m][n], 0, 0, 0); __builtin_amdgcn_s_setprio(0); } while (0)
#define PG8_WAIT_V(n) asm volatile("s_waitcnt vmcnt(" #n ")" ::: "memory")
#define PG8_WAIT_L(n) asm volatile("s_waitcnt lgkmcnt(" #n ")" ::: "memory")
#define PG8_BAR __builtin_amdgcn_s_barrier()
#define PG8_SCHED __builtin_amdgcn_sched_barrier(0)
    Unit cur, nxt; int ui = 0;
    if (!S.next(0, cur)) return;
    f32x4 acc[2][2][4][2];
#pragma unroll
    for (int a = 0; a < 2; ++a)
#pragma unroll
        for (int b = 0; b < 2; ++b)
#pragma unroll
            for (int m = 0; m < 4; ++m)
#pragma unroll
                for (int n = 0; n < 2; ++n) acc[a][b][m][n] = (f32x4){0.f, 0.f, 0.f, 0.f};
    bf16x8 At[4][2], B0[2][2], B1[2][2];
    const char* cA = GATHER ? (const char*)g.A : (const char*)g.A + (size_t)cur.pm * tstep; const char* cB = (const char*)g.Bt + (size_t)cur.pb * tstep; const char* nA = cA;
    if (GATHER) { PG8_GOFF(gcur, cur); }
    PG8_STAGE(PG8_SB(0, 0), cB, voffB); PG8_STAGE(PG8_SB(0, 1), cB + hstep, voffB); PG8_STAGE_A(PG8_SA(0, 0), 0, 0, false); PG8_STAGE_A(PG8_SA(0, 1), 1, 0, false);
    if (wr == 1) PG8_BAR;
    PG8_WAIT_V(2); PG8_BAR;
    PG8_STAGE(PG8_SB(1, 0), cB + kstep, voffB); PG8_STAGE_A(PG8_SA(1, 0), 0, kstep, false); PG8_STAGE(PG8_SB(1, 1), cB + hstep + kstep, voffB);
    PG8_WAIT_V(6); PG8_BAR;
    for (;;) {
        const bool has_next = S.next(ui + 1, nxt);
        nA = GATHER ? cA : (has_next ? (const char*)g.A + (size_t)nxt.pm * tstep : cA); const char* nB = has_next ? (const char*)g.Bt + (size_t)nxt.pb * tstep : cB;
        if (GATHER) { if (has_next) { PG8_GOFF(gnxt, nxt); } else {
#pragma unroll
            for (int _h = 0; _h < 2; ++_h)
#pragma unroll
                for (int _i = 0; _i < 2; ++_i) gnxt[_h][_i] = gcur[_h][_i]; } }
        for (int t = 0; t < nt; t += 2) {
            const bool last = (t == nt - 2);
            const size_t k1 = (size_t)(t + 1) * kstep, k2 = last ? 0 : (size_t)(t + 2) * kstep, k3 = k2 + kstep;
            const char* b2 = last ? nB : cB + (size_t)(t + 2) * kstep; const char* b3 = b2 + kstep;
            PG8_LDB(B0, 0, 0); PG8_LDB(B1, 0, 1); PG8_SCHED; PG8_LDA(At, 0, 0); PG8_STAGE_A(PG8_SA(1, 1), 1, k1, false);
            PG8_WAIT_V(8); PG8_WAIT_L(0); PG8_BAR; PG8_MMA(0, 0, At, B0); PG8_MMA(0, 1, At, B1); PG8_BAR; PG8_SCHED;
            PG8_LDA(At, 0, 1); PG8_STAGE(PG8_SB(0, 0), b2, voffB); PG8_STAGE(PG8_SB(0, 1), b2 + hstep, voffB); PG8_STAGE_A(PG8_SA(0, 0), 0, k2, last);
            PG8_WAIT_V(8); PG8_WAIT_L(0); PG8_BAR; PG8_MMA(1, 0, At, B0); PG8_MMA(1, 1, At, B1); PG8_BAR; PG8_SCHED;
            PG8_LDB(B0, 1, 0); PG8_LDB(B1, 1, 1); PG8_SCHED; PG8_LDA(At, 1, 0); PG8_STAGE_A(PG8_SA(0, 1), 1, k2, last);
            PG8_WAIT_V(8); PG8_WAIT_L(0); PG8_BAR; PG8_MMA(0, 0, At, B0); PG8_MMA(0, 1, At, B1); PG8_BAR; PG8_SCHED;
            PG8_LDA(At, 1, 1); PG8_STAGE(PG8_SB(1, 0), b3, voffB); PG8_STAGE(PG8_SB(1, 1), b3 + hstep, voffB); PG8_STAGE_A(PG8_SA(1, 0), 0, k3, last);
            PG8_WAIT_V(8); PG8_WAIT_L(0); PG8_BAR; PG8_MMA(1, 0, At, B0); PG8_MMA(1, 1, At, B1); PG8_BAR; PG8_SCHED;
        }
        if (wr == 0) PG8_BAR;
        E(acc, cur, wr, wc, fr, fq);
        if (!has_next) break;
#pragma unroll
        for (int a = 0; a < 2; ++a)
#pragma unroll
            for (int b = 0; b < 2; ++b)
#pragma unroll
                for (int m = 0; m < 4; ++m)
#pragma unroll
                    for (int n = 0; n < 2; ++n) acc[a][b][m][n] = (f32x4){0.f, 0.f, 0.f, 0.f};
        cur = nxt; cA = nA; cB = nB; ++ui;
        if (GATHER) {
#pragma unroll
            for (int _h = 0; _h < 2; ++_h)
#pragma unroll
                for (int _i = 0; _i < 2; ++_i) gcur[_h][_i] = gnxt[_h][_i]; }
        if (wr == 1) PG8_BAR;
    }
    PG8_WAIT_V(0);
    PG8_BAR;
#undef PG8_SA
#undef PG8_SB
#undef PG8_STAGE
#undef PG8_STAGE_A
#undef PG8_GOFF
#undef PG8_LDA
#undef PG8_LDB
#undef PG8_MMA
#undef PG8_WAIT_V
#undef PG8_WAIT_L
#undef PG8_BAR
#undef PG8_SCHED
}
}

#define LAS __attribute__((address_space(3)))
using pg8::bf16_t; using pg8::f32x4; using pg8::u32x4; using pg8::u32x2;
typedef unsigned short u16x8 __attribute__((ext_vector_type(8)));
typedef float f32x2 __attribute__((ext_vector_type(2)));

constexpr int DM = 1024, NB = 2, SEQ = 8192, NTOK = NB * SEQ, CTXL = 256, NCTX = NB * CTXL, NROW = NTOK + NCTX;
constexpr int NE = 16, CAP = 1024, DE = 2048, NSLOT = NE * NB * CAP;
constexpr int NADA = 6 * DM;
constexpr int NTHR = 512;

constexpr size_t MiB = 1u << 20;
constexpr size_t WS_CTL = 0;
constexpr size_t WS_MOD = 1 * MiB;
constexpr size_t WS_LB = WS_MOD + 256 * 1024;
constexpr size_t WS_POSR = WS_LB + 64 * 1024;
constexpr size_t WS_POSC = WS_POSR + 256 * 1024;
constexpr size_t WS_AFF = 2 * MiB;
constexpr size_t WS_TOPI = 3 * MiB;
constexpr size_t WS_TOPG = WS_TOPI + 128 * 1024;
constexpr size_t WS_SLOT = 4 * MiB;
constexpr size_t WS_WHGIN = 6 * MiB;
constexpr size_t WS_WHGOUT = 16 * MiB;
constexpr size_t WS_WSCIN = 18 * MiB;
constexpr size_t WS_WSCOUT = 24 * MiB;
constexpr size_t WS_WMOE1 = 26 * MiB;
constexpr size_t WS_WMOE2 = WS_WMOE1 + 256 * MiB;
constexpr size_t WS_X = WS_WMOE2 + 128 * MiB;
constexpr size_t WS_H = WS_X + 64 * MiB;
constexpr size_t WS_R = WS_H + 34 * MiB;
constexpr size_t WS_Q = WS_R;
constexpr size_t WS_V = WS_Q + 34 * MiB;
constexpr size_t WS_G = WS_V + 34 * MiB;
constexpr size_t WS_LF = WS_G + 34 * MiB;
constexpr size_t WS_LBK = WS_LF + 66 * MiB;
constexpr size_t WS_OF = WS_LBK + 66 * MiB;
constexpr size_t WS_OB = WS_OF + 64 * MiB;
constexpr size_t WS_U = WS_OB;
constexpr size_t WS_DD = WS_OB + 40 * MiB;
constexpr size_t WS_ON = WS_OB + 64 * MiB;
constexpr size_t WS_HG_END = WS_ON + 32 * MiB;
constexpr size_t WS_XG = WS_R;
constexpr size_t WS_ACT = WS_XG + 64 * MiB;
constexpr size_t WS_Y = WS_ACT + 128 * MiB;
constexpr size_t WS_MOE_END = WS_Y + 128 * MiB;
constexpr size_t WS_BG = WS_R;
constexpr size_t WS_CU = WS_BG + 32 * MiB;
constexpr size_t WS_Z = WS_CU + 32 * MiB;
constexpr size_t WS_END = WS_HG_END > WS_MOE_END ? WS_HG_END : WS_MOE_END;
static_assert(WS_END <= 1024 * MiB, "workspace map exceeds 1 GiB");

constexpr int LDS_BYTES = 147456;

struct Params { const float* in[20]; float* out; unsigned char* ws; int ph_lo, ph_hi; };
enum { I_X = 0, I_C, I_CTX, I_CCTX, I_ADAW, I_ADAB, I_NMIX, I_NFFN, I_NFIN, I_HGWIN, I_HGLB, I_HGNORM, I_HGWOUT, I_SCWIN, I_SCCONV, I_SCWOUT, I_ROUTER, I_WGATE, I_WUP, I_WDOWN };

typedef __bf16 bf16x2_t __attribute__((ext_vector_type(2)));
__device__ __forceinline__ unsigned pk2(float lo, float hi) { const f32x2 v = {lo, hi}; return __builtin_bit_cast(unsigned, __builtin_convertvector(v, bf16x2_t)); }
__device__ __forceinline__ unsigned f2bf(float f) { return pk2(f, 0.f) & 0xffffu; }
__device__ __forceinline__ float bf2f(unsigned short h) { return __builtin_bit_cast(float, (unsigned)h << 16); }
template <int CTRL> __device__ __forceinline__ float dpp_f(float x) { return __builtin_bit_cast(float, __builtin_amdgcn_update_dpp(0, __builtin_bit_cast(int, x), CTRL, 0xf, 0xf, true)); }
__device__ __forceinline__ float row16_sum(float x) {
    x += dpp_f<0xB1>(x);
    x += dpp_f<0x4E>(x);
    x += dpp_f<0x141>(x);
    x += dpp_f<0x140>(x);
    return x;
}
__device__ __forceinline__ float swap16_add(float a, float b) { const auto r = __builtin_amdgcn_permlane16_swap(__float_as_uint(a), __float_as_uint(b), false, false); const unsigned r0 = r[0], r1 = r[1]; return __uint_as_float(r0) + __uint_as_float(r1); }
__device__ __forceinline__ float swap32_add(float a, float b) { const auto r = __builtin_amdgcn_permlane32_swap(__float_as_uint(a), __float_as_uint(b), false, false); const unsigned r0 = r[0], r1 = r[1]; return __uint_as_float(r0) + __uint_as_float(r1); }
__device__ __forceinline__ float swap16_max(float a) { const auto r = __builtin_amdgcn_permlane16_swap(__float_as_uint(a), __float_as_uint(a), false, false); const unsigned r0 = r[0], r1 = r[1]; return fmaxf(__uint_as_float(r0), __uint_as_float(r1)); }
__device__ __forceinline__ float swap32_max(float a) { const auto r = __builtin_amdgcn_permlane32_swap(__float_as_uint(a), __float_as_uint(a), false, false); const unsigned r0 = r[0], r1 = r[1]; return fmaxf(__uint_as_float(r0), __uint_as_float(r1)); }
__device__ __forceinline__ float lane_xor8(float x) { return dpp_f<0x128>(x); }
__device__ __forceinline__ float lane_xor4(float x) { return dpp_f<0x1B>(dpp_f<0x141>(x)); }
__device__ __forceinline__ float wave_sum(float v) { v = row16_sum(v); v = swap16_add(v, v); v = swap32_add(v, v); return v; }
__device__ __forceinline__ float sigmoidf_(float x) { return 1.f / (1.f + expf(-x)); }
__device__ __forceinline__ float fsigmoid(float x) { return __builtin_amdgcn_rcpf(1.f + __builtin_amdgcn_exp2f(-1.4426950408889634f * x)); }
__device__ __forceinline__ float fsilu(float x) { return x * fsigmoid(x); }
__device__ __forceinline__ float siluf_(float x) { return x / (1.f + expf(-x)); }

struct EpiInProj {
    static constexpr bool PERM = false;
    unsigned char* ws;
    __device__ __forceinline__ void operator()(const f32x4 (&acc)[2][2][4][2], const pg8::Unit& u, int wr, int wc, int fr, int fq) const {
        const int sec = u.pn >> 2;
        const int row0 = u.pm * 256 + wr * 64 + fr, cb = (u.pn & 3) * 256 + wc * 32 + 4 * fq;
        if (sec == 0 || sec == 1 || sec == 4) {
            bf16_t* O = (bf16_t*)(ws + (sec == 0 ? WS_Q : (sec == 1 ? WS_V : WS_G)));
#pragma unroll
            for (int ai = 0; ai < 2; ++ai)
#pragma unroll
                for (int m = 0; m < 4; ++m) { bf16_t* rp = O + (size_t)(row0 + ai * 128 + m * 16) * DM + cb;
#pragma unroll
                    for (int bj = 0; bj < 2; ++bj)
#pragma unroll
                        for (int n = 0; n < 2; ++n) { f32x4 v = acc[ai][bj][m][n];
                            if (sec == 0) v = v * 0.08838834764831845f;
                            if (sec == 4) { v[0] = fsilu(v[0]); v[1] = fsilu(v[1]); v[2] = fsilu(v[2]); v[3] = fsilu(v[3]); }
                            u32x2 w; w.x = pk2(v[0], v[1]); w.y = pk2(v[2], v[3]); *(u32x2*)(rp + bj * 128 + n * 16) = w; } }
        } else {
            float* O = (float*)(ws + (sec == 2 ? WS_LF : WS_LBK)); const float* lb0 = (const float*)(ws + WS_LB);
            f32x4 lbv[2][2];
#pragma unroll
            for (int bj = 0; bj < 2; ++bj)
#pragma unroll
                for (int n = 0; n < 2; ++n) lbv[bj][n] = *(const f32x4*)(lb0 + cb + bj * 128 + n * 16);
#pragma unroll
            for (int ai = 0; ai < 2; ++ai)
#pragma unroll
                for (int m = 0; m < 4; ++m) { float* rp = O + (size_t)(row0 + ai * 128 + m * 16) * DM + cb;
#pragma unroll
                    for (int bj = 0; bj < 2; ++bj)
#pragma unroll
                        for (int n = 0; n < 2; ++n) { const f32x4 z = acc[ai][bj][m][n], lb = lbv[bj][n]; f32x4 o;
#pragma unroll
                            for (int i = 0; i < 4; ++i) o[i] = lb[i] + (1.f - lb[i]) * fsigmoid(z[i]);
                            *(f32x4*)(rp + bj * 128 + n * 16) = o; } }
        }
    }
};
struct EpiResid {
    static constexpr bool PERM = false;
    float* X; const float* gate;
    __device__ __forceinline__ void operator()(const f32x4 (&acc)[2][2][4][2], const pg8::Unit& u, int wr, int wc, int fr, int fq) const {
        const int row0 = u.pm * 256 + wr * 64 + fr, cb = u.pn * 256 + wc * 32 + 4 * fq;
        const float* gp = gate + (size_t)((u.pm * 256) / SEQ) * NADA + cb;
        f32x4 gv[2][2];
#pragma unroll
        for (int bj = 0; bj < 2; ++bj)
#pragma unroll
            for (int n = 0; n < 2; ++n) gv[bj][n] = *(const f32x4*)(gp + bj * 128 + n * 16);
#pragma unroll
        for (int ai = 0; ai < 2; ++ai)
#pragma unroll
            for (int m = 0; m < 4; ++m) { float* rp = X + (size_t)(row0 + ai * 128 + m * 16) * DM + cb;
#pragma unroll
                for (int bj = 0; bj < 2; ++bj)
#pragma unroll
                    for (int n = 0; n < 2; ++n) { f32x4* q = (f32x4*)(rp + bj * 128 + n * 16); *q = *q + gv[bj][n] * acc[ai][bj][m][n]; } }
    }
};
struct EpiGLU {
    static constexpr bool PERM = true;
    bf16_t* ACT;
    __device__ __forceinline__ void operator()(const f32x4 (&acc)[2][2][4][2], const pg8::Unit& u, int wr, int wc, int fr, int fq) const {
        const int row0 = u.pm * 256 + wr * 64 + fr, cb = u.pn * 128 + wc * 32 + 8 * fq;
#pragma unroll
        for (int ai = 0; ai < 2; ++ai)
#pragma unroll
            for (int m = 0; m < 4; ++m) { bf16_t* rp = ACT + (size_t)(row0 + ai * 128 + m * 16) * DE + cb;
                f32x4 o[2];
#pragma unroll
                for (int n = 0; n < 2; ++n) { const f32x4 a = acc[ai][0][m][n], w = acc[ai][1][m][n];
#pragma unroll
                    for (int i = 0; i < 4; ++i) o[n][i] = fsilu(a[i]) * w[i]; }
                u32x4 w; w.x = pk2(o[0][0], o[0][1]); w.y = pk2(o[0][2], o[0][3]); w.z = pk2(o[1][0], o[1][1]); w.w = pk2(o[1][2], o[1][3]);
                *(u32x4*)rp = w; }
    }
};
struct EpiRowScale {
    static constexpr bool PERM = true;
    bf16_t* Y; const float* rg;
    __device__ __forceinline__ void operator()(const f32x4 (&acc)[2][2][4][2], const pg8::Unit& u, int wr, int wc, int fr, int fq) const {
        const int row0 = u.pm * 256 + wr * 64 + fr, cb = u.pn * 256 + wc * 32 + 8 * fq;
#pragma unroll
        for (int ai = 0; ai < 2; ++ai)
#pragma unroll
            for (int m = 0; m < 4; ++m) { const int row = row0 + ai * 128 + m * 16; const float gsc = rg[row]; bf16_t* rp = Y + (size_t)row * DM + cb;
#pragma unroll
                for (int bj = 0; bj < 2; ++bj) { const f32x4 v0 = acc[ai][bj][m][0] * gsc, v1 = acc[ai][bj][m][1] * gsc;
                    u32x4 w; w.x = pk2(v0[0], v0[1]); w.y = pk2(v0[2], v0[3]); w.z = pk2(v1[0], v1[1]); w.w = pk2(v1[2], v1[3]);
                    *(u32x4*)(rp + bj * 128) = w; } }
    }
};
struct EpiConvIn {
    static constexpr bool PERM = true;
    bf16_t *BG, *CU;
    __device__ __forceinline__ void operator()(const f32x4 (&acc)[2][2][4][2], const pg8::Unit& u, int wr, int wc, int fr, int fq) const {
        const int row0 = u.pm * 256 + wr * 64 + fr;
        if (u.pn < 4) {
            const int cb = u.pn * 256 + wc * 32 + 8 * fq;
#pragma unroll
            for (int ai = 0; ai < 2; ++ai)
#pragma unroll
                for (int m = 0; m < 4; ++m) { bf16_t* rp = BG + (size_t)(row0 + ai * 128 + m * 16) * DM + cb;
#pragma unroll
                    for (int bj = 0; bj < 2; ++bj) { const f32x4 v0 = acc[ai][bj][m][0], v1 = acc[ai][bj][m][1];
                        u32x4 w; w.x = pk2(v0[0], v0[1]); w.y = pk2(v0[2], v0[3]); w.z = pk2(v1[0], v1[1]); w.w = pk2(v1[2], v1[3]);
                        *(u32x4*)(rp + bj * 128) = w; } }
        } else {
            const int cb = (u.pn - 4) * 128 + wc * 32 + 8 * fq;
#pragma unroll
            for (int ai = 0; ai < 2; ++ai)
#pragma unroll
                for (int m = 0; m < 4; ++m) { bf16_t* rp = CU + (size_t)(row0 + ai * 128 + m * 16) * DM + cb;
                    const f32x4 v0 = acc[ai][0][m][0] * acc[ai][1][m][0], v1 = acc[ai][0][m][1] * acc[ai][1][m][1];
                    u32x4 w; w.x = pk2(v0[0], v0[1]); w.y = pk2(v0[2], v0[3]); w.z = pk2(v1[0], v1[1]); w.w = pk2(v1[2], v1[3]);
                    *(u32x4*)rp = w; }
        }
    }
};

__device__ __forceinline__ void ph_prep(const Params& p, unsigned char* lds, int bid, int nblk) {
    float* sv = (float*)lds;
    float* red = sv + 3 * 1024;
    int tid_ = threadIdx.x; asm volatile("" : "+v"(tid_)); const int tid = tid_;
    const float* c = p.in[I_C]; const float* cctx = p.in[I_CCTX];
    for (int i = tid; i < 3 * 1024; i += NTHR) { const float v = (i < 2048) ? c[i] : cctx[i - 2048]; sv[i] = siluf_(v); }
    __syncthreads();
    const float* ada_w = p.in[I_ADAW]; const float* ada_b = p.in[I_ADAB];
    float* mod = (float*)(p.ws + WS_MOD);
    for (int it = bid; it < 192; it += nblk) {
        const int l = it / 96, j0 = (it % 96) * 64, col = tid & 63, ks = tid >> 6;
        const float* W = ada_w + (size_t)l * DM * NADA + j0 + col;
        float a0 = 0.f, a1 = 0.f, a2 = 0.f;
#pragma unroll 16
        for (int k = ks * 128; k < ks * 128 + 128; ++k) { const float w = W[(size_t)k * NADA]; a0 += sv[k] * w; a1 += sv[1024 + k] * w; a2 += sv[2048 + k] * w; }
        red[(ks * 3 + 0) * 64 + col] = a0; red[(ks * 3 + 1) * 64 + col] = a1; red[(ks * 3 + 2) * 64 + col] = a2;
        __syncthreads();
        if (tid < 192) { const int v = tid >> 6, cc = tid & 63; float s = ada_b[l * NADA + j0 + cc];
#pragma unroll
            for (int k2 = 0; k2 < 8; ++k2) s += red[(k2 * 3 + v) * 64 + cc];
            mod[(size_t)(l * 3 + v) * NADA + j0 + cc] = s; }
        __syncthreads();
    }
    const int gt = bid * NTHR + tid, NT = nblk * NTHR;
    const float* lg = p.in[I_HGLB]; float* lb0 = (float*)(p.ws + WS_LB);
    for (int d = gt; d < DM; d += NT) { const float l0 = lg[d], l1 = lg[DM + d], l2 = lg[2 * DM + d]; const float mx = fmaxf(l0, fmaxf(l1, l2));
        const float e0 = expf(l0 - mx), e1 = expf(l1 - mx), e2 = expf(l2 - mx); lb0[d] = e0 / (e0 + e1 + e2); }
    float* posr = (float*)(p.ws + WS_POSR);
    for (int i = gt; i < (128 + 64) * 512; i += NT) { const int pi = i >> 9, dd = i & 511; const int pos = pi < 128 ? pi : pi - 128; const int fi = dd & 255;
        const float om = exp2f(-(float)fi * (13.287712379549449f / 256.0f)); const float a = (float)pos * om; posr[i] = dd < 256 ? sinf(a) : cosf(a); }
}

__device__ __forceinline__ void transpose_item(const float* W, int N, bf16_t* WT, int K, float* scr, int k0, int n0, size_t drow0, int lane) {
#pragma unroll
    for (int i = 0; i < 8; ++i) { const int kk = 8 * i + (lane >> 3); const f32x4 v = *(const f32x4*)(W + (size_t)(k0 + kk) * N + n0 + (lane & 7) * 4); float* d = scr + kk * 33 + (lane & 7) * 4; d[0] = v[0]; d[1] = v[1]; d[2] = v[2]; d[3] = v[3]; }
    __builtin_amdgcn_s_waitcnt(0xc07f); asm volatile("" ::: "memory");
    const int c = lane & 7;
#pragma unroll
    for (int j = 0; j < 4; ++j) { const int n = (lane >> 3) + 8 * j; const float* s = scr + (8 * c) * 33 + n;
        u32x4 o; o.x = pk2(s[0 * 33], s[1 * 33]); o.y = pk2(s[2 * 33], s[3 * 33]); o.z = pk2(s[4 * 33], s[5 * 33]); o.w = pk2(s[6 * 33], s[7 * 33]);
        *(u32x4*)(WT + (drow0 + n) * K + k0 + 8 * c) = o; }
    __builtin_amdgcn_s_waitcnt(0xc07f); asm volatile("" ::: "memory");
}
__device__ __forceinline__ void ph_convert_small(const Params& p, unsigned char* lds, int bid, int nblk) {
    int tid_ = threadIdx.x; asm volatile("" : "+v"(tid_));
    const int tid = tid_, lane = tid & 63, wave = tid >> 6;
    float* scr = (float*)lds + wave * (64 * 33);
    const int gw = bid * 8 + wave, NGW = nblk * 8;
    constexpr int I_A = 16 * 160, I_B = 16 * 32, I_C_ = 16 * 96, I_D = 16 * 32;
    for (int it = gw; it < I_A + I_B + I_C_ + I_D; it += NGW) {
        int r = it;
        if (r < I_A) { const int kb = r / 160, nb = r % 160; transpose_item(p.in[I_HGWIN], 5120, (bf16_t*)(p.ws + WS_WHGIN), 1024, scr, kb * 64, nb * 32, (size_t)nb * 32, lane); continue; } r -= I_A;
        if (r < I_B) { const int kb = r / 32, nb = r % 32; transpose_item(p.in[I_HGWOUT], 1024, (bf16_t*)(p.ws + WS_WHGOUT), 1024, scr, kb * 64, nb * 32, (size_t)nb * 32, lane); continue; } r -= I_B;
        if (r < I_C_) { const int kb = r / 96, nb = r % 96, n0 = nb * 32; size_t dr;
            if (n0 < 1024) dr = n0; else { const int np = n0 - 1024, sec = np >> 10, nn = np & 1023; dr = 1024 + (nn >> 7) * 256 + sec * 128 + (nn & 127); }
            transpose_item(p.in[I_SCWIN], 3072, (bf16_t*)(p.ws + WS_WSCIN), 1024, scr, kb * 64, n0, dr, lane); continue; } r -= I_C_;
        { const int kb = r / 32, nb = r % 32; transpose_item(p.in[I_SCWOUT], 1024, (bf16_t*)(p.ws + WS_WSCOUT), 1024, scr, kb * 64, nb * 32, (size_t)nb * 32, lane); }
    }
}
struct CvtItem { const float* src; bf16_t* dst; int N, K; };
__device__ __forceinline__ CvtItem moe_item(const Params& p, int l, int r) {
    CvtItem c;
    if (r < 32768) { const int up = r >= 16384; if (up) r -= 16384; const int le = l * 16 + (r >> 10), q = r & 1023, kb = q >> 6, nb = q & 63, n0 = nb * 32;
        const size_t dr = (size_t)le * 4096 + (n0 >> 7) * 256 + up * 128 + (n0 & 127);
        c.src = p.in[up ? I_WUP : I_WGATE] + (size_t)le * 1024 * 2048 + (size_t)(kb * 64) * 2048 + n0; c.dst = (bf16_t*)(p.ws + WS_WMOE1) + dr * 1024 + kb * 64; c.N = 2048; c.K = 1024; }
    else { r -= 32768; const int le = l * 16 + (r >> 10), q = r & 1023, kb = q >> 5, nb = q & 31, n0 = nb * 32;
        c.src = p.in[I_WDOWN] + (size_t)le * 2048 * 1024 + (size_t)(kb * 64) * 1024 + n0; c.dst = (bf16_t*)(p.ws + WS_WMOE2) + ((size_t)le * 1024 + n0) * 2048 + kb * 64; c.N = 1024; c.K = 2048; }
    return c;
}
__device__ __forceinline__ void convert_moe_slice(const Params& p, unsigned char* lds, int bid, int nblk, int l, int lo, int hi) {
    int tid_ = threadIdx.x; asm volatile("" : "+v"(tid_));
    const int tid = tid_, lane = tid & 63, wave = tid >> 6;
    float* scr = (float*)lds + wave * (64 * 33);
    const int gw = bid * 8 + wave, NGW = nblk * 8;
    constexpr int NI = 3;
    for (int it = lo + gw; it < hi; it += NGW * NI) {
        f32x4 v[NI][8]; CvtItem ci[NI];
#pragma unroll
        for (int u = 0; u < NI; ++u) { const int r = it + u * NGW; ci[u] = moe_item(p, l, r < hi ? r : it);
#pragma unroll
            for (int i = 0; i < 8; ++i) v[u][i] = __builtin_nontemporal_load((const f32x4*)(ci[u].src + (size_t)(8 * i + (lane >> 3)) * ci[u].N + (lane & 7) * 4)); }
#pragma unroll
        for (int u = 0; u < NI; ++u) { if (it + u * NGW < hi) {
#pragma unroll
            for (int i = 0; i < 8; ++i) { float* d = scr + (8 * i + (lane >> 3)) * 33 + (lane & 7) * 4; d[0] = v[u][i][0]; d[1] = v[u][i][1]; d[2] = v[u][i][2]; d[3] = v[u][i][3]; }
            __builtin_amdgcn_s_waitcnt(0xc07f); asm volatile("" ::: "memory");
            const int c = lane & 7;
#pragma unroll
            for (int j = 0; j < 4; ++j) { const int n = (lane >> 3) + 8 * j; const float* sp = scr + (8 * c) * 33 + n;
                u32x4 o; o.x = pk2(sp[0 * 33], sp[1 * 33]); o.y = pk2(sp[2 * 33], sp[3 * 33]); o.z = pk2(sp[4 * 33], sp[5 * 33]); o.w = pk2(sp[6 * 33], sp[7 * 33]);
                __builtin_nontemporal_store(o, (u32x4*)(ci[u].dst + (size_t)n * ci[u].K + 8 * c)); }
            __builtin_amdgcn_s_waitcnt(0xc07f); asm volatile("" ::: "memory"); } }
    }
    __syncthreads();
}

constexpr int CV_ITEMS = 49152, CW_Q = 1536;
constexpr int MW_LAYER = 12, MW_BASE = 13, MW_EMPTY = 14, MW_REL = 15, MW_LAST = 16;
__device__ __forceinline__ bool cvt_batch(const Params& p, unsigned char* lds, volatile LAS unsigned* MISC, unsigned layer_mask) {
    int tid_ = threadIdx.x; asm volatile("" : "+v"(tid_));
    const int tid = tid_, lane = tid & 63, wave = tid >> 6;
    if (tid == 0) {
        unsigned* q = (unsigned*)(p.ws + WS_CTL) + CW_Q; unsigned empty = MISC[MW_EMPTY]; int layer = -1; unsigned base = 0u;
#pragma unroll
        for (int l = 0; l < 2; ++l) if (layer < 0 && ((layer_mask >> l) & 1u) && !((empty >> l) & 1u)) {
            const unsigned b0 = __hip_atomic_fetch_add(q + 64 * l, 8u, __ATOMIC_RELAXED, __HIP_MEMORY_SCOPE_AGENT);
            if (b0 < (unsigned)CV_ITEMS) { layer = l; base = b0; MISC[MW_LAST + l] = b0 + 8u; } else empty |= 1u << l; }
        MISC[MW_EMPTY] = empty; MISC[MW_LAYER] = (unsigned)layer; MISC[MW_BASE] = base;
    }
    __syncthreads();
    const int layer = (int)MISC[MW_LAYER]; const int item = (int)MISC[MW_BASE] + wave;
    if (layer < 0) return false;
    float* scr = (float*)lds + wave * (64 * 33);
    if (item < CV_ITEMS) {
        const CvtItem ci = moe_item(p, layer, item);
        f32x4 v[8];
#pragma unroll
        for (int i = 0; i < 8; ++i) v[i] = __builtin_nontemporal_load((const f32x4*)(ci.src + (size_t)(8 * i + (lane >> 3)) * ci.N + (lane & 7) * 4));
#pragma unroll
        for (int i = 0; i < 8; ++i) { float* d = scr + (8 * i + (lane >> 3)) * 33 + (lane & 7) * 4; d[0] = v[i][0]; d[1] = v[i][1]; d[2] = v[i][2]; d[3] = v[i][3]; }
        __builtin_amdgcn_s_waitcnt(0xc07f); asm volatile("" ::: "memory");
        const int c = lane & 7;
#pragma unroll
        for (int j = 0; j < 4; ++j) { const int n = (lane >> 3) + 8 * j; const float* sp = scr + (8 * c) * 33 + n;
            u32x4 o; o.x = pk2(sp[0 * 33], sp[1 * 33]); o.y = pk2(sp[2 * 33], sp[3 * 33]); o.z = pk2(sp[4 * 33], sp[5 * 33]); o.w = pk2(sp[6 * 33], sp[7 * 33]);
            __builtin_nontemporal_store(o, (u32x4*)(ci.dst + (size_t)n * ci.K + 8 * c)); }
    }
    __syncthreads();
    return true;
}
__device__ __forceinline__ void cvt_drain_until(const Params& p, unsigned char* lds, volatile LAS unsigned* MISC, int l, unsigned limit) {
    for (;;) { if ((MISC[MW_EMPTY] >> l) & 1u) break; if (MISC[MW_LAST + l] >= limit) break; if (!cvt_batch(p, lds, MISC, 1u << l)) break; }
}
__device__ __forceinline__ void cvt_budget(const Params& p, unsigned char* lds, volatile LAS unsigned* MISC, unsigned layer_mask, int nbatch) {
    for (int i = 0; i < nbatch; ++i) if (!cvt_batch(p, lds, MISC, layer_mask)) break;
}

__device__ __forceinline__ void store_mod_bf16(bf16_t* hrow, const f32x4 (&v)[4], float rstd, const float* g, const float* sh, const float* sc, int lane) {
#pragma unroll
    for (int j = 0; j < 4; ++j) { const int c0 = 256 * j + 4 * lane; const f32x4 gv = *(const f32x4*)(g + c0), shv = *(const f32x4*)(sh + c0), scv = *(const f32x4*)(sc + c0);
        f32x4 h;
#pragma unroll
        for (int i = 0; i < 4; ++i) h[i] = (v[j][i] * rstd * gv[i]) * (1.f + scv[i]) + shv[i];
        u32x2 w; w.x = pk2(h[0], h[1]); w.y = pk2(h[2], h[3]); *(u32x2*)(hrow + c0) = w; }
}
__device__ __forceinline__ void ph_mod0(const Params& p, int row_lo, int row_hi, int wk, int nwk) {
    int tid_ = threadIdx.x; asm volatile("" : "+v"(tid_));
    const int tid = tid_, lane = tid & 63, wave = tid >> 6, gw = wk * 8 + wave, NGW = nwk * 8;
    const float* x = p.in[I_X]; const float* ctx = p.in[I_CTX]; const float* g = p.in[I_NMIX];
    const float* mod = (const float*)(p.ws + WS_MOD); const float* posr = (const float*)(p.ws + WS_POSR); const float* posc = (const float*)(p.ws + WS_POSC);
    float* X = (float*)(p.ws + WS_X); bf16_t* H = (bf16_t*)(p.ws + WS_H);
    f32x4 nx[4];
    { const int row = row_lo + gw; if (row < row_hi) { const float* src = row < NTOK ? x + (size_t)row * DM : ctx + (size_t)(row - NTOK) * DM;
#pragma unroll
        for (int j = 0; j < 4; ++j) nx[j] = *(const f32x4*)(src + 256 * j + 4 * lane); } }
    for (int row = row_lo + gw; row < row_hi; row += NGW) {
        f32x4 v[4]; float ss = 0.f; int vec;
#pragma unroll
        for (int j = 0; j < 4; ++j) v[j] = nx[j];
        { const int r2 = row + NGW; if (r2 < row_hi) { const float* src = r2 < NTOK ? x + (size_t)r2 * DM : ctx + (size_t)(r2 - NTOK) * DM;
#pragma unroll
            for (int j = 0; j < 4; ++j) nx[j] = *(const f32x4*)(src + 256 * j + 4 * lane); } }
        if (row < NTOK) { const int t = row & (SEQ - 1); vec = row >> 13; const float* pr = posr + (size_t)(t >> 6) * 512; const float* pc = posc + (size_t)(t & 63) * 512;
#pragma unroll
            for (int j = 0; j < 4; ++j) { const int c0 = 256 * j + 4 * lane; const f32x4 pv = *(const f32x4*)((j < 2 ? pr : pc) + (c0 & 511));
                v[j] = v[j] + pv; *(f32x4*)(X + (size_t)row * DM + c0) = v[j]; }
        } else vec = 2;
#pragma unroll
        for (int j = 0; j < 4; ++j) ss += (v[j][0] * v[j][0] + v[j][1] * v[j][1]) + (v[j][2] * v[j][2] + v[j][3] * v[j][3]);
        const float rstd = 1.f / sqrtf(wave_sum(ss) * (1.f / DM) + 1e-6f);
        const float* mv = mod + (size_t)(0 * 3 + vec) * NADA;
        store_mod_bf16(H + (size_t)row * DM, v, rstd, g, mv, mv + DM, lane);
    }
}

typedef short s16x4 __attribute__((ext_vector_type(4)));
typedef short v4i16_t __attribute__((ext_vector_type(4)));
using pg8::bf16x8;
constexpr int KT_STR = 160, KS_STR = 144, V_STR = 288;
constexpr int GL_QT = 0, GL_KT = 20480, GL_KS = 40960, GL_PL = 59392, GL_V = 68608, GL_SEG = 87040, GL_DV = 89088, GL_EM = 89600, GL_SSQ = 90112, GL_RSTD = 92160;
__device__ __forceinline__ s16x4 lds_tr(const LAS unsigned char* p) { return __builtin_bit_cast(s16x4, __builtin_amdgcn_ds_read_tr16_b64_v4i16((LAS v4i16_t*)p)); }
__device__ __forceinline__ bf16x8 cat8(s16x4 a, s16x4 b) { return __builtin_shufflevector(a, b, 0, 1, 2, 3, 4, 5, 6, 7); }
__device__ __forceinline__ bf16x8 lds_pair64(const LAS unsigned char* p, int d2) { const u32x2 a = *(const LAS u32x2*)p, b = *(const LAS u32x2*)(p + d2); u32x4 r; r.x = a.x; r.y = a.y; r.z = b.x; r.w = b.y; return __builtin_bit_cast(bf16x8, r); }

constexpr int ON_STR = 272;
constexpr int GL_RF = 92416, GL_RQ = 125184, GL_END = 141568;
struct GlaRegs { f32x4 f[4]; u32x4 q[2]; u32x4 v[2]; };
template <bool WITHQ>
__device__ __forceinline__ void gla_load(GlaRegs& R, const float* F, const bf16_t* Q, const bf16_t* V, int rb, int h, int tid) {
    const unsigned lf = (unsigned)((tid >> 5) * DM + (tid & 31) * 4), lq = (unsigned)((tid >> 4) * DM + (tid & 15) * 8);
#pragma unroll
    for (int i = 0; i < 4; ++i) { const float* fb = F + (size_t)(rb + 16 * i) * DM + h * 128; R.f[i] = *(const f32x4*)(fb + lf); }
#pragma unroll
    for (int i = 0; i < 2; ++i) { const size_t ub = (size_t)(rb + 32 * i) * DM + h * 128;
        if (WITHQ) R.q[i] = *(const u32x4*)(Q + ub + lq); R.v[i] = *(const u32x4*)(V + ub + lq); }
}
template <bool WITHQ>
__device__ __forceinline__ void gla_put_raw(const GlaRegs& R, LAS unsigned char* lds, int dir, int tid) {
#pragma unroll
    for (int i = 0; i < 4; ++i) { const int id = tid + 512 * i, row = id >> 5, c4 = (id & 31) * 4, p = dir ? 63 - row : row; *(LAS f32x4*)(lds + GL_RF + p * 512 + c4 * 4) = R.f[i]; }
#pragma unroll
    for (int i = 0; i < 2; ++i) { const int id = tid + 512 * i, row = id >> 4, c8 = (id & 15) * 8, p = dir ? 63 - row : row;
        if (WITHQ) *(LAS u32x4*)(lds + GL_RQ + p * 256 + c8 * 2) = R.q[i]; *(LAS u32x4*)(lds + GL_V + p * V_STR + c8 * 2) = R.v[i]; }
}
template <bool G2>
__device__ __forceinline__ void gla_phase_a(LAS unsigned char* lds, int tid) {
    const int k = tid & 127, seg = tid >> 7;
    LAS float* segtot = (LAS float*)(lds + GL_SEG);
    float f[16];
#pragma unroll
    for (int i = 0; i < 16; ++i) f[i] = *(const LAS float*)(lds + GL_RF + (16 * seg + i) * 512 + k * 4);
    if (G2) {
        unsigned short q[16];
#pragma unroll
        for (int i = 0; i < 16; ++i) q[i] = *(const LAS unsigned short*)(lds + GL_RQ + (16 * seg + i) * 256 + k * 2);
        float c[16]; c[0] = f[0];
#pragma unroll
        for (int i = 1; i < 16; ++i) c[i] = c[i - 1] * f[i];
        segtot[seg * 128 + k] = c[15];
        __syncthreads();
        const float T0 = segtot[k], T1 = segtot[128 + k], T2 = segtot[256 + k], T3 = segtot[384 + k];
        const float Fs = seg == 0 ? 1.f / (T0 * T1) : (seg == 1 ? 1.f / T1 : (seg == 2 ? 1.f : T2));
        const float cK = T2 * T3;
        if (seg == 0) { ((LAS float*)(lds + GL_DV))[k] = T0 * T1 * cK; ((LAS float*)(lds + GL_EM))[k] = T0 * T1; }
        unsigned wq[8], wk[8], ws_[8];
#pragma unroll
        for (int i = 0; i < 16; i += 2) { float qp[2], kp[2], ks[2];
#pragma unroll
            for (int e = 0; e < 2; ++e) { const float eq = c[i + e] * Fs, inv = __builtin_amdgcn_rcpf(eq), kk = 1.f - f[i + e];
                qp[e] = bf2f(q[i + e]) * eq; kp[e] = kk * inv; ks[e] = kp[e] * cK; }
            wq[i >> 1] = pk2(qp[0], qp[1]); wk[i >> 1] = pk2(kp[0], kp[1]); ws_[i >> 1] = pk2(ks[0], ks[1]); }
        LAS unsigned char* dq = lds + GL_QT + k * KT_STR + seg * 32; LAS unsigned char* dk = lds + GL_KT + k * KT_STR + seg * 32; LAS unsigned char* ds = lds + GL_KS + k * KS_STR + seg * 32;
        *(LAS u32x4*)dq = (u32x4){wq[0], wq[1], wq[2], wq[3]}; *(LAS u32x4*)(dq + 16) = (u32x4){wq[4], wq[5], wq[6], wq[7]};
        *(LAS u32x4*)dk = (u32x4){wk[0], wk[1], wk[2], wk[3]}; *(LAS u32x4*)(dk + 16) = (u32x4){wk[4], wk[5], wk[6], wk[7]};
        *(LAS u32x4*)ds = (u32x4){ws_[0], ws_[1], ws_[2], ws_[3]}; *(LAS u32x4*)(ds + 16) = (u32x4){ws_[4], ws_[5], ws_[6], ws_[7]};
    } else {
        float sx[16]; sx[15] = 1.f;
#pragma unroll
        for (int i = 14; i >= 0; --i) sx[i] = sx[i + 1] * f[i + 1];
        segtot[seg * 128 + k] = sx[0] * f[0];
        __syncthreads();
        const float T0 = segtot[k], T1 = segtot[128 + k], T2 = segtot[256 + k], T3 = segtot[384 + k];
        const float later = seg == 0 ? T1 * T2 * T3 : (seg == 1 ? T2 * T3 : (seg == 2 ? T3 : 1.f));
        if (seg == 0) ((LAS float*)(lds + GL_DV))[k] = T0 * T1 * T2 * T3;
        unsigned ws_[8];
#pragma unroll
        for (int i = 0; i < 16; i += 2) ws_[i >> 1] = pk2((1.f - f[i]) * sx[i] * later, (1.f - f[i + 1]) * sx[i + 1] * later);
        LAS unsigned char* ds = lds + GL_KS + k * KS_STR + seg * 32;
        *(LAS u32x4*)ds = (u32x4){ws_[0], ws_[1], ws_[2], ws_[3]}; *(LAS u32x4*)(ds + 16) = (u32x4){ws_[4], ws_[5], ws_[6], ws_[7]};
    }
    __syncthreads();
}
__device__ __forceinline__ void gla_state_update(f32x4 (&S)[8], const bf16x8 (&Vf)[2], const LAS unsigned char* lds, int i16, int g) {
#pragma unroll
    for (int j = 0; j < 8; ++j) { const f32x4 dv = *(const LAS f32x4*)(lds + GL_DV + (16 * j + 4 * g) * 4); S[j] = S[j] * dv;
#pragma unroll
        for (int c2 = 0; c2 < 2; ++c2) { const bf16x8 a = lds_pair64(lds + GL_KS + (16 * j + i16) * KS_STR + (32 * c2 + 4 * g) * 2, 32);
            S[j] = __builtin_amdgcn_mfma_f32_16x16x32_bf16(a, Vf[c2], S[j], 0, 0, 0); }
        if (j & 1) asm volatile("" ::: "memory"); }
}
__device__ __forceinline__ void gla_load_vf(bf16x8 (&Vf)[2], const LAS unsigned char* lds, int w, int i16, int g) {
    const int q4 = i16 >> 2, pp = i16 & 3;
#pragma unroll
    for (int c2 = 0; c2 < 2; ++c2) { const LAS unsigned char* vb = lds + GL_V + (32 * c2 + 4 * g + q4) * V_STR + (16 * w + 4 * pp) * 2; Vf[c2] = cat8(lds_tr(vb), lds_tr(vb + 16 * V_STR)); }
}

__device__ __forceinline__ void ph_gla_states(const Params& p, unsigned char* lds_, int bid, int nblk) {
    int tid_ = threadIdx.x; asm volatile("" : "+v"(tid_));
    const int tid = tid_, lane = tid & 63, w = __builtin_amdgcn_readfirstlane(tid >> 6), i16 = lane & 15, g = lane >> 4;
    LAS unsigned char* lds = (LAS unsigned char*)lds_;
    const bf16_t* V = (const bf16_t*)(p.ws + WS_V);
    float* U = (float*)(p.ws + WS_U); float* DD = (float*)(p.ws + WS_DD);
    for (int ui = bid; ui < 544; ui += nblk) {
        int b, h, dir, nch, rb0, uidx;
        if (ui < 512) { b = ui >> 8; h = (ui >> 5) & 7; dir = (ui >> 4) & 1; const int sc = ui & 15; nch = 8; rb0 = b * SEQ + sc * 512; uidx = ((b * 8 + h) * 2 + dir) * 17 + sc; }
        else { const int r = ui - 512; b = r >> 4; h = (r >> 1) & 7; dir = r & 1; nch = 4; rb0 = NTOK + b * CTXL; uidx = ((b * 8 + h) * 2 + dir) * 17 + 16; }
        const float* F = (const float*)(p.ws + (dir ? WS_LBK : WS_LF));
        f32x4 S[8];
#pragma unroll
        for (int j = 0; j < 8; ++j) S[j] = (f32x4){0.f, 0.f, 0.f, 0.f};
        float dtot = 1.f;
        GlaRegs R;
        gla_load<false>(R, F, nullptr, V, rb0 + 64 * (dir ? nch - 1 : 0), h, tid);
        for (int step = 0; step < nch; ++step) {
            gla_put_raw<false>(R, lds, dir, tid);
            __syncthreads();
            if (step + 1 < nch) gla_load<false>(R, F, nullptr, V, rb0 + 64 * (dir ? nch - 2 - step : step + 1), h, tid);
            gla_phase_a<false>(lds, tid);
            if (tid < 128) dtot *= ((const LAS float*)(lds + GL_DV))[tid];
            bf16x8 Vf[2]; gla_load_vf(Vf, lds, w, i16, g);
            gla_state_update(S, Vf, lds, i16, g);
            __syncthreads();
        }
        float* up = U + (size_t)uidx * 16384 + (size_t)(w * 8) * 256 + lane * 4;
#pragma unroll
        for (int j = 0; j < 8; ++j) *(f32x4*)(up + j * 256) = S[j];
        if (tid < 128) DD[(size_t)uidx * 128 + tid] = dtot;
    }
}

__device__ __forceinline__ void ph_gla_out(const Params& p, unsigned char* lds_, int bid, int nblk) {
    int tid_ = threadIdx.x; asm volatile("" : "+v"(tid_));
    const int tid = tid_, lane = tid & 63, w = __builtin_amdgcn_readfirstlane(tid >> 6), i16 = lane & 15, g = lane >> 4, q4 = i16 >> 2, pp = i16 & 3;
    LAS unsigned char* lds = (LAS unsigned char*)lds_;
    const bf16_t* Q = (const bf16_t*)(p.ws + WS_Q); const bf16_t* V = (const bf16_t*)(p.ws + WS_V); const bf16_t* G = (const bf16_t*)(p.ws + WS_G);
    const float* U = (const float*)(p.ws + WS_U); const float* DD = (const float*)(p.ws + WS_DD);
    float* OFL = (float*)(p.ws + WS_OF); bf16_t* ON = (bf16_t*)(p.ws + WS_ON);
    const float ngv = p.in[I_HGNORM][16 * w + i16];
    const int troff = (4 * g + q4) * KT_STR + (4 * pp) * 2;
    for (int unit = bid; unit < 256; unit += nblk) {
        const int b = unit >> 7, h = (unit >> 4) & 7, sc = unit & 15, rbs = b * SEQ + sc * 512;
        const unsigned loff = (unsigned)((3 - g) * 4 * DM + i16);
#pragma unroll 1
        for (int dir = 0; dir < 2; ++dir) {
            const float* F = (const float*)(p.ws + (dir ? WS_LBK : WS_LF));
            GlaRegs R;
            gla_load<true>(R, F, Q, V, rbs + 64 * (dir ? 7 : 0), h, tid);
            int on_rb = -1;
#define GLA_ON_FLUSH() do { _Pragma("unroll") for (int i_ = 0; i_ < 2; ++i_) { const int id_ = tid + 512 * i_, row_ = id_ >> 4, c8_ = (id_ & 15) * 8; \
                *(u32x4*)(ON + (size_t)(on_rb + row_) * DM + h * 128 + c8_) = *(const LAS u32x4*)(lds + GL_QT + row_ * ON_STR + c8_ * 2); } } while (0)
            const int ub = ((b * 8 + h) * 2 + dir) * 17;
            f32x4 S[8];
            { const float* up = U + (size_t)(ub + 16) * 16384 + (size_t)(w * 8) * 256 + lane * 4;
#pragma unroll
                for (int j = 0; j < 8; ++j) S[j] = *(const f32x4*)(up + j * 256); }
            { const int nf = dir ? 15 - sc : sc;
                LAS float* dl = (LAS float*)(lds + GL_QT);
                for (int i = tid; i < 16 * 128; i += NTHR) dl[i] = DD[(size_t)ub * 128 + i];
                __syncthreads();
                f32x4 Ua[8];
#define FOLD_LOAD(UU, s_) do { const int u_ = dir ? 15 - (s_) : (s_); const float* up_ = U + (size_t)(ub + u_) * 16384 + (size_t)(w * 8) * 256 + lane * 4; \
                    _Pragma("unroll") for (int j = 0; j < 8; ++j) UU[j] = *(const f32x4*)(up_ + j * 256); } while (0)
                if (nf > 0) FOLD_LOAD(Ua, 0);
                for (int s = 0; s < nf; ++s) { const int u = dir ? 15 - s : s;
#pragma unroll
                    for (int j = 0; j < 8; ++j) S[j] = S[j] * *(const LAS f32x4*)(dl + u * 128 + 16 * j + 4 * g) + Ua[j];
                    if (s + 1 < nf) FOLD_LOAD(Ua, s + 1); }
#undef FOLD_LOAD
                __syncthreads();
            }
            for (int step = 0; step < 8; ++step) {
                const int n = dir ? 7 - step : step, rb = rbs + 64 * n;
                gla_put_raw<true>(R, lds, dir, tid);
                __syncthreads();
                if (on_rb >= 0) { GLA_ON_FLUSH(); on_rb = -1; }
                if (step < 7) gla_load<true>(R, F, Q, V, rbs + 64 * (dir ? 6 - step : step + 1), h, tid);
                gla_phase_a<true>(lds, tid);
                f32x4 O[4];
                if (dir) { const float* ob = OFL + ((size_t)((unit * 8 + n) * 8 + w) * 4) * 256 + ((3 - g) * 16 + i16) * 4;
#pragma unroll
                    for (int ti = 0; ti < 4; ++ti) { const f32x4 t4 = *(const f32x4*)(ob + (3 - ti) * 256); O[ti] = (f32x4){t4[3], t4[2], t4[1], t4[0]}; } }
                else {
#pragma unroll
                    for (int ti = 0; ti < 4; ++ti) O[ti] = (f32x4){0.f, 0.f, 0.f, 0.f}; }
                { const int si = w >> 1, tb = 2 * (w & 1);
                    f32x4 pa[2] = {(f32x4){0.f, 0.f, 0.f, 0.f}, (f32x4){0.f, 0.f, 0.f, 0.f}};
#pragma unroll
                    for (int c = 0; c < 4; ++c) { const LAS unsigned char* ka = lds + GL_KT + troff + (32 * c) * KT_STR + (16 * si) * 2; const bf16x8 a = cat8(lds_tr(ka), lds_tr(ka + 16 * KT_STR));
#pragma unroll
                        for (int tt = 0; tt < 2; ++tt) { const LAS unsigned char* qa = lds + GL_QT + troff + (32 * c) * KT_STR + (16 * (tb + tt)) * 2; const bf16x8 bq = cat8(lds_tr(qa), lds_tr(qa + 16 * KT_STR));
                            pa[tt] = __builtin_amdgcn_mfma_f32_16x16x32_bf16(a, bq, pa[tt], 0, 0, 0); } }
#pragma unroll
                    for (int tt = 0; tt < 2; ++tt) { const int t = 16 * (tb + tt) + i16, s0 = 16 * si + 4 * g; f32x4 v = pa[tt];
#pragma unroll
                        for (int r = 0; r < 4; ++r) v[r] = (s0 + r <= t) ? v[r] : 0.f;
                        u32x2 wv; wv.x = pk2(v[0], v[1]); wv.y = pk2(v[2], v[3]); *(LAS u32x2*)(lds + GL_PL + t * KS_STR + s0 * 2) = wv; } }
                __syncthreads();
                {
#pragma unroll
                    for (int c = 0; c < 4; ++c) { const f32x4 e0 = *(const LAS f32x4*)(lds + GL_EM + (32 * c + 4 * g) * 4), e1 = *(const LAS f32x4*)(lds + GL_EM + (32 * c + 16 + 4 * g) * 4);
                        const f32x4 a0 = S[2 * c] * e0, b0 = S[2 * c + 1] * e1; u32x4 r; r.x = pk2(a0[0], a0[1]); r.y = pk2(a0[2], a0[3]); r.z = pk2(b0[0], b0[1]); r.w = pk2(b0[2], b0[3]); const bf16x8 Sb = __builtin_bit_cast(bf16x8, r);
#pragma unroll
                        for (int ti = 0; ti < 4; ++ti) { const LAS unsigned char* qa = lds + GL_QT + troff + (32 * c) * KT_STR + (16 * ti) * 2; const bf16x8 a = cat8(lds_tr(qa), lds_tr(qa + 16 * KT_STR));
                            O[ti] = __builtin_amdgcn_mfma_f32_16x16x32_bf16(a, Sb, O[ti], 0, 0, 0); }
                        asm volatile("" ::: "memory"); } }
                bf16x8 Vf[2]; gla_load_vf(Vf, lds, w, i16, g);
#pragma unroll
                for (int ti = 0; ti < 4; ++ti) {
#pragma unroll
                    for (int c2 = 0; c2 < 2; ++c2) { const bf16x8 a = lds_pair64(lds + GL_PL + (16 * ti + i16) * KS_STR + (32 * c2 + 4 * g) * 2, 32);
                        O[ti] = __builtin_amdgcn_mfma_f32_16x16x32_bf16(a, Vf[c2], O[ti], 0, 0, 0); }
                    if (ti & 1) asm volatile("" ::: "memory"); }
                gla_state_update(S, Vf, lds, i16, g);
                if (dir == 0) {
                    float* ob = OFL + ((size_t)((unit * 8 + n) * 8 + w) * 4) * 256 + lane * 4;
#pragma unroll
                    for (int ti = 0; ti < 4; ++ti) *(f32x4*)(ob + ti * 256) = O[ti];
                    __syncthreads();
                } else {
                    float part[4][4];
#pragma unroll
                    for (int ti = 0; ti < 4; ++ti)
#pragma unroll
                        for (int r = 0; r < 4; ++r) { const float o = O[ti][r]; part[ti][r] = row16_sum(o * o); }
                    unsigned short gq[4][4];
#pragma unroll
                    for (int ti = 0; ti < 4; ++ti)
#pragma unroll
                        for (int r = 0; r < 4; ++r) { const bf16_t* gb = G + (size_t)(rb + 51 - 16 * ti - r) * DM + h * 128 + 16 * w; gq[ti][r] = gb[loff]; }
                    if (i16 == 0) {
#pragma unroll
                        for (int ti = 0; ti < 4; ++ti) *(LAS f32x4*)(lds + GL_SSQ + (w * 64 + 16 * ti + 4 * g) * 4) = (f32x4){part[ti][0], part[ti][1], part[ti][2], part[ti][3]}; }
                    __syncthreads();
                    if (tid < 64) { float s2 = 0.f;
#pragma unroll
                        for (int ww = 0; ww < 8; ++ww) s2 += ((const LAS float*)(lds + GL_SSQ))[ww * 64 + tid];
                        ((LAS float*)(lds + GL_RSTD))[tid] = 1.f / sqrtf(s2 * (1.f / 128.f) + 1e-6f); }
                    __syncthreads();
#pragma unroll
                    for (int ti = 0; ti < 4; ++ti) { const f32x4 rs = *(const LAS f32x4*)(lds + GL_RSTD + (16 * ti + 4 * g) * 4);
#pragma unroll
                        for (int r = 0; r < 4; ++r) *(LAS unsigned short*)(lds + GL_QT + (63 - (16 * ti + 4 * g + r)) * ON_STR + (16 * w + i16) * 2) = (unsigned short)f2bf(O[ti][r] * rs[r] * ngv * bf2f(gq[ti][r])); }
                    on_rb = rb;
                }
            }
            if (on_rb >= 0) { __syncthreads(); GLA_ON_FLUSH(); on_rb = -1; }
            asm volatile("s_waitcnt vmcnt(0)" ::: "memory");
            __syncthreads();
        }
    }
}

__device__ __forceinline__ void ph_modffn(const Params& p, unsigned char* lds, int bid, int nblk, int l) {
    int tid_ = threadIdx.x; asm volatile("" : "+v"(tid_));
    const int tid = tid_, lane = tid & 63, wave = tid >> 6;
    float* rw = (float*)lds;
    float* stg = (float*)(lds + 71680);
    const float* router = p.in[I_ROUTER] + (size_t)l * DM * NE;
    for (int i = tid; i < DM * NE / 4; i += NTHR) { const int d = i >> 2; *(f32x4*)(rw + d * 16 + (d >> 2) * 4 + (i & 3) * 4) = ((const f32x4*)router)[i]; }
    __syncthreads();
    const float* X = (const float*)(p.ws + WS_X); bf16_t* H = (bf16_t*)(p.ws + WS_H); float* aff = (float*)(p.ws + WS_AFF); int* slot = (int*)(p.ws + WS_SLOT);
    const float* g = p.in[I_NFFN] + (size_t)l * DM; const float* mod = (const float*)(p.ws + WS_MOD);
    for (int base = bid * 64; base < NTOK; base += nblk * 64) {
        const int b = base >> 13, t0 = base & (SEQ - 1);
        const float* mv = mod + (size_t)(l * 3 + b) * NADA; const float* sh = mv + 3 * DM; const float* sc = mv + 4 * DM;
        f32x4 nxv[4];
#pragma unroll
        for (int j = 0; j < 4; ++j) nxv[j] = *(const f32x4*)(X + (size_t)(base + 8 * wave) * DM + 256 * j + 4 * lane);
#pragma unroll 1
        for (int r = 0; r < 8; ++r) {
            const int row = base + 8 * wave + r;
            f32x4 v[4]; float ss = 0.f;
#pragma unroll
            for (int j = 0; j < 4; ++j) { v[j] = nxv[j]; ss += (v[j][0] * v[j][0] + v[j][1] * v[j][1]) + (v[j][2] * v[j][2] + v[j][3] * v[j][3]); }
            if (r < 7) {
#pragma unroll
                for (int j = 0; j < 4; ++j) nxv[j] = *(const f32x4*)(X + (size_t)(row + 1) * DM + 256 * j + 4 * lane); }
            const float rstd = 1.f / sqrtf(wave_sum(ss) * (1.f / DM) + 1e-6f);
            float lg[16];
#pragma unroll
            for (int e = 0; e < 16; ++e) lg[e] = 0.f;
#pragma unroll
            for (int j = 0; j < 4; ++j) { const int c0 = 256 * j + 4 * lane; const f32x4 gv = *(const f32x4*)(g + c0), shv = *(const f32x4*)(sh + c0), scv = *(const f32x4*)(sc + c0);
                f32x4 h;
#pragma unroll
                for (int i = 0; i < 4; ++i) { h[i] = (v[j][i] * rstd * gv[i]) * (1.f + scv[i]) + shv[i];
                    const float* rp = rw + (c0 + i) * 16 + (c0 >> 2) * 4; const f32x4 r0 = *(const f32x4*)(rp), r1 = *(const f32x4*)(rp + 4), r2 = *(const f32x4*)(rp + 8), r3 = *(const f32x4*)(rp + 12);
#pragma unroll
                    for (int e = 0; e < 4; ++e) { lg[e] += h[i] * r0[e]; lg[4 + e] += h[i] * r1[e]; lg[8 + e] += h[i] * r2[e]; lg[12 + e] += h[i] * r3[e]; }
                    asm volatile("" ::: "memory"); }
                u32x2 w; w.x = pk2(h[0], h[1]); w.y = pk2(h[2], h[3]); *(u32x2*)(H + (size_t)row * DM + c0) = w; }
            float a8[8], a4[4], a2[2], a1;
#pragma unroll
            for (int i = 0; i < 8; ++i) a8[i] = swap32_add(lg[i], lg[8 + i]);
#pragma unroll
            for (int i = 0; i < 4; ++i) a4[i] = swap16_add(a8[i], a8[4 + i]);
            { const bool hi = (lane & 8) != 0;
#pragma unroll
                for (int i = 0; i < 2; ++i) { const float send = hi ? a4[i] : a4[2 + i], keep = hi ? a4[2 + i] : a4[i]; a2[i] = keep + lane_xor8(send); } }
            { const bool hi = (lane & 4) != 0; const float send = hi ? a2[0] : a2[1], keep = hi ? a2[1] : a2[0]; a1 = keep + lane_xor4(send); }
            a1 += dpp_f<0x4E>(a1); a1 += dpp_f<0xB1>(a1);
            float mx = a1;
            mx = fmaxf(mx, lane_xor4(mx)); mx = fmaxf(mx, lane_xor8(mx)); mx = swap16_max(mx); mx = swap32_max(mx);
            const float ex = expf(a1 - mx); float den = ex;
            den += lane_xor4(den); den += lane_xor8(den); den = swap16_add(den, den); den = swap32_add(den, den);
            if ((lane & 3) == 0) stg[((lane >> 2) & 15) * 64 + 8 * wave + r] = ex / den;
        }
        __syncthreads();
        { const int e = tid >> 5, tt = (tid & 31) * 2; *(f32x2*)(aff + (size_t)(b * NE + e) * SEQ + t0 + tt) = *(const f32x2*)(stg + e * 64 + tt);
            *(u32x2*)(slot + (size_t)base * NE + 2 * tid) = (u32x2){0xffffffffu, 0xffffffffu}; }
        __syncthreads();
    }
}

__device__ __forceinline__ void ph_topk(const Params& p, unsigned char* lds, int bid, int nblk) {
    int tid_ = threadIdx.x; asm volatile("" : "+v"(tid_)); const int tid = tid_, lane = tid & 63, wave = tid >> 6;
    unsigned* hist = (unsigned*)lds;
    unsigned* ctl = hist + 256;
    unsigned* wsum = ctl + 8;
    const float* aff = (const float*)(p.ws + WS_AFF); int* topi = (int*)(p.ws + WS_TOPI); float* topg = (float*)(p.ws + WS_TOPG); int* slot = (int*)(p.ws + WS_SLOT);
    for (int it = bid; it < NB * NE; it += nblk) {
        const int b = it >> 4, e = it & 15; const float* src = aff + (size_t)it * SEQ + 16 * tid;
        unsigned key[16];
#pragma unroll
        for (int j = 0; j < 4; ++j) { const f32x4 v = *(const f32x4*)(src + 4 * j); key[4 * j] = __float_as_uint(v[0]); key[4 * j + 1] = __float_as_uint(v[1]); key[4 * j + 2] = __float_as_uint(v[2]); key[4 * j + 3] = __float_as_uint(v[3]); }
        unsigned prefix = 0u;
#pragma unroll 1
        for (int bit = 30; bit >= 0; --bit) {
            const unsigned cand = prefix | (1u << bit);
            unsigned cnt = 0u;
#pragma unroll
            for (int i = 0; i < 16; ++i) cnt += (unsigned)__popcll(__ballot(key[i] >= cand));
            if (lane == 0) wsum[(bit & 1) * 8 + wave] = cnt;
            __syncthreads();
            unsigned tot = 0u;
#pragma unroll
            for (int w2 = 0; w2 < 8; ++w2) tot += wsum[(bit & 1) * 8 + w2];
            if (tot >= (unsigned)CAP) prefix = cand;
        }
        __syncthreads();
        unsigned cg = 0u, ce = 0u;
#pragma unroll
        for (int i = 0; i < 16; ++i) { cg += key[i] > prefix ? 1u : 0u; ce += key[i] == prefix ? 1u : 0u; }
        unsigned pk = cg | (ce << 16), inc = pk;
#pragma unroll
        for (int o = 1; o < 64; o <<= 1) { const unsigned t = __shfl_up(inc, o); if (lane >= o) inc += t; }
        if (lane == 63) wsum[wave] = inc;
        __syncthreads();
        unsigned base = 0u, total = 0u;
#pragma unroll
        for (int w2 = 0; w2 < 8; ++w2) { const unsigned t = wsum[w2]; if (w2 < wave) base += t; total += t; }
        const unsigned excl = base + inc - pk;
        unsigned rg = excl & 0xffffu, re = excl >> 16; const unsigned ngt = total & 0xffffu, kth = (unsigned)CAP - ngt;
#pragma unroll
        for (int i = 0; i < 16; ++i) { int s = -1;
            if (key[i] > prefix) { s = (int)rg; ++rg; }
            else if (key[i] == prefix) { if (re < kth) s = (int)(ngt + re); ++re; }
            if (s >= 0) { const int idx = 16 * tid + i, r = (e * NB + b) * CAP + s; topi[r] = b * SEQ + idx; topg[r] = __uint_as_float(key[i]); slot[(size_t)(b * SEQ + idx) * NE + e] = s; } }
        __syncthreads();
    }
}

__device__ __forceinline__ void ph_combine(const Params& p, int bid, int nblk, int l, bool final_) {
    int tid_ = threadIdx.x; asm volatile("" : "+v"(tid_));
    const int tid = tid_, lane = tid & 63, wave = tid >> 6, gw = bid * 8 + wave, NGW = nblk * 8;
    float* X = (float*)(p.ws + WS_X); bf16_t* H = (bf16_t*)(p.ws + WS_H); const bf16_t* Y = (const bf16_t*)(p.ws + WS_Y); const int* slot = (const int*)(p.ws + WS_SLOT);
    const float* mod = (const float*)(p.ws + WS_MOD);
    int nslot = -1; f32x4 nxv[4];
    if (gw < NTOK) { nslot = lane < 16 ? slot[(size_t)gw * NE + lane] : -1;
#pragma unroll
        for (int j = 0; j < 4; ++j) nxv[j] = *(const f32x4*)(X + (size_t)gw * DM + 256 * j + 4 * lane); }
    for (int row = gw; row < NTOK; row += NGW) {
        const int b = row >> 13;
        const float* g2 = mod + (size_t)(l * 3 + b) * NADA + 5 * DM;
        const int myslot = nslot; f32x4 xv[4];
#pragma unroll
        for (int j = 0; j < 4; ++j) xv[j] = nxv[j];
        unsigned long long m = __ballot(myslot >= 0) & 0xffffull;
        f32x4 a[4];
#pragma unroll
        for (int j = 0; j < 4; ++j) a[j] = (f32x4){0.f, 0.f, 0.f, 0.f};
        u32x2 ya[4], yb[4];
#define YLOAD(dst, e_) do { const int s_ = __shfl(myslot, (e_)); const bf16_t* yr_ = Y + (size_t)(((e_) * NB + b) * CAP + s_) * DM; \
            _Pragma("unroll") for (int j = 0; j < 4; ++j) dst[j] = *(const u32x2*)(yr_ + 256 * j + 4 * lane); } while (0)
        if (m) { const int e0 = __builtin_ctzll(m); m &= m - 1; YLOAD(ya, e0); }
        const bool any = __ballot(myslot >= 0) & 0xffffull;
        { const int r2 = row + NGW; if (r2 < NTOK) { nslot = lane < 16 ? slot[(size_t)r2 * NE + lane] : -1;
#pragma unroll
            for (int j = 0; j < 4; ++j) nxv[j] = *(const f32x4*)(X + (size_t)r2 * DM + 256 * j + 4 * lane); } }
        if (any) for (;;) {
            const bool more = m != 0ull;
            if (more) { const int e1 = __builtin_ctzll(m); m &= m - 1; YLOAD(yb, e1); }
#pragma unroll
            for (int j = 0; j < 4; ++j) { a[j][0] += __uint_as_float(ya[j].x << 16); a[j][1] += __uint_as_float(ya[j].x & 0xffff0000u); a[j][2] += __uint_as_float(ya[j].y << 16); a[j][3] += __uint_as_float(ya[j].y & 0xffff0000u); }
            if (!more) break;
#pragma unroll
            for (int j = 0; j < 4; ++j) ya[j] = yb[j];
        }
#undef YLOAD
        f32x4 v[4]; float ss = 0.f;
#pragma unroll
        for (int j = 0; j < 4; ++j) { const int c0 = 256 * j + 4 * lane; v[j] = xv[j] + *(const f32x4*)(g2 + c0) * a[j];
            ss += (v[j][0] * v[j][0] + v[j][1] * v[j][1]) + (v[j][2] * v[j][2] + v[j][3] * v[j][3]); }
        const float rstd = 1.f / sqrtf(wave_sum(ss) * (1.f / DM) + 1e-6f);
        if (final_) { const float* gf = p.in[I_NFIN];
#pragma unroll
            for (int j = 0; j < 4; ++j) { const int c0 = 256 * j + 4 * lane; const f32x4 gv = *(const f32x4*)(gf + c0); *(f32x4*)(p.out + (size_t)row * DM + c0) = v[j] * rstd * gv; }
        } else {
#pragma unroll
            for (int j = 0; j < 4; ++j) *(f32x4*)(X + (size_t)row * DM + 256 * j + 4 * lane) = v[j];
            const float* mv = mod + (size_t)((l + 1) * 3 + b) * NADA;
            store_mod_bf16(H + (size_t)row * DM, v, rstd, p.in[I_NMIX] + (size_t)(l + 1) * DM, mv, mv + DM, lane);
        }
    }
}

__device__ __forceinline__ void ph_conv(const Params& p, int bid, int nblk) {
    int tid_ = threadIdx.x; asm volatile("" : "+v"(tid_));
    const int tid = tid_, lane = tid & 63, wave = tid >> 6, gw = bid * 8 + wave, NGW = nblk * 8;
    const bf16_t* BG = (const bf16_t*)(p.ws + WS_BG); const bf16_t* CU = (const bf16_t*)(p.ws + WS_CU); bf16_t* Z = (bf16_t*)(p.ws + WS_Z);
    const float* wc = p.in[I_SCCONV];
    for (int row = gw; row < NTOK; row += NGW) { const int t = row & (SEQ - 1);
#pragma unroll
        for (int hh = 0; hh < 2; ++hh) { const int c0 = hh * 512 + 8 * lane; const size_t off = (size_t)row * DM + c0;
            const u16x8 z0 = {0, 0, 0, 0, 0, 0, 0, 0};
            const u16x8 um = t > 0 ? *(const u16x8*)(CU + off - DM) : z0, u0 = *(const u16x8*)(CU + off), up = t < SEQ - 1 ? *(const u16x8*)(CU + off + DM) : z0, bg = *(const u16x8*)(BG + off);
            float o[8];
#pragma unroll
            for (int i = 0; i < 8; ++i) o[i] = bf2f(bg[i]) * (wc[c0 + i] * bf2f(um[i]) + wc[DM + c0 + i] * bf2f(u0[i]) + wc[2 * DM + c0 + i] * bf2f(up[i]));
            u32x4 w; w.x = pk2(o[0], o[1]); w.y = pk2(o[2], o[3]); w.z = pk2(o[4], o[5]); w.w = pk2(o[6], o[7]); *(u32x4*)(Z + off) = w; }
    }
}

#define XB_TMO      128
#define XB_XCNT(j)  (256  + 64 * (j))
#define XB_XSUB(j)  (1280 + 64 * (j))
#define XB_XGEN(j)  (2304 + 64 * (j))
#define XB_TOP      3328
#define XB_TOPGEN   3392
#define XCD_BAR_WORDS 3456
#define XB_SPIN_CAP (1u << 18)
__device__ __forceinline__ unsigned xb_ld(unsigned* p)              { return __hip_atomic_load(p, __ATOMIC_RELAXED, __HIP_MEMORY_SCOPE_AGENT); }
__device__ __forceinline__ unsigned xb_add(unsigned* p, unsigned v) { return __hip_atomic_fetch_add(p, v, __ATOMIC_RELAXED, __HIP_MEMORY_SCOPE_AGENT); }
__device__ __forceinline__ unsigned xb_xcc_id() { return (unsigned)__builtin_amdgcn_s_getreg((3 << 11) | 20) & 0xFu; }
#define XB_SPIN(cond, bar) do { unsigned _sp = 0; while (cond) { __builtin_amdgcn_s_sleep(1); \
    if ((++_sp & 255u) == 0u) { if (xb_ld(&(bar)[XB_TMO])) break; if (_sp > XB_SPIN_CAP) { atomicAdd(&(bar)[XB_TMO], 1u); break; } } } } while (0)
struct XcdBarrier { unsigned* bar; unsigned x; volatile LAS unsigned* st; };
__device__ __forceinline__ XcdBarrier xcd_barrier_post(unsigned* bar, volatile LAS unsigned* st) {
    XcdBarrier b; b.bar = bar; b.x = xb_xcc_id(); b.st = st;
    if (threadIdx.x == 0) (void)xb_add(&bar[XB_XCNT(b.x)], 1u);
    return b;
}
__device__ __forceinline__ void xcd_barrier_complete(unsigned* bar, unsigned x, unsigned& nloc, unsigned& nx) {
    const unsigned G = gridDim.x * gridDim.y * gridDim.z;
    unsigned sum, cnt, mine, sp = 0u;
    for (;;) {
        sum = 0u; cnt = 0u; mine = 0u;
#pragma unroll
        for (unsigned j = 0; j < 16; ++j) { const unsigned c = xb_ld(&bar[XB_XCNT(j)]); sum += c; cnt += (c > 0u) ? 1u : 0u; mine = (j == x) ? c : mine; }
        if (sum == G) break;
        __builtin_amdgcn_s_sleep(1);
        if ((++sp & 255u) == 0u) { if (xb_ld(&bar[XB_TMO])) break; if (sp > XB_SPIN_CAP) { atomicAdd(&bar[XB_TMO], 1u); break; } }
    }
    nloc = mine > 0u ? mine : 1u; nx = cnt > 0u ? cnt : 1u;
}
__device__ __forceinline__ void xcd_barrier(const Params& p, unsigned char* lds, unsigned* bar_, volatile LAS unsigned* MISC, unsigned filler) {
    volatile LAS unsigned* st_ = MISC + 8;
    XcdBarrier b; b.bar = bar_; b.x = xb_xcc_id(); b.st = st_;
    asm volatile("s_waitcnt vmcnt(0)" ::: "memory");
    __syncthreads();
    unsigned target = 0u;
    if (threadIdx.x == 0) {
        unsigned* bar = b.bar;
        __builtin_amdgcn_s_waitcnt(0);
        unsigned nloc = b.st[0], nx = b.st[1];
        if (nloc == 0u) { xcd_barrier_complete(bar, b.x, nloc, nx); b.st[0] = nloc; b.st[1] = nx; }
        const unsigned epoch = b.st[2] + 1u; b.st[2] = epoch;
        const unsigned old = xb_add(&bar[XB_XSUB(b.x)], 1u);
        if (old + 1u == epoch * nloc) {
            __builtin_amdgcn_fence(__ATOMIC_RELEASE, "agent");
            asm volatile("s_waitcnt vmcnt(0)" ::: "memory");
            (void)xb_add(&bar[XB_TOP], 1u);
        }
        target = epoch * nx;
    }
    if (filler) {
        for (;;) {
            if (threadIdx.x == 0) MISC[MW_REL] = (xb_ld(&b.bar[XB_TOP]) >= target || xb_ld(&b.bar[XB_TMO])) ? 1u : 0u;
            __syncthreads();
            const unsigned rel = MISC[MW_REL];
            __syncthreads();
            if (rel) break;
            if (!cvt_batch(p, lds, MISC, filler)) break;
        }
    }
    if (threadIdx.x == 0) {
        XB_SPIN(xb_ld(&b.bar[XB_TOP]) < target, b.bar);
        __builtin_amdgcn_fence(__ATOMIC_ACQUIRE, "agent");
        asm volatile("s_waitcnt vmcnt(0)" ::: "memory");
    }
    __syncthreads();
}

constexpr int NPHASE = 19;
constexpr int CVB_P2 = 2, CVB_P8 = 4;
constexpr int MISC_OFF = 146944;
constexpr int CW_BAR = 4096;
constexpr int CW_CTX = 1024;
template <int LO, int HI> __global__ void __launch_bounds__(NTHR, 2) mega(Params p) {
    extern __shared__ __attribute__((aligned(16))) unsigned char lds[];
    const int bid = blockIdx.x, nblk = gridDim.x;
    PG8_LAS unsigned char* l3 = (PG8_LAS unsigned char*)lds;
    unsigned char* ws = p.ws;
    const float* mod = (const float*)(ws + WS_MOD);
    constexpr bool MULTI = (HI - LO) > 1;
    if (MULTI) {
        volatile LAS unsigned* MISC = (volatile LAS unsigned*)(l3 + MISC_OFF);
        if (threadIdx.x < 32) MISC[threadIdx.x] = 0u;
        __syncthreads();
        (void)xcd_barrier_post((unsigned*)(ws + WS_CTL) + CW_BAR, MISC + 8);
    }
#define IN(k) (LO <= (k) && (k) < HI)
#ifndef PROBE_DUP
#define PROBE_DUP 0u
#endif
#define DUPQ(k) (((PROBE_DUP) >> (k)) & 1u)
#define MISCP ((volatile LAS unsigned*)(l3 + MISC_OFF))
#define BARRIER_MASK(m) xcd_barrier(p, lds, (unsigned*)(p.ws + WS_CTL) + CW_BAR, MISCP, (m))
#define BARRIER_NOW() BARRIER_MASK(0u)
#define SEAM(k) do { if (IN(k) && IN((k) + 1)) BARRIER_MASK(((k) <= 7 ? 1u : 0u) | ((k) <= 15 ? 2u : 0u)); } while (0)
#define PHASE(k, ...) do { if (IN(k)) { __VA_ARGS__; if (DUPQ(k)) { BARRIER_NOW(); __VA_ARGS__; } } SEAM(k); } while (0)
#define GEMM_INPROJ() do { pg8::Gemm g{(const bf16_t*)(ws + WS_H), (const bf16_t*)(ws + WS_WHGIN), NTOK, 5120, DM}; pg8::StaticOrder S; S.init(NTOK, 5120, nblk, bid, 0); EpiInProj E{ws}; pg8::gemm_phase<EpiInProj, pg8::StaticOrder, false>(l3, g, S, E, nullptr); } while (0)
#define GEMM_OUT(AOFF, WOFF, GATE) do { pg8::Gemm g{(const bf16_t*)(ws + (AOFF)), (const bf16_t*)(ws + (WOFF)), NTOK, DM, DM}; pg8::StaticOrder S; S.init(NTOK, DM, nblk, bid, 0); EpiResid E{(float*)(ws + WS_X), (GATE)}; pg8::gemm_phase<EpiResid, pg8::StaticOrder, false>(l3, g, S, E, nullptr); } while (0)
#define GEMM_MOE1(l) do { pg8::Gemm g{(const bf16_t*)(ws + WS_H), (const bf16_t*)(ws + WS_WMOE1) + (size_t)(l) * NE * 4096 * DM, NSLOT, 4096, DM}; pg8::StaticOrder S; S.init(NSLOT, 4096, nblk, bid, 8); EpiGLU E{(bf16_t*)(ws + WS_ACT)}; pg8::gemm_phase<EpiGLU, pg8::StaticOrder, true>(l3, g, S, E, (const int*)(ws + WS_TOPI)); } while (0)
#define GEMM_MOE2(l) do { pg8::Gemm g{(const bf16_t*)(ws + WS_ACT), (const bf16_t*)(ws + WS_WMOE2) + (size_t)(l) * NE * DM * DE, NSLOT, DM, DE}; pg8::StaticOrder S; S.init(NSLOT, DM, nblk, bid, 8); EpiRowScale E{(bf16_t*)(ws + WS_Y), (const float*)(ws + WS_TOPG)}; pg8::gemm_phase<EpiRowScale, pg8::StaticOrder, false>(l3, g, S, E, nullptr); } while (0)
#define GEMM_CONVIN() do { pg8::Gemm g{(const bf16_t*)(ws + WS_H), (const bf16_t*)(ws + WS_WSCIN), NTOK, 3072, DM}; pg8::StaticOrder S; S.init(NTOK, 3072, nblk, bid, 0); EpiConvIn E{(bf16_t*)(ws + WS_BG), (bf16_t*)(ws + WS_CU)}; pg8::gemm_phase<EpiConvIn, pg8::StaticOrder, false>(l3, g, S, E, nullptr); } while (0)
#define MOD0_PHASE() do { if (nblk >= 48) { if (bid < 24) { ph_mod0(p, NTOK + (bid * NCTX) / 24, NTOK + ((bid + 1) * NCTX) / 24, 0, 1); \
              \
            asm volatile("s_waitcnt vmcnt(0)" ::: "memory"); __syncthreads(); \
            if (threadIdx.x == 0) { unsigned* cnt = (unsigned*)(p.ws + WS_CTL) + CW_CTX; __builtin_amdgcn_fence(__ATOMIC_RELEASE, "agent"); asm volatile("s_waitcnt vmcnt(0)" ::: "memory"); \
                xb_add(cnt, 1u); unsigned sp_ = 0u; while (xb_ld(cnt) < 24u) { __builtin_amdgcn_s_sleep(1); if (++sp_ > (1u << 22)) break; } \
                __builtin_amdgcn_fence(__ATOMIC_ACQUIRE, "agent"); asm volatile("s_waitcnt vmcnt(0)" ::: "memory"); } \
            __syncthreads(); \
            pg8::Gemm g{(const bf16_t*)(ws + WS_H), (const bf16_t*)(ws + WS_WHGIN), NROW, 5120, DM}; pg8::OneUnit S{64 + bid / 12, 4 + bid % 12}; EpiInProj E{ws}; pg8::gemm_phase<EpiInProj, pg8::OneUnit, false>(l3, g, S, E, nullptr); } \
          else ph_mod0(p, 0, NTOK, bid - 24, nblk - 24); } \
        else { ph_mod0(p, 0, NROW, bid, nblk); } } while (0)
#define CTX_TILES_FALLBACK() do { if (nblk < 48) { BARRIER_NOW(); pg8::Gemm g{(const bf16_t*)(ws + WS_H), (const bf16_t*)(ws + WS_WHGIN), NROW, 5120, DM}; \
        for (int ti = bid; ti < 24; ti += nblk) { pg8::OneUnit S{64 + ti / 12, 4 + ti % 12}; EpiInProj E{ws}; pg8::gemm_phase<EpiInProj, pg8::OneUnit, false>(l3, g, S, E, nullptr); } } } while (0)
    PHASE(0, ph_prep(p, lds, bid, nblk); __syncthreads(); ph_convert_small(p, lds, bid, nblk));
    if (IN(1)) { MOD0_PHASE(); CTX_TILES_FALLBACK(); }
    SEAM(1);
#define HOSTED(GEMM_RANGE, NR, NBATCH) do { const bool odd_ = (bid & 1) != 0; \
        if (odd_) cvt_budget(p, lds, MISCP, 3u, NBATCH); \
        GEMM_RANGE(0, NR); __syncthreads(); \
        if (!odd_) cvt_budget(p, lds, MISCP, 3u, NBATCH); } while (0)
#define GEMM_INPROJ_R(LO_, HI_) do { pg8::Gemm g{(const bf16_t*)(ws + WS_H), (const bf16_t*)(ws + WS_WHGIN), NTOK, 5120, DM}; pg8::RangeOrder S; S.S.init(NTOK, 5120, nblk, bid, 0); S.lo = (LO_); S.hi = (HI_); EpiInProj E{ws}; pg8::gemm_phase<EpiInProj, pg8::RangeOrder, false>(l3, g, S, E, nullptr); } while (0)
#define GEMM_MOE1_R0(LO_, HI_) do { pg8::Gemm g{(const bf16_t*)(ws + WS_H), (const bf16_t*)(ws + WS_WMOE1), NSLOT, 4096, DM}; pg8::RangeOrder S; S.S.init(NSLOT, 4096, nblk, bid, 8); S.lo = (LO_); S.hi = (HI_); EpiGLU E{(bf16_t*)(ws + WS_ACT)}; pg8::gemm_phase<EpiGLU, pg8::RangeOrder, true>(l3, g, S, E, (const int*)(ws + WS_TOPI)); } while (0)
    PHASE(2, HOSTED(GEMM_INPROJ_R, 5, CVB_P2));
    PHASE(3, ph_gla_states(p, lds, bid, nblk));
    PHASE(4, ph_gla_out(p, lds, bid, nblk));
    if (IN(5)) GEMM_OUT(WS_ON, WS_WHGOUT, mod + 2 * DM);
    SEAM(5);
    PHASE(6, ph_modffn(p, lds, bid, nblk, 0));
    PHASE(7, ph_topk(p, lds, bid, nblk); __syncthreads(); cvt_drain_until(p, lds, MISCP, 0, 32768u));
    PHASE(8, HOSTED(GEMM_MOE1_R0, 8, CVB_P8); cvt_drain_until(p, lds, MISCP, 0, (unsigned)CV_ITEMS));
    PHASE(9, GEMM_MOE2(0));
    if (IN(10)) ph_combine(p, bid, nblk, 0, false);
    SEAM(10);
    PHASE(11, GEMM_CONVIN());
    PHASE(12, ph_conv(p, bid, nblk));
    if (IN(13)) GEMM_OUT(WS_Z, WS_WSCOUT, mod + (size_t)3 * NADA + 2 * DM);
    SEAM(13);
    PHASE(14, ph_modffn(p, lds, bid, nblk, 1));
    PHASE(15, ph_topk(p, lds, bid, nblk); __syncthreads(); cvt_drain_until(p, lds, MISCP, 1, 32768u));
    PHASE(16, GEMM_MOE1(1); __syncthreads(); cvt_drain_until(p, lds, MISCP, 1, (unsigned)CV_ITEMS));
    PHASE(17, GEMM_MOE2(1));
    if (IN(18)) ph_combine(p, bid, nblk, 1, true);
#undef IN
#undef SEAM
}

#ifndef MK_SPLIT
#define MK_SPLIT 0
#endif
#if MK_SPLIT
#include <utility>
template <int... I> static void launch_all(std::integer_sequence<int, I...>, int grid, Params& p, hipStream_t stream) {
    ((void)hipFuncSetAttribute((const void*)mega<I, I + 1>, hipFuncAttributeMaxDynamicSharedMemorySize, LDS_BYTES), ...);
    ((mega<I, I + 1><<<dim3(grid), dim3(NTHR), LDS_BYTES, stream>>>(p)), ...); }
#endif
extern "C" void kernel_launch(void* const* d_in, const int* in_sizes, int n_in, void* d_out, int out_size, void* d_ws, size_t ws_size, hipStream_t stream) {
    static int grid = 0;
    if (grid == 0) {
        if (n_in != 20 || ws_size < WS_END) { fprintf(stderr, "kernel_launch: unexpected inputs (n_in %d, ws %zu, need %zu)\n", n_in, ws_size, (size_t)WS_END); grid = -1; return; }
        int dev = 0, cus = 0, per_cu = 0;
        (void)hipGetDevice(&dev); (void)hipDeviceGetAttribute(&cus, hipDeviceAttributeMultiprocessorCount, dev);
        (void)hipFuncSetAttribute((const void*)mega<0, NPHASE>, hipFuncAttributeMaxDynamicSharedMemorySize, LDS_BYTES);
        if (hipOccupancyMaxActiveBlocksPerMultiprocessor(&per_cu, (const void*)mega<0, NPHASE>, NTHR, LDS_BYTES) != hipSuccess || per_cu < 1) { fprintf(stderr, "kernel_launch: occupancy query failed (%d)\n", per_cu); per_cu = 1; }
        (void)hipGetLastError();
        if (per_cu > 1) per_cu = 1;
        grid = (cus > 0 ? cus : 256) * per_cu;
    }
    if (grid < 0) return;
    Params p{};
    for (int i = 0; i < 20; ++i) p.in[i] = (const float*)d_in[i];
    p.out = (float*)d_out; p.ws = (unsigned char*)d_ws;
#if MK_SPLIT
    launch_all(std::make_integer_sequence<int, NPHASE>{}, grid, p, stream);
#else
    (void)hipMemsetAsync((char*)d_ws + WS_CTL, 0, 65536, stream);
    void* args[] = {&p};
    hipError_t e = hipLaunchCooperativeKernel((const void*)mega<0, NPHASE>, dim3(grid), dim3(NTHR), args, LDS_BYTES, stream);
    if (e != hipSuccess) fprintf(stderr, "kernel_launch: cooperative launch failed: %s (grid %d)\n", hipGetErrorString(e), grid);
#endif
}
```

```cpp
#include <hip/hip_runtime.h>
#include <cstdio>
#include <cstdint>

namespace pg8 {
#define PG8_LAS __attribute__((address_space(3)))
typedef unsigned short bf16_t;
typedef short bf16x8 __attribute__((ext_vector_type(8)));
typedef float f32x4 __attribute__((ext_vector_type(4)));
typedef unsigned u32x4 __attribute__((ext_vector_type(4)));
typedef unsigned u32x2 __attribute__((ext_vector_type(2)));
constexpr int BM = 256, BK = 64, HALF = 128, HTB = HALF * BK * 2, STAGE_BYTES = 8 * HTB, NXCD = 8, WGM = 8;

__host__ __device__ __forceinline__ int lds_byte(int r, int c) { const int st = (r >> 4) * 2 + (c >> 5), rr = r & 15, cc = c & 31, ob = rr * 64 + cc * 2; return st * 1024 + (ob ^ (((ob >> 9) & 1) << 5)); }
__host__ __device__ __forceinline__ void stage_rc(int b, int& R, int& C) { const int st = b / 1024, sb = b % 1024, swz = sb ^ (((sb >> 9) & 1) << 5); R = (st >> 1) * 16 + swz / 64; C = (st & 1) * 32 + (swz % 64) / 2; }
__host__ __device__ __forceinline__ int perm32(int rho) { const int n = rho >> 4, i = rho & 15; return 8 * (i >> 2) + 4 * n + (i & 3); }

struct Unit { int pm, pn, pb; };
struct Gemm { const bf16_t* A; const bf16_t* Bt; int M, N, K; };

struct StaticOrder {
    int nM, nN, nwg, G, c, mpe;
    __device__ void init(int M, int N, int G_, int c_, int mpe_) { nM = M / BM; nN = N / BM; nwg = nM * nN; G = G_; c = c_; mpe = mpe_; }
    __device__ bool next(int i, Unit& u) const {
        const long L = (long)i * G + c; if (L >= nwg) return false;
        int wgid = (int)L; { const int q = nwg / NXCD, r = nwg % NXCD, xcd = wgid % NXCD, off = wgid / NXCD; wgid = (xcd < r ? xcd * (q + 1) : r * (q + 1) + (xcd - r) * q) + off; }
        const int nig = WGM * nN, gid = wgid / nig, fm = gid * WGM, gsz = (nM - fm) < WGM ? (nM - fm) : WGM;
        u.pm = fm + ((wgid % nig) % gsz); u.pn = (wgid % nig) / gsz; u.pb = mpe > 0 ? (u.pm / mpe) * nN + u.pn : u.pn; return true;
    }
};

__device__ __forceinline__ unsigned cvt_pk_bf16(float lo, float hi) { unsigned r; asm volatile("v_cvt_pk_bf16_f32 %0, %1, %2" : "=v"(r) : "v"(lo), "v"(hi)); return r; }

struct RangeOrder {
    StaticOrder S; int lo, hi;
    __device__ bool next(int i, Unit& u) const { return (lo + i < hi) ? S.next(lo + i, u) : false; }
};
struct OneUnit {
    int pm, pn;
    __device__ bool next(int i, Unit& u) const { if (i != 0) return false; u.pm = pm; u.pn = pn; u.pb = pn; return true; }
};
template <class Epi, class Sched, bool GATHER>
__device__ __forceinline__ void gemm_phase(PG8_LAS unsigned char* lds, const Gemm g, const Sched& S, const Epi& E, const int* gidx) {
    int tid_ = threadIdx.x; asm volatile("" : "+v"(tid_));
    const int tid = tid_, wid = __builtin_amdgcn_readfirstlane(tid >> 6), lane = tid & 63, wr = wid >> 2, wc = wid & 3, fr = lane & 15, fq = lane >> 4;
    const int K = g.K, nt = K / BK;
    unsigned voffA[2], voffB[2]; int rA[2], cA2[2];
#pragma unroll
    for (int i = 0; i < 2; ++i) { int R, C; stage_rc(tid * 16 + i * 8192, R, C); const int Rb = Epi::PERM ? ((R & ~31) + perm32(R & 31)) : R;
        voffA[i] = (unsigned)(R * K + C) * 2u; voffB[i] = (unsigned)(Rb * K + C) * 2u; rA[i] = R; cA2[i] = C * 2; }
    unsigned gcur[2][2], gnxt[2][2];
#define PG8_GOFF(dst, u) do { _Pragma("unroll") for (int _h = 0; _h < 2; ++_h) _Pragma("unroll") for (int _i = 0; _i < 2; ++_i) \
        dst[_h][_i] = (unsigned)gidx[(u).pm * BM + _h * HALF + rA[_i]] * (unsigned)(K * 2) + (unsigned)cA2[_i]; } while (0)
    const size_t kstep = (size_t)(BK * 2);
    const size_t hstep = (size_t)HALF * K * 2;
    const size_t tstep = 2 * hstep;
    const unsigned ldsw = (unsigned)wid * 1024u;
    const int aoff = lds_byte(wr * 64 + fr, fq * 8), boff = lds_byte(wc * 32 + fr, fq * 8);
#define PG8_SA(b, h) (((b) * 2 + (h)) * HTB)
#define PG8_SB(b, h) ((4 + (b) * 2 + (h)) * HTB)
#define PG8_STAGE(bufoff, gbase, voff) do { _Pragma("unroll") for (int _i = 0; _i < 2; ++_i) \
        __builtin_amdgcn_global_load_lds((const unsigned*)((const char*)(gbase) + (voff)[_i]), (PG8_LAS unsigned*)(lds + (bufoff) + ldsw + _i * 8192), 16, 0, 0); } while (0)
#define PG8_STAGE_A(bufoff, half, kb, NX) do { _Pragma("unroll") for (int _i = 0; _i < 2; ++_i) { \
        const char* _src = GATHER ? (const char*)g.A + (kb) + ((NX) ? gnxt[half][_i] : gcur[half][_i]) : ((NX) ? nA : cA) + (size_t)(half) * hstep + (kb) + voffA[_i]; \
        __builtin_amdgcn_global_load_lds((const unsigned*)_src, (PG8_LAS unsigned*)(lds + (bufoff) + ldsw + _i * 8192), 16, 0, 0); } } while (0)
#define PG8_LDA(dst, b, h) do { _Pragma("unroll") for (int m = 0; m < 4; ++m) _Pragma("unroll") for (int k = 0; k < 2; ++k) dst[m][k] = *(const PG8_LAS bf16x8*)(lds + PG8_SA(b, h) + aoff + m * 2048 + k * 1024); } while (0)
#define PG8_LDB(dst, b, h) do { _Pragma("unroll") for (int n = 0; n < 2; ++n) _Pragma("unroll") for (int k = 0; k < 2; ++k) dst[n][k] = *(const PG8_LAS bf16x8*)(lds + PG8_SB(b, h) + boff + n * 2048 + k * 1024); } while (0)
#define PG8_MMA(ai, bj, At, Bt) do { __builtin_amdgcn_s_setprio(1); _Pragma("unroll") for (int m = 0; m < 4; ++m) _Pragma("unroll") for (int n = 0; n < 2; ++n) _Pragma("unroll") for (int k = 0; k < 2; ++k) \
        acc[ai][bj][m][n] = __builtin_amdgcn_mfma_f32_16x16x32_bf16(Bt[n][k], At[m][k], acc[ai][bj][m][n], 0, 0, 0); __builtin_amdgcn_s_setprio(0); } while (0)
#define PG8_WAIT_V(n) asm volatile("s_waitcnt vmcnt(" #n ")" ::: "memory")
#define PG8_WAIT_L(n) asm volatile("s_waitcnt lgkmcnt(" #n ")" ::: "memory")
#define PG8_BAR __builtin_amdgcn_s_barrier()
#define PG8_SCHED __builtin_amdgcn_sched_barrier(0)
    Unit cur, nxt; int ui = 0;
    if (!S.next(0, cur)) return;
    f32x4 acc[2][2][4][2];
#pragma unroll
    for (int a = 0; a < 2; ++a)
#pragma unroll
        for (int b = 0; b < 2; ++b)
#pragma unroll
            for (int m = 0; m < 4; ++m)
#pragma unroll
                for (int n = 0; n < 2; ++n) acc[a][b][m][n] = (f32x4){0.f, 0.f, 0.f, 0.f};
    bf16x8 At[4][2], B0[2][2], B1[2][2];
    const char* cA = GATHER ? (const char*)g.A : (const char*)g.A + (size_t)cur.pm * tstep; const char* cB = (const char*)g.Bt + (size_t)cur.pb * tstep; const char* nA = cA;
    if (GATHER) { PG8_GOFF(gcur, cur); }
    PG8_STAGE(PG8_SB(0, 0), cB, voffB); PG8_STAGE(PG8_SB(0, 1), cB + hstep, voffB); PG8_STAGE_A(PG8_SA(0, 0), 0, 0, false); PG8_STAGE_A(PG8_SA(0, 1), 1, 0, false);
    if (wr == 1) PG8_BAR;
    PG8_WAIT_V(2); PG8_BAR;
    PG8_STAGE(PG8_SB(1, 0), cB + kstep, voffB); PG8_STAGE_A(PG8_SA(1, 0), 0, kstep, false); PG8_STAGE(PG8_SB(1, 1), cB + hstep + kstep, voffB);
    PG8_WAIT_V(6); PG8_BAR;
    for (;;) {
        const bool has_next = S.next(ui + 1, nxt);
        nA = GATHER ? cA : (has_next ? (const char*)g.A + (size_t)nxt.pm * tstep : cA); const char* nB = has_next ? (const char*)g.Bt + (size_t)nxt.pb * tstep : cB;
        if (GATHER) { if (has_next) { PG8_GOFF(gnxt, nxt); } else {
#pragma unroll
            for (int _h = 0; _h < 2; ++_h)
#pragma unroll
                for (int _i = 0; _i < 2; ++_i) gnxt[_h][_i] = gcur[_h][_i]; } }
        for (int t = 0; t < nt; t += 2) {
            const bool last = (t == nt - 2);
            const size_t k1 = (size_t)(t + 1) * kstep, k2 = last ? 0 : (size_t)(t + 2) * kstep, k3 = k2 + kstep;
            const char* b2 = last ? nB : cB + (size_t)(t + 2) * kstep; const char* b3 = b2 + kstep;
            PG8_LDB(B0, 0, 0); PG8_LDB(B1, 0, 1); PG8_SCHED; PG8_LDA(At, 0, 0); PG8_STAGE_A(PG8_SA(1, 1), 1, k1, false);
            PG8_WAIT_V(8); PG8_WAIT_L(0); PG8_BAR; PG8_MMA(0, 0, At, B0); PG8_MMA(0, 1, At, B1); PG8_BAR; PG8_SCHED;
            PG8_LDA(At, 0, 1); PG8_STAGE(PG8_SB(0, 0), b2, voffB); PG8_STAGE(PG8_SB(0, 1), b2 + hstep, voffB); PG8_STAGE_A(PG8_SA(0, 0), 0, k2, last);
            PG8_WAIT_V(8); PG8_WAIT_L(0); PG8_BAR; PG8_MMA(1, 0, At, B0); PG8_MMA(1, 1, At, B1); PG8_BAR; PG8_SCHED;
            PG8_LDB(B0, 1, 0); PG8_LDB(B1, 1, 1); PG8_SCHED; PG8_LDA(At, 1, 0); PG8_STAGE_A(PG8_SA(0, 1), 1, k2, last);
            PG8_WAIT_V(8); PG8_WAIT_L(0); PG8_BAR; PG8_MMA(0, 0, At, B0); PG8_MMA(0, 1, At, B1); PG8_BAR; PG8_SCHED;
            PG8_LDA(At, 1, 1); PG8_STAGE(PG8_SB(1, 0), b3, voffB); PG8_STAGE(PG8_SB(1, 1), b3 + hstep, voffB); PG8_STAGE_A(PG8_SA(1, 0), 0, k3, last);
            PG8_WAIT_V(8); PG8_WAIT_L(0); PG8_BAR; PG8_MMA(1, 0, At, B0); PG8_MMA(1, 1, At, B1); PG8_BAR; PG8_SCHED;
        }
        if (wr == 0) PG8_BAR;
        E(acc, cur, wr, wc, fr, fq);
        if (!has_next) break;
#pragma unroll
        for (int a = 0; a < 2; ++a)
#pragma unroll
            for (int b = 0; b < 2; ++b)
#pragma unroll
                for (int m = 0; m < 4; ++m)
#pragma unroll
                    for (int n = 0; n < 2; ++n) acc[a][b][m][n] = (f32x4){0.f, 0.f, 0.f, 0.f};
        cur = nxt; cA = nA; cB = nB; ++ui;
        if (GATHER) {
#pragma unroll
            for (int _h = 0; _h < 2; ++_h)
#pragma unroll
                for (int _i = 0; _i < 2; ++_i) gcur[_h][_i] = gnxt[_h][_i]; }
        if (wr == 1) PG8_BAR;
    }
    PG8_WAIT_V(0);
    PG8_BAR;
#undef PG8_SA
#undef PG8_SB
#undef PG8_STAGE
#undef PG8_STAGE_A
#undef PG8_GOFF
#undef PG8_LDA
#undef PG8_LDB
#undef PG8_MMA
#undef PG8_WAIT_V
#undef PG8_WAIT_L
#undef PG8_BAR
#undef PG8_SCHED
}
}

#define LAS __attribute__((address_space(3)))
using pg8::bf16_t; using pg8::f32x4; using pg8::u32x4; using pg8::u32x2;
typedef unsigned short u16x8 __attribute__((ext_vector_type(8)));
typedef float f32x2 __attribute__((ext_vector_type(2)));

constexpr int DM = 1024, NB = 2, SEQ = 8192, NTOK = NB * SEQ, CTXL = 256, NCTX = NB * CTXL, NROW = NTOK + NCTX;
constexpr int NE = 16, CAP = 1024, DE = 2048, NSLOT = NE * NB * CAP;
constexpr int NADA = 6 * DM;
constexpr int NTHR = 512;

constexpr size_t MiB = 1u << 20;
constexpr size_t WS_CTL = 0;
constexpr size_t WS_MOD = 1 * MiB;
constexpr size_t WS_LB = WS_MOD + 256 * 1024;
constexpr size_t WS_POSR = WS_LB + 64 * 1024;
constexpr size_t WS_POSC = WS_POSR + 256 * 1024;
constexpr size_t WS_AFF = 2 * MiB;
constexpr size_t WS_TOPI = 3 * MiB;
constexpr size_t WS_TOPG = WS_TOPI + 128 * 1024;
constexpr size_t WS_SLOT = 4 * MiB;
constexpr size_t WS_WHGIN = 6 * MiB;
constexpr size_t WS_WHGOUT = 16 * MiB;
constexpr size_t WS_WSCIN = 18 * MiB;
constexpr size_t WS_WSCOUT = 24 * MiB;
constexpr size_t WS_WMOE1 = 26 * MiB;
constexpr size_t WS_WMOE2 = WS_WMOE1 + 256 * MiB;
constexpr size_t WS_X = WS_WMOE2 + 128 * MiB;
constexpr size_t WS_H = WS_X + 64 * MiB;
constexpr size_t WS_R = WS_H + 34 * MiB;
constexpr size_t WS_Q = WS_R;
constexpr size_t WS_V = WS_Q + 34 * MiB;
constexpr size_t WS_G = WS_V + 34 * MiB;
constexpr size_t WS_LF = WS_G + 34 * MiB;
constexpr size_t WS_LBK = WS_LF + 66 * MiB;
constexpr size_t WS_OF = WS_LBK + 66 * MiB;
constexpr size_t WS_OB = WS_OF + 64 * MiB;
constexpr size_t WS_U = WS_OB;
constexpr size_t WS_DD = WS_OB + 40 * MiB;
constexpr size_t WS_ON = WS_OB + 64 * MiB;
constexpr size_t WS_HG_END = WS_ON + 32 * MiB;
constexpr size_t WS_XG = WS_R;
constexpr size_t WS_ACT = WS_XG + 64 * MiB;
constexpr size_t WS_Y = WS_ACT + 128 * MiB;
constexpr size_t WS_MOE_END = WS_Y + 128 * MiB;
constexpr size_t WS_BG = WS_R;
constexpr size_t WS_CU = WS_BG + 32 * MiB;
constexpr size_t WS_Z = WS_CU + 32 * MiB;
constexpr size_t WS_END = WS_HG_END > WS_MOE_END ? WS_HG_END : WS_MOE_END;
static_assert(WS_END <= 1024 * MiB, "workspace map exceeds 1 GiB");

constexpr int LDS_BYTES = 147456;

struct Params { const float* in[20]; float* out; unsigned char* ws; int ph_lo, ph_hi; };
enum { I_X = 0, I_C, I_CTX, I_CCTX, I_ADAW, I_ADAB, I_NMIX, I_NFFN, I_NFIN, I_HGWIN, I_HGLB, I_HGNORM, I_HGWOUT, I_SCWIN, I_SCCONV, I_SCWOUT, I_ROUTER, I_WGATE, I_WUP, I_WDOWN };

typedef __bf16 bf16x2_t __attribute__((ext_vector_type(2)));
__device__ __forceinline__ unsigned pk2(float lo, float hi) { const f32x2 v = {lo, hi}; return __builtin_bit_cast(unsigned, __builtin_convertvector(v, bf16x2_t)); }
__device__ __forceinline__ unsigned f2bf(float f) { return pk2(f, 0.f) & 0xffffu; }
__device__ __forceinline__ float bf2f(unsigned short h) { return __builtin_bit_cast(float, (unsigned)h << 16); }
template <int CTRL> __device__ __forceinline__ float dpp_f(float x) { return __builtin_bit_cast(float, __builtin_amdgcn_update_dpp(0, __builtin_bit_cast(int, x), CTRL, 0xf, 0xf, true)); }
__device__ __forceinline__ float row16_sum(float x) {
    x += dpp_f<0xB1>(x);
    x += dpp_f<0x4E>(x);
    x += dpp_f<0x141>(x);
    x += dpp_f<0x140>(x);
    return x;
}
__device__ __forceinline__ float swap16_add(float a, float b) { const auto r = __builtin_amdgcn_permlane16_swap(__float_as_uint(a), __float_as_uint(b), false, false); const unsigned r0 = r[0], r1 = r[1]; return __uint_as_float(r0) + __uint_as_float(r1); }
__device__ __forceinline__ float swap32_add(float a, float b) { const auto r = __builtin_amdgcn_permlane32_swap(__float_as_uint(a), __float_as_uint(b), false, false); const unsigned r0 = r[0], r1 = r[1]; return __uint_as_float(r0) + __uint_as_float(r1); }
__device__ __forceinline__ float swap16_max(float a) { const auto r = __builtin_amdgcn_permlane16_swap(__float_as_uint(a), __float_as_uint(a), false, false); const unsigned r0 = r[0], r1 = r[1]; return fmaxf(__uint_as_float(r0), __uint_as_float(r1)); }
__device__ __forceinline__ float swap32_max(float a) { const auto r = __builtin_amdgcn_permlane32_swap(__float_as_uint(a), __float_as_uint(a), false, false); const unsigned r0 = r[0], r1 = r[1]; return fmaxf(__uint_as_float(r0), __uint_as_float(r1)); }
__device__ __forceinline__ float lane_xor8(float x) { return dpp_f<0x128>(x); }
__device__ __forceinline__ float lane_xor4(float x) { return dpp_f<0x1B>(dpp_f<0x141>(x)); }
__device__ __forceinline__ float wave_sum(float v) { v = row16_sum(v); v = swap16_add(v, v); v = swap32_add(v, v); return v; }
__device__ __forceinline__ float sigmoidf_(float x) { return 1.f / (1.f + expf(-x)); }
__device__ __forceinline__ float fsigmoid(float x) { return __builtin_amdgcn_rcpf(1.f + __builtin_amdgcn_exp2f(-1.4426950408889634f * x)); }
__device__ __forceinline__ float fsilu(float x) { return x * fsigmoid(x); }
__device__ __forceinline__ float siluf_(float x) { return x / (1.f + expf(-x)); }

struct EpiInProj {
    static constexpr bool PERM = false;
    unsigned char* ws;
    __device__ __forceinline__ void operator()(const f32x4 (&acc)[2][2][4][2], const pg8::Unit& u, int wr, int wc, int fr, int fq) const {
        const int sec = u.pn >> 2;
        const int row0 = u.pm * 256 + wr * 64 + fr, cb = (u.pn & 3) * 256 + wc * 32 + 4 * fq;
        if (sec == 0 || sec == 1 || sec == 4) {
            bf16_t* O = (bf16_t*)(ws + (sec == 0 ? WS_Q : (sec == 1 ? WS_V : WS_G)));
#pragma unroll
            for (int ai = 0; ai < 2; ++ai)
#pragma unroll
                for (int m = 0; m < 4; ++m) { bf16_t* rp = O + (size_t)(row0 + ai * 128 + m * 16) * DM + cb;
#pragma unroll
                    for (int bj = 0; bj < 2; ++bj)
#pragma unroll
                        for (int n = 0; n < 2; ++n) { f32x4 v = acc[ai][bj][m][n];
                            if (sec == 0) v = v * 0.08838834764831845f;
                            if (sec == 4) { v[0] = fsilu(v[0]); v[1] = fsilu(v[1]); v[2] = fsilu(v[2]); v[3] = fsilu(v[3]); }
                            u32x2 w; w.x = pk2(v[0], v[1]); w.y = pk2(v[2], v[3]); *(u32x2*)(rp + bj * 128 + n * 16) = w; } }
        } else {
            float* O = (float*)(ws + (sec == 2 ? WS_LF : WS_LBK)); const float* lb0 = (const float*)(ws + WS_LB);
            f32x4 lbv[2][2];
#pragma unroll
            for (int bj = 0; bj < 2; ++bj)
#pragma unroll
                for (int n = 0; n < 2; ++n) lbv[bj][n] = *(const f32x4*)(lb0 + cb + bj * 128 + n * 16);
#pragma unroll
            for (int ai = 0; ai < 2; ++ai)
#pragma unroll
                for (int m = 0; m < 4; ++m) { float* rp = O + (size_t)(row0 + ai * 128 + m * 16) * DM + cb;
#pragma unroll
                    for (int bj = 0; bj < 2; ++bj)
#pragma unroll
                        for (int n = 0; n < 2; ++n) { const f32x4 z = acc[ai][bj][m][n], lb = lbv[bj][n]; f32x4 o;
#pragma unroll
                            for (int i = 0; i < 4; ++i) o[i] = lb[i] + (1.f - lb[i]) * fsigmoid(z[i]);
                            *(f32x4*)(rp + bj * 128 + n * 16) = o; } }
        }
    }
};
struct EpiResid {
    static constexpr bool PERM = false;
    float* X; const float* gate;
    __device__ __forceinline__ void operator()(const f32x4 (&acc)[2][2][4][2], const pg8::Unit& u, int wr, int wc, int fr, int fq) const {
        const int row0 = u.pm * 256 + wr * 64 + fr, cb = u.pn * 256 + wc * 32 + 4 * fq;
        const float* gp = gate + (size_t)((u.pm * 256) / SEQ) * NADA + cb;
        f32x4 gv[2][2];
#pragma unroll
        for (int bj = 0; bj < 2; ++bj)
#pragma unroll
            for (int n = 0; n < 2; ++n) gv[bj][n] = *(const f32x4*)(gp + bj * 128 + n * 16);
#pragma unroll
        for (int ai = 0; ai < 2; ++ai)
#pragma unroll
            for (int m = 0; m < 4; ++m) { float* rp = X + (size_t)(row0 + ai * 128 + m * 16) * DM + cb;
#pragma unroll
                for (int bj = 0; bj < 2; ++bj)
#pragma unroll
                    for (int n = 0; n < 2; ++n) { f32x4* q = (f32x4*)(rp + bj * 128 + n * 16); *q = *q + gv[bj][n] * acc[ai][bj][m][n]; } }
    }
};
struct EpiGLU {
    static constexpr bool PERM = true;
    bf16_t* ACT;
    __device__ __forceinline__ void operator()(const f32x4 (&acc)[2][2][4][2], const pg8::Unit& u, int wr, int wc, int fr, int fq) const {
        const int row0 = u.pm * 256 + wr * 64 + fr, cb = u.pn * 128 + wc * 32 + 8 * fq;
#pragma unroll
        for (int ai = 0; ai < 2; ++ai)
#pragma unroll
            for (int m = 0; m < 4; ++m) { bf16_t* rp = ACT + (size_t)(row0 + ai * 128 + m * 16) * DE + cb;
                f32x4 o[2];
#pragma unroll
                for (int n = 0; n < 2; ++n) { const f32x4 a = acc[ai][0][m][n], w = acc[ai][1][m][n];
#pragma unroll
                    for (int i = 0; i < 4; ++i) o[n][i] = fsilu(a[i]) * w[i]; }
                u32x4 w; w.x = pk2(o[0][0], o[0][1]); w.y = pk2(o[0][2], o[0][3]); w.z = pk2(o[1][0], o[1][1]); w.w = pk2(o[1][2], o[1][3]);
                *(u32x4*)rp = w; }
    }
};
struct EpiRowScale {
    static constexpr bool PERM = true;
    bf16_t* Y; const float* rg;
    __device__ __forceinline__ void operator()(const f32x4 (&acc)[2][2][4][2], const pg8::Unit& u, int wr, int wc, int fr, int fq) const {
        const int row0 = u.pm * 256 + wr * 64 + fr, cb = u.pn * 256 + wc * 32 + 8 * fq;
#pragma unroll
        for (int ai = 0; ai < 2; ++ai)
#pragma unroll
            for (int m = 0; m < 4; ++m) { const int row = row0 + ai * 128 + m * 16; bf16_t* rp = Y + (size_t)row * DM + cb;
#pragma unroll
                for (int bj = 0; bj < 2; ++bj) { const f32x4 v0 = acc[ai][bj][m][0], v1 = acc[ai][bj][m][1];
                    u32x4 w; w.x = pk2(v0[0], v0[1]); w.y = pk2(v0[2], v0[3]); w.z = pk2(v1[0], v1[1]); w.w = pk2(v1[2], v1[3]);
                    *(u32x4*)(rp + bj * 128) = w; } }
    }
};
struct EpiConvIn {
    static constexpr bool PERM = true;
    bf16_t *BG, *CU;
    __device__ __forceinline__ void operator()(const f32x4 (&acc)[2][2][4][2], const pg8::Unit& u, int wr, int wc, int fr, int fq) const {
        const int row0 = u.pm * 256 + wr * 64 + fr;
        if (u.pn < 4) {
            const int cb = u.pn * 256 + wc * 32 + 8 * fq;
#pragma unroll
            for (int ai = 0; ai < 2; ++ai)
#pragma unroll
                for (int m = 0; m < 4; ++m) { bf16_t* rp = BG + (size_t)(row0 + ai * 128 + m * 16) * DM + cb;
#pragma unroll
                    for (int bj = 0; bj < 2; ++bj) { const f32x4 v0 = acc[ai][bj][m][0], v1 = acc[ai][bj][m][1];
                        u32x4 w; w.x = pk2(v0[0], v0[1]); w.y = pk2(v0[2], v0[3]); w.z = pk2(v1[0], v1[1]); w.w = pk2(v1[2], v1[3]);
                        *(u32x4*)(rp + bj * 128) = w; } }
        } else {
            const int cb = (u.pn - 4) * 128 + wc * 32 + 8 * fq;
#pragma unroll
            for (int ai = 0; ai < 2; ++ai)
#pragma unroll
                for (int m = 0; m < 4; ++m) { bf16_t* rp = CU + (size_t)(row0 + ai * 128 + m * 16) * DM + cb;
                    const f32x4 v0 = acc[ai][0][m][0] * acc[ai][1][m][0], v1 = acc[ai][0][m][1] * acc[ai][1][m][1];
                    u32x4 w; w.x = pk2(v0[0], v0[1]); w.y = pk2(v0[2], v0[3]); w.z = pk2(v1[0], v1[1]); w.w = pk2(v1[2], v1[3]);
                    *(u32x4*)rp = w; }
        }
    }
};

__device__ __forceinline__ void ph_prep(const Params& p, unsigned char* lds, int bid, int nblk) {
    float* sv = (float*)lds;
    float* red = sv + 3 * 1024;
    int tid_ = threadIdx.x; asm volatile("" : "+v"(tid_)); const int tid = tid_;
    const float* c = p.in[I_C]; const float* cctx = p.in[I_CCTX];
    for (int i = tid; i < 3 * 1024; i += NTHR) { const float v = (i < 2048) ? c[i] : cctx[i - 2048]; sv[i] = siluf_(v); }
    __syncthreads();
    const float* ada_w = p.in[I_ADAW]; const float* ada_b = p.in[I_ADAB];
    float* mod = (float*)(p.ws + WS_MOD);
    for (int it = bid; it < 192; it += nblk) {
        const int l = it / 96, j0 = (it % 96) * 64, col = tid & 63, ks = tid >> 6;
        const float* W = ada_w + (size_t)l * DM * NADA + j0 + col;
        float a0 = 0.f, a1 = 0.f, a2 = 0.f;
#pragma unroll 16
        for (int k = ks * 128; k < ks * 128 + 128; ++k) { const float w = W[(size_t)k * NADA]; a0 += sv[k] * w; a1 += sv[1024 + k] * w; a2 += sv[2048 + k] * w; }
        red[(ks * 3 + 0) * 64 + col] = a0; red[(ks * 3 + 1) * 64 + col] = a1; red[(ks * 3 + 2) * 64 + col] = a2;
        __syncthreads();
        if (tid < 192) { const int v = tid >> 6, cc = tid & 63; float s = ada_b[l * NADA + j0 + cc];
#pragma unroll
            for (int k2 = 0; k2 < 8; ++k2) s += red[(k2 * 3 + v) * 64 + cc];
            mod[(size_t)(l * 3 + v) * NADA + j0 + cc] = s; }
        __syncthreads();
    }
    const int gt = bid * NTHR + tid, NT = nblk * NTHR;
    const float* lg = p.in[I_HGLB]; float* lb0 = (float*)(p.ws + WS_LB);
    for (int d = gt; d < DM; d += NT) { const float l0 = lg[d], l1 = lg[DM + d], l2 = lg[2 * DM + d]; const float mx = fmaxf(l0, fmaxf(l1, l2));
        const float e0 = expf(l0 - mx), e1 = expf(l1 - mx), e2 = expf(l2 - mx); lb0[d] = e0 / (e0 + e1 + e2); }
    float* posr = (float*)(p.ws + WS_POSR);
    for (int i = gt; i < (128 + 64) * 512; i += NT) { const int pi = i >> 9, dd = i & 511; const int pos = pi < 128 ? pi : pi - 128; const int fi = dd & 255;
        const float om = exp2f(-(float)fi * (13.287712379549449f / 256.0f)); const float a = (float)pos * om; posr[i] = dd < 256 ? sinf(a) : cosf(a); }
}

__device__ __forceinline__ void transpose_item(const float* W, int N, bf16_t* WT, int K, float* scr, int k0, int n0, size_t drow0, int lane) {
#pragma unroll
    for (int i = 0; i < 8; ++i) { const int kk = 8 * i + (lane >> 3); const f32x4 v = *(const f32x4*)(W + (size_t)(k0 + kk) * N + n0 + (lane & 7) * 4); float* d = scr + kk * 33 + (lane & 7) * 4; d[0] = v[0]; d[1] = v[1]; d[2] = v[2]; d[3] = v[3]; }
    __builtin_amdgcn_s_waitcnt(0xc07f); asm volatile("" ::: "memory");
    const int c = lane & 7;
#pragma unroll
    for (int j = 0; j < 4; ++j) { const int n = (lane >> 3) + 8 * j; const float* s = scr + (8 * c) * 33 + n;
        u32x4 o; o.x = pk2(s[0 * 33], s[1 * 33]); o.y = pk2(s[2 * 33], s[3 * 33]); o.z = pk2(s[4 * 33], s[5 * 33]); o.w = pk2(s[6 * 33], s[7 * 33]);
        *(u32x4*)(WT + (drow0 + n) * K + k0 + 8 * c) = o; }
    __builtin_amdgcn_s_waitcnt(0xc07f); asm volatile("" ::: "memory");
}
__device__ __forceinline__ void ph_convert_small(const Params& p, unsigned char* lds, int bid, int nblk) {
    int tid_ = threadIdx.x; asm volatile("" : "+v"(tid_));
    const int tid = tid_, lane = tid & 63, wave = tid >> 6;
    float* scr = (float*)lds + wave * (64 * 33);
    const int gw = bid * 8 + wave, NGW = nblk * 8;
    constexpr int I_A = 16 * 160, I_B = 16 * 32, I_C_ = 16 * 96, I_D = 16 * 32;
    for (int it = gw; it < I_A + I_B + I_C_ + I_D; it += NGW) {
        int r = it;
        if (r < I_A) { const int kb = r / 160, nb = r % 160; transpose_item(p.in[I_HGWIN], 5120, (bf16_t*)(p.ws + WS_WHGIN), 1024, scr, kb * 64, nb * 32, (size_t)nb * 32, lane); continue; } r -= I_A;
        if (r < I_B) { const int kb = r / 32, nb = r % 32; transpose_item(p.in[I_HGWOUT], 1024, (bf16_t*)(p.ws + WS_WHGOUT), 1024, scr, kb * 64, nb * 32, (size_t)nb * 32, lane); continue; } r -= I_B;
        if (r < I_C_) { const int kb = r / 96, nb = r % 96, n0 = nb * 32; size_t dr;
            if (n0 < 1024) dr = n0; else { const int np = n0 - 1024, sec = np >> 10, nn = np & 1023; dr = 1024 + (nn >> 7) * 256 + sec * 128 + (nn & 127); }
            transpose_item(p.in[I_SCWIN], 3072, (bf16_t*)(p.ws + WS_WSCIN), 1024, scr, kb * 64, n0, dr, lane); continue; } r -= I_C_;
        { const int kb = r / 32, nb = r % 32; transpose_item(p.in[I_SCWOUT], 1024, (bf16_t*)(p.ws + WS_WSCOUT), 1024, scr, kb * 64, nb * 32, (size_t)nb * 32, lane); }
    }
}
struct CvtItem { const float* src; bf16_t* dst; int N, K; };
__device__ __forceinline__ CvtItem moe_item(const Params& p, int l, int r) {
    CvtItem c;
    if (r < 32768) { const int up = r >= 16384; if (up) r -= 16384; const int le = l * 16 + (r >> 10), q = r & 1023, kb = q >> 6, nb = q & 63, n0 = nb * 32;
        const size_t dr = (size_t)le * 4096 + (n0 >> 7) * 256 + up * 128 + (n0 & 127);
        c.src = p.in[up ? I_WUP : I_WGATE] + (size_t)le * 1024 * 2048 + (size_t)(kb * 64) * 2048 + n0; c.dst = (bf16_t*)(p.ws + WS_WMOE1) + dr * 1024 + kb * 64; c.N = 2048; c.K = 1024; }
    else { r -= 32768; const int le = l * 16 + (r >> 10), q = r & 1023, kb = q >> 5, nb = q & 31, n0 = nb * 32;
        c.src = p.in[I_WDOWN] + (size_t)le * 2048 * 1024 + (size_t)(kb * 64) * 1024 + n0; c.dst = (bf16_t*)(p.ws + WS_WMOE2) + ((size_t)le * 1024 + n0) * 2048 + kb * 64; c.N = 1024; c.K = 2048; }
    return c;
}
__device__ __forceinline__ void convert_moe_slice(const Params& p, unsigned char* lds, int bid, int nblk, int l, int lo, int hi) {
    int tid_ = threadIdx.x; asm volatile("" : "+v"(tid_));
    const int tid = tid_, lane = tid & 63, wave = tid >> 6;
    float* scr = (float*)lds + wave * (64 * 33);
    const int gw = bid * 8 + wave, NGW = nblk * 8;
    constexpr int NI = 3;
    for (int it = lo + gw; it < hi; it += NGW * NI) {
        f32x4 v[NI][8]; CvtItem ci[NI];
#pragma unroll
        for (int u = 0; u < NI; ++u) { const int r = it + u * NGW; ci[u] = moe_item(p, l, r < hi ? r : it);
#pragma unroll
            for (int i = 0; i < 8; ++i) v[u][i] = __builtin_nontemporal_load((const f32x4*)(ci[u].src + (size_t)(8 * i + (lane >> 3)) * ci[u].N + (lane & 7) * 4)); }
#pragma unroll
        for (int u = 0; u < NI; ++u) { if (it + u * NGW < hi) {
#pragma unroll
            for (int i = 0; i < 8; ++i) { float* d = scr + (8 * i + (lane >> 3)) * 33 + (lane & 7) * 4; d[0] = v[u][i][0]; d[1] = v[u][i][1]; d[2] = v[u][i][2]; d[3] = v[u][i][3]; }
            __builtin_amdgcn_s_waitcnt(0xc07f); asm volatile("" ::: "memory");
            const int c = lane & 7;
#pragma unroll
            for (int j = 0; j < 4; ++j) { const int n = (lane >> 3) + 8 * j; const float* sp = scr + (8 * c) * 33 + n;
                u32x4 o; o.x = pk2(sp[0 * 33], sp[1 * 33]); o.y = pk2(sp[2 * 33], sp[3 * 33]); o.z = pk2(sp[4 * 33], sp[5 * 33]); o.w = pk2(sp[6 * 33], sp[7 * 33]);
                __builtin_nontemporal_store(o, (u32x4*)(ci[u].dst + (size_t)n * ci[u].K + 8 * c)); }
            __builtin_amdgcn_s_waitcnt(0xc07f); asm volatile("" ::: "memory"); } }
    }
    __syncthreads();
}

constexpr int CV_ITEMS = 49152, CW_Q = 1536;
constexpr int MW_LAYER = 12, MW_BASE = 13, MW_EMPTY = 14, MW_REL = 15, MW_LAST = 16;
__device__ __forceinline__ bool cvt_batch(const Params& p, unsigned char* lds, volatile LAS unsigned* MISC, unsigned layer_mask) {
    int tid_ = threadIdx.x; asm volatile("" : "+v"(tid_));
    const int tid = tid_, lane = tid & 63, wave = tid >> 6;
    if (tid == 0) {
        unsigned* q = (unsigned*)(p.ws + WS_CTL) + CW_Q; unsigned empty = MISC[MW_EMPTY]; int layer = -1; unsigned base = 0u;
#pragma unroll
        for (int l = 0; l < 2; ++l) if (layer < 0 && ((layer_mask >> l) & 1u) && !((empty >> l) & 1u)) {
            const unsigned b0 = __hip_atomic_fetch_add(q + 64 * l, 8u, __ATOMIC_RELAXED, __HIP_MEMORY_SCOPE_AGENT);
            if (b0 < (unsigned)CV_ITEMS) { layer = l; base = b0; MISC[MW_LAST + l] = b0 + 8u; } else empty |= 1u << l; }
        MISC[MW_EMPTY] = empty; MISC[MW_LAYER] = (unsigned)layer; MISC[MW_BASE] = base;
    }
    __syncthreads();
    const int layer = (int)MISC[MW_LAYER]; const int item = (int)MISC[MW_BASE] + wave;
    if (layer < 0) return false;
    float* scr = (float*)lds + wave * (64 * 33);
    if (item < CV_ITEMS) {
        const CvtItem ci = moe_item(p, layer, item);
        f32x4 v[8];
#pragma unroll
        for (int i = 0; i < 8; ++i) v[i] = __builtin_nontemporal_load((const f32x4*)(ci.src + (size_t)(8 * i + (lane >> 3)) * ci.N + (lane & 7) * 4));
#pragma unroll
        for (int i = 0; i < 8; ++i) { float* d = scr + (8 * i + (lane >> 3)) * 33 + (lane & 7) * 4; d[0] = v[i][0]; d[1] = v[i][1]; d[2] = v[i][2]; d[3] = v[i][3]; }
        __builtin_amdgcn_s_waitcnt(0xc07f); asm volatile("" ::: "memory");
        const int c = lane & 7;
#pragma unroll
        for (int j = 0; j < 4; ++j) { const int n = (lane >> 3) + 8 * j; const float* sp = scr + (8 * c) * 33 + n;
            u32x4 o; o.x = pk2(sp[0 * 33], sp[1 * 33]); o.y = pk2(sp[2 * 33], sp[3 * 33]); o.z = pk2(sp[4 * 33], sp[5 * 33]); o.w = pk2(sp[6 * 33], sp[7 * 33]);
            __builtin_nontemporal_store(o, (u32x4*)(ci.dst + (size_t)n * ci.K + 8 * c)); }
    }
    __syncthreads();
    return true;
}
__device__ __forceinline__ void cvt_drain_until(const Params& p, unsigned char* lds, volatile LAS unsigned* MISC, int l, unsigned limit) {
    for (;;) { if ((MISC[MW_EMPTY] >> l) & 1u) break; if (MISC[MW_LAST + l] >= limit) break; if (!cvt_batch(p, lds, MISC, 1u << l)) break; }
}
__device__ __forceinline__ void cvt_budget(const Params& p, unsigned char* lds, volatile LAS unsigned* MISC, unsigned layer_mask, int nbatch) {
    for (int i = 0; i < nbatch; ++i) if (!cvt_batch(p, lds, MISC, layer_mask)) break;
}

__device__ __forceinline__ void store_mod_bf16(bf16_t* hrow, const f32x4 (&v)[4], float rstd, const float* g, const float* sh, const float* sc, int lane) {
#pragma unroll
    for (int j = 0; j < 4; ++j) { const int c0 = 256 * j + 4 * lane; const f32x4 gv = *(const f32x4*)(g + c0), shv = *(const f32x4*)(sh + c0), scv = *(const f32x4*)(sc + c0);
        f32x4 h;
#pragma unroll
        for (int i = 0; i < 4; ++i) h[i] = (v[j][i] * rstd * gv[i]) * (1.f + scv[i]) + shv[i];
        u32x2 w; w.x = pk2(h[0], h[1]); w.y = pk2(h[2], h[3]); *(u32x2*)(hrow + c0) = w; }
}
__device__ __forceinline__ void ph_mod0(const Params& p, int row_lo, int row_hi, int wk, int nwk) {
    int tid_ = threadIdx.x; asm volatile("" : "+v"(tid_));
    const int tid = tid_, lane = tid & 63, wave = tid >> 6, gw = wk * 8 + wave, NGW = nwk * 8;
    const float* x = p.in[I_X]; const float* ctx = p.in[I_CTX]; const float* g = p.in[I_NMIX];
    const float* mod = (const float*)(p.ws + WS_MOD); const float* posr = (const float*)(p.ws + WS_POSR); const float* posc = (const float*)(p.ws + WS_POSC);
    float* X = (float*)(p.ws + WS_X); bf16_t* H = (bf16_t*)(p.ws + WS_H);
    f32x4 nx[4];
    { const int row = row_lo + gw; if (row < row_hi) { const float* src = row < NTOK ? x + (size_t)row * DM : ctx + (size_t)(row - NTOK) * DM;
#pragma unroll
        for (int j = 0; j < 4; ++j) nx[j] = *(const f32x4*)(src + 256 * j + 4 * lane); } }
    for (int row = row_lo + gw; row < row_hi; row += NGW) {
        f32x4 v[4]; float ss = 0.f; int vec;
#pragma unroll
        for (int j = 0; j < 4; ++j) v[j] = nx[j];
        { const int r2 = row + NGW; if (r2 < row_hi) { const float* src = r2 < NTOK ? x + (size_t)r2 * DM : ctx + (size_t)(r2 - NTOK) * DM;
#pragma unroll
            for (int j = 0; j < 4; ++j) nx[j] = *(const f32x4*)(src + 256 * j + 4 * lane); } }
        if (row < NTOK) { const int t = row & (SEQ - 1); vec = row >> 13; const float* pr = posr + (size_t)(t >> 6) * 512; const float* pc = posc + (size_t)(t & 63) * 512;
#pragma unroll
            for (int j = 0; j < 4; ++j) { const int c0 = 256 * j + 4 * lane; const f32x4 pv = *(const f32x4*)((j < 2 ? pr : pc) + (c0 & 511));
                v[j] = v[j] + pv; *(f32x4*)(X + (size_t)row * DM + c0) = v[j]; }
        } else vec = 2;
#pragma unroll
        for (int j = 0; j < 4; ++j) ss += (v[j][0] * v[j][0] + v[j][1] * v[j][1]) + (v[j][2] * v[j][2] + v[j][3] * v[j][3]);
        const float rstd = 1.f / sqrtf(wave_sum(ss) * (1.f / DM) + 1e-6f);
        const float* mv = mod + (size_t)(0 * 3 + vec) * NADA;
        store_mod_bf16(H + (size_t)row * DM, v, rstd, g, mv, mv + DM, lane);
    }
}

typedef short s16x4 __attribute__((ext_vector_type(4)));
typedef short v4i16_t __attribute__((ext_vector_type(4)));
using pg8::bf16x8;
constexpr int KT_STR = 160, KS_STR = 144, V_STR = 288;
constexpr int GL_QT = 0, GL_KT = 20480, GL_KS = 40960, GL_PL = 59392, GL_V = 68608, GL_SEG = 87040, GL_DV = 89088, GL_EM = 89600, GL_SSQ = 90112, GL_RSTD = 92160;
__device__ __forceinline__ s16x4 lds_tr(const LAS unsigned char* p) { return __builtin_bit_cast(s16x4, __builtin_amdgcn_ds_read_tr16_b64_v4i16((LAS v4i16_t*)p)); }
__device__ __forceinline__ bf16x8 cat8(s16x4 a, s16x4 b) { return __builtin_shufflevector(a, b, 0, 1, 2, 3, 4, 5, 6, 7); }
__device__ __forceinline__ bf16x8 lds_pair64(const LAS unsigned char* p, int d2) { const u32x2 a = *(const LAS u32x2*)p, b = *(const LAS u32x2*)(p + d2); u32x4 r; r.x = a.x; r.y = a.y; r.z = b.x; r.w = b.y; return __builtin_bit_cast(bf16x8, r); }

constexpr int ON_STR = 272;
constexpr int GL_RF = 92416, GL_RQ = 125184, GL_END = 141568;
struct GlaRegs { f32x4 f[4]; u32x4 q[2]; u32x4 v[2]; };
template <bool WITHQ>
__device__ __forceinline__ void gla_load(GlaRegs& R, const float* F, const bf16_t* Q, const bf16_t* V, int rb, int h, int tid) {
    const unsigned lf = (unsigned)((tid >> 5) * DM + (tid & 31) * 4), lq = (unsigned)((tid >> 4) * DM + (tid & 15) * 8);
#pragma unroll
    for (int i = 0; i < 4; ++i) { const float* fb = F + (size_t)(rb + 16 * i) * DM + h * 128; R.f[i] = *(const f32x4*)(fb + lf); }
#pragma unroll
    for (int i = 0; i < 2; ++i) { const size_t ub = (size_t)(rb + 32 * i) * DM + h * 128;
        if (WITHQ) R.q[i] = *(const u32x4*)(Q + ub + lq); R.v[i] = *(const u32x4*)(V + ub + lq); }
}
template <bool WITHQ>
__device__ __forceinline__ void gla_put_raw(const GlaRegs& R, LAS unsigned char* lds, int dir, int tid) {
#pragma unroll
    for (int i = 0; i < 4; ++i) { const int id = tid + 512 * i, row = id >> 5, c4 = (id & 31) * 4, p = dir ? 63 - row : row; *(LAS f32x4*)(lds + GL_RF + p * 512 + c4 * 4) = R.f[i]; }
#pragma unroll
    for (int i = 0; i < 2; ++i) { const int id = tid + 512 * i, row = id >> 4, c8 = (id & 15) * 8, p = dir ? 63 - row : row;
        if (WITHQ) *(LAS u32x4*)(lds + GL_RQ + p * 256 + c8 * 2) = R.q[i]; *(LAS u32x4*)(lds + GL_V + p * V_STR + c8 * 2) = R.v[i]; }
}
template <bool G2>
__device__ __forceinline__ void gla_phase_a(LAS unsigned char* lds, int tid) {
    const int k = tid & 127, seg = tid >> 7;
    LAS float* segtot = (LAS float*)(lds + GL_SEG);
    float f[16];
#pragma unroll
    for (int i = 0; i < 16; ++i) f[i] = *(const LAS float*)(lds + GL_RF + (16 * seg + i) * 512 + k * 4);
    if (G2) {
        unsigned short q[16];
#pragma unroll
        for (int i = 0; i < 16; ++i) q[i] = *(const LAS unsigned short*)(lds + GL_RQ + (16 * seg + i) * 256 + k * 2);
        float c[16]; c[0] = f[0];
#pragma unroll
        for (int i = 1; i < 16; ++i) c[i] = c[i - 1] * f[i];
        segtot[seg * 128 + k] = c[15];
        __syncthreads();
        const float T0 = segtot[k], T1 = segtot[128 + k], T2 = segtot[256 + k], T3 = segtot[384 + k];
        const float Fs = seg == 0 ? 1.f / (T0 * T1) : (seg == 1 ? 1.f / T1 : (seg == 2 ? 1.f : T2));
        const float cK = T2 * T3;
        if (seg == 0) { ((LAS float*)(lds + GL_DV))[k] = T0 * T1 * cK; ((LAS float*)(lds + GL_EM))[k] = T0 * T1; }
        unsigned wq[8], wk[8], ws_[8];
#pragma unroll
        for (int i = 0; i < 16; i += 2) { float qp[2], kp[2], ks[2];
#pragma unroll
            for (int e = 0; e < 2; ++e) { const float eq = c[i + e] * Fs, inv = __builtin_amdgcn_rcpf(eq), kk = 1.f - f[i + e];
                qp[e] = bf2f(q[i + e]) * eq; kp[e] = kk * inv; ks[e] = kp[e] * cK; }
            wq[i >> 1] = pk2(qp[0], qp[1]); wk[i >> 1] = pk2(kp[0], kp[1]); ws_[i >> 1] = pk2(ks[0], ks[1]); }
        LAS unsigned char* dq = lds + GL_QT + k * KT_STR + seg * 32; LAS unsigned char* dk = lds + GL_KT + k * KT_STR + seg * 32; LAS unsigned char* ds = lds + GL_KS + k * KS_STR + seg * 32;
        *(LAS u32x4*)dq = (u32x4){wq[0], wq[1], wq[2], wq[3]}; *(LAS u32x4*)(dq + 16) = (u32x4){wq[4], wq[5], wq[6], wq[7]};
        *(LAS u32x4*)dk = (u32x4){wk[0], wk[1], wk[2], wk[3]}; *(LAS u32x4*)(dk + 16) = (u32x4){wk[4], wk[5], wk[6], wk[7]};
        *(LAS u32x4*)ds = (u32x4){ws_[0], ws_[1], ws_[2], ws_[3]}; *(LAS u32x4*)(ds + 16) = (u32x4){ws_[4], ws_[5], ws_[6], ws_[7]};
    } else {
        float sx[16]; sx[15] = 1.f;
#pragma unroll
        for (int i = 14; i >= 0; --i) sx[i] = sx[i + 1] * f[i + 1];
        segtot[seg * 128 + k] = sx[0] * f[0];
        __syncthreads();
        const float T0 = segtot[k], T1 = segtot[128 + k], T2 = segtot[256 + k], T3 = segtot[384 + k];
        const float later = seg == 0 ? T1 * T2 * T3 : (seg == 1 ? T2 * T3 : (seg == 2 ? T3 : 1.f));
        if (seg == 0) ((LAS float*)(lds + GL_DV))[k] = T0 * T1 * T2 * T3;
        unsigned ws_[8];
#pragma unroll
        for (int i = 0; i < 16; i += 2) ws_[i >> 1] = pk2((1.f - f[i]) * sx[i] * later, (1.f - f[i + 1]) * sx[i + 1] * later);
        LAS unsigned char* ds = lds + GL_KS + k * KS_STR + seg * 32;
        *(LAS u32x4*)ds = (u32x4){ws_[0], ws_[1], ws_[2], ws_[3]}; *(LAS u32x4*)(ds + 16) = (u32x4){ws_[4], ws_[5], ws_[6], ws_[7]};
    }
    __syncthreads();
}
__device__ __forceinline__ void gla_state_update(f32x4 (&S)[8], const bf16x8 (&Vf)[2], const LAS unsigned char* lds, int i16, int g) {
#pragma unroll
    for (int j = 0; j < 8; ++j) { const f32x4 dv = *(const LAS f32x4*)(lds + GL_DV + (16 * j + 4 * g) * 4); S[j] = S[j] * dv;
#pragma unroll
        for (int c2 = 0; c2 < 2; ++c2) { const bf16x8 a = lds_pair64(lds + GL_KS + (16 * j + i16) * KS_STR + (32 * c2 + 4 * g) * 2, 32);
            S[j] = __builtin_amdgcn_mfma_f32_16x16x32_bf16(a, Vf[c2], S[j], 0, 0, 0); }
        if (j & 1) asm volatile("" ::: "memory"); }
}
__device__ __forceinline__ void gla_load_vf(bf16x8 (&Vf)[2], const LAS unsigned char* lds, int w, int i16, int g) {
    const int q4 = i16 >> 2, pp = i16 & 3;
#pragma unroll
    for (int c2 = 0; c2 < 2; ++c2) { const LAS unsigned char* vb = lds + GL_V + (32 * c2 + 4 * g + q4) * V_STR + (16 * w + 4 * pp) * 2; Vf[c2] = cat8(lds_tr(vb), lds_tr(vb + 16 * V_STR)); }
}

__device__ __forceinline__ void ph_gla_states(const Params& p, unsigned char* lds_, int bid, int nblk) {
    int tid_ = threadIdx.x; asm volatile("" : "+v"(tid_));
    const int tid = tid_, lane = tid & 63, w = __builtin_amdgcn_readfirstlane(tid >> 6), i16 = lane & 15, g = lane >> 4;
    LAS unsigned char* lds = (LAS unsigned char*)lds_;
    const bf16_t* V = (const bf16_t*)(p.ws + WS_V);
    float* U = (float*)(p.ws + WS_U); float* DD = (float*)(p.ws + WS_DD);
    for (int ui = bid; ui < 544; ui += nblk) {
        int b, h, dir, nch, rb0, uidx;
        if (ui < 512) { b = ui >> 8; h = (ui >> 5) & 7; dir = (ui >> 4) & 1; const int sc = ui & 15; nch = 8; rb0 = b * SEQ + sc * 512; uidx = ((b * 8 + h) * 2 + dir) * 17 + sc; }
        else { const int r = ui - 512; b = r >> 4; h = (r >> 1) & 7; dir = r & 1; nch = 4; rb0 = NTOK + b * CTXL; uidx = ((b * 8 + h) * 2 + dir) * 17 + 16; }
        const float* F = (const float*)(p.ws + (dir ? WS_LBK : WS_LF));
        f32x4 S[8];
#pragma unroll
        for (int j = 0; j < 8; ++j) S[j] = (f32x4){0.f, 0.f, 0.f, 0.f};
        float dtot = 1.f;
        GlaRegs R;
        gla_load<false>(R, F, nullptr, V, rb0 + 64 * (dir ? nch - 1 : 0), h, tid);
        for (int step = 0; step < nch; ++step) {
            gla_put_raw<false>(R, lds, dir, tid);
            __syncthreads();
            if (step + 1 < nch) gla_load<false>(R, F, nullptr, V, rb0 + 64 * (dir ? nch - 2 - step : step + 1), h, tid);
            gla_phase_a<false>(lds, tid);
            if (tid < 128) dtot *= ((const LAS float*)(lds + GL_DV))[tid];
            bf16x8 Vf[2]; gla_load_vf(Vf, lds, w, i16, g);
            gla_state_update(S, Vf, lds, i16, g);
            __syncthreads();
        }
        float* up = U + (size_t)uidx * 16384 + (size_t)(w * 8) * 256 + lane * 4;
#pragma unroll
        for (int j = 0; j < 8; ++j) *(f32x4*)(up + j * 256) = S[j];
        if (tid < 128) DD[(size_t)uidx * 128 + tid] = dtot;
    }
}

__device__ __forceinline__ void ph_gla_out(const Params& p, unsigned char* lds_, int bid, int nblk) {
    int tid_ = threadIdx.x; asm volatile("" : "+v"(tid_));
    const int tid = tid_, lane = tid & 63, w = __builtin_amdgcn_readfirstlane(tid >> 6), i16 = lane & 15, g = lane >> 4, q4 = i16 >> 2, pp = i16 & 3;
    LAS unsigned char* lds = (LAS unsigned char*)lds_;
    const bf16_t* Q = (const bf16_t*)(p.ws + WS_Q); const bf16_t* V = (const bf16_t*)(p.ws + WS_V); const bf16_t* G = (const bf16_t*)(p.ws + WS_G);
    const float* U = (const float*)(p.ws + WS_U); const float* DD = (const float*)(p.ws + WS_DD);
    float* OFL = (float*)(p.ws + WS_OF); bf16_t* ON = (bf16_t*)(p.ws + WS_ON);
    const float ngv = p.in[I_HGNORM][16 * w + i16];
    const int troff = (4 * g + q4) * KT_STR + (4 * pp) * 2;
    for (int unit = bid; unit < 256; unit += nblk) {
        const int b = unit >> 7, h = (unit >> 4) & 7, sc = unit & 15, rbs = b * SEQ + sc * 512;
        const unsigned loff = (unsigned)((3 - g) * 4 * DM + i16);
#pragma unroll 1
        for (int dir = 0; dir < 2; ++dir) {
            const float* F = (const float*)(p.ws + (dir ? WS_LBK : WS_LF));
            GlaRegs R;
            gla_load<true>(R, F, Q, V, rbs + 64 * (dir ? 7 : 0), h, tid);
            int on_rb = -1;
#define GLA_ON_FLUSH() do { _Pragma("unroll") for (int i_ = 0; i_ < 2; ++i_) { const int id_ = tid + 512 * i_, row_ = id_ >> 4, c8_ = (id_ & 15) * 8; \
                *(u32x4*)(ON + (size_t)(on_rb + row_) * DM + h * 128 + c8_) = *(const LAS u32x4*)(lds + GL_QT + row_ * ON_STR + c8_ * 2); } } while (0)
            const int ub = ((b * 8 + h) * 2 + dir) * 17;
            f32x4 S[8];
            { const float* up = U + (size_t)(ub + 16) * 16384 + (size_t)(w * 8) * 256 + lane * 4;
#pragma unroll
                for (int j = 0; j < 8; ++j) S[j] = *(const f32x4*)(up + j * 256); }
            { const int nf = dir ? 15 - sc : sc;
                LAS float* dl = (LAS float*)(lds + GL_QT);
                for (int i = tid; i < 16 * 128; i += NTHR) dl[i] = DD[(size_t)ub * 128 + i];
                __syncthreads();
                f32x4 Ua[8];
#define FOLD_LOAD(UU, s_) do { const int u_ = dir ? 15 - (s_) : (s_); const float* up_ = U + (size_t)(ub + u_) * 16384 + (size_t)(w * 8) * 256 + lane * 4; \
                    _Pragma("unroll") for (int j = 0; j < 8; ++j) UU[j] = *(const f32x4*)(up_ + j * 256); } while (0)
                if (nf > 0) FOLD_LOAD(Ua, 0);
                for (int s = 0; s < nf; ++s) { const int u = dir ? 15 - s : s;
#pragma unroll
                    for (int j = 0; j < 8; ++j) S[j] = S[j] * *(const LAS f32x4*)(dl + u * 128 + 16 * j + 4 * g) + Ua[j];
                    if (s + 1 < nf) FOLD_LOAD(Ua, s + 1); }
#undef FOLD_LOAD
                __syncthreads();
            }
            for (int step = 0; step < 8; ++step) {
                const int n = dir ? 7 - step : step, rb = rbs + 64 * n;
                gla_put_raw<true>(R, lds, dir, tid);
                __syncthreads();
                if (on_rb >= 0) { GLA_ON_FLUSH(); on_rb = -1; }
                if (step < 7) gla_load<true>(R, F, Q, V, rbs + 64 * (dir ? 6 - step : step + 1), h, tid);
                gla_phase_a<true>(lds, tid);
                f32x4 O[4];
                if (dir) { const float* ob = OFL + ((size_t)((unit * 8 + n) * 8 + w) * 4) * 256 + ((3 - g) * 16 + i16) * 4;
#pragma unroll
                    for (int ti = 0; ti < 4; ++ti) { const f32x4 t4 = *(const f32x4*)(ob + (3 - ti) * 256); O[ti] = (f32x4){t4[3], t4[2], t4[1], t4[0]}; } }
                else {
#pragma unroll
                    for (int ti = 0; ti < 4; ++ti) O[ti] = (f32x4){0.f, 0.f, 0.f, 0.f}; }
                { const int si = w >> 1, tb = 2 * (w & 1);
                    f32x4 pa[2] = {(f32x4){0.f, 0.f, 0.f, 0.f}, (f32x4){0.f, 0.f, 0.f, 0.f}};
#pragma unroll
                    for (int c = 0; c < 4; ++c) { const LAS unsigned char* ka = lds + GL_KT + troff + (32 * c) * KT_STR + (16 * si) * 2; const bf16x8 a = cat8(lds_tr(ka), lds_tr(ka + 16 * KT_STR));
#pragma unroll
                        for (int tt = 0; tt < 2; ++tt) { const LAS unsigned char* qa = lds + GL_QT + troff + (32 * c) * KT_STR + (16 * (tb + tt)) * 2; const bf16x8 bq = cat8(lds_tr(qa), lds_tr(qa + 16 * KT_STR));
                            pa[tt] = __builtin_amdgcn_mfma_f32_16x16x32_bf16(a, bq, pa[tt], 0, 0, 0); } }
#pragma unroll
                    for (int tt = 0; tt < 2; ++tt) { const int t = 16 * (tb + tt) + i16, s0 = 16 * si + 4 * g; f32x4 v = pa[tt];
#pragma unroll
                        for (int r = 0; r < 4; ++r) v[r] = (s0 + r <= t) ? v[r] : 0.f;
                        u32x2 wv; wv.x = pk2(v[0], v[1]); wv.y = pk2(v[2], v[3]); *(LAS u32x2*)(lds + GL_PL + t * KS_STR + s0 * 2) = wv; } }
                __syncthreads();
                {
#pragma unroll
                    for (int c = 0; c < 4; ++c) { const f32x4 e0 = *(const LAS f32x4*)(lds + GL_EM + (32 * c + 4 * g) * 4), e1 = *(const LAS f32x4*)(lds + GL_EM + (32 * c + 16 + 4 * g) * 4);
                        const f32x4 a0 = S[2 * c] * e0, b0 = S[2 * c + 1] * e1; u32x4 r; r.x = pk2(a0[0], a0[1]); r.y = pk2(a0[2], a0[3]); r.z = pk2(b0[0], b0[1]); r.w = pk2(b0[2], b0[3]); const bf16x8 Sb = __builtin_bit_cast(bf16x8, r);
#pragma unroll
                        for (int ti = 0; ti < 4; ++ti) { const LAS unsigned char* qa = lds + GL_QT + troff + (32 * c) * KT_STR + (16 * ti) * 2; const bf16x8 a = cat8(lds_tr(qa), lds_tr(qa + 16 * KT_STR));
                            O[ti] = __builtin_amdgcn_mfma_f32_16x16x32_bf16(a, Sb, O[ti], 0, 0, 0); }
                        asm volatile("" ::: "memory"); } }
                bf16x8 Vf[2]; gla_load_vf(Vf, lds, w, i16, g);
#pragma unroll
                for (int ti = 0; ti < 4; ++ti) {
#pragma unroll
                    for (int c2 = 0; c2 < 2; ++c2) { const bf16x8 a = lds_pair64(lds + GL_PL + (16 * ti + i16) * KS_STR + (32 * c2 + 4 * g) * 2, 32);
                        O[ti] = __builtin_amdgcn_mfma_f32_16x16x32_bf16(a, Vf[c2], O[ti], 0, 0, 0); }
                    if (ti & 1) asm volatile("" ::: "memory"); }
                gla_state_update(S, Vf, lds, i16, g);
                if (dir == 0) {
                    float* ob = OFL + ((size_t)((unit * 8 + n) * 8 + w) * 4) * 256 + lane * 4;
#pragma unroll
                    for (int ti = 0; ti < 4; ++ti) *(f32x4*)(ob + ti * 256) = O[ti];
                    __syncthreads();
                } else {
                    float part[4][4];
#pragma unroll
                    for (int ti = 0; ti < 4; ++ti)
#pragma unroll
                        for (int r = 0; r < 4; ++r) { const float o = O[ti][r]; part[ti][r] = row16_sum(o * o); }
                    unsigned short gq[4][4];
#pragma unroll
                    for (int ti = 0; ti < 4; ++ti)
#pragma unroll
                        for (int r = 0; r < 4; ++r) { const bf16_t* gb = G + (size_t)(rb + 51 - 16 * ti - r) * DM + h * 128 + 16 * w; gq[ti][r] = gb[loff]; }
                    if (i16 == 0) {
#pragma unroll
                        for (int ti = 0; ti < 4; ++ti) *(LAS f32x4*)(lds + GL_SSQ + (w * 64 + 16 * ti + 4 * g) * 4) = (f32x4){part[ti][0], part[ti][1], part[ti][2], part[ti][3]}; }
                    __syncthreads();
                    if (tid < 64) { float s2 = 0.f;
#pragma unroll
                        for (int ww = 0; ww < 8; ++ww) s2 += ((const LAS float*)(lds + GL_SSQ))[ww * 64 + tid];
                        ((LAS float*)(lds + GL_RSTD))[tid] = 1.f / sqrtf(s2 * (1.f / 128.f) + 1e-6f); }
                    __syncthreads();
#pragma unroll
                    for (int ti = 0; ti < 4; ++ti) { const f32x4 rs = *(const LAS f32x4*)(lds + GL_RSTD + (16 * ti + 4 * g) * 4);
#pragma unroll
                        for (int r = 0; r < 4; ++r) *(LAS unsigned short*)(lds + GL_QT + (63 - (16 * ti + 4 * g + r)) * ON_STR + (16 * w + i16) * 2) = (unsigned short)f2bf(O[ti][r] * rs[r] * ngv * bf2f(gq[ti][r])); }
                    on_rb = rb;
                }
            }
            if (on_rb >= 0) { __syncthreads(); GLA_ON_FLUSH(); on_rb = -1; }
            asm volatile("s_waitcnt vmcnt(0)" ::: "memory");
            __syncthreads();
        }
    }
}

__device__ __forceinline__ void ph_modffn(const Params& p, unsigned char* lds, int bid, int nblk, int l) {
    int tid_ = threadIdx.x; asm volatile("" : "+v"(tid_));
    const int tid = tid_, lane = tid & 63, wave = tid >> 6;
    float* rw = (float*)lds;
    float* stg = (float*)(lds + 71680);
    const float* router = p.in[I_ROUTER] + (size_t)l * DM * NE;
    for (int i = tid; i < DM * NE / 4; i += NTHR) { const int d = i >> 2; *(f32x4*)(rw + d * 16 + (d >> 2) * 4 + (i & 3) * 4) = ((const f32x4*)router)[i]; }
    __syncthreads();
    const float* X = (const float*)(p.ws + WS_X); bf16_t* H = (bf16_t*)(p.ws + WS_H); float* aff = (float*)(p.ws + WS_AFF); int* slot = (int*)(p.ws + WS_SLOT);
    const float* g = p.in[I_NFFN] + (size_t)l * DM; const float* mod = (const float*)(p.ws + WS_MOD);
    for (int base = bid * 64; base < NTOK; base += nblk * 64) {
        const int b = base >> 13, t0 = base & (SEQ - 1);
        const float* mv = mod + (size_t)(l * 3 + b) * NADA; const float* sh = mv + 3 * DM; const float* sc = mv + 4 * DM;
        f32x4 nxv[4];
#pragma unroll
        for (int j = 0; j < 4; ++j) nxv[j] = *(const f32x4*)(X + (size_t)(base + 8 * wave) * DM + 256 * j + 4 * lane);
#pragma unroll 1
        for (int r = 0; r < 8; ++r) {
            const int row = base + 8 * wave + r;
            f32x4 v[4]; float ss = 0.f;
#pragma unroll
            for (int j = 0; j < 4; ++j) { v[j] = nxv[j]; ss += (v[j][0] * v[j][0] + v[j][1] * v[j][1]) + (v[j][2] * v[j][2] + v[j][3] * v[j][3]); }
            if (r < 7) {
#pragma unroll
                for (int j = 0; j < 4; ++j) nxv[j] = *(const f32x4*)(X + (size_t)(row + 1) * DM + 256 * j + 4 * lane); }
            const float rstd = 1.f / sqrtf(wave_sum(ss) * (1.f / DM) + 1e-6f);
            float lg[16];
#pragma unroll
            for (int e = 0; e < 16; ++e) lg[e] = 0.f;
#pragma unroll
            for (int j = 0; j < 4; ++j) { const int c0 = 256 * j + 4 * lane; const f32x4 gv = *(const f32x4*)(g + c0), shv = *(const f32x4*)(sh + c0), scv = *(const f32x4*)(sc + c0);
                f32x4 h;
#pragma unroll
                for (int i = 0; i < 4; ++i) { h[i] = (v[j][i] * rstd * gv[i]) * (1.f + scv[i]) + shv[i];
                    const float* rp = rw + (c0 + i) * 16 + (c0 >> 2) * 4; const f32x4 r0 = *(const f32x4*)(rp), r1 = *(const f32x4*)(rp + 4), r2 = *(const f32x4*)(rp + 8), r3 = *(const f32x4*)(rp + 12);
#pragma unroll
                    for (int e = 0; e < 4; ++e) { lg[e] += h[i] * r0[e]; lg[4 + e] += h[i] * r1[e]; lg[8 + e] += h[i] * r2[e]; lg[12 + e] += h[i] * r3[e]; }
                    asm volatile("" ::: "memory"); }
                u32x2 w; w.x = pk2(h[0], h[1]); w.y = pk2(h[2], h[3]); *(u32x2*)(H + (size_t)row * DM + c0) = w; }
            float a8[8], a4[4], a2[2], a1;
#pragma unroll
            for (int i = 0; i < 8; ++i) a8[i] = swap32_add(lg[i], lg[8 + i]);
#pragma unroll
            for (int i = 0; i < 4; ++i) a4[i] = swap16_add(a8[i], a8[4 + i]);
            { const bool hi = (lane & 8) != 0;
#pragma unroll
                for (int i = 0; i < 2; ++i) { const float send = hi ? a4[i] : a4[2 + i], keep = hi ? a4[2 + i] : a4[i]; a2[i] = keep + lane_xor8(send); } }
            { const bool hi = (lane & 4) != 0; const float send = hi ? a2[0] : a2[1], keep = hi ? a2[1] : a2[0]; a1 = keep + lane_xor4(send); }
            a1 += dpp_f<0x4E>(a1); a1 += dpp_f<0xB1>(a1);
            float mx = a1;
            mx = fmaxf(mx, lane_xor4(mx)); mx = fmaxf(mx, lane_xor8(mx)); mx = swap16_max(mx); mx = swap32_max(mx);
            const float ex = expf(a1 - mx); float den = ex;
            den += lane_xor4(den); den += lane_xor8(den); den = swap16_add(den, den); den = swap32_add(den, den);
            if ((lane & 3) == 0) stg[((lane >> 2) & 15) * 64 + 8 * wave + r] = ex / den;
        }
        __syncthreads();
        { const int e = tid >> 5, tt = (tid & 31) * 2; *(f32x2*)(aff + (size_t)(b * NE + e) * SEQ + t0 + tt) = *(const f32x2*)(stg + e * 64 + tt);
            *(u32x2*)(slot + (size_t)base * NE + 2 * tid) = (u32x2){0xffffffffu, 0xffffffffu}; }
        __syncthreads();
    }
}

__device__ __forceinline__ void ph_topk(const Params& p, unsigned char* lds, int bid, int nblk) {
    int tid_ = threadIdx.x; asm volatile("" : "+v"(tid_)); const int tid = tid_, lane = tid & 63, wave = tid >> 6;
    unsigned* hist = (unsigned*)lds;
    unsigned* ctl = hist + 256;
    unsigned* wsum = ctl + 8;
    const float* aff = (const float*)(p.ws + WS_AFF); int* topi = (int*)(p.ws + WS_TOPI); float* topg = (float*)(p.ws + WS_TOPG); int* slot = (int*)(p.ws + WS_SLOT);
    for (int it = bid; it < NB * NE; it += nblk) {
        const int b = it >> 4, e = it & 15; const float* src = aff + (size_t)it * SEQ + 16 * tid;
        unsigned key[16];
#pragma unroll
        for (int j = 0; j < 4; ++j) { const f32x4 v = *(const f32x4*)(src + 4 * j); key[4 * j] = __float_as_uint(v[0]); key[4 * j + 1] = __float_as_uint(v[1]); key[4 * j + 2] = __float_as_uint(v[2]); key[4 * j + 3] = __float_as_uint(v[3]); }
        unsigned prefix = 0u;
#pragma unroll 1
        for (int bit = 30; bit >= 0; --bit) {
            const unsigned cand = prefix | (1u << bit);
            unsigned cnt = 0u;
#pragma unroll
            for (int i = 0; i < 16; ++i) cnt += (unsigned)__popcll(__ballot(key[i] >= cand));
            if (lane == 0) wsum[(bit & 1) * 8 + wave] = cnt;
            __syncthreads();
            unsigned tot = 0u;
#pragma unroll
            for (int w2 = 0; w2 < 8; ++w2) tot += wsum[(bit & 1) * 8 + w2];
            if (tot >= (unsigned)CAP) prefix = cand;
        }
        __syncthreads();
        unsigned cg = 0u, ce = 0u;
#pragma unroll
        for (int i = 0; i < 16; ++i) { cg += key[i] > prefix ? 1u : 0u; ce += key[i] == prefix ? 1u : 0u; }
        unsigned pk = cg | (ce << 16), inc = pk;
#pragma unroll
        for (int o = 1; o < 64; o <<= 1) { const unsigned t = __shfl_up(inc, o); if (lane >= o) inc += t; }
        if (lane == 63) wsum[wave] = inc;
        __syncthreads();
        unsigned base = 0u, total = 0u;
#pragma unroll
        for (int w2 = 0; w2 < 8; ++w2) { const unsigned t = wsum[w2]; if (w2 < wave) base += t; total += t; }
        const unsigned excl = base + inc - pk;
        unsigned rg = excl & 0xffffu, re = excl >> 16; const unsigned ngt = total & 0xffffu, kth = (unsigned)CAP - ngt;
#pragma unroll
        for (int i = 0; i < 16; ++i) { int s = -1;
            if (key[i] > prefix) { s = (int)rg; ++rg; }
            else if (key[i] == prefix) { if (re < kth) s = (int)(ngt + re); ++re; }
            if (s >= 0) { const int idx = 16 * tid + i, r = (e * NB + b) * CAP + s; topi[r] = b * SEQ + idx; topg[r] = __uint_as_float(key[i]); slot[(size_t)(b * SEQ + idx) * NE + e] = s; } }
        __syncthreads();
    }
}

__device__ __forceinline__ void ph_combine(const Params& p, int bid, int nblk, int l, bool final_) {
    int tid_ = threadIdx.x; asm volatile("" : "+v"(tid_));
    const int tid = tid_, lane = tid & 63, wave = tid >> 6, gw = bid * 8 + wave, NGW = nblk * 8;
    float* X = (float*)(p.ws + WS_X); bf16_t* H = (bf16_t*)(p.ws + WS_H); const bf16_t* Y = (const bf16_t*)(p.ws + WS_Y); const int* slot = (const int*)(p.ws + WS_SLOT); const float* topg = (const float*)(p.ws + WS_TOPG);
    const float* mod = (const float*)(p.ws + WS_MOD);
    int nslot = -1; f32x4 nxv[4];
    if (gw < NTOK) { nslot = lane < 16 ? slot[(size_t)gw * NE + lane] : -1;
#pragma unroll
        for (int j = 0; j < 4; ++j) nxv[j] = *(const f32x4*)(X + (size_t)gw * DM + 256 * j + 4 * lane); }
    for (int row = gw; row < NTOK; row += NGW) {
        const int b = row >> 13;
        const float* g2 = mod + (size_t)(l * 3 + b) * NADA + 5 * DM;
        const int myslot = nslot; f32x4 xv[4];
#pragma unroll
        for (int j = 0; j < 4; ++j) xv[j] = nxv[j];
        unsigned long long m = __ballot(myslot >= 0) & 0xffffull;
        f32x4 a[4];
#pragma unroll
        for (int j = 0; j < 4; ++j) a[j] = (f32x4){0.f, 0.f, 0.f, 0.f};
        u32x2 ya[4], yb[4];
#define YLOAD(dst, gdst, e_) do { const int s_ = __shfl(myslot, (e_)); const size_t yrow_ = (size_t)(((e_) * NB + b) * CAP + s_); const bf16_t* yr_ = Y + yrow_ * DM; gdst = topg[yrow_]; \
            _Pragma("unroll") for (int j = 0; j < 4; ++j) dst[j] = *(const u32x2*)(yr_ + 256 * j + 4 * lane); } while (0)
        float ga = 0.f, gb = 0.f;
        if (m) { const int e0 = __builtin_ctzll(m); m &= m - 1; YLOAD(ya, ga, e0); }
        const bool any = __ballot(myslot >= 0) & 0xffffull;
        { const int r2 = row + NGW; if (r2 < NTOK) { nslot = lane < 16 ? slot[(size_t)r2 * NE + lane] : -1;
#pragma unroll
            for (int j = 0; j < 4; ++j) nxv[j] = *(const f32x4*)(X + (size_t)r2 * DM + 256 * j + 4 * lane); } }
        if (any) for (;;) {
            const bool more = m != 0ull;
            if (more) { const int e1 = __builtin_ctzll(m); m &= m - 1; YLOAD(yb, gb, e1); }
#pragma unroll
            for (int j = 0; j < 4; ++j) { a[j][0] += ga * __uint_as_float(ya[j].x << 16); a[j][1] += ga * __uint_as_float(ya[j].x & 0xffff0000u); a[j][2] += ga * __uint_as_float(ya[j].y << 16); a[j][3] += ga * __uint_as_float(ya[j].y & 0xffff0000u); }
            if (!more) break;
            ga = gb;
#pragma unroll
            for (int j = 0; j < 4; ++j) ya[j] = yb[j];
        }
#undef YLOAD
        f32x4 v[4]; float ss = 0.f;
#pragma unroll
        for (int j = 0; j < 4; ++j) { const int c0 = 256 * j + 4 * lane; v[j] = xv[j] + *(const f32x4*)(g2 + c0) * a[j];
            ss += (v[j][0] * v[j][0] + v[j][1] * v[j][1]) + (v[j][2] * v[j][2] + v[j][3] * v[j][3]); }
        const float rstd = 1.f / sqrtf(wave_sum(ss) * (1.f / DM) + 1e-6f);
        if (final_) { const float* gf = p.in[I_NFIN];
#pragma unroll
            for (int j = 0; j < 4; ++j) { const int c0 = 256 * j + 4 * lane; const f32x4 gv = *(const f32x4*)(gf + c0); *(f32x4*)(p.out + (size_t)row * DM + c0) = v[j] * rstd * gv; }
        } else {
#pragma unroll
            for (int j = 0; j < 4; ++j) *(f32x4*)(X + (size_t)row * DM + 256 * j + 4 * lane) = v[j];
            const float* mv = mod + (size_t)((l + 1) * 3 + b) * NADA;
            store_mod_bf16(H + (size_t)row * DM, v, rstd, p.in[I_NMIX] + (size_t)(l + 1) * DM, mv, mv + DM, lane);
        }
    }
}

__device__ __forceinline__ void ph_conv(const Params& p, int bid, int nblk) {
    int tid_ = threadIdx.x; asm volatile("" : "+v"(tid_));
    const int tid = tid_, lane = tid & 63, wave = tid >> 6, gw = bid * 8 + wave, NGW = nblk * 8;
    const bf16_t* BG = (const bf16_t*)(p.ws + WS_BG); const bf16_t* CU = (const bf16_t*)(p.ws + WS_CU); bf16_t* Z = (bf16_t*)(p.ws + WS_Z);
    const float* wc = p.in[I_SCCONV];
    for (int row = gw; row < NTOK; row += NGW) { const int t = row & (SEQ - 1);
#pragma unroll
        for (int hh = 0; hh < 2; ++hh) { const int c0 = hh * 512 + 8 * lane; const size_t off = (size_t)row * DM + c0;
            const u16x8 z0 = {0, 0, 0, 0, 0, 0, 0, 0};
            const u16x8 um = t > 0 ? *(const u16x8*)(CU + off - DM) : z0, u0 = *(const u16x8*)(CU + off), up = t < SEQ - 1 ? *(const u16x8*)(CU + off + DM) : z0, bg = *(const u16x8*)(BG + off);
            float o[8];
#pragma unroll
            for (int i = 0; i < 8; ++i) o[i] = bf2f(bg[i]) * (wc[c0 + i] * bf2f(um[i]) + wc[DM + c0 + i] * bf2f(u0[i]) + wc[2 * DM + c0 + i] * bf2f(up[i]));
            u32x4 w; w.x = pk2(o[0], o[1]); w.y = pk2(o[2], o[3]); w.z = pk2(o[4], o[5]); w.w = pk2(o[6], o[7]); *(u32x4*)(Z + off) = w; }
    }
}

#define XB_TMO      128
#define XB_XCNT(j)  (256  + 64 * (j))
#define XB_XSUB(j)  (1280 + 64 * (j))
#define XB_XGEN(j)  (2304 + 64 * (j))
#define XB_TOP      3328
#define XB_TOPGEN   3392
#define XCD_BAR_WORDS 3456
#define XB_SPIN_CAP (1u << 18)
__device__ __forceinline__ unsigned xb_ld(unsigned* p)              { return __hip_atomic_load(p, __ATOMIC_RELAXED, __HIP_MEMORY_SCOPE_AGENT); }
__device__ __forceinline__ unsigned xb_add(unsigned* p, unsigned v) { return __hip_atomic_fetch_add(p, v, __ATOMIC_RELAXED, __HIP_MEMORY_SCOPE_AGENT); }
__device__ __forceinline__ unsigned xb_xcc_id() { return (unsigned)__builtin_amdgcn_s_getreg((3 << 11) | 20) & 0xFu; }
#define XB_SPIN(cond, bar) do { unsigned _sp = 0; while (cond) { __builtin_amdgcn_s_sleep(1); \
    if ((++_sp & 255u) == 0u) { if (xb_ld(&(bar)[XB_TMO])) break; if (_sp > XB_SPIN_CAP) { atomicAdd(&(bar)[XB_TMO], 1u); break; } } } } while (0)
struct XcdBarrier { unsigned* bar; unsigned x; volatile LAS unsigned* st; };
__device__ __forceinline__ XcdBarrier xcd_barrier_post(unsigned* bar, volatile LAS unsigned* st) {
    XcdBarrier b; b.bar = bar; b.x = xb_xcc_id(); b.st = st;
    if (threadIdx.x == 0) (void)xb_add(&bar[XB_XCNT(b.x)], 1u);
    return b;
}
__device__ __forceinline__ void xcd_barrier_complete(unsigned* bar, unsigned x, unsigned& nloc, unsigned& nx) {
    const unsigned G = gridDim.x * gridDim.y * gridDim.z;
    unsigned sum, cnt, mine, sp = 0u;
    for (;;) {
        sum = 0u; cnt = 0u; mine = 0u;
#pragma unroll
        for (unsigned j = 0; j < 16; ++j) { const unsigned c = xb_ld(&bar[XB_XCNT(j)]); sum += c; cnt += (c > 0u) ? 1u : 0u; mine = (j == x) ? c : mine; }
        if (sum == G) break;
        __builtin_amdgcn_s_sleep(1);
        if ((++sp & 255u) == 0u) { if (xb_ld(&bar[XB_TMO])) break; if (sp > XB_SPIN_CAP) { atomicAdd(&bar[XB_TMO], 1u); break; } }
    }
    nloc = mine > 0u ? mine : 1u; nx = cnt > 0u ? cnt : 1u;
}
__device__ __forceinline__ void xcd_barrier(const Params& p, unsigned char* lds, unsigned* bar_, volatile LAS unsigned* MISC, unsigned filler) {
    volatile LAS unsigned* st_ = MISC + 8;
    XcdBarrier b; b.bar = bar_; b.x = xb_xcc_id(); b.st = st_;
    asm volatile("s_waitcnt vmcnt(0)" ::: "memory");
    __syncthreads();
    unsigned target = 0u;
    if (threadIdx.x == 0) {
        unsigned* bar = b.bar;
        __builtin_amdgcn_s_waitcnt(0);
        unsigned nloc = b.st[0], nx = b.st[1];
        if (nloc == 0u) { xcd_barrier_complete(bar, b.x, nloc, nx); b.st[0] = nloc; b.st[1] = nx; }
        const unsigned epoch = b.st[2] + 1u; b.st[2] = epoch;
        const unsigned old = xb_add(&bar[XB_XSUB(b.x)], 1u);
        if (old + 1u == epoch * nloc) {
            __builtin_amdgcn_fence(__ATOMIC_RELEASE, "agent");
            asm volatile("s_waitcnt vmcnt(0)" ::: "memory");
            (void)xb_add(&bar[XB_TOP], 1u);
        }
        target = epoch * nx;
    }
    if (filler) {
        for (;;) {
            if (threadIdx.x == 0) MISC[MW_REL] = (xb_ld(&b.bar[XB_TOP]) >= target || xb_ld(&b.bar[XB_TMO])) ? 1u : 0u;
            __syncthreads();
            const unsigned rel = MISC[MW_REL];
            __syncthreads();
            if (rel) break;
            if (!cvt_batch(p, lds, MISC, filler)) break;
        }
    }
    if (threadIdx.x == 0) {
        XB_SPIN(xb_ld(&b.bar[XB_TOP]) < target, b.bar);
        __builtin_amdgcn_fence(__ATOMIC_ACQUIRE, "agent");
        asm volatile("s_waitcnt vmcnt(0)" ::: "memory");
    }
    __syncthreads();
}

constexpr int NPHASE = 19;
constexpr int CVB_P2 = 2, CVB_P8 = 4;
constexpr int MISC_OFF = 146944;
constexpr int CW_BAR = 4096;
constexpr int CW_CTX = 1024;
template <int LO, int HI> __global__ void __launch_bounds__(NTHR, 2) mega(Params p) {
    extern __shared__ __attribute__((aligned(16))) unsigned char lds[];
    const int bid = blockIdx.x, nblk = gridDim.x;
    PG8_LAS unsigned char* l3 = (PG8_LAS unsigned char*)lds;
    unsigned char* ws = p.ws;
    const float* mod = (const float*)(ws + WS_MOD);
    constexpr bool MULTI = (HI - LO) > 1;
    if (MULTI) {
        volatile LAS unsigned* MISC = (volatile LAS unsigned*)(l3 + MISC_OFF);
        if (threadIdx.x < 32) MISC[threadIdx.x] = 0u;
        __syncthreads();
        (void)xcd_barrier_post((unsigned*)(ws + WS_CTL) + CW_BAR, MISC + 8);
    }
#define IN(k) (LO <= (k) && (k) < HI)
#ifndef PROBE_DUP
#define PROBE_DUP 0u
#endif
#define DUPQ(k) (((PROBE_DUP) >> (k)) & 1u)
#define MISCP ((volatile LAS unsigned*)(l3 + MISC_OFF))
#define BARRIER_MASK(m) xcd_barrier(p, lds, (unsigned*)(p.ws + WS_CTL) + CW_BAR, MISCP, (m))
#define BARRIER_NOW() BARRIER_MASK(0u)
#define SEAM(k) do { if (IN(k) && IN((k) + 1)) BARRIER_MASK(((k) <= 7 ? 1u : 0u) | ((k) <= 15 ? 2u : 0u)); } while (0)
#define PHASE(k, ...) do { if (IN(k)) { __VA_ARGS__; if (DUPQ(k)) { BARRIER_NOW(); __VA_ARGS__; } } SEAM(k); } while (0)
#define GEMM_INPROJ() do { pg8::Gemm g{(const bf16_t*)(ws + WS_H), (const bf16_t*)(ws + WS_WHGIN), NTOK, 5120, DM}; pg8::StaticOrder S; S.init(NTOK, 5120, nblk, bid, 0); EpiInProj E{ws}; pg8::gemm_phase<EpiInProj, pg8::StaticOrder, false>(l3, g, S, E, nullptr); } while (0)
#define GEMM_OUT(AOFF, WOFF, GATE) do { pg8::Gemm g{(const bf16_t*)(ws + (AOFF)), (const bf16_t*)(ws + (WOFF)), NTOK, DM, DM}; pg8::StaticOrder S; S.init(NTOK, DM, nblk, bid, 0); EpiResid E{(float*)(ws + WS_X), (GATE)}; pg8::gemm_phase<EpiResid, pg8::StaticOrder, false>(l3, g, S, E, nullptr); } while (0)
#define GEMM_MOE1(l) do { pg8::Gemm g{(const bf16_t*)(ws + WS_H), (const bf16_t*)(ws + WS_WMOE1) + (size_t)(l) * NE * 4096 * DM, NSLOT, 4096, DM}; pg8::StaticOrder S; S.init(NSLOT, 4096, nblk, bid, 8); EpiGLU E{(bf16_t*)(ws + WS_ACT)}; pg8::gemm_phase<EpiGLU, pg8::StaticOrder, true>(l3, g, S, E, (const int*)(ws + WS_TOPI)); } while (0)
#define GEMM_MOE2(l) do { pg8::Gemm g{(const bf16_t*)(ws + WS_ACT), (const bf16_t*)(ws + WS_WMOE2) + (size_t)(l) * NE * DM * DE, NSLOT, DM, DE}; pg8::StaticOrder S; S.init(NSLOT, DM, nblk, bid, 8); EpiRowScale E{(bf16_t*)(ws + WS_Y), (const float*)(ws + WS_TOPG)}; pg8::gemm_phase<EpiRowScale, pg8::StaticOrder, false>(l3, g, S, E, nullptr); } while (0)
#define GEMM_CONVIN() do { pg8::Gemm g{(const bf16_t*)(ws + WS_H), (const bf16_t*)(ws + WS_WSCIN), NTOK, 3072, DM}; pg8::StaticOrder S; S.init(NTOK, 3072, nblk, bid, 0); EpiConvIn E{(bf16_t*)(ws + WS_BG), (bf16_t*)(ws + WS_CU)}; pg8::gemm_phase<EpiConvIn, pg8::StaticOrder, false>(l3, g, S, E, nullptr); } while (0)
#define MOD0_PHASE() do { if (nblk >= 48) { if (bid < 24) { ph_mod0(p, NTOK + (bid * NCTX) / 24, NTOK + ((bid + 1) * NCTX) / 24, 0, 1); \
              \
            asm volatile("s_waitcnt vmcnt(0)" ::: "memory"); __syncthreads(); \
            if (threadIdx.x == 0) { unsigned* cnt = (unsigned*)(p.ws + WS_CTL) + CW_CTX; __builtin_amdgcn_fence(__ATOMIC_RELEASE, "agent"); asm volatile("s_waitcnt vmcnt(0)" ::: "memory"); \
                xb_add(cnt, 1u); unsigned sp_ = 0u; while (xb_ld(cnt) < 24u) { __builtin_amdgcn_s_sleep(1); if (++sp_ > (1u << 22)) break; } \
                __builtin_amdgcn_fence(__ATOMIC_ACQUIRE, "agent"); asm volatile("s_waitcnt vmcnt(0)" ::: "memory"); } \
            __syncthreads(); \
            pg8::Gemm g{(const bf16_t*)(ws + WS_H), (const bf16_t*)(ws + WS_WHGIN), NROW, 5120, DM}; pg8::OneUnit S{64 + bid / 12, 4 + bid % 12}; EpiInProj E{ws}; pg8::gemm_phase<EpiInProj, pg8::OneUnit, false>(l3, g, S, E, nullptr); } \
          else ph_mod0(p, 0, NTOK, bid - 24, nblk - 24); } \
        else { ph_mod0(p, 0, NROW, bid, nblk); } } while (0)
#define CTX_TILES_FALLBACK() do { if (nblk < 48) { BARRIER_NOW(); pg8::Gemm g{(const bf16_t*)(ws + WS_H), (const bf16_t*)(ws + WS_WHGIN), NROW, 5120, DM}; \
        for (int ti = bid; ti < 24; ti += nblk) { pg8::OneUnit S{64 + ti / 12, 4 + ti % 12}; EpiInProj E{ws}; pg8::gemm_phase<EpiInProj, pg8::OneUnit, false>(l3, g, S, E, nullptr); } } } while (0)
    PHASE(0, ph_prep(p, lds, bid, nblk); __syncthreads(); ph_convert_small(p, lds, bid, nblk));
    if (IN(1)) { MOD0_PHASE(); CTX_TILES_FALLBACK(); }
    SEAM(1);
#define HOSTED(GEMM_RANGE, NR, NBATCH) do { const bool odd_ = (bid & 1) != 0; \
        if (odd_) cvt_budget(p, lds, MISCP, 3u, NBATCH); \
        GEMM_RANGE(0, NR); __syncthreads(); \
        if (!odd_) cvt_budget(p, lds, MISCP, 3u, NBATCH); } while (0)
#define GEMM_INPROJ_R(LO_, HI_) do { pg8::Gemm g{(const bf16_t*)(ws + WS_H), (const bf16_t*)(ws + WS_WHGIN), NTOK, 5120, DM}; pg8::RangeOrder S; S.S.init(NTOK, 5120, nblk, bid, 0); S.lo = (LO_); S.hi = (HI_); EpiInProj E{ws}; pg8::gemm_phase<EpiInProj, pg8::RangeOrder, false>(l3, g, S, E, nullptr); } while (0)
#define GEMM_MOE1_R0(LO_, HI_) do { pg8::Gemm g{(const bf16_t*)(ws + WS_H), (const bf16_t*)(ws + WS_WMOE1), NSLOT, 4096, DM}; pg8::RangeOrder S; S.S.init(NSLOT, 4096, nblk, bid, 8); S.lo = (LO_); S.hi = (HI_); EpiGLU E{(bf16_t*)(ws + WS_ACT)}; pg8::gemm_phase<EpiGLU, pg8::RangeOrder, true>(l3, g, S, E, (const int*)(ws + WS_TOPI)); } while (0)
    PHASE(2, HOSTED(GEMM_INPROJ_R, 5, CVB_P2));
    PHASE(3, ph_gla_states(p, lds, bid, nblk));
    PHASE(4, ph_gla_out(p, lds, bid, nblk));
    if (IN(5)) GEMM_OUT(WS_ON, WS_WHGOUT, mod + 2 * DM);
    SEAM(5);
    PHASE(6, ph_modffn(p, lds, bid, nblk, 0));
    PHASE(7, ph_topk(p, lds, bid, nblk); __syncthreads(); cvt_drain_until(p, lds, MISCP, 0, 32768u));
    PHASE(8, HOSTED(GEMM_MOE1_R0, 8, CVB_P8); cvt_drain_until(p, lds, MISCP, 0, (unsigned)CV_ITEMS));
    PHASE(9, GEMM_MOE2(0));
    if (IN(10)) ph_combine(p, bid, nblk, 0, false);
    SEAM(10);
    PHASE(11, GEMM_CONVIN());
    PHASE(12, ph_conv(p, bid, nblk));
    if (IN(13)) GEMM_OUT(WS_Z, WS_WSCOUT, mod + (size_t)3 * NADA + 2 * DM);
    SEAM(13);
    PHASE(14, ph_modffn(p, lds, bid, nblk, 1));
    PHASE(15, ph_topk(p, lds, bid, nblk); __syncthreads(); cvt_drain_until(p, lds, MISCP, 1, 32768u));
    PHASE(16, GEMM_MOE1(1); __syncthreads(); cvt_drain_until(p, lds, MISCP, 1, (unsigned)CV_ITEMS));
    PHASE(17, GEMM_MOE2(1));
    if (IN(18)) ph_combine(p, bid, nblk, 1, true);
#undef IN
#undef SEAM
}

#ifndef MK_SPLIT
#define MK_SPLIT 0
#endif
#if MK_SPLIT
#include <utility>
template <int... I> static void launch_all(std::integer_sequence<int, I...>, int grid, Params& p, hipStream_t stream) {
    ((void)hipFuncSetAttribute((const void*)mega<I, I + 1>, hipFuncAttributeMaxDynamicSharedMemorySize, LDS_BYTES), ...);
    ((mega<I, I + 1><<<dim3(grid), dim3(NTHR), LDS_BYTES, stream>>>(p)), ...); }
#endif
extern "C" void kernel_launch(void* const* d_in, const int* in_sizes, int n_in, void* d_out, int out_size, void* d_ws, size_t ws_size, hipStream_t stream) {
    static int grid = 0;
    if (grid == 0) {
        if (n_in != 20 || ws_size < WS_END) { fprintf(stderr, "kernel_launch: unexpected inputs (n_in %d, ws %zu, need %zu)\n", n_in, ws_size, (size_t)WS_END); grid = -1; return; }
        int dev = 0, cus = 0, per_cu = 0;
        (void)hipGetDevice(&dev); (void)hipDeviceGetAttribute(&cus, hipDeviceAttributeMultiprocessorCount, dev);
        (void)hipFuncSetAttribute((const void*)mega<0, NPHASE>, hipFuncAttributeMaxDynamicSharedMemorySize, LDS_BYTES);
        if (hipOccupancyMaxActiveBlocksPerMultiprocessor(&per_cu, (const void*)mega<0, NPHASE>, NTHR, LDS_BYTES) != hipSuccess || per_cu < 1) { fprintf(stderr, "kernel_launch: occupancy query failed (%d)\n", per_cu); per_cu = 1; }
        (void)hipGetLastError();
        if (per_cu > 1) per_cu = 1;
        grid = (cus > 0 ? cus : 256) * per_cu;
    }
    if (grid < 0) return;
    Params p{};
    for (int i = 0; i < 20; ++i) p.in[i] = (const float*)d_in[i];
    p.out = (float*)d_out; p.ws = (unsigned char*)d_ws;
#if MK_SPLIT
    launch_all(std::make_integer_sequence<int, NPHASE>{}, grid, p, stream);
#else
    (void)hipMemsetAsync((char*)d_ws + WS_CTL, 0, 65536, stream);
    void* args[] = {&p};
    hipError_t e = hipLaunchCooperativeKernel((const void*)mega<0, NPHASE>, dim3(grid), dim3(NTHR), args, LDS_BYTES, stream);
    if (e != hipSuccess) fprintf(stderr, "kernel_launch: cooperative launch failed: %s (grid %d)\n", hipGetErrorString(e), grid);
#endif
}
```

```cpp
#include <hip/hip_runtime.h>
#include <cstdio>
#include <cstdint>

namespace pg8 {
#define PG8_LAS __attribute__((address_space(3)))
typedef unsigned short bf16_t;
typedef short bf16x8 __attribute__((ext_vector_type(8)));
typedef float f32x4 __attribute__((ext_vector_type(4)));
typedef unsigned u32x4 __attribute__((ext_vector_type(4)));
typedef unsigned u32x2 __attribute__((ext_vector_type(2)));
constexpr int BM = 256, BK = 64, HALF = 128, HTB = HALF * BK * 2, STAGE_BYTES = 8 * HTB, NXCD = 8, WGM = 8;

__host__ __device__ __forceinline__ int lds_byte(int r, int c) { const int st = (r >> 4) * 2 + (c >> 5), rr = r & 15, cc = c & 31, ob = rr * 64 + cc * 2; return st * 1024 + (ob ^ (((ob >> 9) & 1) << 5)); }
__host__ __device__ __forceinline__ void stage_rc(int b, int& R, int& C) { const int st = b / 1024, sb = b % 1024, swz = sb ^ (((sb >> 9) & 1) << 5); R = (st >> 1) * 16 + swz / 64; C = (st & 1) * 32 + (swz % 64) / 2; }
__host__ __device__ __forceinline__ int perm32(int rho) { const int n = rho >> 4, i = rho & 15; return 8 * (i >> 2) + 4 * n + (i & 3); }

struct Unit { int pm, pn, pb; };
struct Gemm { const bf16_t* A; const bf16_t* Bt; int M, N, K; };

struct StaticOrder {
    int nM, nN, nwg, G, c, mpe;
    __device__ void init(int M, int N, int G_, int c_, int mpe_) { nM = M / BM; nN = N / BM; nwg = nM * nN; G = G_; c = c_; mpe = mpe_; }
    __device__ bool next(int i, Unit& u) const {
        const long L = (long)i * G + c; if (L >= nwg) return false;
        int wgid = (int)L; { const int q = nwg / NXCD, r = nwg % NXCD, xcd = wgid % NXCD, off = wgid / NXCD; wgid = (xcd < r ? xcd * (q + 1) : r * (q + 1) + (xcd - r) * q) + off; }
        const int nig = WGM * nN, gid = wgid / nig, fm = gid * WGM, gsz = (nM - fm) < WGM ? (nM - fm) : WGM;
        u.pm = fm + ((wgid % nig) % gsz); u.pn = (wgid % nig) / gsz; u.pb = mpe > 0 ? (u.pm / mpe) * nN + u.pn : u.pn; return true;
    }
};

__device__ __forceinline__ unsigned cvt_pk_bf16(float lo, float hi) { unsigned r; asm volatile("v_cvt_pk_bf16_f32 %0, %1, %2" : "=v"(r) : "v"(lo), "v"(hi)); return r; }

struct RangeOrder {
    StaticOrder S; int lo, hi;
    __device__ bool next(int i, Unit& u) const { return (lo + i < hi) ? S.next(lo + i, u) : false; }
};
struct OneUnit {
    int pm, pn;
    __device__ bool next(int i, Unit& u) const { if (i != 0) return false; u.pm = pm; u.pn = pn; u.pb = pn; return true; }
};
template <class Epi, class Sched, bool GATHER>
__device__ __forceinline__ void gemm_phase(PG8_LAS unsigned char* lds, const Gemm g, const Sched& S, const Epi& E, const int* gidx) {
    int tid_ = threadIdx.x; asm volatile("" : "+v"(tid_));
    const int tid = tid_, wid = __builtin_amdgcn_readfirstlane(tid >> 6), lane = tid & 63, wr = wid >> 2, wc = wid & 3, fr = lane & 15, fq = lane >> 4;
    const int K = g.K, nt = K / BK;
    unsigned voffA[2], voffB[2]; int rA[2], cA2[2];
#pragma unroll
    for (int i = 0; i < 2; ++i) { int R, C; stage_rc(tid * 16 + i * 8192, R, C); const int Rb = Epi::PERM ? ((R & ~31) + perm32(R & 31)) : R;
        voffA[i] = (unsigned)(R * K + C) * 2u; voffB[i] = (unsigned)(Rb * K + C) * 2u; rA[i] = R; cA2[i] = C * 2; }
    unsigned gcur[2][2], gnxt[2][2];
#define PG8_GOFF(dst, u) do { _Pragma("unroll") for (int _h = 0; _h < 2; ++_h) _Pragma("unroll") for (int _i = 0; _i < 2; ++_i) \
        dst[_h][_i] = (unsigned)gidx[(u).pm * BM + _h * HALF + rA[_i]] * (unsigned)(K * 2) + (unsigned)cA2[_i]; } while (0)
    const size_t kstep = (size_t)(BK * 2);
    const size_t hstep = (size_t)HALF * K * 2;
    const size_t tstep = 2 * hstep;
    const unsigned ldsw = (unsigned)wid * 1024u;
    const int aoff = lds_byte(wr * 64 + fr, fq * 8), boff = lds_byte(wc * 32 + fr, fq * 8);
#define PG8_SA(b, h) (((b) * 2 + (h)) * HTB)
#define PG8_SB(b, h) ((4 + (b) * 2 + (h)) * HTB)
#define PG8_STAGE(bufoff, gbase, voff) do { _Pragma("unroll") for (int _i = 0; _i < 2; ++_i) \
        __builtin_amdgcn_global_load_lds((const unsigned*)((const char*)(gbase) + (voff)[_i]), (PG8_LAS unsigned*)(lds + (bufoff) + ldsw + _i * 8192), 16, 0, 0); } while (0)
#define PG8_STAGE_A(bufoff, half, kb, NX) do { _Pragma("unroll") for (int _i = 0; _i < 2; ++_i) { \
        const char* _src = GATHER ? (const char*)g.A + (kb) + ((NX) ? gnxt[half][_i] : gcur[half][_i]) : ((NX) ? nA : cA) + (size_t)(half) * hstep + (kb) + voffA[_i]; \
        __builtin_amdgcn_global_load_lds((const unsigned*)_src, (PG8_LAS unsigned*)(lds + (bufoff) + ldsw + _i * 8192), 16, 0, 0); } } while (0)
#define PG8_LDA(dst, b, h) do { _Pragma("unroll") for (int m = 0; m < 4; ++m) _Pragma("unroll") for (int k = 0; k < 2; ++k) dst[m][k] = *(const PG8_LAS bf16x8*)(lds + PG8_SA(b, h) + aoff + m * 2048 + k * 1024); } while (0)
#define PG8_LDB(dst, b, h) do { _Pragma("unroll") for (int n = 0; n < 2; ++n) _Pragma("unroll") for (int k = 0; k < 2; ++k) dst[n][k] = *(const PG8_LAS bf16x8*)(lds + PG8_SB(b, h) + boff + n * 2048 + k * 1024); } while (0)
#define PG8_MMA(ai, bj, At, Bt) do { __builtin_amdgcn_s_setprio(1); _Pragma("unroll") for (int m = 0; m < 4; ++m) _Pragma("unroll") for (int n = 0; n < 2; ++n) _Pragma("unroll") for (int k = 0; k < 2; ++k) \
        acc[ai][bj][m][n] = __builtin_amdgcn_mfma_f32_16x16x32_bf16(Bt[n][k], At[m][k], acc[ai][bj][m][n], 0, 0, 0); __builtin_amdgcn_s_setprio(0); } while (0)
#define PG8_WAIT_V(n) asm volatile("s_waitcnt vmcnt(" #n ")" ::: "memory")
#define PG8_WAIT_L(n) asm volatile("s_waitcnt lgkmcnt(" #n ")" ::: "memory")
#define PG8_BAR __builtin_amdgcn_s_barrier()
#define PG8_SCHED __builtin_amdgcn_sched_barrier(0)
    Unit cur, nxt; int ui = 0;
    if (!S.next(0, cur)) return;
    f32x4 acc[2][2][4][2];
#pragma unroll
    for (int a = 0; a < 2; ++a)
#pragma unroll
        for (int b = 0; b < 2; ++b)
#pragma unroll
            for (int m = 0; m < 4; ++m)
#pragma unroll
                for (int n = 0; n < 2; ++n) acc[a][b][m][n] = (f32x4){0.f, 0.f, 0.f, 0.f};
    bf16x8 At[4][2], B0[2][2], B1[2][2];
    const char* cA = GATHER ? (const char*)g.A : (const char*)g.A + (size_t)cur.pm * tstep; const char* cB = (const char*)g.Bt + (size_t)cur.pb * tstep; const char* nA = cA;
    if (GATHER) { PG8_GOFF(gcur, cur); }
    PG8_STAGE(PG8_SB(0, 0), cB, voffB); PG8_STAGE(PG8_SB(0, 1), cB + hstep, voffB); PG8_STAGE_A(PG8_SA(0, 0), 0, 0, false); PG8_STAGE_A(PG8_SA(0, 1), 1, 0, false);
    if (wr == 1) PG8_BAR;
    PG8_WAIT_V(2); PG8_BAR;
    PG8_STAGE(PG8_SB(1, 0), cB + kstep, voffB); PG8_STAGE_A(PG8_SA(1, 0), 0, kstep, false); PG8_STAGE(PG8_SB(1, 1), cB + hstep + kstep, voffB);
    PG8_WAIT_V(6); PG8_BAR;
    for (;;) {
        const bool has_next = S.next(ui + 1, nxt);
        nA = GATHER ? cA : (has_next ? (const char*)g.A + (size_t)nxt.pm * tstep : cA); const char* nB = has_next ? (const char*)g.Bt + (size_t)nxt.pb * tstep : cB;
        if (GATHER) { if (has_next) { PG8_GOFF(gnxt, nxt); } else {
#pragma unroll
            for (int _h = 0; _h < 2; ++_h)
#pragma unroll
                for (int _i = 0; _i < 2; ++_i) gnxt[_h][_i] = gcur[_h][_i]; } }
        for (int t = 0; t < nt; t += 2) {
            const bool last = (t == nt - 2);
            const size_t k1 = (size_t)(t + 1) * kstep, k2 = last ? 0 : (size_t)(t + 2) * kstep, k3 = k2 + kstep;
            const char* b2 = last ? nB : cB + (size_t)(t + 2) * kstep; const char* b3 = b2 + kstep;
            PG8_LDB(B0, 0, 0); PG8_LDB(B1, 0, 1); PG8_SCHED; PG8_LDA(At, 0, 0); PG8_STAGE_A(PG8_SA(1, 1), 1, k1, false);
            PG8_WAIT_V(8); PG8_WAIT_L(0); PG8_BAR; PG8_MMA(0, 0, At, B0); PG8_MMA(0, 1, At, B1); PG8_BAR; PG8_SCHED;
            PG8_LDA(At, 0, 1); PG8_STAGE(PG8_SB(0, 0), b2, voffB); PG8_STAGE(PG8_SB(0, 1), b2 + hstep, voffB); PG8_STAGE_A(PG8_SA(0, 0), 0, k2, last);
            PG8_WAIT_V(8); PG8_WAIT_L(0); PG8_BAR; PG8_MMA(1, 0, At, B0); PG8_MMA(1, 1, At, B1); PG8_BAR; PG8_SCHED;
            PG8_LDB(B0, 1, 0); PG8_LDB(B1, 1, 1); PG8_SCHED; PG8_LDA(At, 1, 0); PG8_STAGE_A(PG8_SA(0, 1), 1, k2, last);
            PG8_WAIT_V(8); PG8_WAIT_L(0); PG8_BAR; PG8_MMA(0, 0, At, B0); PG8_MMA(0, 1, At, B1); PG8_BAR; PG8_SCHED;
            PG8_LDA(At, 1, 1); PG8_STAGE(PG8_SB(1, 0), b3, voffB); PG8_STAGE(PG8_SB(1, 1), b3 + hstep, voffB); PG8_STAGE_A(PG8_SA(1, 0), 0, k3, last);
            PG8_WAIT_V(8); PG8_WAIT_L(0); PG8_BAR; PG8_MMA(1, 0, At, B0); PG8_MMA(1, 1, At, B1); PG8_BAR; PG8_SCHED;
        }
        if (wr == 0) PG8_BAR;
        E(acc, cur, wr, wc, fr, fq);
        if (!has_next) break;
#pragma unroll
        for (int a = 0; a < 2; ++a)
#pragma unroll
            for (int b = 0; b < 2; ++b)
#pragma unroll
                for (int m = 0; m < 4; ++m)
#pragma unroll
                    for (int n = 0; n < 2; ++n) acc[a][b][m][n] = (f32x4){0.f, 0.f, 0.f, 0.f};
        cur = nxt; cA = nA; cB = nB; ++ui;
        if (GATHER) {
#pragma unroll
            for (int _h = 0; _h < 2; ++_h)
#pragma unroll
                for (int _i = 0; _i < 2; ++_i) gcur[_h][_i] = gnxt[_h][_i]; }
        if (wr == 1) PG8_BAR;
    }
    PG8_WAIT_V(0);
    PG8_BAR;
#undef PG8_SA
#undef PG8_SB
#undef PG8_STAGE
#undef PG8_STAGE_A
#undef PG8_GOFF
#undef PG8_LDA
#undef PG8_LDB
#undef PG8_MMA
#undef PG8_WAIT_V
#undef PG8_WAIT_L
#undef PG8_BAR
#undef PG8_SCHED
}
}

#define LAS __attribute__((address_space(3)))
using pg8::bf16_t; using pg8::f32x4; using pg8::u32x4; using pg8::u32x2;
typedef unsigned short u16x8 __attribute__((ext_vector_type(8)));
typedef float f32x2 __attribute__((ext_vector_type(2)));
typedef _Float16 h16x4 __attribute__((ext_vector_type(4)));

constexpr int DM = 1024, NB = 2, SEQ = 8192, NTOK = NB * SEQ, CTXL = 256, NCTX = NB * CTXL, NROW = NTOK + NCTX;
constexpr int NE = 16, CAP = 1024, DE = 2048, NSLOT = NE * NB * CAP;
constexpr int NADA = 6 * DM;
constexpr int NTHR = 512;

constexpr size_t MiB = 1u << 20;
constexpr size_t WS_CTL = 0;
constexpr size_t WS_MOD = 1 * MiB;
constexpr size_t WS_LB = WS_MOD + 256 * 1024;
constexpr size_t WS_POSR = WS_LB + 64 * 1024;
constexpr size_t WS_POSC = WS_POSR + 256 * 1024;
constexpr size_t WS_AFF = 2 * MiB;
constexpr size_t WS_TOPI = 3 * MiB;
constexpr size_t WS_TOPG = WS_TOPI + 128 * 1024;
constexpr size_t WS_SLOT = 4 * MiB;
constexpr size_t WS_WHGIN = 6 * MiB;
constexpr size_t WS_WHGOUT = 16 * MiB;
constexpr size_t WS_WSCIN = 18 * MiB;
constexpr size_t WS_WSCOUT = 24 * MiB;
constexpr size_t WS_WMOE1 = 26 * MiB;
constexpr size_t WS_WMOE2 = WS_WMOE1 + 256 * MiB;
constexpr size_t WS_X = WS_WMOE2 + 128 * MiB;
constexpr size_t WS_H = WS_X + 64 * MiB;
constexpr size_t WS_R = WS_H + 34 * MiB;
constexpr size_t WS_Q = WS_R;
constexpr size_t WS_V = WS_Q + 34 * MiB;
constexpr size_t WS_G = WS_V + 34 * MiB;
constexpr size_t WS_LF = WS_G + 34 * MiB;
constexpr size_t WS_LBK = WS_LF + 66 * MiB;
constexpr size_t WS_OF = WS_LBK + 66 * MiB;
constexpr size_t WS_OB = WS_OF + 64 * MiB;
constexpr size_t WS_U = WS_OB;
constexpr size_t WS_DD = WS_OB + 40 * MiB;
constexpr size_t WS_ON = WS_OB + 64 * MiB;
constexpr size_t WS_HG_END = WS_ON + 32 * MiB;
constexpr size_t WS_XG = WS_R;
constexpr size_t WS_ACT = WS_XG + 64 * MiB;
constexpr size_t WS_Y = WS_ACT + 128 * MiB;
constexpr size_t WS_MOE_END = WS_Y + 128 * MiB;
constexpr size_t WS_BG = WS_R;
constexpr size_t WS_CU = WS_BG + 32 * MiB;
constexpr size_t WS_Z = WS_CU + 32 * MiB;
constexpr size_t WS_END = WS_HG_END > WS_MOE_END ? WS_HG_END : WS_MOE_END;
static_assert(WS_END <= 1024 * MiB, "workspace map exceeds 1 GiB");

constexpr int LDS_BYTES = 147456;

struct Params { const float* in[20]; float* out; unsigned char* ws; int ph_lo, ph_hi; };
enum { I_X = 0, I_C, I_CTX, I_CCTX, I_ADAW, I_ADAB, I_NMIX, I_NFFN, I_NFIN, I_HGWIN, I_HGLB, I_HGNORM, I_HGWOUT, I_SCWIN, I_SCCONV, I_SCWOUT, I_ROUTER, I_WGATE, I_WUP, I_WDOWN };

typedef __bf16 bf16x2_t __attribute__((ext_vector_type(2)));
__device__ __forceinline__ unsigned pk2(float lo, float hi) { const f32x2 v = {lo, hi}; return __builtin_bit_cast(unsigned, __builtin_convertvector(v, bf16x2_t)); }
__device__ __forceinline__ unsigned f2bf(float f) { return pk2(f, 0.f) & 0xffffu; }
__device__ __forceinline__ float bf2f(unsigned short h) { return __builtin_bit_cast(float, (unsigned)h << 16); }
template <int CTRL> __device__ __forceinline__ float dpp_f(float x) { return __builtin_bit_cast(float, __builtin_amdgcn_update_dpp(0, __builtin_bit_cast(int, x), CTRL, 0xf, 0xf, true)); }
__device__ __forceinline__ float row16_sum(float x) {
    x += dpp_f<0xB1>(x);
    x += dpp_f<0x4E>(x);
    x += dpp_f<0x141>(x);
    x += dpp_f<0x140>(x);
    return x;
}
__device__ __forceinline__ float swap16_add(float a, float b) { const auto r = __builtin_amdgcn_permlane16_swap(__float_as_uint(a), __float_as_uint(b), false, false); const unsigned r0 = r[0], r1 = r[1]; return __uint_as_float(r0) + __uint_as_float(r1); }
__device__ __forceinline__ float swap32_add(float a, float b) { const auto r = __builtin_amdgcn_permlane32_swap(__float_as_uint(a), __float_as_uint(b), false, false); const unsigned r0 = r[0], r1 = r[1]; return __uint_as_float(r0) + __uint_as_float(r1); }
__device__ __forceinline__ float swap16_max(float a) { const auto r = __builtin_amdgcn_permlane16_swap(__float_as_uint(a), __float_as_uint(a), false, false); const unsigned r0 = r[0], r1 = r[1]; return fmaxf(__uint_as_float(r0), __uint_as_float(r1)); }
__device__ __forceinline__ float swap32_max(float a) { const auto r = __builtin_amdgcn_permlane32_swap(__float_as_uint(a), __float_as_uint(a), false, false); const unsigned r0 = r[0], r1 = r[1]; return fmaxf(__uint_as_float(r0), __uint_as_float(r1)); }
__device__ __forceinline__ float lane_xor8(float x) { return dpp_f<0x128>(x); }
__device__ __forceinline__ float lane_xor4(float x) { return dpp_f<0x1B>(dpp_f<0x141>(x)); }
__device__ __forceinline__ float wave_sum(float v) { v = row16_sum(v); v = swap16_add(v, v); v = swap32_add(v, v); return v; }
__device__ __forceinline__ float sigmoidf_(float x) { return 1.f / (1.f + expf(-x)); }
__device__ __forceinline__ float fsigmoid(float x) { return __builtin_amdgcn_rcpf(1.f + __builtin_amdgcn_exp2f(-1.4426950408889634f * x)); }
__device__ __forceinline__ float fsilu(float x) { return x * fsigmoid(x); }
__device__ __forceinline__ float siluf_(float x) { return x / (1.f + expf(-x)); }

struct EpiInProj {
    static constexpr bool PERM = false;
    unsigned char* ws;
    __device__ __forceinline__ void operator()(const f32x4 (&acc)[2][2][4][2], const pg8::Unit& u, int wr, int wc, int fr, int fq) const {
        const int sec = u.pn >> 2;
        const int row0 = u.pm * 256 + wr * 64 + fr, cb = (u.pn & 3) * 256 + wc * 32 + 4 * fq;
        if (sec == 0 || sec == 1 || sec == 4) {
            bf16_t* O = (bf16_t*)(ws + (sec == 0 ? WS_Q : (sec == 1 ? WS_V : WS_G)));
#pragma unroll
            for (int ai = 0; ai < 2; ++ai)
#pragma unroll
                for (int m = 0; m < 4; ++m) { bf16_t* rp = O + (size_t)(row0 + ai * 128 + m * 16) * DM + cb;
#pragma unroll
                    for (int bj = 0; bj < 2; ++bj)
#pragma unroll
                        for (int n = 0; n < 2; ++n) { f32x4 v = acc[ai][bj][m][n];
                            if (sec == 0) v = v * 0.08838834764831845f;
                            if (sec == 4) { v[0] = fsilu(v[0]); v[1] = fsilu(v[1]); v[2] = fsilu(v[2]); v[3] = fsilu(v[3]); }
                            u32x2 w; w.x = pk2(v[0], v[1]); w.y = pk2(v[2], v[3]); *(u32x2*)(rp + bj * 128 + n * 16) = w; } }
        } else {
            _Float16* O = (_Float16*)(ws + (sec == 2 ? WS_LF : WS_LBK)); const float* lb0 = (const float*)(ws + WS_LB);
            f32x4 lbv[2][2];
#pragma unroll
            for (int bj = 0; bj < 2; ++bj)
#pragma unroll
                for (int n = 0; n < 2; ++n) lbv[bj][n] = *(const f32x4*)(lb0 + cb + bj * 128 + n * 16);
#pragma unroll
            for (int ai = 0; ai < 2; ++ai)
#pragma unroll
                for (int m = 0; m < 4; ++m) { _Float16* rp = O + (size_t)(row0 + ai * 128 + m * 16) * DM + cb;
#pragma unroll
                    for (int bj = 0; bj < 2; ++bj)
#pragma unroll
                        for (int n = 0; n < 2; ++n) { const f32x4 z = acc[ai][bj][m][n], lb = lbv[bj][n]; f32x4 o;
#pragma unroll
                            for (int i = 0; i < 4; ++i) o[i] = lb[i] + (1.f - lb[i]) * fsigmoid(z[i]);
                            h16x4 hv = __builtin_convertvector(o, h16x4); *(u32x2*)(rp + bj * 128 + n * 16) = __builtin_bit_cast(u32x2, hv); } }
        }
    }
};
struct EpiResid {
    static constexpr bool PERM = false;
    float* X; const float* gate;
    __device__ __forceinline__ void operator()(const f32x4 (&acc)[2][2][4][2], const pg8::Unit& u, int wr, int wc, int fr, int fq) const {
        const int row0 = u.pm * 256 + wr * 64 + fr, cb = u.pn * 256 + wc * 32 + 4 * fq;
        const float* gp = gate + (size_t)((u.pm * 256) / SEQ) * NADA + cb;
        f32x4 gv[2][2];
#pragma unroll
        for (int bj = 0; bj < 2; ++bj)
#pragma unroll
            for (int n = 0; n < 2; ++n) gv[bj][n] = *(const f32x4*)(gp + bj * 128 + n * 16);
#pragma unroll
        for (int ai = 0; ai < 2; ++ai)
#pragma unroll
            for (int m = 0; m < 4; ++m) { float* rp = X + (size_t)(row0 + ai * 128 + m * 16) * DM + cb;
#pragma unroll
                for (int bj = 0; bj < 2; ++bj)
#pragma unroll
                    for (int n = 0; n < 2; ++n) { f32x4* q = (f32x4*)(rp + bj * 128 + n * 16); *q = *q + gv[bj][n] * acc[ai][bj][m][n]; } }
    }
};
struct EpiResidPos {
    static constexpr bool PERM = false;
    float* X; const float* gate; const float* xin; const float* posr; const float* posc;
    __device__ __forceinline__ void operator()(const f32x4 (&acc)[2][2][4][2], const pg8::Unit& u, int wr, int wc, int fr, int fq) const {
        const int row0 = u.pm * 256 + wr * 64 + fr, cb = u.pn * 256 + wc * 32 + 4 * fq;
        const float* gp = gate + (size_t)((u.pm * 256) / SEQ) * NADA + cb;
        const bool rowpart = u.pn < 2;
        f32x4 gv[2][2];
#pragma unroll
        for (int bj = 0; bj < 2; ++bj)
#pragma unroll
            for (int n = 0; n < 2; ++n) gv[bj][n] = *(const f32x4*)(gp + bj * 128 + n * 16);
#pragma unroll
        for (int ai = 0; ai < 2; ++ai)
#pragma unroll
            for (int m = 0; m < 4; ++m) { const int row = row0 + ai * 128 + m * 16, t = row & (SEQ - 1);
                const float* pp = rowpart ? posr + (size_t)(t >> 6) * 512 + cb : posc + (size_t)(t & 63) * 512 + (cb - 512);
                const float* xp = xin + (size_t)row * DM + cb; float* rp = X + (size_t)row * DM + cb;
#pragma unroll
                for (int bj = 0; bj < 2; ++bj)
#pragma unroll
                    for (int n = 0; n < 2; ++n) { const int o = bj * 128 + n * 16; *(f32x4*)(rp + o) = (*(const f32x4*)(xp + o) + *(const f32x4*)(pp + o)) + gv[bj][n] * acc[ai][bj][m][n]; } }
    }
};
struct EpiGLU {
    static constexpr bool PERM = true;
    bf16_t* ACT;
    __device__ __forceinline__ void operator()(const f32x4 (&acc)[2][2][4][2], const pg8::Unit& u, int wr, int wc, int fr, int fq) const {
        const int row0 = u.pm * 256 + wr * 64 + fr, cb = u.pn * 128 + wc * 32 + 8 * fq;
#pragma unroll
        for (int ai = 0; ai < 2; ++ai)
#pragma unroll
            for (int m = 0; m < 4; ++m) { bf16_t* rp = ACT + (size_t)(row0 + ai * 128 + m * 16) * DE + cb;
                f32x4 o[2];
#pragma unroll
                for (int n = 0; n < 2; ++n) { const f32x4 a = acc[ai][0][m][n], w = acc[ai][1][m][n];
#pragma unroll
                    for (int i = 0; i < 4; ++i) o[n][i] = fsilu(a[i]) * w[i]; }
                u32x4 w; w.x = pk2(o[0][0], o[0][1]); w.y = pk2(o[0][2], o[0][3]); w.z = pk2(o[1][0], o[1][1]); w.w = pk2(o[1][2], o[1][3]);
                *(u32x4*)rp = w; }
    }
};
struct EpiRowScale {
    static constexpr bool PERM = true;
    bf16_t* Y; const float* rg;
    __device__ __forceinline__ void operator()(const f32x4 (&acc)[2][2][4][2], const pg8::Unit& u, int wr, int wc, int fr, int fq) const {
        const int row0 = u.pm * 256 + wr * 64 + fr, cb = u.pn * 256 + wc * 32 + 8 * fq;
#pragma unroll
        for (int ai = 0; ai < 2; ++ai)
#pragma unroll
            for (int m = 0; m < 4; ++m) { const int row = row0 + ai * 128 + m * 16; bf16_t* rp = Y + (size_t)row * DM + cb;
#pragma unroll
                for (int bj = 0; bj < 2; ++bj) { const f32x4 v0 = acc[ai][bj][m][0], v1 = acc[ai][bj][m][1];
                    u32x4 w; w.x = pk2(v0[0], v0[1]); w.y = pk2(v0[2], v0[3]); w.z = pk2(v1[0], v1[1]); w.w = pk2(v1[2], v1[3]);
                    *(u32x4*)(rp + bj * 128) = w; } }
    }
};
struct EpiConvIn {
    static constexpr bool PERM = true;
    bf16_t *BG, *CU;
    __device__ __forceinline__ void operator()(const f32x4 (&acc)[2][2][4][2], const pg8::Unit& u, int wr, int wc, int fr, int fq) const {
        const int row0 = u.pm * 256 + wr * 64 + fr;
        if (u.pn < 4) {
            const int cb = u.pn * 256 + wc * 32 + 8 * fq;
#pragma unroll
            for (int ai = 0; ai < 2; ++ai)
#pragma unroll
                for (int m = 0; m < 4; ++m) { bf16_t* rp = BG + (size_t)(row0 + ai * 128 + m * 16) * DM + cb;
#pragma unroll
                    for (int bj = 0; bj < 2; ++bj) { const f32x4 v0 = acc[ai][bj][m][0], v1 = acc[ai][bj][m][1];
                        u32x4 w; w.x = pk2(v0[0], v0[1]); w.y = pk2(v0[2], v0[3]); w.z = pk2(v1[0], v1[1]); w.w = pk2(v1[2], v1[3]);
                        *(u32x4*)(rp + bj * 128) = w; } }
        } else {
            const int cb = (u.pn - 4) * 128 + wc * 32 + 8 * fq;
#pragma unroll
            for (int ai = 0; ai < 2; ++ai)
#pragma unroll
                for (int m = 0; m < 4; ++m) { bf16_t* rp = CU + (size_t)(row0 + ai * 128 + m * 16) * DM + cb;
                    const f32x4 v0 = acc[ai][0][m][0] * acc[ai][1][m][0], v1 = acc[ai][0][m][1] * acc[ai][1][m][1];
                    u32x4 w; w.x = pk2(v0[0], v0[1]); w.y = pk2(v0[2], v0[3]); w.z = pk2(v1[0], v1[1]); w.w = pk2(v1[2], v1[3]);
                    *(u32x4*)rp = w; }
        }
    }
};

__device__ __forceinline__ void ph_prep(const Params& p, unsigned char* lds, int bid, int nblk) {
    float* sv = (float*)lds;
    float* red = sv + 3 * 1024;
    int tid_ = threadIdx.x; asm volatile("" : "+v"(tid_)); const int tid = tid_;
    const float* c = p.in[I_C]; const float* cctx = p.in[I_CCTX];
    for (int i = tid; i < 3 * 1024; i += NTHR) { const float v = (i < 2048) ? c[i] : cctx[i - 2048]; sv[i] = siluf_(v); }
    __syncthreads();
    const float* ada_w = p.in[I_ADAW]; const float* ada_b = p.in[I_ADAB];
    float* mod = (float*)(p.ws + WS_MOD);
    for (int it = bid; it < 192; it += nblk) {
        const int l = it / 96, j0 = (it % 96) * 64, col = tid & 63, ks = tid >> 6;
        const float* W = ada_w + (size_t)l * DM * NADA + j0 + col;
        float a0 = 0.f, a1 = 0.f, a2 = 0.f;
#pragma unroll 16
        for (int k = ks * 128; k < ks * 128 + 128; ++k) { const float w = W[(size_t)k * NADA]; a0 += sv[k] * w; a1 += sv[1024 + k] * w; a2 += sv[2048 + k] * w; }
        red[(ks * 3 + 0) * 64 + col] = a0; red[(ks * 3 + 1) * 64 + col] = a1; red[(ks * 3 + 2) * 64 + col] = a2;
        __syncthreads();
        if (tid < 192) { const int v = tid >> 6, cc = tid & 63; float s = ada_b[l * NADA + j0 + cc];
#pragma unroll
            for (int k2 = 0; k2 < 8; ++k2) s += red[(k2 * 3 + v) * 64 + cc];
            mod[(size_t)(l * 3 + v) * NADA + j0 + cc] = s; }
        __syncthreads();
    }
    const int gt = bid * NTHR + tid, NT = nblk * NTHR;
    const float* lg = p.in[I_HGLB]; float* lb0 = (float*)(p.ws + WS_LB);
    for (int d = gt; d < DM; d += NT) { const float l0 = lg[d], l1 = lg[DM + d], l2 = lg[2 * DM + d]; const float mx = fmaxf(l0, fmaxf(l1, l2));
        const float e0 = expf(l0 - mx), e1 = expf(l1 - mx), e2 = expf(l2 - mx); lb0[d] = e0 / (e0 + e1 + e2); }
    float* posr = (float*)(p.ws + WS_POSR);
    for (int i = gt; i < (128 + 64) * 512; i += NT) { const int pi = i >> 9, dd = i & 511; const int pos = pi < 128 ? pi : pi - 128; const int fi = dd & 255;
        const float om = exp2f(-(float)fi * (13.287712379549449f / 256.0f)); const float a = (float)pos * om; posr[i] = dd < 256 ? sinf(a) : cosf(a); }
}

__device__ __forceinline__ void transpose_item(const float* W, int N, bf16_t* WT, int K, float* scr, int k0, int n0, size_t drow0, int lane) {
#pragma unroll
    for (int i = 0; i < 8; ++i) { const int kk = 8 * i + (lane >> 3); const f32x4 v = *(const f32x4*)(W + (size_t)(k0 + kk) * N + n0 + (lane & 7) * 4); float* d = scr + kk * 33 + (lane & 7) * 4; d[0] = v[0]; d[1] = v[1]; d[2] = v[2]; d[3] = v[3]; }
    __builtin_amdgcn_s_waitcnt(0xc07f); asm volatile("" ::: "memory");
    const int c = lane & 7;
#pragma unroll
    for (int j = 0; j < 4; ++j) { const int n = (lane >> 3) + 8 * j; const float* s = scr + (8 * c) * 33 + n;
        u32x4 o; o.x = pk2(s[0 * 33], s[1 * 33]); o.y = pk2(s[2 * 33], s[3 * 33]); o.z = pk2(s[4 * 33], s[5 * 33]); o.w = pk2(s[6 * 33], s[7 * 33]);
        *(u32x4*)(WT + (drow0 + n) * K + k0 + 8 * c) = o; }
    __builtin_amdgcn_s_waitcnt(0xc07f); asm volatile("" ::: "memory");
}
__device__ __forceinline__ void ph_convert_small(const Params& p, unsigned char* lds, int bid, int nblk) {
    int tid_ = threadIdx.x; asm volatile("" : "+v"(tid_));
    const int tid = tid_, lane = tid & 63, wave = tid >> 6;
    float* scr = (float*)lds + wave * (64 * 33);
    const int gw = bid * 8 + wave, NGW = nblk * 8;
    constexpr int I_A = 16 * 160, I_B = 16 * 32, I_C_ = 16 * 96, I_D = 16 * 32;
    for (int it = gw; it < I_A + I_B + I_C_ + I_D; it += NGW) {
        int r = it;
        if (r < I_A) { const int kb = r / 160, nb = r % 160; transpose_item(p.in[I_HGWIN], 5120, (bf16_t*)(p.ws + WS_WHGIN), 1024, scr, kb * 64, nb * 32, (size_t)nb * 32, lane); continue; } r -= I_A;
        if (r < I_B) { const int kb = r / 32, nb = r % 32; transpose_item(p.in[I_HGWOUT], 1024, (bf16_t*)(p.ws + WS_WHGOUT), 1024, scr, kb * 64, nb * 32, (size_t)nb * 32, lane); continue; } r -= I_B;
        if (r < I_C_) { const int kb = r / 96, nb = r % 96, n0 = nb * 32; size_t dr;
            if (n0 < 1024) dr = n0; else { const int np = n0 - 1024, sec = np >> 10, nn = np & 1023; dr = 1024 + (nn >> 7) * 256 + sec * 128 + (nn & 127); }
            transpose_item(p.in[I_SCWIN], 3072, (bf16_t*)(p.ws + WS_WSCIN), 1024, scr, kb * 64, n0, dr, lane); continue; } r -= I_C_;
        { const int kb = r / 32, nb = r % 32; transpose_item(p.in[I_SCWOUT], 1024, (bf16_t*)(p.ws + WS_WSCOUT), 1024, scr, kb * 64, nb * 32, (size_t)nb * 32, lane); }
    }
}
struct CvtItem { const float* src; bf16_t* dst; int N, K; };
__device__ __forceinline__ CvtItem moe_item(const Params& p, int l, int r) {
    CvtItem c;
    if (r < 32768) { const int up = r >= 16384; if (up) r -= 16384; const int le = l * 16 + (r >> 10), q = r & 1023, kb = q >> 6, nb = q & 63, n0 = nb * 32;
        const size_t dr = (size_t)le * 4096 + (n0 >> 7) * 256 + up * 128 + (n0 & 127);
        c.src = p.in[up ? I_WUP : I_WGATE] + (size_t)le * 1024 * 2048 + (size_t)(kb * 64) * 2048 + n0; c.dst = (bf16_t*)(p.ws + WS_WMOE1) + dr * 1024 + kb * 64; c.N = 2048; c.K = 1024; }
    else { r -= 32768; const int le = l * 16 + (r >> 10), q = r & 1023, kb = q >> 5, nb = q & 31, n0 = nb * 32;
        c.src = p.in[I_WDOWN] + (size_t)le * 2048 * 1024 + (size_t)(kb * 64) * 1024 + n0; c.dst = (bf16_t*)(p.ws + WS_WMOE2) + ((size_t)le * 1024 + n0) * 2048 + kb * 64; c.N = 1024; c.K = 2048; }
    return c;
}
__device__ __forceinline__ void convert_moe_slice(const Params& p, unsigned char* lds, int bid, int nblk, int l, int lo, int hi) {
    int tid_ = threadIdx.x; asm volatile("" : "+v"(tid_));
    const int tid = tid_, lane = tid & 63, wave = tid >> 6;
    float* scr = (float*)lds + wave * (64 * 33);
    const int gw = bid * 8 + wave, NGW = nblk * 8;
    constexpr int NI = 3;
    for (int it = lo + gw; it < hi; it += NGW * NI) {
        f32x4 v[NI][8]; CvtItem ci[NI];
#pragma unroll
        for (int u = 0; u < NI; ++u) { const int r = it + u * NGW; ci[u] = moe_item(p, l, r < hi ? r : it);
#pragma unroll
            for (int i = 0; i < 8; ++i) v[u][i] = __builtin_nontemporal_load((const f32x4*)(ci[u].src + (size_t)(8 * i + (lane >> 3)) * ci[u].N + (lane & 7) * 4)); }
#pragma unroll
        for (int u = 0; u < NI; ++u) { if (it + u * NGW < hi) {
#pragma unroll
            for (int i = 0; i < 8; ++i) { float* d = scr + (8 * i + (lane >> 3)) * 33 + (lane & 7) * 4; d[0] = v[u][i][0]; d[1] = v[u][i][1]; d[2] = v[u][i][2]; d[3] = v[u][i][3]; }
            __builtin_amdgcn_s_waitcnt(0xc07f); asm volatile("" ::: "memory");
            const int c = lane & 7;
#pragma unroll
            for (int j = 0; j < 4; ++j) { const int n = (lane >> 3) + 8 * j; const float* sp = scr + (8 * c) * 33 + n;
                u32x4 o; o.x = pk2(sp[0 * 33], sp[1 * 33]); o.y = pk2(sp[2 * 33], sp[3 * 33]); o.z = pk2(sp[4 * 33], sp[5 * 33]); o.w = pk2(sp[6 * 33], sp[7 * 33]);
                __builtin_nontemporal_store(o, (u32x4*)(ci[u].dst + (size_t)n * ci[u].K + 8 * c)); }
            __builtin_amdgcn_s_waitcnt(0xc07f); asm volatile("" ::: "memory"); } }
    }
    __syncthreads();
}

constexpr int CV_ITEMS = 49152, CW_Q = 1536;
constexpr int MW_LAYER = 12, MW_BASE = 13, MW_EMPTY = 14, MW_REL = 15, MW_LAST = 16;
__device__ __forceinline__ bool cvt_batch(const Params& p, unsigned char* lds, volatile LAS unsigned* MISC, unsigned layer_mask) {
    int tid_ = threadIdx.x; asm volatile("" : "+v"(tid_));
    const int tid = tid_, lane = tid & 63, wave = tid >> 6;
    if (tid == 0) {
        unsigned* q = (unsigned*)(p.ws + WS_CTL) + CW_Q; unsigned empty = MISC[MW_EMPTY]; int layer = -1; unsigned base = 0u;
#pragma unroll
        for (int l = 0; l < 2; ++l) if (layer < 0 && ((layer_mask >> l) & 1u) && !((empty >> l) & 1u)) {
            const unsigned b0 = __hip_atomic_fetch_add(q + 64 * l, 8u, __ATOMIC_RELAXED, __HIP_MEMORY_SCOPE_AGENT);
            if (b0 < (unsigned)CV_ITEMS) { layer = l; base = b0; MISC[MW_LAST + l] = b0 + 8u; } else empty |= 1u << l; }
        MISC[MW_EMPTY] = empty; MISC[MW_LAYER] = (unsigned)layer; MISC[MW_BASE] = base;
    }
    __syncthreads();
    const int layer = (int)MISC[MW_LAYER]; const int item = (int)MISC[MW_BASE] + wave;
    if (layer < 0) return false;
    float* scr = (float*)lds + wave * (64 * 33);
    if (item < CV_ITEMS) {
        const CvtItem ci = moe_item(p, layer, item);
        f32x4 v[8];
#pragma unroll
        for (int i = 0; i < 8; ++i) v[i] = __builtin_nontemporal_load((const f32x4*)(ci.src + (size_t)(8 * i + (lane >> 3)) * ci.N + (lane & 7) * 4));
#pragma unroll
        for (int i = 0; i < 8; ++i) { float* d = scr + (8 * i + (lane >> 3)) * 33 + (lane & 7) * 4; d[0] = v[i][0]; d[1] = v[i][1]; d[2] = v[i][2]; d[3] = v[i][3]; }
        __builtin_amdgcn_s_waitcnt(0xc07f); asm volatile("" ::: "memory");
        const int c = lane & 7;
#pragma unroll
        for (int j = 0; j < 4; ++j) { const int n = (lane >> 3) + 8 * j; const float* sp = scr + (8 * c) * 33 + n;
            u32x4 o; o.x = pk2(sp[0 * 33], sp[1 * 33]); o.y = pk2(sp[2 * 33], sp[3 * 33]); o.z = pk2(sp[4 * 33], sp[5 * 33]); o.w = pk2(sp[6 * 33], sp[7 * 33]);
            __builtin_nontemporal_store(o, (u32x4*)(ci.dst + (size_t)n * ci.K + 8 * c)); }
    }
    __syncthreads();
    return true;
}
__device__ __forceinline__ void cvt_drain_until(const Params& p, unsigned char* lds, volatile LAS unsigned* MISC, int l, unsigned limit) {
    for (;;) { if ((MISC[MW_EMPTY] >> l) & 1u) break; if (MISC[MW_LAST + l] >= limit) break; if (!cvt_batch(p, lds, MISC, 1u << l)) break; }
}
__device__ __forceinline__ void cvt_budget(const Params& p, unsigned char* lds, volatile LAS unsigned* MISC, unsigned layer_mask, int nbatch) {
    for (int i = 0; i < nbatch; ++i) if (!cvt_batch(p, lds, MISC, layer_mask)) break;
}

__device__ __forceinline__ void store_mod_bf16(bf16_t* hrow, const f32x4 (&v)[4], float rstd, const float* g, const float* sh, const float* sc, int lane) {
#pragma unroll
    for (int j = 0; j < 4; ++j) { const int c0 = 256 * j + 4 * lane; const f32x4 gv = *(const f32x4*)(g + c0), shv = *(const f32x4*)(sh + c0), scv = *(const f32x4*)(sc + c0);
        f32x4 h;
#pragma unroll
        for (int i = 0; i < 4; ++i) h[i] = (v[j][i] * rstd * gv[i]) * (1.f + scv[i]) + shv[i];
        u32x2 w; w.x = pk2(h[0], h[1]); w.y = pk2(h[2], h[3]); *(u32x2*)(hrow + c0) = w; }
}
__device__ __forceinline__ void ph_mod0(const Params& p, int row_lo, int row_hi, int wk, int nwk) {
    int tid_ = threadIdx.x; asm volatile("" : "+v"(tid_));
    const int tid = tid_, lane = tid & 63, wave = tid >> 6, gw = wk * 8 + wave, NGW = nwk * 8;
    const float* x = p.in[I_X]; const float* ctx = p.in[I_CTX]; const float* g = p.in[I_NMIX];
    const float* mod = (const float*)(p.ws + WS_MOD); const float* posr = (const float*)(p.ws + WS_POSR); const float* posc = (const float*)(p.ws + WS_POSC);
    float* X = (float*)(p.ws + WS_X); bf16_t* H = (bf16_t*)(p.ws + WS_H);
    f32x4 nx[4];
    { const int row = row_lo + gw; if (row < row_hi) { const float* src = row < NTOK ? x + (size_t)row * DM : ctx + (size_t)(row - NTOK) * DM;
#pragma unroll
        for (int j = 0; j < 4; ++j) nx[j] = *(const f32x4*)(src + 256 * j + 4 * lane); } }
    for (int row = row_lo + gw; row < row_hi; row += NGW) {
        f32x4 v[4]; float ss = 0.f; int vec;
#pragma unroll
        for (int j = 0; j < 4; ++j) v[j] = nx[j];
        { const int r2 = row + NGW; if (r2 < row_hi) { const float* src = r2 < NTOK ? x + (size_t)r2 * DM : ctx + (size_t)(r2 - NTOK) * DM;
#pragma unroll
            for (int j = 0; j < 4; ++j) nx[j] = *(const f32x4*)(src + 256 * j + 4 * lane); } }
        if (row < NTOK) { const int t = row & (SEQ - 1); vec = row >> 13; const float* pr = posr + (size_t)(t >> 6) * 512; const float* pc = posc + (size_t)(t & 63) * 512;
#pragma unroll
            for (int j = 0; j < 4; ++j) { const int c0 = 256 * j + 4 * lane; const f32x4 pv = *(const f32x4*)((j < 2 ? pr : pc) + (c0 & 511));
                v[j] = v[j] + pv; }
        } else vec = 2;
#pragma unroll
        for (int j = 0; j < 4; ++j) ss += (v[j][0] * v[j][0] + v[j][1] * v[j][1]) + (v[j][2] * v[j][2] + v[j][3] * v[j][3]);
        const float rstd = 1.f / sqrtf(wave_sum(ss) * (1.f / DM) + 1e-6f);
        const float* mv = mod + (size_t)(0 * 3 + vec) * NADA;
        store_mod_bf16(H + (size_t)row * DM, v, rstd, g, mv, mv + DM, lane);
    }
}

typedef short s16x4 __attribute__((ext_vector_type(4)));
typedef short v4i16_t __attribute__((ext_vector_type(4)));
using pg8::bf16x8;
constexpr int KT_STR = 160, KS_STR = 144, V_STR = 288;
constexpr int GL_QT = 0, GL_KT = 20480, GL_KS = 40960, GL_PL = 59392, GL_V = 68608, GL_SEG = 87040, GL_DV = 89088, GL_EM = 89600, GL_SSQ = 90112, GL_RSTD = 92160;
__device__ __forceinline__ s16x4 lds_tr(const LAS unsigned char* p) { return __builtin_bit_cast(s16x4, __builtin_amdgcn_ds_read_tr16_b64_v4i16((LAS v4i16_t*)p)); }
__device__ __forceinline__ bf16x8 cat8(s16x4 a, s16x4 b) { return __builtin_shufflevector(a, b, 0, 1, 2, 3, 4, 5, 6, 7); }
__device__ __forceinline__ bf16x8 lds_pair64(const LAS unsigned char* p, int d2) { const u32x2 a = *(const LAS u32x2*)p, b = *(const LAS u32x2*)(p + d2); u32x4 r; r.x = a.x; r.y = a.y; r.z = b.x; r.w = b.y; return __builtin_bit_cast(bf16x8, r); }

constexpr int ON_STR = 272;
constexpr int GL_RF = 92416, GL_RQ = 125184, GL_END = 141568;
struct GlaRegs { u32x4 f[2]; u32x4 q[2]; u32x4 v[2]; };
template <bool WITHQ>
__device__ __forceinline__ void gla_load(GlaRegs& R, const float* F, const bf16_t* Q, const bf16_t* V, int rb, int h, int tid) {
    const unsigned lq = (unsigned)((tid >> 4) * DM + (tid & 15) * 8);
#pragma unroll
    for (int i = 0; i < 2; ++i) { const size_t ub = (size_t)(rb + 32 * i) * DM + h * 128;
        R.f[i] = *(const u32x4*)((const bf16_t*)F + ub + lq); if (WITHQ) R.q[i] = *(const u32x4*)(Q + ub + lq); R.v[i] = *(const u32x4*)(V + ub + lq); }
}
template <bool WITHQ>
__device__ __forceinline__ void gla_put_raw(const GlaRegs& R, LAS unsigned char* lds, int dir, int tid) {
#pragma unroll
    for (int i = 0; i < 2; ++i) { const int id = tid + 512 * i, row = id >> 4, c8 = (id & 15) * 8, p = dir ? 63 - row : row;
        *(LAS u32x4*)(lds + GL_RF + p * 256 + c8 * 2) = R.f[i];
        if (WITHQ) *(LAS u32x4*)(lds + GL_RQ + p * 256 + c8 * 2) = R.q[i]; *(LAS u32x4*)(lds + GL_V + p * V_STR + c8 * 2) = R.v[i]; }
}
template <bool G2>
__device__ __forceinline__ void gla_phase_a(LAS unsigned char* lds, int tid) {
    const int k = tid & 127, seg = tid >> 7;
    LAS float* segtot = (LAS float*)(lds + GL_SEG);
    float f[16];
#pragma unroll
    for (int i = 0; i < 16; ++i) f[i] = (float)*(const LAS _Float16*)(lds + GL_RF + (16 * seg + i) * 256 + k * 2);
    if (G2) {
        unsigned short q[16];
#pragma unroll
        for (int i = 0; i < 16; ++i) q[i] = *(const LAS unsigned short*)(lds + GL_RQ + (16 * seg + i) * 256 + k * 2);
        float c[16]; c[0] = f[0];
#pragma unroll
        for (int i = 1; i < 16; ++i) c[i] = c[i - 1] * f[i];
        segtot[seg * 128 + k] = c[15];
        __syncthreads();
        const float T0 = segtot[k], T1 = segtot[128 + k], T2 = segtot[256 + k], T3 = segtot[384 + k];
        const float Fs = seg == 0 ? 1.f / (T0 * T1) : (seg == 1 ? 1.f / T1 : (seg == 2 ? 1.f : T2));
        const float cK = T2 * T3;
        if (seg == 0) { ((LAS float*)(lds + GL_DV))[k] = T0 * T1 * cK; ((LAS float*)(lds + GL_EM))[k] = T0 * T1; }
        unsigned wq[8], wk[8], ws_[8];
#pragma unroll
        for (int i = 0; i < 16; i += 2) { float qp[2], kp[2], ks[2];
#pragma unroll
            for (int e = 0; e < 2; ++e) { const float eq = c[i + e] * Fs, inv = __builtin_amdgcn_rcpf(eq), kk = 1.f - f[i + e];
                qp[e] = bf2f(q[i + e]) * eq; kp[e] = kk * inv; ks[e] = kp[e] * cK; }
            wq[i >> 1] = pk2(qp[0], qp[1]); wk[i >> 1] = pk2(kp[0], kp[1]); ws_[i >> 1] = pk2(ks[0], ks[1]); }
        LAS unsigned char* dq = lds + GL_QT + k * KT_STR + seg * 32; LAS unsigned char* dk = lds + GL_KT + k * KT_STR + seg * 32; LAS unsigned char* ds = lds + GL_KS + k * KS_STR + seg * 32;
        *(LAS u32x4*)dq = (u32x4){wq[0], wq[1], wq[2], wq[3]}; *(LAS u32x4*)(dq + 16) = (u32x4){wq[4], wq[5], wq[6], wq[7]};
        *(LAS u32x4*)dk = (u32x4){wk[0], wk[1], wk[2], wk[3]}; *(LAS u32x4*)(dk + 16) = (u32x4){wk[4], wk[5], wk[6], wk[7]};
        *(LAS u32x4*)ds = (u32x4){ws_[0], ws_[1], ws_[2], ws_[3]}; *(LAS u32x4*)(ds + 16) = (u32x4){ws_[4], ws_[5], ws_[6], ws_[7]};
    } else {
        float sx[16]; sx[15] = 1.f;
#pragma unroll
        for (int i = 14; i >= 0; --i) sx[i] = sx[i + 1] * f[i + 1];
        segtot[seg * 128 + k] = sx[0] * f[0];
        __syncthreads();
        const float T0 = segtot[k], T1 = segtot[128 + k], T2 = segtot[256 + k], T3 = segtot[384 + k];
        const float later = seg == 0 ? T1 * T2 * T3 : (seg == 1 ? T2 * T3 : (seg == 2 ? T3 : 1.f));
        if (seg == 0) ((LAS float*)(lds + GL_DV))[k] = T0 * T1 * T2 * T3;
        unsigned ws_[8];
#pragma unroll
        for (int i = 0; i < 16; i += 2) ws_[i >> 1] = pk2((1.f - f[i]) * sx[i] * later, (1.f - f[i + 1]) * sx[i + 1] * later);
        LAS unsigned char* ds = lds + GL_KS + k * KS_STR + seg * 32;
        *(LAS u32x4*)ds = (u32x4){ws_[0], ws_[1], ws_[2], ws_[3]}; *(LAS u32x4*)(ds + 16) = (u32x4){ws_[4], ws_[5], ws_[6], ws_[7]};
    }
    __syncthreads();
}
__device__ __forceinline__ void gla_state_update(f32x4 (&S)[8], const bf16x8 (&Vf)[2], const LAS unsigned char* lds, int i16, int g) {
#pragma unroll
    for (int j = 0; j < 8; ++j) { const f32x4 dv = *(const LAS f32x4*)(lds + GL_DV + (16 * j + 4 * g) * 4); S[j] = S[j] * dv;
#pragma unroll
        for (int c2 = 0; c2 < 2; ++c2) { const bf16x8 a = lds_pair64(lds + GL_KS + (16 * j + i16) * KS_STR + (32 * c2 + 4 * g) * 2, 32);
            S[j] = __builtin_amdgcn_mfma_f32_16x16x32_bf16(a, Vf[c2], S[j], 0, 0, 0); }
        if (j & 1) asm volatile("" ::: "memory"); }
}
__device__ __forceinline__ void gla_load_vf(bf16x8 (&Vf)[2], const LAS unsigned char* lds, int w, int i16, int g) {
    const int q4 = i16 >> 2, pp = i16 & 3;
#pragma unroll
    for (int c2 = 0; c2 < 2; ++c2) { const LAS unsigned char* vb = lds + GL_V + (32 * c2 + 4 * g + q4) * V_STR + (16 * w + 4 * pp) * 2; Vf[c2] = cat8(lds_tr(vb), lds_tr(vb + 16 * V_STR)); }
}

__device__ __forceinline__ void ph_gla_states(const Params& p, unsigned char* lds_, int bid, int nblk) {
    int tid_ = threadIdx.x; asm volatile("" : "+v"(tid_));
    const int tid = tid_, lane = tid & 63, w = __builtin_amdgcn_readfirstlane(tid >> 6), i16 = lane & 15, g = lane >> 4;
    LAS unsigned char* lds = (LAS unsigned char*)lds_;
    const bf16_t* V = (const bf16_t*)(p.ws + WS_V);
    float* U = (float*)(p.ws + WS_U); float* DD = (float*)(p.ws + WS_DD);
    for (int ui = bid; ui < 544; ui += nblk) {
        int b, h, dir, nch, rb0, uidx;
        if (ui < 512) { b = ui >> 8; h = (ui >> 5) & 7; dir = (ui >> 4) & 1; const int sc = ui & 15; nch = 8; rb0 = b * SEQ + sc * 512; uidx = ((b * 8 + h) * 2 + dir) * 17 + sc; }
        else { const int r = ui - 512; b = r >> 4; h = (r >> 1) & 7; dir = r & 1; nch = 4; rb0 = NTOK + b * CTXL; uidx = ((b * 8 + h) * 2 + dir) * 17 + 16; }
        const float* F = (const float*)(p.ws + (dir ? WS_LBK : WS_LF));
        f32x4 S[8];
#pragma unroll
        for (int j = 0; j < 8; ++j) S[j] = (f32x4){0.f, 0.f, 0.f, 0.f};
        float dtot = 1.f;
        GlaRegs R;
        gla_load<false>(R, F, nullptr, V, rb0 + 64 * (dir ? nch - 1 : 0), h, tid);
        for (int step = 0; step < nch; ++step) {
            gla_put_raw<false>(R, lds, dir, tid);
            __syncthreads();
            if (step + 1 < nch) gla_load<false>(R, F, nullptr, V, rb0 + 64 * (dir ? nch - 2 - step : step + 1), h, tid);
            gla_phase_a<false>(lds, tid);
            if (tid < 128) dtot *= ((const LAS float*)(lds + GL_DV))[tid];
            bf16x8 Vf[2]; gla_load_vf(Vf, lds, w, i16, g);
            gla_state_update(S, Vf, lds, i16, g);
            __syncthreads();
        }
        float* up = U + (size_t)uidx * 16384 + (size_t)(w * 8) * 256 + lane * 4;
#pragma unroll
        for (int j = 0; j < 8; ++j) *(f32x4*)(up + j * 256) = S[j];
        if (tid < 128) DD[(size_t)uidx * 128 + tid] = dtot;
    }
}

__device__ __forceinline__ void ph_gla_out(const Params& p, unsigned char* lds_, int bid, int nblk) {
    int tid_ = threadIdx.x; asm volatile("" : "+v"(tid_));
    const int tid = tid_, lane = tid & 63, w = __builtin_amdgcn_readfirstlane(tid >> 6), i16 = lane & 15, g = lane >> 4, q4 = i16 >> 2, pp = i16 & 3;
    LAS unsigned char* lds = (LAS unsigned char*)lds_;
    const bf16_t* Q = (const bf16_t*)(p.ws + WS_Q); const bf16_t* V = (const bf16_t*)(p.ws + WS_V); const bf16_t* G = (const bf16_t*)(p.ws + WS_G);
    const float* U = (const float*)(p.ws + WS_U); const float* DD = (const float*)(p.ws + WS_DD);
    float* OFL = (float*)(p.ws + WS_OF); bf16_t* ON = (bf16_t*)(p.ws + WS_ON);
    const float ngv = p.in[I_HGNORM][16 * w + i16];
    const int troff = (4 * g + q4) * KT_STR + (4 * pp) * 2;
    for (int unit = bid; unit < 256; unit += nblk) {
        const int b = unit >> 7, h = (unit >> 4) & 7, sc = unit & 15, rbs = b * SEQ + sc * 512;
        const unsigned loff = (unsigned)((3 - g) * 4 * DM + i16);
#pragma unroll 1
        for (int dir = 0; dir < 2; ++dir) {
            const float* F = (const float*)(p.ws + (dir ? WS_LBK : WS_LF));
            GlaRegs R;
            gla_load<true>(R, F, Q, V, rbs + 64 * (dir ? 7 : 0), h, tid);
            int on_rb = -1;
#define GLA_ON_FLUSH() do { _Pragma("unroll") for (int i_ = 0; i_ < 2; ++i_) { const int id_ = tid + 512 * i_, row_ = id_ >> 4, c8_ = (id_ & 15) * 8; \
                *(u32x4*)(ON + (size_t)(on_rb + row_) * DM + h * 128 + c8_) = *(const LAS u32x4*)(lds + GL_QT + row_ * ON_STR + c8_ * 2); } } while (0)
            const int ub = ((b * 8 + h) * 2 + dir) * 17;
            f32x4 S[8];
            { const float* up = U + (size_t)(ub + 16) * 16384 + (size_t)(w * 8) * 256 + lane * 4;
#pragma unroll
                for (int j = 0; j < 8; ++j) S[j] = *(const f32x4*)(up + j * 256); }
            { const int nf = dir ? 15 - sc : sc;
                LAS float* dl = (LAS float*)(lds + GL_QT);
                for (int i = tid; i < 16 * 128; i += NTHR) dl[i] = DD[(size_t)ub * 128 + i];
                __syncthreads();
                f32x4 Ua[8];
#define FOLD_LOAD(UU, s_) do { const int u_ = dir ? 15 - (s_) : (s_); const float* up_ = U + (size_t)(ub + u_) * 16384 + (size_t)(w * 8) * 256 + lane * 4; \
                    _Pragma("unroll") for (int j = 0; j < 8; ++j) UU[j] = *(const f32x4*)(up_ + j * 256); } while (0)
                if (nf > 0) FOLD_LOAD(Ua, 0);
                for (int s = 0; s < nf; ++s) { const int u = dir ? 15 - s : s;
#pragma unroll
                    for (int j = 0; j < 8; ++j) S[j] = S[j] * *(const LAS f32x4*)(dl + u * 128 + 16 * j + 4 * g) + Ua[j];
                    if (s + 1 < nf) FOLD_LOAD(Ua, s + 1); }
#undef FOLD_LOAD
                __syncthreads();
            }
            for (int step = 0; step < 8; ++step) {
                const int n = dir ? 7 - step : step, rb = rbs + 64 * n;
                gla_put_raw<true>(R, lds, dir, tid);
                __syncthreads();
                if (on_rb >= 0) { GLA_ON_FLUSH(); on_rb = -1; }
                if (step < 7) gla_load<true>(R, F, Q, V, rbs + 64 * (dir ? 6 - step : step + 1), h, tid);
                gla_phase_a<true>(lds, tid);
                f32x4 O[4];
                if (dir) { const float* ob = OFL + ((size_t)((unit * 8 + n) * 8 + w) * 4) * 256 + ((3 - g) * 16 + i16) * 4;
#pragma unroll
                    for (int ti = 0; ti < 4; ++ti) { const f32x4 t4 = *(const f32x4*)(ob + (3 - ti) * 256); O[ti] = (f32x4){t4[3], t4[2], t4[1], t4[0]}; } }
                else {
#pragma unroll
                    for (int ti = 0; ti < 4; ++ti) O[ti] = (f32x4){0.f, 0.f, 0.f, 0.f}; }
                { const int si = w >> 1, tb = 2 * (w & 1);
                    f32x4 pa[2] = {(f32x4){0.f, 0.f, 0.f, 0.f}, (f32x4){0.f, 0.f, 0.f, 0.f}};
#pragma unroll
                    for (int c = 0; c < 4; ++c) { const LAS unsigned char* ka = lds + GL_KT + troff + (32 * c) * KT_STR + (16 * si) * 2; const bf16x8 a = cat8(lds_tr(ka), lds_tr(ka + 16 * KT_STR));
#pragma unroll
                        for (int tt = 0; tt < 2; ++tt) { const LAS unsigned char* qa = lds + GL_QT + troff + (32 * c) * KT_STR + (16 * (tb + tt)) * 2; const bf16x8 bq = cat8(lds_tr(qa), lds_tr(qa + 16 * KT_STR));
                            pa[tt] = __builtin_amdgcn_mfma_f32_16x16x32_bf16(a, bq, pa[tt], 0, 0, 0); } }
#pragma unroll
                    for (int tt = 0; tt < 2; ++tt) { const int t = 16 * (tb + tt) + i16, s0 = 16 * si + 4 * g; f32x4 v = pa[tt];
#pragma unroll
                        for (int r = 0; r < 4; ++r) v[r] = (s0 + r <= t) ? v[r] : 0.f;
                        u32x2 wv; wv.x = pk2(v[0], v[1]); wv.y = pk2(v[2], v[3]); *(LAS u32x2*)(lds + GL_PL + t * KS_STR + s0 * 2) = wv; } }
                __syncthreads();
                {
#pragma unroll
                    for (int c = 0; c < 4; ++c) { const f32x4 e0 = *(const LAS f32x4*)(lds + GL_EM + (32 * c + 4 * g) * 4), e1 = *(const LAS f32x4*)(lds + GL_EM + (32 * c + 16 + 4 * g) * 4);
                        const f32x4 a0 = S[2 * c] * e0, b0 = S[2 * c + 1] * e1; u32x4 r; r.x = pk2(a0[0], a0[1]); r.y = pk2(a0[2], a0[3]); r.z = pk2(b0[0], b0[1]); r.w = pk2(b0[2], b0[3]); const bf16x8 Sb = __builtin_bit_cast(bf16x8, r);
#pragma unroll
                        for (int ti = 0; ti < 4; ++ti) { const LAS unsigned char* qa = lds + GL_QT + troff + (32 * c) * KT_STR + (16 * ti) * 2; const bf16x8 a = cat8(lds_tr(qa), lds_tr(qa + 16 * KT_STR));
                            O[ti] = __builtin_amdgcn_mfma_f32_16x16x32_bf16(a, Sb, O[ti], 0, 0, 0); }
                        asm volatile("" ::: "memory"); } }
                bf16x8 Vf[2]; gla_load_vf(Vf, lds, w, i16, g);
#pragma unroll
                for (int ti = 0; ti < 4; ++ti) {
#pragma unroll
                    for (int c2 = 0; c2 < 2; ++c2) { const bf16x8 a = lds_pair64(lds + GL_PL + (16 * ti + i16) * KS_STR + (32 * c2 + 4 * g) * 2, 32);
                        O[ti] = __builtin_amdgcn_mfma_f32_16x16x32_bf16(a, Vf[c2], O[ti], 0, 0, 0); }
                    if (ti & 1) asm volatile("" ::: "memory"); }
                gla_state_update(S, Vf, lds, i16, g);
                if (dir == 0) {
                    float* ob = OFL + ((size_t)((unit * 8 + n) * 8 + w) * 4) * 256 + lane * 4;
#pragma unroll
                    for (int ti = 0; ti < 4; ++ti) *(f32x4*)(ob + ti * 256) = O[ti];
                    __syncthreads();
                } else {
                    float part[4][4];
#pragma unroll
                    for (int ti = 0; ti < 4; ++ti)
#pragma unroll
                        for (int r = 0; r < 4; ++r) { const float o = O[ti][r]; part[ti][r] = row16_sum(o * o); }
                    unsigned short gq[4][4];
#pragma unroll
                    for (int ti = 0; ti < 4; ++ti)
#pragma unroll
                        for (int r = 0; r < 4; ++r) { const bf16_t* gb = G + (size_t)(rb + 51 - 16 * ti - r) * DM + h * 128 + 16 * w; gq[ti][r] = gb[loff]; }
                    if (i16 == 0) {
#pragma unroll
                        for (int ti = 0; ti < 4; ++ti) *(LAS f32x4*)(lds + GL_SSQ + (w * 64 + 16 * ti + 4 * g) * 4) = (f32x4){part[ti][0], part[ti][1], part[ti][2], part[ti][3]}; }
                    __syncthreads();
                    if (tid < 64) { float s2 = 0.f;
#pragma unroll
                        for (int ww = 0; ww < 8; ++ww) s2 += ((const LAS float*)(lds + GL_SSQ))[ww * 64 + tid];
                        ((LAS float*)(lds + GL_RSTD))[tid] = 1.f / sqrtf(s2 * (1.f / 128.f) + 1e-6f); }
                    __syncthreads();
#pragma unroll
                    for (int ti = 0; ti < 4; ++ti) { const f32x4 rs = *(const LAS f32x4*)(lds + GL_RSTD + (16 * ti + 4 * g) * 4);
#pragma unroll
                        for (int r = 0; r < 4; ++r) *(LAS unsigned short*)(lds + GL_QT + (63 - (16 * ti + 4 * g + r)) * ON_STR + (16 * w + i16) * 2) = (unsigned short)f2bf(O[ti][r] * rs[r] * ngv * bf2f(gq[ti][r])); }
                    on_rb = rb;
                }
            }
            if (on_rb >= 0) { __syncthreads(); GLA_ON_FLUSH(); on_rb = -1; }
            asm volatile("s_waitcnt vmcnt(0)" ::: "memory");
            __syncthreads();
        }
    }
}

__device__ __forceinline__ void ph_modffn(const Params& p, unsigned char* lds, int bid, int nblk, int l) {
    int tid_ = threadIdx.x; asm volatile("" : "+v"(tid_));
    const int tid = tid_, lane = tid & 63, wave = tid >> 6;
    float* rw = (float*)lds;
    float* stg = (float*)(lds + 71680);
    const float* router = p.in[I_ROUTER] + (size_t)l * DM * NE;
    for (int i = tid; i < DM * NE / 4; i += NTHR) { const int d = i >> 2; *(f32x4*)(rw + d * 16 + (d >> 2) * 4 + (i & 3) * 4) = ((const f32x4*)router)[i]; }
    __syncthreads();
    const float* X = (const float*)(p.ws + WS_X); bf16_t* H = (bf16_t*)(p.ws + WS_H); float* aff = (float*)(p.ws + WS_AFF); int* slot = (int*)(p.ws + WS_SLOT);
    const float* g = p.in[I_NFFN] + (size_t)l * DM; const float* mod = (const float*)(p.ws + WS_MOD);
    for (int base = bid * 64; base < NTOK; base += nblk * 64) {
        const int b = base >> 13, t0 = base & (SEQ - 1);
        const float* mv = mod + (size_t)(l * 3 + b) * NADA; const float* sh = mv + 3 * DM; const float* sc = mv + 4 * DM;
        f32x4 nxv[4];
#pragma unroll
        for (int j = 0; j < 4; ++j) nxv[j] = *(const f32x4*)(X + (size_t)(base + 8 * wave) * DM + 256 * j + 4 * lane);
#pragma unroll 1
        for (int r = 0; r < 8; ++r) {
            const int row = base + 8 * wave + r;
            f32x4 v[4]; float ss = 0.f;
#pragma unroll
            for (int j = 0; j < 4; ++j) { v[j] = nxv[j]; ss += (v[j][0] * v[j][0] + v[j][1] * v[j][1]) + (v[j][2] * v[j][2] + v[j][3] * v[j][3]); }
            if (r < 7) {
#pragma unroll
                for (int j = 0; j < 4; ++j) nxv[j] = *(const f32x4*)(X + (size_t)(row + 1) * DM + 256 * j + 4 * lane); }
            const float rstd = 1.f / sqrtf(wave_sum(ss) * (1.f / DM) + 1e-6f);
            float lg[16];
#pragma unroll
            for (int e = 0; e < 16; ++e) lg[e] = 0.f;
#pragma unroll
            for (int j = 0; j < 4; ++j) { const int c0 = 256 * j + 4 * lane; const f32x4 gv = *(const f32x4*)(g + c0), shv = *(const f32x4*)(sh + c0), scv = *(const f32x4*)(sc + c0);
                f32x4 h;
#pragma unroll
                for (int i = 0; i < 4; ++i) { h[i] = (v[j][i] * rstd * gv[i]) * (1.f + scv[i]) + shv[i];
                    const float* rp = rw + (c0 + i) * 16 + (c0 >> 2) * 4; const f32x4 r0 = *(const f32x4*)(rp), r1 = *(const f32x4*)(rp + 4), r2 = *(const f32x4*)(rp + 8), r3 = *(const f32x4*)(rp + 12);
#pragma unroll
                    for (int e = 0; e < 4; ++e) { lg[e] += h[i] * r0[e]; lg[4 + e] += h[i] * r1[e]; lg[8 + e] += h[i] * r2[e]; lg[12 + e] += h[i] * r3[e]; }
                    asm volatile("" ::: "memory"); }
                u32x2 w; w.x = pk2(h[0], h[1]); w.y = pk2(h[2], h[3]); *(u32x2*)(H + (size_t)row * DM + c0) = w; }
            float a8[8], a4[4], a2[2], a1;
#pragma unroll
            for (int i = 0; i < 8; ++i) a8[i] = swap32_add(lg[i], lg[8 + i]);
#pragma unroll
            for (int i = 0; i < 4; ++i) a4[i] = swap16_add(a8[i], a8[4 + i]);
            { const bool hi = (lane & 8) != 0;
#pragma unroll
                for (int i = 0; i < 2; ++i) { const float send = hi ? a4[i] : a4[2 + i], keep = hi ? a4[2 + i] : a4[i]; a2[i] = keep + lane_xor8(send); } }
            { const bool hi = (lane & 4) != 0; const float send = hi ? a2[0] : a2[1], keep = hi ? a2[1] : a2[0]; a1 = keep + lane_xor4(send); }
            a1 += dpp_f<0x4E>(a1); a1 += dpp_f<0xB1>(a1);
            float mx = a1;
            mx = fmaxf(mx, lane_xor4(mx)); mx = fmaxf(mx, lane_xor8(mx)); mx = swap16_max(mx); mx = swap32_max(mx);
            const float ex = expf(a1 - mx); float den = ex;
            den += lane_xor4(den); den += lane_xor8(den); den = swap16_add(den, den); den = swap32_add(den, den);
            if ((lane & 3) == 0) stg[((lane >> 2) & 15) * 64 + 8 * wave + r] = ex / den;
        }
        __syncthreads();
        { const int e = tid >> 5, tt = (tid & 31) * 2; *(f32x2*)(aff + (size_t)(b * NE + e) * SEQ + t0 + tt) = *(const f32x2*)(stg + e * 64 + tt);
            *(u32x2*)(slot + (size_t)base * NE + 2 * tid) = (u32x2){0xffffffffu, 0xffffffffu}; }
        __syncthreads();
    }
}

__device__ __forceinline__ void ph_topk(const Params& p, unsigned char* lds, int bid, int nblk) {
    int tid_ = threadIdx.x; asm volatile("" : "+v"(tid_)); const int tid = tid_, lane = tid & 63, wave = tid >> 6;
    unsigned* hist = (unsigned*)lds;
    unsigned* ctl = hist + 256;
    unsigned* wsum = ctl + 8;
    const float* aff = (const float*)(p.ws + WS_AFF); int* topi = (int*)(p.ws + WS_TOPI); float* topg = (float*)(p.ws + WS_TOPG); int* slot = (int*)(p.ws + WS_SLOT);
    for (int it = bid; it < NB * NE; it += nblk) {
        const int b = it >> 4, e = it & 15; const float* src = aff + (size_t)it * SEQ + 16 * tid;
        unsigned key[16];
#pragma unroll
        for (int j = 0; j < 4; ++j) { const f32x4 v = *(const f32x4*)(src + 4 * j); key[4 * j] = __float_as_uint(v[0]); key[4 * j + 1] = __float_as_uint(v[1]); key[4 * j + 2] = __float_as_uint(v[2]); key[4 * j + 3] = __float_as_uint(v[3]); }
        unsigned prefix = 0u;
#pragma unroll 1
        for (int bit = 30; bit >= 0; --bit) {
            const unsigned cand = prefix | (1u << bit);
            unsigned cnt = 0u;
#pragma unroll
            for (int i = 0; i < 16; ++i) cnt += (unsigned)__popcll(__ballot(key[i] >= cand));
            if (lane == 0) wsum[(bit & 1) * 8 + wave] = cnt;
            __syncthreads();
            unsigned tot = 0u;
#pragma unroll
            for (int w2 = 0; w2 < 8; ++w2) tot += wsum[(bit & 1) * 8 + w2];
            if (tot >= (unsigned)CAP) prefix = cand;
        }
        __syncthreads();
        unsigned cg = 0u, ce = 0u;
#pragma unroll
        for (int i = 0; i < 16; ++i) { cg += key[i] > prefix ? 1u : 0u; ce += key[i] == prefix ? 1u : 0u; }
        unsigned pk = cg | (ce << 16), inc = pk;
#pragma unroll
        for (int o = 1; o < 64; o <<= 1) { const unsigned t = __shfl_up(inc, o); if (lane >= o) inc += t; }
        if (lane == 63) wsum[wave] = inc;
        __syncthreads();
        unsigned base = 0u, total = 0u;
#pragma unroll
        for (int w2 = 0; w2 < 8; ++w2) { const unsigned t = wsum[w2]; if (w2 < wave) base += t; total += t; }
        const unsigned excl = base + inc - pk;
        unsigned rg = excl & 0xffffu, re = excl >> 16; const unsigned ngt = total & 0xffffu, kth = (unsigned)CAP - ngt;
#pragma unroll
        for (int i = 0; i < 16; ++i) { int s = -1;
            if (key[i] > prefix) { s = (int)rg; ++rg; }
            else if (key[i] == prefix) { if (re < kth) s = (int)(ngt + re); ++re; }
            if (s >= 0) { const int idx = 16 * tid + i, r = (e * NB + b) * CAP + s; topi[r] = b * SEQ + idx; topg[r] = __uint_as_float(key[i]); slot[(size_t)(b * SEQ + idx) * NE + e] = s; } }
        __syncthreads();
    }
}

__device__ __forceinline__ void ph_combine(const Params& p, int bid, int nblk, int l, bool final_) {
    int tid_ = threadIdx.x; asm volatile("" : "+v"(tid_));
    const int tid = tid_, lane = tid & 63, wave = tid >> 6, gw = bid * 8 + wave, NGW = nblk * 8;
    float* X = (float*)(p.ws + WS_X); bf16_t* H = (bf16_t*)(p.ws + WS_H); const bf16_t* Y = (const bf16_t*)(p.ws + WS_Y); const int* slot = (const int*)(p.ws + WS_SLOT); const float* topg = (const float*)(p.ws + WS_TOPG);
    const float* mod = (const float*)(p.ws + WS_MOD);
    int nslot = -1; f32x4 nxv[4];
    if (gw < NTOK) { nslot = lane < 16 ? slot[(size_t)gw * NE + lane] : -1;
#pragma unroll
        for (int j = 0; j < 4; ++j) nxv[j] = *(const f32x4*)(X + (size_t)gw * DM + 256 * j + 4 * lane); }
    for (int row = gw; row < NTOK; row += NGW) {
        const int b = row >> 13;
        const float* g2 = mod + (size_t)(l * 3 + b) * NADA + 5 * DM;
        const int myslot = nslot; f32x4 xv[4];
#pragma unroll
        for (int j = 0; j < 4; ++j) xv[j] = nxv[j];
        unsigned long long m = __ballot(myslot >= 0) & 0xffffull;
        f32x4 a[4];
#pragma unroll
        for (int j = 0; j < 4; ++j) a[j] = (f32x4){0.f, 0.f, 0.f, 0.f};
        u32x2 ya[4], yb[4];
#define YLOAD(dst, gdst, e_) do { const int s_ = __shfl(myslot, (e_)); const size_t yrow_ = (size_t)(((e_) * NB + b) * CAP + s_); const bf16_t* yr_ = Y + yrow_ * DM; gdst = topg[yrow_]; \
            _Pragma("unroll") for (int j = 0; j < 4; ++j) dst[j] = *(const u32x2*)(yr_ + 256 * j + 4 * lane); } while (0)
        float ga = 0.f, gb = 0.f;
        if (m) { const int e0 = __builtin_ctzll(m); m &= m - 1; YLOAD(ya, ga, e0); }
        const bool any = __ballot(myslot >= 0) & 0xffffull;
        { const int r2 = row + NGW; if (r2 < NTOK) { nslot = lane < 16 ? slot[(size_t)r2 * NE + lane] : -1;
#pragma unroll
            for (int j = 0; j < 4; ++j) nxv[j] = *(const f32x4*)(X + (size_t)r2 * DM + 256 * j + 4 * lane); } }
        if (any) for (;;) {
            const bool more = m != 0ull;
            if (more) { const int e1 = __builtin_ctzll(m); m &= m - 1; YLOAD(yb, gb, e1); }
#pragma unroll
            for (int j = 0; j < 4; ++j) { a[j][0] += ga * __uint_as_float(ya[j].x << 16); a[j][1] += ga * __uint_as_float(ya[j].x & 0xffff0000u); a[j][2] += ga * __uint_as_float(ya[j].y << 16); a[j][3] += ga * __uint_as_float(ya[j].y & 0xffff0000u); }
            if (!more) break;
            ga = gb;
#pragma unroll
            for (int j = 0; j < 4; ++j) ya[j] = yb[j];
        }
#undef YLOAD
        f32x4 v[4]; float ss = 0.f;
#pragma unroll
        for (int j = 0; j < 4; ++j) { const int c0 = 256 * j + 4 * lane; v[j] = xv[j] + *(const f32x4*)(g2 + c0) * a[j];
            ss += (v[j][0] * v[j][0] + v[j][1] * v[j][1]) + (v[j][2] * v[j][2] + v[j][3] * v[j][3]); }
        const float rstd = 1.f / sqrtf(wave_sum(ss) * (1.f / DM) + 1e-6f);
        if (final_) { const float* gf = p.in[I_NFIN];
#pragma unroll
            for (int j = 0; j < 4; ++j) { const int c0 = 256 * j + 4 * lane; const f32x4 gv = *(const f32x4*)(gf + c0); *(f32x4*)(p.out + (size_t)row * DM + c0) = v[j] * rstd * gv; }
        } else {
#pragma unroll
            for (int j = 0; j < 4; ++j) *(f32x4*)(X + (size_t)row * DM + 256 * j + 4 * lane) = v[j];
            const float* mv = mod + (size_t)((l + 1) * 3 + b) * NADA;
            store_mod_bf16(H + (size_t)row * DM, v, rstd, p.in[I_NMIX] + (size_t)(l + 1) * DM, mv, mv + DM, lane);
        }
    }
}

__device__ __forceinline__ void ph_conv(const Params& p, int bid, int nblk) {
    int tid_ = threadIdx.x; asm volatile("" : "+v"(tid_));
    const int tid = tid_, lane = tid & 63, wave = tid >> 6, gw = bid * 8 + wave, NGW = nblk * 8;
    const bf16_t* BG = (const bf16_t*)(p.ws + WS_BG); const bf16_t* CU = (const bf16_t*)(p.ws + WS_CU); bf16_t* Z = (bf16_t*)(p.ws + WS_Z);
    const float* wc = p.in[I_SCCONV];
    for (int row = gw; row < NTOK; row += NGW) { const int t = row & (SEQ - 1);
#pragma unroll
        for (int hh = 0; hh < 2; ++hh) { const int c0 = hh * 512 + 8 * lane; const size_t off = (size_t)row * DM + c0;
            const u16x8 z0 = {0, 0, 0, 0, 0, 0, 0, 0};
            const u16x8 um = t > 0 ? *(const u16x8*)(CU + off - DM) : z0, u0 = *(const u16x8*)(CU + off), up = t < SEQ - 1 ? *(const u16x8*)(CU + off + DM) : z0, bg = *(const u16x8*)(BG + off);
            float o[8];
#pragma unroll
            for (int i = 0; i < 8; ++i) o[i] = bf2f(bg[i]) * (wc[c0 + i] * bf2f(um[i]) + wc[DM + c0 + i] * bf2f(u0[i]) + wc[2 * DM + c0 + i] * bf2f(up[i]));
            u32x4 w; w.x = pk2(o[0], o[1]); w.y = pk2(o[2], o[3]); w.z = pk2(o[4], o[5]); w.w = pk2(o[6], o[7]); *(u32x4*)(Z + off) = w; }
    }
}

#define XB_TMO      128
#define XB_XCNT(j)  (256  + 64 * (j))
#define XB_XSUB(j)  (1280 + 64 * (j))
#define XB_XGEN(j)  (2304 + 64 * (j))
#define XB_TOP      3328
#define XB_TOPGEN   3392
#define XCD_BAR_WORDS 3456
#define XB_SPIN_CAP (1u << 18)
__device__ __forceinline__ unsigned xb_ld(unsigned* p)              { return __hip_atomic_load(p, __ATOMIC_RELAXED, __HIP_MEMORY_SCOPE_AGENT); }
__device__ __forceinline__ unsigned xb_add(unsigned* p, unsigned v) { return __hip_atomic_fetch_add(p, v, __ATOMIC_RELAXED, __HIP_MEMORY_SCOPE_AGENT); }
__device__ __forceinline__ unsigned xb_xcc_id() { return (unsigned)__builtin_amdgcn_s_getreg((3 << 11) | 20) & 0xFu; }
#define XB_SPIN(cond, bar) do { unsigned _sp = 0; while (cond) { __builtin_amdgcn_s_sleep(1); \
    if ((++_sp & 255u) == 0u) { if (xb_ld(&(bar)[XB_TMO])) break; if (_sp > XB_SPIN_CAP) { atomicAdd(&(bar)[XB_TMO], 1u); break; } } } } while (0)
struct XcdBarrier { unsigned* bar; unsigned x; volatile LAS unsigned* st; };
__device__ __forceinline__ XcdBarrier xcd_barrier_post(unsigned* bar, volatile LAS unsigned* st) {
    XcdBarrier b; b.bar = bar; b.x = xb_xcc_id(); b.st = st;
    if (threadIdx.x == 0) (void)xb_add(&bar[XB_XCNT(b.x)], 1u);
    return b;
}
__device__ __forceinline__ void xcd_barrier_complete(unsigned* bar, unsigned x, unsigned& nloc, unsigned& nx) {
    const unsigned G = gridDim.x * gridDim.y * gridDim.z;
    unsigned sum, cnt, mine, sp = 0u;
    for (;;) {
        sum = 0u; cnt = 0u; mine = 0u;
#pragma unroll
        for (unsigned j = 0; j < 16; ++j) { const unsigned c = xb_ld(&bar[XB_XCNT(j)]); sum += c; cnt += (c > 0u) ? 1u : 0u; mine = (j == x) ? c : mine; }
        if (sum == G) break;
        __builtin_amdgcn_s_sleep(1);
        if ((++sp & 255u) == 0u) { if (xb_ld(&bar[XB_TMO])) break; if (sp > XB_SPIN_CAP) { atomicAdd(&bar[XB_TMO], 1u); break; } }
    }
    nloc = mine > 0u ? mine : 1u; nx = cnt > 0u ? cnt : 1u;
}
__device__ __forceinline__ void xcd_barrier(const Params& p, unsigned char* lds, unsigned* bar_, volatile LAS unsigned* MISC, unsigned filler) {
    volatile LAS unsigned* st_ = MISC + 8;
    XcdBarrier b; b.bar = bar_; b.x = xb_xcc_id(); b.st = st_;
    asm volatile("s_waitcnt vmcnt(0)" ::: "memory");
    __syncthreads();
    unsigned target = 0u;
    if (threadIdx.x == 0) {
        unsigned* bar = b.bar;
        __builtin_amdgcn_s_waitcnt(0);
        unsigned nloc = b.st[0], nx = b.st[1];
        if (nloc == 0u) { xcd_barrier_complete(bar, b.x, nloc, nx); b.st[0] = nloc; b.st[1] = nx; }
        const unsigned epoch = b.st[2] + 1u; b.st[2] = epoch;
        const unsigned old = xb_add(&bar[XB_XSUB(b.x)], 1u);
        if (old + 1u == epoch * nloc) {
            __builtin_amdgcn_fence(__ATOMIC_RELEASE, "agent");
            asm volatile("s_waitcnt vmcnt(0)" ::: "memory");
            (void)xb_add(&bar[XB_TOP], 1u);
        }
        target = epoch * nx;
    }
    if (filler) {
        for (;;) {
            if (threadIdx.x == 0) MISC[MW_REL] = (xb_ld(&b.bar[XB_TOP]) >= target || xb_ld(&b.bar[XB_TMO])) ? 1u : 0u;
            __syncthreads();
            const unsigned rel = MISC[MW_REL];
            __syncthreads();
            if (rel) break;
            if (!cvt_batch(p, lds, MISC, filler)) break;
        }
    }
    if (threadIdx.x == 0) {
        XB_SPIN(xb_ld(&b.bar[XB_TOP]) < target, b.bar);
        __builtin_amdgcn_fence(__ATOMIC_ACQUIRE, "agent");
        asm volatile("s_waitcnt vmcnt(0)" ::: "memory");
    }
    __syncthreads();
}

constexpr int NPHASE = 19;
constexpr int CVB_P2 = 2, CVB_P8 = 4;
constexpr int MISC_OFF = 146944;
constexpr int CW_BAR = 4096;
constexpr int CW_CTX = 1024;
template <int LO, int HI> __global__ void __launch_bounds__(NTHR, 2) mega(Params p) {
    extern __shared__ __attribute__((aligned(16))) unsigned char lds[];
    const int bid = blockIdx.x, nblk = gridDim.x;
    PG8_LAS unsigned char* l3 = (PG8_LAS unsigned char*)lds;
    unsigned char* ws = p.ws;
    const float* mod = (const float*)(ws + WS_MOD);
    constexpr bool MULTI = (HI - LO) > 1;
    if (MULTI) {
        volatile LAS unsigned* MISC = (volatile LAS unsigned*)(l3 + MISC_OFF);
        if (threadIdx.x < 32) MISC[threadIdx.x] = 0u;
        __syncthreads();
        (void)xcd_barrier_post((unsigned*)(ws + WS_CTL) + CW_BAR, MISC + 8);
    }
#define IN(k) (LO <= (k) && (k) < HI)
#ifndef PROBE_DUP
#define PROBE_DUP 0u
#endif
#define DUPQ(k) (((PROBE_DUP) >> (k)) & 1u)
#define MISCP ((volatile LAS unsigned*)(l3 + MISC_OFF))
#define BARRIER_MASK(m) xcd_barrier(p, lds, (unsigned*)(p.ws + WS_CTL) + CW_BAR, MISCP, (m))
#define BARRIER_NOW() BARRIER_MASK(0u)
#define SEAM(k) do { if (IN(k) && IN((k) + 1)) BARRIER_MASK(((k) <= 7 ? 1u : 0u) | ((k) <= 15 ? 2u : 0u)); } while (0)
#define PHASE(k, ...) do { if (IN(k)) { __VA_ARGS__; if (DUPQ(k)) { BARRIER_NOW(); __VA_ARGS__; } } SEAM(k); } while (0)
#define GEMM_INPROJ() do { pg8::Gemm g{(const bf16_t*)(ws + WS_H), (const bf16_t*)(ws + WS_WHGIN), NTOK, 5120, DM}; pg8::StaticOrder S; S.init(NTOK, 5120, nblk, bid, 0); EpiInProj E{ws}; pg8::gemm_phase<EpiInProj, pg8::StaticOrder, false>(l3, g, S, E, nullptr); } while (0)
#define GEMM_OUT(AOFF, WOFF, GATE) do { pg8::Gemm g{(const bf16_t*)(ws + (AOFF)), (const bf16_t*)(ws + (WOFF)), NTOK, DM, DM}; pg8::StaticOrder S; S.init(NTOK, DM, nblk, bid, 0); EpiResid E{(float*)(ws + WS_X), (GATE)}; pg8::gemm_phase<EpiResid, pg8::StaticOrder, false>(l3, g, S, E, nullptr); } while (0)
#define GEMM_MOE1(l) do { pg8::Gemm g{(const bf16_t*)(ws + WS_H), (const bf16_t*)(ws + WS_WMOE1) + (size_t)(l) * NE * 4096 * DM, NSLOT, 4096, DM}; pg8::StaticOrder S; S.init(NSLOT, 4096, nblk, bid, 8); EpiGLU E{(bf16_t*)(ws + WS_ACT)}; pg8::gemm_phase<EpiGLU, pg8::StaticOrder, true>(l3, g, S, E, (const int*)(ws + WS_TOPI)); } while (0)
#define GEMM_MOE2(l) do { pg8::Gemm g{(const bf16_t*)(ws + WS_ACT), (const bf16_t*)(ws + WS_WMOE2) + (size_t)(l) * NE * DM * DE, NSLOT, DM, DE}; pg8::StaticOrder S; S.init(NSLOT, DM, nblk, bid, 8); EpiRowScale E{(bf16_t*)(ws + WS_Y), (const float*)(ws + WS_TOPG)}; pg8::gemm_phase<EpiRowScale, pg8::StaticOrder, false>(l3, g, S, E, nullptr); } while (0)
#define GEMM_CONVIN() do { pg8::Gemm g{(const bf16_t*)(ws + WS_H), (const bf16_t*)(ws + WS_WSCIN), NTOK, 3072, DM}; pg8::StaticOrder S; S.init(NTOK, 3072, nblk, bid, 0); EpiConvIn E{(bf16_t*)(ws + WS_BG), (bf16_t*)(ws + WS_CU)}; pg8::gemm_phase<EpiConvIn, pg8::StaticOrder, false>(l3, g, S, E, nullptr); } while (0)
#define MOD0_PHASE() do { if (nblk >= 48) { if (bid < 24) { ph_mod0(p, NTOK + (bid * NCTX) / 24, NTOK + ((bid + 1) * NCTX) / 24, 0, 1); \
              \
            asm volatile("s_waitcnt vmcnt(0)" ::: "memory"); __syncthreads(); \
            if (threadIdx.x == 0) { unsigned* cnt = (unsigned*)(p.ws + WS_CTL) + CW_CTX; __builtin_amdgcn_fence(__ATOMIC_RELEASE, "agent"); asm volatile("s_waitcnt vmcnt(0)" ::: "memory"); \
                xb_add(cnt, 1u); unsigned sp_ = 0u; while (xb_ld(cnt) < 24u) { __builtin_amdgcn_s_sleep(1); if (++sp_ > (1u << 22)) break; } \
                __builtin_amdgcn_fence(__ATOMIC_ACQUIRE, "agent"); asm volatile("s_waitcnt vmcnt(0)" ::: "memory"); } \
            __syncthreads(); \
            pg8::Gemm g{(const bf16_t*)(ws + WS_H), (const bf16_t*)(ws + WS_WHGIN), NROW, 5120, DM}; pg8::OneUnit S{64 + bid / 12, 4 + bid % 12}; EpiInProj E{ws}; pg8::gemm_phase<EpiInProj, pg8::OneUnit, false>(l3, g, S, E, nullptr); } \
          else ph_mod0(p, 0, NTOK, bid - 24, nblk - 24); } \
        else { ph_mod0(p, 0, NROW, bid, nblk); } } while (0)
#define CTX_TILES_FALLBACK() do { if (nblk < 48) { BARRIER_NOW(); pg8::Gemm g{(const bf16_t*)(ws + WS_H), (const bf16_t*)(ws + WS_WHGIN), NROW, 5120, DM}; \
        for (int ti = bid; ti < 24; ti += nblk) { pg8::OneUnit S{64 + ti / 12, 4 + ti % 12}; EpiInProj E{ws}; pg8::gemm_phase<EpiInProj, pg8::OneUnit, false>(l3, g, S, E, nullptr); } } } while (0)
    PHASE(0, ph_prep(p, lds, bid, nblk); __syncthreads(); ph_convert_small(p, lds, bid, nblk));
    if (IN(1)) { MOD0_PHASE(); CTX_TILES_FALLBACK(); }
    SEAM(1);
#define HOSTED(GEMM_RANGE, NR, NBATCH) do { const bool odd_ = (bid & 1) != 0; \
        if (odd_) cvt_budget(p, lds, MISCP, 3u, NBATCH); \
        GEMM_RANGE(0, NR); __syncthreads(); \
        if (!odd_) cvt_budget(p, lds, MISCP, 3u, NBATCH); } while (0)
#define GEMM_INPROJ_R(LO_, HI_) do { pg8::Gemm g{(const bf16_t*)(ws + WS_H), (const bf16_t*)(ws + WS_WHGIN), NTOK, 5120, DM}; pg8::RangeOrder S; S.S.init(NTOK, 5120, nblk, bid, 0); S.lo = (LO_); S.hi = (HI_); EpiInProj E{ws}; pg8::gemm_phase<EpiInProj, pg8::RangeOrder, false>(l3, g, S, E, nullptr); } while (0)
#define GEMM_MOE1_R0(LO_, HI_) do { pg8::Gemm g{(const bf16_t*)(ws + WS_H), (const bf16_t*)(ws + WS_WMOE1), NSLOT, 4096, DM}; pg8::RangeOrder S; S.S.init(NSLOT, 4096, nblk, bid, 8); S.lo = (LO_); S.hi = (HI_); EpiGLU E{(bf16_t*)(ws + WS_ACT)}; pg8::gemm_phase<EpiGLU, pg8::RangeOrder, true>(l3, g, S, E, (const int*)(ws + WS_TOPI)); } while (0)
    PHASE(2, HOSTED(GEMM_INPROJ_R, 5, CVB_P2));
    PHASE(3, ph_gla_states(p, lds, bid, nblk));
    PHASE(4, ph_gla_out(p, lds, bid, nblk));
    if (IN(5)) { pg8::Gemm g{(const bf16_t*)(ws + WS_ON), (const bf16_t*)(ws + WS_WHGOUT), NTOK, DM, DM}; pg8::StaticOrder S; S.init(NTOK, DM, nblk, bid, 0);
        EpiResidPos E{(float*)(ws + WS_X), mod + 2 * DM, p.in[I_X], (const float*)(ws + WS_POSR), (const float*)(ws + WS_POSC)}; pg8::gemm_phase<EpiResidPos, pg8::StaticOrder, false>(l3, g, S, E, nullptr); }
    SEAM(5);
    PHASE(6, ph_modffn(p, lds, bid, nblk, 0));
    PHASE(7, ph_topk(p, lds, bid, nblk); __syncthreads(); cvt_drain_until(p, lds, MISCP, 0, 32768u));
    PHASE(8, HOSTED(GEMM_MOE1_R0, 8, CVB_P8); cvt_drain_until(p, lds, MISCP, 0, (unsigned)CV_ITEMS));
    PHASE(9, GEMM_MOE2(0));
    if (IN(10)) ph_combine(p, bid, nblk, 0, false);
    SEAM(10);
    PHASE(11, GEMM_CONVIN());
    PHASE(12, ph_conv(p, bid, nblk));
    if (IN(13)) GEMM_OUT(WS_Z, WS_WSCOUT, mod + (size_t)3 * NADA + 2 * DM);
    SEAM(13);
    PHASE(14, ph_modffn(p, lds, bid, nblk, 1));
    PHASE(15, ph_topk(p, lds, bid, nblk); __syncthreads(); cvt_drain_until(p, lds, MISCP, 1, 32768u));
    PHASE(16, GEMM_MOE1(1); __syncthreads(); cvt_drain_until(p, lds, MISCP, 1, (unsigned)CV_ITEMS));
    PHASE(17, GEMM_MOE2(1));
    if (IN(18)) ph_combine(p, bid, nblk, 1, true);
#undef IN
#undef SEAM
}

#ifndef MK_SPLIT
#define MK_SPLIT 0
#endif
#if MK_SPLIT
#include <utility>
template <int... I> static void launch_all(std::integer_sequence<int, I...>, int grid, Params& p, hipStream_t stream) {
    ((void)hipFuncSetAttribute((const void*)mega<I, I + 1>, hipFuncAttributeMaxDynamicSharedMemorySize, LDS_BYTES), ...);
    ((mega<I, I + 1><<<dim3(grid), dim3(NTHR), LDS_BYTES, stream>>>(p)), ...); }
#endif
extern "C" void kernel_launch(void* const* d_in, const int* in_sizes, int n_in, void* d_out, int out_size, void* d_ws, size_t ws_size, hipStream_t stream) {
    static int grid = 0;
    if (grid == 0) {
        if (n_in != 20 || ws_size < WS_END) { fprintf(stderr, "kernel_launch: unexpected inputs (n_in %d, ws %zu, need %zu)\n", n_in, ws_size, (size_t)WS_END); grid = -1; return; }
        int dev = 0, cus = 0, per_cu = 0;
        (void)hipGetDevice(&dev); (void)hipDeviceGetAttribute(&cus, hipDeviceAttributeMultiprocessorCount, dev);
        (void)hipFuncSetAttribute((const void*)mega<0, NPHASE>, hipFuncAttributeMaxDynamicSharedMemorySize, LDS_BYTES);
        if (hipOccupancyMaxActiveBlocksPerMultiprocessor(&per_cu, (const void*)mega<0, NPHASE>, NTHR, LDS_BYTES) != hipSuccess || per_cu < 1) { fprintf(stderr, "kernel_launch: occupancy query failed (%d)\n", per_cu); per_cu = 1; }
        (void)hipGetLastError();
        if (per_cu > 1) per_cu = 1;
        grid = (cus > 0 ? cus : 256) * per_cu;
    }
    if (grid < 0) return;
    Params p{};
    for (int i = 0; i < 20; ++i) p.in[i] = (const float*)d_in[i];
    p.out = (float*)d_out; p.ws = (unsigned char*)d_ws;
#if MK_SPLIT
    launch_all(std::make_integer_sequence<int, NPHASE>{}, grid, p, stream);
#else
    (void)hipMemsetAsync((char*)d_ws + WS_CTL, 0, 65536, stream);
    void* args[] = {&p};
    hipError_t e = hipLaunchCooperativeKernel((const void*)mega<0, NPHASE>, dim3(grid), dim3(NTHR), args, LDS_BYTES, stream);
    if (e != hipSuccess) fprintf(stderr, "kernel_launch: cooperative launch failed: %s (grid %d)\n", hipGetErrorString(e), grid);
#endif
}
```
